# Optimizing an MI355X kernel written in HIP

```python
import math
import jax, jax.numpy as jnp
from jax import lax
import numpy as np

D_MODEL = 2048
BATCH = 16
SEQ = 2048
DEPTH = 4

HEAD_DIM = 128
BRANCH_W = D_MODEL // 2
N_BRANCH = 3
NSA_HEADS = BRANCH_W // HEAD_DIM
NSA_KV_HEADS = NSA_HEADS // 4
NSA_GROUP = NSA_HEADS // NSA_KV_HEADS
CMP_BLOCK = 32
CMP_STRIDE = 16
SEL_BLOCK = 64
SEL_TOPK = 16
WINDOW = 512
Q_BLOCK = 128
SEL_QCHUNK = 16
SB_HEADS = BRANCH_W // HEAD_DIM
HG_DK = 128
HG_DV = 128
HG_HEADS = BRANCH_W // HG_DV
HG_CHUNK = 64
D_FF = 256 * ((8 * D_MODEL // 3 + 255) // 256)
CONV_W = 3
REL_BUCKETS = 32
REL_MAX_DIST = 128
EPS = 1e-6
NEG = -1e30
TINY = 1e-30

NSA_Q = NSA_HEADS * HEAD_DIM
NSA_KV = NSA_KV_HEADS * HEAD_DIM
NSA_GATE = 3 * NSA_HEADS
SB_W = SB_HEADS * HEAD_DIM
HG_KW = HG_HEADS * HG_DK
HG_VW = HG_HEADS * HG_DV
SPLIT_SIZES = (NSA_Q,) + (NSA_KV,) * 6 + (NSA_GATE,) + (SB_W,) * 3 + (HG_KW, HG_KW, HG_VW, HG_VW, N_BRANCH * D_MODEL)
IN_COLS = sum(SPLIT_SIZES)

kernel_name = 'hybrid_nsa_stickbreaking_hgrn2_block'


def rmsnorm(x, g):
    xf = x.astype(jnp.float32)
    y = xf * lax.rsqrt(jnp.mean(xf * xf, axis=-1, keepdims=True) + EPS)
    return (y * g.astype(jnp.float32)).astype(x.dtype)


def masked_softmax(s, mask):
    s = jnp.where(mask, s, NEG)
    e = jnp.where(mask, jnp.exp(s - jnp.max(s, axis=-1, keepdims=True)), 0.0)
    return e / jnp.maximum(jnp.sum(e, axis=-1, keepdims=True), TINY)


def t5_bucket(dist):
    n = jnp.maximum(dist, 0)
    exact = REL_BUCKETS // 2
    big = exact + (jnp.log(jnp.maximum(n, 1).astype(jnp.float32) / exact)
                   / math.log(REL_MAX_DIST / exact) * (REL_BUCKETS - exact)).astype(jnp.int32)
    return jnp.where(n < exact, n, jnp.minimum(big, REL_BUCKETS - 1))


def nsa_mixer(q, kc, vc, ks, vs, kw, vw, g, q_gain, k_gain, cmp_pos, cmp_w1, cmp_w2, rel_bias):
    B, T, _ = q.shape
    G, R, Dh = NSA_KV_HEADS, NSA_GROUP, HEAD_DIM
    scale = HEAD_DIM ** -0.5
    q = rmsnorm(q.reshape(B, T, G, R, Dh), q_gain).transpose(0, 2, 3, 1, 4)
    kc, vc, ks, vs, kw, vw = (a.reshape(B, T, G, Dh).transpose(0, 2, 1, 3) for a in (kc, vc, ks, vs, kw, vw))
    ks = rmsnorm(ks, k_gain[1])
    kw = rmsnorm(kw, k_gain[2])
    tab_h = rel_bias.T
    tab_gr = tab_h.reshape(G, R, REL_BUCKETS)

    n_cmp = (T - CMP_BLOCK) // CMP_STRIDE + 1
    cidx = np.arange(n_cmp)[:, None] * CMP_STRIDE + np.arange(CMP_BLOCK)[None, :]

    def compress(a, j):
        blocks = a[:, :, cidx] + cmp_pos[j]
        hid = jax.nn.gelu(jnp.einsum('bgnld,lde->bgne', blocks, cmp_w1[j]))
        return hid @ cmp_w2[j]

    kcmp = rmsnorm(compress(kc, 0), k_gain[0])
    vcmp = compress(vc, 1)
    dist_c = np.arange(T)[:, None] - cidx[None, :, -1]
    bias_c = jnp.take(tab_h, t5_bucket(jnp.asarray(dist_c)), axis=1).reshape(G, R, T, n_cmp)
    s_c = jnp.einsum('bgrtd,bgnd->bgrtn', q, kcmp).astype(jnp.float32) * scale + bias_c
    p_cmp = masked_softmax(s_c, jnp.asarray(dist_c >= 0))
    o_cmp = jnp.einsum('bgrtn,bgnd->bgrtd', p_cmp, vcmp)

    n_sel = T // SEL_BLOCK
    c_start = cidx[:, 0]
    s_start = np.arange(n_sel) * SEL_BLOCK
    overlap = ((c_start[:, None] < s_start[None, :] + SEL_BLOCK)
               & (c_start[:, None] + CMP_BLOCK > s_start[None, :])).astype(np.float32)
    imp = jnp.einsum('bgrtn,nj->bgtj', p_cmp, jnp.asarray(overlap))
    qblk = np.arange(T) // SEL_BLOCK
    jb = np.arange(n_sel)
    causal_b = jb[None, :] <= qblk[:, None]
    forced = causal_b & ((jb[None, :] == 0) | (jb[None, :] >= qblk[:, None] - 1))
    score = jnp.where(jnp.asarray(forced), jnp.inf, jnp.where(jnp.asarray(causal_b), imp, -jnp.inf))
    n_top = min(SEL_TOPK, n_sel)
    top_val, top_idx = lax.top_k(score, n_top)
    sel_ok = top_val > -jnp.inf

    kb = ks.reshape(B, G, n_sel, SEL_BLOCK, Dh)
    vb = vs.reshape(B, G, n_sel, SEL_BLOCK, Dh)
    QC = SEL_QCHUNK
    nqc = T // QC
    q_c = q.reshape(B, G, R, nqc, QC, Dh).transpose(3, 0, 1, 2, 4, 5)
    idx_c = top_idx.reshape(B, G, nqc, QC, n_top).transpose(2, 0, 1, 3, 4)
    ok_c = sel_ok.reshape(B, G, nqc, QC, n_top).transpose(2, 0, 1, 3, 4)
    pos_c = jnp.arange(T, dtype=jnp.int32).reshape(nqc, QC)
    b_ix = jnp.arange(B)[:, None, None, None]
    g_ix = jnp.arange(G)[None, :, None, None]
    g6 = jnp.arange(G).reshape(1, G, 1, 1, 1, 1)
    r6 = jnp.arange(R).reshape(1, 1, R, 1, 1, 1)

    def sel_block(args):
        qq, ii, ok, pp = args
        kg = kb[b_ix, g_ix, ii]
        vg = vb[b_ix, g_ix, ii]
        kpos = ii[..., None] * SEL_BLOCK + jnp.arange(SEL_BLOCK, dtype=jnp.int32)
        dist = pp[None, None, :, None, None] - kpos
        mask = (ok[..., None] & (dist >= 0))[:, :, None]
        bias = tab_gr[g6, r6, t5_bucket(dist)[:, :, None]]
        s = jnp.einsum('bgrqd,bgqksd->bgrqks', qq, kg).astype(jnp.float32) * scale + bias
        flat = s.shape[:4] + (-1,)
        p = masked_softmax(s.reshape(flat), mask.reshape(mask.shape[:4] + (-1,)))
        return jnp.einsum('bgrqm,bgqmd->bgrqd', p, vg.reshape(B, G, QC, -1, Dh))

    o_sel = lax.map(sel_block, (q_c, idx_c, ok_c, pos_c))
    o_sel = o_sel.transpose(1, 2, 3, 0, 4, 5).reshape(B, G, R, T, Dh)

    nqb = T // Q_BLOCK
    widx = np.arange(nqb)[:, None] * Q_BLOCK + np.arange(Q_BLOCK + WINDOW)[None, :]
    kwin = jnp.pad(kw, ((0, 0), (0, 0), (WINDOW, 0), (0, 0)))[:, :, widx]
    vwin = jnp.pad(vw, ((0, 0), (0, 0), (WINDOW, 0), (0, 0)))[:, :, widx]
    qpos = np.arange(nqb)[:, None] * Q_BLOCK + np.arange(Q_BLOCK)[None, :]
    kpos = widx - WINDOW
    dist_w = qpos[:, :, None] - kpos[:, None, :]
    mask_w = (dist_w >= 0) & (dist_w < WINDOW) & (kpos[:, None, :] >= 0)
    bias_w = jnp.take(tab_h, t5_bucket(jnp.asarray(dist_w)), axis=1).reshape(G, R, nqb, Q_BLOCK, Q_BLOCK + WINDOW)
    s_w = jnp.einsum('bgrnqd,bgnkd->bgrnqk', q.reshape(B, G, R, nqb, Q_BLOCK, Dh), kwin).astype(jnp.float32) * scale
    p_w = masked_softmax(s_w + bias_w, jnp.asarray(mask_w))
    o_win = jnp.einsum('bgrnqk,bgnkd->bgrnqd', p_w, vwin).reshape(B, G, R, T, Dh)

    gate = jax.nn.sigmoid(g.astype(jnp.float32)).reshape(B, T, G, R, 3).transpose(0, 2, 3, 1, 4)
    o = gate[..., 0:1] * o_cmp + gate[..., 1:2] * o_sel + gate[..., 2:3] * o_win
    return o.transpose(0, 3, 1, 2, 4).reshape(B, T, NSA_HEADS * Dh)


def stick_breaking(q, k, v):
    B, T, _ = q.shape
    q, k, v = (a.reshape(B, T, SB_HEADS, HEAD_DIM).transpose(0, 2, 1, 3) for a in (q, k, v))
    scale = HEAD_DIM ** -0.5
    outs = []
    for i in range(T // Q_BLOCK):
        end = (i + 1) * Q_BLOCK
        z = jnp.einsum('bhqd,bhkd->bhqk', q[:, :, i * Q_BLOCK:end], k[:, :, :end]).astype(jnp.float32) * scale
        causal = jnp.asarray(np.arange(end)[None, :] < np.arange(i * Q_BLOCK, end)[:, None])
        log_1mb = jnp.where(causal, jax.nn.log_sigmoid(-z), 0.0)
        log_a = jax.nn.log_sigmoid(z) + lax.cumsum(log_1mb, axis=3, reverse=True) - log_1mb
        a = jnp.where(causal, jnp.exp(log_a), 0.0)
        outs.append(jnp.einsum('bhqk,bhkd->bhqd', a, v[:, :, :end]))
    o = jnp.concatenate(outs, axis=2)
    return o.transpose(0, 2, 1, 3).reshape(B, T, SB_HEADS * HEAD_DIM)


def hgrn2(q, f_pre, inp, g_out, lb, norm_gain):
    B, T, _ = q.shape
    H, C = HG_HEADS, HG_CHUNK
    nc = T // C
    f_pre = f_pre.astype(jnp.float32).reshape(B, T, H, HG_DK)
    lb = lb.reshape(H, HG_DK)
    log_f = jnp.logaddexp(jnp.log(lb), jnp.log1p(-lb) + jax.nn.log_sigmoid(f_pre))
    k = (1.0 - lb) * jax.nn.sigmoid(-f_pre)

    def chunks(a, d):
        return a.astype(jnp.float32).reshape(B, nc, C, H, d).transpose(1, 0, 3, 2, 4)

    xs = (chunks(q, HG_DK), chunks(k, HG_DK), chunks(inp, HG_DV), chunks(log_f, HG_DK))
    tri = jnp.asarray(np.tril(np.ones((C, C), dtype=bool)))

    def step(S, xs_c):
        qq, kk, vv, lf = xs_c
        b = jnp.cumsum(lf, axis=2)
        decay = jnp.exp(jnp.where(tri[:, :, None], b[:, :, :, None, :] - b[:, :, None, :, :], -jnp.inf))
        a = jnp.einsum('bhtd,bhsd,bhtsd->bhts', qq, kk, decay)
        o = jnp.einsum('bhts,bhse->bhte', a, vv) + jnp.einsum('bhtd,bhde->bhte', qq * jnp.exp(b), S)
        b_last = b[:, :, -1:, :]
        S = jnp.exp(b_last[:, :, 0, :, None]) * S + jnp.einsum('bhsd,bhse->bhde', kk * jnp.exp(b_last - b), vv)
        return S, o

    S0 = jnp.zeros((B, H, HG_DK, HG_DV), jnp.float32)
    _, o = lax.scan(step, S0, xs)
    o = o.transpose(1, 0, 3, 2, 4).reshape(B, T, H, HG_DV)
    gate = jax.nn.sigmoid(g_out.astype(jnp.float32).reshape(B, T, H, HG_DV))
    return (rmsnorm(o, norm_gain) * gate).reshape(B, T, H * HG_DV)


def conv_ffn(h, w_up, conv_w, conv_b, w_down):
    u = h @ w_up
    T = u.shape[1]
    up = jnp.pad(u, ((0, 0), (CONV_W - 1, 0), (0, 0)))
    c = conv_b
    for j in range(CONV_W):
        c = c + up[:, j:j + T] * conv_w[j]
    gate, val = jnp.split(c, 2, axis=-1)
    return (jax.nn.silu(gate) * val) @ w_down


def setup_inputs(seed: int = 0) -> dict:
    key = jax.random.key(seed)
    ks = jax.random.split(key, 18)

    def nrm(k, shape, scale):
        return jax.random.normal(k, shape, jnp.float32) * scale

    res = (2 * DEPTH) ** -0.5
    return {
        'x': nrm(ks[0], (BATCH, SEQ, D_MODEL), 1.0),
        'norm_attn': 1.0 + nrm(ks[1], (DEPTH, D_MODEL), 0.02),
        'w_in': nrm(ks[2], (DEPTH, D_MODEL, IN_COLS), D_MODEL ** -0.5),
        'nsa_q_gain': 1.0 + nrm(ks[3], (DEPTH, HEAD_DIM), 0.02),
        'nsa_k_gain': 1.0 + nrm(ks[4], (DEPTH, 3, HEAD_DIM), 0.02),
        'cmp_pos': nrm(ks[5], (DEPTH, 2, CMP_BLOCK, HEAD_DIM), 0.02),
        'cmp_w1': nrm(ks[6], (DEPTH, 2, CMP_BLOCK, HEAD_DIM, HEAD_DIM), (CMP_BLOCK * HEAD_DIM) ** -0.5),
        'cmp_w2': nrm(ks[7], (DEPTH, 2, HEAD_DIM, HEAD_DIM), HEAD_DIM ** -0.5),
        'rel_bias': nrm(ks[8], (REL_BUCKETS, NSA_HEADS), 0.1),
        'hg_lower_bound': nrm(ks[9], (DEPTH, HG_HEADS * HG_DK), 0.1),
        'hg_norm_gain': 1.0 + nrm(ks[10], (DEPTH, HG_DV), 0.02),
        'w_branch': nrm(ks[11], (DEPTH, N_BRANCH, BRANCH_W, D_MODEL), BRANCH_W ** -0.5),
        'w_out': nrm(ks[12], (DEPTH, D_MODEL, D_MODEL), D_MODEL ** -0.5 * res),
        'norm_ffn': 1.0 + nrm(ks[13], (DEPTH, D_MODEL), 0.02),
        'w_up': nrm(ks[14], (DEPTH, D_MODEL, 2 * D_FF), D_MODEL ** -0.5),
        'conv_w': nrm(ks[15], (DEPTH, CONV_W, 2 * D_FF), CONV_W ** -0.5),
        'conv_b': nrm(ks[16], (DEPTH, 2 * D_FF), 0.02),
        'w_down': nrm(ks[17], (DEPTH, D_FF, D_MODEL), D_FF ** -0.5 * res),
    }


def reference(x, norm_attn, w_in, nsa_q_gain, nsa_k_gain, cmp_pos, cmp_w1, cmp_w2, rel_bias,
              hg_lower_bound, hg_norm_gain, w_branch, w_out, norm_ffn, w_up, conv_w, conv_b, w_down):
    B, T, _ = x.shape
    lb_all = jnp.cumsum(jax.nn.softmax(hg_lower_bound.astype(jnp.float32), axis=0), axis=0)
    lb_all = jnp.maximum(lb_all - lb_all[0:1], 0.0)
    split_at = np.cumsum(SPLIT_SIZES)[:-1].tolist()
    for l in range(DEPTH):
        h = rmsnorm(x, norm_attn[l])
        (q_n, kc_n, vc_n, ks_n, vs_n, kw_n, vw_n, g_n, q_s, k_s, v_s,
         q_h, f_h, i_h, g_h, gates) = jnp.split(h @ w_in[l], split_at, axis=-1)
        o_nsa = nsa_mixer(q_n, kc_n, vc_n, ks_n, vs_n, kw_n, vw_n, g_n, nsa_q_gain[l], nsa_k_gain[l],
                          cmp_pos[l], cmp_w1[l], cmp_w2[l], rel_bias).astype(h.dtype)
        o_sb = stick_breaking(q_s, k_s, v_s).astype(h.dtype)
        o_hg = hgrn2(q_h, f_h, i_h, g_h, lb_all[l], hg_norm_gain[l]).astype(h.dtype)
        branches = jnp.stack([o_nsa, o_sb, o_hg], axis=2)
        y = jnp.einsum('btnc,ncd->btnd', branches, w_branch[l])
        gsig = jax.nn.sigmoid(gates.astype(jnp.float32)).reshape(B, T, N_BRANCH, D_MODEL)
        merged = jnp.sum(gsig * y, axis=2).astype(h.dtype)
        x = x + merged @ w_out[l]
        x = x + conv_ffn(rmsnorm(x, norm_ffn[l]), w_up[l], conv_w[l], conv_b[l], w_down[l])
    return x
```

```cpp
#include <hip/hip_runtime.h>
#include <stdint.h>
#include <stdio.h>

#ifndef MK_ONE_LAUNCH
#define MK_ONE_LAUNCH 1
#endif
#ifndef MK_PHASE_MASK
#define MK_PHASE_MASK 0x3ff
#endif
#ifndef MK_BUILD_MASK
#define MK_BUILD_MASK 0x3ff
#endif

#define LAS __attribute__((address_space(3)))
typedef unsigned short bf16_t;
typedef short bf16x8 __attribute__((ext_vector_type(8)));
typedef short s16x4 __attribute__((ext_vector_type(4)));
typedef float f32x4 __attribute__((ext_vector_type(4)));
typedef float f32x16 __attribute__((ext_vector_type(16)));
typedef float f32x2 __attribute__((ext_vector_type(2)));
typedef unsigned u32x4 __attribute__((ext_vector_type(4)));
typedef unsigned u32x2 __attribute__((ext_vector_type(2)));
typedef __bf16 bfv2 __attribute__((ext_vector_type(2)));

constexpr int DM = 2048, NB = 16, T = 2048, DEPTH = 4, M = NB * T, HD = 128;
constexpr int INC = 15896;
constexpr int NPC = 16128;
constexpr int PQN = 0, PKC = 1024, PVC = 1280, PKS = 1536, PVS = 1792, PKW = 2048, PVW = 2304, PQS = 2560, PKSB = 3584, PVSB = 4608,
              PQH = 5632, PFH = 6656, PIH = 7680, PGH = 8704, PGT = 9728, PGN = 15872;
constexpr int DFF = 5632, NUP = 2 * DFF;
constexpr int BW = 1024;
constexpr float EPS = 1e-6f;
constexpr float LOG2E = 1.4426950408889634f, LN2 = 0.6931471805599453f;
constexpr float QSCALE = 0.08838834764831845f;

constexpr size_t MiB = 1u << 20;
constexpr size_t WS_CTL = 0, CTL_BYTES = 1 * MiB;
constexpr size_t WS_WIN = 1 * MiB, WS_WBR = 64 * MiB, WS_WOUT = 76 * MiB, WS_WUP = 84 * MiB, WS_WDN = 128 * MiB;
constexpr size_t WS_MISC = 150 * MiB;
constexpr size_t MISC_CVEC = 0, MISC_KCMP = 64 * 1024, MISC_VCMP = MISC_KCMP + 1 * MiB, MISC_LB = MISC_VCMP + 1 * MiB;
constexpr size_t WS_SCR = 154 * MiB;
constexpr size_t WS_P = 218 * MiB;
constexpr size_t WS_H = 1226 * MiB;
constexpr size_t WS_OBR = 1354 * MiB;
constexpr size_t WS_ORAW = 1546 * MiB;
constexpr size_t WS_END = 1674 * MiB;
constexpr size_t WS_ACT = WS_P + 704 * MiB;
constexpr int CW_BAR = 4096;
constexpr int CW_QUEUE = 16384;

constexpr int RING_BYTES = 131072;
constexpr int MISC_OFF = RING_BYTES;
constexpr int LDS_BYTES = 147456;

__device__ __forceinline__ float bf2f(unsigned short b) { return __uint_as_float(((unsigned)b) << 16); }
__device__ __forceinline__ float bflo(unsigned w) { return __uint_as_float(w << 16); }
__device__ __forceinline__ float bfhi(unsigned w) { return __uint_as_float(w & 0xffff0000u); }
__device__ __forceinline__ unsigned pk2(float lo, float hi) { f32x2 v = {lo, hi}; bfv2 b = __builtin_convertvector(v, bfv2); return __builtin_bit_cast(unsigned, b); }
__device__ __forceinline__ float wave_sum(float v) {
#pragma unroll
    for (int o = 1; o < 64; o <<= 1) v += __shfl_xor(v, o);
    return v;
}
__device__ __forceinline__ float fast_exp2(float x) { return __builtin_amdgcn_exp2f(x); }
__device__ __forceinline__ float fast_log2(float x) { return __builtin_amdgcn_logf(x); }
__device__ __forceinline__ float fast_rcp(float x) { return __builtin_amdgcn_rcpf(x); }
__device__ __forceinline__ float sigmoidf_(float x) { return fast_rcp(1.f + fast_exp2(-x * LOG2E)); }
#define LDS_WAIT() asm volatile("s_waitcnt lgkmcnt(0)" ::: "memory")

#define XB_TMO      128
#define XB_XCNT(j)  (256  + 64 * (j))
#define XB_XSUB(j)  (1280 + 64 * (j))
#define XB_XGEN(j)  (2304 + 64 * (j))
#define XB_TOP      3328
#define XB_TOPGEN   3392
#define XCD_BAR_WORDS 3456
#define XB_SPIN_CAP (1u << 22)
__device__ __forceinline__ unsigned xb_ld(unsigned* p)              { return __hip_atomic_load(p, __ATOMIC_RELAXED, __HIP_MEMORY_SCOPE_AGENT); }
__device__ __forceinline__ unsigned xb_add(unsigned* p, unsigned v) { return __hip_atomic_fetch_add(p, v, __ATOMIC_RELAXED, __HIP_MEMORY_SCOPE_AGENT); }
__device__ __forceinline__ unsigned xb_xcc_id() { return (unsigned)__builtin_amdgcn_s_getreg((3 << 11) | 20) & 0xFu; }
#define XB_SPIN(cond, bar) do { unsigned _sp = 0; while (cond) { __builtin_amdgcn_s_sleep(1); \
    if ((++_sp & 255u) == 0u) { if (xb_ld(&(bar)[XB_TMO])) break; if (_sp > XB_SPIN_CAP) { atomicAdd(&(bar)[XB_TMO], 1u); break; } } } } while (0)
struct XcdBarrier { unsigned* bar; unsigned x; volatile LAS unsigned* st; };
__device__ __forceinline__ XcdBarrier xcd_barrier_post(unsigned* bar, volatile LAS unsigned* st) {
    XcdBarrier b; b.bar = bar; b.x = xb_xcc_id(); b.st = st;
    if (threadIdx.x == 0) (void)xb_add(&bar[XB_XCNT(b.x)], 1u);
    return b;
}
__device__ __forceinline__ void xcd_barrier_complete(unsigned* bar, unsigned x, unsigned& nloc, unsigned& nx) {
    const unsigned G = gridDim.x * gridDim.y * gridDim.z;
    unsigned sum, cnt, mine, sp = 0u;
    for (;;) {
        sum = 0u; cnt = 0u; mine = 0u;
#pragma unroll
        for (unsigned j = 0; j < 16; ++j) { const unsigned c = xb_ld(&bar[XB_XCNT(j)]); sum += c; cnt += (c > 0u) ? 1u : 0u; mine = (j == x) ? c : mine; }
        if (sum == G) break;
        __builtin_amdgcn_s_sleep(1);
        if ((++sp & 255u) == 0u) { if (xb_ld(&bar[XB_TMO])) break; if (sp > XB_SPIN_CAP) { atomicAdd(&bar[XB_TMO], 1u); break; } }
    }
    nloc = mine > 0u ? mine : 1u; nx = cnt > 0u ? cnt : 1u;
}
__device__ __forceinline__ void xcd_barrier(const XcdBarrier& b) {
    asm volatile("s_waitcnt vmcnt(0)" ::: "memory");
    __syncthreads();
    if (threadIdx.x == 0) {
        unsigned* bar = b.bar;
        __builtin_amdgcn_s_waitcnt(0);
        unsigned nloc = b.st[0], nx = b.st[1];
        if (nloc == 0u) { xcd_barrier_complete(bar, b.x, nloc, nx); b.st[0] = nloc; b.st[1] = nx; }
        const unsigned old = xb_add(&bar[XB_XSUB(b.x)], 1u);
        const unsigned gen = old / nloc;
        if (old + 1u == (gen + 1u) * nloc) {
            __builtin_amdgcn_fence(__ATOMIC_RELEASE, "agent");
            asm volatile("s_waitcnt vmcnt(0)" ::: "memory");
            const unsigned og = xb_add(&bar[XB_TOP], 1u);
            const unsigned tg = og / nx;
            if (og + 1u == (tg + 1u) * nx) xb_add(&bar[XB_TOPGEN], 1u);
            else XB_SPIN(xb_ld(&bar[XB_TOPGEN]) == tg, bar);
            __builtin_amdgcn_fence(__ATOMIC_ACQUIRE, "agent");
            xb_add(&bar[XB_XGEN(b.x)], 1u);
            asm volatile("s_waitcnt vmcnt(0)" ::: "memory");
        } else {
            XB_SPIN(xb_ld(&bar[XB_XGEN(b.x)]) == gen, bar);
            __builtin_amdgcn_fence(__ATOMIC_ACQUIRE, "agent");
            asm volatile("s_waitcnt vmcnt(0)" ::: "memory");
        }
    }
    __syncthreads();
}

namespace pg8 {
constexpr int BM = 256, BK = 64, HALF = 128, HTB = HALF * BK * 2, STAGE_BYTES = 8 * HTB, NXCD = 8, WGM = 8;
__host__ __device__ __forceinline__ int lds_byte(int r, int c) { const int st = (r >> 4) * 2 + (c >> 5), rr = r & 15, cc = c & 31, ob = rr * 64 + cc * 2; return st * 1024 + (ob ^ (((ob >> 9) & 1) << 5)); }
__host__ __device__ __forceinline__ void stage_rc(int b, int& R, int& C) { const int st = b / 1024, sb = b % 1024, swz = sb ^ (((sb >> 9) & 1) << 5); R = (st >> 1) * 16 + swz / 64; C = (st & 1) * 32 + (swz % 64) / 2; }
__host__ __device__ __forceinline__ int perm32(int rho) { const int n = rho >> 4, i = rho & 15; return 8 * (i >> 2) + 4 * n + (i & 3); }
struct Unit { int pm, pn, aux; };
struct Gemm { const bf16_t* A; const bf16_t* Bt; int M, N, K; };
struct StaticOrder {
    int nM, nN, nwg, G, c;
    __device__ void init(int M_, int N_, int G_, int c_) { nM = M_ / BM; nN = N_ / BM; nwg = nM * nN; G = G_; c = c_; }
    __device__ __forceinline__ bool tile(long L, Unit& u) const {
        if (L >= nwg) return false;
        int wgid = (int)L; { const int q = nwg / NXCD, r = nwg % NXCD, xcd = wgid % NXCD, off = wgid / NXCD; wgid = (xcd < r ? xcd * (q + 1) : r * (q + 1) + (xcd - r) * q) + off; }
        const int nig = WGM * nN, gid = wgid / nig, fm = gid * WGM, gsz = (nM - fm) < WGM ? (nM - fm) : WGM;
        u.pm = fm + ((wgid % nig) % gsz); u.pn = (wgid % nig) / gsz; u.aux = 0; return true;
    }
    __device__ __forceinline__ bool next(int i, Unit& u) const { return tile((long)i * G + c, u); }
    __device__ __forceinline__ const char* aptr(const Gemm& g, const Unit& u, size_t tstep) const { return (const char*)g.A + (size_t)u.pm * tstep; }
    __device__ __forceinline__ const char* bptr(const Gemm& g, const Unit& u, size_t tstep) const { return (const char*)g.Bt + (size_t)u.pn * tstep; }
    __device__ __forceinline__ void a_ready(const Unit&) const {}
    __device__ __forceinline__ void done(const Unit&) const {}
};
struct BranchOrder : StaticOrder {
    __device__ __forceinline__ bool next(int i, Unit& u) const { const int ti = i / 3; if (!tile((long)ti * G + c, u)) return false; u.aux = i - 3 * ti; return true; }
    __device__ __forceinline__ const char* aptr(const Gemm& g, const Unit& u, size_t tstep) const { return (const char*)g.A + (size_t)u.aux * ((size_t)M * BW * 2) + (size_t)u.pm * tstep; }
    __device__ __forceinline__ const char* bptr(const Gemm& g, const Unit& u, size_t tstep) const { return (const char*)g.Bt + (size_t)(u.aux * (DM / 256) + u.pn) * tstep; }
};

struct EpiStoreBf16 {
    static constexpr bool PERM = true, AFTER_DRAIN = false;
    bf16_t* O; int ldc;
    __device__ __forceinline__ void operator()(const f32x4 (&acc)[2][2][4][2], const Unit& u, int wr, int wc, int fr, int fq) const {
        const int row0 = u.pm * BM + wr * 64 + fr, col0 = u.pn * BM + wc * 32 + 8 * fq;
#pragma unroll
        for (int ai = 0; ai < 2; ++ai)
#pragma unroll
            for (int m = 0; m < 4; ++m) { bf16_t* rowp = O + (size_t)(row0 + ai * HALF + m * 16) * ldc + col0;
#pragma unroll
                for (int bj = 0; bj < 2; ++bj) { const f32x4 v0 = acc[ai][bj][m][0], v1 = acc[ai][bj][m][1];
                    u32x4 w; w.x = pk2(v0[0], v0[1]); w.y = pk2(v0[2], v0[3]); w.z = pk2(v1[0], v1[1]); w.w = pk2(v1[2], v1[3]);
                    *(u32x4*)(rowp + bj * HALF) = w; } }
    }
};
struct EpiResidF32 {
    static constexpr bool PERM = false, AFTER_DRAIN = false;
    float* C; int ldc;
    __device__ __forceinline__ void operator()(const f32x4 (&acc)[2][2][4][2], const Unit& u, int wr, int wc, int fr, int fq) const {
        const int row0 = u.pm * BM + wr * 64 + fr, col0 = u.pn * BM + wc * 32 + 4 * fq;
#pragma unroll
        for (int ai = 0; ai < 2; ++ai)
#pragma unroll
            for (int m = 0; m < 4; ++m) { float* rowp = C + (size_t)(row0 + ai * HALF + m * 16) * ldc + col0;
                f32x4 old[2][2];
#pragma unroll
                for (int bj = 0; bj < 2; ++bj)
#pragma unroll
                    for (int n = 0; n < 2; ++n) old[bj][n] = *(const f32x4*)(rowp + bj * HALF + n * 16);
#pragma unroll
                for (int bj = 0; bj < 2; ++bj)
#pragma unroll
                    for (int n = 0; n < 2; ++n) *(f32x4*)(rowp + bj * HALF + n * 16) = old[bj][n] + acc[ai][bj][m][n]; }
    }
};
struct EpiBranch {
    static constexpr bool PERM = true, AFTER_DRAIN = false;
    const bf16_t* P; float* scr; bf16_t* merged; int tid;
    __device__ __forceinline__ void operator()(const f32x4 (&acc)[2][2][4][2], const Unit& u, int wr, int wc, int fr, int fq) const {
        const unsigned row0 = (unsigned)(u.pm * BM + wr * 64 + fr), col0 = (unsigned)(u.pn * BM + wc * 32 + 8 * fq);
        const char* Pg = (const char*)(P + PGT + u.aux * DM); const char* sb = (const char*)scr; char* mg = (char*)merged;
        const int aux = u.aux; unsigned tbase = (unsigned)tid * 16u; asm volatile("" : "+v"(tbase));
#pragma unroll
        for (int ai = 0; ai < 2; ++ai)
#pragma unroll
            for (int m = 0; m < 4; ++m) { const unsigned row = row0 + ai * HALF + m * 16;
                const unsigned poff = (row * (unsigned)NPC + col0) * 2u, moff = (row * (unsigned)DM + col0) * 2u;
#pragma unroll
                for (int bj = 0; bj < 2; ++bj) {
                    const u32x4 gw = *(const u32x4*)(Pg + (size_t)(poff + bj * 256u));
                    f32x4 s0, s1;
                    s0[0] = sigmoidf_(bflo(gw.x)); s0[1] = sigmoidf_(bfhi(gw.x)); s0[2] = sigmoidf_(bflo(gw.y)); s0[3] = sigmoidf_(bfhi(gw.y));
                    s1[0] = sigmoidf_(bflo(gw.z)); s1[1] = sigmoidf_(bfhi(gw.z)); s1[2] = sigmoidf_(bflo(gw.w)); s1[3] = sigmoidf_(bfhi(gw.w));
                    f32x4 v0 = acc[ai][bj][m][0] * s0, v1 = acc[ai][bj][m][1] * s1;
                    const unsigned soff = (unsigned)(((ai * 4 + m) * 2 + bj) * 2) * 8192u + tbase;
                    if (aux > 0) { v0 += *(const f32x4*)(sb + (size_t)soff); v1 += *(const f32x4*)(sb + (size_t)(soff + 8192u)); }
                    if (aux < 2) { *(f32x4*)(const_cast<char*>(sb) + (size_t)soff) = v0; *(f32x4*)(const_cast<char*>(sb) + (size_t)(soff + 8192u)) = v1; }
                    else { u32x4 w; w.x = pk2(v0[0], v0[1]); w.y = pk2(v0[2], v0[3]); w.z = pk2(v1[0], v1[1]); w.w = pk2(v1[2], v1[3]);
                        *(u32x4*)(mg + (size_t)(moff + bj * 256u)) = w; } }
                asm volatile("" ::: "memory"); }
    }
};

template <class Epi, class Sched, bool ALIGN_EPI = false, bool SP2 = false>
__device__ __forceinline__ void gemm_phase(LAS unsigned char* lds, const Gemm g, const Sched& S, const Epi& E, const int tid) {
    const int wid = __builtin_amdgcn_readfirstlane(tid >> 6), lane = tid & 63, wr = wid >> 2, wc = wid & 3, fr = lane & 15, fq = lane >> 4;
    const int K = g.K, nt = K / BK;
    unsigned voffA[2], voffB[2];
#pragma unroll
    for (int i = 0; i < 2; ++i) { int R, C; stage_rc(tid * 16 + i * 8192, R, C); const int Rb = Epi::PERM ? ((R & ~31) + perm32(R & 31)) : R;
        voffA[i] = (unsigned)(R * K + C) * 2u; voffB[i] = (unsigned)(Rb * K + C) * 2u; }
    const size_t kstep = (size_t)(BK * 2);
    const size_t hstep = (size_t)HALF * K * 2;
    const size_t tstep = 2 * hstep;
    const unsigned ldsw = (unsigned)wid * 1024u;
    const int aoff = lds_byte(wr * 64 + fr, fq * 8), boff = lds_byte(wc * 32 + fr, fq * 8);
#define PG8_SA(b, h) (((b) * 2 + (h)) * HTB)
#define PG8_SB(b, h) ((4 + (b) * 2 + (h)) * HTB)
#define PG8_STAGE(bufoff, gbase, voff) do { _Pragma("unroll") for (int _i = 0; _i < 2; ++_i) \
        __builtin_amdgcn_global_load_lds((const unsigned*)((const char*)(gbase) + (voff)[_i]), (LAS unsigned*)(lds + (bufoff) + ldsw + _i * 8192), 16, 0, 0); } while (0)
#define PG8_LDA(dst, b, h) do { _Pragma("unroll") for (int m = 0; m < 4; ++m) _Pragma("unroll") for (int k = 0; k < 2; ++k) dst[m][k] = *(const LAS bf16x8*)(lds + PG8_SA(b, h) + aoff + m * 2048 + k * 1024); } while (0)
#define PG8_LDB(dst, b, h) do { _Pragma("unroll") for (int n = 0; n < 2; ++n) _Pragma("unroll") for (int k = 0; k < 2; ++k) dst[n][k] = *(const LAS bf16x8*)(lds + PG8_SB(b, h) + boff + n * 2048 + k * 1024); } while (0)
#define PG8_MMA(ai, bj, At, Bt) do { __builtin_amdgcn_s_setprio(1); _Pragma("unroll") for (int m = 0; m < 4; ++m) _Pragma("unroll") for (int n = 0; n < 2; ++n) _Pragma("unroll") for (int k = 0; k < 2; ++k) \
        acc[ai][bj][m][n] = __builtin_amdgcn_mfma_f32_16x16x32_bf16(Bt[n][k], At[m][k], acc[ai][bj][m][n], 0, 0, 0); __builtin_amdgcn_s_setprio(0); } while (0)
#define PG8_WAIT_V(n) asm volatile("s_waitcnt vmcnt(" #n ")" ::: "memory")
#define PG8_WAIT_L(n) asm volatile("s_waitcnt lgkmcnt(" #n ")" ::: "memory")
#define PG8_BAR __builtin_amdgcn_s_barrier()
#define PG8_SCHED __builtin_amdgcn_sched_barrier(0)
    Unit cur, nxt; int ui = 0;
    if (!S.next(0, cur)) return;
    f32x4 acc[2][2][4][2];
#pragma unroll
    for (int a = 0; a < 2; ++a)
#pragma unroll
        for (int b = 0; b < 2; ++b)
#pragma unroll
            for (int m = 0; m < 4; ++m)
#pragma unroll
                for (int n = 0; n < 2; ++n) acc[a][b][m][n] = (f32x4){0.f, 0.f, 0.f, 0.f};
    bf16x8 At[4][2], B0[2][2], B1[2][2];
    const char* cA = S.aptr(g, cur, tstep); const char* cB = S.bptr(g, cur, tstep);
    S.a_ready(cur);
    if constexpr (SP2) {
        PG8_STAGE(PG8_SB(0, 0), cB, voffB); PG8_STAGE(PG8_SB(0, 1), cB + hstep, voffB); PG8_STAGE(PG8_SA(0, 0), cA, voffA); PG8_STAGE(PG8_SA(0, 1), cA + hstep, voffA);
        if (wr == 1) PG8_BAR;
        PG8_WAIT_V(2); PG8_BAR;
        PG8_STAGE(PG8_SB(1, 0), cB + kstep, voffB); PG8_STAGE(PG8_SA(1, 0), cA + kstep, voffA); PG8_STAGE(PG8_SB(1, 1), cB + hstep + kstep, voffB);
        PG8_WAIT_V(6); PG8_BAR;
    } else {
        PG8_STAGE(PG8_SB(0, 0), cB, voffB); PG8_STAGE(PG8_SA(0, 0), cA, voffA); PG8_STAGE(PG8_SB(0, 1), cB + hstep, voffB); PG8_STAGE(PG8_SA(0, 1), cA + hstep, voffA);
        if (wr == 1) PG8_BAR;
        PG8_WAIT_V(4); PG8_BAR;
        PG8_STAGE(PG8_SB(1, 0), cB + kstep, voffB); PG8_STAGE(PG8_SA(1, 0), cA + kstep, voffA); PG8_STAGE(PG8_SB(1, 1), cB + hstep + kstep, voffB);
        PG8_WAIT_V(6); PG8_BAR;
    }
    for (;;) {
        const bool has_next = S.next(ui + 1, nxt);
        const char* nA = has_next ? S.aptr(g, nxt, tstep) : cA; const char* nB = has_next ? S.bptr(g, nxt, tstep) : cB;
        for (int t = 0; t < nt; t += 2) {
            const bool last = (t == nt - 2);
            const char* a1 = cA + (size_t)(t + 1) * kstep;
            const char* a2 = last ? nA : cA + (size_t)(t + 2) * kstep; const char* b2 = last ? nB : cB + (size_t)(t + 2) * kstep;
            const char* a3 = a2 + kstep; const char* b3 = b2 + kstep;
            if (last && has_next) S.a_ready(nxt);
            if constexpr (SP2) {
            PG8_LDB(B0, 0, 0); PG8_LDB(B1, 0, 1); PG8_SCHED; PG8_LDA(At, 0, 0); PG8_STAGE(PG8_SA(1, 1), a1 + hstep, voffA);
            PG8_WAIT_V(8); PG8_WAIT_L(0); PG8_BAR; PG8_MMA(0, 0, At, B0); PG8_MMA(0, 1, At, B1); PG8_BAR; PG8_SCHED;
            PG8_LDA(At, 0, 1); PG8_STAGE(PG8_SB(0, 0), b2, voffB); PG8_STAGE(PG8_SB(0, 1), b2 + hstep, voffB); PG8_STAGE(PG8_SA(0, 0), a2, voffA);
            PG8_WAIT_V(8); PG8_WAIT_L(0); PG8_BAR; PG8_MMA(1, 0, At, B0); PG8_MMA(1, 1, At, B1); PG8_BAR; PG8_SCHED;
            PG8_LDB(B0, 1, 0); PG8_LDB(B1, 1, 1); PG8_SCHED; PG8_LDA(At, 1, 0); PG8_STAGE(PG8_SA(0, 1), a2 + hstep, voffA);
            PG8_WAIT_V(8); PG8_WAIT_L(0); PG8_BAR; PG8_MMA(0, 0, At, B0); PG8_MMA(0, 1, At, B1); PG8_BAR; PG8_SCHED;
            PG8_LDA(At, 1, 1); PG8_STAGE(PG8_SB(1, 0), b3, voffB); PG8_STAGE(PG8_SB(1, 1), b3 + hstep, voffB); PG8_STAGE(PG8_SA(1, 0), a3, voffA);
            PG8_WAIT_V(8); PG8_WAIT_L(0); PG8_BAR; PG8_MMA(1, 0, At, B0); PG8_MMA(1, 1, At, B1); PG8_BAR; PG8_SCHED;
            } else {
            PG8_LDB(B0, 0, 0); PG8_SCHED; PG8_LDA(At, 0, 0); PG8_STAGE(PG8_SA(1, 1), a1 + hstep, voffA);
            PG8_WAIT_L(8); PG8_BAR; PG8_WAIT_L(0); PG8_MMA(0, 0, At, B0); PG8_BAR; PG8_SCHED;
            PG8_LDB(B1, 0, 1); PG8_STAGE(PG8_SB(0, 0), b2, voffB);
            PG8_BAR; PG8_WAIT_L(0); PG8_MMA(0, 1, At, B1); PG8_BAR;
            PG8_LDA(At, 0, 1); PG8_STAGE(PG8_SA(0, 0), a2, voffA);
            PG8_BAR; PG8_WAIT_L(0); PG8_MMA(1, 0, At, B0); PG8_BAR; PG8_SCHED;
            PG8_STAGE(PG8_SB(0, 1), b2 + hstep, voffB);
            PG8_WAIT_V(6); PG8_BAR; PG8_MMA(1, 1, At, B1); PG8_BAR;
            PG8_LDB(B0, 1, 0); PG8_SCHED; PG8_LDA(At, 1, 0); PG8_STAGE(PG8_SA(0, 1), a2 + hstep, voffA);
            PG8_WAIT_L(8); PG8_BAR; PG8_WAIT_L(0); PG8_MMA(0, 0, At, B0); PG8_BAR; PG8_SCHED;
            PG8_LDB(B1, 1, 1); PG8_STAGE(PG8_SB(1, 0), b3, voffB);
            PG8_BAR; PG8_WAIT_L(0); PG8_MMA(0, 1, At, B1); PG8_BAR;
            PG8_LDA(At, 1, 1); PG8_STAGE(PG8_SA(1, 0), a3, voffA);
            PG8_BAR; PG8_WAIT_L(0); PG8_MMA(1, 0, At, B0); PG8_BAR; PG8_SCHED;
            PG8_STAGE(PG8_SB(1, 1), b3 + hstep, voffB);
            PG8_WAIT_V(6); PG8_BAR; PG8_MMA(1, 1, At, B1); PG8_BAR;
            }
        }
        if constexpr (ALIGN_EPI) { if (wr == 0) PG8_BAR; }
        if constexpr (!Epi::AFTER_DRAIN) { E(acc, cur, wr, wc, fr, fq); S.done(cur); }
        if (!has_next) break;
#pragma unroll
        for (int a = 0; a < 2; ++a)
#pragma unroll
            for (int b = 0; b < 2; ++b)
#pragma unroll
                for (int m = 0; m < 4; ++m)
#pragma unroll
                    for (int n = 0; n < 2; ++n) acc[a][b][m][n] = (f32x4){0.f, 0.f, 0.f, 0.f};
        cur = nxt; cA = nA; cB = nB; ++ui;
        if constexpr (ALIGN_EPI) { if (wr == 1) PG8_BAR; }
    }
    PG8_WAIT_V(0);
    if constexpr (!ALIGN_EPI) { if (wr == 0) PG8_BAR; }
    PG8_BAR;
#undef PG8_SA
#undef PG8_SB
#undef PG8_STAGE
#undef PG8_LDA
#undef PG8_LDB
#undef PG8_MMA
#undef PG8_WAIT_V
#undef PG8_WAIT_L
#undef PG8_BAR
#undef PG8_SCHED
}
}
#define PG8_SP2 true
#define PG8_ALIGN true

struct Args { const float* in[18]; float* out; unsigned char* ws; int ph_lo, ph_hi; };
enum { I_X = 0, I_NATT, I_WIN, I_QG, I_KG, I_CPOS, I_CW1, I_CW2, I_RELB, I_HLB, I_HNG, I_WBR, I_WOUT, I_NFFN, I_WUP, I_CONVW, I_CONVB, I_WDN };

struct Frame {
    LAS unsigned char* lds; volatile LAS unsigned* MISC;
    unsigned* ctl; unsigned char* ws;
    int tid, lane, wave, G, bid;
};

__device__ __forceinline__ int inproj_src_col(int n) { return n < 2560 ? n : (n < 15872 ? n + 24 : (n < 15896 ? n - 15872 + 2560 : -1)); }
__device__ __forceinline__ void transpose_item(const float* W, int K, int Nsrc, bf16_t* WT, const float* gain, int mode, LAS float* scr, int item, int nblk, int lane) {
    const int kb = item / nblk, nb = item - kb * nblk, k0 = 64 * kb, n0 = 32 * nb;
    const int nn = n0 + (lane & 31); const int sc = mode ? inproj_src_col(nn) : nn;
#pragma unroll 8
    for (int i = 0; i < 32; ++i) { const int kk = 2 * i + (lane >> 5); float v = sc >= 0 ? W[(size_t)(k0 + kk) * Nsrc + sc] : 0.f; if (gain) v *= gain[k0 + kk]; scr[kk * 33 + (lane & 31)] = v; }
    LDS_WAIT(); asm volatile("" ::: "memory");
    const int c = lane & 7;
#pragma unroll
    for (int j = 0; j < 4; ++j) { const int n = (lane >> 3) + 8 * j; const LAS float* s = scr + (8 * c) * 33 + n;
        u32x4 o; o.x = pk2(s[0 * 33], s[1 * 33]); o.y = pk2(s[2 * 33], s[3 * 33]); o.z = pk2(s[4 * 33], s[5 * 33]); o.w = pk2(s[6 * 33], s[7 * 33]);
        *(u32x4*)(WT + (size_t)(n0 + n) * K + k0 + 8 * c) = o; }
    LDS_WAIT(); asm volatile("" ::: "memory");
}
__device__ __forceinline__ void rms_row(const float* xin, float* xcopy, bf16_t* hout, int lane) {
    const f32x4* xr = (const f32x4*)xin + lane;
    f32x4 v[8]; float s = 0.f;
#pragma unroll
    for (int j = 0; j < 8; ++j) { v[j] = xr[64 * j]; s += (v[j].x * v[j].x + v[j].y * v[j].y) + (v[j].z * v[j].z + v[j].w * v[j].w); }
    s = wave_sum(s);
    const float r = rsqrtf(s * (1.f / DM) + EPS);
    if (xcopy) { f32x4* xc = (f32x4*)xcopy + lane;
#pragma unroll
        for (int j = 0; j < 8; ++j) xc[64 * j] = v[j]; }
    u32x2* o8 = (u32x2*)hout + lane;
#pragma unroll
    for (int j = 0; j < 8; ++j) { u32x2 w; w.x = pk2(v[j].x * r, v[j].y * r); w.y = pk2(v[j].z * r, v[j].w * r); o8[64 * j] = w; }
}

__device__ __forceinline__ void cvec_item(Frame& F, const Args& a, int layer, int j);
__device__ __forceinline__ void phase_A(Frame& F, const Args& a, int layer) {
    LAS float* scr = (LAS float*)(F.lds + F.wave * 16384);
    const int gw = F.bid * 8 + F.wave, NGW = F.G * 8;
    bf16_t* Wt_in = (bf16_t*)(F.ws + WS_WIN); bf16_t* Wt_br = (bf16_t*)(F.ws + WS_WBR); bf16_t* Wt_out = (bf16_t*)(F.ws + WS_WOUT);
    bf16_t* Wt_up = (bf16_t*)(F.ws + WS_WUP); bf16_t* Wt_dn = (bf16_t*)(F.ws + WS_WDN);
    const float* w_in = a.in[I_WIN] + (size_t)layer * DM * INC; const float* g_att = a.in[I_NATT] + layer * DM;
    const float* w_br = a.in[I_WBR] + (size_t)layer * 3 * BW * DM; const float* w_out = a.in[I_WOUT] + (size_t)layer * DM * DM;
    const float* w_up = a.in[I_WUP] + (size_t)layer * DM * NUP; const float* g_ffn = a.in[I_NFFN] + layer * DM;
    const float* w_dn = a.in[I_WDN] + (size_t)layer * DFF * DM;
    constexpr int I_IN = (DM / 64) * (NPC / 32), I_BR1 = (BW / 64) * (DM / 32), I_OUT = (DM / 64) * (DM / 32), I_UP = (DM / 64) * (NUP / 32), I_DN = (DFF / 64) * (DM / 32);
    constexpr int NITEMS = I_IN + 3 * I_BR1 + I_OUT + I_UP + I_DN;
    for (int it = gw; it < NITEMS; it += NGW) {
        int r = it;
        if (r < I_IN) { transpose_item(w_in, DM, INC, Wt_in, g_att, 1, scr, r, NPC / 32, F.lane); continue; } r -= I_IN;
        if (r < 3 * I_BR1) { const int n = r / I_BR1; r -= n * I_BR1; transpose_item(w_br + (size_t)n * BW * DM, BW, DM, Wt_br + (size_t)n * DM * BW, nullptr, 0, scr, r, DM / 32, F.lane); continue; } r -= 3 * I_BR1;
        if (r < I_OUT) { transpose_item(w_out, DM, DM, Wt_out, nullptr, 0, scr, r, DM / 32, F.lane); continue; } r -= I_OUT;
        if (r < I_UP) { transpose_item(w_up, DM, NUP, Wt_up, g_ffn, 0, scr, r, NUP / 32, F.lane); continue; } r -= I_UP;
        transpose_item(w_dn, DFF, DM, Wt_dn, nullptr, 0, scr, r, DM / 32, F.lane);
    }
    if (F.bid < 2) cvec_item(F, a, layer, F.bid);
    const float* xin = layer == 0 ? a.in[I_X] : a.out; float* xcopy = layer == 0 ? a.out : nullptr; bf16_t* H = (bf16_t*)(F.ws + WS_H);
    for (int m = gw; m < M; m += NGW) rms_row(xin + (size_t)m * DM, xcopy ? xcopy + (size_t)m * DM : nullptr, H + (size_t)m * DM, F.lane);
}
__device__ __forceinline__ void phase_F(Frame& F, const Args& a) {
    const int gw = F.bid * 8 + F.wave, NGW = F.G * 8; bf16_t* H = (bf16_t*)(F.ws + WS_H);
    for (int m = gw; m < M; m += NGW) rms_row(a.out + (size_t)m * DM, nullptr, H + (size_t)m * DM, F.lane);
}
__device__ __forceinline__ void phase_H(Frame& F, const Args& a, int layer) {
    const bf16_t* U = (const bf16_t*)(F.ws + WS_P); bf16_t* ACT = (bf16_t*)(F.ws + WS_ACT);
    const float* cw = a.in[I_CONVW] + (size_t)layer * 3 * NUP; const float* cb = a.in[I_CONVB] + (size_t)layer * NUP;
    constexpr int CG = DFF / 8, TBK = 16, NIT = M / TBK;
    for (int it = F.bid; it < NIT; it += F.G) {
        for (int idx = F.tid; idx < TBK * CG; idx += 512) {
            const int tl = idx / CG, cg = idx - tl * CG, m = it * TBK + tl, tpos = m & (T - 1), c0 = cg * 8;
            float accg[8], accv[8];
#pragma unroll
            for (int e = 0; e < 8; ++e) { accg[e] = cb[c0 + e]; accv[e] = cb[DFF + c0 + e]; }
#pragma unroll
            for (int j = 0; j < 3; ++j) { const int dt = 2 - j; if (tpos - dt < 0) continue;
                const u32x4 ug = *(const u32x4*)(U + (size_t)(m - dt) * NUP + c0), uv = *(const u32x4*)(U + (size_t)(m - dt) * NUP + DFF + c0);
                const float* wg = cw + (size_t)j * NUP + c0; const float* wv = wg + DFF;
                const unsigned ugw[4] = {ug.x, ug.y, ug.z, ug.w}, uvw[4] = {uv.x, uv.y, uv.z, uv.w};
#pragma unroll
                for (int q = 0; q < 4; ++q) { accg[2 * q] += bflo(ugw[q]) * wg[2 * q]; accg[2 * q + 1] += bfhi(ugw[q]) * wg[2 * q + 1];
                    accv[2 * q] += bflo(uvw[q]) * wv[2 * q]; accv[2 * q + 1] += bfhi(uvw[q]) * wv[2 * q + 1]; } }
            float o[8];
#pragma unroll
            for (int e = 0; e < 8; ++e) o[e] = accg[e] * sigmoidf_(accg[e]) * accv[e];
            u32x4 w; w.x = pk2(o[0], o[1]); w.y = pk2(o[2], o[3]); w.z = pk2(o[4], o[5]); w.w = pk2(o[6], o[7]);
            *(u32x4*)(ACT + (size_t)m * DFF + c0) = w;
        }
    }
}


__device__ __forceinline__ int q_next(Frame& F, unsigned* head) {
    __syncthreads();
    if (F.tid == 0) F.MISC[16] = __hip_atomic_fetch_add(head, 1u, __ATOMIC_RELAXED, __HIP_MEMORY_SCOPE_AGENT);
    __syncthreads();
    return __builtin_amdgcn_readfirstlane((int)F.MISC[16]);
}
__device__ __forceinline__ int t5_bucket(int n) {
    if (n < 16) return n;
    int b = 16;
    b += (n >= 19); b += (n >= 21); b += (n >= 24); b += (n >= 27); b += (n >= 31); b += (n >= 35); b += (n >= 40); b += (n >= 46);
    b += (n >= 52); b += (n >= 59); b += (n >= 67); b += (n >= 77); b += (n >= 87); b += (n >= 99); b += (n >= 113);
    return b;
}
__device__ __forceinline__ int crow(int i, int h) { return (i & 3) + 8 * (i >> 2) + 4 * h; }

__device__ __forceinline__ void item_norm(Frame& F, const Args& a, int layer, int it) {
    bf16_t* P = (bf16_t*)(F.ws + WS_P);
    const float* qg = a.in[I_QG] + layer * HD; const float* kg = a.in[I_KG] + layer * 3 * HD;
    const int lane = F.lane;
    for (int rr = 0; rr < 8; ++rr) {
        bf16_t* pr = P + (size_t)(it * 64 + F.wave * 8 + rr) * NPC;
#pragma unroll
        for (int hh = 0; hh < 12; ++hh) {
            const int col = hh < 8 ? PQN + hh * HD : (hh < 10 ? PKS + (hh - 8) * HD : PKW + (hh - 10) * HD);
            const float* gn = hh < 8 ? qg : (hh < 10 ? kg + HD : kg + 2 * HD); const float sc = hh < 8 ? QSCALE : 1.f;
            unsigned* pp = (unsigned*)(pr + col) + lane; const unsigned w = *pp; const float x0 = bflo(w), x1 = bfhi(w);
            const float ss = wave_sum(x0 * x0 + x1 * x1); const float r = rsqrtf(ss * (1.f / HD) + EPS) * sc;
            *pp = pk2(x0 * r * gn[2 * lane], x1 * r * gn[2 * lane + 1]);
        }
    }
}
__device__ __forceinline__ void item_hgfin(Frame& F, const Args& a, int layer, int it) {
    const bf16_t* P = (const bf16_t*)(F.ws + WS_P); const float* OR = (const float*)(F.ws + WS_ORAW); bf16_t* OH = (bf16_t*)(F.ws + WS_OBR) + (size_t)2 * M * BW;
    const float* ng = a.in[I_HNG] + layer * HD; const int lane = F.lane;
    for (int rr = 0; rr < 8; ++rr) { const size_t row = (size_t)(it * 64 + F.wave * 8 + rr);
#pragma unroll
        for (int hh = 0; hh < 8; ++hh) {
            const f32x2 o = *((const f32x2*)(OR + row * BW + hh * HD) + lane);
            const unsigned gw = *((const unsigned*)(P + row * NPC + PGH + hh * HD) + lane);
            const float ss = wave_sum(o.x * o.x + o.y * o.y); const float r = rsqrtf(ss * (1.f / HD) + EPS);
            *((unsigned*)(OH + row * BW + hh * HD) + lane) = pk2(o.x * r * ng[2 * lane] * sigmoidf_(bflo(gw)), o.y * r * ng[2 * lane + 1] * sigmoidf_(bfhi(gw)));
        }
    }
}
__device__ __forceinline__ void cvec_item(Frame& F, const Args& a, int layer, int j) {
    const float* pos = a.in[I_CPOS] + (size_t)(layer * 2 + j) * 32 * HD; const float* w1 = a.in[I_CW1] + (size_t)(layer * 2 + j) * 32 * HD * HD;
    LAS float* red = (LAS float*)F.lds; const int e = F.tid & 127, ks = F.tid >> 7;
    float acc = 0.f;
    for (int k = ks * 1024; k < ks * 1024 + 1024; ++k) acc += pos[k] * w1[(size_t)k * HD + e];
    __syncthreads(); red[ks * 128 + e] = acc; __syncthreads();
    if (F.tid < 128) ((float*)(F.ws + WS_MISC + MISC_CVEC))[j * 128 + F.tid] = red[F.tid] + red[128 + F.tid] + red[256 + F.tid] + red[384 + F.tid];
    __syncthreads();
}
__device__ __forceinline__ void item_compress(Frame& F, const Args& a, int layer, int id) {
    const int j = id >> 9, rem = id & 511, b = rem >> 5, g = (rem >> 4) & 1, n0 = (rem & 15) * 8;
    const bf16_t* P = (const bf16_t*)(F.ws + WS_P);
    LAS float* A = (LAS float*)F.lds; LAS float* red = (LAS float*)(F.lds + 73728); LAS float* hid = (LAS float*)(F.lds + 90112); LAS float* outv = (LAS float*)(F.lds + 94208);
    const int tid = F.tid;
    for (int idx = tid; idx < 144 * 16; idx += 512) { const int rr = idx >> 4, ch = idx & 15; int t = 16 * n0 + rr; t = t < T ? t : T - 1;
        const u32x4 w = *(const u32x4*)(P + (size_t)(b * T + t) * NPC + (j ? PVC : PKC) + g * HD + ch * 8);
        LAS f32x4* d = (LAS f32x4*)(A + rr * 128 + ch * 8);
        d[0] = (f32x4){bflo(w.x), bfhi(w.x), bflo(w.y), bfhi(w.y)}; d[1] = (f32x4){bflo(w.z), bfhi(w.z), bflo(w.w), bfhi(w.w)}; }
    __syncthreads();
    const int e = tid & 127, ks = __builtin_amdgcn_readfirstlane(tid >> 7);
    const float* w1 = a.in[I_CW1] + (size_t)(layer * 2 + j) * 32 * HD * HD + e;
    float acc[8];
#pragma unroll
    for (int n = 0; n < 8; ++n) acc[n] = 0.f;
    for (int l = ks * 8; l < ks * 8 + 8; ++l)
        for (int d = 0; d < 128; d += 4) {
            const float* wp = w1 + (size_t)(l * 128 + d) * HD; const float wa = wp[0], wb = wp[HD], wc = wp[2 * HD], wd = wp[3 * HD];
#pragma unroll
            for (int n = 0; n < 8; ++n) { const f32x4 av = *(const LAS f32x4*)(A + (16 * n + l) * 128 + d); acc[n] += (av.x * wa + av.y * wb) + (av.z * wc + av.w * wd); }
        }
#pragma unroll
    for (int n = 0; n < 8; ++n) red[(ks * 8 + n) * 128 + e] = acc[n];
    __syncthreads();
    const float* cvec = (const float*)(F.ws + WS_MISC + MISC_CVEC) + j * 128;
    for (int idx = tid; idx < 1024; idx += 512) { const int n = idx >> 7, ee = idx & 127;
        const float x = red[(0 * 8 + n) * 128 + ee] + red[(8 + n) * 128 + ee] + red[(16 + n) * 128 + ee] + red[(24 + n) * 128 + ee] + cvec[ee];
        const float y = 0.7978845608028654f * (x + 0.044715f * x * x * x);
        const float th = 1.f - 2.f * fast_rcp(1.f + fast_exp2(2.f * y * LOG2E));
        hid[idx] = 0.5f * x * (1.f + th); }
    __syncthreads();
    { const float* w2 = a.in[I_CW2] + (size_t)(layer * 2 + j) * HD * HD + e; const int np = ks;
      float o0 = 0.f, o1 = 0.f;
      for (int k = 0; k < 128; ++k) { const float w = w2[(size_t)k * HD]; o0 += hid[(2 * np) * 128 + k] * w; o1 += hid[(2 * np + 1) * 128 + k] * w; }
      outv[(2 * np) * 128 + e] = o0; outv[(2 * np + 1) * 128 + e] = o1; }
    __syncthreads();
    { const int n = F.wave, lane = F.lane; float v0 = outv[n * 128 + 2 * lane], v1 = outv[n * 128 + 2 * lane + 1];
      if (j == 0) { const float* kg0 = a.in[I_KG] + layer * 3 * HD; const float ss = wave_sum(v0 * v0 + v1 * v1); const float r = rsqrtf(ss * (1.f / HD) + EPS); v0 *= r * kg0[2 * lane]; v1 *= r * kg0[2 * lane + 1]; }
      if (n0 + n >= 127) { v0 = 0.f; v1 = 0.f; }
      bf16_t* dst = (bf16_t*)(F.ws + WS_MISC + (j ? MISC_VCMP : MISC_KCMP)) + (size_t)((b * 2 + g) * 128 + n0 + n) * HD;
      *((unsigned*)dst + lane) = pk2(v0, v1); }
}
__device__ __forceinline__ void item_hgrn(Frame& F, const Args& a, int layer, int id) {
    const int b = id >> 4, hh = (id >> 1) & 7, half = id & 1;
    const bf16_t* P = (const bf16_t*)(F.ws + WS_P); float* OR = (float*)(F.ws + WS_ORAW);
    LAS float* qs = (LAS float*)F.lds; LAS float* fs = (LAS float*)(F.lds + 16384); LAS float* ks_ = (LAS float*)(F.lds + 32768); LAS float* vs = (LAS float*)(F.lds + 49152);
    LAS float* opart = (LAS float*)(F.lds + 57344); LAS float* lbs = (LAS float*)(F.lds + 122880);
    const int tid = F.tid, lane = F.lane, wave = F.wave;
    if (tid < 128) { const float* hb = a.in[I_HLB] + hh * HD + tid; const float x0 = hb[0], x1 = hb[1024], x2 = hb[2048], x3 = hb[3072];
        const float mx = fmaxf(fmaxf(x0, x1), fmaxf(x2, x3)); const float e0 = __expf(x0 - mx), e1 = __expf(x1 - mx), e2 = __expf(x2 - mx), e3 = __expf(x3 - mx);
        const float inv = 1.f / (e0 + e1 + e2 + e3); float c = 0.f; if (layer >= 1) c += e1; if (layer >= 2) c += e2; if (layer >= 3) c += e3;
        lbs[tid] = fmaxf(c * inv, 0.f); }
    float S[16];
#pragma unroll
    for (int i = 0; i < 16; ++i) S[i] = 0.f;
    __syncthreads();
    for (int tb = 0; tb < T / 32; ++tb) {
        { const int tk = tid >> 4, ch = tid & 15; const size_t row = (size_t)(b * T + tb * 32 + tk);
          const u32x4 qw = *(const u32x4*)(P + row * NPC + PQH + hh * HD + ch * 8), fw = *(const u32x4*)(P + row * NPC + PFH + hh * HD + ch * 8);
          const unsigned qa[4] = {qw.x, qw.y, qw.z, qw.w}, fa[4] = {fw.x, fw.y, fw.z, fw.w};
          float qv[8], fv[8], kv[8];
#pragma unroll
          for (int q = 0; q < 4; ++q) { qv[2 * q] = bflo(qa[q]); qv[2 * q + 1] = bfhi(qa[q]);
              const float lb0 = lbs[ch * 8 + 2 * q], lb1 = lbs[ch * 8 + 2 * q + 1];
              const float f0 = lb0 + (1.f - lb0) * sigmoidf_(bflo(fa[q])), f1 = lb1 + (1.f - lb1) * sigmoidf_(bfhi(fa[q]));
              fv[2 * q] = f0; fv[2 * q + 1] = f1; kv[2 * q] = 1.f - f0; kv[2 * q + 1] = 1.f - f1; }
          LAS f32x4* dq = (LAS f32x4*)(qs + tk * 128 + ch * 8); dq[0] = (f32x4){qv[0], qv[1], qv[2], qv[3]}; dq[1] = (f32x4){qv[4], qv[5], qv[6], qv[7]};
          LAS f32x4* df = (LAS f32x4*)(fs + tk * 128 + ch * 8); df[0] = (f32x4){fv[0], fv[1], fv[2], fv[3]}; df[1] = (f32x4){fv[4], fv[5], fv[6], fv[7]};
          LAS f32x4* dk = (LAS f32x4*)(ks_ + tk * 128 + ch * 8); dk[0] = (f32x4){kv[0], kv[1], kv[2], kv[3]}; dk[1] = (f32x4){kv[4], kv[5], kv[6], kv[7]};
          if (tid < 256) { const int tk2 = tid >> 3, ch2 = tid & 7; const size_t row2 = (size_t)(b * T + tb * 32 + tk2);
              const u32x4 vw = *(const u32x4*)(P + row2 * NPC + PIH + hh * HD + half * 64 + ch2 * 8);
              LAS f32x4* dv = (LAS f32x4*)(vs + tk2 * 64 + ch2 * 8);
              dv[0] = (f32x4){bflo(vw.x), bfhi(vw.x), bflo(vw.y), bfhi(vw.y)}; dv[1] = (f32x4){bflo(vw.z), bfhi(vw.z), bflo(vw.w), bfhi(vw.w)}; } }
        __syncthreads();
        for (int t = 0; t < 32; ++t) {
            const float v = vs[t * 64 + lane]; float op = 0.f;
#pragma unroll
            for (int i4 = 0; i4 < 4; ++i4) {
                const f32x4 f4 = *(const LAS f32x4*)(fs + t * 128 + wave * 16 + i4 * 4), k4 = *(const LAS f32x4*)(ks_ + t * 128 + wave * 16 + i4 * 4), q4 = *(const LAS f32x4*)(qs + t * 128 + wave * 16 + i4 * 4);
#pragma unroll
                for (int e = 0; e < 4; ++e) { float& s = S[i4 * 4 + e]; s = f4[e] * s + k4[e] * v; op += q4[e] * s; }
            }
            opart[(t * 8 + wave) * 64 + lane] = op;
        }
        __syncthreads();
#pragma unroll
        for (int jj = 0; jj < 4; ++jj) { const int idx = tid + 512 * jj, t = idx >> 6, dv = idx & 63; float o = 0.f;
#pragma unroll
            for (int w = 0; w < 8; ++w) o += opart[(t * 8 + w) * 64 + dv];
            OR[(size_t)(b * T + tb * 32 + t) * BW + hh * HD + half * 64 + dv] = o; }
        __syncthreads();
    }
}

constexpr int AT_K = 0, AT_V = 16384, AT_TAB = 33792, AT_IMP = 35840, AT_SELM = 69632, AT_MISC = 69888;
constexpr int VT_STRIDE = 136;
__device__ __forceinline__ unsigned koff(int row, int ch) { return 256u * (unsigned)row + 16u * (unsigned)(ch ^ (((row & 3) << 2) | ((row >> 2) & 3))); }
struct Stg { u32x4 k0, k1, v0, v1; };
__device__ __forceinline__ void stg_load(Stg& s, const bf16_t* Kp, const bf16_t* Vp, int ld, int tid, bool doK, bool doV) {
    const int row = tid >> 4, ch = tid & 15;
    if (doK) { s.k0 = *(const u32x4*)(Kp + (size_t)row * ld + ch * 8); s.k1 = *(const u32x4*)(Kp + (size_t)(row + 32) * ld + ch * 8); }
    if (doV) { s.v0 = *(const u32x4*)(Vp + (size_t)row * ld + ch * 8); s.v1 = *(const u32x4*)(Vp + (size_t)(row + 32) * ld + ch * 8); }
}
__device__ __forceinline__ void stg_write(const Stg& s, LAS unsigned char* L, int tid, bool doK, bool doV) {
    const int row = tid >> 4, ch = tid & 15;
    if (doK) { *(LAS u32x4*)(L + AT_K + koff(row, ch)) = s.k0; *(LAS u32x4*)(L + AT_K + koff(row + 32, ch)) = s.k1; }
    if (doV) { const unsigned a0[4] = {s.v0.x, s.v0.y, s.v0.z, s.v0.w}, a1[4] = {s.v1.x, s.v1.y, s.v1.z, s.v1.w};
#pragma unroll
        for (int q = 0; q < 4; ++q) {
            LAS unsigned short* p0 = (LAS unsigned short*)(L + AT_V + (8 * ch + 2 * q) * VT_STRIDE + row * 2); LAS unsigned short* p1 = (LAS unsigned short*)(L + AT_V + (8 * ch + 2 * q + 1) * VT_STRIDE + row * 2);
            p0[0] = (unsigned short)(a0[q] & 0xffffu); p1[0] = (unsigned short)(a0[q] >> 16); p0[32] = (unsigned short)(a1[q] & 0xffffu); p1[32] = (unsigned short)(a1[q] >> 16); } }
}
#define MFMA32(a, b, c) __builtin_amdgcn_mfma_f32_32x32x16_bf16((a), (b), (c), 0, 0, 0)
__device__ __forceinline__ void qk_tile(f32x16& p0, f32x16& p1, const LAS unsigned char* L, const bf16x8 (&qf)[8], int r, int h) {
#pragma unroll
    for (int i = 0; i < 16; ++i) { p0[i] = 0.f; p1[i] = 0.f; }
#pragma unroll
    for (int s = 0; s < 8; ++s) {
        const bf16x8 a0 = *(const LAS bf16x8*)(L + AT_K + koff(r, 2 * s + h)), a1 = *(const LAS bf16x8*)(L + AT_K + koff(r + 32, 2 * s + h));
        p0 = MFMA32(a0, qf[s], p0); p1 = MFMA32(a1, qf[s], p1); }
}
__device__ __forceinline__ bf16x8 pack8(const f32x16& p, int s) {
    u32x4 w; w.x = pk2(p[8 * s], p[8 * s + 1]); w.y = pk2(p[8 * s + 2], p[8 * s + 3]); w.z = pk2(p[8 * s + 4], p[8 * s + 5]); w.w = pk2(p[8 * s + 6], p[8 * s + 7]);
    return __builtin_bit_cast(bf16x8, w);
}
__device__ __forceinline__ void pv_tile(f32x16 (&o)[4], const f32x16& p0, const f32x16& p1, const LAS unsigned char* L, int r, int h) {
    bf16x8 pb[4]; pb[0] = pack8(p0, 0); pb[1] = pack8(p0, 1); pb[2] = pack8(p1, 0); pb[3] = pack8(p1, 1);
#pragma unroll
    for (int c = 0; c < 4; ++c)
#pragma unroll
        for (int s = 0; s < 4; ++s) {
            const LAS unsigned char* base = L + AT_V + (32 * c + r) * VT_STRIDE + (16 * s + 4 * h) * 2;
            const s16x4 lo = *(const LAS s16x4*)base, hi = *(const LAS s16x4*)(base + 16);
            const bf16x8 av = __builtin_shufflevector(lo, hi, 0, 1, 2, 3, 4, 5, 6, 7);
            o[c] = MFMA32(av, pb[s], o[c]); }
}
__device__ __forceinline__ void softmax_step(f32x16& p0, f32x16& p1, float& m, float& l, f32x16 (&o)[4]) {
    float mx = p0[0];
#pragma unroll
    for (int i = 1; i < 16; ++i) mx = fmaxf(mx, p0[i]);
#pragma unroll
    for (int i = 0; i < 16; ++i) mx = fmaxf(mx, p1[i]);
    mx = fmaxf(mx, __shfl_xor(mx, 32));
    const float mn = fmaxf(m, mx); const float alpha = fast_exp2((m - mn) * LOG2E); m = mn;
    const float mb = mn * LOG2E; float ps = 0.f;
#pragma unroll
    for (int i = 0; i < 16; ++i) { p0[i] = fast_exp2(p0[i] * LOG2E - mb); ps += p0[i]; }
#pragma unroll
    for (int i = 0; i < 16; ++i) { p1[i] = fast_exp2(p1[i] * LOG2E - mb); ps += p1[i]; }
    ps += __shfl_xor(ps, 32);
    l = l * alpha + ps;
#pragma unroll
    for (int c = 0; c < 4; ++c)
#pragma unroll
        for (int i = 0; i < 16; ++i) o[c][i] *= alpha;
}
__device__ __forceinline__ void store_ot(const f32x16 (&o)[4], float sc, bf16_t* dst  , int h, bool add) {
#pragma unroll
    for (int c = 0; c < 4; ++c)
#pragma unroll
        for (int g4 = 0; g4 < 4; ++g4) { u32x2* p = (u32x2*)(dst + 32 * c + 8 * g4 + 4 * h);
            float v0 = sc * o[c][4 * g4], v1 = sc * o[c][4 * g4 + 1], v2 = sc * o[c][4 * g4 + 2], v3 = sc * o[c][4 * g4 + 3];
            if (add) { const u32x2 w0 = *p; v0 += bflo(w0.x); v1 += bfhi(w0.x); v2 += bflo(w0.y); v3 += bfhi(w0.y); }
            u32x2 w; w.x = pk2(v0, v1); w.y = pk2(v2, v3); *p = w; }
}

__device__ __forceinline__ void item_sb(Frame& F, const Args& a, int item) {
    LAS unsigned char* L = F.lds;
    const int qb = 7 - (item >> 7), rem = item & 127, b = rem >> 3, hh = rem & 7, t0 = qb * 256;
    const int tid = F.tid, lane = F.lane, wave = F.wave, r = lane & 31, h = lane >> 5;
    const int tq = t0 + 32 * wave + r;
    const bf16_t* P = (const bf16_t*)(F.ws + WS_P); const size_t rowq = (size_t)(b * T + tq);
    const bf16_t* Kb = P + (size_t)(b * T) * NPC + PKSB + hh * HD; const bf16_t* Vb = P + (size_t)(b * T) * NPC + PVSB + hh * HD;
    bf16x8 qf[8];
#pragma unroll
    for (int s = 0; s < 8; ++s) qf[s] = *(const bf16x8*)(P + rowq * NPC + PQS + hh * HD + 16 * s + 8 * h);
    f32x16 o[4];
#pragma unroll
    for (int c = 0; c < 4; ++c)
#pragma unroll
        for (int i = 0; i < 16; ++i) o[c][i] = 0.f;
    float C = 0.f; bool wdone = false;
    volatile LAS unsigned* flags = (volatile LAS unsigned*)(L + AT_MISC);
    Stg st; int j = 4 * qb + 3;
    stg_load(st, Kb + (size_t)(64 * j) * NPC, Vb + (size_t)(64 * j) * NPC, NPC, tid, true, true);
    for (;;) {
        __syncthreads();
        stg_write(st, L, tid, true, true);
        if (lane == 0) flags[wave] = wdone ? 1u : 0u;
        __syncthreads();
        unsigned nd = 0;
#pragma unroll
        for (int w = 0; w < 8; ++w) nd += flags[w];
        if (__builtin_amdgcn_readfirstlane(nd) == 8u) break;
        if (j > 0) stg_load(st, Kb + (size_t)(64 * (j - 1)) * NPC, Vb + (size_t)(64 * (j - 1)) * NPC, NPC, tid, true, true);
        const bool active = !wdone && (64 * j <= t0 + 32 * wave + 30);
        if (active) {
            f32x16 p0, p1; qk_tile(p0, p1, L, qf, r, h);
            float lm0[16], lm1[16];
            const int kb = 64 * j + 4 * h;
#pragma unroll
            for (int i = 0; i < 16; ++i) {
                const int key0 = kb + (i & 3) + 8 * (i >> 2);
                { const float z = p0[i] * QSCALE; const float sp = fmaxf(z, 0.f) + LN2 * fast_log2(1.f + fast_exp2(-fabsf(z) * LOG2E)); const bool cz = key0 < tq; lm0[i] = cz ? -sp : 0.f; p0[i] = z - sp; }
                { const float z = p1[i] * QSCALE; const float sp = fmaxf(z, 0.f) + LN2 * fast_log2(1.f + fast_exp2(-fabsf(z) * LOG2E)); const bool cz = key0 + 32 < tq; lm1[i] = cz ? -sp : 0.f; p1[i] = z - sp; }
            }
            float Tm[2][4], Tr[2][4];
#pragma unroll
            for (int g4 = 0; g4 < 4; ++g4) { Tm[0][g4] = (lm0[4 * g4] + lm0[4 * g4 + 1]) + (lm0[4 * g4 + 2] + lm0[4 * g4 + 3]); Tm[1][g4] = (lm1[4 * g4] + lm1[4 * g4 + 1]) + (lm1[4 * g4 + 2] + lm1[4 * g4 + 3]); }
#pragma unroll
            for (int k = 0; k < 2; ++k)
#pragma unroll
                for (int g4 = 0; g4 < 4; ++g4) Tr[k][g4] = __shfl_xor(Tm[k][g4], 32);
            float aft[2][4]; float run = C;
#pragma unroll
            for (int G = 15; G >= 0; --G) { const int k = G >> 3, g4 = (G >> 1) & 3, par = G & 1;
                const float tg = (par == 1) ? (h ? Tm[k][g4] : Tr[k][g4]) : (h ? Tr[k][g4] : Tm[k][g4]);
                if (par == 1) { if (h) aft[k][g4] = run; } else { if (!h) aft[k][g4] = run; }
                run += tg; }
            C = run;
#pragma unroll
            for (int g4 = 0; g4 < 4; ++g4) {
                { float ca = aft[0][g4];
#pragma unroll
                  for (int e = 3; e >= 0; --e) { const int i = 4 * g4 + e; const float la = p0[i] + ca; ca += lm0[i]; p0[i] = (kb + e + 8 * g4 < tq) ? fast_exp2(la * LOG2E) : 0.f; } }
                { float ca = aft[1][g4];
#pragma unroll
                  for (int e = 3; e >= 0; --e) { const int i = 4 * g4 + e; const float la = p1[i] + ca; ca += lm1[i]; p1[i] = (kb + 32 + e + 8 * g4 < tq) ? fast_exp2(la * LOG2E) : 0.f; } }
            }
            pv_tile(o, p0, p1, L, r, h);
            wdone = __all(C < -104.f);
        }
        if (j == 0) break;
        --j;
    }
    bf16_t* OS = (bf16_t*)(F.ws + WS_OBR) + (size_t)1 * M * BW;
    store_ot(o, 1.f, OS + rowq * BW + hh * HD, h, false);
}

__device__ __forceinline__ void item_nsa(Frame& F, const Args& a, int item) {
    LAS unsigned char* L = F.lds;
    const int qblk = 31 - (item >> 5), rem = item & 31, b = rem >> 1, g = rem & 1, t0 = qblk * 64;
    const int tid = F.tid, lane = F.lane, wave = F.wave, r = lane & 31, h = lane >> 5, hr = wave >> 1, th = wave & 1;
    const int tl = 32 * th + r, tq = t0 + tl, hq = g * 4 + hr;
    const bf16_t* P = (const bf16_t*)(F.ws + WS_P); const size_t rowq = (size_t)(b * T + tq);
    LAS float* tab = (LAS float*)(L + AT_TAB); LAS float* imp = (LAS float*)(L + AT_IMP); volatile LAS unsigned* selm = (volatile LAS unsigned*)(L + AT_SELM); volatile LAS unsigned* misc = (volatile LAS unsigned*)(L + AT_MISC);
    { const int hh = tid >> 7, dd = tid & 127; tab[tid] = a.in[I_RELB][t5_bucket(dd) * 8 + g * 4 + hh]; }
    bf16x8 qf[8];
#pragma unroll
    for (int s = 0; s < 8; ++s) qf[s] = *(const bf16x8*)(P + rowq * NPC + PQN + hq * HD + 16 * s + 8 * h);
    const bf16_t* gp = P + rowq * NPC + PGN + hq * 3;
    const float g0 = sigmoidf_(bf2f(gp[0])), g1 = sigmoidf_(bf2f(gp[1])), g2 = sigmoidf_(bf2f(gp[2]));
    f32x16 o[4];
    Stg st;
    bf16_t* ONr = (bf16_t*)(F.ws + WS_OBR) + rowq * BW + hq * HD;
    {
        const bf16_t* kc = (const bf16_t*)(F.ws + WS_MISC + MISC_KCMP) + (size_t)((b * 2 + g) * 128) * HD; const bf16_t* vc = (const bf16_t*)(F.ws + WS_MISC + MISC_VCMP) + (size_t)((b * 2 + g) * 128) * HD;
        const bool two = qblk >= 16;
        f32x16 pc[4];
        __syncthreads();
        stg_load(st, kc, vc, HD, tid, true, false); stg_write(st, L, tid, true, false); __syncthreads();
        qk_tile(pc[0], pc[1], L, qf, r, h);
        if (two) { __syncthreads(); stg_load(st, kc + 64 * HD, vc, HD, tid, true, false); stg_write(st, L, tid, true, false); __syncthreads(); qk_tile(pc[2], pc[3], L, qf, r, h); }
        float mx = -1e30f;
#pragma unroll
        for (int k = 0; k < 4; ++k) { if (k >= 2 && !two) break;
#pragma unroll
            for (int i = 0; i < 16; ++i) { const int n = 32 * k + crow(i, h); const int dc = tq - (16 * n + 31); const int di = dc < 113 ? dc : 113;
                const float sv = dc >= 0 ? pc[k][i] + tab[hr * 128 + (di < 0 ? 0 : di)] : -__builtin_inff(); pc[k][i] = sv; mx = fmaxf(mx, sv); } }
        mx = fmaxf(mx, __shfl_xor(mx, 32));
        float sum = 0.f;
#pragma unroll
        for (int k = 0; k < 4; ++k) { if (k >= 2 && !two) break;
#pragma unroll
            for (int i = 0; i < 16; ++i) { const float e = fast_exp2((pc[k][i] - mx) * LOG2E); pc[k][i] = e; sum += e; } }
        sum += __shfl_xor(sum, 32);
        const float inv = 1.f / fmaxf(sum, 1e-30f);
#pragma unroll
        for (int k = 0; k < 4; ++k)
#pragma unroll
            for (int i = 0; i < 16; ++i) pc[k][i] = (k >= 2 && !two) ? 0.f : pc[k][i] * inv;
        float gs[16], gl[16], rc[16];
#pragma unroll
        for (int k = 0; k < 4; ++k)
#pragma unroll
            for (int g4 = 0; g4 < 4; ++g4) { gs[4 * k + g4] = (pc[k][4 * g4] + pc[k][4 * g4 + 1]) + (pc[k][4 * g4 + 2] + pc[k][4 * g4 + 3]); gl[4 * k + g4] = pc[k][4 * g4 + 3]; }
#pragma unroll
        for (int f = 0; f < 16; ++f) rc[f] = __shfl_xor(gl[f], 32);
#pragma unroll
        for (int f = 0; f < 16; ++f) { const float prev = h ? rc[f] : (f >= 1 ? rc[f - 1] : 0.f); const int G = 8 * (f >> 2) + 2 * (f & 3) + h;
            imp[(hr * 64 + tl) * 33 + G] = gs[f] + prev; }
#pragma unroll
        for (int c = 0; c < 4; ++c)
#pragma unroll
            for (int i = 0; i < 16; ++i) o[c][i] = 0.f;
        __syncthreads();
        stg_load(st, kc, vc, HD, tid, false, true); stg_write(st, L, tid, false, true); __syncthreads();
        pv_tile(o, pc[0], pc[1], L, r, h);
        if (two) { __syncthreads(); stg_load(st, kc, vc + 64 * HD, HD, tid, false, true); stg_write(st, L, tid, false, true); __syncthreads(); pv_tile(o, pc[2], pc[3], L, r, h); }
        store_ot(o, g0, ONr, h, false);
    }
    __syncthreads();
    if (wave == 0) {
        const int tk = lane; unsigned msk;
        if (qblk < 16) msk = (2u << qblk) - 1u;
        else {
            for (int jj = 1; jj <= qblk - 2; ++jj) imp[tk * 33 + jj] = (imp[tk * 33 + jj] + imp[(64 + tk) * 33 + jj]) + (imp[(128 + tk) * 33 + jj] + imp[(192 + tk) * 33 + jj]);
            msk = 1u | (1u << (qblk - 1)) | (1u << qblk);
            for (int pick = 0; pick < 13; ++pick) { int best = 1; float bv = -1.f;
                for (int jj = 1; jj <= qblk - 2; ++jj) { const float v = imp[tk * 33 + jj]; if (v > bv) { bv = v; best = jj; } }
                msk |= 1u << best; imp[tk * 33 + best] = -2.f; }
        }
        selm[tk] = msk;
        unsigned om = msk;
#pragma unroll
        for (int off = 1; off < 64; off <<= 1) om |= (unsigned)__shfl_xor((int)om, off);
        if (lane == 0) misc[0] = om;
    }
    __syncthreads();
    const bf16_t* Kbase = P + (size_t)(b * T) * NPC + g * HD;
    {
        unsigned om = __builtin_amdgcn_readfirstlane(misc[0]); const unsigned mym = selm[tl];
        float m = -1e30f, l = 0.f;
#pragma unroll
        for (int c = 0; c < 4; ++c)
#pragma unroll
            for (int i = 0; i < 16; ++i) o[c][i] = 0.f;
        int j = __builtin_ctz(om); om &= om - 1u;
        stg_load(st, Kbase + PKS + (size_t)(64 * j) * NPC, Kbase + PVS + (size_t)(64 * j) * NPC, NPC, tid, true, true);
        for (;;) {
            __syncthreads(); stg_write(st, L, tid, true, true); __syncthreads();
            const int jn = om ? __builtin_ctz(om) : -1;
            if (jn >= 0) stg_load(st, Kbase + PKS + (size_t)(64 * jn) * NPC, Kbase + PVS + (size_t)(64 * jn) * NPC, NPC, tid, true, true);
            f32x16 p0, p1; qk_tile(p0, p1, L, qf, r, h);
            const bool sel = (mym >> j) & 1u; const bool far = j <= qblk - 3; const float bfar = tab[hr * 128 + 113];
#pragma unroll
            for (int i = 0; i < 16; ++i) { const int d0 = tq - (64 * j + crow(i, h)), d1 = d0 - 32;
                const float b0 = far ? bfar : tab[hr * 128 + (d0 < 0 ? 0 : (d0 > 113 ? 113 : d0))], b1 = far ? bfar : tab[hr * 128 + (d1 < 0 ? 0 : (d1 > 113 ? 113 : d1))];
                p0[i] = (sel && d0 >= 0) ? p0[i] + b0 : -__builtin_inff(); p1[i] = (sel && d1 >= 0) ? p1[i] + b1 : -__builtin_inff(); }
            softmax_step(p0, p1, m, l, o);
            pv_tile(o, p0, p1, L, r, h);
            if (jn < 0) break;
            j = jn; om &= om - 1u;
        }
        store_ot(o, g1 / l, ONr, h, true);
    }
    {
        float m = -1e30f, l = 0.f;
#pragma unroll
        for (int c = 0; c < 4; ++c)
#pragma unroll
            for (int i = 0; i < 16; ++i) o[c][i] = 0.f;
        int j = qblk >= 8 ? qblk - 8 : 0;
        stg_load(st, Kbase + PKW + (size_t)(64 * j) * NPC, Kbase + PVW + (size_t)(64 * j) * NPC, NPC, tid, true, true);
        for (;;) {
            __syncthreads(); stg_write(st, L, tid, true, true); __syncthreads();
            if (j < qblk) stg_load(st, Kbase + PKW + (size_t)(64 * (j + 1)) * NPC, Kbase + PVW + (size_t)(64 * (j + 1)) * NPC, NPC, tid, true, true);
            f32x16 p0, p1; qk_tile(p0, p1, L, qf, r, h);
            const bool far = j <= qblk - 3; const float bfar = tab[hr * 128 + 113];
#pragma unroll
            for (int i = 0; i < 16; ++i) { const int d0 = tq - (64 * j + crow(i, h)), d1 = d0 - 32;
                const float b0 = far ? bfar : tab[hr * 128 + (d0 < 0 ? 0 : (d0 > 113 ? 113 : d0))], b1 = far ? bfar : tab[hr * 128 + (d1 < 0 ? 0 : (d1 > 113 ? 113 : d1))];
                p0[i] = ((unsigned)d0 < 512u) ? p0[i] + b0 : -__builtin_inff(); p1[i] = ((unsigned)d1 < 512u) ? p1[i] + b1 : -__builtin_inff(); }
            softmax_step(p0, p1, m, l, o);
            pv_tile(o, p0, p1, L, r, h);
            if (j == qblk) break;
            ++j;
        }
        store_ot(o, g2 / l, ONr, h, true);
    }
}

constexpr int NI_H = 256, NI_S = 1024, NI_C = 1024, NI_N = 512, NI_A = 1024, NI_F = 512;
#define FRESH_F() do { int t_ = threadIdx.x; asm volatile("" : "+v"(t_)); F.tid = t_; F.lane = t_ & 63; F.wave = __builtin_amdgcn_readfirstlane(t_ >> 6); } while (0)
__device__ __forceinline__ void phase_Ca(Frame& F, const Args& a, int layer) {
    unsigned* head = F.ctl + CW_QUEUE + 64 * (layer * 8);
    for (;;) { const int it = q_next(F, head + 0); if (it >= NI_H) break; FRESH_F(); item_hgrn(F, a, layer, it); }
    for (;;) { const int it = q_next(F, head + 64); if (it >= NI_S) break; FRESH_F(); item_sb(F, a, it); }
    for (;;) { const int it = q_next(F, head + 128); if (it >= NI_C) break; FRESH_F(); item_compress(F, a, layer, it); }
    for (;;) { const int it = q_next(F, head + 192); if (it >= NI_N) break; FRESH_F(); item_norm(F, a, layer, it); }
}
__device__ __forceinline__ void phase_Cb(Frame& F, const Args& a, int layer) {
    unsigned* head = F.ctl + CW_QUEUE + 64 * (layer * 8 + 4);
    for (;;) { const int it = q_next(F, head + 0); if (it >= NI_A) break; FRESH_F(); item_nsa(F, a, it); }
    for (;;) { const int it = q_next(F, head + 64); if (it >= NI_F) break; FRESH_F(); item_hgfin(F, a, layer, it); }
}

__global__ void __launch_bounds__(512, 2) mega(Args a) {
    extern __shared__ __attribute__((aligned(16))) unsigned char lds_raw[];
    Frame F;
    F.lds = (LAS unsigned char*)lds_raw; F.MISC = (volatile LAS unsigned*)(F.lds + MISC_OFF);
    F.tid = threadIdx.x; F.lane = F.tid & 63; F.wave = __builtin_amdgcn_readfirstlane(F.tid >> 6); F.G = gridDim.x; F.bid = blockIdx.x;
    F.ws = a.ws; F.ctl = (unsigned*)(a.ws + WS_CTL);
    if (F.tid < 64) F.MISC[F.tid] = 0u;
    __syncthreads();
    const int lo = a.ph_lo, hi = a.ph_hi;
    XcdBarrier bar; bar.bar = F.ctl + CW_BAR; bar.x = 0; bar.st = F.MISC + 8;
    if (hi - lo > 1) bar = xcd_barrier_post(F.ctl + CW_BAR, F.MISC + 8);
#define IN(k) (lo <= (k) && (k) < hi)
#define ON(k) (((MK_PHASE_MASK & MK_BUILD_MASK) >> (k)) & 1)
#define SEAM(k) do { if (IN(k) && IN((k) + 1)) xcd_barrier(bar); } while (0)
    bf16_t* Hb = (bf16_t*)(F.ws + WS_H); bf16_t* Pb = (bf16_t*)(F.ws + WS_P);
    for (int layer = 0; layer < DEPTH; ++layer) {
        const int pb = layer * 10;
#define FRESH() do { int t_ = threadIdx.x; asm volatile("" : "+v"(t_)); F.tid = t_; F.lane = t_ & 63; F.wave = __builtin_amdgcn_readfirstlane(t_ >> 6); } while (0)
        if (ON(0) && IN(pb + 0)) { FRESH(); phase_A(F, a, layer); } SEAM(pb + 0);
        if (ON(1) && IN(pb + 1)) { FRESH();
            pg8::Gemm g{Hb, (const bf16_t*)(F.ws + WS_WIN), M, NPC, DM}; pg8::StaticOrder S; S.init(M, NPC, F.G, F.bid);
            pg8::EpiStoreBf16 E{Pb, NPC};
            pg8::gemm_phase<pg8::EpiStoreBf16, pg8::StaticOrder, PG8_ALIGN, PG8_SP2>(F.lds, g, S, E, F.tid);
        } SEAM(pb + 1);
        if (ON(2) && IN(pb + 2)) { FRESH(); phase_Ca(F, a, layer); } SEAM(pb + 2);
        if (ON(3) && IN(pb + 3)) { FRESH(); phase_Cb(F, a, layer); } SEAM(pb + 3);
        if (ON(4) && IN(pb + 4)) { FRESH();
            pg8::Gemm g{(const bf16_t*)(F.ws + WS_OBR), (const bf16_t*)(F.ws + WS_WBR), M, DM, BW}; pg8::BranchOrder S; S.init(M, DM, F.G, F.bid);
            pg8::EpiBranch E{Pb, (float*)(F.ws + WS_SCR) + (size_t)F.bid * 65536, Hb, F.tid};
            pg8::gemm_phase<pg8::EpiBranch, pg8::BranchOrder, PG8_ALIGN, PG8_SP2>(F.lds, g, S, E, F.tid);
        } SEAM(pb + 4);
        if (ON(5) && IN(pb + 5)) { FRESH();
            pg8::Gemm g{Hb, (const bf16_t*)(F.ws + WS_WOUT), M, DM, DM}; pg8::StaticOrder S; S.init(M, DM, F.G, F.bid);
            pg8::EpiResidF32 E{a.out, DM};
            pg8::gemm_phase<pg8::EpiResidF32, pg8::StaticOrder, PG8_ALIGN, PG8_SP2>(F.lds, g, S, E, F.tid);
        } SEAM(pb + 5);
        if (ON(6) && IN(pb + 6)) { FRESH(); phase_F(F, a); } SEAM(pb + 6);
        if (ON(7) && IN(pb + 7)) { FRESH();
            pg8::Gemm g{Hb, (const bf16_t*)(F.ws + WS_WUP), M, NUP, DM}; pg8::StaticOrder S; S.init(M, NUP, F.G, F.bid);
            pg8::EpiStoreBf16 E{Pb, NUP};
            pg8::gemm_phase<pg8::EpiStoreBf16, pg8::StaticOrder, PG8_ALIGN, PG8_SP2>(F.lds, g, S, E, F.tid);
        } SEAM(pb + 7);
        if (ON(8) && IN(pb + 8)) { FRESH(); phase_H(F, a, layer); } SEAM(pb + 8);
        if (ON(9) && IN(pb + 9)) { FRESH();
            pg8::Gemm g{(const bf16_t*)(F.ws + WS_ACT), (const bf16_t*)(F.ws + WS_WDN), M, DM, DFF}; pg8::StaticOrder S; S.init(M, DM, F.G, F.bid);
            pg8::EpiResidF32 E{a.out, DM};
            pg8::gemm_phase<pg8::EpiResidF32, pg8::StaticOrder, PG8_ALIGN, PG8_SP2>(F.lds, g, S, E, F.tid);
        } SEAM(pb + 9);
    }
}

extern "C" void kernel_launch(void* const* d_in, const int* in_sizes, int n_in, void* d_out, int out_size, void* d_ws, size_t ws_size, hipStream_t stream) {
    static int grid = 0;
    if (grid == 0) {
        if (n_in != 18 || in_sizes[0] != M * DM || out_size != M * DM || ws_size < WS_END) { fprintf(stderr, "kernel_launch: unexpected shapes / workspace (%d inputs, ws %zu)\n", n_in, ws_size); grid = -1; return; }
        int dev = 0, cus = 0, per_cu = 0;
        if (hipGetDevice(&dev) != hipSuccess || hipDeviceGetAttribute(&cus, hipDeviceAttributeMultiprocessorCount, dev) != hipSuccess) { grid = -1; return; }
        if (hipFuncSetAttribute((const void*)mega, hipFuncAttributeMaxDynamicSharedMemorySize, LDS_BYTES) != hipSuccess) { grid = -1; return; }
        if (hipOccupancyMaxActiveBlocksPerMultiprocessor(&per_cu, (const void*)mega, 512, LDS_BYTES) != hipSuccess || per_cu < 1) { fprintf(stderr, "kernel_launch: occupancy query says %d\n", per_cu); }
        (void)hipGetLastError();
        grid = cus;
    }
    if (grid < 0) return;
    (void)hipMemsetAsync((char*)d_ws + WS_CTL, 0, CTL_BYTES, stream);
    Args a{};
    for (int i = 0; i < 18; ++i) a.in[i] = (const float*)d_in[i];
    a.out = (float*)d_out; a.ws = (unsigned char*)d_ws;
#if MK_ONE_LAUNCH
    a.ph_lo = 0; a.ph_hi = DEPTH * 10;
    hipLaunchKernelGGL(mega, dim3(grid), dim3(512), LDS_BYTES, stream, a);
#else
    for (int p = 0; p < DEPTH * 10; ++p) { a.ph_lo = p; a.ph_hi = p + 1; hipLaunchKernelGGL(mega, dim3(grid), dim3(512), LDS_BYTES, stream, a); }
#endif
}
```

```cpp
#include <hip/hip_runtime.h>
#include <stdint.h>
#include <stdio.h>

#ifndef MK_ONE_LAUNCH
#define MK_ONE_LAUNCH 1
#endif
#ifndef MK_PHASE_MASK
#define MK_PHASE_MASK 0x3ff
#endif
#ifndef MK_PROBE
#define MK_PROBE -1
#endif
#ifndef MK_BUILD_MASK
#define MK_BUILD_MASK 0x3ff
#endif

#define LAS __attribute__((address_space(3)))
typedef unsigned short bf16_t;
typedef short bf16x8 __attribute__((ext_vector_type(8)));
typedef short s16x4 __attribute__((ext_vector_type(4)));
typedef float f32x4 __attribute__((ext_vector_type(4)));
typedef float f32x16 __attribute__((ext_vector_type(16)));
typedef float f32x2 __attribute__((ext_vector_type(2)));
typedef unsigned u32x4 __attribute__((ext_vector_type(4)));
typedef unsigned u32x2 __attribute__((ext_vector_type(2)));
typedef __bf16 bfv2 __attribute__((ext_vector_type(2)));

constexpr int DM = 2048, NB = 16, T = 2048, DEPTH = 4, M = NB * T, HD = 128;
constexpr int INC = 15896;
constexpr int NPC = 16128;
constexpr int PQN = 0, PKC = 1024, PVC = 1280, PKS = 1536, PVS = 1792, PKW = 2048, PVW = 2304, PQS = 2560, PKSB = 3584, PVSB = 4608,
              PQH = 5632, PFH = 6656, PIH = 7680, PGH = 8704, PGT = 9728, PGN = 15872;
constexpr int DFF = 5632, NUP = 2 * DFF;
constexpr int BW = 1024;
constexpr float EPS = 1e-6f;
constexpr float LOG2E = 1.4426950408889634f, LN2 = 0.6931471805599453f;
constexpr float QSCALE = 0.08838834764831845f;

constexpr size_t MiB = 1u << 20;
constexpr size_t WS_CTL = 0, CTL_BYTES = 1 * MiB;
constexpr size_t WS_WIN = 1 * MiB, WS_WBR = 64 * MiB, WS_WOUT = 76 * MiB, WS_WUP = 84 * MiB, WS_WDN = 128 * MiB;
constexpr size_t WS_MISC = 150 * MiB;
constexpr size_t MISC_KCMP = 0, MISC_VCMP = 1 * MiB, MISC_WC1 = 2 * MiB;
constexpr int CW_CVEC = 32768;
constexpr size_t WS_SCR = 154 * MiB;
constexpr size_t WS_P = 218 * MiB;
constexpr size_t WS_H = 1226 * MiB;
constexpr size_t WS_OBR = 1354 * MiB;
constexpr size_t WS_ORAW = 1546 * MiB;
constexpr size_t WS_END = 1674 * MiB;
constexpr size_t WS_ACT = WS_P + 704 * MiB;
constexpr int CW_BAR = 4096;
constexpr int CW_QUEUE = 16384;

constexpr int RING_BYTES = 131072;
constexpr int MISC_OFF = RING_BYTES;
constexpr int LDS_BYTES = 147456;

__device__ __forceinline__ float bf2f(unsigned short b) { return __uint_as_float(((unsigned)b) << 16); }
__device__ __forceinline__ float bflo(unsigned w) { return __uint_as_float(w << 16); }
__device__ __forceinline__ float bfhi(unsigned w) { return __uint_as_float(w & 0xffff0000u); }
__device__ __forceinline__ unsigned pk2(float lo, float hi) { f32x2 v = {lo, hi}; bfv2 b = __builtin_convertvector(v, bfv2); return __builtin_bit_cast(unsigned, b); }
__device__ __forceinline__ float wave_sum(float v) {
#pragma unroll
    for (int o = 1; o < 64; o <<= 1) v += __shfl_xor(v, o);
    return v;
}
__device__ __forceinline__ float fast_exp2(float x) { return __builtin_amdgcn_exp2f(x); }
__device__ __forceinline__ float fast_log2(float x) { return __builtin_amdgcn_logf(x); }
__device__ __forceinline__ float fast_rcp(float x) { return __builtin_amdgcn_rcpf(x); }
__device__ __forceinline__ float sigmoidf_(float x) { return fast_rcp(1.f + fast_exp2(-x * LOG2E)); }
#define LDS_WAIT() asm volatile("s_waitcnt lgkmcnt(0)" ::: "memory")

#define XB_TMO      128
#define XB_XCNT(j)  (256  + 64 * (j))
#define XB_XSUB(j)  (1280 + 64 * (j))
#define XB_XGEN(j)  (2304 + 64 * (j))
#define XB_TOP      3328
#define XB_TOPGEN   3392
#define XCD_BAR_WORDS 3456
#define XB_SPIN_CAP (1u << 22)
__device__ __forceinline__ unsigned xb_ld(unsigned* p)              { return __hip_atomic_load(p, __ATOMIC_RELAXED, __HIP_MEMORY_SCOPE_AGENT); }
__device__ __forceinline__ unsigned xb_add(unsigned* p, unsigned v) { return __hip_atomic_fetch_add(p, v, __ATOMIC_RELAXED, __HIP_MEMORY_SCOPE_AGENT); }
__device__ __forceinline__ unsigned xb_xcc_id() { return (unsigned)__builtin_amdgcn_s_getreg((3 << 11) | 20) & 0xFu; }
#define XB_SPIN(cond, bar) do { unsigned _sp = 0; while (cond) { __builtin_amdgcn_s_sleep(1); \
    if ((++_sp & 255u) == 0u) { if (xb_ld(&(bar)[XB_TMO])) break; if (_sp > XB_SPIN_CAP) { atomicAdd(&(bar)[XB_TMO], 1u); break; } } } } while (0)
struct XcdBarrier { unsigned* bar; unsigned x; volatile LAS unsigned* st; };
__device__ __forceinline__ XcdBarrier xcd_barrier_post(unsigned* bar, volatile LAS unsigned* st) {
    XcdBarrier b; b.bar = bar; b.x = xb_xcc_id(); b.st = st;
    if (threadIdx.x == 0) (void)xb_add(&bar[XB_XCNT(b.x)], 1u);
    return b;
}
__device__ __forceinline__ void xcd_barrier_complete(unsigned* bar, unsigned x, unsigned& nloc, unsigned& nx) {
    const unsigned G = gridDim.x * gridDim.y * gridDim.z;
    unsigned sum, cnt, mine, sp = 0u;
    for (;;) {
        sum = 0u; cnt = 0u; mine = 0u;
#pragma unroll
        for (unsigned j = 0; j < 16; ++j) { const unsigned c = xb_ld(&bar[XB_XCNT(j)]); sum += c; cnt += (c > 0u) ? 1u : 0u; mine = (j == x) ? c : mine; }
        if (sum == G) break;
        __builtin_amdgcn_s_sleep(1);
        if ((++sp & 255u) == 0u) { if (xb_ld(&bar[XB_TMO])) break; if (sp > XB_SPIN_CAP) { atomicAdd(&bar[XB_TMO], 1u); break; } }
    }
    nloc = mine > 0u ? mine : 1u; nx = cnt > 0u ? cnt : 1u;
}
__device__ __forceinline__ void xcd_barrier(const XcdBarrier& b) {
    asm volatile("s_waitcnt vmcnt(0)" ::: "memory");
    __syncthreads();
    if (threadIdx.x == 0) {
        unsigned* bar = b.bar;
        __builtin_amdgcn_s_waitcnt(0);
        unsigned nloc = b.st[0], nx = b.st[1];
        if (nloc == 0u) { xcd_barrier_complete(bar, b.x, nloc, nx); b.st[0] = nloc; b.st[1] = nx; }
        const unsigned old = xb_add(&bar[XB_XSUB(b.x)], 1u);
        const unsigned gen = old / nloc;
        if (old + 1u == (gen + 1u) * nloc) {
            __builtin_amdgcn_fence(__ATOMIC_RELEASE, "agent");
            asm volatile("s_waitcnt vmcnt(0)" ::: "memory");
            const unsigned og = xb_add(&bar[XB_TOP], 1u);
            const unsigned tg = og / nx;
            if (og + 1u == (tg + 1u) * nx) xb_add(&bar[XB_TOPGEN], 1u);
            else XB_SPIN(xb_ld(&bar[XB_TOPGEN]) == tg, bar);
            __builtin_amdgcn_fence(__ATOMIC_ACQUIRE, "agent");
            xb_add(&bar[XB_XGEN(b.x)], 1u);
            asm volatile("s_waitcnt vmcnt(0)" ::: "memory");
        } else {
            XB_SPIN(xb_ld(&bar[XB_XGEN(b.x)]) == gen, bar);
            __builtin_amdgcn_fence(__ATOMIC_ACQUIRE, "agent");
            asm volatile("s_waitcnt vmcnt(0)" ::: "memory");
        }
    }
    __syncthreads();
}

namespace pg8 {
constexpr int BM = 256, BK = 64, HALF = 128, HTB = HALF * BK * 2, STAGE_BYTES = 8 * HTB, NXCD = 8, WGM = 8;
__host__ __device__ __forceinline__ int lds_byte(int r, int c) { const int st = (r >> 4) * 2 + (c >> 5), rr = r & 15, cc = c & 31, ob = rr * 64 + cc * 2; return st * 1024 + (ob ^ (((ob >> 9) & 1) << 5)); }
__host__ __device__ __forceinline__ void stage_rc(int b, int& R, int& C) { const int st = b / 1024, sb = b % 1024, swz = sb ^ (((sb >> 9) & 1) << 5); R = (st >> 1) * 16 + swz / 64; C = (st & 1) * 32 + (swz % 64) / 2; }
__host__ __device__ __forceinline__ int perm32(int rho) { const int n = rho >> 4, i = rho & 15; return 8 * (i >> 2) + 4 * n + (i & 3); }
struct Unit { int pm, pn, aux; };
struct Gemm { const bf16_t* A; const bf16_t* Bt; int M, N, K; };
struct StaticOrder {
    int nM, nN, nwg, G, c;
    __device__ void init(int M_, int N_, int G_, int c_) { nM = M_ / BM; nN = N_ / BM; nwg = nM * nN; G = G_; c = c_; }
    __device__ __forceinline__ bool tile(long L, Unit& u) const {
        if (L >= nwg) return false;
        int wgid = (int)L; { const int q = nwg / NXCD, r = nwg % NXCD, xcd = wgid % NXCD, off = wgid / NXCD; wgid = (xcd < r ? xcd * (q + 1) : r * (q + 1) + (xcd - r) * q) + off; }
        const int nig = WGM * nN, gid = wgid / nig, fm = gid * WGM, gsz = (nM - fm) < WGM ? (nM - fm) : WGM;
        u.pm = fm + ((wgid % nig) % gsz); u.pn = (wgid % nig) / gsz; u.aux = 0; return true;
    }
    __device__ __forceinline__ bool next(int i, Unit& u) const { return tile((long)i * G + c, u); }
    __device__ __forceinline__ const char* aptr(const Gemm& g, const Unit& u, size_t tstep) const { return (const char*)g.A + (size_t)u.pm * tstep; }
    __device__ __forceinline__ const char* bptr(const Gemm& g, const Unit& u, size_t tstep) const { return (const char*)g.Bt + (size_t)u.pn * tstep; }
    __device__ __forceinline__ void a_ready(const Unit&) const {}
    __device__ __forceinline__ void done(const Unit&) const {}
};
struct BranchOrder : StaticOrder {
    __device__ __forceinline__ bool next(int i, Unit& u) const { const int ti = i / 3; if (!tile((long)ti * G + c, u)) return false; u.aux = i - 3 * ti; return true; }
    __device__ __forceinline__ const char* aptr(const Gemm& g, const Unit& u, size_t tstep) const { return (const char*)g.A + (size_t)u.aux * ((size_t)M * BW * 2) + (size_t)u.pm * tstep; }
    __device__ __forceinline__ const char* bptr(const Gemm& g, const Unit& u, size_t tstep) const { return (const char*)g.Bt + (size_t)(u.aux * (DM / 256) + u.pn) * tstep; }
};

struct EpiStoreBf16 {
    static constexpr bool PERM = true, AFTER_DRAIN = false;
    bf16_t* O; int ldc;
    __device__ __forceinline__ void operator()(const f32x4 (&acc)[2][2][4][2], const Unit& u, int wr, int wc, int fr, int fq) const {
        const int row0 = u.pm * BM + wr * 64 + fr, col0 = u.pn * BM + wc * 32 + 8 * fq;
#pragma unroll
        for (int ai = 0; ai < 2; ++ai)
#pragma unroll
            for (int m = 0; m < 4; ++m) { bf16_t* rowp = O + (size_t)(row0 + ai * HALF + m * 16) * ldc + col0;
#pragma unroll
                for (int bj = 0; bj < 2; ++bj) { const f32x4 v0 = acc[ai][bj][m][0], v1 = acc[ai][bj][m][1];
                    u32x4 w; w.x = pk2(v0[0], v0[1]); w.y = pk2(v0[2], v0[3]); w.z = pk2(v1[0], v1[1]); w.w = pk2(v1[2], v1[3]);
                    *(u32x4*)(rowp + bj * HALF) = w; } }
    }
};
struct EpiResidF32 {
    static constexpr bool PERM = false, AFTER_DRAIN = false;
    float* C; int ldc;
    __device__ __forceinline__ void operator()(const f32x4 (&acc)[2][2][4][2], const Unit& u, int wr, int wc, int fr, int fq) const {
        const int row0 = u.pm * BM + wr * 64 + fr, col0 = u.pn * BM + wc * 32 + 4 * fq;
#pragma unroll
        for (int ai = 0; ai < 2; ++ai)
#pragma unroll
            for (int m = 0; m < 4; ++m) { float* rowp = C + (size_t)(row0 + ai * HALF + m * 16) * ldc + col0;
                f32x4 old[2][2];
#pragma unroll
                for (int bj = 0; bj < 2; ++bj)
#pragma unroll
                    for (int n = 0; n < 2; ++n) old[bj][n] = *(const f32x4*)(rowp + bj * HALF + n * 16);
#pragma unroll
                for (int bj = 0; bj < 2; ++bj)
#pragma unroll
                    for (int n = 0; n < 2; ++n) *(f32x4*)(rowp + bj * HALF + n * 16) = old[bj][n] + acc[ai][bj][m][n]; }
    }
};
struct EpiBranch {
    static constexpr bool PERM = true, AFTER_DRAIN = false;
    const bf16_t* P; float* scr; bf16_t* merged; int tid;
    __device__ __forceinline__ void operator()(const f32x4 (&acc)[2][2][4][2], const Unit& u, int wr, int wc, int fr, int fq) const {
        const unsigned row0 = (unsigned)(u.pm * BM + wr * 64 + fr), col0 = (unsigned)(u.pn * BM + wc * 32 + 8 * fq);
        const char* Pg = (const char*)(P + PGT + u.aux * DM); const char* sb = (const char*)scr; char* mg = (char*)merged;
        const int aux = u.aux; unsigned tbase = (unsigned)tid * 16u; asm volatile("" : "+v"(tbase));
#pragma unroll
        for (int ai = 0; ai < 2; ++ai)
#pragma unroll
            for (int m = 0; m < 4; ++m) { const unsigned row = row0 + ai * HALF + m * 16;
                const unsigned poff = (row * (unsigned)NPC + col0) * 2u, moff = (row * (unsigned)DM + col0) * 2u;
#pragma unroll
                for (int bj = 0; bj < 2; ++bj) {
                    const u32x4 gw = *(const u32x4*)(Pg + (size_t)(poff + bj * 256u));
                    f32x4 s0, s1;
                    s0[0] = sigmoidf_(bflo(gw.x)); s0[1] = sigmoidf_(bfhi(gw.x)); s0[2] = sigmoidf_(bflo(gw.y)); s0[3] = sigmoidf_(bfhi(gw.y));
                    s1[0] = sigmoidf_(bflo(gw.z)); s1[1] = sigmoidf_(bfhi(gw.z)); s1[2] = sigmoidf_(bflo(gw.w)); s1[3] = sigmoidf_(bfhi(gw.w));
                    f32x4 v0 = acc[ai][bj][m][0] * s0, v1 = acc[ai][bj][m][1] * s1;
                    const unsigned soff = (unsigned)(((ai * 4 + m) * 2 + bj) * 2) * 8192u + tbase;
                    if (aux > 0) { v0 += *(const f32x4*)(sb + (size_t)soff); v1 += *(const f32x4*)(sb + (size_t)(soff + 8192u)); }
                    if (aux < 2) { *(f32x4*)(const_cast<char*>(sb) + (size_t)soff) = v0; *(f32x4*)(const_cast<char*>(sb) + (size_t)(soff + 8192u)) = v1; }
                    else { u32x4 w; w.x = pk2(v0[0], v0[1]); w.y = pk2(v0[2], v0[3]); w.z = pk2(v1[0], v1[1]); w.w = pk2(v1[2], v1[3]);
                        *(u32x4*)(mg + (size_t)(moff + bj * 256u)) = w; } }
                asm volatile("" ::: "memory"); }
    }
};

template <class Epi, class Sched, bool ALIGN_EPI = false, bool SP2 = false>
__device__ __forceinline__ void gemm_phase(LAS unsigned char* lds, const Gemm g, const Sched& S, const Epi& E, const int tid) {
    const int wid = __builtin_amdgcn_readfirstlane(tid >> 6), lane = tid & 63, wr = wid >> 2, wc = wid & 3, fr = lane & 15, fq = lane >> 4;
    const int K = g.K, nt = K / BK;
    unsigned voffA[2], voffB[2];
#pragma unroll
    for (int i = 0; i < 2; ++i) { int R, C; stage_rc(tid * 16 + i * 8192, R, C); const int Rb = Epi::PERM ? ((R & ~31) + perm32(R & 31)) : R;
        voffA[i] = (unsigned)(R * K + C) * 2u; voffB[i] = (unsigned)(Rb * K + C) * 2u; }
    const size_t kstep = (size_t)(BK * 2);
    const size_t hstep = (size_t)HALF * K * 2;
    const size_t tstep = 2 * hstep;
    const unsigned ldsw = (unsigned)wid * 1024u;
    const int aoff = lds_byte(wr * 64 + fr, fq * 8), boff = lds_byte(wc * 32 + fr, fq * 8);
#define PG8_SA(b, h) (((b) * 2 + (h)) * HTB)
#define PG8_SB(b, h) ((4 + (b) * 2 + (h)) * HTB)
#define PG8_STAGE(bufoff, gbase, voff) do { _Pragma("unroll") for (int _i = 0; _i < 2; ++_i) \
        __builtin_amdgcn_global_load_lds((const unsigned*)((const char*)(gbase) + (voff)[_i]), (LAS unsigned*)(lds + (bufoff) + ldsw + _i * 8192), 16, 0, 0); } while (0)
#define PG8_LDA(dst, b, h) do { _Pragma("unroll") for (int m = 0; m < 4; ++m) _Pragma("unroll") for (int k = 0; k < 2; ++k) dst[m][k] = *(const LAS bf16x8*)(lds + PG8_SA(b, h) + aoff + m * 2048 + k * 1024); } while (0)
#define PG8_LDB(dst, b, h) do { _Pragma("unroll") for (int n = 0; n < 2; ++n) _Pragma("unroll") for (int k = 0; k < 2; ++k) dst[n][k] = *(const LAS bf16x8*)(lds + PG8_SB(b, h) + boff + n * 2048 + k * 1024); } while (0)
#define PG8_MMA(ai, bj, At, Bt) do { __builtin_amdgcn_s_setprio(1); _Pragma("unroll") for (int m = 0; m < 4; ++m) _Pragma("unroll") for (int n = 0; n < 2; ++n) _Pragma("unroll") for (int k = 0; k < 2; ++k) \
        acc[ai][bj][m][n] = __builtin_amdgcn_mfma_f32_16x16x32_bf16(Bt[n][k], At[m][k], acc[ai][bj][m][n], 0, 0, 0); __builtin_amdgcn_s_setprio(0); } while (0)
#define PG8_WAIT_V(n) asm volatile("s_waitcnt vmcnt(" #n ")" ::: "memory")
#define PG8_WAIT_L(n) asm volatile("s_waitcnt lgkmcnt(" #n ")" ::: "memory")
#define PG8_BAR __builtin_amdgcn_s_barrier()
#define PG8_SCHED __builtin_amdgcn_sched_barrier(0)
    Unit cur, nxt; int ui = 0;
    if (!S.next(0, cur)) return;
    f32x4 acc[2][2][4][2];
#pragma unroll
    for (int a = 0; a < 2; ++a)
#pragma unroll
        for (int b = 0; b < 2; ++b)
#pragma unroll
            for (int m = 0; m < 4; ++m)
#pragma unroll
                for (int n = 0; n < 2; ++n) acc[a][b][m][n] = (f32x4){0.f, 0.f, 0.f, 0.f};
    bf16x8 At[4][2], B0[2][2], B1[2][2];
    const char* cA = S.aptr(g, cur, tstep); const char* cB = S.bptr(g, cur, tstep);
    S.a_ready(cur);
    if constexpr (SP2) {
        PG8_STAGE(PG8_SB(0, 0), cB, voffB); PG8_STAGE(PG8_SB(0, 1), cB + hstep, voffB); PG8_STAGE(PG8_SA(0, 0), cA, voffA); PG8_STAGE(PG8_SA(0, 1), cA + hstep, voffA);
        if (wr == 1) PG8_BAR;
        PG8_WAIT_V(2); PG8_BAR;
        PG8_STAGE(PG8_SB(1, 0), cB + kstep, voffB); PG8_STAGE(PG8_SA(1, 0), cA + kstep, voffA); PG8_STAGE(PG8_SB(1, 1), cB + hstep + kstep, voffB);
        PG8_WAIT_V(6); PG8_BAR;
    } else {
        PG8_STAGE(PG8_SB(0, 0), cB, voffB); PG8_STAGE(PG8_SA(0, 0), cA, voffA); PG8_STAGE(PG8_SB(0, 1), cB + hstep, voffB); PG8_STAGE(PG8_SA(0, 1), cA + hstep, voffA);
        if (wr == 1) PG8_BAR;
        PG8_WAIT_V(4); PG8_BAR;
        PG8_STAGE(PG8_SB(1, 0), cB + kstep, voffB); PG8_STAGE(PG8_SA(1, 0), cA + kstep, voffA); PG8_STAGE(PG8_SB(1, 1), cB + hstep + kstep, voffB);
        PG8_WAIT_V(6); PG8_BAR;
    }
    for (;;) {
        const bool has_next = S.next(ui + 1, nxt);
        const char* nA = has_next ? S.aptr(g, nxt, tstep) : cA; const char* nB = has_next ? S.bptr(g, nxt, tstep) : cB;
        for (int t = 0; t < nt; t += 2) {
            const bool last = (t == nt - 2);
            const char* a1 = cA + (size_t)(t + 1) * kstep;
            const char* a2 = last ? nA : cA + (size_t)(t + 2) * kstep; const char* b2 = last ? nB : cB + (size_t)(t + 2) * kstep;
            const char* a3 = a2 + kstep; const char* b3 = b2 + kstep;
            if (last && has_next) S.a_ready(nxt);
            if constexpr (SP2) {
            PG8_LDB(B0, 0, 0); PG8_LDB(B1, 0, 1); PG8_SCHED; PG8_LDA(At, 0, 0); PG8_STAGE(PG8_SA(1, 1), a1 + hstep, voffA);
            PG8_WAIT_V(8); PG8_WAIT_L(0); PG8_BAR; PG8_MMA(0, 0, At, B0); PG8_MMA(0, 1, At, B1); PG8_BAR; PG8_SCHED;
            PG8_LDA(At, 0, 1); PG8_STAGE(PG8_SB(0, 0), b2, voffB); PG8_STAGE(PG8_SB(0, 1), b2 + hstep, voffB); PG8_STAGE(PG8_SA(0, 0), a2, voffA);
            PG8_WAIT_V(8); PG8_WAIT_L(0); PG8_BAR; PG8_MMA(1, 0, At, B0); PG8_MMA(1, 1, At, B1); PG8_BAR; PG8_SCHED;
            PG8_LDB(B0, 1, 0); PG8_LDB(B1, 1, 1); PG8_SCHED; PG8_LDA(At, 1, 0); PG8_STAGE(PG8_SA(0, 1), a2 + hstep, voffA);
            PG8_WAIT_V(8); PG8_WAIT_L(0); PG8_BAR; PG8_MMA(0, 0, At, B0); PG8_MMA(0, 1, At, B1); PG8_BAR; PG8_SCHED;
            PG8_LDA(At, 1, 1); PG8_STAGE(PG8_SB(1, 0), b3, voffB); PG8_STAGE(PG8_SB(1, 1), b3 + hstep, voffB); PG8_STAGE(PG8_SA(1, 0), a3, voffA);
            PG8_WAIT_V(8); PG8_WAIT_L(0); PG8_BAR; PG8_MMA(1, 0, At, B0); PG8_MMA(1, 1, At, B1); PG8_BAR; PG8_SCHED;
            } else {
            PG8_LDB(B0, 0, 0); PG8_SCHED; PG8_LDA(At, 0, 0); PG8_STAGE(PG8_SA(1, 1), a1 + hstep, voffA);
            PG8_WAIT_L(8); PG8_BAR; PG8_WAIT_L(0); PG8_MMA(0, 0, At, B0); PG8_BAR; PG8_SCHED;
            PG8_LDB(B1, 0, 1); PG8_STAGE(PG8_SB(0, 0), b2, voffB);
            PG8_BAR; PG8_WAIT_L(0); PG8_MMA(0, 1, At, B1); PG8_BAR;
            PG8_LDA(At, 0, 1); PG8_STAGE(PG8_SA(0, 0), a2, voffA);
            PG8_BAR; PG8_WAIT_L(0); PG8_MMA(1, 0, At, B0); PG8_BAR; PG8_SCHED;
            PG8_STAGE(PG8_SB(0, 1), b2 + hstep, voffB);
            PG8_WAIT_V(6); PG8_BAR; PG8_MMA(1, 1, At, B1); PG8_BAR;
            PG8_LDB(B0, 1, 0); PG8_SCHED; PG8_LDA(At, 1, 0); PG8_STAGE(PG8_SA(0, 1), a2 + hstep, voffA);
            PG8_WAIT_L(8); PG8_BAR; PG8_WAIT_L(0); PG8_MMA(0, 0, At, B0); PG8_BAR; PG8_SCHED;
            PG8_LDB(B1, 1, 1); PG8_STAGE(PG8_SB(1, 0), b3, voffB);
            PG8_BAR; PG8_WAIT_L(0); PG8_MMA(0, 1, At, B1); PG8_BAR;
            PG8_LDA(At, 1, 1); PG8_STAGE(PG8_SA(1, 0), a3, voffA);
            PG8_BAR; PG8_WAIT_L(0); PG8_MMA(1, 0, At, B0); PG8_BAR; PG8_SCHED;
            PG8_STAGE(PG8_SB(1, 1), b3 + hstep, voffB);
            PG8_WAIT_V(6); PG8_BAR; PG8_MMA(1, 1, At, B1); PG8_BAR;
            }
        }
        if constexpr (ALIGN_EPI) { if (wr == 0) PG8_BAR; }
        if constexpr (!Epi::AFTER_DRAIN) { E(acc, cur, wr, wc, fr, fq); S.done(cur); }
        if (!has_next) break;
#pragma unroll
        for (int a = 0; a < 2; ++a)
#pragma unroll
            for (int b = 0; b < 2; ++b)
#pragma unroll
                for (int m = 0; m < 4; ++m)
#pragma unroll
                    for (int n = 0; n < 2; ++n) acc[a][b][m][n] = (f32x4){0.f, 0.f, 0.f, 0.f};
        cur = nxt; cA = nA; cB = nB; ++ui;
        if constexpr (ALIGN_EPI) { if (wr == 1) PG8_BAR; }
    }
    PG8_WAIT_V(0);
    if constexpr (!ALIGN_EPI) { if (wr == 0) PG8_BAR; }
    PG8_BAR;
#undef PG8_SA
#undef PG8_SB
#undef PG8_STAGE
#undef PG8_LDA
#undef PG8_LDB
#undef PG8_MMA
#undef PG8_WAIT_V
#undef PG8_WAIT_L
#undef PG8_BAR
#undef PG8_SCHED
}
}
#define PG8_SP2 true
#define PG8_ALIGN true

struct Args { const float* in[18]; float* out; unsigned char* ws; int ph_lo, ph_hi; };
enum { I_X = 0, I_NATT, I_WIN, I_QG, I_KG, I_CPOS, I_CW1, I_CW2, I_RELB, I_HLB, I_HNG, I_WBR, I_WOUT, I_NFFN, I_WUP, I_CONVW, I_CONVB, I_WDN };

struct Frame {
    LAS unsigned char* lds; volatile LAS unsigned* MISC;
    unsigned* ctl; unsigned char* ws;
    int tid, lane, wave, G, bid;
};

__device__ __forceinline__ int inproj_src_col(int n) { return n < 2560 ? n : (n < 15872 ? n + 24 : (n < 15896 ? n - 15872 + 2560 : -1)); }
__device__ __forceinline__ void transpose_item(const float* W, int K, int Nsrc, bf16_t* WT, const float* gain, int mode, LAS float* scr, int item, int nblk, int lane) {
    const int kb = item / nblk, nb = item - kb * nblk, k0 = 64 * kb, n0 = 32 * nb;
    const int nn = n0 + (lane & 7) * 4; const int sc = mode ? inproj_src_col(nn) : nn;
    f32x4 v[8];
#pragma unroll
    for (int i = 0; i < 8; ++i) { const int kk = 8 * i + (lane >> 3); v[i] = sc >= 0 ? *(const f32x4*)(W + (size_t)(k0 + kk) * Nsrc + sc) : (f32x4){0.f, 0.f, 0.f, 0.f}; }
#pragma unroll
    for (int i = 0; i < 8; ++i) { const int kk = 8 * i + (lane >> 3); const float gk = gain ? gain[k0 + kk] : 1.f; LAS float* d = scr + kk * 33 + (lane & 7) * 4;
        d[0] = v[i].x * gk; d[1] = v[i].y * gk; d[2] = v[i].z * gk; d[3] = v[i].w * gk; }
    LDS_WAIT(); asm volatile("" ::: "memory");
    const int c = lane & 7;
#pragma unroll
    for (int j = 0; j < 4; ++j) { const int n = (lane >> 3) + 8 * j; const LAS float* sp = scr + (8 * c) * 33 + n;
        u32x4 o; o.x = pk2(sp[0 * 33], sp[1 * 33]); o.y = pk2(sp[2 * 33], sp[3 * 33]); o.z = pk2(sp[4 * 33], sp[5 * 33]); o.w = pk2(sp[6 * 33], sp[7 * 33]);
        *(u32x4*)(WT + (size_t)(n0 + n) * K + k0 + 8 * c) = o; }
    LDS_WAIT(); asm volatile("" ::: "memory");
}
__device__ __forceinline__ void rms_row(const float* xin, float* xcopy, bf16_t* hout, int lane) {
    const f32x4* xr = (const f32x4*)xin + lane;
    f32x4 v[8]; float s = 0.f;
#pragma unroll
    for (int j = 0; j < 8; ++j) { v[j] = xr[64 * j]; s += (v[j].x * v[j].x + v[j].y * v[j].y) + (v[j].z * v[j].z + v[j].w * v[j].w); }
    s = wave_sum(s);
    const float r = rsqrtf(s * (1.f / DM) + EPS);
    if (xcopy) { f32x4* xc = (f32x4*)xcopy + lane;
#pragma unroll
        for (int j = 0; j < 8; ++j) xc[64 * j] = v[j]; }
    u32x2* o8 = (u32x2*)hout + lane;
#pragma unroll
    for (int j = 0; j < 8; ++j) { u32x2 w; w.x = pk2(v[j].x * r, v[j].y * r); w.y = pk2(v[j].z * r, v[j].w * r); o8[64 * j] = w; }
}

__device__ __forceinline__ void cvec_item(Frame& F, const Args& a, int layer, int j);
__device__ __forceinline__ void phase_A(Frame& F, const Args& a, int layer) {
    LAS float* scr = (LAS float*)(F.lds + F.wave * 16384);
    const int gw = F.bid * 8 + F.wave, NGW = F.G * 8;
    bf16_t* Wt_in = (bf16_t*)(F.ws + WS_WIN); bf16_t* Wt_br = (bf16_t*)(F.ws + WS_WBR); bf16_t* Wt_out = (bf16_t*)(F.ws + WS_WOUT);
    bf16_t* Wt_up = (bf16_t*)(F.ws + WS_WUP); bf16_t* Wt_dn = (bf16_t*)(F.ws + WS_WDN);
    const float* w_in = a.in[I_WIN] + (size_t)layer * DM * INC; const float* g_att = a.in[I_NATT] + layer * DM;
    const float* w_br = a.in[I_WBR] + (size_t)layer * 3 * BW * DM; const float* w_out = a.in[I_WOUT] + (size_t)layer * DM * DM;
    const float* w_up = a.in[I_WUP] + (size_t)layer * DM * NUP; const float* g_ffn = a.in[I_NFFN] + layer * DM;
    const float* w_dn = a.in[I_WDN] + (size_t)layer * DFF * DM;
    constexpr int I_IN = (DM / 64) * (NPC / 32), I_BR1 = (BW / 64) * (DM / 32), I_OUT = (DM / 64) * (DM / 32), I_UP = (DM / 64) * (NUP / 32), I_DN = (DFF / 64) * (DM / 32);
    constexpr int I_C1 = (4096 / 64) * (HD / 32);
    constexpr int NITEMS = I_IN + 3 * I_BR1 + I_OUT + I_UP + I_DN + 2 * I_C1;
    for (int it = gw; it < NITEMS; it += NGW) {
        int r = it;
        if (r < I_IN) { transpose_item(w_in, DM, INC, Wt_in, g_att, 1, scr, r, NPC / 32, F.lane); continue; } r -= I_IN;
        if (r < 3 * I_BR1) { const int n = r / I_BR1; r -= n * I_BR1; transpose_item(w_br + (size_t)n * BW * DM, BW, DM, Wt_br + (size_t)n * DM * BW, nullptr, 0, scr, r, DM / 32, F.lane); continue; } r -= 3 * I_BR1;
        if (r < I_OUT) { transpose_item(w_out, DM, DM, Wt_out, nullptr, 0, scr, r, DM / 32, F.lane); continue; } r -= I_OUT;
        if (r < I_UP) { transpose_item(w_up, DM, NUP, Wt_up, g_ffn, 0, scr, r, NUP / 32, F.lane); continue; } r -= I_UP;
        if (r < I_DN) { transpose_item(w_dn, DFF, DM, Wt_dn, nullptr, 0, scr, r, DM / 32, F.lane); continue; } r -= I_DN;
        { const int j = r / I_C1; r -= j * I_C1; transpose_item(a.in[I_CW1] + (size_t)(layer * 2 + j) * 4096 * HD, 4096, HD, (bf16_t*)(F.ws + WS_MISC + MISC_WC1) + (size_t)j * HD * 4096, nullptr, 0, scr, r, HD / 32, F.lane); }
    }
    if (F.bid < 2) cvec_item(F, a, layer, F.bid);
    const float* xin = layer == 0 ? a.in[I_X] : a.out; float* xcopy = layer == 0 ? a.out : nullptr; bf16_t* H = (bf16_t*)(F.ws + WS_H);
    for (int m = gw; m < M; m += NGW) rms_row(xin + (size_t)m * DM, xcopy ? xcopy + (size_t)m * DM : nullptr, H + (size_t)m * DM, F.lane);
}
__device__ __forceinline__ void phase_F(Frame& F, const Args& a) {
    const int gw = F.bid * 8 + F.wave, NGW = F.G * 8; bf16_t* H = (bf16_t*)(F.ws + WS_H);
    for (int m = gw; m < M; m += NGW) rms_row(a.out + (size_t)m * DM, nullptr, H + (size_t)m * DM, F.lane);
}
__device__ __forceinline__ void phase_H(Frame& F, const Args& a, int layer) {
    const bf16_t* U = (const bf16_t*)(F.ws + WS_P); bf16_t* ACT = (bf16_t*)(F.ws + WS_ACT);
    const float* cw = a.in[I_CONVW] + (size_t)layer * 3 * NUP; const float* cb = a.in[I_CONVB] + (size_t)layer * NUP;
    constexpr int CG = DFF / 8, TBK = 32, NTASK = (M / TBK) * CG;
    for (int task = F.bid * 512 + F.tid; task < NTASK; task += F.G * 512) {
        const int blk = task / CG, cg = task - blk * CG, m0 = blk * TBK, c0 = cg * 8; const bool first = (m0 & (T - 1)) == 0;
        float wg[3][8], wv[3][8], bg[8], bv[8];
#pragma unroll
        for (int j = 0; j < 3; ++j) { const f32x4 g0 = *(const f32x4*)(cw + (size_t)j * NUP + c0), g1 = *(const f32x4*)(cw + (size_t)j * NUP + c0 + 4), v0 = *(const f32x4*)(cw + (size_t)j * NUP + DFF + c0), v1 = *(const f32x4*)(cw + (size_t)j * NUP + DFF + c0 + 4);
#pragma unroll
            for (int e = 0; e < 4; ++e) { wg[j][e] = g0[e]; wg[j][4 + e] = g1[e]; wv[j][e] = v0[e]; wv[j][4 + e] = v1[e]; } }
        { const f32x4 g0 = *(const f32x4*)(cb + c0), g1 = *(const f32x4*)(cb + c0 + 4), v0 = *(const f32x4*)(cb + DFF + c0), v1 = *(const f32x4*)(cb + DFF + c0 + 4);
#pragma unroll
          for (int e = 0; e < 4; ++e) { bg[e] = g0[e]; bg[4 + e] = g1[e]; bv[e] = v0[e]; bv[4 + e] = v1[e]; } }
        float g1h[8], g2h[8], v1h[8], v2h[8];
#pragma unroll
        for (int e = 0; e < 8; ++e) { g1h[e] = 0.f; g2h[e] = 0.f; v1h[e] = 0.f; v2h[e] = 0.f; }
        if (!first) {
            const u32x4 a2 = *(const u32x4*)(U + (size_t)(m0 - 2) * NUP + c0), a1 = *(const u32x4*)(U + (size_t)(m0 - 1) * NUP + c0);
            const u32x4 b2 = *(const u32x4*)(U + (size_t)(m0 - 2) * NUP + DFF + c0), b1 = *(const u32x4*)(U + (size_t)(m0 - 1) * NUP + DFF + c0);
            const unsigned x2[4] = {a2.x, a2.y, a2.z, a2.w}, x1[4] = {a1.x, a1.y, a1.z, a1.w}, y2[4] = {b2.x, b2.y, b2.z, b2.w}, y1[4] = {b1.x, b1.y, b1.z, b1.w};
#pragma unroll
            for (int q = 0; q < 4; ++q) { g2h[2 * q] = bflo(x2[q]); g2h[2 * q + 1] = bfhi(x2[q]); g1h[2 * q] = bflo(x1[q]); g1h[2 * q + 1] = bfhi(x1[q]);
                v2h[2 * q] = bflo(y2[q]); v2h[2 * q + 1] = bfhi(y2[q]); v1h[2 * q] = bflo(y1[q]); v1h[2 * q + 1] = bfhi(y1[q]); }
        }
#pragma unroll 4
        for (int t = 0; t < TBK; ++t) {
            const u32x4 ug = *(const u32x4*)(U + (size_t)(m0 + t) * NUP + c0), uv = *(const u32x4*)(U + (size_t)(m0 + t) * NUP + DFF + c0);
            const unsigned ugw[4] = {ug.x, ug.y, ug.z, ug.w}, uvw[4] = {uv.x, uv.y, uv.z, uv.w};
            float gc[8], vc[8], o[8];
#pragma unroll
            for (int q = 0; q < 4; ++q) { gc[2 * q] = bflo(ugw[q]); gc[2 * q + 1] = bfhi(ugw[q]); vc[2 * q] = bflo(uvw[q]); vc[2 * q + 1] = bfhi(uvw[q]); }
#pragma unroll
            for (int e = 0; e < 8; ++e) {
                const float cg_ = bg[e] + g2h[e] * wg[0][e] + g1h[e] * wg[1][e] + gc[e] * wg[2][e];
                const float cv_ = bv[e] + v2h[e] * wv[0][e] + v1h[e] * wv[1][e] + vc[e] * wv[2][e];
                o[e] = cg_ * sigmoidf_(cg_) * cv_;
                g2h[e] = g1h[e]; g1h[e] = gc[e]; v2h[e] = v1h[e]; v1h[e] = vc[e]; }
            u32x4 w; w.x = pk2(o[0], o[1]); w.y = pk2(o[2], o[3]); w.z = pk2(o[4], o[5]); w.w = pk2(o[6], o[7]);
            *(u32x4*)(ACT + (size_t)(m0 + t) * DFF + c0) = w;
        }
    }
}

__device__ __forceinline__ int q_next(Frame& F, unsigned* head) {
    __syncthreads();
    if (F.tid == 0) F.MISC[16] = __hip_atomic_fetch_add(head, 1u, __ATOMIC_RELAXED, __HIP_MEMORY_SCOPE_AGENT);
    __syncthreads();
    return __builtin_amdgcn_readfirstlane((int)F.MISC[16]);
}
__device__ __forceinline__ int t5_bucket(int n) {
    if (n < 16) return n;
    int b = 16;
    b += (n >= 19); b += (n >= 21); b += (n >= 24); b += (n >= 27); b += (n >= 31); b += (n >= 35); b += (n >= 40); b += (n >= 46);
    b += (n >= 52); b += (n >= 59); b += (n >= 67); b += (n >= 77); b += (n >= 87); b += (n >= 99); b += (n >= 113);
    return b;
}
__device__ __forceinline__ int crow(int i, int h) { return (i & 3) + 8 * (i >> 2) + 4 * h; }

#define MFMA32(a, b, c) __builtin_amdgcn_mfma_f32_32x32x16_bf16((a), (b), (c), 0, 0, 0)
__device__ __forceinline__ void item_norm(Frame& F, const Args& a, int layer, int it) {
    bf16_t* P = (bf16_t*)(F.ws + WS_P);
    const float* qg = a.in[I_QG] + layer * HD; const float* kg = a.in[I_KG] + layer * 3 * HD;
    const int lane = F.lane;
    for (int rr = 0; rr < 8; ++rr) {
        bf16_t* pr = P + (size_t)(it * 64 + F.wave * 8 + rr) * NPC;
#pragma unroll
        for (int hh = 0; hh < 12; ++hh) {
            const int col = hh < 8 ? PQN + hh * HD : (hh < 10 ? PKS + (hh - 8) * HD : PKW + (hh - 10) * HD);
            const float* gn = hh < 8 ? qg : (hh < 10 ? kg + HD : kg + 2 * HD); const float sc = hh < 8 ? QSCALE : 1.f;
            unsigned* pp = (unsigned*)(pr + col) + lane; const unsigned w = *pp; const float x0 = bflo(w), x1 = bfhi(w);
            const float ss = wave_sum(x0 * x0 + x1 * x1); const float r = rsqrtf(ss * (1.f / HD) + EPS) * sc;
            *pp = pk2(x0 * r * gn[2 * lane], x1 * r * gn[2 * lane + 1]);
        }
    }
}
__device__ __forceinline__ void item_hgfin(Frame& F, const Args& a, int layer, int it) {
    const bf16_t* P = (const bf16_t*)(F.ws + WS_P); const float* OR = (const float*)(F.ws + WS_ORAW); bf16_t* OH = (bf16_t*)(F.ws + WS_OBR) + (size_t)2 * M * BW;
    const float* ng = a.in[I_HNG] + layer * HD; const int lane = F.lane;
    for (int rr = 0; rr < 8; ++rr) { const size_t row = (size_t)(it * 64 + F.wave * 8 + rr);
#pragma unroll
        for (int hh = 0; hh < 8; ++hh) {
            const f32x2 o = *((const f32x2*)(OR + row * BW + hh * HD) + lane);
            const unsigned gw = *((const unsigned*)(P + row * NPC + PGH + hh * HD) + lane);
            const float ss = wave_sum(o.x * o.x + o.y * o.y); const float r = rsqrtf(ss * (1.f / HD) + EPS);
            *((unsigned*)(OH + row * BW + hh * HD) + lane) = pk2(o.x * r * ng[2 * lane] * sigmoidf_(bflo(gw)), o.y * r * ng[2 * lane + 1] * sigmoidf_(bfhi(gw)));
        }
    }
}
__device__ __forceinline__ void cvec_item(Frame& F, const Args& a, int layer, int j) {
    const float* pos = a.in[I_CPOS] + (size_t)(layer * 2 + j) * 32 * HD; const float* w1 = a.in[I_CW1] + (size_t)(layer * 2 + j) * 32 * HD * HD;
    LAS float* red = (LAS float*)F.lds; const int e = F.tid & 127, ks = F.tid >> 7;
    float acc = 0.f;
    for (int k = ks * 1024; k < ks * 1024 + 1024; ++k) acc += pos[k] * w1[(size_t)k * HD + e];
    __syncthreads(); red[ks * 128 + e] = acc; __syncthreads();
    if (F.tid < 128) ((float*)(F.ctl + CW_CVEC))[j * 128 + F.tid] = red[F.tid] + red[128 + F.tid] + red[256 + F.tid] + red[384 + F.tid];
    __syncthreads();
}
__device__ __forceinline__ void item_compress(Frame& F, const Args& a, int layer, int id) {
    const int j = id >> 7, rem = id & 127, b = rem >> 3, g = (rem >> 2) & 1, n0 = (rem & 3) * 32;
    const bf16_t* P = (const bf16_t*)(F.ws + WS_P);
    LAS float* red = (LAS float*)F.lds;
    LAS float* hid = (LAS float*)(F.lds + 16384);
    LAS float* outv = (LAS float*)(F.lds + 16384 + 32 * 132 * 4);
    const int tid = F.tid, lane = F.lane, wave = F.wave, r = lane & 31, h = lane >> 5, ct = wave & 3, kh = wave >> 2;
    f32x16 acc;
#pragma unroll
    for (int i = 0; i < 16; ++i) acc[i] = 0.f;
    {
        int trow = 16 * (n0 + r) + 16 * kh; const int tmax = T - 1;
        const bf16_t* Ab = P + (size_t)(b * T) * NPC + (j ? PVC : PKC) + g * HD + 8 * h;
        const bf16_t* Bb = (const bf16_t*)(F.ws + WS_MISC + MISC_WC1) + (size_t)(j * HD + 32 * ct + r) * 4096 + (size_t)(16 * kh) * HD + 8 * h;
        for (int l = 0; l < 16; ++l) { const int t = (trow + l) < tmax ? (trow + l) : tmax; const bf16_t* ap = Ab + (size_t)t * NPC; const bf16_t* bp = Bb + l * HD;
#pragma unroll
            for (int ds = 0; ds < 8; ++ds) { const bf16x8 av = *(const bf16x8*)(ap + 16 * ds), bv = *(const bf16x8*)(bp + 16 * ds); acc = MFMA32(av, bv, acc); } }
    }
    if (kh == 1) {
#pragma unroll
        for (int i = 0; i < 16; ++i) red[(ct * 16 + i) * 64 + lane] = acc[i]; }
    __syncthreads();
    if (kh == 0) { const float cv = ((const float*)(F.ctl + CW_CVEC))[j * 128 + 32 * ct + r];
#pragma unroll
        for (int i = 0; i < 16; ++i) { const float x = acc[i] + red[(ct * 16 + i) * 64 + lane] + cv;
            const float y = 0.7978845608028654f * (x + 0.044715f * x * x * x);
            const float th = 1.f - 2.f * fast_rcp(1.f + fast_exp2(2.f * y * LOG2E));
            hid[crow(i, h) * 132 + 32 * ct + r] = 0.5f * x * (1.f + th); } }
    __syncthreads();
    { const int e2 = tid & 127, ng = __builtin_amdgcn_readfirstlane(tid >> 7); const float* w2 = a.in[I_CW2] + (size_t)(layer * 2 + j) * HD * HD + e2;
      float o[8];
#pragma unroll
      for (int q = 0; q < 8; ++q) o[q] = 0.f;
      for (int k = 0; k < 128; k += 4) { const float w0 = w2[(size_t)k * HD], w1 = w2[(size_t)(k + 1) * HD], w2_ = w2[(size_t)(k + 2) * HD], w3 = w2[(size_t)(k + 3) * HD];
#pragma unroll
          for (int q = 0; q < 8; ++q) { const f32x4 hv = *(const LAS f32x4*)(hid + (8 * ng + q) * 132 + k); o[q] += (hv.x * w0 + hv.y * w1) + (hv.z * w2_ + hv.w * w3); } }
#pragma unroll
      for (int q = 0; q < 8; ++q) outv[(8 * ng + q) * 132 + e2] = o[q]; }
    __syncthreads();
    const float* kg0 = a.in[I_KG] + layer * 3 * HD;
#pragma unroll
    for (int q = 0; q < 4; ++q) { const int n = 4 * wave + q; float v0 = outv[n * 132 + 2 * lane], v1 = outv[n * 132 + 2 * lane + 1];
        if (j == 0) { const float ss = wave_sum(v0 * v0 + v1 * v1); const float rr = rsqrtf(ss * (1.f / HD) + EPS); v0 *= rr * kg0[2 * lane]; v1 *= rr * kg0[2 * lane + 1]; }
        if (n0 + n >= 127) { v0 = 0.f; v1 = 0.f; }
        bf16_t* dst = (bf16_t*)(F.ws + WS_MISC + (j ? MISC_VCMP : MISC_KCMP)) + (size_t)((b * 2 + g) * 128 + n0 + n) * HD;
        *((unsigned*)dst + lane) = pk2(v0, v1); }
}
constexpr int HG_Q1 = 0, HG_K1 = 17408, HG_QI = 34816, HG_K2 = 43520, HG_K3T = 52224, HG_VT = 70656, HG_AT = 79872, HG_SB = 89088, HG_TOT = 123904, HG_LB = 125952;
__device__ __forceinline__ void item_hgrn(Frame& F, const Args& a, int layer, int id) {
    const int b = id >> 4, hh = (id >> 1) & 7, half = id & 1;
    const bf16_t* P = (const bf16_t*)(F.ws + WS_P); float* OR = (float*)(F.ws + WS_ORAW);
    LAS unsigned char* L = F.lds;
    LAS float* tot = (LAS float*)(L + HG_TOT); LAS float* lbs = (LAS float*)(L + HG_LB);
    const int tid = F.tid, lane = F.lane, wave = F.wave, r = lane & 31, h = lane >> 5;
    if (tid < 128) { const float* hb = a.in[I_HLB] + hh * HD + tid; const float x0 = hb[0], x1 = hb[1024], x2 = hb[2048], x3 = hb[3072];
        const float mx = fmaxf(fmaxf(x0, x1), fmaxf(x2, x3)); const float e0 = __expf(x0 - mx), e1 = __expf(x1 - mx), e2 = __expf(x2 - mx), e3 = __expf(x3 - mx);
        const float inv = 1.f / (e0 + e1 + e2 + e3); float c = 0.f; if (layer >= 1) c += e1; if (layer >= 2) c += e2; if (layer >= 3) c += e3;
        lbs[tid] = fmaxf(c * inv, 0.f); }
    for (int i = tid; i < 17408 / 16; i += 512) *(LAS u32x4*)(L + HG_SB + i * 16) = (u32x4){0u, 0u, 0u, 0u};
    f32x16 Sacc;
#pragma unroll
    for (int i = 0; i < 16; ++i) Sacc[i] = 0.f;
    const int pd = tid & 127, psc = __builtin_amdgcn_readfirstlane(tid >> 7);
    const int srow = tid >> 4, sch = tid & 15, vrow = tid >> 3, vch = tid & 7;
    const bf16_t* gq = P + (size_t)(b * T + srow) * NPC + PQH + hh * HD + sch * 8; const bf16_t* gf = P + (size_t)(b * T + srow) * NPC + PFH + hh * HD + sch * 8;
    const bf16_t* gv = P + (size_t)(b * T + vrow) * NPC + PIH + hh * HD + half * 64 + vch * 8;
    u32x4 rq0 = *(const u32x4*)gq, rq1 = *(const u32x4*)(gq + (size_t)32 * NPC), rf0 = *(const u32x4*)gf, rf1 = *(const u32x4*)(gf + (size_t)32 * NPC), rv = *(const u32x4*)gv;
    for (int c = 0; c < T / 64; ++c) {
        __syncthreads();
        *(LAS u32x4*)(L + HG_Q1 + srow * 272 + sch * 16) = rq0; *(LAS u32x4*)(L + HG_Q1 + (srow + 32) * 272 + sch * 16) = rq1;
        *(LAS u32x4*)(L + HG_K1 + srow * 272 + sch * 16) = rf0; *(LAS u32x4*)(L + HG_K1 + (srow + 32) * 272 + sch * 16) = rf1;
        { const unsigned vw[4] = {rv.x, rv.y, rv.z, rv.w};
#pragma unroll
          for (int q = 0; q < 4; ++q) { *(LAS unsigned short*)(L + HG_VT + (8 * vch + 2 * q) * 144 + vrow * 2) = (unsigned short)(vw[q] & 0xffffu); *(LAS unsigned short*)(L + HG_VT + (8 * vch + 2 * q + 1) * 144 + vrow * 2) = (unsigned short)(vw[q] >> 16); } }
        __syncthreads();
        if (c + 1 < T / 64) { const size_t adv = (size_t)(64 * (c + 1)) * NPC;
            rq0 = *(const u32x4*)(gq + adv); rq1 = *(const u32x4*)(gq + adv + (size_t)32 * NPC); rf0 = *(const u32x4*)(gf + adv); rf1 = *(const u32x4*)(gf + adv + (size_t)32 * NPC); rv = *(const u32x4*)(gv + adv); }
        float qv[16], kv[16], bl[16];
        { const float lb = lbs[pd]; float run = 0.f;
#pragma unroll
          for (int tt = 0; tt < 16; ++tt) { const int t = 16 * psc + tt;
              qv[tt] = bf2f(*(const LAS unsigned short*)(L + HG_Q1 + t * 272 + pd * 2)); const float fp = bf2f(*(const LAS unsigned short*)(L + HG_K1 + t * 272 + pd * 2));
              const float ex = fast_exp2(-fabsf(fp) * LOG2E);
              const float sg = (fp >= 0.f ? 1.f : ex) * fast_rcp(1.f + ex);
              const float f = lb + (1.f - lb) * sg; kv[tt] = 1.f - f;
              const float lf = (layer == 0) ? (fminf(fp, 0.f) - LN2 * fast_log2(1.f + ex)) : LN2 * fast_log2(f);
              run += lf; bl[tt] = run; }
          tot[psc * 128 + pd] = run; }
        __syncthreads();
        { const float t0 = tot[pd], t1 = tot[128 + pd], t2 = tot[256 + pd], t3 = tot[384 + pd];
          const float b31 = t0 + t1, b63 = (t0 + t1) + (t2 + t3);
          const float pre = psc == 0 ? 0.f : (psc == 1 ? t0 : (psc == 2 ? b31 : b31 + t2));
          const float rref = psc >= 2 ? b31 : 0.f; const float eb31 = fast_exp2(b31 * LOG2E);
          unsigned k3w[8];
#pragma unroll
          for (int tt = 0; tt < 16; ++tt) { const int t = 16 * psc + tt; const float bb = pre + bl[tt];
              const float e1 = fast_exp2((bb - rref) * LOG2E); const float q1 = qv[tt] * e1;
              const float k1 = kv[tt] * fast_exp2(fminf(rref - bb, 80.f) * LOG2E);
              const float k3 = kv[tt] * fast_exp2((b63 - bb) * LOG2E);
              *(LAS unsigned short*)(L + HG_Q1 + t * 272 + pd * 2) = (unsigned short)(pk2(q1, 0.f) & 0xffffu);
              *(LAS unsigned short*)(L + HG_K1 + t * 272 + pd * 2) = (unsigned short)(pk2(k1, 0.f) & 0xffffu);
              if (psc >= 2) *(LAS unsigned short*)(L + HG_QI + (t - 32) * 272 + pd * 2) = (unsigned short)(pk2(q1 * eb31, 0.f) & 0xffffu);
              else *(LAS unsigned short*)(L + HG_K2 + t * 272 + pd * 2) = (unsigned short)(pk2(kv[tt] * fast_exp2((b31 - bb) * LOG2E), 0.f) & 0xffffu);
              if (tt & 1) k3w[tt >> 1] = (k3w[tt >> 1] & 0xffffu) | (pk2(0.f, k3) & 0xffff0000u); else k3w[tt >> 1] = pk2(k3, 0.f) & 0xffffu; }
          *(LAS u32x4*)(L + HG_K3T + pd * 144 + psc * 32) = (u32x4){k3w[0], k3w[1], k3w[2], k3w[3]}; *(LAS u32x4*)(L + HG_K3T + pd * 144 + psc * 32 + 16) = (u32x4){k3w[4], k3w[5], k3w[6], k3w[7]}; }
        __syncthreads();
        if (wave < 3) {
            const int st = wave == 1 ? 1 : 0, tt2 = wave == 0 ? 0 : 1;
            const LAS unsigned char* Kb = L + (wave == 2 ? HG_K2 : HG_K1 + st * 32 * 272) + r * 272 + 16 * h; const LAS unsigned char* Qb = L + HG_Q1 + (32 * tt2 + r) * 272 + 16 * h;
            f32x16 at;
#pragma unroll
            for (int i = 0; i < 16; ++i) at[i] = 0.f;
#pragma unroll
            for (int s8 = 0; s8 < 8; ++s8) at = MFMA32(*(const LAS bf16x8*)(Kb + 32 * s8), *(const LAS bf16x8*)(Qb + 32 * s8), at);
            if (wave < 2) {
#pragma unroll
                for (int i = 0; i < 16; ++i) at[i] = (crow(i, h) <= r) ? at[i] : 0.f; }
#pragma unroll
            for (int g4 = 0; g4 < 4; ++g4) { u32x2 w; w.x = pk2(at[4 * g4], at[4 * g4 + 1]); w.y = pk2(at[4 * g4 + 2], at[4 * g4 + 3]);
                *(LAS u32x2*)(L + HG_AT + (32 * tt2 + r) * 144 + (32 * st + 8 * g4 + 4 * h) * 2) = w; }
        }
        {   const int et = wave & 1, dt = wave >> 1; const int dd = 32 * dt + r;
            const float eb63 = fast_exp2(((tot[dd] + tot[128 + dd]) + (tot[256 + dd] + tot[384 + dd])) * LOG2E);
#pragma unroll
            for (int i = 0; i < 16; ++i) Sacc[i] *= eb63;
            const LAS unsigned char* Vb = L + HG_VT + (32 * et + r) * 144 + 16 * h; const LAS unsigned char* Kb = L + HG_K3T + dd * 144 + 16 * h;
#pragma unroll
            for (int s4 = 0; s4 < 4; ++s4) Sacc = MFMA32(*(const LAS bf16x8*)(Vb + 32 * s4), *(const LAS bf16x8*)(Kb + 32 * s4), Sacc);
            LAS unsigned char* Sw = L + HG_SB + ((c + 1) & 1) * 17408 + dd * 2;
#pragma unroll
            for (int i = 0; i < 16; i += 2) { const unsigned w = pk2(Sacc[i], Sacc[i + 1]);
                *(LAS unsigned short*)(Sw + (32 * et + crow(i, h)) * 272) = (unsigned short)(w & 0xffffu); *(LAS unsigned short*)(Sw + (32 * et + crow(i + 1, h)) * 272) = (unsigned short)(w >> 16); }
        }
        __syncthreads();
        if (wave < 4) {
            const int et = wave & 1, tt2 = wave >> 1;
            f32x16 oo;
#pragma unroll
            for (int i = 0; i < 16; ++i) oo[i] = 0.f;
            const LAS unsigned char* Sb = L + HG_SB + (c & 1) * 17408 + (32 * et + r) * 272 + 16 * h; const LAS unsigned char* Qb = L + (tt2 ? HG_QI : HG_Q1) + r * 272 + 16 * h;
#pragma unroll
            for (int s8 = 0; s8 < 8; ++s8) oo = MFMA32(*(const LAS bf16x8*)(Sb + 32 * s8), *(const LAS bf16x8*)(Qb + 32 * s8), oo);
            const LAS unsigned char* Vb = L + HG_VT + (32 * et + r) * 144 + 16 * h; const LAS unsigned char* Ab = L + HG_AT + (32 * tt2 + r) * 144 + 16 * h;
            oo = MFMA32(*(const LAS bf16x8*)(Vb), *(const LAS bf16x8*)(Ab), oo); oo = MFMA32(*(const LAS bf16x8*)(Vb + 32), *(const LAS bf16x8*)(Ab + 32), oo);
            if (tt2) { oo = MFMA32(*(const LAS bf16x8*)(Vb + 64), *(const LAS bf16x8*)(Ab + 64), oo); oo = MFMA32(*(const LAS bf16x8*)(Vb + 96), *(const LAS bf16x8*)(Ab + 96), oo); }
            float* op = OR + (size_t)(b * T + 64 * c + 32 * tt2 + r) * BW + hh * HD + half * 64 + 32 * et + 4 * h;
#pragma unroll
            for (int g4 = 0; g4 < 4; ++g4) *(f32x4*)(op + 8 * g4) = (f32x4){oo[4 * g4], oo[4 * g4 + 1], oo[4 * g4 + 2], oo[4 * g4 + 3]};
        }
    }
}

constexpr int AT_K = 0, AT_V = 16384, AT_TAB = 33792, AT_IMP = 35840, AT_SELM = 69632, AT_MISC = 69888;
constexpr int VT_STRIDE = 136;
__device__ __forceinline__ unsigned koff(int row, int ch) { return 256u * (unsigned)row + 16u * (unsigned)(ch ^ (((row & 3) << 2) | ((row >> 2) & 3))); }
struct Stg { u32x4 k0, k1, v0, v1; };
__device__ __forceinline__ void stg_load(Stg& s, const bf16_t* Kp, const bf16_t* Vp, int ld, int tid, bool doK, bool doV) {
    const int row = tid >> 4, ch = tid & 15;
    if (doK) { s.k0 = *(const u32x4*)(Kp + (size_t)row * ld + ch * 8); s.k1 = *(const u32x4*)(Kp + (size_t)(row + 32) * ld + ch * 8); }
    if (doV) { s.v0 = *(const u32x4*)(Vp + (size_t)row * ld + ch * 8); s.v1 = *(const u32x4*)(Vp + (size_t)(row + 32) * ld + ch * 8); }
}
__device__ __forceinline__ void stg_write(const Stg& s, LAS unsigned char* L, int tid, bool doK, bool doV) {
    const int row = tid >> 4, ch = tid & 15;
    if (doK) { *(LAS u32x4*)(L + AT_K + koff(row, ch)) = s.k0; *(LAS u32x4*)(L + AT_K + koff(row + 32, ch)) = s.k1; }
    if (doV) { const unsigned a0[4] = {s.v0.x, s.v0.y, s.v0.z, s.v0.w}, a1[4] = {s.v1.x, s.v1.y, s.v1.z, s.v1.w};
#pragma unroll
        for (int q = 0; q < 4; ++q) {
            LAS unsigned short* p0 = (LAS unsigned short*)(L + AT_V + (8 * ch + 2 * q) * VT_STRIDE + row * 2); LAS unsigned short* p1 = (LAS unsigned short*)(L + AT_V + (8 * ch + 2 * q + 1) * VT_STRIDE + row * 2);
            p0[0] = (unsigned short)(a0[q] & 0xffffu); p1[0] = (unsigned short)(a0[q] >> 16); p0[32] = (unsigned short)(a1[q] & 0xffffu); p1[32] = (unsigned short)(a1[q] >> 16); } }
}
__device__ __forceinline__ void qk_tile(f32x16& p0, f32x16& p1, const LAS unsigned char* L, const bf16x8 (&qf)[8], int r, int h) {
#pragma unroll
    for (int i = 0; i < 16; ++i) { p0[i] = 0.f; p1[i] = 0.f; }
#pragma unroll
    for (int s = 0; s < 8; ++s) {
        const bf16x8 a0 = *(const LAS bf16x8*)(L + AT_K + koff(r, 2 * s + h)), a1 = *(const LAS bf16x8*)(L + AT_K + koff(r + 32, 2 * s + h));
        p0 = MFMA32(a0, qf[s], p0); p1 = MFMA32(a1, qf[s], p1); }
}
__device__ __forceinline__ bf16x8 pack8(const f32x16& p, int s) {
    u32x4 w; w.x = pk2(p[8 * s], p[8 * s + 1]); w.y = pk2(p[8 * s + 2], p[8 * s + 3]); w.z = pk2(p[8 * s + 4], p[8 * s + 5]); w.w = pk2(p[8 * s + 6], p[8 * s + 7]);
    return __builtin_bit_cast(bf16x8, w);
}
__device__ __forceinline__ void pv_tile(f32x16 (&o)[4], const f32x16& p0, const f32x16& p1, const LAS unsigned char* L, int r, int h) {
    bf16x8 pb[4]; pb[0] = pack8(p0, 0); pb[1] = pack8(p0, 1); pb[2] = pack8(p1, 0); pb[3] = pack8(p1, 1);
#pragma unroll
    for (int c = 0; c < 4; ++c)
#pragma unroll
        for (int s = 0; s < 4; ++s) {
            const LAS unsigned char* base = L + AT_V + (32 * c + r) * VT_STRIDE + (16 * s + 4 * h) * 2;
            const s16x4 lo = *(const LAS s16x4*)base, hi = *(const LAS s16x4*)(base + 16);
            const bf16x8 av = __builtin_shufflevector(lo, hi, 0, 1, 2, 3, 4, 5, 6, 7);
            o[c] = MFMA32(av, pb[s], o[c]); }
}
__device__ __forceinline__ void softmax_step(f32x16& p0, f32x16& p1, float& m, float& l, f32x16 (&o)[4]) {
    float mx = p0[0];
#pragma unroll
    for (int i = 1; i < 16; ++i) mx = fmaxf(mx, p0[i]);
#pragma unroll
    for (int i = 0; i < 16; ++i) mx = fmaxf(mx, p1[i]);
    mx = fmaxf(mx, __shfl_xor(mx, 32));
    const float mn = fmaxf(m, mx); const float alpha = fast_exp2((m - mn) * LOG2E); m = mn;
    const float mb = mn * LOG2E; float ps = 0.f;
#pragma unroll
    for (int i = 0; i < 16; ++i) { p0[i] = fast_exp2(p0[i] * LOG2E - mb); ps += p0[i]; }
#pragma unroll
    for (int i = 0; i < 16; ++i) { p1[i] = fast_exp2(p1[i] * LOG2E - mb); ps += p1[i]; }
    ps += __shfl_xor(ps, 32);
    l = l * alpha + ps;
#pragma unroll
    for (int c = 0; c < 4; ++c)
#pragma unroll
        for (int i = 0; i < 16; ++i) o[c][i] *= alpha;
}
__device__ __forceinline__ void store_ot(const f32x16 (&o)[4], float sc, bf16_t* dst  , int h, bool add) {
#pragma unroll
    for (int c = 0; c < 4; ++c)
#pragma unroll
        for (int g4 = 0; g4 < 4; ++g4) { u32x2* p = (u32x2*)(dst + 32 * c + 8 * g4 + 4 * h);
            float v0 = sc * o[c][4 * g4], v1 = sc * o[c][4 * g4 + 1], v2 = sc * o[c][4 * g4 + 2], v3 = sc * o[c][4 * g4 + 3];
            if (add) { const u32x2 w0 = *p; v0 += bflo(w0.x); v1 += bfhi(w0.x); v2 += bflo(w0.y); v3 += bfhi(w0.y); }
            u32x2 w; w.x = pk2(v0, v1); w.y = pk2(v2, v3); *p = w; }
}

__device__ __forceinline__ void item_sb(Frame& F, const Args& a, int item) {
    LAS unsigned char* L = F.lds;
    const int qb = 7 - (item >> 7), rem = item & 127, b = rem >> 3, hh = rem & 7, t0 = qb * 256;
    const int tid = F.tid, lane = F.lane, wave = F.wave, r = lane & 31, h = lane >> 5;
    const int tq = t0 + 32 * wave + r;
    const bf16_t* P = (const bf16_t*)(F.ws + WS_P); const size_t rowq = (size_t)(b * T + tq);
    const bf16_t* Kb = P + (size_t)(b * T) * NPC + PKSB + hh * HD; const bf16_t* Vb = P + (size_t)(b * T) * NPC + PVSB + hh * HD;
    bf16x8 qf[8];
#pragma unroll
    for (int s = 0; s < 8; ++s) qf[s] = *(const bf16x8*)(P + rowq * NPC + PQS + hh * HD + 16 * s + 8 * h);
    f32x16 o[4];
#pragma unroll
    for (int c = 0; c < 4; ++c)
#pragma unroll
        for (int i = 0; i < 16; ++i) o[c][i] = 0.f;
    float C = 0.f; bool wdone = false;
    volatile LAS unsigned* flags = (volatile LAS unsigned*)(L + AT_MISC);
    Stg st; int j = 4 * qb + 3;
    stg_load(st, Kb + (size_t)(64 * j) * NPC, Vb + (size_t)(64 * j) * NPC, NPC, tid, true, true);
    for (;;) {
        __syncthreads();
        stg_write(st, L, tid, true, true);
        if (lane == 0) flags[wave] = wdone ? 1u : 0u;
        __syncthreads();
        unsigned nd = 0;
#pragma unroll
        for (int w = 0; w < 8; ++w) nd += flags[w];
        if (__builtin_amdgcn_readfirstlane(nd) == 8u) break;
        if (j > 0) stg_load(st, Kb + (size_t)(64 * (j - 1)) * NPC, Vb + (size_t)(64 * (j - 1)) * NPC, NPC, tid, true, true);
        const bool active = !wdone && (64 * j <= t0 + 32 * wave + 30);
        if (active) {
            f32x16 p0, p1; qk_tile(p0, p1, L, qf, r, h);
            float lm0[16], lm1[16];
            const int kb = 64 * j + 4 * h;
#pragma unroll
            for (int i = 0; i < 16; ++i) {
                const int key0 = kb + (i & 3) + 8 * (i >> 2);
                { const float z = p0[i] * QSCALE; const float sp = fmaxf(z, 0.f) + LN2 * fast_log2(1.f + fast_exp2(-fabsf(z) * LOG2E)); const bool cz = key0 < tq; lm0[i] = cz ? -sp : 0.f; p0[i] = z - sp; }
                { const float z = p1[i] * QSCALE; const float sp = fmaxf(z, 0.f) + LN2 * fast_log2(1.f + fast_exp2(-fabsf(z) * LOG2E)); const bool cz = key0 + 32 < tq; lm1[i] = cz ? -sp : 0.f; p1[i] = z - sp; }
            }
            float Tm[2][4], Tr[2][4];
#pragma unroll
            for (int g4 = 0; g4 < 4; ++g4) { Tm[0][g4] = (lm0[4 * g4] + lm0[4 * g4 + 1]) + (lm0[4 * g4 + 2] + lm0[4 * g4 + 3]); Tm[1][g4] = (lm1[4 * g4] + lm1[4 * g4 + 1]) + (lm1[4 * g4 + 2] + lm1[4 * g4 + 3]); }
#pragma unroll
            for (int k = 0; k < 2; ++k)
#pragma unroll
                for (int g4 = 0; g4 < 4; ++g4) Tr[k][g4] = __shfl_xor(Tm[k][g4], 32);
            float aft[2][4]; float run = C;
#pragma unroll
            for (int G = 15; G >= 0; --G) { const int k = G >> 3, g4 = (G >> 1) & 3, par = G & 1;
                const float tg = (par == 1) ? (h ? Tm[k][g4] : Tr[k][g4]) : (h ? Tr[k][g4] : Tm[k][g4]);
                if (par == 1) { if (h) aft[k][g4] = run; } else { if (!h) aft[k][g4] = run; }
                run += tg; }
            C = run;
#pragma unroll
            for (int g4 = 0; g4 < 4; ++g4) {
                { float ca = aft[0][g4];
#pragma unroll
                  for (int e = 3; e >= 0; --e) { const int i = 4 * g4 + e; const float la = p0[i] + ca; ca += lm0[i]; p0[i] = (kb + e + 8 * g4 < tq) ? fast_exp2(la * LOG2E) : 0.f; } }
                { float ca = aft[1][g4];
#pragma unroll
                  for (int e = 3; e >= 0; --e) { const int i = 4 * g4 + e; const float la = p1[i] + ca; ca += lm1[i]; p1[i] = (kb + 32 + e + 8 * g4 < tq) ? fast_exp2(la * LOG2E) : 0.f; } }
            }
            pv_tile(o, p0, p1, L, r, h);
            wdone = __all(C < -104.f);
        }
        if (j == 0) break;
        --j;
    }
    bf16_t* OS = (bf16_t*)(F.ws + WS_OBR) + (size_t)1 * M * BW;
    store_ot(o, 1.f, OS + rowq * BW + hh * HD, h, false);
}

__device__ __forceinline__ void item_nsa(Frame& F, const Args& a, int item) {
    LAS unsigned char* L = F.lds;
    const int qblk = 31 - (item >> 5), rem = item & 31, b = rem >> 1, g = rem & 1, t0 = qblk * 64;
    const int tid = F.tid, lane = F.lane, wave = F.wave, r = lane & 31, h = lane >> 5, hr = wave >> 1, th = wave & 1;
    const int tl = 32 * th + r, tq = t0 + tl, hq = g * 4 + hr;
    const bf16_t* P = (const bf16_t*)(F.ws + WS_P); const size_t rowq = (size_t)(b * T + tq);
    LAS float* tab = (LAS float*)(L + AT_TAB); LAS float* imp = (LAS float*)(L + AT_IMP); volatile LAS unsigned* selm = (volatile LAS unsigned*)(L + AT_SELM); volatile LAS unsigned* misc = (volatile LAS unsigned*)(L + AT_MISC);
    { const int hh = tid >> 7, dd = tid & 127; tab[tid] = a.in[I_RELB][t5_bucket(dd) * 8 + g * 4 + hh]; }
    bf16x8 qf[8];
#pragma unroll
    for (int s = 0; s < 8; ++s) qf[s] = *(const bf16x8*)(P + rowq * NPC + PQN + hq * HD + 16 * s + 8 * h);
    const bf16_t* gp = P + rowq * NPC + PGN + hq * 3;
    const float g0 = sigmoidf_(bf2f(gp[0])), g1 = sigmoidf_(bf2f(gp[1])), g2 = sigmoidf_(bf2f(gp[2]));
    f32x16 o[4];
    Stg st;
    bf16_t* ONr = (bf16_t*)(F.ws + WS_OBR) + rowq * BW + hq * HD;
    {
        const bf16_t* kc = (const bf16_t*)(F.ws + WS_MISC + MISC_KCMP) + (size_t)((b * 2 + g) * 128) * HD; const bf16_t* vc = (const bf16_t*)(F.ws + WS_MISC + MISC_VCMP) + (size_t)((b * 2 + g) * 128) * HD;
        const bool two = qblk >= 16;
        f32x16 pc[4];
        __syncthreads();
        stg_load(st, kc, vc, HD, tid, true, false); stg_write(st, L, tid, true, false); __syncthreads();
        qk_tile(pc[0], pc[1], L, qf, r, h);
        if (two) { __syncthreads(); stg_load(st, kc + 64 * HD, vc, HD, tid, true, false); stg_write(st, L, tid, true, false); __syncthreads(); qk_tile(pc[2], pc[3], L, qf, r, h); }
        float mx = -1e30f;
#pragma unroll
        for (int k = 0; k < 4; ++k) { if (k >= 2 && !two) break;
#pragma unroll
            for (int i = 0; i < 16; ++i) { const int n = 32 * k + crow(i, h); const int dc = tq - (16 * n + 31); const int di = dc < 113 ? dc : 113;
                const float sv = dc >= 0 ? pc[k][i] + tab[hr * 128 + (di < 0 ? 0 : di)] : -__builtin_inff(); pc[k][i] = sv; mx = fmaxf(mx, sv); } }
        mx = fmaxf(mx, __shfl_xor(mx, 32));
        float sum = 0.f;
#pragma unroll
        for (int k = 0; k < 4; ++k) { if (k >= 2 && !two) break;
#pragma unroll
            for (int i = 0; i < 16; ++i) { const float e = fast_exp2((pc[k][i] - mx) * LOG2E); pc[k][i] = e; sum += e; } }
        sum += __shfl_xor(sum, 32);
        const float inv = 1.f / fmaxf(sum, 1e-30f);
#pragma unroll
        for (int k = 0; k < 4; ++k)
#pragma unroll
            for (int i = 0; i < 16; ++i) pc[k][i] = (k >= 2 && !two) ? 0.f : pc[k][i] * inv;
        float gs[16], gl[16], rc[16];
#pragma unroll
        for (int k = 0; k < 4; ++k)
#pragma unroll
            for (int g4 = 0; g4 < 4; ++g4) { gs[4 * k + g4] = (pc[k][4 * g4] + pc[k][4 * g4 + 1]) + (pc[k][4 * g4 + 2] + pc[k][4 * g4 + 3]); gl[4 * k + g4] = pc[k][4 * g4 + 3]; }
#pragma unroll
        for (int f = 0; f < 16; ++f) rc[f] = __shfl_xor(gl[f], 32);
#pragma unroll
        for (int f = 0; f < 16; ++f) { const float prev = h ? rc[f] : (f >= 1 ? rc[f - 1] : 0.f); const int G = 8 * (f >> 2) + 2 * (f & 3) + h;
            imp[(hr * 64 + tl) * 33 + G] = gs[f] + prev; }
#pragma unroll
        for (int c = 0; c < 4; ++c)
#pragma unroll
            for (int i = 0; i < 16; ++i) o[c][i] = 0.f;
        __syncthreads();
        stg_load(st, kc, vc, HD, tid, false, true); stg_write(st, L, tid, false, true); __syncthreads();
        pv_tile(o, pc[0], pc[1], L, r, h);
        if (two) { __syncthreads(); stg_load(st, kc, vc + 64 * HD, HD, tid, false, true); stg_write(st, L, tid, false, true); __syncthreads(); pv_tile(o, pc[2], pc[3], L, r, h); }
        store_ot(o, g0, ONr, h, false);
    }
    __syncthreads();
    if (wave == 0) {
        const int tk = lane; unsigned msk;
        if (qblk < 16) msk = (2u << qblk) - 1u;
        else {
            for (int jj = 1; jj <= qblk - 2; ++jj) imp[tk * 33 + jj] = (imp[tk * 33 + jj] + imp[(64 + tk) * 33 + jj]) + (imp[(128 + tk) * 33 + jj] + imp[(192 + tk) * 33 + jj]);
            msk = 1u | (1u << (qblk - 1)) | (1u << qblk);
            for (int pick = 0; pick < 13; ++pick) { int best = 1; float bv = -1.f;
                for (int jj = 1; jj <= qblk - 2; ++jj) { const float v = imp[tk * 33 + jj]; if (v > bv) { bv = v; best = jj; } }
                msk |= 1u << best; imp[tk * 33 + best] = -2.f; }
        }
        selm[tk] = msk;
        unsigned om = msk;
#pragma unroll
        for (int off = 1; off < 64; off <<= 1) om |= (unsigned)__shfl_xor((int)om, off);
        if (lane == 0) misc[0] = om;
    }
    __syncthreads();
    const bf16_t* Kbase = P + (size_t)(b * T) * NPC + g * HD;
    {
        unsigned om = __builtin_amdgcn_readfirstlane(misc[0]); const unsigned mym = selm[tl];
        float m = -1e30f, l = 0.f;
#pragma unroll
        for (int c = 0; c < 4; ++c)
#pragma unroll
            for (int i = 0; i < 16; ++i) o[c][i] = 0.f;
        int j = __builtin_ctz(om); om &= om - 1u;
        stg_load(st, Kbase + PKS + (size_t)(64 * j) * NPC, Kbase + PVS + (size_t)(64 * j) * NPC, NPC, tid, true, true);
        for (;;) {
            __syncthreads(); stg_write(st, L, tid, true, true); __syncthreads();
            const int jn = om ? __builtin_ctz(om) : -1;
            if (jn >= 0) stg_load(st, Kbase + PKS + (size_t)(64 * jn) * NPC, Kbase + PVS + (size_t)(64 * jn) * NPC, NPC, tid, true, true);
            f32x16 p0, p1; qk_tile(p0, p1, L, qf, r, h);
            const bool sel = (mym >> j) & 1u; const bool far = j <= qblk - 3; const float bfar = tab[hr * 128 + 113];
#pragma unroll
            for (int i = 0; i < 16; ++i) { const int d0 = tq - (64 * j + crow(i, h)), d1 = d0 - 32;
                const float b0 = far ? bfar : tab[hr * 128 + (d0 < 0 ? 0 : (d0 > 113 ? 113 : d0))], b1 = far ? bfar : tab[hr * 128 + (d1 < 0 ? 0 : (d1 > 113 ? 113 : d1))];
                p0[i] = (sel && d0 >= 0) ? p0[i] + b0 : -__builtin_inff(); p1[i] = (sel && d1 >= 0) ? p1[i] + b1 : -__builtin_inff(); }
            softmax_step(p0, p1, m, l, o);
            pv_tile(o, p0, p1, L, r, h);
            if (jn < 0) break;
            j = jn; om &= om - 1u;
        }
        store_ot(o, g1 / l, ONr, h, true);
    }
    {
        float m = -1e30f, l = 0.f;
#pragma unroll
        for (int c = 0; c < 4; ++c)
#pragma unroll
            for (int i = 0; i < 16; ++i) o[c][i] = 0.f;
        int j = qblk >= 8 ? qblk - 8 : 0;
        stg_load(st, Kbase + PKW + (size_t)(64 * j) * NPC, Kbase + PVW + (size_t)(64 * j) * NPC, NPC, tid, true, true);
        for (;;) {
            __syncthreads(); stg_write(st, L, tid, true, true); __syncthreads();
            if (j < qblk) stg_load(st, Kbase + PKW + (size_t)(64 * (j + 1)) * NPC, Kbase + PVW + (size_t)(64 * (j + 1)) * NPC, NPC, tid, true, true);
            f32x16 p0, p1; qk_tile(p0, p1, L, qf, r, h);
            const bool far = j <= qblk - 3; const float bfar = tab[hr * 128 + 113];
#pragma unroll
            for (int i = 0; i < 16; ++i) { const int d0 = tq - (64 * j + crow(i, h)), d1 = d0 - 32;
                const float b0 = far ? bfar : tab[hr * 128 + (d0 < 0 ? 0 : (d0 > 113 ? 113 : d0))], b1 = far ? bfar : tab[hr * 128 + (d1 < 0 ? 0 : (d1 > 113 ? 113 : d1))];
                p0[i] = ((unsigned)d0 < 512u) ? p0[i] + b0 : -__builtin_inff(); p1[i] = ((unsigned)d1 < 512u) ? p1[i] + b1 : -__builtin_inff(); }
            softmax_step(p0, p1, m, l, o);
            pv_tile(o, p0, p1, L, r, h);
            if (j == qblk) break;
            ++j;
        }
        store_ot(o, g2 / l, ONr, h, true);
    }
}

constexpr int NI_H = 256, NI_S = 1024, NI_C = 256, NI_N = 512, NI_A = 1024, NI_F = 512;
#define FRESH_F() do { int t_ = threadIdx.x; asm volatile("" : "+v"(t_)); F.tid = t_; F.lane = t_ & 63; F.wave = __builtin_amdgcn_readfirstlane(t_ >> 6); } while (0)
__device__ __forceinline__ void phase_Ca(Frame& F, const Args& a, int layer, int bank, int types) {
    unsigned* head = F.ctl + CW_QUEUE + 64 * (layer * 8) + bank * 4096;
    if (types & 1) for (;;) { const int it = q_next(F, head + 0); if (it >= NI_H) break; FRESH_F(); item_hgrn(F, a, layer, it); }
    if (types & 2) for (;;) { const int it = q_next(F, head + 64); if (it >= NI_S) break; FRESH_F(); item_sb(F, a, it); }
    if (types & 4) for (;;) { const int it = q_next(F, head + 128); if (it >= NI_C) break; FRESH_F(); item_compress(F, a, layer, it); }
    if (types & 8) for (;;) { const int it = q_next(F, head + 192); if (it >= NI_N) break; FRESH_F(); item_norm(F, a, layer, it); }
}
__device__ __forceinline__ void phase_Cb(Frame& F, const Args& a, int layer, int bank) {
    unsigned* head = F.ctl + CW_QUEUE + 64 * (layer * 8 + 4) + bank * 4096;
    for (;;) { const int it = q_next(F, head + 0); if (it >= NI_A) break; FRESH_F(); item_nsa(F, a, it); }
    for (;;) { const int it = q_next(F, head + 64); if (it >= NI_F) break; FRESH_F(); item_hgfin(F, a, layer, it); }
}

__global__ void __launch_bounds__(512, 2) mega(Args a) {
    extern __shared__ __attribute__((aligned(16))) unsigned char lds_raw[];
    Frame F;
    F.lds = (LAS unsigned char*)lds_raw; F.MISC = (volatile LAS unsigned*)(F.lds + MISC_OFF);
    F.tid = threadIdx.x; F.lane = F.tid & 63; F.wave = __builtin_amdgcn_readfirstlane(F.tid >> 6); F.G = gridDim.x; F.bid = blockIdx.x;
    F.ws = a.ws; F.ctl = (unsigned*)(a.ws + WS_CTL);
    if (F.tid < 64) F.MISC[F.tid] = 0u;
    __syncthreads();
    const int lo = a.ph_lo, hi = a.ph_hi;
    XcdBarrier bar; bar.bar = F.ctl + CW_BAR; bar.x = 0; bar.st = F.MISC + 8;
    if (hi - lo > 1) bar = xcd_barrier_post(F.ctl + CW_BAR, F.MISC + 8);
#define IN(k) (lo <= (k) && (k) < hi)
#define ON(k) (((MK_PHASE_MASK & MK_BUILD_MASK) >> (k)) & 1)
#define SEAM(k) do { if (IN(k) && IN((k) + 1)) xcd_barrier(bar); } while (0)
    bf16_t* Hb = (bf16_t*)(F.ws + WS_H); bf16_t* Pb = (bf16_t*)(F.ws + WS_P);
    for (int layer = 0; layer < DEPTH; ++layer) {
        const int pb = layer * 10;
#define FRESH() do { int t_ = threadIdx.x; asm volatile("" : "+v"(t_)); F.tid = t_; F.lane = t_ & 63; F.wave = __builtin_amdgcn_readfirstlane(t_ >> 6); } while (0)
        if (ON(0) && IN(pb + 0)) { FRESH(); if (MK_PROBE == 0) { phase_A(F, a, layer); xcd_barrier(bar); } phase_A(F, a, layer); } SEAM(pb + 0);
        if (ON(1) && IN(pb + 1)) { FRESH();
            pg8::Gemm g{Hb, (const bf16_t*)(F.ws + WS_WIN), M, NPC, DM}; pg8::StaticOrder S; S.init(M, NPC, F.G, F.bid);
            pg8::EpiStoreBf16 E{Pb, NPC};
            pg8::gemm_phase<pg8::EpiStoreBf16, pg8::StaticOrder, PG8_ALIGN, PG8_SP2>(F.lds, g, S, E, F.tid);
        } SEAM(pb + 1);
        if (ON(2) && IN(pb + 2)) { FRESH(); if (MK_PROBE >= 20 && MK_PROBE < 28) { phase_Ca(F, a, layer, 1, MK_PROBE - 20); xcd_barrier(bar); } phase_Ca(F, a, layer, 0, 15); } SEAM(pb + 2);
        if (ON(3) && IN(pb + 3)) { FRESH(); if (MK_PROBE == 3) { phase_Cb(F, a, layer, 1); xcd_barrier(bar); } phase_Cb(F, a, layer, 0); } SEAM(pb + 3);
        if (ON(4) && IN(pb + 4)) { FRESH();
            pg8::Gemm g{(const bf16_t*)(F.ws + WS_OBR), (const bf16_t*)(F.ws + WS_WBR), M, DM, BW}; pg8::BranchOrder S; S.init(M, DM, F.G, F.bid);
            pg8::EpiBranch E{Pb, (float*)(F.ws + WS_SCR) + (size_t)F.bid * 65536, Hb, F.tid};
            pg8::gemm_phase<pg8::EpiBranch, pg8::BranchOrder, PG8_ALIGN, PG8_SP2>(F.lds, g, S, E, F.tid);
        } SEAM(pb + 4);
        if (ON(5) && IN(pb + 5)) { FRESH();
            pg8::Gemm g{Hb, (const bf16_t*)(F.ws + WS_WOUT), M, DM, DM}; pg8::StaticOrder S; S.init(M, DM, F.G, F.bid);
            pg8::EpiResidF32 E{a.out, DM};
            pg8::gemm_phase<pg8::EpiResidF32, pg8::StaticOrder, PG8_ALIGN, PG8_SP2>(F.lds, g, S, E, F.tid);
        } SEAM(pb + 5);
        if (ON(6) && IN(pb + 6)) { FRESH(); phase_F(F, a); } SEAM(pb + 6);
        if (ON(7) && IN(pb + 7)) { FRESH();
            pg8::Gemm g{Hb, (const bf16_t*)(F.ws + WS_WUP), M, NUP, DM}; pg8::StaticOrder S; S.init(M, NUP, F.G, F.bid);
            pg8::EpiStoreBf16 E{Pb, NUP};
            pg8::gemm_phase<pg8::EpiStoreBf16, pg8::StaticOrder, PG8_ALIGN, PG8_SP2>(F.lds, g, S, E, F.tid);
        } SEAM(pb + 7);
        if (ON(8) && IN(pb + 8)) { FRESH(); if (MK_PROBE == 8) { phase_H(F, a, layer); xcd_barrier(bar); } phase_H(F, a, layer); } SEAM(pb + 8);
        if (ON(9) && IN(pb + 9)) { FRESH();
            pg8::Gemm g{(const bf16_t*)(F.ws + WS_ACT), (const bf16_t*)(F.ws + WS_WDN), M, DM, DFF}; pg8::StaticOrder S; S.init(M, DM, F.G, F.bid);
            pg8::EpiResidF32 E{a.out, DM};
            pg8::gemm_phase<pg8::EpiResidF32, pg8::StaticOrder, PG8_ALIGN, PG8_SP2>(F.lds, g, S, E, F.tid);
        } SEAM(pb + 9);
    }
}

extern "C" void kernel_launch(void* const* d_in, const int* in_sizes, int n_in, void* d_out, int out_size, void* d_ws, size_t ws_size, hipStream_t stream) {
    static int grid = 0;
    if (grid == 0) {
        if (n_in != 18 || in_sizes[0] != M * DM || out_size != M * DM || ws_size < WS_END) { fprintf(stderr, "kernel_launch: unexpected shapes / workspace (%d inputs, ws %zu)\n", n_in, ws_size); grid = -1; return; }
        int dev = 0, cus = 0, per_cu = 0;
        if (hipGetDevice(&dev) != hipSuccess || hipDeviceGetAttribute(&cus, hipDeviceAttributeMultiprocessorCount, dev) != hipSuccess) { grid = -1; return; }
        if (hipFuncSetAttribute((const void*)mega, hipFuncAttributeMaxDynamicSharedMemorySize, LDS_BYTES) != hipSuccess) { grid = -1; return; }
        if (hipOccupancyMaxActiveBlocksPerMultiprocessor(&per_cu, (const void*)mega, 512, LDS_BYTES) != hipSuccess || per_cu < 1) { fprintf(stderr, "kernel_launch: occupancy query says %d\n", per_cu); }
        (void)hipGetLastError();
        grid = cus;
    }
    if (grid < 0) return;
    (void)hipMemsetAsync((char*)d_ws + WS_CTL, 0, CTL_BYTES, stream);
    Args a{};
    for (int i = 0; i < 18; ++i) a.in[i] = (const float*)d_in[i];
    a.out = (float*)d_out; a.ws = (unsigned char*)d_ws;
#if MK_ONE_LAUNCH
    a.ph_lo = 0; a.ph_hi = DEPTH * 10;
    hipLaunchKernelGGL(mega, dim3(grid), dim3(512), LDS_BYTES, stream, a);
#else
    for (int p = 0; p < DEPTH * 10; ++p) { a.ph_lo = p; a.ph_hi = p + 1; hipLaunchKernelGGL(mega, dim3(grid), dim3(512), LDS_BYTES, stream, a); }
#endif
}
```

```cpp
#include <hip/hip_runtime.h>
#include <stdint.h>
#include <stdio.h>

#ifndef MK_ONE_LAUNCH
#define MK_ONE_LAUNCH 1
#endif
#ifndef MK_PHASE_MASK
#define MK_PHASE_MASK 0x3ff
#endif
#ifndef MK_PROBE
#define MK_PROBE -1
#endif
#ifndef MK_STAGGER
#define MK_STAGGER 0
#endif
#ifndef MK_DIAG
#define MK_DIAG 0
#endif
#ifndef MK_BUILD_MASK
#define MK_BUILD_MASK 0x3ff
#endif

#define LAS __attribute__((address_space(3)))
typedef unsigned short bf16_t;
typedef short bf16x8 __attribute__((ext_vector_type(8)));
typedef short s16x4 __attribute__((ext_vector_type(4)));
typedef float f32x4 __attribute__((ext_vector_type(4)));
typedef float f32x16 __attribute__((ext_vector_type(16)));
typedef float f32x2 __attribute__((ext_vector_type(2)));
typedef unsigned u32x4 __attribute__((ext_vector_type(4)));
typedef unsigned u32x2 __attribute__((ext_vector_type(2)));
typedef __bf16 bfv2 __attribute__((ext_vector_type(2)));

constexpr int DM = 2048, NB = 16, T = 2048, DEPTH = 4, M = NB * T, HD = 128;
constexpr int INC = 15896;
constexpr int NPC = 16128;
constexpr int PQN = 0, PKC = 1024, PVC = 1280, PKS = 1536, PVS = 1792, PKW = 2048, PVW = 2304, PQS = 2560, PKSB = 3584, PVSB = 4608,
              PQH = 5632, PFH = 6656, PIH = 7680, PGH = 8704, PGT = 9728, PGN = 15872;
constexpr int DFF = 5632, NUP = 2 * DFF;
constexpr int BW = 1024;
constexpr float EPS = 1e-6f;
constexpr float LOG2E = 1.4426950408889634f, LN2 = 0.6931471805599453f;
constexpr float QSCALE = 0.08838834764831845f;

constexpr size_t MiB = 1u << 20;
constexpr size_t WS_CTL = 0, CTL_BYTES = 1 * MiB;
constexpr size_t WS_WIN = 1 * MiB, WS_WBR = 64 * MiB, WS_WOUT = 76 * MiB, WS_WUP = 84 * MiB, WS_WDN = 128 * MiB;
constexpr size_t WS_MISC = 150 * MiB;
constexpr size_t MISC_KCMP = 0, MISC_VCMP = 1 * MiB, MISC_WC1 = 2 * MiB;
constexpr int CW_CVEC = 32768;
constexpr size_t WS_SCR = 154 * MiB;
constexpr size_t WS_P = 218 * MiB;
constexpr size_t WS_H = 1226 * MiB;
constexpr size_t WS_OBR = 1354 * MiB;
constexpr size_t WS_ORAW = 1546 * MiB;
constexpr size_t WS_XB = 1674 * MiB;
constexpr size_t WS_SSQ = 1802 * MiB;
constexpr size_t WS_RSTD = 1806 * MiB;
constexpr size_t WS_USIDE = 1807 * MiB;
constexpr size_t WS_END = 1853 * MiB;
constexpr size_t WS_ACT = WS_P + 704 * MiB;
constexpr int CW_BAR = 4096;
constexpr int CW_QUEUE = 16384;

constexpr int RING_BYTES = 131072;
constexpr int MISC_OFF = RING_BYTES;
constexpr int LDS_BYTES = 147456;

__device__ __forceinline__ float bf2f(unsigned short b) { return __uint_as_float(((unsigned)b) << 16); }
__device__ __forceinline__ float bflo(unsigned w) { return __uint_as_float(w << 16); }
__device__ __forceinline__ float bfhi(unsigned w) { return __uint_as_float(w & 0xffff0000u); }
__device__ __forceinline__ unsigned pk2(float lo, float hi) { f32x2 v = {lo, hi}; bfv2 b = __builtin_convertvector(v, bfv2); return __builtin_bit_cast(unsigned, b); }
__device__ __forceinline__ float wave_sum(float v) {
#pragma unroll
    for (int o = 1; o < 64; o <<= 1) v += __shfl_xor(v, o);
    return v;
}
__device__ __forceinline__ float fast_exp2(float x) { return __builtin_amdgcn_exp2f(x); }
__device__ __forceinline__ float fast_log2(float x) { return __builtin_amdgcn_logf(x); }
__device__ __forceinline__ float fast_rcp(float x) { return __builtin_amdgcn_rcpf(x); }
__device__ __forceinline__ float sigmoidf_(float x) { return fast_rcp(1.f + fast_exp2(-x * LOG2E)); }
#define LDS_WAIT() asm volatile("s_waitcnt lgkmcnt(0)" ::: "memory")

#define XB_TMO      128
#define XB_XCNT(j)  (256  + 64 * (j))
#define XB_XSUB(j)  (1280 + 64 * (j))
#define XB_XGEN(j)  (2304 + 64 * (j))
#define XB_TOP      3328
#define XB_TOPGEN   3392
#define XCD_BAR_WORDS 3456
#define XB_SPIN_CAP (1u << 22)
__device__ __forceinline__ unsigned xb_ld(unsigned* p)              { return __hip_atomic_load(p, __ATOMIC_RELAXED, __HIP_MEMORY_SCOPE_AGENT); }
__device__ __forceinline__ unsigned xb_add(unsigned* p, unsigned v) { return __hip_atomic_fetch_add(p, v, __ATOMIC_RELAXED, __HIP_MEMORY_SCOPE_AGENT); }
__device__ __forceinline__ unsigned xb_xcc_id() { return (unsigned)__builtin_amdgcn_s_getreg((3 << 11) | 20) & 0xFu; }
#define XB_SPIN(cond, bar) do { unsigned _sp = 0; while (cond) { __builtin_amdgcn_s_sleep(1); \
    if ((++_sp & 255u) == 0u) { if (xb_ld(&(bar)[XB_TMO])) break; if (_sp > XB_SPIN_CAP) { atomicAdd(&(bar)[XB_TMO], 1u); break; } } } } while (0)
struct XcdBarrier { unsigned* bar; unsigned x; volatile LAS unsigned* st; };
__device__ __forceinline__ XcdBarrier xcd_barrier_post(unsigned* bar, volatile LAS unsigned* st) {
    XcdBarrier b; b.bar = bar; b.x = xb_xcc_id(); b.st = st;
    if (threadIdx.x == 0) (void)xb_add(&bar[XB_XCNT(b.x)], 1u);
    return b;
}
__device__ __forceinline__ void xcd_barrier_complete(unsigned* bar, unsigned x, unsigned& nloc, unsigned& nx) {
    const unsigned G = gridDim.x * gridDim.y * gridDim.z;
    unsigned sum, cnt, mine, sp = 0u;
    for (;;) {
        sum = 0u; cnt = 0u; mine = 0u;
#pragma unroll
        for (unsigned j = 0; j < 16; ++j) { const unsigned c = xb_ld(&bar[XB_XCNT(j)]); sum += c; cnt += (c > 0u) ? 1u : 0u; mine = (j == x) ? c : mine; }
        if (sum == G) break;
        __builtin_amdgcn_s_sleep(1);
        if ((++sp & 255u) == 0u) { if (xb_ld(&bar[XB_TMO])) break; if (sp > XB_SPIN_CAP) { atomicAdd(&bar[XB_TMO], 1u); break; } }
    }
    nloc = mine > 0u ? mine : 1u; nx = cnt > 0u ? cnt : 1u;
}
__device__ __forceinline__ void xcd_barrier(const XcdBarrier& b) {
    asm volatile("s_waitcnt vmcnt(0)" ::: "memory");
    __syncthreads();
    if (threadIdx.x == 0) {
        unsigned* bar = b.bar;
        __builtin_amdgcn_s_waitcnt(0);
        unsigned nloc = b.st[0], nx = b.st[1];
        if (nloc == 0u) { xcd_barrier_complete(bar, b.x, nloc, nx); b.st[0] = nloc; b.st[1] = nx; }
        const unsigned old = xb_add(&bar[XB_XSUB(b.x)], 1u);
        const unsigned gen = old / nloc;
        if (old + 1u == (gen + 1u) * nloc) {
            __builtin_amdgcn_fence(__ATOMIC_RELEASE, "agent");
            asm volatile("s_waitcnt vmcnt(0)" ::: "memory");
            const unsigned og = xb_add(&bar[XB_TOP], 1u);
            const unsigned tg = og / nx;
            if (og + 1u == (tg + 1u) * nx) xb_add(&bar[XB_TOPGEN], 1u);
            else XB_SPIN(xb_ld(&bar[XB_TOPGEN]) == tg, bar);
            __builtin_amdgcn_fence(__ATOMIC_ACQUIRE, "agent");
            xb_add(&bar[XB_XGEN(b.x)], 1u);
            asm volatile("s_waitcnt vmcnt(0)" ::: "memory");
        } else {
            XB_SPIN(xb_ld(&bar[XB_XGEN(b.x)]) == gen, bar);
            __builtin_amdgcn_fence(__ATOMIC_ACQUIRE, "agent");
            asm volatile("s_waitcnt vmcnt(0)" ::: "memory");
        }
    }
    __syncthreads();
}

namespace pg8 {
constexpr int BM = 256, BK = 64, HALF = 128, HTB = HALF * BK * 2, STAGE_BYTES = 8 * HTB, NXCD = 8;
__host__ __device__ __forceinline__ int lds_byte(int r, int c) { const int st = (r >> 4) * 2 + (c >> 5), rr = r & 15, cc = c & 31, ob = rr * 64 + cc * 2; return st * 1024 + (ob ^ (((ob >> 9) & 1) << 5)); }
__host__ __device__ __forceinline__ void stage_rc(int b, int& R, int& C) { const int st = b / 1024, sb = b % 1024, swz = sb ^ (((sb >> 9) & 1) << 5); R = (st >> 1) * 16 + swz / 64; C = (st & 1) * 32 + (swz % 64) / 2; }
__host__ __device__ __forceinline__ int perm32(int rho) { const int n = rho >> 4, i = rho & 15; return 8 * (i >> 2) + 4 * n + (i & 3); }
struct Unit { int pm, pn, aux; };
struct Gemm { const bf16_t* A; const bf16_t* Bt; int M, N, K; };
struct StaticOrder {
    int nM, nN, nwg, G, c, WGM, rev;
    int pad_;
    __device__ void init(int M_, int N_, int G_, int c_, int wgm = 4, int rev_ = 0) { nM = M_ / BM; nN = N_ / BM; nwg = nM * nN; G = G_; c = c_; WGM = wgm; rev = rev_; pad_ = 0; }
    __device__ __forceinline__ bool tile(long L, Unit& u) const {
        if (L >= nwg) return false;
        int wgid = (int)L; { const int q = nwg / NXCD, r = nwg % NXCD, xcd = wgid % NXCD, off = wgid / NXCD; wgid = (xcd < r ? xcd * (q + 1) : r * (q + 1) + (xcd - r) * q) + off; }
        const int nig = WGM * nN, gid = wgid / nig, fm = gid * WGM, gsz = (nM - fm) < WGM ? (nM - fm) : WGM;
        u.pm = fm + ((wgid % nig) % gsz); u.pn = (wgid % nig) / gsz; u.aux = 0; if (rev) u.pm = nM - 1 - u.pm; return true;
    }
    __device__ __forceinline__ bool next(int i, Unit& u) const { return tile((long)i * G + c, u); }
    __device__ __forceinline__ const char* aptr(const Gemm& g, const Unit& u, size_t tstep) const { return (const char*)g.A + (size_t)u.pm * tstep; }
    __device__ __forceinline__ const char* bptr(const Gemm& g, const Unit& u, size_t tstep) const { return (const char*)g.Bt + (size_t)u.pn * tstep; }
    __device__ __forceinline__ void a_ready(const Unit&) const {}
    __device__ __forceinline__ void done(const Unit&) const {}
};
struct EpiStoreBf16 {
    static constexpr bool PERM = true, AFTER_DRAIN = false;
    bf16_t* O; int ldc; int sg_lo, sg_hi; const float* rs;
    __device__ __forceinline__ void operator()(const f32x4 (&acc)[2][2][4][2], const Unit& u, int wr, int wc, int fr, int fq) const {
        const int row0 = u.pm * BM + wr * 64 + fr, col0 = u.pn * BM + wc * 32 + 8 * fq; const bool sg = u.pn >= sg_lo && u.pn < sg_hi;
        float rsv[8];
#pragma unroll
        for (int g = 0; g < 8; ++g) rsv[g] = rs[row0 + (g >> 2) * HALF + (g & 3) * 16];
#pragma unroll
        for (int ai = 0; ai < 2; ++ai)
#pragma unroll
            for (int m = 0; m < 4; ++m) { bf16_t* rowp = O + (size_t)(row0 + ai * HALF + m * 16) * ldc + col0;
#pragma unroll
                for (int bj = 0; bj < 2; ++bj) { f32x4 v0 = acc[ai][bj][m][0] * rsv[ai * 4 + m], v1 = acc[ai][bj][m][1] * rsv[ai * 4 + m];
                    if (sg) {
#pragma unroll
                        for (int e = 0; e < 4; ++e) { v0[e] = sigmoidf_(v0[e]); v1[e] = sigmoidf_(v1[e]); } }
                    u32x4 w; w.x = pk2(v0[0], v0[1]); w.y = pk2(v0[2], v0[3]); w.z = pk2(v1[0], v1[1]); w.w = pk2(v1[2], v1[3]);
                    __builtin_nontemporal_store(w, (u32x4*)(rowp + bj * HALF)); } }
    }
};
struct EpiConvAct {
    static constexpr bool PERM = true, AFTER_DRAIN = false;
    bf16_t* ACT; bf16_t* side; const float* rs; const float* cw; const float* cb;
    __device__ __forceinline__ void operator()(const f32x4 (&acc)[2][2][4][2], const Unit& u, int wr, int wc, int fr, int fq) const {
        const int row0 = u.pm * BM + wr * 64 + fr, ch0 = u.pn * 128 + wc * 32 + 8 * fq;
        float rsv[8];
#pragma unroll
        for (int g = 0; g < 8; ++g) rsv[g] = rs[row0 + (g >> 2) * HALF + (g & 3) * 16];
#pragma unroll
        for (int n = 0; n < 2; ++n) {
            const f32x4 wg0 = *(const f32x4*)(cw + ch0 + 4 * n), wg1 = *(const f32x4*)(cw + NUP + ch0 + 4 * n), wg2 = *(const f32x4*)(cw + 2 * NUP + ch0 + 4 * n), bg = *(const f32x4*)(cb + ch0 + 4 * n);
            const f32x4 wv0 = *(const f32x4*)(cw + DFF + ch0 + 4 * n), wv1 = *(const f32x4*)(cw + NUP + DFF + ch0 + 4 * n), wv2 = *(const f32x4*)(cw + 2 * NUP + DFF + ch0 + 4 * n), bv = *(const f32x4*)(cb + DFF + ch0 + 4 * n);
#pragma unroll
            for (int ai = 0; ai < 2; ++ai) {
                float act[4][4];
#pragma unroll
                for (int e = 0; e < 4; ++e) {
                    float pg1 = 0.f, pg2 = 0.f, pv1 = 0.f, pv2 = 0.f;
#pragma unroll
                    for (int m = 0; m < 4; ++m) {
                        const float xg = acc[ai][0][m][n][e] * rsv[ai * 4 + m], xv = acc[ai][1][m][n][e] * rsv[ai * 4 + m];
                        const float rg1 = __int_as_float(__builtin_amdgcn_update_dpp(0, __float_as_int(xg), 0x121, 0xf, 0xf, false)), rg2 = __int_as_float(__builtin_amdgcn_update_dpp(0, __float_as_int(xg), 0x122, 0xf, 0xf, false));
                        const float rv1 = __int_as_float(__builtin_amdgcn_update_dpp(0, __float_as_int(xv), 0x121, 0xf, 0xf, false)), rv2 = __int_as_float(__builtin_amdgcn_update_dpp(0, __float_as_int(xv), 0x122, 0xf, 0xf, false));
                        const float g1 = fr == 0 ? pg1 : rg1, g2 = fr < 2 ? pg2 : rg2, v1 = fr == 0 ? pv1 : rv1, v2 = fr < 2 ? pv2 : rv2;
                        const float cg = bg[e] + wg0[e] * g2 + wg1[e] * g1 + wg2[e] * xg, cv = bv[e] + wv0[e] * v2 + wv1[e] * v1 + wv2[e] * xv;
                        act[m][e] = cg * sigmoidf_(cg) * cv;
                        pg1 = rg1; pg2 = rg2; pv1 = rv1; pv2 = rv2;
                    }
                }
#pragma unroll
                for (int m = 0; m < 4; ++m) { u32x2 w; w.x = pk2(act[m][0], act[m][1]); w.y = pk2(act[m][2], act[m][3]); *(u32x2*)(ACT + (size_t)(row0 + ai * HALF + m * 16) * DFF + ch0 + 4 * n) = w; }
            }
        }
        const int slot = fr < 2 ? fr : fr - 12;
        if (fr < 2 || fr >= 14) {
            const int m = fr < 2 ? 0 : 3;
#pragma unroll
            for (int ai = 0; ai < 2; ++ai) { const int blk = (u.pm * BM + ai * HALF + wr * 64) >> 6; const float r_ = fr < 2 ? rsv[ai * 4] : rsv[ai * 4 + 3];
                bf16_t* sp = side + ((size_t)blk * 4 + slot) * NUP + u.pn * 256 + wc * 32 + 8 * fq;
#pragma unroll
                for (int bj = 0; bj < 2; ++bj) { const f32x4 a0 = (fr < 2 ? acc[ai][bj][0][0] : acc[ai][bj][3][0]) * r_, a1 = (fr < 2 ? acc[ai][bj][0][1] : acc[ai][bj][3][1]) * r_;
                    *(u32x4*)(sp + bj * HALF) = (u32x4){pk2(a0[0], a0[1]), pk2(a0[2], a0[3]), pk2(a1[0], a1[1]), pk2(a1[2], a1[3])}; } }
            (void)m;
        }
    }
};
struct EpiResidBf16 {
    static constexpr bool PERM = true, AFTER_DRAIN = false;
    bf16_t* XB; float* Cout; float* ssq; int ldc;
    __device__ __forceinline__ void operator()(const f32x4 (&acc)[2][2][4][2], const Unit& u, int wr, int wc, int fr, int fq) const {
        const int row0 = u.pm * BM + wr * 64 + fr, col0 = u.pn * BM + wc * 32 + 8 * fq;
        u32x4 old[2][2]; float ssv[8];
#define ER_ROWI(g) (row0 + ((g) >> 2) * HALF + ((g) & 3) * 16)
#define ER_LOAD(g) do { const bf16_t* rp_ = XB + (size_t)ER_ROWI(g) * ldc + col0; old[(g) & 1][0] = *(const u32x4*)rp_; old[(g) & 1][1] = *(const u32x4*)(rp_ + HALF); } while (0)
        ER_LOAD(0);
#pragma unroll
        for (int g = 0; g < 8; ++g) {
            asm volatile("" ::: "memory");
            if (g < 7) ER_LOAD(g + 1);
            const size_t ro = (size_t)ER_ROWI(g) * ldc + col0; float ss = 0.f;
#pragma unroll
            for (int bj = 0; bj < 2; ++bj) { const u32x4 o_ = old[g & 1][bj];
                f32x4 v0 = acc[g >> 2][bj][g & 3][0], v1 = acc[g >> 2][bj][g & 3][1];
                v0[0] += bflo(o_.x); v0[1] += bfhi(o_.x); v0[2] += bflo(o_.y); v0[3] += bfhi(o_.y); v1[0] += bflo(o_.z); v1[1] += bfhi(o_.z); v1[2] += bflo(o_.w); v1[3] += bfhi(o_.w);
                if (Cout) { *(f32x4*)(Cout + ro + bj * HALF) = v0; *(f32x4*)(Cout + ro + bj * HALF + 4) = v1; }
                else { u32x4 w; w.x = pk2(v0[0], v0[1]); w.y = pk2(v0[2], v0[3]); w.z = pk2(v1[0], v1[1]); w.w = pk2(v1[2], v1[3]); *(u32x4*)(XB + ro + bj * HALF) = w;
                    const float r0 = bflo(w.x), r1 = bfhi(w.x), r2 = bflo(w.y), r3 = bfhi(w.y), r4 = bflo(w.z), r5 = bfhi(w.z), r6 = bflo(w.w), r7 = bfhi(w.w);
                    ss += ((r0 * r0 + r1 * r1) + (r2 * r2 + r3 * r3)) + ((r4 * r4 + r5 * r5) + (r6 * r6 + r7 * r7)); } }
            ssv[g] = ss;
        }
        if (!Cout) {
#pragma unroll
            for (int g = 0; g < 8; ++g) ssv[g] += __shfl_xor(ssv[g], 16);
#pragma unroll
            for (int g = 0; g < 8; ++g) ssv[g] += __shfl_xor(ssv[g], 32);
            if (fq == 0) {
#pragma unroll
                for (int g = 0; g < 8; ++g) ssq[(size_t)ER_ROWI(g) * 32 + u.pn * 4 + wc] = ssv[g]; } }
#undef ER_ROWI
#undef ER_LOAD
    }
};
struct EpiGated {
    static constexpr bool PERM = true, AFTER_DRAIN = false, HOOK = true; static constexpr int HOOK_KT = 16;
    const bf16_t* P; bf16_t* merged;
    static __device__ __forceinline__ float gl(unsigned w) { return fmaxf(bflo(w), 1e-30f); }
    static __device__ __forceinline__ float gh(unsigned w) { return fmaxf(bfhi(w), 1e-30f); }
    __device__ __forceinline__ void mid(f32x4 (&acc)[2][2][4][2], const Unit& u, int wr, int wc, int fr, int fq, int s) const {
        const unsigned row0 = (unsigned)(u.pm * BM + wr * 64 + fr), col0 = (unsigned)(u.pn * BM + wc * 32 + 8 * fq);
        const char* Pa = (const char*)(P + PGT + (s - 1) * DM); const char* Pb = (const char*)(P + PGT + s * DM);
#pragma unroll
        for (int hf = 0; hf < 2; ++hf) {
            u32x4 ga[4][2], gb[4][2];
#pragma unroll
            for (int gg = 0; gg < 4; ++gg) { const int g = hf * 4 + gg; const unsigned po = ((row0 + (unsigned)((g >> 2) * HALF + (g & 3) * 16)) * (unsigned)NPC + col0) * 2u;
#pragma unroll
                for (int bj = 0; bj < 2; ++bj) { ga[gg][bj] = *(const u32x4*)(Pa + (size_t)(po + bj * 256u)); gb[gg][bj] = *(const u32x4*)(Pb + (size_t)(po + bj * 256u)); } }
#pragma unroll
            for (int gg = 0; gg < 4; ++gg) { const int g = hf * 4 + gg;
#pragma unroll
                for (int bj = 0; bj < 2; ++bj) { const u32x4 a_ = ga[gg][bj], b_ = gb[gg][bj];
                    f32x4& v0 = acc[g >> 2][bj][g & 3][0]; f32x4& v1 = acc[g >> 2][bj][g & 3][1];
                    v0[0] *= gl(a_.x) * fast_rcp(gl(b_.x)); v0[1] *= gh(a_.x) * fast_rcp(gh(b_.x)); v0[2] *= gl(a_.y) * fast_rcp(gl(b_.y)); v0[3] *= gh(a_.y) * fast_rcp(gh(b_.y));
                    v1[0] *= gl(a_.z) * fast_rcp(gl(b_.z)); v1[1] *= gh(a_.z) * fast_rcp(gh(b_.z)); v1[2] *= gl(a_.w) * fast_rcp(gl(b_.w)); v1[3] *= gh(a_.w) * fast_rcp(gh(b_.w)); } }
            asm volatile("" ::: "memory"); }
    }
    __device__ __forceinline__ void operator()(const f32x4 (&acc)[2][2][4][2], const Unit& u, int wr, int wc, int fr, int fq) const {
        const unsigned row0 = (unsigned)(u.pm * BM + wr * 64 + fr), col0 = (unsigned)(u.pn * BM + wc * 32 + 8 * fq);
        const char* Pg = (const char*)(P + PGT + 2 * DM); char* mg = (char*)merged;
        u32x4 gw[8][2];
#pragma unroll
        for (int g = 0; g < 8; ++g) { const unsigned po = ((row0 + (unsigned)((g >> 2) * HALF + (g & 3) * 16)) * (unsigned)NPC + col0) * 2u;
#pragma unroll
            for (int bj = 0; bj < 2; ++bj) gw[g][bj] = *(const u32x4*)(Pg + (size_t)(po + bj * 256u)); }
#pragma unroll
        for (int g = 0; g < 8; ++g) { const unsigned moff = ((row0 + (unsigned)((g >> 2) * HALF + (g & 3) * 16)) * (unsigned)DM + col0) * 2u;
#pragma unroll
            for (int bj = 0; bj < 2; ++bj) { const u32x4 w_ = gw[g][bj]; const f32x4 v0 = acc[g >> 2][bj][g & 3][0], v1 = acc[g >> 2][bj][g & 3][1];
                u32x4 w; w.x = pk2(v0[0] * gl(w_.x), v0[1] * gh(w_.x)); w.y = pk2(v0[2] * gl(w_.y), v0[3] * gh(w_.y)); w.z = pk2(v1[0] * gl(w_.z), v1[1] * gh(w_.z)); w.w = pk2(v1[2] * gl(w_.w), v1[3] * gh(w_.w));
                *(u32x4*)(mg + (size_t)(moff + bj * 256u)) = w; } }
    }
};

template <class E, class = void> struct has_hook { static constexpr bool v = false; };
template <class E> struct has_hook<E, decltype((void)E::HOOK)> { static constexpr bool v = true; };
template <class Epi, class Sched, bool ALIGN_EPI = false, bool SP2 = false>
__device__ __forceinline__ void gemm_phase(LAS unsigned char* lds, const Gemm g, const Sched& S, const Epi& E, const int tid, unsigned long long* dg = nullptr) {
    float zf; asm volatile("v_mov_b32 %0, 0" : "=v"(zf));
    const int wid = __builtin_amdgcn_readfirstlane(tid >> 6), lane = tid & 63, wr = wid >> 2, wc = wid & 3, fr = lane & 15, fq = lane >> 4;
    const int K = g.K, nt = K / BK;
    unsigned voffA[2], voffB[2];
#pragma unroll
    for (int i = 0; i < 2; ++i) { int R, C; stage_rc(tid * 16 + i * 8192, R, C); const int Rb = Epi::PERM ? ((R & ~31) + perm32(R & 31)) : R;
        voffA[i] = (unsigned)(R * K + C) * 2u; voffB[i] = (unsigned)(Rb * K + C) * 2u; }
    const size_t kstep = (size_t)(BK * 2);
    const size_t hstep = (size_t)HALF * K * 2;
    const size_t tstep = 2 * hstep;
    const unsigned ldsw = (unsigned)wid * 1024u;
    const int aoff = lds_byte(wr * 64 + fr, fq * 8), boff = lds_byte(wc * 32 + fr, fq * 8);
#define PG8_SA(b, h) (((b) * 2 + (h)) * HTB)
#define PG8_SB(b, h) ((4 + (b) * 2 + (h)) * HTB)
#define PG8_STAGE(bufoff, gbase, voff) do { _Pragma("unroll") for (int _i = 0; _i < 2; ++_i) \
        __builtin_amdgcn_global_load_lds((const unsigned*)((const char*)(gbase) + (voff)[_i]), (LAS unsigned*)(lds + (bufoff) + ldsw + _i * 8192), 16, 0, 0); } while (0)
#define PG8_LDA(dst, b, h) do { _Pragma("unroll") for (int m = 0; m < 4; ++m) _Pragma("unroll") for (int k = 0; k < 2; ++k) dst[m][k] = *(const LAS bf16x8*)(lds + PG8_SA(b, h) + aoff + m * 2048 + k * 1024); } while (0)
#define PG8_LDB(dst, b, h) do { _Pragma("unroll") for (int n = 0; n < 2; ++n) _Pragma("unroll") for (int k = 0; k < 2; ++k) dst[n][k] = *(const LAS bf16x8*)(lds + PG8_SB(b, h) + boff + n * 2048 + k * 1024); } while (0)
#define PG8_MMA(ai, bj, At, Bt) do { __builtin_amdgcn_s_setprio(1); _Pragma("unroll") for (int m = 0; m < 4; ++m) _Pragma("unroll") for (int n = 0; n < 2; ++n) _Pragma("unroll") for (int k = 0; k < 2; ++k) \
        acc[ai][bj][m][n] = __builtin_amdgcn_mfma_f32_16x16x32_bf16(Bt[n][k], At[m][k], acc[ai][bj][m][n], 0, 0, 0); __builtin_amdgcn_s_setprio(0); } while (0)
#define PG8_WAIT_V(n) asm volatile("s_waitcnt vmcnt(" #n ")" ::: "memory")
#define PG8_WAIT_L(n) asm volatile("s_waitcnt lgkmcnt(" #n ")" ::: "memory")
#define PG8_BAR __builtin_amdgcn_s_barrier()
#define PG8_SCHED __builtin_amdgcn_sched_barrier(0)
    Unit cur, nxt; int ui = 0;
    if (!S.next(0, cur)) return;
    f32x4 acc[2][2][4][2];
#pragma unroll
    for (int a = 0; a < 2; ++a)
#pragma unroll
        for (int b = 0; b < 2; ++b)
#pragma unroll
            for (int m = 0; m < 4; ++m)
#pragma unroll
                for (int n = 0; n < 2; ++n) acc[a][b][m][n] = (f32x4){zf, zf, zf, zf};
    bf16x8 At[4][2], B0[2][2], B1[2][2];
    const char* cA = S.aptr(g, cur, tstep); const char* cB = S.bptr(g, cur, tstep);
    S.a_ready(cur);
    if constexpr (SP2) {
        PG8_STAGE(PG8_SB(0, 0), cB, voffB); PG8_STAGE(PG8_SB(0, 1), cB + hstep, voffB); PG8_STAGE(PG8_SA(0, 0), cA, voffA); PG8_STAGE(PG8_SA(0, 1), cA + hstep, voffA);
        if (wr == 1) PG8_BAR;
        PG8_WAIT_V(2); PG8_BAR;
        PG8_STAGE(PG8_SB(1, 0), cB + kstep, voffB); PG8_STAGE(PG8_SA(1, 0), cA + kstep, voffA); PG8_STAGE(PG8_SB(1, 1), cB + hstep + kstep, voffB);
        PG8_WAIT_V(6); PG8_BAR;
    } else {
        PG8_STAGE(PG8_SB(0, 0), cB, voffB); PG8_STAGE(PG8_SA(0, 0), cA, voffA); PG8_STAGE(PG8_SB(0, 1), cB + hstep, voffB); PG8_STAGE(PG8_SA(0, 1), cA + hstep, voffA);
        if (wr == 1) PG8_BAR;
        PG8_WAIT_V(4); PG8_BAR;
        PG8_STAGE(PG8_SB(1, 0), cB + kstep, voffB); PG8_STAGE(PG8_SA(1, 0), cA + kstep, voffA); PG8_STAGE(PG8_SB(1, 1), cB + hstep + kstep, voffB);
        PG8_WAIT_V(6); PG8_BAR;
    }
    for (;;) {
        const bool has_next = S.next(ui + 1, nxt);
        if (MK_DIAG && dg && tid == 0 && (ui == 2 || ui == 3)) dg[(ui - 2) * 2] = wall_clock64();
        const char* nA = has_next ? S.aptr(g, nxt, tstep) : cA; const char* nB = has_next ? S.bptr(g, nxt, tstep) : cB;
        for (int t = 0; t < nt; t += 2) {
            const bool last = (t == nt - 2);
            const char* a1 = cA + (size_t)(t + 1) * kstep;
            const char* a2 = last ? nA : cA + (size_t)(t + 2) * kstep; const char* b2 = last ? nB : cB + (size_t)(t + 2) * kstep;
            const char* a3 = a2 + kstep; const char* b3 = b2 + kstep;
            if (last && has_next) S.a_ready(nxt);
            if constexpr (SP2) {
            PG8_LDB(B0, 0, 0); PG8_LDB(B1, 0, 1); PG8_SCHED; PG8_LDA(At, 0, 0); PG8_STAGE(PG8_SA(1, 1), a1 + hstep, voffA);
            PG8_WAIT_V(8); PG8_WAIT_L(0); PG8_BAR; PG8_MMA(0, 0, At, B0); PG8_MMA(0, 1, At, B1); PG8_BAR; PG8_SCHED;
            PG8_LDA(At, 0, 1); PG8_STAGE(PG8_SB(0, 0), b2, voffB); PG8_STAGE(PG8_SB(0, 1), b2 + hstep, voffB); PG8_STAGE(PG8_SA(0, 0), a2, voffA);
            PG8_WAIT_V(8); PG8_WAIT_L(0); PG8_BAR; PG8_MMA(1, 0, At, B0); PG8_MMA(1, 1, At, B1); PG8_BAR; PG8_SCHED;
            PG8_LDB(B0, 1, 0); PG8_LDB(B1, 1, 1); PG8_SCHED; PG8_LDA(At, 1, 0); PG8_STAGE(PG8_SA(0, 1), a2 + hstep, voffA);
            PG8_WAIT_V(8); PG8_WAIT_L(0); PG8_BAR; PG8_MMA(0, 0, At, B0); PG8_MMA(0, 1, At, B1); PG8_BAR; PG8_SCHED;
            PG8_LDA(At, 1, 1); PG8_STAGE(PG8_SB(1, 0), b3, voffB); PG8_STAGE(PG8_SB(1, 1), b3 + hstep, voffB); PG8_STAGE(PG8_SA(1, 0), a3, voffA);
            PG8_WAIT_V(8); PG8_WAIT_L(0); PG8_BAR; PG8_MMA(1, 0, At, B0); PG8_MMA(1, 1, At, B1); PG8_BAR; PG8_SCHED;
            if constexpr (has_hook<Epi>::v) { if (t + 2 < nt && (t + 2) % Epi::HOOK_KT == 0) { const_cast<Epi&>(E).mid(acc, cur, wr, wc, fr, fq, (t + 2) / Epi::HOOK_KT); PG8_SCHED; } }
            } else {
            PG8_LDB(B0, 0, 0); PG8_SCHED; PG8_LDA(At, 0, 0); PG8_STAGE(PG8_SA(1, 1), a1 + hstep, voffA);
            PG8_WAIT_L(8); PG8_BAR; PG8_WAIT_L(0); PG8_MMA(0, 0, At, B0); PG8_BAR; PG8_SCHED;
            PG8_LDB(B1, 0, 1); PG8_STAGE(PG8_SB(0, 0), b2, voffB);
            PG8_BAR; PG8_WAIT_L(0); PG8_MMA(0, 1, At, B1); PG8_BAR;
            PG8_LDA(At, 0, 1); PG8_STAGE(PG8_SA(0, 0), a2, voffA);
            PG8_BAR; PG8_WAIT_L(0); PG8_MMA(1, 0, At, B0); PG8_BAR; PG8_SCHED;
            PG8_STAGE(PG8_SB(0, 1), b2 + hstep, voffB);
            PG8_WAIT_V(6); PG8_BAR; PG8_MMA(1, 1, At, B1); PG8_BAR;
            PG8_LDB(B0, 1, 0); PG8_SCHED; PG8_LDA(At, 1, 0); PG8_STAGE(PG8_SA(0, 1), a2 + hstep, voffA);
            PG8_WAIT_L(8); PG8_BAR; PG8_WAIT_L(0); PG8_MMA(0, 0, At, B0); PG8_BAR; PG8_SCHED;
            PG8_LDB(B1, 1, 1); PG8_STAGE(PG8_SB(1, 0), b3, voffB);
            PG8_BAR; PG8_WAIT_L(0); PG8_MMA(0, 1, At, B1); PG8_BAR;
            PG8_LDA(At, 1, 1); PG8_STAGE(PG8_SA(1, 0), a3, voffA);
            PG8_BAR; PG8_WAIT_L(0); PG8_MMA(1, 0, At, B0); PG8_BAR; PG8_SCHED;
            PG8_STAGE(PG8_SB(1, 1), b3 + hstep, voffB);
            PG8_WAIT_V(6); PG8_BAR; PG8_MMA(1, 1, At, B1); PG8_BAR;
            }
        }
        if (MK_DIAG && dg && tid == 0 && ui == 2) dg[1] = wall_clock64();
        if constexpr (ALIGN_EPI) { if (wr == 0) PG8_BAR; }
        if constexpr (!Epi::AFTER_DRAIN) { E(acc, cur, wr, wc, fr, fq); S.done(cur); }
        if (!has_next) break;
#pragma unroll
        for (int a = 0; a < 2; ++a)
#pragma unroll
            for (int b = 0; b < 2; ++b)
#pragma unroll
                for (int m = 0; m < 4; ++m)
#pragma unroll
                    for (int n = 0; n < 2; ++n) acc[a][b][m][n] = (f32x4){zf, zf, zf, zf};
        cur = nxt; cA = nA; cB = nB; ++ui;
        if constexpr (ALIGN_EPI) { if (wr == 1) PG8_BAR; }
    }
    PG8_WAIT_V(0);
    if constexpr (!ALIGN_EPI) { if (wr == 0) PG8_BAR; }
    PG8_BAR;
#undef PG8_SA
#undef PG8_SB
#undef PG8_STAGE
#undef PG8_LDA
#undef PG8_LDB
#undef PG8_MMA
#undef PG8_WAIT_V
#undef PG8_WAIT_L
#undef PG8_BAR
#undef PG8_SCHED
}
}
#define PG8_SP2 true
#define PG8_ALIGN true

struct Args { const float* in[18]; float* out; unsigned char* ws; int ph_lo, ph_hi; };
typedef const __attribute__((address_space(4))) Args* KArgs;
enum { I_X = 0, I_NATT, I_WIN, I_QG, I_KG, I_CPOS, I_CW1, I_CW2, I_RELB, I_HLB, I_HNG, I_WBR, I_WOUT, I_NFFN, I_WUP, I_CONVW, I_CONVB, I_WDN };

struct Frame {
    LAS unsigned char* lds; volatile LAS unsigned* MISC;
    unsigned* ctl; unsigned char* ws;
    int tid, lane, wave, G, bid;
};

__device__ __forceinline__ int up_src_col(int n) { const int pn = n >> 8, c = n & 255; return c < 128 ? 128 * pn + c : DFF + 128 * pn + (c - 128); }
__device__ __forceinline__ int inproj_src_col(int n) { return n < 2560 ? n : (n < 15872 ? n + 24 : (n < 15896 ? n - 15872 + 2560 : -1)); }
__device__ __forceinline__ void transpose_item(const float* W, int K, int Nsrc, bf16_t* WT, const float* gain, int mode, LAS float* scr, int item, int nblk, int lane, int ldw = 0) {
    if (ldw == 0) ldw = K;
    const int kb = item / nblk, nb = item - kb * nblk, k0 = 64 * kb, n0 = 32 * nb;
    const int nn = n0 + (lane & 7) * 4; const int sc = mode == 1 ? inproj_src_col(nn) : (mode == 2 ? up_src_col(nn) : nn);
    f32x4 v[8];
#pragma unroll
    for (int i = 0; i < 8; ++i) { const int kk = 8 * i + (lane >> 3); v[i] = sc >= 0 ? __builtin_nontemporal_load((const f32x4*)(W + (size_t)(k0 + kk) * Nsrc + sc)) : (f32x4){0.f, 0.f, 0.f, 0.f}; }
#pragma unroll
    for (int i = 0; i < 8; ++i) { const int kk = 8 * i + (lane >> 3); const float gk = gain ? gain[k0 + kk] : 1.f; LAS float* d = scr + kk * 33 + (lane & 7) * 4;
        d[0] = v[i].x * gk; d[1] = v[i].y * gk; d[2] = v[i].z * gk; d[3] = v[i].w * gk; }
    LDS_WAIT(); asm volatile("" ::: "memory");
    const int c = lane & 7;
#pragma unroll
    for (int j = 0; j < 4; ++j) { const int n = (lane >> 3) + 8 * j; const LAS float* sp = scr + (8 * c) * 33 + n;
        u32x4 o; o.x = pk2(sp[0 * 33], sp[1 * 33]); o.y = pk2(sp[2 * 33], sp[3 * 33]); o.z = pk2(sp[4 * 33], sp[5 * 33]); o.w = pk2(sp[6 * 33], sp[7 * 33]);
        *(u32x4*)(WT + (size_t)(n0 + n) * ldw + k0 + 8 * c) = o; }
    LDS_WAIT(); asm volatile("" ::: "memory");
}
__device__ __forceinline__ void rms_row0(const float* xin, bf16_t* xb, float* rstd, int lane) {
    const f32x4* xr = (const f32x4*)xin + lane;
    f32x4 v[8]; float s = 0.f;
#pragma unroll
    for (int j = 0; j < 8; ++j) { v[j] = xr[64 * j]; s += (v[j].x * v[j].x + v[j].y * v[j].y) + (v[j].z * v[j].z + v[j].w * v[j].w); }
    s = wave_sum(s);
    if (lane == 0) *rstd = rsqrtf(s * (1.f / DM) + EPS);
    u32x2* o8 = (u32x2*)xb + lane;
#pragma unroll
    for (int j = 0; j < 8; ++j) { u32x2 w; w.x = pk2(v[j].x, v[j].y); w.y = pk2(v[j].z, v[j].w); o8[64 * j] = w; }
}
__device__ __forceinline__ void rstd_rows(Frame& F) {
    const float* ssq = (const float*)(F.ws + WS_SSQ); float* rstd = (float*)(F.ws + WS_RSTD);
    for (int row = F.bid * 512 + F.tid; row < M; row += F.G * 512) { const f32x4* p = (const f32x4*)(ssq + (size_t)row * 32); float s = 0.f;
#pragma unroll
        for (int j = 0; j < 8; ++j) { const f32x4 v = p[j]; s += (v.x + v.y) + (v.z + v.w); }
        rstd[row] = rsqrtf(s * (1.f / DM) + EPS); }
}

__device__ __forceinline__ void cvec_item(Frame& F, KArgs a, int layer, int j);
__device__ __forceinline__ void phase_A(Frame& F, KArgs a, int layer) {
    LAS float* scr = (LAS float*)(F.lds + F.wave * 16384);
    const int gw = F.bid * 8 + F.wave, NGW = F.G * 8;
    bf16_t* Wt_in = (bf16_t*)(F.ws + WS_WIN); bf16_t* Wt_br = (bf16_t*)(F.ws + WS_WBR); bf16_t* Wt_out = (bf16_t*)(F.ws + WS_WOUT);
    bf16_t* Wt_up = (bf16_t*)(F.ws + WS_WUP); bf16_t* Wt_dn = (bf16_t*)(F.ws + WS_WDN);
    const float* w_in = a->in[I_WIN] + (size_t)layer * DM * INC; const float* g_att = a->in[I_NATT] + layer * DM;
    const float* w_br = a->in[I_WBR] + (size_t)layer * 3 * BW * DM; const float* w_out = a->in[I_WOUT] + (size_t)layer * DM * DM;
    const float* w_up = a->in[I_WUP] + (size_t)layer * DM * NUP; const float* g_ffn = a->in[I_NFFN] + layer * DM;
    const float* w_dn = a->in[I_WDN] + (size_t)layer * DFF * DM;
    constexpr int I_IN = (DM / 64) * (NPC / 32), I_BR1 = (BW / 64) * (DM / 32), I_OUT = (DM / 64) * (DM / 32), I_UP = (DM / 64) * (NUP / 32), I_DN = (DFF / 64) * (DM / 32);
    constexpr int I_C1 = (4096 / 64) * (HD / 32);
    constexpr int NITEMS = I_IN + 3 * I_BR1 + I_OUT + I_UP + I_DN + 2 * I_C1;
    for (int it = gw; it < NITEMS; it += NGW) {
        int r = it;
        if (r < I_IN) { transpose_item(w_in, DM, INC, Wt_in, g_att, 1, scr, r, NPC / 32, F.lane); continue; } r -= I_IN;
        if (r < 3 * I_BR1) { const int n = r / I_BR1; r -= n * I_BR1; transpose_item(w_br + (size_t)n * BW * DM, BW, DM, Wt_br + (size_t)n * BW, nullptr, 0, scr, r, DM / 32, F.lane, 3 * BW); continue; } r -= 3 * I_BR1;
        if (r < I_OUT) { transpose_item(w_out, DM, DM, Wt_out, nullptr, 0, scr, r, DM / 32, F.lane); continue; } r -= I_OUT;
        if (r < I_UP) { transpose_item(w_up, DM, NUP, Wt_up, g_ffn, 2, scr, r, NUP / 32, F.lane); continue; } r -= I_UP;
        if (r < I_DN) { transpose_item(w_dn, DFF, DM, Wt_dn, nullptr, 0, scr, r, DM / 32, F.lane); continue; } r -= I_DN;
        { const int j = r / I_C1; r -= j * I_C1; transpose_item(a->in[I_CW1] + (size_t)(layer * 2 + j) * 4096 * HD, 4096, HD, (bf16_t*)(F.ws + WS_MISC + MISC_WC1) + (size_t)j * HD * 4096, nullptr, 0, scr, r, HD / 32, F.lane); }
    }
    if (F.bid < 64) cvec_item(F, a, layer, F.bid);
    if (layer == 0) { bf16_t* XB = (bf16_t*)(F.ws + WS_XB); float* rstd = (float*)(F.ws + WS_RSTD);
        for (int m = gw; m < M; m += NGW) rms_row0(a->in[I_X] + (size_t)m * DM, XB + (size_t)m * DM, rstd + m, F.lane); }
    else rstd_rows(F);
}
__device__ __forceinline__ void phase_F(Frame& F, KArgs a) { rstd_rows(F); }
__device__ __forceinline__ void phase_H(Frame& F, KArgs a, int layer) {
    const bf16_t* SD = (const bf16_t*)(F.ws + WS_USIDE); bf16_t* ACT = (bf16_t*)(F.ws + WS_ACT);
    const float* cw = a->in[I_CONVW] + (size_t)layer * 3 * NUP; const float* cb = a->in[I_CONVB] + (size_t)layer * NUP;
    constexpr int CG = DFF / 8, NTASK = (M / 64) * 2 * CG;
    for (int task = F.bid * 512 + F.tid; task < NTASK; task += F.G * 512) {
        const int cg = task % CG, rb = task / CG, rw = rb & 1, blk = rb >> 1; if ((blk & 31) == 0) continue;
        const int c0 = cg * 8, uc = 256 * (c0 >> 7) + (c0 & 127);
        const bf16_t* t2 = rw == 0 ? SD + ((size_t)(blk - 1) * 4 + 2) * NUP : SD + ((size_t)(blk - 1) * 4 + 3) * NUP;
        const bf16_t* t1 = rw == 0 ? SD + ((size_t)(blk - 1) * 4 + 3) * NUP : SD + ((size_t)blk * 4 + 0) * NUP;
        const bf16_t* t0 = SD + ((size_t)blk * 4 + rw) * NUP;
        const u32x4 g2 = *(const u32x4*)(t2 + uc), g1 = *(const u32x4*)(t1 + uc), g0 = *(const u32x4*)(t0 + uc), v2 = *(const u32x4*)(t2 + uc + 128), v1 = *(const u32x4*)(t1 + uc + 128), v0 = *(const u32x4*)(t0 + uc + 128);
        const unsigned G2[4] = {g2.x, g2.y, g2.z, g2.w}, G1[4] = {g1.x, g1.y, g1.z, g1.w}, G0[4] = {g0.x, g0.y, g0.z, g0.w}, V2[4] = {v2.x, v2.y, v2.z, v2.w}, V1[4] = {v1.x, v1.y, v1.z, v1.w}, V0[4] = {v0.x, v0.y, v0.z, v0.w};
        float o[8];
#pragma unroll
        for (int e = 0; e < 8; ++e) { const int q = e >> 1; const bool hi = e & 1;
            const float xg2 = hi ? bfhi(G2[q]) : bflo(G2[q]), xg1 = hi ? bfhi(G1[q]) : bflo(G1[q]), xg0 = hi ? bfhi(G0[q]) : bflo(G0[q]);
            const float xv2 = hi ? bfhi(V2[q]) : bflo(V2[q]), xv1 = hi ? bfhi(V1[q]) : bflo(V1[q]), xv0 = hi ? bfhi(V0[q]) : bflo(V0[q]);
            const float cgv = cb[c0 + e] + cw[c0 + e] * xg2 + cw[NUP + c0 + e] * xg1 + cw[2 * NUP + c0 + e] * xg0;
            const float cvv = cb[DFF + c0 + e] + cw[DFF + c0 + e] * xv2 + cw[NUP + DFF + c0 + e] * xv1 + cw[2 * NUP + DFF + c0 + e] * xv0;
            o[e] = cgv * sigmoidf_(cgv) * cvv; }
        *(u32x4*)(ACT + (size_t)(blk * 64 + rw) * DFF + c0) = (u32x4){pk2(o[0], o[1]), pk2(o[2], o[3]), pk2(o[4], o[5]), pk2(o[6], o[7])};
    }
}

__device__ __forceinline__ int q_next(Frame& F, unsigned* head) {
    __syncthreads();
    if (F.tid == 0) F.MISC[16] = __hip_atomic_fetch_add(head, 1u, __ATOMIC_RELAXED, __HIP_MEMORY_SCOPE_AGENT);
    __syncthreads();
    return __builtin_amdgcn_readfirstlane((int)F.MISC[16]);
}
__device__ __forceinline__ int t5_bucket(int n) {
    if (n < 16) return n;
    int b = 16;
    b += (n >= 19); b += (n >= 21); b += (n >= 24); b += (n >= 27); b += (n >= 31); b += (n >= 35); b += (n >= 40); b += (n >= 46);
    b += (n >= 52); b += (n >= 59); b += (n >= 67); b += (n >= 77); b += (n >= 87); b += (n >= 99); b += (n >= 113);
    return b;
}
__device__ __forceinline__ int crow(int i, int h) { return (i & 3) + 8 * (i >> 2) + 4 * h; }

#define MFMA32(a, b, c) __builtin_amdgcn_mfma_f32_32x32x16_bf16((a), (b), (c), 0, 0, 0)
__device__ __forceinline__ float sum8lanes(float v) { v += __shfl_xor(v, 1); v += __shfl_xor(v, 2); v += __shfl_xor(v, 4); return v; }
__device__ __forceinline__ void norm16(unsigned* pp, const float* gn, float sc) {
    const u32x4 w0 = *(const u32x4*)pp, w1 = *(const u32x4*)(pp + 4); const unsigned w[8] = {w0.x, w0.y, w0.z, w0.w, w1.x, w1.y, w1.z, w1.w};
    float x[16], ss = 0.f;
#pragma unroll
    for (int q = 0; q < 8; ++q) { x[2 * q] = bflo(w[q]); x[2 * q + 1] = bfhi(w[q]); ss += x[2 * q] * x[2 * q] + x[2 * q + 1] * x[2 * q + 1]; }
    const float r = rsqrtf(sum8lanes(ss) * (1.f / HD) + EPS) * sc;
    u32x4 o0, o1;
    o0.x = pk2(x[0] * r * gn[0], x[1] * r * gn[1]); o0.y = pk2(x[2] * r * gn[2], x[3] * r * gn[3]); o0.z = pk2(x[4] * r * gn[4], x[5] * r * gn[5]); o0.w = pk2(x[6] * r * gn[6], x[7] * r * gn[7]);
    o1.x = pk2(x[8] * r * gn[8], x[9] * r * gn[9]); o1.y = pk2(x[10] * r * gn[10], x[11] * r * gn[11]); o1.z = pk2(x[12] * r * gn[12], x[13] * r * gn[13]); o1.w = pk2(x[14] * r * gn[14], x[15] * r * gn[15]);
    *(u32x4*)pp = o0; *(u32x4*)(pp + 4) = o1;
}
__device__ __forceinline__ void item_norm(Frame& F, KArgs a, int layer, int it) {
    bf16_t* P = (bf16_t*)(F.ws + WS_P);
    const float* qg = a->in[I_QG] + layer * HD; const float* kg = a->in[I_KG] + layer * 3 * HD;
    const int lane = F.lane, e0 = (lane & 7) * 16;
    float gq[16], gk[16];
#pragma unroll
    for (int e = 0; e < 16; ++e) { gq[e] = qg[e0 + e]; gk[e] = kg[((lane >> 4) & 1 ? 2 : 1) * HD + e0 + e]; }
    for (int rr = 0; rr < 8; ++rr) {
        bf16_t* pr = P + (size_t)(it * 64 + F.wave * 8 + rr) * NPC;
        norm16((unsigned*)(pr + PQN + lane * 16), gq, QSCALE);
        if (lane < 32) norm16((unsigned*)(pr + (lane < 16 ? PKS + lane * 16 : PKW + (lane - 16) * 16)), gk, 1.f);
    }
}
__device__ __forceinline__ void item_hgfin(Frame& F, KArgs a, int layer, int it) {
    const bf16_t* P = (const bf16_t*)(F.ws + WS_P); const float* OR = (const float*)(F.ws + WS_ORAW); bf16_t* OH = (bf16_t*)(F.ws + WS_OBR) + 2 * BW;
    const float* ng = a->in[I_HNG] + layer * HD; const int lane = F.lane, e0 = (lane & 7) * 16;
    float gn[16];
#pragma unroll
    for (int e = 0; e < 16; ++e) gn[e] = ng[e0 + e];
    for (int rr = 0; rr < 8; ++rr) { const size_t row = (size_t)(it * 64 + F.wave * 8 + rr);
        const f32x4* op = (const f32x4*)(OR + row * BW + lane * 16); const f32x4 o0 = op[0], o1 = op[1], o2 = op[2], o3 = op[3];
        const unsigned* gp = (const unsigned*)(P + row * NPC + PGH + lane * 16); const u32x4 g0 = *(const u32x4*)gp, g1 = *(const u32x4*)(gp + 4);
        const float x[16] = {o0.x, o0.y, o0.z, o0.w, o1.x, o1.y, o1.z, o1.w, o2.x, o2.y, o2.z, o2.w, o3.x, o3.y, o3.z, o3.w}; const unsigned gw[8] = {g0.x, g0.y, g0.z, g0.w, g1.x, g1.y, g1.z, g1.w};
        float ss = 0.f;
#pragma unroll
        for (int e = 0; e < 16; ++e) ss += x[e] * x[e];
        const float r = rsqrtf(sum8lanes(ss) * (1.f / HD) + EPS);
        unsigned ow[8];
#pragma unroll
        for (int q = 0; q < 8; ++q) ow[q] = pk2(x[2 * q] * r * gn[2 * q] * sigmoidf_(bflo(gw[q])), x[2 * q + 1] * r * gn[2 * q + 1] * sigmoidf_(bfhi(gw[q])));
        unsigned* dst = (unsigned*)(OH + row * (3 * BW) + lane * 16);
        *(u32x4*)dst = (u32x4){ow[0], ow[1], ow[2], ow[3]}; *(u32x4*)(dst + 4) = (u32x4){ow[4], ow[5], ow[6], ow[7]};
    }
}
__device__ __forceinline__ void cvec_item(Frame& F, KArgs a, int layer, int blk) {
    const int j = blk >> 5, ks = blk & 31;
    const float* pos = a->in[I_CPOS] + (size_t)(layer * 2 + j) * 32 * HD; const float* w1 = a->in[I_CW1] + (size_t)(layer * 2 + j) * 32 * HD * HD;
    LAS float* red = (LAS float*)F.lds; const int e = F.tid & 127, sub = F.tid >> 7;
    float acc = 0.f;
#pragma unroll 8
    for (int k = ks * 128 + sub * 32; k < ks * 128 + sub * 32 + 32; ++k) acc += pos[k] * w1[(size_t)k * HD + e];
    __syncthreads(); red[sub * 128 + e] = acc; __syncthreads();
    if (F.tid < 128) ((float*)(F.ctl + CW_CVEC))[(j * 32 + ks) * 128 + F.tid] = (red[F.tid] + red[128 + F.tid]) + (red[256 + F.tid] + red[384 + F.tid]);
    __syncthreads();
}
__device__ __forceinline__ void item_compress(Frame& F, KArgs a, int layer, int id) {
    const int j = id >> 7, rem = id & 127, b = rem >> 3, g = (rem >> 2) & 1, n0 = (rem & 3) * 32;
    const bf16_t* P = (const bf16_t*)(F.ws + WS_P);
    LAS float* red = (LAS float*)F.lds;
    LAS float* hid = (LAS float*)(F.lds + 16384);
    LAS float* outv = (LAS float*)(F.lds + 16384 + 32 * 132 * 4);
    const int tid = F.tid, lane = F.lane, wave = F.wave, r = lane & 31, h = lane >> 5, ct = wave & 3, kh = wave >> 2;
    f32x16 acc;
#pragma unroll
    for (int i = 0; i < 16; ++i) acc[i] = 0.f;
    {
        int trow = 16 * (n0 + r) + 16 * kh; const int tmax = T - 1;
        const bf16_t* Ab = P + (size_t)(b * T) * NPC + (j ? PVC : PKC) + g * HD + 8 * h;
        const bf16_t* Bb = (const bf16_t*)(F.ws + WS_MISC + MISC_WC1) + (size_t)(j * HD + 32 * ct + r) * 4096 + (size_t)(16 * kh) * HD + 8 * h;
        for (int l = 0; l < 16; ++l) { const int t = (trow + l) < tmax ? (trow + l) : tmax; const bf16_t* ap = Ab + (size_t)t * NPC; const bf16_t* bp = Bb + l * HD;
#pragma unroll
            for (int ds = 0; ds < 8; ++ds) { const bf16x8 av = *(const bf16x8*)(ap + 16 * ds), bv = *(const bf16x8*)(bp + 16 * ds); acc = MFMA32(av, bv, acc); } }
    }
    if (kh == 1) {
#pragma unroll
        for (int i = 0; i < 16; ++i) red[(ct * 16 + i) * 64 + lane] = acc[i]; }
    __syncthreads();
    if (kh == 0) { float cv = 0.f; { const float* cp = (const float*)(F.ctl + CW_CVEC) + (size_t)(j * 32) * 128 + 32 * ct + r;
#pragma unroll 8
        for (int q = 0; q < 32; ++q) cv += cp[q * 128]; }
#pragma unroll
        for (int i = 0; i < 16; ++i) { const float x = acc[i] + red[(ct * 16 + i) * 64 + lane] + cv;
            const float y = 0.7978845608028654f * (x + 0.044715f * x * x * x);
            const float th = 1.f - 2.f * fast_rcp(1.f + fast_exp2(2.f * y * LOG2E));
            hid[crow(i, h) * 132 + 32 * ct + r] = 0.5f * x * (1.f + th); } }
    __syncthreads();
    { const int e2 = tid & 127, ng = __builtin_amdgcn_readfirstlane(tid >> 7); const float* w2 = a->in[I_CW2] + (size_t)(layer * 2 + j) * HD * HD + e2;
      float o[8];
#pragma unroll
      for (int q = 0; q < 8; ++q) o[q] = 0.f;
      for (int k = 0; k < 128; k += 4) { const float w0 = w2[(size_t)k * HD], w1 = w2[(size_t)(k + 1) * HD], w2_ = w2[(size_t)(k + 2) * HD], w3 = w2[(size_t)(k + 3) * HD];
#pragma unroll
          for (int q = 0; q < 8; ++q) { const f32x4 hv = *(const LAS f32x4*)(hid + (8 * ng + q) * 132 + k); o[q] += (hv.x * w0 + hv.y * w1) + (hv.z * w2_ + hv.w * w3); } }
#pragma unroll
      for (int q = 0; q < 8; ++q) outv[(8 * ng + q) * 132 + e2] = o[q]; }
    __syncthreads();
    const float* kg0 = a->in[I_KG] + layer * 3 * HD;
#pragma unroll
    for (int q = 0; q < 4; ++q) { const int n = 4 * wave + q; float v0 = outv[n * 132 + 2 * lane], v1 = outv[n * 132 + 2 * lane + 1];
        if (j == 0) { const float ss = wave_sum(v0 * v0 + v1 * v1); const float rr = rsqrtf(ss * (1.f / HD) + EPS); v0 *= rr * kg0[2 * lane]; v1 *= rr * kg0[2 * lane + 1]; }
        if (n0 + n >= 127) { v0 = 0.f; v1 = 0.f; }
        bf16_t* dst = (bf16_t*)(F.ws + WS_MISC + (j ? MISC_VCMP : MISC_KCMP)) + (size_t)((b * 2 + g) * 128 + n0 + n) * HD;
        *((unsigned*)dst + lane) = pk2(v0, v1); }
}
constexpr int HG_Q1 = 0, HG_K1 = 17408, HG_QI = 34816, HG_K2 = 43520, HG_K3T = 52224, HG_VT = 70656, HG_AT = 79872, HG_SB = 89088, HG_TOT = 123904, HG_LB = 125952;
__device__ __forceinline__ void item_hgrn(Frame& F, KArgs a, int layer, int id) {
    const int b = id >> 4, hh = (id >> 1) & 7, half = id & 1;
    const bf16_t* P = (const bf16_t*)(F.ws + WS_P); float* OR = (float*)(F.ws + WS_ORAW);
    LAS unsigned char* L = F.lds;
    LAS float* tot = (LAS float*)(L + HG_TOT); LAS float* lbs = (LAS float*)(L + HG_LB);
    const int tid = F.tid, lane = F.lane, wave = F.wave, r = lane & 31, h = lane >> 5;
    if (tid < 128) { const float* hb = a->in[I_HLB] + hh * HD + tid; const float x0 = hb[0], x1 = hb[1024], x2 = hb[2048], x3 = hb[3072];
        const float mx = fmaxf(fmaxf(x0, x1), fmaxf(x2, x3)); const float e0 = __expf(x0 - mx), e1 = __expf(x1 - mx), e2 = __expf(x2 - mx), e3 = __expf(x3 - mx);
        const float inv = 1.f / (e0 + e1 + e2 + e3); float c = 0.f; if (layer >= 1) c += e1; if (layer >= 2) c += e2; if (layer >= 3) c += e3;
        lbs[tid] = fmaxf(c * inv, 0.f); }
    { unsigned zu; asm volatile("v_mov_b32 %0, 0" : "=v"(zu));
      for (int i = tid; i < 17408 / 16; i += 512) *(LAS u32x4*)(L + HG_SB + i * 16) = (u32x4){zu, zu, zu, zu}; }
    f32x16 Sacc;
#pragma unroll
    for (int i = 0; i < 16; ++i) Sacc[i] = 0.f;
    const int pd = tid & 127, psc = __builtin_amdgcn_readfirstlane(tid >> 7);
    const int srow = tid >> 4, sch = tid & 15, vrow = tid >> 3, vch = tid & 7;
    const bf16_t* gq = P + (size_t)(b * T + srow) * NPC + PQH + hh * HD + sch * 8; const bf16_t* gf = P + (size_t)(b * T + srow) * NPC + PFH + hh * HD + sch * 8;
    const bf16_t* gv = P + (size_t)(b * T + vrow) * NPC + PIH + hh * HD + half * 64 + vch * 8;
    u32x4 rq0 = *(const u32x4*)gq, rq1 = *(const u32x4*)(gq + (size_t)32 * NPC), rf0 = *(const u32x4*)gf, rf1 = *(const u32x4*)(gf + (size_t)32 * NPC), rv = *(const u32x4*)gv;
    for (int c = 0; c < T / 64; ++c) {
        __syncthreads();
        *(LAS u32x4*)(L + HG_Q1 + srow * 272 + sch * 16) = rq0; *(LAS u32x4*)(L + HG_Q1 + (srow + 32) * 272 + sch * 16) = rq1;
        *(LAS u32x4*)(L + HG_K1 + srow * 272 + sch * 16) = rf0; *(LAS u32x4*)(L + HG_K1 + (srow + 32) * 272 + sch * 16) = rf1;
        { const unsigned vw[4] = {rv.x, rv.y, rv.z, rv.w};
#pragma unroll
          for (int q = 0; q < 4; ++q) { *(LAS unsigned short*)(L + HG_VT + (8 * vch + 2 * q) * 144 + vrow * 2) = (unsigned short)(vw[q] & 0xffffu); *(LAS unsigned short*)(L + HG_VT + (8 * vch + 2 * q + 1) * 144 + vrow * 2) = (unsigned short)(vw[q] >> 16); } }
        __syncthreads();
        if (c + 1 < T / 64) { const size_t adv = (size_t)(64 * (c + 1)) * NPC;
            rq0 = *(const u32x4*)(gq + adv); rq1 = *(const u32x4*)(gq + adv + (size_t)32 * NPC); rf0 = *(const u32x4*)(gf + adv); rf1 = *(const u32x4*)(gf + adv + (size_t)32 * NPC); rv = *(const u32x4*)(gv + adv); }
        float qv[16], kv[16], bl[16];
        { const float lb = lbs[pd]; float run = 0.f;
#pragma unroll
          for (int tt = 0; tt < 16; ++tt) { const int t = 16 * psc + tt;
              qv[tt] = bf2f(*(const LAS unsigned short*)(L + HG_Q1 + t * 272 + pd * 2)); const float fp = bf2f(*(const LAS unsigned short*)(L + HG_K1 + t * 272 + pd * 2));
              const float ex = fast_exp2(-fabsf(fp) * LOG2E);
              const float sg = (fp >= 0.f ? 1.f : ex) * fast_rcp(1.f + ex);
              const float f = lb + (1.f - lb) * sg; kv[tt] = 1.f - f;
              const float lf = (layer == 0) ? (fminf(fp, 0.f) - LN2 * fast_log2(1.f + ex)) : LN2 * fast_log2(f);
              run += lf; bl[tt] = run; }
          tot[psc * 128 + pd] = run; }
        __syncthreads();
        { const float t0 = tot[pd], t1 = tot[128 + pd], t2 = tot[256 + pd], t3 = tot[384 + pd];
          const float b31 = t0 + t1, b63 = (t0 + t1) + (t2 + t3);
          const float pre = psc == 0 ? 0.f : (psc == 1 ? t0 : (psc == 2 ? b31 : b31 + t2));
          const float rref = psc >= 2 ? b31 : 0.f; const float eb31 = fast_exp2(b31 * LOG2E), c3 = fast_exp2((b63 - rref) * LOG2E);
          unsigned k3w[8];
#pragma unroll
          for (int tt = 0; tt < 16; ++tt) { const int t = 16 * psc + tt; const float bb = pre + bl[tt];
              const float e1 = fast_exp2((bb - rref) * LOG2E); const float q1 = qv[tt] * e1;
              const float k1 = kv[tt] * fast_exp2(fminf(rref - bb, 80.f) * LOG2E);
              const float k3 = k1 * c3;
              *(LAS unsigned short*)(L + HG_Q1 + t * 272 + pd * 2) = (unsigned short)(pk2(q1, 0.f) & 0xffffu);
              *(LAS unsigned short*)(L + HG_K1 + t * 272 + pd * 2) = (unsigned short)(pk2(k1, 0.f) & 0xffffu);
              if (psc >= 2) *(LAS unsigned short*)(L + HG_QI + (t - 32) * 272 + pd * 2) = (unsigned short)(pk2(q1 * eb31, 0.f) & 0xffffu);
              else *(LAS unsigned short*)(L + HG_K2 + t * 272 + pd * 2) = (unsigned short)(pk2(k1 * eb31, 0.f) & 0xffffu);
              if (tt & 1) k3w[tt >> 1] = (k3w[tt >> 1] & 0xffffu) | (pk2(0.f, k3) & 0xffff0000u); else k3w[tt >> 1] = pk2(k3, 0.f) & 0xffffu; }
          *(LAS u32x4*)(L + HG_K3T + pd * 144 + psc * 32) = (u32x4){k3w[0], k3w[1], k3w[2], k3w[3]}; *(LAS u32x4*)(L + HG_K3T + pd * 144 + psc * 32 + 16) = (u32x4){k3w[4], k3w[5], k3w[6], k3w[7]}; }
        __syncthreads();
        if (wave < 3) {
            const int st = wave == 1 ? 1 : 0, tt2 = wave == 0 ? 0 : 1;
            const LAS unsigned char* Kb = L + (wave == 2 ? HG_K2 : HG_K1 + st * 32 * 272) + r * 272 + 16 * h; const LAS unsigned char* Qb = L + HG_Q1 + (32 * tt2 + r) * 272 + 16 * h;
            f32x16 at;
#pragma unroll
            for (int i = 0; i < 16; ++i) at[i] = 0.f;
#pragma unroll
            for (int s8 = 0; s8 < 8; ++s8) at = MFMA32(*(const LAS bf16x8*)(Kb + 32 * s8), *(const LAS bf16x8*)(Qb + 32 * s8), at);
            if (wave < 2) {
#pragma unroll
                for (int i = 0; i < 16; ++i) at[i] = (crow(i, h) <= r) ? at[i] : 0.f; }
#pragma unroll
            for (int g4 = 0; g4 < 4; ++g4) { u32x2 w; w.x = pk2(at[4 * g4], at[4 * g4 + 1]); w.y = pk2(at[4 * g4 + 2], at[4 * g4 + 3]);
                *(LAS u32x2*)(L + HG_AT + (32 * tt2 + r) * 144 + (32 * st + 8 * g4 + 4 * h) * 2) = w; }
        }
        {   const int et = wave & 1, dt = wave >> 1; const int dd = 32 * dt + r;
            const float eb63 = fast_exp2(((tot[dd] + tot[128 + dd]) + (tot[256 + dd] + tot[384 + dd])) * LOG2E);
#pragma unroll
            for (int i = 0; i < 16; ++i) Sacc[i] *= eb63;
            const LAS unsigned char* Vb = L + HG_VT + (32 * et + r) * 144 + 16 * h; const LAS unsigned char* Kb = L + HG_K3T + dd * 144 + 16 * h;
#pragma unroll
            for (int s4 = 0; s4 < 4; ++s4) Sacc = MFMA32(*(const LAS bf16x8*)(Vb + 32 * s4), *(const LAS bf16x8*)(Kb + 32 * s4), Sacc);
            LAS unsigned char* Sw = L + HG_SB + ((c + 1) & 1) * 17408 + dd * 2;
#pragma unroll
            for (int i = 0; i < 16; i += 2) { const unsigned w = pk2(Sacc[i], Sacc[i + 1]);
                *(LAS unsigned short*)(Sw + (32 * et + crow(i, h)) * 272) = (unsigned short)(w & 0xffffu); *(LAS unsigned short*)(Sw + (32 * et + crow(i + 1, h)) * 272) = (unsigned short)(w >> 16); }
        }
        __syncthreads();
        if (wave < 4) {
            const int et = wave & 1, tt2 = wave >> 1;
            f32x16 oo;
#pragma unroll
            for (int i = 0; i < 16; ++i) oo[i] = 0.f;
            const LAS unsigned char* Sb = L + HG_SB + (c & 1) * 17408 + (32 * et + r) * 272 + 16 * h; const LAS unsigned char* Qb = L + (tt2 ? HG_QI : HG_Q1) + r * 272 + 16 * h;
#pragma unroll
            for (int s8 = 0; s8 < 8; ++s8) oo = MFMA32(*(const LAS bf16x8*)(Sb + 32 * s8), *(const LAS bf16x8*)(Qb + 32 * s8), oo);
            const LAS unsigned char* Vb = L + HG_VT + (32 * et + r) * 144 + 16 * h; const LAS unsigned char* Ab = L + HG_AT + (32 * tt2 + r) * 144 + 16 * h;
            oo = MFMA32(*(const LAS bf16x8*)(Vb), *(const LAS bf16x8*)(Ab), oo); oo = MFMA32(*(const LAS bf16x8*)(Vb + 32), *(const LAS bf16x8*)(Ab + 32), oo);
            if (tt2) { oo = MFMA32(*(const LAS bf16x8*)(Vb + 64), *(const LAS bf16x8*)(Ab + 64), oo); oo = MFMA32(*(const LAS bf16x8*)(Vb + 96), *(const LAS bf16x8*)(Ab + 96), oo); }
            float* op = OR + (size_t)(b * T + 64 * c + 32 * tt2 + r) * BW + hh * HD + half * 64 + 32 * et + 4 * h;
#pragma unroll
            for (int g4 = 0; g4 < 4; ++g4) *(f32x4*)(op + 8 * g4) = (f32x4){oo[4 * g4], oo[4 * g4 + 1], oo[4 * g4 + 2], oo[4 * g4 + 3]};
        }
    }
}

constexpr int AT_K = 0, AT_V = 32768, AT_TAB = 73728, AT_IMP = 75776, AT_SELM = 109568, AT_MISC = 109824;
constexpr int K_TB = 16384, V_RS = 320, V_TB = 64 * V_RS;
__device__ __forceinline__ unsigned koff(int row, int ch) { return 256u * (unsigned)row + 16u * (unsigned)(ch ^ (((row & 3) << 2) | ((row >> 2) & 3))); }
struct Stg { u32x4 k0, k1, v0, v1; };
__device__ __forceinline__ void stg_load(Stg& s, const bf16_t* Kp, const bf16_t* Vp, int ld, int tid) {
    const int row = tid >> 4, ch = tid & 15;
    s.k0 = *(const u32x4*)(Kp + (size_t)row * ld + ch * 8); s.k1 = *(const u32x4*)(Kp + (size_t)(row + 32) * ld + ch * 8);
    s.v0 = *(const u32x4*)(Vp + (size_t)row * ld + ch * 8); s.v1 = *(const u32x4*)(Vp + (size_t)(row + 32) * ld + ch * 8);
}
__device__ __forceinline__ void stg_write(const Stg& s, LAS unsigned char* L, int tid, int buf) {
    const int row = tid >> 4, ch = tid & 15;
    *(LAS u32x4*)(L + AT_K + buf * K_TB + koff(row, ch)) = s.k0; *(LAS u32x4*)(L + AT_K + buf * K_TB + koff(row + 32, ch)) = s.k1;
    *(LAS u32x4*)(L + AT_V + buf * V_TB + row * V_RS + ch * 16) = s.v0; *(LAS u32x4*)(L + AT_V + buf * V_TB + (row + 32) * V_RS + ch * 16) = s.v1;
}
__device__ __forceinline__ float xhalf_max(float v) { auto rr = __builtin_amdgcn_permlane32_swap(__float_as_uint(v), __float_as_uint(v), false, false); return fmaxf(__uint_as_float(rr[0]), __uint_as_float(rr[1])); }
__device__ __forceinline__ float xhalf_sum(float v) { auto rr = __builtin_amdgcn_permlane32_swap(__float_as_uint(v), __float_as_uint(v), false, false); return __uint_as_float(rr[0]) + __uint_as_float(rr[1]); }
__device__ __forceinline__ float xhalf_get(float v, int h) { auto rr = __builtin_amdgcn_permlane32_swap(__float_as_uint(v), __float_as_uint(v), false, false); return __uint_as_float(h ? rr[0] : rr[1]); }
__device__ __forceinline__ void qk_tile(f32x16& p0, f32x16& p1, const LAS unsigned char* L, int buf, const bf16x8 (&qf)[8], int r, int h) {
#pragma unroll
    for (int i = 0; i < 16; ++i) { p0[i] = 0.f; p1[i] = 0.f; }
    const LAS unsigned char* Kb = L + AT_K + buf * K_TB;
    bf16x8 a0[8], a1[8];
#pragma unroll
    for (int s = 0; s < 8; ++s) { a0[s] = *(const LAS bf16x8*)(Kb + koff(r, 2 * s + h)); a1[s] = *(const LAS bf16x8*)(Kb + koff(r + 32, 2 * s + h)); }
#pragma unroll
    for (int s = 0; s < 8; ++s) { p0 = MFMA32(a0[s], qf[s], p0); p1 = MFMA32(a1[s], qf[s], p1); }
    __builtin_amdgcn_sched_group_barrier(0x100, 4, 0);
#pragma unroll
    for (int i = 0; i < 6; ++i) { __builtin_amdgcn_sched_group_barrier(0x008, 2, 0); __builtin_amdgcn_sched_group_barrier(0x100, 2, 0); }
    __builtin_amdgcn_sched_group_barrier(0x008, 4, 0);
}
__device__ __forceinline__ bf16x8 pack8(const f32x16& p, int s) {
    u32x4 w; w.x = pk2(p[8 * s], p[8 * s + 1]); w.y = pk2(p[8 * s + 2], p[8 * s + 3]); w.z = pk2(p[8 * s + 4], p[8 * s + 5]); w.w = pk2(p[8 * s + 6], p[8 * s + 7]);
    return __builtin_bit_cast(bf16x8, w);
}
__device__ __forceinline__ void pv_tile(f32x16 (&o)[4], const f32x16& p0, const f32x16& p1, const LAS unsigned char* L, int buf, int lane) {
    bf16x8 pb[4]; pb[0] = pack8(p0, 0); pb[1] = pack8(p0, 1); pb[2] = pack8(p1, 0); pb[3] = pack8(p1, 1);
    const LAS unsigned char* vb = L + AT_V + buf * V_TB + (4 * (lane >> 5) + ((lane & 15) >> 2)) * V_RS + ((lane >> 4) & 1) * 32 + (lane & 3) * 8;
    __builtin_amdgcn_sched_barrier(0);
    s16x4 lo[16], hi[16];
#pragma unroll
    for (int c = 0; c < 4; ++c)
#pragma unroll
        for (int s = 0; s < 4; ++s) { lo[4 * c + s] = __builtin_amdgcn_ds_read_tr16_b64_v4i16((LAS s16x4*)(vb + (16 * s) * V_RS + 64 * c)); hi[4 * c + s] = __builtin_amdgcn_ds_read_tr16_b64_v4i16((LAS s16x4*)(vb + (16 * s + 8) * V_RS + 64 * c)); }
#pragma unroll
    for (int c = 0; c < 4; ++c)
#pragma unroll
        for (int s = 0; s < 4; ++s) o[c] = MFMA32(__builtin_shufflevector(lo[4 * c + s], hi[4 * c + s], 0, 1, 2, 3, 4, 5, 6, 7), pb[s], o[c]);
    __builtin_amdgcn_sched_group_barrier(0x100, 4, 1);
#pragma unroll
    for (int i = 0; i < 14; ++i) { __builtin_amdgcn_sched_group_barrier(0x008, 1, 1); __builtin_amdgcn_sched_group_barrier(0x100, 2, 1); }
    __builtin_amdgcn_sched_group_barrier(0x008, 2, 1);
    __builtin_amdgcn_sched_barrier(0);
}
__device__ __forceinline__ void softmax_step(f32x16& p0, f32x16& p1, float& m, float& l, f32x16 (&o)[4]) {
    float mx = p0[0];
#pragma unroll
    for (int i = 1; i < 16; ++i) mx = fmaxf(mx, p0[i]);
#pragma unroll
    for (int i = 0; i < 16; ++i) mx = fmaxf(mx, p1[i]);
    mx = xhalf_max(mx);
    const float mn = fmaxf(m, mx); const float alpha = fast_exp2((m - mn) * LOG2E); m = mn;
    const float mb = mn * LOG2E; float ps = 0.f;
#pragma unroll
    for (int i = 0; i < 16; ++i) { p0[i] = fast_exp2(p0[i] * LOG2E - mb); ps += p0[i]; }
#pragma unroll
    for (int i = 0; i < 16; ++i) { p1[i] = fast_exp2(p1[i] * LOG2E - mb); ps += p1[i]; }
    ps = xhalf_sum(ps);
    l = l * alpha + ps;
    if (!__all(alpha == 1.f)) {
#pragma unroll
        for (int c = 0; c < 4; ++c)
#pragma unroll
            for (int i = 0; i < 16; ++i) o[c][i] *= alpha; }
}
__device__ __forceinline__ void store_ot(const f32x16 (&o)[4], float sc, bf16_t* dst  , int h, bool add) {
#pragma unroll
    for (int c = 0; c < 4; ++c)
#pragma unroll
        for (int g4 = 0; g4 < 4; ++g4) { u32x2* p = (u32x2*)(dst + 32 * c + 8 * g4 + 4 * h);
            float v0 = sc * o[c][4 * g4], v1 = sc * o[c][4 * g4 + 1], v2 = sc * o[c][4 * g4 + 2], v3 = sc * o[c][4 * g4 + 3];
            if (add) { const u32x2 w0 = *p; v0 += bflo(w0.x); v1 += bfhi(w0.x); v2 += bflo(w0.y); v3 += bfhi(w0.y); }
            u32x2 w; w.x = pk2(v0, v1); w.y = pk2(v2, v3); *p = w; }
}

__device__ __forceinline__ void item_sb(Frame& F, KArgs a, int item) {
    LAS unsigned char* L = F.lds;
    const int qb = 7 - (item >> 7), rem = item & 127, b = rem >> 3, hh = rem & 7, t0 = qb * 256;
    const int tid = F.tid, lane = F.lane, wave = F.wave, r = lane & 31, h = lane >> 5;
    const int tq = t0 + 32 * wave + r;
    const bf16_t* P = (const bf16_t*)(F.ws + WS_P); const size_t rowq = (size_t)(b * T + tq);
    const bf16_t* Kb = P + (size_t)(b * T) * NPC + PKSB + hh * HD; const bf16_t* Vb = P + (size_t)(b * T) * NPC + PVSB + hh * HD;
    bf16x8 qf[8];
#pragma unroll
    for (int s = 0; s < 8; ++s) qf[s] = *(const bf16x8*)(P + rowq * NPC + PQS + hh * HD + 16 * s + 8 * h);
    f32x16 o[4];
#pragma unroll
    for (int c = 0; c < 4; ++c)
#pragma unroll
        for (int i = 0; i < 16; ++i) o[c][i] = 0.f;
    float C = 0.f; bool wdone = false;
    volatile LAS unsigned* flags = (volatile LAS unsigned*)(L + AT_MISC);
    Stg st; int j = 4 * qb + 3, buf = 0, it = 0;
    stg_load(st, Kb + (size_t)(64 * j) * NPC, Vb + (size_t)(64 * j) * NPC, NPC, tid);
    __syncthreads();
    stg_write(st, L, tid, 0);
    if (j > 0) stg_load(st, Kb + (size_t)(64 * (j - 1)) * NPC, Vb + (size_t)(64 * (j - 1)) * NPC, NPC, tid);
    for (;;) {
        if (lane == 0) flags[(it & 1) * 8 + wave] = wdone ? 1u : 0u;
        __syncthreads();
        unsigned nd = 0;
#pragma unroll
        for (int w = 0; w < 8; ++w) nd += flags[(it & 1) * 8 + w];
        if (__builtin_amdgcn_readfirstlane(nd) == 8u) break;
        if (j > 0) stg_write(st, L, tid, buf ^ 1);
        if (j > 1) stg_load(st, Kb + (size_t)(64 * (j - 2)) * NPC, Vb + (size_t)(64 * (j - 2)) * NPC, NPC, tid);
        const bool active = !wdone && (64 * j <= t0 + 32 * wave + 30);
        if (active) {
            f32x16 p0, p1; qk_tile(p0, p1, L, buf, qf, r, h);
            float lm0[16], lm1[16];
            const int kb = 64 * j + 4 * h;
#pragma unroll
            for (int i = 0; i < 16; ++i) {
                const int key0 = kb + (i & 3) + 8 * (i >> 2);
                { const float z = p0[i] * QSCALE; const float sp = fmaxf(z, 0.f) + LN2 * fast_log2(1.f + fast_exp2(-fabsf(z) * LOG2E)); const bool cz = key0 < tq; lm0[i] = cz ? -sp : 0.f; p0[i] = z - sp; }
                { const float z = p1[i] * QSCALE; const float sp = fmaxf(z, 0.f) + LN2 * fast_log2(1.f + fast_exp2(-fabsf(z) * LOG2E)); const bool cz = key0 + 32 < tq; lm1[i] = cz ? -sp : 0.f; p1[i] = z - sp; }
            }
            float Tm[2][4], Tr[2][4];
#pragma unroll
            for (int g4 = 0; g4 < 4; ++g4) { Tm[0][g4] = (lm0[4 * g4] + lm0[4 * g4 + 1]) + (lm0[4 * g4 + 2] + lm0[4 * g4 + 3]); Tm[1][g4] = (lm1[4 * g4] + lm1[4 * g4 + 1]) + (lm1[4 * g4 + 2] + lm1[4 * g4 + 3]); }
#pragma unroll
            for (int k = 0; k < 2; ++k)
#pragma unroll
                for (int g4 = 0; g4 < 4; ++g4) Tr[k][g4] = xhalf_get(Tm[k][g4], h);
            float aft[2][4]; float run = C;
#pragma unroll
            for (int G = 15; G >= 0; --G) { const int k = G >> 3, g4 = (G >> 1) & 3, par = G & 1;
                const float tg = (par == 1) ? (h ? Tm[k][g4] : Tr[k][g4]) : (h ? Tr[k][g4] : Tm[k][g4]);
                if (par == 1) { if (h) aft[k][g4] = run; } else { if (!h) aft[k][g4] = run; }
                run += tg; }
            C = run;
#pragma unroll
            for (int g4 = 0; g4 < 4; ++g4) {
                { float ca = aft[0][g4];
#pragma unroll
                  for (int e = 3; e >= 0; --e) { const int i = 4 * g4 + e; const float la = p0[i] + ca; ca += lm0[i]; p0[i] = (kb + e + 8 * g4 < tq) ? fast_exp2(la * LOG2E) : 0.f; } }
                { float ca = aft[1][g4];
#pragma unroll
                  for (int e = 3; e >= 0; --e) { const int i = 4 * g4 + e; const float la = p1[i] + ca; ca += lm1[i]; p1[i] = (kb + 32 + e + 8 * g4 < tq) ? fast_exp2(la * LOG2E) : 0.f; } }
            }
            pv_tile(o, p0, p1, L, buf, lane);
            wdone = __all(C < -104.f);
        }
        if (j == 0) break;
        --j; buf ^= 1; ++it;
    }
    bf16_t* OS = (bf16_t*)(F.ws + WS_OBR) + BW;
    store_ot(o, 1.f, OS + rowq * (3 * BW) + hh * HD, h, false);
}

__device__ __forceinline__ void item_nsa(Frame& F, KArgs a, int item) {
    LAS unsigned char* L = F.lds;
    const int qblk = 31 - (item >> 5), rem = item & 31, b = rem >> 1, g = rem & 1, t0 = qblk * 64;
    const int tid = F.tid, lane = F.lane, wave = F.wave, r = lane & 31, h = lane >> 5, hr = wave >> 1, th = wave & 1;
    const int tl = 32 * th + r, tq = t0 + tl, hq = g * 4 + hr;
    const bf16_t* P = (const bf16_t*)(F.ws + WS_P);
    LAS float* tab = (LAS float*)(L + AT_TAB); LAS float* imp = (LAS float*)(L + AT_IMP); volatile LAS unsigned* selm = (volatile LAS unsigned*)(L + AT_SELM); LAS unsigned* misc = (LAS unsigned*)(L + AT_MISC);
    { const int hh = tid >> 7, dd = tid & 127; tab[tid] = a->in[I_RELB][t5_bucket(dd) * 8 + g * 4 + hh]; }
    if (tid == 0) misc[0] = 0u;
    bf16x8 qf[8];
#pragma unroll
    for (int s = 0; s < 8; ++s) qf[s] = *(const bf16x8*)(P + (size_t)(b * T + tq) * NPC + PQN + hq * HD + 16 * s + 8 * h);
    f32x16 o[4];
    Stg st;
    auto opq = [](int v) { asm volatile("" : "+v"(v)); return v; };
#define NSA_GATE(i) sigmoidf_(bf2f(P[((size_t)(b * T + opq(tq))) * NPC + PGN + hq * 3 + (i)]))
#define NSA_OUT() ((bf16_t*)(F.ws + WS_OBR) + ((size_t)(b * T + opq(tq))) * (3 * BW) + hq * HD)
    {
        const bf16_t* kc = (const bf16_t*)(F.ws + WS_MISC + MISC_KCMP) + (size_t)((b * 2 + g) * 128) * HD; const bf16_t* vc = (const bf16_t*)(F.ws + WS_MISC + MISC_VCMP) + (size_t)((b * 2 + g) * 128) * HD;
        const bool two = qblk >= 16;
        f32x16 pc[4];
        __syncthreads();
        { Stg st1; stg_load(st, kc, vc, HD, tid); if (two) stg_load(st1, kc + 64 * HD, vc + 64 * HD, HD, tid);
          stg_write(st, L, tid, 0); if (two) stg_write(st1, L, tid, 1); }
        __syncthreads();
        qk_tile(pc[0], pc[1], L, 0, qf, r, h);
        if (two) qk_tile(pc[2], pc[3], L, 1, qf, r, h);
        float mx = -1e30f;
#pragma unroll
        for (int k = 0; k < 4; ++k) { if (k >= 2 && !two) break;
#pragma unroll
            for (int i = 0; i < 16; ++i) { const int n = 32 * k + crow(i, h); const int dc = tq - (16 * n + 31); const int di = dc < 113 ? dc : 113;
                const float sv = dc >= 0 ? pc[k][i] + tab[hr * 128 + (di < 0 ? 0 : di)] : -__builtin_inff(); pc[k][i] = sv; mx = fmaxf(mx, sv); } }
        mx = xhalf_max(mx);
        float sum = 0.f;
#pragma unroll
        for (int k = 0; k < 4; ++k) { if (k >= 2 && !two) break;
#pragma unroll
            for (int i = 0; i < 16; ++i) { const float e = fast_exp2((pc[k][i] - mx) * LOG2E); pc[k][i] = e; sum += e; } }
        sum = xhalf_sum(sum);
        const float inv = 1.f / fmaxf(sum, 1e-30f);
#pragma unroll
        for (int k = 0; k < 4; ++k)
#pragma unroll
            for (int i = 0; i < 16; ++i) pc[k][i] = (k >= 2 && !two) ? 0.f : pc[k][i] * inv;
        float gs[16], gl[16], rc[16];
#pragma unroll
        for (int k = 0; k < 4; ++k)
#pragma unroll
            for (int g4 = 0; g4 < 4; ++g4) { gs[4 * k + g4] = (pc[k][4 * g4] + pc[k][4 * g4 + 1]) + (pc[k][4 * g4 + 2] + pc[k][4 * g4 + 3]); gl[4 * k + g4] = pc[k][4 * g4 + 3]; }
#pragma unroll
        for (int f = 0; f < 16; ++f) rc[f] = xhalf_get(gl[f], h);
#pragma unroll
        for (int f = 0; f < 16; ++f) { const float prev = h ? rc[f] : (f >= 1 ? rc[f - 1] : 0.f); const int G = 8 * (f >> 2) + 2 * (f & 3) + h;
            imp[(hr * 64 + tl) * 33 + G] = gs[f] + prev; }
#pragma unroll
        for (int c = 0; c < 4; ++c)
#pragma unroll
            for (int i = 0; i < 16; ++i) o[c][i] = 0.f;
        pv_tile(o, pc[0], pc[1], L, 0, lane);
        if (two) pv_tile(o, pc[2], pc[3], L, 1, lane);
        store_ot(o, NSA_GATE(0), NSA_OUT(), h, false);
    }
    __syncthreads();
    const int tk = tid >> 3, part = tid & 7;
    if (qblk >= 16) {
#pragma unroll
        for (int q = 0; q < 4; ++q) { const int jj = part + 8 * q; imp[tk * 33 + jj] = (imp[tk * 33 + jj] + imp[(64 + tk) * 33 + jj]) + (imp[(128 + tk) * 33 + jj] + imp[(192 + tk) * 33 + jj]); }
    }
    __syncthreads();
    {
        unsigned msk;
        if (qblk < 16) msk = (2u << qblk) - 1u;
        else {
            msk = 0u;
#pragma unroll
            for (int q = 0; q < 4; ++q) { const int jj = part + 8 * q;
                if (jj >= 1 && jj <= qblk - 2) { const float v = imp[tk * 33 + jj]; int rank = 0;
#pragma unroll
                    for (int j2 = 1; j2 < 30; ++j2) { const float v2 = imp[tk * 33 + j2]; rank += (j2 <= qblk - 2 && (v2 > v || (v2 == v && j2 < jj))) ? 1 : 0; }
                    if (rank < 13) msk |= 1u << jj; } }
            msk |= (unsigned)__shfl_xor((int)msk, 1); msk |= (unsigned)__shfl_xor((int)msk, 2); msk |= (unsigned)__shfl_xor((int)msk, 4);
            msk |= 1u | (1u << (qblk - 1)) | (1u << qblk);
        }
        if (part == 0) selm[tk] = msk;
        unsigned om = msk;
#pragma unroll
        for (int off = 8; off < 64; off <<= 1) om |= (unsigned)__shfl_xor((int)om, off);
        if (lane == 0) __hip_atomic_fetch_or(misc, om, __ATOMIC_RELAXED, __HIP_MEMORY_SCOPE_WORKGROUP);
    }
    __syncthreads();
    const bf16_t* Kbase = P + (size_t)(b * T) * NPC + g * HD;
    const float bfar = tab[hr * 128 + 113];
    for (int rep = 0; rep < (MK_PROBE == 31 ? 2 : 1); ++rep) {
        if (rep) __syncthreads();
        unsigned om = __builtin_amdgcn_readfirstlane(misc[0]); const unsigned mym = selm[tl];
        float m = -1e30f, l = 0.f;
#pragma unroll
        for (int c = 0; c < 4; ++c)
#pragma unroll
            for (int i = 0; i < 16; ++i) o[c][i] = 0.f;
        int jc = __builtin_ctz(om); om &= om - 1u;
        stg_load(st, Kbase + PKS + (size_t)(64 * jc) * NPC, Kbase + PVS + (size_t)(64 * jc) * NPC, NPC, tid);
        stg_write(st, L, tid, 0);
        int jn = om ? __builtin_ctz(om) : -1; if (jn >= 0) { om &= om - 1u; stg_load(st, Kbase + PKS + (size_t)(64 * jn) * NPC, Kbase + PVS + (size_t)(64 * jn) * NPC, NPC, tid); }
        int buf = 0;
        for (;;) {
            __syncthreads();
            if (jn >= 0) stg_write(st, L, tid, buf ^ 1);
            const int jnn = om ? __builtin_ctz(om) : -1; if (jnn >= 0) { om &= om - 1u; stg_load(st, Kbase + PKS + (size_t)(64 * jnn) * NPC, Kbase + PVS + (size_t)(64 * jnn) * NPC, NPC, tid); }
            f32x16 p0, p1; qk_tile(p0, p1, L, buf, qf, r, h);
            const bool sel = (mym >> jc) & 1u;
            if (jc <= qblk - 3) {
#pragma unroll
                for (int i = 0; i < 16; ++i) { p0[i] = sel ? p0[i] + bfar : -__builtin_inff(); p1[i] = sel ? p1[i] + bfar : -__builtin_inff(); }
            } else {
#pragma unroll
                for (int i = 0; i < 16; ++i) { const int d0 = tq - (64 * jc + crow(i, h)), d1 = d0 - 32;
                    const float b0 = tab[hr * 128 + (d0 < 0 ? 0 : (d0 > 113 ? 113 : d0))], b1 = tab[hr * 128 + (d1 < 0 ? 0 : (d1 > 113 ? 113 : d1))];
                    p0[i] = (sel && d0 >= 0) ? p0[i] + b0 : -__builtin_inff(); p1[i] = (sel && d1 >= 0) ? p1[i] + b1 : -__builtin_inff(); }
            }
            softmax_step(p0, p1, m, l, o);
            pv_tile(o, p0, p1, L, buf, lane);
            if (jn < 0) break;
            jc = jn; jn = jnn; buf ^= 1;
        }
        if (rep == (MK_PROBE == 31 ? 1 : 0)) store_ot(o, NSA_GATE(1) / l, NSA_OUT(), h, true);
    }
    for (int rep = 0; rep < (MK_PROBE == 32 ? 2 : 1); ++rep) {
        float m = -1e30f, l = 0.f;
#pragma unroll
        for (int c = 0; c < 4; ++c)
#pragma unroll
            for (int i = 0; i < 16; ++i) o[c][i] = 0.f;
        int jc = qblk >= 8 ? qblk - 8 : 0;
        stg_load(st, Kbase + PKW + (size_t)(64 * jc) * NPC, Kbase + PVW + (size_t)(64 * jc) * NPC, NPC, tid);
        __syncthreads();
        stg_write(st, L, tid, 0);
        if (jc < qblk) stg_load(st, Kbase + PKW + (size_t)(64 * (jc + 1)) * NPC, Kbase + PVW + (size_t)(64 * (jc + 1)) * NPC, NPC, tid);
        int buf = 0;
        for (;;) {
            __syncthreads();
            if (jc < qblk) stg_write(st, L, tid, buf ^ 1);
            if (jc + 1 < qblk) stg_load(st, Kbase + PKW + (size_t)(64 * (jc + 2)) * NPC, Kbase + PVW + (size_t)(64 * (jc + 2)) * NPC, NPC, tid);
            f32x16 p0, p1; qk_tile(p0, p1, L, buf, qf, r, h);
            if (jc <= qblk - 3 && jc >= qblk - 7) {
#pragma unroll
                for (int i = 0; i < 16; ++i) { p0[i] += bfar; p1[i] += bfar; }
            } else {
                const bool far = jc <= qblk - 3;
#pragma unroll
                for (int i = 0; i < 16; ++i) { const int d0 = tq - (64 * jc + crow(i, h)), d1 = d0 - 32;
                    const float b0 = far ? bfar : tab[hr * 128 + (d0 < 0 ? 0 : (d0 > 113 ? 113 : d0))], b1 = far ? bfar : tab[hr * 128 + (d1 < 0 ? 0 : (d1 > 113 ? 113 : d1))];
                    p0[i] = ((unsigned)d0 < 512u) ? p0[i] + b0 : -__builtin_inff(); p1[i] = ((unsigned)d1 < 512u) ? p1[i] + b1 : -__builtin_inff(); }
            }
            softmax_step(p0, p1, m, l, o);
            pv_tile(o, p0, p1, L, buf, lane);
            if (jc == qblk) break;
            ++jc; buf ^= 1;
        }
        if (rep == (MK_PROBE == 32 ? 1 : 0)) store_ot(o, NSA_GATE(2) / l, NSA_OUT(), h, true);
    }
#undef NSA_GATE
#undef NSA_OUT
}

constexpr int NI_H = 256, NI_S = 1024, NI_C = 256, NI_N = 512, NI_A = 1024, NI_F = 512;
#define FRESH_F() do { unsigned on_ = ~0u; asm volatile("" : "+s"(on_)); int t_ = F.wave * 64 + (int)__builtin_amdgcn_mbcnt_hi(on_, __builtin_amdgcn_mbcnt_lo(on_, 0u)); asm volatile("" : "+v"(t_)); F.tid = t_; F.lane = t_ & 63; F.wave = __builtin_amdgcn_readfirstlane(t_ >> 6); } while (0)
__device__ __forceinline__ void phase_Ca(Frame& F, KArgs a, int layer, int bank, int types) {
    unsigned* head = F.ctl + CW_QUEUE + 64 * (layer * 8) + bank * 4096;
    if (types & 1) for (;;) { const int it = q_next(F, head + 0); if (it >= NI_H) break; FRESH_F(); item_hgrn(F, a, layer, it); }
    if (types & 2) for (;;) { const int it = q_next(F, head + 64); if (it >= NI_S) break; FRESH_F(); item_sb(F, a, it); }
    if (types & 4) for (;;) { const int it = q_next(F, head + 128); if (it >= NI_C) break; FRESH_F(); item_compress(F, a, layer, it); }
    if (types & 8) for (;;) { const int it = q_next(F, head + 192); if (it >= NI_N) break; FRESH_F(); item_norm(F, a, layer, it); }
}
__device__ __forceinline__ void phase_Cb(Frame& F, KArgs a, int layer, int bank) {
    unsigned* head = F.ctl + CW_QUEUE + 64 * (layer * 8 + 4) + bank * 4096;
    for (;;) { const int it = q_next(F, head + 0); if (it >= NI_A) break; FRESH_F(); item_nsa(F, a, it); }
    if (MK_PROBE == 34 && bank == 0) for (;;) { const int it = q_next(F, head + 192); if (it >= NI_F) break; FRESH_F(); item_hgfin(F, a, layer, it); }
    for (;;) { const int it = q_next(F, head + 64); if (it >= NI_F) break; FRESH_F(); item_hgfin(F, a, layer, it); }
}

__global__ void __launch_bounds__(512, 2) mega(Args karg) {
    extern __shared__ __attribute__((aligned(16))) unsigned char lds_raw[];
    Frame F;
    F.lds = (LAS unsigned char*)lds_raw; F.MISC = (volatile LAS unsigned*)(F.lds + MISC_OFF);
    F.tid = threadIdx.x; F.lane = F.tid & 63; F.wave = __builtin_amdgcn_readfirstlane(F.tid >> 6); F.G = gridDim.x; F.bid = blockIdx.x;
    KArgs a = (KArgs)__builtin_amdgcn_kernarg_segment_ptr();
    F.ws = a->ws; F.ctl = (unsigned*)(a->ws + WS_CTL);
    if (F.tid < 64) F.MISC[F.tid] = 0u;
    __syncthreads();
    const int lo = karg.ph_lo, hi = karg.ph_hi;
    XcdBarrier bar; bar.bar = F.ctl + CW_BAR; bar.x = 0; bar.st = F.MISC + 8;
    if (hi - lo > 1) bar = xcd_barrier_post(F.ctl + CW_BAR, F.MISC + 8);
#define IN(k) (lo <= (k) && (k) < hi)
#define ON(k) (((MK_PHASE_MASK & MK_BUILD_MASK) >> (k)) & 1)
#define GRID_BAR() do { unsigned* bp_ = (unsigned*)(a->ws + WS_CTL) + CW_BAR; asm volatile("" : "+s"(bp_)); bar.bar = bp_; xcd_barrier(bar); } while (0)
#define SEAM(k) do { if (IN(k) && IN((k) + 1)) GRID_BAR(); } while (0)
    bf16_t* Hb; bf16_t* Pb; const int wave_s = __builtin_amdgcn_readfirstlane(threadIdx.x >> 6);
    for (int layer = 0; layer < DEPTH; ++layer) {
        const int pb = layer * 10;
#define FRESH() do { unsigned on_ = ~0u; asm volatile("" : "+s"(on_)); int t_ = wave_s * 64 + (int)__builtin_amdgcn_mbcnt_hi(on_, __builtin_amdgcn_mbcnt_lo(on_, 0u)); asm volatile("" : "+v"(t_)); F.tid = t_; F.lane = t_ & 63; F.wave = __builtin_amdgcn_readfirstlane(t_ >> 6); \
        asm volatile("" : "+s"(a)); F.ws = a->ws; F.ctl = (unsigned*)(a->ws + WS_CTL); Hb = (bf16_t*)(F.ws + WS_H); Pb = (bf16_t*)(F.ws + WS_P); } while (0)
        if (ON(0) && IN(pb + 0)) { FRESH(); if (MK_PROBE == 0) { phase_A(F, a, layer); GRID_BAR(); } phase_A(F, a, layer); } SEAM(pb + 0);
        if (ON(1) && IN(pb + 1)) for (int rep = 0; rep < (MK_PROBE == 1 ? 2 : 1); ++rep) { FRESH();
            if (rep) GRID_BAR();
            if (MK_STAGGER) { const unsigned long long t0 = __builtin_amdgcn_s_memrealtime(), dl = (unsigned long long)((F.bid >> 3) & 7) * MK_STAGGER; while (__builtin_amdgcn_s_memrealtime() - t0 < dl) __builtin_amdgcn_s_sleep(4); }
            pg8::Gemm g{(const bf16_t*)(F.ws + WS_XB), (const bf16_t*)(F.ws + WS_WIN), M, NPC, DM}; pg8::StaticOrder S; S.init(M, NPC, F.G, F.bid);
            pg8::EpiStoreBf16 E{Pb, NPC, PGT / 256, PGN / 256, (const float*)(F.ws + WS_RSTD)};
            pg8::gemm_phase<pg8::EpiStoreBf16, pg8::StaticOrder, PG8_ALIGN, PG8_SP2>(F.lds, g, S, E, F.tid, (MK_DIAG && layer == 0 && F.bid == 0) ? (unsigned long long*)(F.ctl + 49152) : nullptr);
        } SEAM(pb + 1);
        if (ON(2) && IN(pb + 2)) { FRESH(); if (MK_PROBE >= 20 && MK_PROBE < 28) { phase_Ca(F, a, layer, 1, MK_PROBE - 20); GRID_BAR(); } phase_Ca(F, a, layer, 0, 15); } SEAM(pb + 2);
        if (ON(3) && IN(pb + 3)) { FRESH(); if (MK_PROBE == 3) { phase_Cb(F, a, layer, 1); GRID_BAR(); } phase_Cb(F, a, layer, 0); } SEAM(pb + 3);
        if (ON(4) && IN(pb + 4)) for (int rep = 0; rep < (MK_PROBE == 4 ? 2 : 1); ++rep) { FRESH();
            if (rep) GRID_BAR();
            pg8::Gemm g{(const bf16_t*)(F.ws + WS_OBR), (const bf16_t*)(F.ws + WS_WBR), M, DM, 3 * BW}; pg8::StaticOrder S; S.init(M, DM, F.G, F.bid);
            pg8::EpiGated E{Pb, Hb};
            pg8::gemm_phase<pg8::EpiGated, pg8::StaticOrder, PG8_ALIGN, PG8_SP2>(F.lds, g, S, E, F.tid);
        } SEAM(pb + 4);
        if (ON(5) && IN(pb + 5)) { FRESH();
            pg8::Gemm g{Hb, (const bf16_t*)(F.ws + WS_WOUT), M, DM, DM}; pg8::StaticOrder S; S.init(M, DM, F.G, F.bid);
            pg8::EpiResidBf16 E{(bf16_t*)(F.ws + WS_XB), nullptr, (float*)(F.ws + WS_SSQ), DM};
            pg8::gemm_phase<pg8::EpiResidBf16, pg8::StaticOrder, PG8_ALIGN, PG8_SP2>(F.lds, g, S, E, F.tid);
        } SEAM(pb + 5);
        if (ON(6) && IN(pb + 6)) { FRESH(); phase_F(F, a); } SEAM(pb + 6);
        if (ON(7) && IN(pb + 7)) for (int rep = 0; rep < (MK_PROBE == 7 ? 2 : 1); ++rep) { FRESH();
            if (rep) GRID_BAR();
            if (MK_STAGGER) { const unsigned long long t0 = __builtin_amdgcn_s_memrealtime(), dl = (unsigned long long)((F.bid >> 3) & 7) * MK_STAGGER; while (__builtin_amdgcn_s_memrealtime() - t0 < dl) __builtin_amdgcn_s_sleep(4); }
            pg8::Gemm g{(const bf16_t*)(F.ws + WS_XB), (const bf16_t*)(F.ws + WS_WUP), M, NUP, DM}; pg8::StaticOrder S; S.init(M, NUP, F.G, F.bid);
            pg8::EpiConvAct E{(bf16_t*)(F.ws + WS_ACT), (bf16_t*)(F.ws + WS_USIDE), (const float*)(F.ws + WS_RSTD), a->in[I_CONVW] + (size_t)layer * 3 * NUP, a->in[I_CONVB] + (size_t)layer * NUP};
            pg8::gemm_phase<pg8::EpiConvAct, pg8::StaticOrder, PG8_ALIGN, PG8_SP2>(F.lds, g, S, E, F.tid);
        } SEAM(pb + 7);
        if (ON(8) && IN(pb + 8)) { FRESH(); if (MK_PROBE == 8) { phase_H(F, a, layer); GRID_BAR(); } phase_H(F, a, layer); } SEAM(pb + 8);
        if (ON(9) && IN(pb + 9)) { FRESH();
            pg8::Gemm g{(const bf16_t*)(F.ws + WS_ACT), (const bf16_t*)(F.ws + WS_WDN), M, DM, DFF}; pg8::StaticOrder S; S.init(M, DM, F.G, F.bid, 4, 1);
            pg8::EpiResidBf16 E{(bf16_t*)(F.ws + WS_XB), layer == DEPTH - 1 ? a->out : nullptr, (float*)(F.ws + WS_SSQ), DM};
            pg8::gemm_phase<pg8::EpiResidBf16, pg8::StaticOrder, PG8_ALIGN, PG8_SP2>(F.lds, g, S, E, F.tid);
        } SEAM(pb + 9);
    }
#if MK_DIAG
    GRID_BAR();
    { const unsigned long long* dg = (const unsigned long long*)(F.ctl + 49152); const float kl = (float)(long long)(dg[1] - dg[0]), per = (float)(long long)(dg[2] - dg[0]);
      const float eps = MK_DIAG == 1 ? kl / per : (MK_DIAG == 2 ? per * 1e-4f : kl * 1e-4f);
      for (size_t i = (size_t)F.bid * 512 + threadIdx.x; i < (size_t)M * DM; i += (size_t)F.G * 512) a->out[i] *= (1.f + eps); }
#endif
}

extern "C" void kernel_launch(void* const* d_in, const int* in_sizes, int n_in, void* d_out, int out_size, void* d_ws, size_t ws_size, hipStream_t stream) {
    static int grid = 0;
    if (grid == 0) {
        if (n_in != 18 || in_sizes[0] != M * DM || out_size != M * DM || ws_size < WS_END) { fprintf(stderr, "kernel_launch: unexpected shapes / workspace (%d inputs, ws %zu)\n", n_in, ws_size); grid = -1; return; }
        int dev = 0, cus = 0, per_cu = 0;
        if (hipGetDevice(&dev) != hipSuccess || hipDeviceGetAttribute(&cus, hipDeviceAttributeMultiprocessorCount, dev) != hipSuccess) { grid = -1; return; }
        if (hipFuncSetAttribute((const void*)mega, hipFuncAttributeMaxDynamicSharedMemorySize, LDS_BYTES) != hipSuccess) { grid = -1; return; }
        if (hipOccupancyMaxActiveBlocksPerMultiprocessor(&per_cu, (const void*)mega, 512, LDS_BYTES) != hipSuccess || per_cu < 1) { fprintf(stderr, "kernel_launch: occupancy query says %d\n", per_cu); }
        (void)hipGetLastError();
        grid = cus;
    }
    if (grid < 0) return;
    (void)hipMemsetAsync((char*)d_ws + WS_CTL, 0, CTL_BYTES, stream);
    Args a{};
    for (int i = 0; i < 18; ++i) a.in[i] = (const float*)d_in[i];
    a.out = (float*)d_out; a.ws = (unsigned char*)d_ws;
#if MK_ONE_LAUNCH
    a.ph_lo = 0; a.ph_hi = DEPTH * 10;
    hipLaunchKernelGGL(mega, dim3(grid), dim3(512), LDS_BYTES, stream, a);
#else
    for (int p = 0; p < DEPTH * 10; ++p) { a.ph_lo = p; a.ph_hi = p + 1; hipLaunchKernelGGL(mega, dim3(grid), dim3(512), LDS_BYTES, stream, a); }
#endif
}
```

```cpp
#include <hip/hip_runtime.h>
#include <stdint.h>
#include <stdio.h>

#ifndef MK_ONE_LAUNCH
#define MK_ONE_LAUNCH 1
#endif
#ifndef MK_PHASE_MASK
#define MK_PHASE_MASK 0x3ff
#endif
#ifndef MK_PROBE
#define MK_PROBE -1
#endif
#ifndef MK_STAGGER
#define MK_STAGGER 0
#endif
#ifndef MK_DIAG
#define MK_DIAG 0
#endif
#ifndef MK_BUILD_MASK
#define MK_BUILD_MASK 0x3ff
#endif

#define LAS __attribute__((address_space(3)))
typedef unsigned short bf16_t;
typedef short bf16x8 __attribute__((ext_vector_type(8)));
typedef short s16x4 __attribute__((ext_vector_type(4)));
typedef float f32x4 __attribute__((ext_vector_type(4)));
typedef float f32x16 __attribute__((ext_vector_type(16)));
typedef float f32x2 __attribute__((ext_vector_type(2)));
typedef unsigned u32x4 __attribute__((ext_vector_type(4)));
typedef unsigned u32x2 __attribute__((ext_vector_type(2)));
typedef __bf16 bfv2 __attribute__((ext_vector_type(2)));

constexpr int DM = 2048, NB = 16, T = 2048, DEPTH = 4, M = NB * T, HD = 128;
constexpr int INC = 15896;
constexpr int NPC = 16128;
constexpr int PQN = 0, PKC = 1024, PVC = 1280, PKS = 1536, PVS = 1792, PKW = 2048, PVW = 2304, PQS = 2560, PKSB = 3584, PVSB = 4608,
              PQH = 5632, PFH = 6656, PIH = 7680, PGH = 8704, PGT = 9728, PGN = 15872;
constexpr int DFF = 5632, NUP = 2 * DFF;
constexpr int BW = 1024;
constexpr float EPS = 1e-6f;
constexpr float LOG2E = 1.4426950408889634f, LN2 = 0.6931471805599453f;
constexpr float QSCALE = 0.08838834764831845f;

constexpr size_t MiB = 1u << 20;
constexpr size_t WS_CTL = 0, CTL_BYTES = 1 * MiB;
constexpr size_t WS_WIN = 1 * MiB, WS_WBR = 64 * MiB, WS_WOUT = 76 * MiB, WS_WUP = 84 * MiB, WS_WDN = 128 * MiB;
constexpr size_t WS_MISC = 150 * MiB;
constexpr size_t MISC_KCMP = 0, MISC_VCMP = 1 * MiB, MISC_WC1 = 2 * MiB;
constexpr int CW_CVEC = 32768;
constexpr size_t WS_SCR = 154 * MiB;
constexpr size_t WS_P = 218 * MiB;
constexpr size_t WS_H = 1226 * MiB;
constexpr size_t WS_OBR = 1354 * MiB;
constexpr size_t WS_ORAW = 1546 * MiB;
constexpr size_t WS_XB = 1674 * MiB;
constexpr size_t WS_SSQ = 1802 * MiB;
constexpr size_t WS_RSTD = 1806 * MiB;
constexpr size_t WS_USIDE = 1807 * MiB;
constexpr size_t WS_END = 1853 * MiB;
constexpr size_t WS_ACT = WS_P + 704 * MiB;
constexpr int CW_BAR = 4096;
constexpr int CW_QUEUE = 16384;

constexpr int RING_BYTES = 131072;
constexpr int MISC_OFF = RING_BYTES;
constexpr int LDS_BYTES = 147456;

__device__ __forceinline__ float bf2f(unsigned short b) { return __uint_as_float(((unsigned)b) << 16); }
__device__ __forceinline__ float bflo(unsigned w) { return __uint_as_float(w << 16); }
__device__ __forceinline__ float bfhi(unsigned w) { return __uint_as_float(w & 0xffff0000u); }
__device__ __forceinline__ unsigned pk2(float lo, float hi) { f32x2 v = {lo, hi}; bfv2 b = __builtin_convertvector(v, bfv2); return __builtin_bit_cast(unsigned, b); }
__device__ __forceinline__ float wave_sum(float v) {
#pragma unroll
    for (int o = 1; o < 64; o <<= 1) v += __shfl_xor(v, o);
    return v;
}
__device__ __forceinline__ float fast_exp2(float x) { return __builtin_amdgcn_exp2f(x); }
__device__ __forceinline__ float fast_log2(float x) { return __builtin_amdgcn_logf(x); }
__device__ __forceinline__ float fast_rcp(float x) { return __builtin_amdgcn_rcpf(x); }
__device__ __forceinline__ float sigmoidf_(float x) { return fast_rcp(1.f + fast_exp2(-x * LOG2E)); }
#define LDS_WAIT() asm volatile("s_waitcnt lgkmcnt(0)" ::: "memory")

#define XB_TMO      128
#define XB_XCNT(j)  (256  + 64 * (j))
#define XB_XSUB(j)  (1280 + 64 * (j))
#define XB_XGEN(j)  (2304 + 64 * (j))
#define XB_TOP      3328
#define XB_TOPGEN   3392
#define XCD_BAR_WORDS 3456
#define XB_SPIN_CAP (1u << 22)
__device__ __forceinline__ unsigned xb_ld(unsigned* p)              { return __hip_atomic_load(p, __ATOMIC_RELAXED, __HIP_MEMORY_SCOPE_AGENT); }
__device__ __forceinline__ unsigned xb_add(unsigned* p, unsigned v) { return __hip_atomic_fetch_add(p, v, __ATOMIC_RELAXED, __HIP_MEMORY_SCOPE_AGENT); }
__device__ __forceinline__ unsigned xb_xcc_id() { return (unsigned)__builtin_amdgcn_s_getreg((3 << 11) | 20) & 0xFu; }
#define XB_SPIN(cond, bar) do { unsigned _sp = 0; while (cond) { __builtin_amdgcn_s_sleep(1); \
    if ((++_sp & 255u) == 0u) { if (xb_ld(&(bar)[XB_TMO])) break; if (_sp > XB_SPIN_CAP) { atomicAdd(&(bar)[XB_TMO], 1u); break; } } } } while (0)
struct XcdBarrier { unsigned* bar; unsigned x; volatile LAS unsigned* st; };
__device__ __forceinline__ XcdBarrier xcd_barrier_post(unsigned* bar, volatile LAS unsigned* st) {
    XcdBarrier b; b.bar = bar; b.x = xb_xcc_id(); b.st = st;
    if (threadIdx.x == 0) (void)xb_add(&bar[XB_XCNT(b.x)], 1u);
    return b;
}
__device__ __forceinline__ void xcd_barrier_complete(unsigned* bar, unsigned x, unsigned& nloc, unsigned& nx) {
    const unsigned G = gridDim.x * gridDim.y * gridDim.z;
    unsigned sum, cnt, mine, sp = 0u;
    for (;;) {
        sum = 0u; cnt = 0u; mine = 0u;
#pragma unroll
        for (unsigned j = 0; j < 16; ++j) { const unsigned c = xb_ld(&bar[XB_XCNT(j)]); sum += c; cnt += (c > 0u) ? 1u : 0u; mine = (j == x) ? c : mine; }
        if (sum == G) break;
        __builtin_amdgcn_s_sleep(1);
        if ((++sp & 255u) == 0u) { if (xb_ld(&bar[XB_TMO])) break; if (sp > XB_SPIN_CAP) { atomicAdd(&bar[XB_TMO], 1u); break; } }
    }
    nloc = mine > 0u ? mine : 1u; nx = cnt > 0u ? cnt : 1u;
}
__device__ __forceinline__ void xcd_barrier(const XcdBarrier& b) {
    asm volatile("s_waitcnt vmcnt(0)" ::: "memory");
    __syncthreads();
    if (threadIdx.x == 0) {
        unsigned* bar = b.bar;
        __builtin_amdgcn_s_waitcnt(0);
        unsigned nloc = b.st[0], nx = b.st[1];
        if (nloc == 0u) { xcd_barrier_complete(bar, b.x, nloc, nx); b.st[0] = nloc; b.st[1] = nx; }
        const unsigned old = xb_add(&bar[XB_XSUB(b.x)], 1u);
        const unsigned gen = old / nloc;
        if (old + 1u == (gen + 1u) * nloc) {
            __builtin_amdgcn_fence(__ATOMIC_RELEASE, "agent");
            asm volatile("s_waitcnt vmcnt(0)" ::: "memory");
            const unsigned og = xb_add(&bar[XB_TOP], 1u);
            const unsigned tg = og / nx;
            if (og + 1u == (tg + 1u) * nx) xb_add(&bar[XB_TOPGEN], 1u);
            else XB_SPIN(xb_ld(&bar[XB_TOPGEN]) == tg, bar);
            __builtin_amdgcn_fence(__ATOMIC_ACQUIRE, "agent");
            xb_add(&bar[XB_XGEN(b.x)], 1u);
            asm volatile("s_waitcnt vmcnt(0)" ::: "memory");
        } else {
            XB_SPIN(xb_ld(&bar[XB_XGEN(b.x)]) == gen, bar);
            __builtin_amdgcn_fence(__ATOMIC_ACQUIRE, "agent");
            asm volatile("s_waitcnt vmcnt(0)" ::: "memory");
        }
    }
    __syncthreads();
}

namespace pg8 {
constexpr int BM = 256, BK = 64, HALF = 128, HTB = HALF * BK * 2, STAGE_BYTES = 8 * HTB, NXCD = 8;
__host__ __device__ __forceinline__ int lds_byte(int r, int c) { const int st = (r >> 4) * 2 + (c >> 5), rr = r & 15, cc = c & 31, ob = rr * 64 + cc * 2; return st * 1024 + (ob ^ (((ob >> 9) & 1) << 5)); }
__host__ __device__ __forceinline__ void stage_rc(int b, int& R, int& C) { const int st = b / 1024, sb = b % 1024, swz = sb ^ (((sb >> 9) & 1) << 5); R = (st >> 1) * 16 + swz / 64; C = (st & 1) * 32 + (swz % 64) / 2; }
__host__ __device__ __forceinline__ int perm32(int rho) { const int n = rho >> 4, i = rho & 15; return 8 * (i >> 2) + 4 * n + (i & 3); }
struct Unit { int pm, pn, aux; };
struct Gemm { const bf16_t* A; const bf16_t* Bt; int M, N, K; int akm; };
struct StaticOrder {
    int nM, nN, nwg, G, c, WGM, rev;
    int pad_;
    __device__ void init(int M_, int N_, int G_, int c_, int wgm = 4, int rev_ = 0) { nM = M_ / BM; nN = N_ / BM; nwg = nM * nN; G = G_; c = c_; WGM = wgm; rev = rev_; pad_ = 0; }
    __device__ __forceinline__ bool tile(long L, Unit& u) const {
        if (L >= nwg) return false;
        int wgid = (int)L; { const int q = nwg / NXCD, r = nwg % NXCD, xcd = wgid % NXCD, off = wgid / NXCD; wgid = (xcd < r ? xcd * (q + 1) : r * (q + 1) + (xcd - r) * q) + off; }
        const int nig = WGM * nN, gid = wgid / nig, fm = gid * WGM, gsz = (nM - fm) < WGM ? (nM - fm) : WGM;
        u.pm = fm + ((wgid % nig) % gsz); u.pn = (wgid % nig) / gsz; u.aux = 0; if (rev) u.pm = nM - 1 - u.pm; return true;
    }
    __device__ __forceinline__ bool next(int i, Unit& u) const { return tile((long)i * G + c, u); }
    __device__ __forceinline__ const char* aptr(const Gemm& g, const Unit& u, size_t tstep) const { return (const char*)g.A + (size_t)u.pm * tstep; }
    __device__ __forceinline__ const char* bptr(const Gemm& g, const Unit& u, size_t tstep) const { return (const char*)g.Bt + (size_t)u.pn * tstep; }
    __device__ __forceinline__ void a_ready(const Unit&) const {}
    __device__ __forceinline__ void done(const Unit&) const {}
};
struct EpiStoreBf16 {
    static constexpr bool PERM = true, AFTER_DRAIN = false;
    bf16_t* O; int ldc; int sg_lo, sg_hi; const float* rs;
    __device__ __forceinline__ void operator()(const f32x4 (&acc)[2][2][4][2], const Unit& u, int wr, int wc, int fr, int fq) const {
        const int row0 = u.pm * BM + wr * 64 + fr, col0 = u.pn * BM + wc * 32 + 8 * fq; const bool sg = u.pn >= sg_lo && u.pn < sg_hi;
        float rsv[8];
#pragma unroll
        for (int g = 0; g < 8; ++g) rsv[g] = rs[row0 + (g >> 2) * HALF + (g & 3) * 16];
#pragma unroll
        for (int ai = 0; ai < 2; ++ai)
#pragma unroll
            for (int m = 0; m < 4; ++m) { bf16_t* rowp = O + (size_t)(row0 + ai * HALF + m * 16) * ldc + col0;
#pragma unroll
                for (int bj = 0; bj < 2; ++bj) { f32x4 v0 = acc[ai][bj][m][0] * rsv[ai * 4 + m], v1 = acc[ai][bj][m][1] * rsv[ai * 4 + m];
                    if (sg) {
#pragma unroll
                        for (int e = 0; e < 4; ++e) { v0[e] = sigmoidf_(v0[e]); v1[e] = sigmoidf_(v1[e]); } }
                    u32x4 w; w.x = pk2(v0[0], v0[1]); w.y = pk2(v0[2], v0[3]); w.z = pk2(v1[0], v1[1]); w.w = pk2(v1[2], v1[3]);
                    __builtin_nontemporal_store(w, (u32x4*)(rowp + bj * HALF)); } }
    }
};
struct EpiConvAct {
    static constexpr bool PERM = true, AFTER_DRAIN = false;
    bf16_t* ACT; bf16_t* side; const float* rs; const float* cw; const float* cb;
    __device__ __forceinline__ void operator()(const f32x4 (&acc)[2][2][4][2], const Unit& u, int wr, int wc, int fr, int fq) const {
        const int row0 = u.pm * BM + wr * 64 + fr, ch0 = u.pn * 128 + wc * 32 + 8 * fq;
        float rsv[8];
#pragma unroll
        for (int g = 0; g < 8; ++g) rsv[g] = rs[row0 + (g >> 2) * HALF + (g & 3) * 16];
#pragma unroll
        for (int n = 0; n < 2; ++n) {
            const f32x4 wg0 = *(const f32x4*)(cw + ch0 + 4 * n), wg1 = *(const f32x4*)(cw + NUP + ch0 + 4 * n), wg2 = *(const f32x4*)(cw + 2 * NUP + ch0 + 4 * n), bg = *(const f32x4*)(cb + ch0 + 4 * n);
            const f32x4 wv0 = *(const f32x4*)(cw + DFF + ch0 + 4 * n), wv1 = *(const f32x4*)(cw + NUP + DFF + ch0 + 4 * n), wv2 = *(const f32x4*)(cw + 2 * NUP + DFF + ch0 + 4 * n), bv = *(const f32x4*)(cb + DFF + ch0 + 4 * n);
#pragma unroll
            for (int ai = 0; ai < 2; ++ai) {
                float act[4][4];
#pragma unroll
                for (int e = 0; e < 4; ++e) {
                    float pg1 = 0.f, pg2 = 0.f, pv1 = 0.f, pv2 = 0.f;
#pragma unroll
                    for (int m = 0; m < 4; ++m) {
                        const float xg = acc[ai][0][m][n][e] * rsv[ai * 4 + m], xv = acc[ai][1][m][n][e] * rsv[ai * 4 + m];
                        const float rg1 = __int_as_float(__builtin_amdgcn_update_dpp(0, __float_as_int(xg), 0x121, 0xf, 0xf, false)), rg2 = __int_as_float(__builtin_amdgcn_update_dpp(0, __float_as_int(xg), 0x122, 0xf, 0xf, false));
                        const float rv1 = __int_as_float(__builtin_amdgcn_update_dpp(0, __float_as_int(xv), 0x121, 0xf, 0xf, false)), rv2 = __int_as_float(__builtin_amdgcn_update_dpp(0, __float_as_int(xv), 0x122, 0xf, 0xf, false));
                        const float g1 = fr == 0 ? pg1 : rg1, g2 = fr < 2 ? pg2 : rg2, v1 = fr == 0 ? pv1 : rv1, v2 = fr < 2 ? pv2 : rv2;
                        const float cg = bg[e] + wg0[e] * g2 + wg1[e] * g1 + wg2[e] * xg, cv = bv[e] + wv0[e] * v2 + wv1[e] * v1 + wv2[e] * xv;
                        act[m][e] = cg * sigmoidf_(cg) * cv;
                        pg1 = rg1; pg2 = rg2; pv1 = rv1; pv2 = rv2;
                    }
                }
#pragma unroll
                for (int m = 0; m < 4; ++m) { u32x2 w; w.x = pk2(act[m][0], act[m][1]); w.y = pk2(act[m][2], act[m][3]); *(u32x2*)(ACT + ((size_t)((ch0 + 4 * n) >> 6) * M + (size_t)(row0 + ai * HALF + m * 16)) * 64 + ((ch0 + 4 * n) & 63)) = w; }
            }
        }
        const int slot = fr < 2 ? fr : fr - 12;
        if (fr < 2 || fr >= 14) {
            const int m = fr < 2 ? 0 : 3;
#pragma unroll
            for (int ai = 0; ai < 2; ++ai) { const int blk = (u.pm * BM + ai * HALF + wr * 64) >> 6; const float r_ = fr < 2 ? rsv[ai * 4] : rsv[ai * 4 + 3];
                bf16_t* sp = side + ((size_t)blk * 4 + slot) * NUP + u.pn * 256 + wc * 32 + 8 * fq;
#pragma unroll
                for (int bj = 0; bj < 2; ++bj) { const f32x4 a0 = (fr < 2 ? acc[ai][bj][0][0] : acc[ai][bj][3][0]) * r_, a1 = (fr < 2 ? acc[ai][bj][0][1] : acc[ai][bj][3][1]) * r_;
                    *(u32x4*)(sp + bj * HALF) = (u32x4){pk2(a0[0], a0[1]), pk2(a0[2], a0[3]), pk2(a1[0], a1[1]), pk2(a1[2], a1[3])}; } }
            (void)m;
        }
    }
};
struct EpiResidBf16 {
    static constexpr bool PERM = true, AFTER_DRAIN = false;
    bf16_t* XB; float* Cout; float* ssq; int ldc;
    __device__ __forceinline__ void operator()(const f32x4 (&acc)[2][2][4][2], const Unit& u, int wr, int wc, int fr, int fq) const {
        const int row0 = u.pm * BM + wr * 64 + fr, col0 = u.pn * BM + wc * 32 + 8 * fq;
        u32x4 old[2][2]; float ssv[8];
#define ER_ROWI(g) (row0 + ((g) >> 2) * HALF + ((g) & 3) * 16)
#define ER_LOAD(g) do { const bf16_t* rp_ = XB + (size_t)ER_ROWI(g) * ldc + col0; old[(g) & 1][0] = *(const u32x4*)rp_; old[(g) & 1][1] = *(const u32x4*)(rp_ + HALF); } while (0)
        ER_LOAD(0);
#pragma unroll
        for (int g = 0; g < 8; ++g) {
            asm volatile("" ::: "memory");
            if (g < 7) ER_LOAD(g + 1);
            const size_t ro = (size_t)ER_ROWI(g) * ldc + col0; float ss = 0.f;
#pragma unroll
            for (int bj = 0; bj < 2; ++bj) { const u32x4 o_ = old[g & 1][bj];
                f32x4 v0 = acc[g >> 2][bj][g & 3][0], v1 = acc[g >> 2][bj][g & 3][1];
                v0[0] += bflo(o_.x); v0[1] += bfhi(o_.x); v0[2] += bflo(o_.y); v0[3] += bfhi(o_.y); v1[0] += bflo(o_.z); v1[1] += bfhi(o_.z); v1[2] += bflo(o_.w); v1[3] += bfhi(o_.w);
                if (Cout) { *(f32x4*)(Cout + ro + bj * HALF) = v0; *(f32x4*)(Cout + ro + bj * HALF + 4) = v1; }
                else { u32x4 w; w.x = pk2(v0[0], v0[1]); w.y = pk2(v0[2], v0[3]); w.z = pk2(v1[0], v1[1]); w.w = pk2(v1[2], v1[3]); *(u32x4*)(XB + ro + bj * HALF) = w;
                    const float r0 = bflo(w.x), r1 = bfhi(w.x), r2 = bflo(w.y), r3 = bfhi(w.y), r4 = bflo(w.z), r5 = bfhi(w.z), r6 = bflo(w.w), r7 = bfhi(w.w);
                    ss += ((r0 * r0 + r1 * r1) + (r2 * r2 + r3 * r3)) + ((r4 * r4 + r5 * r5) + (r6 * r6 + r7 * r7)); } }
            ssv[g] = ss;
        }
        if (!Cout) {
#pragma unroll
            for (int g = 0; g < 8; ++g) ssv[g] += __shfl_xor(ssv[g], 16);
#pragma unroll
            for (int g = 0; g < 8; ++g) ssv[g] += __shfl_xor(ssv[g], 32);
            if (fq == 0) {
#pragma unroll
                for (int g = 0; g < 8; ++g) ssq[(size_t)ER_ROWI(g) * 32 + u.pn * 4 + wc] = ssv[g]; } }
#undef ER_ROWI
#undef ER_LOAD
    }
};
struct EpiGated {
    static constexpr bool PERM = true, AFTER_DRAIN = false, HOOK = true; static constexpr int HOOK_KT = 16;
    const bf16_t* P; bf16_t* merged;
    static __device__ __forceinline__ float gl(unsigned w) { return fmaxf(bflo(w), 1e-30f); }
    static __device__ __forceinline__ float gh(unsigned w) { return fmaxf(bfhi(w), 1e-30f); }
    __device__ __forceinline__ void mid(f32x4 (&acc)[2][2][4][2], const Unit& u, int wr, int wc, int fr, int fq, int s) const {
        const unsigned row0 = (unsigned)(u.pm * BM + wr * 64 + fr), col0 = (unsigned)(u.pn * BM + wc * 32 + 8 * fq);
        const char* Pa = (const char*)(P + PGT + (s - 1) * DM); const char* Pb = (const char*)(P + PGT + s * DM);
#pragma unroll
        for (int hf = 0; hf < 2; ++hf) {
            u32x4 ga[4][2], gb[4][2];
#pragma unroll
            for (int gg = 0; gg < 4; ++gg) { const int g = hf * 4 + gg; const unsigned po = ((row0 + (unsigned)((g >> 2) * HALF + (g & 3) * 16)) * (unsigned)NPC + col0) * 2u;
#pragma unroll
                for (int bj = 0; bj < 2; ++bj) { ga[gg][bj] = *(const u32x4*)(Pa + (size_t)(po + bj * 256u)); gb[gg][bj] = *(const u32x4*)(Pb + (size_t)(po + bj * 256u)); } }
#pragma unroll
            for (int gg = 0; gg < 4; ++gg) { const int g = hf * 4 + gg;
#pragma unroll
                for (int bj = 0; bj < 2; ++bj) { const u32x4 a_ = ga[gg][bj], b_ = gb[gg][bj];
                    f32x4& v0 = acc[g >> 2][bj][g & 3][0]; f32x4& v1 = acc[g >> 2][bj][g & 3][1];
                    v0[0] *= gl(a_.x) * fast_rcp(gl(b_.x)); v0[1] *= gh(a_.x) * fast_rcp(gh(b_.x)); v0[2] *= gl(a_.y) * fast_rcp(gl(b_.y)); v0[3] *= gh(a_.y) * fast_rcp(gh(b_.y));
                    v1[0] *= gl(a_.z) * fast_rcp(gl(b_.z)); v1[1] *= gh(a_.z) * fast_rcp(gh(b_.z)); v1[2] *= gl(a_.w) * fast_rcp(gl(b_.w)); v1[3] *= gh(a_.w) * fast_rcp(gh(b_.w)); } }
            asm volatile("" ::: "memory"); }
    }
    __device__ __forceinline__ void operator()(const f32x4 (&acc)[2][2][4][2], const Unit& u, int wr, int wc, int fr, int fq) const {
        const unsigned row0 = (unsigned)(u.pm * BM + wr * 64 + fr), col0 = (unsigned)(u.pn * BM + wc * 32 + 8 * fq);
        const char* Pg = (const char*)(P + PGT + 2 * DM); char* mg = (char*)merged;
        u32x4 gw[8][2];
#pragma unroll
        for (int g = 0; g < 8; ++g) { const unsigned po = ((row0 + (unsigned)((g >> 2) * HALF + (g & 3) * 16)) * (unsigned)NPC + col0) * 2u;
#pragma unroll
            for (int bj = 0; bj < 2; ++bj) gw[g][bj] = *(const u32x4*)(Pg + (size_t)(po + bj * 256u)); }
#pragma unroll
        for (int g = 0; g < 8; ++g) { const unsigned moff = ((row0 + (unsigned)((g >> 2) * HALF + (g & 3) * 16)) * (unsigned)DM + col0) * 2u;
#pragma unroll
            for (int bj = 0; bj < 2; ++bj) { const u32x4 w_ = gw[g][bj]; const f32x4 v0 = acc[g >> 2][bj][g & 3][0], v1 = acc[g >> 2][bj][g & 3][1];
                u32x4 w; w.x = pk2(v0[0] * gl(w_.x), v0[1] * gh(w_.x)); w.y = pk2(v0[2] * gl(w_.y), v0[3] * gh(w_.y)); w.z = pk2(v1[0] * gl(w_.z), v1[1] * gh(w_.z)); w.w = pk2(v1[2] * gl(w_.w), v1[3] * gh(w_.w));
                *(u32x4*)(mg + (size_t)(moff + bj * 256u)) = w; } }
    }
};

template <class E, class = void> struct has_hook { static constexpr bool v = false; };
template <class E> struct has_hook<E, decltype((void)E::HOOK)> { static constexpr bool v = true; };
template <class Epi, class Sched, bool ALIGN_EPI = false, bool SP2 = false>
__device__ __forceinline__ void gemm_phase(LAS unsigned char* lds, const Gemm g, const Sched& S, const Epi& E, const int tid, unsigned long long* dg = nullptr) {
    float zf; asm volatile("v_mov_b32 %0, 0" : "=v"(zf));
    const int wid = __builtin_amdgcn_readfirstlane(tid >> 6), lane = tid & 63, wr = wid >> 2, wc = wid & 3, fr = lane & 15, fq = lane >> 4;
    const int K = g.K, nt = K / BK;
    unsigned voffA[2], voffB[2];
#pragma unroll
    for (int i = 0; i < 2; ++i) { int R, C; stage_rc(tid * 16 + i * 8192, R, C); const int Rb = Epi::PERM ? ((R & ~31) + perm32(R & 31)) : R;
        voffA[i] = (unsigned)(R * (g.akm ? BK : K) + C) * 2u; voffB[i] = (unsigned)(Rb * K + C) * 2u; }
    const size_t kstep = (size_t)(BK * 2);
    const size_t hstep = (size_t)HALF * K * 2;
    const size_t tstep = 2 * hstep;
    const size_t kstepA = g.akm ? (size_t)g.M * BK * 2 : kstep, hstepA = g.akm ? (size_t)HALF * BK * 2 : hstep, tstepA = 2 * hstepA;
    const unsigned ldsw = (unsigned)wid * 1024u;
    const int aoff = lds_byte(wr * 64 + fr, fq * 8), boff = lds_byte(wc * 32 + fr, fq * 8);
#define PG8_SA(b, h) (((b) * 2 + (h)) * HTB)
#define PG8_SB(b, h) ((4 + (b) * 2 + (h)) * HTB)
#define PG8_STAGE(bufoff, gbase, voff) do { _Pragma("unroll") for (int _i = 0; _i < 2; ++_i) \
        __builtin_amdgcn_global_load_lds((const unsigned*)((const char*)(gbase) + (voff)[_i]), (LAS unsigned*)(lds + (bufoff) + ldsw + _i * 8192), 16, 0, 0); } while (0)
#define PG8_LDA(dst, b, h) do { _Pragma("unroll") for (int m = 0; m < 4; ++m) _Pragma("unroll") for (int k = 0; k < 2; ++k) dst[m][k] = *(const LAS bf16x8*)(lds + PG8_SA(b, h) + aoff + m * 2048 + k * 1024); } while (0)
#define PG8_LDB(dst, b, h) do { _Pragma("unroll") for (int n = 0; n < 2; ++n) _Pragma("unroll") for (int k = 0; k < 2; ++k) dst[n][k] = *(const LAS bf16x8*)(lds + PG8_SB(b, h) + boff + n * 2048 + k * 1024); } while (0)
#define PG8_MMA(ai, bj, At, Bt) do { __builtin_amdgcn_s_setprio(1); _Pragma("unroll") for (int m = 0; m < 4; ++m) _Pragma("unroll") for (int n = 0; n < 2; ++n) _Pragma("unroll") for (int k = 0; k < 2; ++k) \
        acc[ai][bj][m][n] = __builtin_amdgcn_mfma_f32_16x16x32_bf16(Bt[n][k], At[m][k], acc[ai][bj][m][n], 0, 0, 0); __builtin_amdgcn_s_setprio(0); } while (0)
#define PG8_WAIT_V(n) asm volatile("s_waitcnt vmcnt(" #n ")" ::: "memory")
#define PG8_WAIT_L(n) asm volatile("s_waitcnt lgkmcnt(" #n ")" ::: "memory")
#define PG8_BAR __builtin_amdgcn_s_barrier()
#define PG8_SCHED __builtin_amdgcn_sched_barrier(0)
    Unit cur, nxt; int ui = 0;
    if (!S.next(0, cur)) return;
    f32x4 acc[2][2][4][2];
#pragma unroll
    for (int a = 0; a < 2; ++a)
#pragma unroll
        for (int b = 0; b < 2; ++b)
#pragma unroll
            for (int m = 0; m < 4; ++m)
#pragma unroll
                for (int n = 0; n < 2; ++n) acc[a][b][m][n] = (f32x4){zf, zf, zf, zf};
    bf16x8 At[4][2], B0[2][2], B1[2][2];
    const char* cA = S.aptr(g, cur, tstepA); const char* cB = S.bptr(g, cur, tstep);
    S.a_ready(cur);
    if constexpr (SP2) {
        PG8_STAGE(PG8_SB(0, 0), cB, voffB); PG8_STAGE(PG8_SB(0, 1), cB + hstep, voffB); PG8_STAGE(PG8_SA(0, 0), cA, voffA); PG8_STAGE(PG8_SA(0, 1), cA + hstepA, voffA);
        if (wr == 1) PG8_BAR;
        PG8_WAIT_V(2); PG8_BAR;
        PG8_STAGE(PG8_SB(1, 0), cB + kstep, voffB); PG8_STAGE(PG8_SA(1, 0), cA + kstepA, voffA); PG8_STAGE(PG8_SB(1, 1), cB + hstep + kstep, voffB);
        PG8_WAIT_V(6); PG8_BAR;
    } else {
        PG8_STAGE(PG8_SB(0, 0), cB, voffB); PG8_STAGE(PG8_SA(0, 0), cA, voffA); PG8_STAGE(PG8_SB(0, 1), cB + hstep, voffB); PG8_STAGE(PG8_SA(0, 1), cA + hstepA, voffA);
        if (wr == 1) PG8_BAR;
        PG8_WAIT_V(4); PG8_BAR;
        PG8_STAGE(PG8_SB(1, 0), cB + kstep, voffB); PG8_STAGE(PG8_SA(1, 0), cA + kstepA, voffA); PG8_STAGE(PG8_SB(1, 1), cB + hstep + kstep, voffB);
        PG8_WAIT_V(6); PG8_BAR;
    }
    for (;;) {
        const bool has_next = S.next(ui + 1, nxt);
        if (MK_DIAG && dg && tid == 0 && (ui == 2 || ui == 3)) dg[(ui - 2) * 2] = wall_clock64();
        const char* nA = has_next ? S.aptr(g, nxt, tstepA) : cA; const char* nB = has_next ? S.bptr(g, nxt, tstep) : cB;
        for (int t = 0; t < nt; t += 2) {
            const bool last = (t == nt - 2);
            const char* a1 = cA + (size_t)(t + 1) * kstepA;
            const char* a2 = last ? nA : cA + (size_t)(t + 2) * kstepA; const char* b2 = last ? nB : cB + (size_t)(t + 2) * kstep;
            const char* a3 = a2 + kstepA; const char* b3 = b2 + kstep;
            if (last && has_next) S.a_ready(nxt);
            if constexpr (SP2) {
            PG8_LDB(B0, 0, 0); PG8_LDB(B1, 0, 1); PG8_SCHED; PG8_LDA(At, 0, 0); PG8_STAGE(PG8_SA(1, 1), a1 + hstepA, voffA);
            PG8_WAIT_V(8); PG8_WAIT_L(0); PG8_BAR; PG8_MMA(0, 0, At, B0); PG8_MMA(0, 1, At, B1); PG8_BAR; PG8_SCHED;
            PG8_LDA(At, 0, 1); PG8_STAGE(PG8_SB(0, 0), b2, voffB); PG8_STAGE(PG8_SB(0, 1), b2 + hstep, voffB); PG8_STAGE(PG8_SA(0, 0), a2, voffA);
            PG8_WAIT_V(8); PG8_WAIT_L(0); PG8_BAR; PG8_MMA(1, 0, At, B0); PG8_MMA(1, 1, At, B1); PG8_BAR; PG8_SCHED;
            PG8_LDB(B0, 1, 0); PG8_LDB(B1, 1, 1); PG8_SCHED; PG8_LDA(At, 1, 0); PG8_STAGE(PG8_SA(0, 1), a2 + hstepA, voffA);
            PG8_WAIT_V(8); PG8_WAIT_L(0); PG8_BAR; PG8_MMA(0, 0, At, B0); PG8_MMA(0, 1, At, B1); PG8_BAR; PG8_SCHED;
            PG8_LDA(At, 1, 1); PG8_STAGE(PG8_SB(1, 0), b3, voffB); PG8_STAGE(PG8_SB(1, 1), b3 + hstep, voffB); PG8_STAGE(PG8_SA(1, 0), a3, voffA);
            PG8_WAIT_V(8); PG8_WAIT_L(0); PG8_BAR; PG8_MMA(1, 0, At, B0); PG8_MMA(1, 1, At, B1); PG8_BAR; PG8_SCHED;
            if constexpr (has_hook<Epi>::v) { if (t + 2 < nt && (t + 2) % Epi::HOOK_KT == 0) { const_cast<Epi&>(E).mid(acc, cur, wr, wc, fr, fq, (t + 2) / Epi::HOOK_KT); PG8_SCHED; } }
            } else {
            PG8_LDB(B0, 0, 0); PG8_SCHED; PG8_LDA(At, 0, 0); PG8_STAGE(PG8_SA(1, 1), a1 + hstepA, voffA);
            PG8_WAIT_L(8); PG8_BAR; PG8_WAIT_L(0); PG8_MMA(0, 0, At, B0); PG8_BAR; PG8_SCHED;
            PG8_LDB(B1, 0, 1); PG8_STAGE(PG8_SB(0, 0), b2, voffB);
            PG8_BAR; PG8_WAIT_L(0); PG8_MMA(0, 1, At, B1); PG8_BAR;
            PG8_LDA(At, 0, 1); PG8_STAGE(PG8_SA(0, 0), a2, voffA);
            PG8_BAR; PG8_WAIT_L(0); PG8_MMA(1, 0, At, B0); PG8_BAR; PG8_SCHED;
            PG8_STAGE(PG8_SB(0, 1), b2 + hstep, voffB);
            PG8_WAIT_V(6); PG8_BAR; PG8_MMA(1, 1, At, B1); PG8_BAR;
            PG8_LDB(B0, 1, 0); PG8_SCHED; PG8_LDA(At, 1, 0); PG8_STAGE(PG8_SA(0, 1), a2 + hstepA, voffA);
            PG8_WAIT_L(8); PG8_BAR; PG8_WAIT_L(0); PG8_MMA(0, 0, At, B0); PG8_BAR; PG8_SCHED;
            PG8_LDB(B1, 1, 1); PG8_STAGE(PG8_SB(1, 0), b3, voffB);
            PG8_BAR; PG8_WAIT_L(0); PG8_MMA(0, 1, At, B1); PG8_BAR;
            PG8_LDA(At, 1, 1); PG8_STAGE(PG8_SA(1, 0), a3, voffA);
            PG8_BAR; PG8_WAIT_L(0); PG8_MMA(1, 0, At, B0); PG8_BAR; PG8_SCHED;
            PG8_STAGE(PG8_SB(1, 1), b3 + hstep, voffB);
            PG8_WAIT_V(6); PG8_BAR; PG8_MMA(1, 1, At, B1); PG8_BAR;
            }
        }
        if (MK_DIAG && dg && tid == 0 && ui == 2) dg[1] = wall_clock64();
        if constexpr (ALIGN_EPI) { if (wr == 0) PG8_BAR; }
        if constexpr (!Epi::AFTER_DRAIN) { E(acc, cur, wr, wc, fr, fq); S.done(cur); }
        if (!has_next) break;
#pragma unroll
        for (int a = 0; a < 2; ++a)
#pragma unroll
            for (int b = 0; b < 2; ++b)
#pragma unroll
                for (int m = 0; m < 4; ++m)
#pragma unroll
                    for (int n = 0; n < 2; ++n) acc[a][b][m][n] = (f32x4){zf, zf, zf, zf};
        cur = nxt; cA = nA; cB = nB; ++ui;
        if constexpr (ALIGN_EPI) { if (wr == 1) PG8_BAR; }
    }
    PG8_WAIT_V(0);
    if constexpr (!ALIGN_EPI) { if (wr == 0) PG8_BAR; }
    PG8_BAR;
#undef PG8_SA
#undef PG8_SB
#undef PG8_STAGE
#undef PG8_LDA
#undef PG8_LDB
#undef PG8_MMA
#undef PG8_WAIT_V
#undef PG8_WAIT_L
#undef PG8_BAR
#undef PG8_SCHED
}
}
#define PG8_SP2 true
#define PG8_ALIGN true

struct Args { const float* in[18]; float* out; unsigned char* ws; int ph_lo, ph_hi; };
typedef const __attribute__((address_space(4))) Args* KArgs;
enum { I_X = 0, I_NATT, I_WIN, I_QG, I_KG, I_CPOS, I_CW1, I_CW2, I_RELB, I_HLB, I_HNG, I_WBR, I_WOUT, I_NFFN, I_WUP, I_CONVW, I_CONVB, I_WDN };

struct Frame {
    LAS unsigned char* lds; volatile LAS unsigned* MISC;
    unsigned* ctl; unsigned char* ws;
    int tid, lane, wave, G, bid;
};

__device__ __forceinline__ int up_src_col(int n) { const int pn = n >> 8, c = n & 255; return c < 128 ? 128 * pn + c : DFF + 128 * pn + (c - 128); }
__device__ __forceinline__ int inproj_src_col(int n) { return n < 2560 ? n : (n < 15872 ? n + 24 : (n < 15896 ? n - 15872 + 2560 : -1)); }
__device__ __forceinline__ void transpose_item(const float* W, int K, int Nsrc, bf16_t* WT, const float* gain, int mode, LAS float* scr, int item, int nblk, int lane, int ldw = 0) {
    if (ldw == 0) ldw = K;
    const int kb = item / nblk, nb = item - kb * nblk, k0 = 64 * kb, n0 = 32 * nb;
    const int nn = n0 + (lane & 7) * 4; const int sc = mode == 1 ? inproj_src_col(nn) : (mode == 2 ? up_src_col(nn) : nn);
    f32x4 v[8];
#pragma unroll
    for (int i = 0; i < 8; ++i) { const int kk = 8 * i + (lane >> 3); v[i] = sc >= 0 ? __builtin_nontemporal_load((const f32x4*)(W + (size_t)(k0 + kk) * Nsrc + sc)) : (f32x4){0.f, 0.f, 0.f, 0.f}; }
#pragma unroll
    for (int i = 0; i < 8; ++i) { const int kk = 8 * i + (lane >> 3); const float gk = gain ? gain[k0 + kk] : 1.f; LAS float* d = scr + kk * 33 + (lane & 7) * 4;
        d[0] = v[i].x * gk; d[1] = v[i].y * gk; d[2] = v[i].z * gk; d[3] = v[i].w * gk; }
    LDS_WAIT(); asm volatile("" ::: "memory");
    const int c = lane & 7;
#pragma unroll
    for (int j = 0; j < 4; ++j) { const int n = (lane >> 3) + 8 * j; const LAS float* sp = scr + (8 * c) * 33 + n;
        u32x4 o; o.x = pk2(sp[0 * 33], sp[1 * 33]); o.y = pk2(sp[2 * 33], sp[3 * 33]); o.z = pk2(sp[4 * 33], sp[5 * 33]); o.w = pk2(sp[6 * 33], sp[7 * 33]);
        *(u32x4*)(WT + (size_t)(n0 + n) * ldw + k0 + 8 * c) = o; }
    LDS_WAIT(); asm volatile("" ::: "memory");
}
__device__ __forceinline__ void rms_row0(const float* xin, bf16_t* xb, float* rstd, int lane) {
    const f32x4* xr = (const f32x4*)xin + lane;
    f32x4 v[8]; float s = 0.f;
#pragma unroll
    for (int j = 0; j < 8; ++j) { v[j] = xr[64 * j]; s += (v[j].x * v[j].x + v[j].y * v[j].y) + (v[j].z * v[j].z + v[j].w * v[j].w); }
    s = wave_sum(s);
    if (lane == 0) *rstd = rsqrtf(s * (1.f / DM) + EPS);
    u32x2* o8 = (u32x2*)xb + lane;
#pragma unroll
    for (int j = 0; j < 8; ++j) { u32x2 w; w.x = pk2(v[j].x, v[j].y); w.y = pk2(v[j].z, v[j].w); o8[64 * j] = w; }
}
__device__ __forceinline__ void rstd_rows(Frame& F) {
    const float* ssq = (const float*)(F.ws + WS_SSQ); float* rstd = (float*)(F.ws + WS_RSTD);
    for (int row = F.bid * 512 + F.tid; row < M; row += F.G * 512) { const f32x4* p = (const f32x4*)(ssq + (size_t)row * 32); float s = 0.f;
#pragma unroll
        for (int j = 0; j < 8; ++j) { const f32x4 v = p[j]; s += (v.x + v.y) + (v.z + v.w); }
        rstd[row] = rsqrtf(s * (1.f / DM) + EPS); }
}

__device__ __forceinline__ void cvec_item(Frame& F, KArgs a, int layer, int j);
__device__ __forceinline__ void phase_A(Frame& F, KArgs a, int layer) {
    LAS float* scr = (LAS float*)(F.lds + F.wave * 16384);
    const int gw = F.bid * 8 + F.wave, NGW = F.G * 8;
    bf16_t* Wt_in = (bf16_t*)(F.ws + WS_WIN); bf16_t* Wt_br = (bf16_t*)(F.ws + WS_WBR); bf16_t* Wt_out = (bf16_t*)(F.ws + WS_WOUT);
    bf16_t* Wt_up = (bf16_t*)(F.ws + WS_WUP); bf16_t* Wt_dn = (bf16_t*)(F.ws + WS_WDN);
    const float* w_in = a->in[I_WIN] + (size_t)layer * DM * INC; const float* g_att = a->in[I_NATT] + layer * DM;
    const float* w_br = a->in[I_WBR] + (size_t)layer * 3 * BW * DM; const float* w_out = a->in[I_WOUT] + (size_t)layer * DM * DM;
    const float* w_up = a->in[I_WUP] + (size_t)layer * DM * NUP; const float* g_ffn = a->in[I_NFFN] + layer * DM;
    const float* w_dn = a->in[I_WDN] + (size_t)layer * DFF * DM;
    constexpr int I_IN = (DM / 64) * (NPC / 32), I_BR1 = (BW / 64) * (DM / 32), I_OUT = (DM / 64) * (DM / 32), I_UP = (DM / 64) * (NUP / 32), I_DN = (DFF / 64) * (DM / 32);
    constexpr int I_C1 = (4096 / 64) * (HD / 32);
    constexpr int NITEMS = I_IN + 3 * I_BR1 + I_OUT + I_UP + I_DN + 2 * I_C1;
    for (int it = gw; it < NITEMS; it += NGW) {
        int r = it;
        if (r < I_IN) { transpose_item(w_in, DM, INC, Wt_in, g_att, 1, scr, r, NPC / 32, F.lane); continue; } r -= I_IN;
        if (r < 3 * I_BR1) { const int n = r / I_BR1; r -= n * I_BR1; transpose_item(w_br + (size_t)n * BW * DM, BW, DM, Wt_br + (size_t)n * BW, nullptr, 0, scr, r, DM / 32, F.lane, 3 * BW); continue; } r -= 3 * I_BR1;
        if (r < I_OUT) { transpose_item(w_out, DM, DM, Wt_out, nullptr, 0, scr, r, DM / 32, F.lane); continue; } r -= I_OUT;
        if (r < I_UP) { transpose_item(w_up, DM, NUP, Wt_up, g_ffn, 2, scr, r, NUP / 32, F.lane); continue; } r -= I_UP;
        if (r < I_DN) { transpose_item(w_dn, DFF, DM, Wt_dn, nullptr, 0, scr, r, DM / 32, F.lane); continue; } r -= I_DN;
        { const int j = r / I_C1; r -= j * I_C1; transpose_item(a->in[I_CW1] + (size_t)(layer * 2 + j) * 4096 * HD, 4096, HD, (bf16_t*)(F.ws + WS_MISC + MISC_WC1) + (size_t)j * HD * 4096, nullptr, 0, scr, r, HD / 32, F.lane); }
    }
    if (F.bid < 64) cvec_item(F, a, layer, F.bid);
    if (layer == 0) { bf16_t* XB = (bf16_t*)(F.ws + WS_XB); float* rstd = (float*)(F.ws + WS_RSTD);
        for (int m = gw; m < M; m += NGW) rms_row0(a->in[I_X] + (size_t)m * DM, XB + (size_t)m * DM, rstd + m, F.lane); }
    else rstd_rows(F);
}
__device__ __forceinline__ void phase_F(Frame& F, KArgs a) { rstd_rows(F); }
__device__ __forceinline__ void phase_H(Frame& F, KArgs a, int layer) {
    const bf16_t* SD = (const bf16_t*)(F.ws + WS_USIDE); bf16_t* ACT = (bf16_t*)(F.ws + WS_ACT);
    const float* cw = a->in[I_CONVW] + (size_t)layer * 3 * NUP; const float* cb = a->in[I_CONVB] + (size_t)layer * NUP;
    constexpr int CG = DFF / 8, NTASK = (M / 64) * 2 * CG;
    for (int task = F.bid * 512 + F.tid; task < NTASK; task += F.G * 512) {
        const int cg = task % CG, rb = task / CG, rw = rb & 1, blk = rb >> 1; if ((blk & 31) == 0) continue;
        const int c0 = cg * 8, uc = 256 * (c0 >> 7) + (c0 & 127);
        const bf16_t* t2 = rw == 0 ? SD + ((size_t)(blk - 1) * 4 + 2) * NUP : SD + ((size_t)(blk - 1) * 4 + 3) * NUP;
        const bf16_t* t1 = rw == 0 ? SD + ((size_t)(blk - 1) * 4 + 3) * NUP : SD + ((size_t)blk * 4 + 0) * NUP;
        const bf16_t* t0 = SD + ((size_t)blk * 4 + rw) * NUP;
        const u32x4 g2 = *(const u32x4*)(t2 + uc), g1 = *(const u32x4*)(t1 + uc), g0 = *(const u32x4*)(t0 + uc), v2 = *(const u32x4*)(t2 + uc + 128), v1 = *(const u32x4*)(t1 + uc + 128), v0 = *(const u32x4*)(t0 + uc + 128);
        const unsigned G2[4] = {g2.x, g2.y, g2.z, g2.w}, G1[4] = {g1.x, g1.y, g1.z, g1.w}, G0[4] = {g0.x, g0.y, g0.z, g0.w}, V2[4] = {v2.x, v2.y, v2.z, v2.w}, V1[4] = {v1.x, v1.y, v1.z, v1.w}, V0[4] = {v0.x, v0.y, v0.z, v0.w};
        float o[8];
#pragma unroll
        for (int e = 0; e < 8; ++e) { const int q = e >> 1; const bool hi = e & 1;
            const float xg2 = hi ? bfhi(G2[q]) : bflo(G2[q]), xg1 = hi ? bfhi(G1[q]) : bflo(G1[q]), xg0 = hi ? bfhi(G0[q]) : bflo(G0[q]);
            const float xv2 = hi ? bfhi(V2[q]) : bflo(V2[q]), xv1 = hi ? bfhi(V1[q]) : bflo(V1[q]), xv0 = hi ? bfhi(V0[q]) : bflo(V0[q]);
            const float cgv = cb[c0 + e] + cw[c0 + e] * xg2 + cw[NUP + c0 + e] * xg1 + cw[2 * NUP + c0 + e] * xg0;
            const float cvv = cb[DFF + c0 + e] + cw[DFF + c0 + e] * xv2 + cw[NUP + DFF + c0 + e] * xv1 + cw[2 * NUP + DFF + c0 + e] * xv0;
            o[e] = cgv * sigmoidf_(cgv) * cvv; }
        *(u32x4*)(ACT + ((size_t)(c0 >> 6) * M + (size_t)(blk * 64 + rw)) * 64 + (c0 & 63)) = (u32x4){pk2(o[0], o[1]), pk2(o[2], o[3]), pk2(o[4], o[5]), pk2(o[6], o[7])};
    }
}

__device__ __forceinline__ int q_next(Frame& F, unsigned* head) {
    __syncthreads();
    if (F.tid == 0) F.MISC[16] = __hip_atomic_fetch_add(head, 1u, __ATOMIC_RELAXED, __HIP_MEMORY_SCOPE_AGENT);
    __syncthreads();
    return __builtin_amdgcn_readfirstlane((int)F.MISC[16]);
}
__device__ __forceinline__ int t5_bucket(int n) {
    if (n < 16) return n;
    int b = 16;
    b += (n >= 19); b += (n >= 21); b += (n >= 24); b += (n >= 27); b += (n >= 31); b += (n >= 35); b += (n >= 40); b += (n >= 46);
    b += (n >= 52); b += (n >= 59); b += (n >= 67); b += (n >= 77); b += (n >= 87); b += (n >= 99); b += (n >= 113);
    return b;
}
__device__ __forceinline__ int crow(int i, int h) { return (i & 3) + 8 * (i >> 2) + 4 * h; }

#define MFMA32(a, b, c) __builtin_amdgcn_mfma_f32_32x32x16_bf16((a), (b), (c), 0, 0, 0)
__device__ __forceinline__ float sum8lanes(float v) { v += __shfl_xor(v, 1); v += __shfl_xor(v, 2); v += __shfl_xor(v, 4); return v; }
__device__ __forceinline__ void norm16(unsigned* pp, const float* gn, float sc) {
    const u32x4 w0 = *(const u32x4*)pp, w1 = *(const u32x4*)(pp + 4); const unsigned w[8] = {w0.x, w0.y, w0.z, w0.w, w1.x, w1.y, w1.z, w1.w};
    float x[16], ss = 0.f;
#pragma unroll
    for (int q = 0; q < 8; ++q) { x[2 * q] = bflo(w[q]); x[2 * q + 1] = bfhi(w[q]); ss += x[2 * q] * x[2 * q] + x[2 * q + 1] * x[2 * q + 1]; }
    const float r = rsqrtf(sum8lanes(ss) * (1.f / HD) + EPS) * sc;
    u32x4 o0, o1;
    o0.x = pk2(x[0] * r * gn[0], x[1] * r * gn[1]); o0.y = pk2(x[2] * r * gn[2], x[3] * r * gn[3]); o0.z = pk2(x[4] * r * gn[4], x[5] * r * gn[5]); o0.w = pk2(x[6] * r * gn[6], x[7] * r * gn[7]);
    o1.x = pk2(x[8] * r * gn[8], x[9] * r * gn[9]); o1.y = pk2(x[10] * r * gn[10], x[11] * r * gn[11]); o1.z = pk2(x[12] * r * gn[12], x[13] * r * gn[13]); o1.w = pk2(x[14] * r * gn[14], x[15] * r * gn[15]);
    *(u32x4*)pp = o0; *(u32x4*)(pp + 4) = o1;
}
__device__ __forceinline__ void item_norm(Frame& F, KArgs a, int layer, int it) {
    bf16_t* P = (bf16_t*)(F.ws + WS_P);
    const float* qg = a->in[I_QG] + layer * HD; const float* kg = a->in[I_KG] + layer * 3 * HD;
    const int lane = F.lane, e0 = (lane & 7) * 16;
    float gq[16], gk[16];
#pragma unroll
    for (int e = 0; e < 16; ++e) { gq[e] = qg[e0 + e]; gk[e] = kg[((lane >> 4) & 1 ? 2 : 1) * HD + e0 + e]; }
    for (int rr = 0; rr < 8; ++rr) {
        bf16_t* pr = P + (size_t)(it * 64 + F.wave * 8 + rr) * NPC;
        norm16((unsigned*)(pr + PQN + lane * 16), gq, QSCALE);
        if (lane < 32) norm16((unsigned*)(pr + (lane < 16 ? PKS + lane * 16 : PKW + (lane - 16) * 16)), gk, 1.f);
    }
}
__device__ __forceinline__ void item_hgfin(Frame& F, KArgs a, int layer, int it) {
    const bf16_t* P = (const bf16_t*)(F.ws + WS_P); const float* OR = (const float*)(F.ws + WS_ORAW); bf16_t* OH = (bf16_t*)(F.ws + WS_OBR) + 2 * BW;
    const float* ng = a->in[I_HNG] + layer * HD; const int lane = F.lane, e0 = (lane & 7) * 16;
    float gn[16];
#pragma unroll
    for (int e = 0; e < 16; ++e) gn[e] = ng[e0 + e];
    for (int rr = 0; rr < 8; ++rr) { const size_t row = (size_t)(it * 64 + F.wave * 8 + rr);
        const f32x4* op = (const f32x4*)(OR + row * BW + lane * 16); const f32x4 o0 = op[0], o1 = op[1], o2 = op[2], o3 = op[3];
        const unsigned* gp = (const unsigned*)(P + row * NPC + PGH + lane * 16); const u32x4 g0 = *(const u32x4*)gp, g1 = *(const u32x4*)(gp + 4);
        const float x[16] = {o0.x, o0.y, o0.z, o0.w, o1.x, o1.y, o1.z, o1.w, o2.x, o2.y, o2.z, o2.w, o3.x, o3.y, o3.z, o3.w}; const unsigned gw[8] = {g0.x, g0.y, g0.z, g0.w, g1.x, g1.y, g1.z, g1.w};
        float ss = 0.f;
#pragma unroll
        for (int e = 0; e < 16; ++e) ss += x[e] * x[e];
        const float r = rsqrtf(sum8lanes(ss) * (1.f / HD) + EPS);
        unsigned ow[8];
#pragma unroll
        for (int q = 0; q < 8; ++q) ow[q] = pk2(x[2 * q] * r * gn[2 * q] * sigmoidf_(bflo(gw[q])), x[2 * q + 1] * r * gn[2 * q + 1] * sigmoidf_(bfhi(gw[q])));
        unsigned* dst = (unsigned*)(OH + row * (3 * BW) + lane * 16);
        *(u32x4*)dst = (u32x4){ow[0], ow[1], ow[2], ow[3]}; *(u32x4*)(dst + 4) = (u32x4){ow[4], ow[5], ow[6], ow[7]};
    }
}
__device__ __forceinline__ void cvec_item(Frame& F, KArgs a, int layer, int blk) {
    const int j = blk >> 5, ks = blk & 31;
    const float* pos = a->in[I_CPOS] + (size_t)(layer * 2 + j) * 32 * HD; const float* w1 = a->in[I_CW1] + (size_t)(layer * 2 + j) * 32 * HD * HD;
    LAS float* red = (LAS float*)F.lds; const int e = F.tid & 127, sub = F.tid >> 7;
    float acc = 0.f;
#pragma unroll 8
    for (int k = ks * 128 + sub * 32; k < ks * 128 + sub * 32 + 32; ++k) acc += pos[k] * w1[(size_t)k * HD + e];
    __syncthreads(); red[sub * 128 + e] = acc; __syncthreads();
    if (F.tid < 128) ((float*)(F.ctl + CW_CVEC))[(j * 32 + ks) * 128 + F.tid] = (red[F.tid] + red[128 + F.tid]) + (red[256 + F.tid] + red[384 + F.tid]);
    __syncthreads();
}
__device__ __forceinline__ void item_compress(Frame& F, KArgs a, int layer, int id) {
    const int j = id >> 7, rem = id & 127, b = rem >> 3, g = (rem >> 2) & 1, n0 = (rem & 3) * 32;
    const bf16_t* P = (const bf16_t*)(F.ws + WS_P);
    LAS float* red = (LAS float*)F.lds;
    LAS float* hid = (LAS float*)(F.lds + 16384);
    LAS float* outv = (LAS float*)(F.lds + 16384 + 32 * 132 * 4);
    const int tid = F.tid, lane = F.lane, wave = F.wave, r = lane & 31, h = lane >> 5, ct = wave & 3, kh = wave >> 2;
    f32x16 acc;
#pragma unroll
    for (int i = 0; i < 16; ++i) acc[i] = 0.f;
    {
        int trow = 16 * (n0 + r) + 16 * kh; const int tmax = T - 1;
        const bf16_t* Ab = P + (size_t)(b * T) * NPC + (j ? PVC : PKC) + g * HD + 8 * h;
        const bf16_t* Bb = (const bf16_t*)(F.ws + WS_MISC + MISC_WC1) + (size_t)(j * HD + 32 * ct + r) * 4096 + (size_t)(16 * kh) * HD + 8 * h;
        for (int l = 0; l < 16; ++l) { const int t = (trow + l) < tmax ? (trow + l) : tmax; const bf16_t* ap = Ab + (size_t)t * NPC; const bf16_t* bp = Bb + l * HD;
#pragma unroll
            for (int ds = 0; ds < 8; ++ds) { const bf16x8 av = *(const bf16x8*)(ap + 16 * ds), bv = *(const bf16x8*)(bp + 16 * ds); acc = MFMA32(av, bv, acc); } }
    }
    if (kh == 1) {
#pragma unroll
        for (int i = 0; i < 16; ++i) red[(ct * 16 + i) * 64 + lane] = acc[i]; }
    __syncthreads();
    if (kh == 0) { float cv = 0.f; { const float* cp = (const float*)(F.ctl + CW_CVEC) + (size_t)(j * 32) * 128 + 32 * ct + r;
#pragma unroll 8
        for (int q = 0; q < 32; ++q) cv += cp[q * 128]; }
#pragma unroll
        for (int i = 0; i < 16; ++i) { const float x = acc[i] + red[(ct * 16 + i) * 64 + lane] + cv;
            const float y = 0.7978845608028654f * (x + 0.044715f * x * x * x);
            const float th = 1.f - 2.f * fast_rcp(1.f + fast_exp2(2.f * y * LOG2E));
            hid[crow(i, h) * 132 + 32 * ct + r] = 0.5f * x * (1.f + th); } }
    __syncthreads();
    { const int e2 = tid & 127, ng = __builtin_amdgcn_readfirstlane(tid >> 7); const float* w2 = a->in[I_CW2] + (size_t)(layer * 2 + j) * HD * HD + e2;
      float o[8];
#pragma unroll
      for (int q = 0; q < 8; ++q) o[q] = 0.f;
      for (int k = 0; k < 128; k += 4) { const float w0 = w2[(size_t)k * HD], w1 = w2[(size_t)(k + 1) * HD], w2_ = w2[(size_t)(k + 2) * HD], w3 = w2[(size_t)(k + 3) * HD];
#pragma unroll
          for (int q = 0; q < 8; ++q) { const f32x4 hv = *(const LAS f32x4*)(hid + (8 * ng + q) * 132 + k); o[q] += (hv.x * w0 + hv.y * w1) + (hv.z * w2_ + hv.w * w3); } }
#pragma unroll
      for (int q = 0; q < 8; ++q) outv[(8 * ng + q) * 132 + e2] = o[q]; }
    __syncthreads();
    const float* kg0 = a->in[I_KG] + layer * 3 * HD;
#pragma unroll
    for (int q = 0; q < 4; ++q) { const int n = 4 * wave + q; float v0 = outv[n * 132 + 2 * lane], v1 = outv[n * 132 + 2 * lane + 1];
        if (j == 0) { const float ss = wave_sum(v0 * v0 + v1 * v1); const float rr = rsqrtf(ss * (1.f / HD) + EPS); v0 *= rr * kg0[2 * lane]; v1 *= rr * kg0[2 * lane + 1]; }
        if (n0 + n >= 127) { v0 = 0.f; v1 = 0.f; }
        bf16_t* dst = (bf16_t*)(F.ws + WS_MISC + (j ? MISC_VCMP : MISC_KCMP)) + (size_t)((b * 2 + g) * 128 + n0 + n) * HD;
        *((unsigned*)dst + lane) = pk2(v0, v1); }
}
constexpr int HG_Q1 = 0, HG_K1 = 17408, HG_QI = 34816, HG_K2 = 43520, HG_K3T = 52224, HG_VT = 70656, HG_AT = 79872, HG_SB = 89088, HG_TOT = 123904, HG_LB = 125952;
__device__ __forceinline__ void item_hgrn(Frame& F, KArgs a, int layer, int id) {
    const int b = id >> 4, hh = (id >> 1) & 7, half = id & 1;
    const bf16_t* P = (const bf16_t*)(F.ws + WS_P); float* OR = (float*)(F.ws + WS_ORAW);
    LAS unsigned char* L = F.lds;
    LAS float* tot = (LAS float*)(L + HG_TOT); LAS float* lbs = (LAS float*)(L + HG_LB);
    const int tid = F.tid, lane = F.lane, wave = F.wave, r = lane & 31, h = lane >> 5;
    if (tid < 128) { const float* hb = a->in[I_HLB] + hh * HD + tid; const float x0 = hb[0], x1 = hb[1024], x2 = hb[2048], x3 = hb[3072];
        const float mx = fmaxf(fmaxf(x0, x1), fmaxf(x2, x3)); const float e0 = __expf(x0 - mx), e1 = __expf(x1 - mx), e2 = __expf(x2 - mx), e3 = __expf(x3 - mx);
        const float inv = 1.f / (e0 + e1 + e2 + e3); float c = 0.f; if (layer >= 1) c += e1; if (layer >= 2) c += e2; if (layer >= 3) c += e3;
        lbs[tid] = fmaxf(c * inv, 0.f); }
    { unsigned zu; asm volatile("v_mov_b32 %0, 0" : "=v"(zu));
      for (int i = tid; i < 17408 / 16; i += 512) *(LAS u32x4*)(L + HG_SB + i * 16) = (u32x4){zu, zu, zu, zu}; }
    f32x16 Sacc;
#pragma unroll
    for (int i = 0; i < 16; ++i) Sacc[i] = 0.f;
    const int pd = tid & 127, psc = __builtin_amdgcn_readfirstlane(tid >> 7);
    const int srow = tid >> 4, sch = tid & 15, vrow = tid >> 3, vch = tid & 7;
    const bf16_t* gq = P + (size_t)(b * T + srow) * NPC + PQH + hh * HD + sch * 8; const bf16_t* gf = P + (size_t)(b * T + srow) * NPC + PFH + hh * HD + sch * 8;
    const bf16_t* gv = P + (size_t)(b * T + vrow) * NPC + PIH + hh * HD + half * 64 + vch * 8;
    u32x4 rq0 = *(const u32x4*)gq, rq1 = *(const u32x4*)(gq + (size_t)32 * NPC), rf0 = *(const u32x4*)gf, rf1 = *(const u32x4*)(gf + (size_t)32 * NPC), rv = *(const u32x4*)gv;
    for (int c = 0; c < T / 64; ++c) {
        __syncthreads();
        *(LAS u32x4*)(L + HG_Q1 + srow * 272 + sch * 16) = rq0; *(LAS u32x4*)(L + HG_Q1 + (srow + 32) * 272 + sch * 16) = rq1;
        *(LAS u32x4*)(L + HG_K1 + srow * 272 + sch * 16) = rf0; *(LAS u32x4*)(L + HG_K1 + (srow + 32) * 272 + sch * 16) = rf1;
        { const unsigned vw[4] = {rv.x, rv.y, rv.z, rv.w};
#pragma unroll
          for (int q = 0; q < 4; ++q) { *(LAS unsigned short*)(L + HG_VT + (8 * vch + 2 * q) * 144 + vrow * 2) = (unsigned short)(vw[q] & 0xffffu); *(LAS unsigned short*)(L + HG_VT + (8 * vch + 2 * q + 1) * 144 + vrow * 2) = (unsigned short)(vw[q] >> 16); } }
        __syncthreads();
        if (c + 1 < T / 64) { const size_t adv = (size_t)(64 * (c + 1)) * NPC;
            rq0 = *(const u32x4*)(gq + adv); rq1 = *(const u32x4*)(gq + adv + (size_t)32 * NPC); rf0 = *(const u32x4*)(gf + adv); rf1 = *(const u32x4*)(gf + adv + (size_t)32 * NPC); rv = *(const u32x4*)(gv + adv); }
        float qv[16], kv[16], bl[16];
        { const float lb = lbs[pd]; float run = 0.f;
#pragma unroll
          for (int tt = 0; tt < 16; ++tt) { const int t = 16 * psc + tt;
              qv[tt] = bf2f(*(const LAS unsigned short*)(L + HG_Q1 + t * 272 + pd * 2)); const float fp = bf2f(*(const LAS unsigned short*)(L + HG_K1 + t * 272 + pd * 2));
              const float ex = fast_exp2(-fabsf(fp) * LOG2E);
              const float sg = (fp >= 0.f ? 1.f : ex) * fast_rcp(1.f + ex);
              const float f = lb + (1.f - lb) * sg; kv[tt] = 1.f - f;
              const float lf = (layer == 0) ? (fminf(fp, 0.f) - LN2 * fast_log2(1.f + ex)) : LN2 * fast_log2(f);
              run += lf; bl[tt] = run; }
          tot[psc * 128 + pd] = run; }
        __syncthreads();
        { const float t0 = tot[pd], t1 = tot[128 + pd], t2 = tot[256 + pd], t3 = tot[384 + pd];
          const float b31 = t0 + t1, b63 = (t0 + t1) + (t2 + t3);
          const float pre = psc == 0 ? 0.f : (psc == 1 ? t0 : (psc == 2 ? b31 : b31 + t2));
          const float rref = psc >= 2 ? b31 : 0.f; const float eb31 = fast_exp2(b31 * LOG2E), c3 = fast_exp2((b63 - rref) * LOG2E);
          unsigned k3w[8];
#pragma unroll
          for (int tt = 0; tt < 16; ++tt) { const int t = 16 * psc + tt; const float bb = pre + bl[tt];
              const float e1 = fast_exp2((bb - rref) * LOG2E); const float q1 = qv[tt] * e1;
              const float k1 = kv[tt] * fast_exp2(fminf(rref - bb, 80.f) * LOG2E);
              const float k3 = k1 * c3;
              *(LAS unsigned short*)(L + HG_Q1 + t * 272 + pd * 2) = (unsigned short)(pk2(q1, 0.f) & 0xffffu);
              *(LAS unsigned short*)(L + HG_K1 + t * 272 + pd * 2) = (unsigned short)(pk2(k1, 0.f) & 0xffffu);
              if (psc >= 2) *(LAS unsigned short*)(L + HG_QI + (t - 32) * 272 + pd * 2) = (unsigned short)(pk2(q1 * eb31, 0.f) & 0xffffu);
              else *(LAS unsigned short*)(L + HG_K2 + t * 272 + pd * 2) = (unsigned short)(pk2(k1 * eb31, 0.f) & 0xffffu);
              if (tt & 1) k3w[tt >> 1] = (k3w[tt >> 1] & 0xffffu) | (pk2(0.f, k3) & 0xffff0000u); else k3w[tt >> 1] = pk2(k3, 0.f) & 0xffffu; }
          *(LAS u32x4*)(L + HG_K3T + pd * 144 + psc * 32) = (u32x4){k3w[0], k3w[1], k3w[2], k3w[3]}; *(LAS u32x4*)(L + HG_K3T + pd * 144 + psc * 32 + 16) = (u32x4){k3w[4], k3w[5], k3w[6], k3w[7]}; }
        __syncthreads();
        if (wave < 3) {
            const int st = wave == 1 ? 1 : 0, tt2 = wave == 0 ? 0 : 1;
            const LAS unsigned char* Kb = L + (wave == 2 ? HG_K2 : HG_K1 + st * 32 * 272) + r * 272 + 16 * h; const LAS unsigned char* Qb = L + HG_Q1 + (32 * tt2 + r) * 272 + 16 * h;
            f32x16 at;
#pragma unroll
            for (int i = 0; i < 16; ++i) at[i] = 0.f;
#pragma unroll
            for (int s8 = 0; s8 < 8; ++s8) at = MFMA32(*(const LAS bf16x8*)(Kb + 32 * s8), *(const LAS bf16x8*)(Qb + 32 * s8), at);
            if (wave < 2) {
#pragma unroll
                for (int i = 0; i < 16; ++i) at[i] = (crow(i, h) <= r) ? at[i] : 0.f; }
#pragma unroll
            for (int g4 = 0; g4 < 4; ++g4) { u32x2 w; w.x = pk2(at[4 * g4], at[4 * g4 + 1]); w.y = pk2(at[4 * g4 + 2], at[4 * g4 + 3]);
                *(LAS u32x2*)(L + HG_AT + (32 * tt2 + r) * 144 + (32 * st + 8 * g4 + 4 * h) * 2) = w; }
        }
        {   const int et = wave & 1, dt = wave >> 1; const int dd = 32 * dt + r;
            const float eb63 = fast_exp2(((tot[dd] + tot[128 + dd]) + (tot[256 + dd] + tot[384 + dd])) * LOG2E);
#pragma unroll
            for (int i = 0; i < 16; ++i) Sacc[i] *= eb63;
            const LAS unsigned char* Vb = L + HG_VT + (32 * et + r) * 144 + 16 * h; const LAS unsigned char* Kb = L + HG_K3T + dd * 144 + 16 * h;
#pragma unroll
            for (int s4 = 0; s4 < 4; ++s4) Sacc = MFMA32(*(const LAS bf16x8*)(Vb + 32 * s4), *(const LAS bf16x8*)(Kb + 32 * s4), Sacc);
            LAS unsigned char* Sw = L + HG_SB + ((c + 1) & 1) * 17408 + dd * 2;
#pragma unroll
            for (int i = 0; i < 16; i += 2) { const unsigned w = pk2(Sacc[i], Sacc[i + 1]);
                *(LAS unsigned short*)(Sw + (32 * et + crow(i, h)) * 272) = (unsigned short)(w & 0xffffu); *(LAS unsigned short*)(Sw + (32 * et + crow(i + 1, h)) * 272) = (unsigned short)(w >> 16); }
        }
        __syncthreads();
        if (wave < 4) {
            const int et = wave & 1, tt2 = wave >> 1;
            f32x16 oo;
#pragma unroll
            for (int i = 0; i < 16; ++i) oo[i] = 0.f;
            const LAS unsigned char* Sb = L + HG_SB + (c & 1) * 17408 + (32 * et + r) * 272 + 16 * h; const LAS unsigned char* Qb = L + (tt2 ? HG_QI : HG_Q1) + r * 272 + 16 * h;
#pragma unroll
            for (int s8 = 0; s8 < 8; ++s8) oo = MFMA32(*(const LAS bf16x8*)(Sb + 32 * s8), *(const LAS bf16x8*)(Qb + 32 * s8), oo);
            const LAS unsigned char* Vb = L + HG_VT + (32 * et + r) * 144 + 16 * h; const LAS unsigned char* Ab = L + HG_AT + (32 * tt2 + r) * 144 + 16 * h;
            oo = MFMA32(*(const LAS bf16x8*)(Vb), *(const LAS bf16x8*)(Ab), oo); oo = MFMA32(*(const LAS bf16x8*)(Vb + 32), *(const LAS bf16x8*)(Ab + 32), oo);
            if (tt2) { oo = MFMA32(*(const LAS bf16x8*)(Vb + 64), *(const LAS bf16x8*)(Ab + 64), oo); oo = MFMA32(*(const LAS bf16x8*)(Vb + 96), *(const LAS bf16x8*)(Ab + 96), oo); }
            float* op = OR + (size_t)(b * T + 64 * c + 32 * tt2 + r) * BW + hh * HD + half * 64 + 32 * et + 4 * h;
#pragma unroll
            for (int g4 = 0; g4 < 4; ++g4) *(f32x4*)(op + 8 * g4) = (f32x4){oo[4 * g4], oo[4 * g4 + 1], oo[4 * g4 + 2], oo[4 * g4 + 3]};
        }
    }
}

constexpr int AT_K = 0, AT_V = 32768, AT_TAB = 73728, AT_IMP = 75776, AT_SELM = 109568, AT_MISC = 109824;
constexpr int K_TB = 16384, V_RS = 320, V_TB = 64 * V_RS;
__device__ __forceinline__ unsigned koff(int row, int ch) { return 256u * (unsigned)row + 16u * (unsigned)(ch ^ (((row & 3) << 2) | ((row >> 2) & 3))); }
struct Stg { u32x4 k0, k1, v0, v1; };
__device__ __forceinline__ void stg_load(Stg& s, const bf16_t* Kp, const bf16_t* Vp, int ld, int tid) {
    const int row = tid >> 4, ch = tid & 15;
    s.k0 = *(const u32x4*)(Kp + (size_t)row * ld + ch * 8); s.k1 = *(const u32x4*)(Kp + (size_t)(row + 32) * ld + ch * 8);
    s.v0 = *(const u32x4*)(Vp + (size_t)row * ld + ch * 8); s.v1 = *(const u32x4*)(Vp + (size_t)(row + 32) * ld + ch * 8);
}
__device__ __forceinline__ void stg_write(const Stg& s, LAS unsigned char* L, int tid, int buf) {
    const int row = tid >> 4, ch = tid & 15;
    *(LAS u32x4*)(L + AT_K + buf * K_TB + koff(row, ch)) = s.k0; *(LAS u32x4*)(L + AT_K + buf * K_TB + koff(row + 32, ch)) = s.k1;
    *(LAS u32x4*)(L + AT_V + buf * V_TB + row * V_RS + ch * 16) = s.v0; *(LAS u32x4*)(L + AT_V + buf * V_TB + (row + 32) * V_RS + ch * 16) = s.v1;
}
__device__ __forceinline__ float xhalf_max(float v) { auto rr = __builtin_amdgcn_permlane32_swap(__float_as_uint(v), __float_as_uint(v), false, false); return fmaxf(__uint_as_float(rr[0]), __uint_as_float(rr[1])); }
__device__ __forceinline__ float xhalf_sum(float v) { auto rr = __builtin_amdgcn_permlane32_swap(__float_as_uint(v), __float_as_uint(v), false, false); return __uint_as_float(rr[0]) + __uint_as_float(rr[1]); }
__device__ __forceinline__ float xhalf_get(float v, int h) { auto rr = __builtin_amdgcn_permlane32_swap(__float_as_uint(v), __float_as_uint(v), false, false); return __uint_as_float(h ? rr[0] : rr[1]); }
__device__ __forceinline__ void qk_tile(f32x16& p0, f32x16& p1, const LAS unsigned char* L, int buf, const bf16x8 (&qf)[8], int r, int h) {
#pragma unroll
    for (int i = 0; i < 16; ++i) { p0[i] = 0.f; p1[i] = 0.f; }
    const LAS unsigned char* Kb = L + AT_K + buf * K_TB;
    bf16x8 a0[8], a1[8];
#pragma unroll
    for (int s = 0; s < 8; ++s) { a0[s] = *(const LAS bf16x8*)(Kb + koff(r, 2 * s + h)); a1[s] = *(const LAS bf16x8*)(Kb + koff(r + 32, 2 * s + h)); }
#pragma unroll
    for (int s = 0; s < 8; ++s) { p0 = MFMA32(a0[s], qf[s], p0); p1 = MFMA32(a1[s], qf[s], p1); }
    __builtin_amdgcn_sched_group_barrier(0x100, 4, 0);
#pragma unroll
    for (int i = 0; i < 6; ++i) { __builtin_amdgcn_sched_group_barrier(0x008, 2, 0); __builtin_amdgcn_sched_group_barrier(0x100, 2, 0); }
    __builtin_amdgcn_sched_group_barrier(0x008, 4, 0);
}
__device__ __forceinline__ bf16x8 pack8(const f32x16& p, int s) {
    u32x4 w; w.x = pk2(p[8 * s], p[8 * s + 1]); w.y = pk2(p[8 * s + 2], p[8 * s + 3]); w.z = pk2(p[8 * s + 4], p[8 * s + 5]); w.w = pk2(p[8 * s + 6], p[8 * s + 7]);
    return __builtin_bit_cast(bf16x8, w);
}
__device__ __forceinline__ void pv_tile(f32x16 (&o)[4], const f32x16& p0, const f32x16& p1, const LAS unsigned char* L, int buf, int lane) {
    bf16x8 pb[4]; pb[0] = pack8(p0, 0); pb[1] = pack8(p0, 1); pb[2] = pack8(p1, 0); pb[3] = pack8(p1, 1);
    const LAS unsigned char* vb = L + AT_V + buf * V_TB + (4 * (lane >> 5) + ((lane & 15) >> 2)) * V_RS + ((lane >> 4) & 1) * 32 + (lane & 3) * 8;
    __builtin_amdgcn_sched_barrier(0);
    s16x4 lo[16], hi[16];
#pragma unroll
    for (int c = 0; c < 4; ++c)
#pragma unroll
        for (int s = 0; s < 4; ++s) { lo[4 * c + s] = __builtin_amdgcn_ds_read_tr16_b64_v4i16((LAS s16x4*)(vb + (16 * s) * V_RS + 64 * c)); hi[4 * c + s] = __builtin_amdgcn_ds_read_tr16_b64_v4i16((LAS s16x4*)(vb + (16 * s + 8) * V_RS + 64 * c)); }
#pragma unroll
    for (int c = 0; c < 4; ++c)
#pragma unroll
        for (int s = 0; s < 4; ++s) o[c] = MFMA32(__builtin_shufflevector(lo[4 * c + s], hi[4 * c + s], 0, 1, 2, 3, 4, 5, 6, 7), pb[s], o[c]);
    __builtin_amdgcn_sched_group_barrier(0x100, 4, 1);
#pragma unroll
    for (int i = 0; i < 14; ++i) { __builtin_amdgcn_sched_group_barrier(0x008, 1, 1); __builtin_amdgcn_sched_group_barrier(0x100, 2, 1); }
    __builtin_amdgcn_sched_group_barrier(0x008, 2, 1);
    __builtin_amdgcn_sched_barrier(0);
}
__device__ __forceinline__ void softmax_step(f32x16& p0, f32x16& p1, float& m, float& l, f32x16 (&o)[4]) {
    float mx = p0[0];
#pragma unroll
    for (int i = 1; i < 16; ++i) mx = fmaxf(mx, p0[i]);
#pragma unroll
    for (int i = 0; i < 16; ++i) mx = fmaxf(mx, p1[i]);
    mx = xhalf_max(mx);
    const float mn = fmaxf(m, mx); const float alpha = fast_exp2((m - mn) * LOG2E); m = mn;
    const float mb = mn * LOG2E; float ps = 0.f;
#pragma unroll
    for (int i = 0; i < 16; ++i) { p0[i] = fast_exp2(p0[i] * LOG2E - mb); ps += p0[i]; }
#pragma unroll
    for (int i = 0; i < 16; ++i) { p1[i] = fast_exp2(p1[i] * LOG2E - mb); ps += p1[i]; }
    ps = xhalf_sum(ps);
    l = l * alpha + ps;
    if (!__all(alpha == 1.f)) {
#pragma unroll
        for (int c = 0; c < 4; ++c)
#pragma unroll
            for (int i = 0; i < 16; ++i) o[c][i] *= alpha; }
}
__device__ __forceinline__ void store_ot(const f32x16 (&o)[4], float sc, bf16_t* dst  , int h, bool add) {
#pragma unroll
    for (int c = 0; c < 4; ++c)
#pragma unroll
        for (int g4 = 0; g4 < 4; ++g4) { u32x2* p = (u32x2*)(dst + 32 * c + 8 * g4 + 4 * h);
            float v0 = sc * o[c][4 * g4], v1 = sc * o[c][4 * g4 + 1], v2 = sc * o[c][4 * g4 + 2], v3 = sc * o[c][4 * g4 + 3];
            if (add) { const u32x2 w0 = *p; v0 += bflo(w0.x); v1 += bfhi(w0.x); v2 += bflo(w0.y); v3 += bfhi(w0.y); }
            u32x2 w; w.x = pk2(v0, v1); w.y = pk2(v2, v3); *p = w; }
}

__device__ __forceinline__ void item_sb(Frame& F, KArgs a, int item) {
    LAS unsigned char* L = F.lds;
    const int qb = 7 - (item >> 7), rem = item & 127, b = rem >> 3, hh = rem & 7, t0 = qb * 256;
    const int tid = F.tid, lane = F.lane, wave = F.wave, r = lane & 31, h = lane >> 5;
    const int tq = t0 + 32 * wave + r;
    const bf16_t* P = (const bf16_t*)(F.ws + WS_P); const size_t rowq = (size_t)(b * T + tq);
    const bf16_t* Kb = P + (size_t)(b * T) * NPC + PKSB + hh * HD; const bf16_t* Vb = P + (size_t)(b * T) * NPC + PVSB + hh * HD;
    bf16x8 qf[8];
#pragma unroll
    for (int s = 0; s < 8; ++s) qf[s] = *(const bf16x8*)(P + rowq * NPC + PQS + hh * HD + 16 * s + 8 * h);
    f32x16 o[4];
#pragma unroll
    for (int c = 0; c < 4; ++c)
#pragma unroll
        for (int i = 0; i < 16; ++i) o[c][i] = 0.f;
    float C = 0.f; bool wdone = false;
    volatile LAS unsigned* flags = (volatile LAS unsigned*)(L + AT_MISC);
    Stg st; int j = 4 * qb + 3, buf = 0, it = 0;
    stg_load(st, Kb + (size_t)(64 * j) * NPC, Vb + (size_t)(64 * j) * NPC, NPC, tid);
    __syncthreads();
    stg_write(st, L, tid, 0);
    if (j > 0) stg_load(st, Kb + (size_t)(64 * (j - 1)) * NPC, Vb + (size_t)(64 * (j - 1)) * NPC, NPC, tid);
    for (;;) {
        if (lane == 0) flags[(it & 1) * 8 + wave] = wdone ? 1u : 0u;
        __syncthreads();
        unsigned nd = 0;
#pragma unroll
        for (int w = 0; w < 8; ++w) nd += flags[(it & 1) * 8 + w];
        if (__builtin_amdgcn_readfirstlane(nd) == 8u) break;
        if (j > 0) stg_write(st, L, tid, buf ^ 1);
        if (j > 1) stg_load(st, Kb + (size_t)(64 * (j - 2)) * NPC, Vb + (size_t)(64 * (j - 2)) * NPC, NPC, tid);
        const bool active = !wdone && (64 * j <= t0 + 32 * wave + 30);
        if (active) {
            f32x16 p0, p1; qk_tile(p0, p1, L, buf, qf, r, h);
            float lm0[16], lm1[16];
            const int kb = 64 * j + 4 * h;
#pragma unroll
            for (int i = 0; i < 16; ++i) {
                const int key0 = kb + (i & 3) + 8 * (i >> 2);
                { const float z = p0[i] * QSCALE; const float sp = fmaxf(z, 0.f) + LN2 * fast_log2(1.f + fast_exp2(-fabsf(z) * LOG2E)); const bool cz = key0 < tq; lm0[i] = cz ? -sp : 0.f; p0[i] = z - sp; }
                { const float z = p1[i] * QSCALE; const float sp = fmaxf(z, 0.f) + LN2 * fast_log2(1.f + fast_exp2(-fabsf(z) * LOG2E)); const bool cz = key0 + 32 < tq; lm1[i] = cz ? -sp : 0.f; p1[i] = z - sp; }
            }
            float Tm[2][4], Tr[2][4];
#pragma unroll
            for (int g4 = 0; g4 < 4; ++g4) { Tm[0][g4] = (lm0[4 * g4] + lm0[4 * g4 + 1]) + (lm0[4 * g4 + 2] + lm0[4 * g4 + 3]); Tm[1][g4] = (lm1[4 * g4] + lm1[4 * g4 + 1]) + (lm1[4 * g4 + 2] + lm1[4 * g4 + 3]); }
#pragma unroll
            for (int k = 0; k < 2; ++k)
#pragma unroll
                for (int g4 = 0; g4 < 4; ++g4) Tr[k][g4] = xhalf_get(Tm[k][g4], h);
            float aft[2][4]; float run = C;
#pragma unroll
            for (int G = 15; G >= 0; --G) { const int k = G >> 3, g4 = (G >> 1) & 3, par = G & 1;
                const float tg = (par == 1) ? (h ? Tm[k][g4] : Tr[k][g4]) : (h ? Tr[k][g4] : Tm[k][g4]);
                if (par == 1) { if (h) aft[k][g4] = run; } else { if (!h) aft[k][g4] = run; }
                run += tg; }
            C = run;
#pragma unroll
            for (int g4 = 0; g4 < 4; ++g4) {
                { float ca = aft[0][g4];
#pragma unroll
                  for (int e = 3; e >= 0; --e) { const int i = 4 * g4 + e; const float la = p0[i] + ca; ca += lm0[i]; p0[i] = (kb + e + 8 * g4 < tq) ? fast_exp2(la * LOG2E) : 0.f; } }
                { float ca = aft[1][g4];
#pragma unroll
                  for (int e = 3; e >= 0; --e) { const int i = 4 * g4 + e; const float la = p1[i] + ca; ca += lm1[i]; p1[i] = (kb + 32 + e + 8 * g4 < tq) ? fast_exp2(la * LOG2E) : 0.f; } }
            }
            pv_tile(o, p0, p1, L, buf, lane);
            wdone = __all(C < -104.f);
        }
        if (j == 0) break;
        --j; buf ^= 1; ++it;
    }
    bf16_t* OS = (bf16_t*)(F.ws + WS_OBR) + BW;
    store_ot(o, 1.f, OS + rowq * (3 * BW) + hh * HD, h, false);
}

__device__ __forceinline__ void item_nsa(Frame& F, KArgs a, int item) {
    LAS unsigned char* L = F.lds;
    const int qblk = 31 - (item >> 5), rem = item & 31, b = rem >> 1, g = rem & 1, t0 = qblk * 64;
    const int tid = F.tid, lane = F.lane, wave = F.wave, r = lane & 31, h = lane >> 5, hr = wave >> 1, th = wave & 1;
    const int tl = 32 * th + r, tq = t0 + tl, hq = g * 4 + hr;
    const bf16_t* P = (const bf16_t*)(F.ws + WS_P);
    LAS float* tab = (LAS float*)(L + AT_TAB); LAS float* imp = (LAS float*)(L + AT_IMP); volatile LAS unsigned* selm = (volatile LAS unsigned*)(L + AT_SELM); LAS unsigned* misc = (LAS unsigned*)(L + AT_MISC);
    { const int hh = tid >> 7, dd = tid & 127; tab[tid] = a->in[I_RELB][t5_bucket(dd) * 8 + g * 4 + hh]; }
    if (tid == 0) misc[0] = 0u;
    bf16x8 qf[8];
#pragma unroll
    for (int s = 0; s < 8; ++s) qf[s] = *(const bf16x8*)(P + (size_t)(b * T + tq) * NPC + PQN + hq * HD + 16 * s + 8 * h);
    f32x16 o[4];
    Stg st;
    auto opq = [](int v) { asm volatile("" : "+v"(v)); return v; };
#define NSA_GATE(i) sigmoidf_(bf2f(P[((size_t)(b * T + opq(tq))) * NPC + PGN + hq * 3 + (i)]))
#define NSA_OUT() ((bf16_t*)(F.ws + WS_OBR) + ((size_t)(b * T + opq(tq))) * (3 * BW) + hq * HD)
    {
        const bf16_t* kc = (const bf16_t*)(F.ws + WS_MISC + MISC_KCMP) + (size_t)((b * 2 + g) * 128) * HD; const bf16_t* vc = (const bf16_t*)(F.ws + WS_MISC + MISC_VCMP) + (size_t)((b * 2 + g) * 128) * HD;
        const bool two = qblk >= 16;
        f32x16 pc[4];
        __syncthreads();
        { Stg st1; stg_load(st, kc, vc, HD, tid); if (two) stg_load(st1, kc + 64 * HD, vc + 64 * HD, HD, tid);
          stg_write(st, L, tid, 0); if (two) stg_write(st1, L, tid, 1); }
        __syncthreads();
        qk_tile(pc[0], pc[1], L, 0, qf, r, h);
        if (two) qk_tile(pc[2], pc[3], L, 1, qf, r, h);
        float mx = -1e30f;
#pragma unroll
        for (int k = 0; k < 4; ++k) { if (k >= 2 && !two) break;
#pragma unroll
            for (int i = 0; i < 16; ++i) { const int n = 32 * k + crow(i, h); const int dc = tq - (16 * n + 31); const int di = dc < 113 ? dc : 113;
                const float sv = dc >= 0 ? pc[k][i] + tab[hr * 128 + (di < 0 ? 0 : di)] : -__builtin_inff(); pc[k][i] = sv; mx = fmaxf(mx, sv); } }
        mx = xhalf_max(mx);
        float sum = 0.f;
#pragma unroll
        for (int k = 0; k < 4; ++k) { if (k >= 2 && !two) break;
#pragma unroll
            for (int i = 0; i < 16; ++i) { const float e = fast_exp2((pc[k][i] - mx) * LOG2E); pc[k][i] = e; sum += e; } }
        sum = xhalf_sum(sum);
        const float inv = 1.f / fmaxf(sum, 1e-30f);
#pragma unroll
        for (int k = 0; k < 4; ++k)
#pragma unroll
            for (int i = 0; i < 16; ++i) pc[k][i] = (k >= 2 && !two) ? 0.f : pc[k][i] * inv;
        float gs[16], gl[16], rc[16];
#pragma unroll
        for (int k = 0; k < 4; ++k)
#pragma unroll
            for (int g4 = 0; g4 < 4; ++g4) { gs[4 * k + g4] = (pc[k][4 * g4] + pc[k][4 * g4 + 1]) + (pc[k][4 * g4 + 2] + pc[k][4 * g4 + 3]); gl[4 * k + g4] = pc[k][4 * g4 + 3]; }
#pragma unroll
        for (int f = 0; f < 16; ++f) rc[f] = xhalf_get(gl[f], h);
#pragma unroll
        for (int f = 0; f < 16; ++f) { const float prev = h ? rc[f] : (f >= 1 ? rc[f - 1] : 0.f); const int G = 8 * (f >> 2) + 2 * (f & 3) + h;
            imp[(hr * 64 + tl) * 33 + G] = gs[f] + prev; }
#pragma unroll
        for (int c = 0; c < 4; ++c)
#pragma unroll
            for (int i = 0; i < 16; ++i) o[c][i] = 0.f;
        pv_tile(o, pc[0], pc[1], L, 0, lane);
        if (two) pv_tile(o, pc[2], pc[3], L, 1, lane);
        store_ot(o, NSA_GATE(0), NSA_OUT(), h, false);
    }
    __syncthreads();
    const int tk = tid >> 3, part = tid & 7;
    if (qblk >= 16) {
#pragma unroll
        for (int q = 0; q < 4; ++q) { const int jj = part + 8 * q; imp[tk * 33 + jj] = (imp[tk * 33 + jj] + imp[(64 + tk) * 33 + jj]) + (imp[(128 + tk) * 33 + jj] + imp[(192 + tk) * 33 + jj]); }
    }
    __syncthreads();
    {
        unsigned msk;
        if (qblk < 16) msk = (2u << qblk) - 1u;
        else {
            msk = 0u;
#pragma unroll
            for (int q = 0; q < 4; ++q) { const int jj = part + 8 * q;
                if (jj >= 1 && jj <= qblk - 2) { const float v = imp[tk * 33 + jj]; int rank = 0;
#pragma unroll
                    for (int j2 = 1; j2 < 30; ++j2) { const float v2 = imp[tk * 33 + j2]; rank += (j2 <= qblk - 2 && (v2 > v || (v2 == v && j2 < jj))) ? 1 : 0; }
                    if (rank < 13) msk |= 1u << jj; } }
            msk |= (unsigned)__shfl_xor((int)msk, 1); msk |= (unsigned)__shfl_xor((int)msk, 2); msk |= (unsigned)__shfl_xor((int)msk, 4);
            msk |= 1u | (1u << (qblk - 1)) | (1u << qblk);
        }
        if (part == 0) selm[tk] = msk;
        unsigned om = msk;
#pragma unroll
        for (int off = 8; off < 64; off <<= 1) om |= (unsigned)__shfl_xor((int)om, off);
        if (lane == 0) __hip_atomic_fetch_or(misc, om, __ATOMIC_RELAXED, __HIP_MEMORY_SCOPE_WORKGROUP);
    }
    __syncthreads();
    const bf16_t* Kbase = P + (size_t)(b * T) * NPC + g * HD;
    const float bfar = tab[hr * 128 + 113];
    for (int rep = 0; rep < (MK_PROBE == 31 ? 2 : 1); ++rep) {
        if (rep) __syncthreads();
        unsigned om = __builtin_amdgcn_readfirstlane(misc[0]); const unsigned mym = selm[tl];
        float m = -1e30f, l = 0.f;
#pragma unroll
        for (int c = 0; c < 4; ++c)
#pragma unroll
            for (int i = 0; i < 16; ++i) o[c][i] = 0.f;
        int jc = __builtin_ctz(om); om &= om - 1u;
        stg_load(st, Kbase + PKS + (size_t)(64 * jc) * NPC, Kbase + PVS + (size_t)(64 * jc) * NPC, NPC, tid);
        stg_write(st, L, tid, 0);
        int jn = om ? __builtin_ctz(om) : -1; if (jn >= 0) { om &= om - 1u; stg_load(st, Kbase + PKS + (size_t)(64 * jn) * NPC, Kbase + PVS + (size_t)(64 * jn) * NPC, NPC, tid); }
        int buf = 0;
        for (;;) {
            __syncthreads();
            if (jn >= 0) stg_write(st, L, tid, buf ^ 1);
            const int jnn = om ? __builtin_ctz(om) : -1; if (jnn >= 0) { om &= om - 1u; stg_load(st, Kbase + PKS + (size_t)(64 * jnn) * NPC, Kbase + PVS + (size_t)(64 * jnn) * NPC, NPC, tid); }
            f32x16 p0, p1; qk_tile(p0, p1, L, buf, qf, r, h);
            const bool sel = (mym >> jc) & 1u;
            if (jc <= qblk - 3) {
#pragma unroll
                for (int i = 0; i < 16; ++i) { p0[i] = sel ? p0[i] + bfar : -__builtin_inff(); p1[i] = sel ? p1[i] + bfar : -__builtin_inff(); }
            } else {
#pragma unroll
                for (int i = 0; i < 16; ++i) { const int d0 = tq - (64 * jc + crow(i, h)), d1 = d0 - 32;
                    const float b0 = tab[hr * 128 + (d0 < 0 ? 0 : (d0 > 113 ? 113 : d0))], b1 = tab[hr * 128 + (d1 < 0 ? 0 : (d1 > 113 ? 113 : d1))];
                    p0[i] = (sel && d0 >= 0) ? p0[i] + b0 : -__builtin_inff(); p1[i] = (sel && d1 >= 0) ? p1[i] + b1 : -__builtin_inff(); }
            }
            softmax_step(p0, p1, m, l, o);
            pv_tile(o, p0, p1, L, buf, lane);
            if (jn < 0) break;
            jc = jn; jn = jnn; buf ^= 1;
        }
        if (rep == (MK_PROBE == 31 ? 1 : 0)) store_ot(o, NSA_GATE(1) / l, NSA_OUT(), h, true);
    }
    for (int rep = 0; rep < (MK_PROBE == 32 ? 2 : 1); ++rep) {
        float m = -1e30f, l = 0.f;
#pragma unroll
        for (int c = 0; c < 4; ++c)
#pragma unroll
            for (int i = 0; i < 16; ++i) o[c][i] = 0.f;
        int jc = qblk >= 8 ? qblk - 8 : 0;
        stg_load(st, Kbase + PKW + (size_t)(64 * jc) * NPC, Kbase + PVW + (size_t)(64 * jc) * NPC, NPC, tid);
        __syncthreads();
        stg_write(st, L, tid, 0);
        if (jc < qblk) stg_load(st, Kbase + PKW + (size_t)(64 * (jc + 1)) * NPC, Kbase + PVW + (size_t)(64 * (jc + 1)) * NPC, NPC, tid);
        int buf = 0;
        for (;;) {
            __syncthreads();
            if (jc < qblk) stg_write(st, L, tid, buf ^ 1);
            if (jc + 1 < qblk) stg_load(st, Kbase + PKW + (size_t)(64 * (jc + 2)) * NPC, Kbase + PVW + (size_t)(64 * (jc + 2)) * NPC, NPC, tid);
            f32x16 p0, p1; qk_tile(p0, p1, L, buf, qf, r, h);
            if (jc <= qblk - 3 && jc >= qblk - 7) {
#pragma unroll
                for (int i = 0; i < 16; ++i) { p0[i] += bfar; p1[i] += bfar; }
            } else {
                const bool far = jc <= qblk - 3;
#pragma unroll
                for (int i = 0; i < 16; ++i) { const int d0 = tq - (64 * jc + crow(i, h)), d1 = d0 - 32;
                    const float b0 = far ? bfar : tab[hr * 128 + (d0 < 0 ? 0 : (d0 > 113 ? 113 : d0))], b1 = far ? bfar : tab[hr * 128 + (d1 < 0 ? 0 : (d1 > 113 ? 113 : d1))];
                    p0[i] = ((unsigned)d0 < 512u) ? p0[i] + b0 : -__builtin_inff(); p1[i] = ((unsigned)d1 < 512u) ? p1[i] + b1 : -__builtin_inff(); }
            }
            softmax_step(p0, p1, m, l, o);
            pv_tile(o, p0, p1, L, buf, lane);
            if (jc == qblk) break;
            ++jc; buf ^= 1;
        }
        if (rep == (MK_PROBE == 32 ? 1 : 0)) store_ot(o, NSA_GATE(2) / l, NSA_OUT(), h, true);
    }
#undef NSA_GATE
#undef NSA_OUT
}

constexpr int NI_H = 256, NI_S = 1024, NI_C = 256, NI_N = 512, NI_A = 1024, NI_F = 512;
#define FRESH_F() do { unsigned on_ = ~0u; asm volatile("" : "+s"(on_)); int t_ = F.wave * 64 + (int)__builtin_amdgcn_mbcnt_hi(on_, __builtin_amdgcn_mbcnt_lo(on_, 0u)); asm volatile("" : "+v"(t_)); F.tid = t_; F.lane = t_ & 63; F.wave = __builtin_amdgcn_readfirstlane(t_ >> 6); } while (0)
__device__ __forceinline__ void phase_Ca(Frame& F, KArgs a, int layer, int bank, int types) {
    unsigned* head = F.ctl + CW_QUEUE + 64 * (layer * 8) + bank * 4096;
    if (types & 1) for (;;) { const int it = q_next(F, head + 0); if (it >= NI_H) break; FRESH_F(); item_hgrn(F, a, layer, it); }
    if (types & 2) for (;;) { const int it = q_next(F, head + 64); if (it >= NI_S) break; FRESH_F(); item_sb(F, a, it); }
    if (types & 4) for (;;) { const int it = q_next(F, head + 128); if (it >= NI_C) break; FRESH_F(); item_compress(F, a, layer, it); }
    if (types & 8) for (;;) { const int it = q_next(F, head + 192); if (it >= NI_N) break; FRESH_F(); item_norm(F, a, layer, it); }
}
__device__ __forceinline__ void phase_Cb(Frame& F, KArgs a, int layer, int bank) {
    unsigned* head = F.ctl + CW_QUEUE + 64 * (layer * 8 + 4) + bank * 4096;
    for (;;) { const int it = q_next(F, head + 0); if (it >= NI_A) break; FRESH_F(); item_nsa(F, a, it); }
    if (MK_PROBE == 34 && bank == 0) for (;;) { const int it = q_next(F, head + 192); if (it >= NI_F) break; FRESH_F(); item_hgfin(F, a, layer, it); }
    for (;;) { const int it = q_next(F, head + 64); if (it >= NI_F) break; FRESH_F(); item_hgfin(F, a, layer, it); }
}

__global__ void __launch_bounds__(512, 2) mega(Args karg) {
    extern __shared__ __attribute__((aligned(16))) unsigned char lds_raw[];
    Frame F;
    F.lds = (LAS unsigned char*)lds_raw; F.MISC = (volatile LAS unsigned*)(F.lds + MISC_OFF);
    F.tid = threadIdx.x; F.lane = F.tid & 63; F.wave = __builtin_amdgcn_readfirstlane(F.tid >> 6); F.G = gridDim.x; F.bid = blockIdx.x;
    KArgs a = (KArgs)__builtin_amdgcn_kernarg_segment_ptr();
    F.ws = a->ws; F.ctl = (unsigned*)(a->ws + WS_CTL);
    if (F.tid < 64) F.MISC[F.tid] = 0u;
    __syncthreads();
    const int lo = karg.ph_lo, hi = karg.ph_hi;
    XcdBarrier bar; bar.bar = F.ctl + CW_BAR; bar.x = 0; bar.st = F.MISC + 8;
    if (hi - lo > 1) bar = xcd_barrier_post(F.ctl + CW_BAR, F.MISC + 8);
#define IN(k) (lo <= (k) && (k) < hi)
#define ON(k) (((MK_PHASE_MASK & MK_BUILD_MASK) >> (k)) & 1)
#define GRID_BAR() do { unsigned* bp_ = (unsigned*)(a->ws + WS_CTL) + CW_BAR; asm volatile("" : "+s"(bp_)); bar.bar = bp_; xcd_barrier(bar); } while (0)
#define SEAM(k) do { if (IN(k) && IN((k) + 1)) GRID_BAR(); } while (0)
    bf16_t* Hb; bf16_t* Pb; const int wave_s = __builtin_amdgcn_readfirstlane(threadIdx.x >> 6);
    for (int layer = 0; layer < DEPTH; ++layer) {
        const int pb = layer * 10;
#define FRESH() do { unsigned on_ = ~0u; asm volatile("" : "+s"(on_)); int t_ = wave_s * 64 + (int)__builtin_amdgcn_mbcnt_hi(on_, __builtin_amdgcn_mbcnt_lo(on_, 0u)); asm volatile("" : "+v"(t_)); F.tid = t_; F.lane = t_ & 63; F.wave = __builtin_amdgcn_readfirstlane(t_ >> 6); \
        asm volatile("" : "+s"(a)); F.ws = a->ws; F.ctl = (unsigned*)(a->ws + WS_CTL); Hb = (bf16_t*)(F.ws + WS_H); Pb = (bf16_t*)(F.ws + WS_P); } while (0)
        if (ON(0) && IN(pb + 0)) { FRESH(); if (MK_PROBE == 0) { phase_A(F, a, layer); GRID_BAR(); } phase_A(F, a, layer); } SEAM(pb + 0);
        if (ON(1) && IN(pb + 1)) for (int rep = 0; rep < (MK_PROBE == 1 ? 2 : 1); ++rep) { FRESH();
            if (rep) GRID_BAR();
            if (MK_STAGGER) { const unsigned long long t0 = __builtin_amdgcn_s_memrealtime(), dl = (unsigned long long)((F.bid >> 3) & 7) * MK_STAGGER; while (__builtin_amdgcn_s_memrealtime() - t0 < dl) __builtin_amdgcn_s_sleep(4); }
            pg8::Gemm g{(const bf16_t*)(F.ws + WS_XB), (const bf16_t*)(F.ws + WS_WIN), M, NPC, DM, 0}; pg8::StaticOrder S; S.init(M, NPC, F.G, F.bid);
            pg8::EpiStoreBf16 E{Pb, NPC, PGT / 256, PGN / 256, (const float*)(F.ws + WS_RSTD)};
            pg8::gemm_phase<pg8::EpiStoreBf16, pg8::StaticOrder, PG8_ALIGN, PG8_SP2>(F.lds, g, S, E, F.tid, (MK_DIAG && layer == 0 && F.bid == 0) ? (unsigned long long*)(F.ctl + 49152) : nullptr);
        } SEAM(pb + 1);
        if (ON(2) && IN(pb + 2)) { FRESH(); if (MK_PROBE >= 20 && MK_PROBE < 28) { phase_Ca(F, a, layer, 1, MK_PROBE - 20); GRID_BAR(); } phase_Ca(F, a, layer, 0, 15); } SEAM(pb + 2);
        if (ON(3) && IN(pb + 3)) { FRESH(); if (MK_PROBE == 3) { phase_Cb(F, a, layer, 1); GRID_BAR(); } phase_Cb(F, a, layer, 0); } SEAM(pb + 3);
        if (ON(4) && IN(pb + 4)) for (int rep = 0; rep < (MK_PROBE == 4 ? 2 : 1); ++rep) { FRESH();
            if (rep) GRID_BAR();
            pg8::Gemm g{(const bf16_t*)(F.ws + WS_OBR), (const bf16_t*)(F.ws + WS_WBR), M, DM, 3 * BW, 0}; pg8::StaticOrder S; S.init(M, DM, F.G, F.bid);
            pg8::EpiGated E{Pb, Hb};
            pg8::gemm_phase<pg8::EpiGated, pg8::StaticOrder, PG8_ALIGN, PG8_SP2>(F.lds, g, S, E, F.tid);
        } SEAM(pb + 4);
        if (ON(5) && IN(pb + 5)) for (int rep = 0; rep < (MK_PROBE == 5 ? 2 : 1); ++rep) { FRESH();
            if (rep) GRID_BAR();
            pg8::Gemm g{Hb, (const bf16_t*)(F.ws + WS_WOUT), M, DM, DM, 0}; pg8::StaticOrder S; S.init(M, DM, F.G, F.bid);
            pg8::EpiResidBf16 E{(MK_PROBE == 5 && rep == 0) ? (bf16_t*)(F.ws + WS_P) : (bf16_t*)(F.ws + WS_XB), nullptr, (MK_PROBE == 5 && rep == 0) ? (float*)(F.ws + WS_P + 256 * MiB) : (float*)(F.ws + WS_SSQ), DM};
            pg8::gemm_phase<pg8::EpiResidBf16, pg8::StaticOrder, PG8_ALIGN, PG8_SP2>(F.lds, g, S, E, F.tid);
        } SEAM(pb + 5);
        if (ON(6) && IN(pb + 6)) { FRESH(); phase_F(F, a); } SEAM(pb + 6);
        if (ON(7) && IN(pb + 7)) for (int rep = 0; rep < (MK_PROBE == 7 ? 2 : 1); ++rep) { FRESH();
            if (rep) GRID_BAR();
            if (MK_STAGGER) { const unsigned long long t0 = __builtin_amdgcn_s_memrealtime(), dl = (unsigned long long)((F.bid >> 3) & 7) * MK_STAGGER; while (__builtin_amdgcn_s_memrealtime() - t0 < dl) __builtin_amdgcn_s_sleep(4); }
            pg8::Gemm g{(const bf16_t*)(F.ws + WS_XB), (const bf16_t*)(F.ws + WS_WUP), M, NUP, DM, 0}; pg8::StaticOrder S; S.init(M, NUP, F.G, F.bid);
            pg8::EpiConvAct E{(bf16_t*)(F.ws + WS_ACT), (bf16_t*)(F.ws + WS_USIDE), (const float*)(F.ws + WS_RSTD), a->in[I_CONVW] + (size_t)layer * 3 * NUP, a->in[I_CONVB] + (size_t)layer * NUP};
            pg8::gemm_phase<pg8::EpiConvAct, pg8::StaticOrder, PG8_ALIGN, PG8_SP2>(F.lds, g, S, E, F.tid);
        } SEAM(pb + 7);
        if (ON(8) && IN(pb + 8)) { FRESH(); if (MK_PROBE == 8) { phase_H(F, a, layer); GRID_BAR(); } phase_H(F, a, layer); } SEAM(pb + 8);
        if (ON(9) && IN(pb + 9)) for (int rep = 0; rep < (MK_PROBE == 9 ? 2 : 1); ++rep) { FRESH();
            if (rep) GRID_BAR();
            pg8::Gemm g{(const bf16_t*)(F.ws + WS_ACT), (const bf16_t*)(F.ws + WS_WDN), M, DM, DFF, 1}; pg8::StaticOrder S; S.init(M, DM, F.G, F.bid, 4, 1);
            pg8::EpiResidBf16 E{(MK_PROBE == 9 && rep == 0) ? (bf16_t*)(F.ws + WS_P) : (bf16_t*)(F.ws + WS_XB), (layer == DEPTH - 1 && !(MK_PROBE == 9 && rep == 0)) ? a->out : nullptr, (MK_PROBE == 9 && rep == 0) ? (float*)(F.ws + WS_P + 256 * MiB) : (float*)(F.ws + WS_SSQ), DM};
            pg8::gemm_phase<pg8::EpiResidBf16, pg8::StaticOrder, PG8_ALIGN, PG8_SP2>(F.lds, g, S, E, F.tid);
        } SEAM(pb + 9);
    }
#if MK_DIAG
    GRID_BAR();
    { const unsigned long long* dg = (const unsigned long long*)(F.ctl + 49152); const float kl = (float)(long long)(dg[1] - dg[0]), per = (float)(long long)(dg[2] - dg[0]);
      const float eps = MK_DIAG == 1 ? kl / per : (MK_DIAG == 2 ? per * 1e-4f : kl * 1e-4f);
      for (size_t i = (size_t)F.bid * 512 + threadIdx.x; i < (size_t)M * DM; i += (size_t)F.G * 512) a->out[i] *= (1.f + eps); }
#endif
}

extern "C" void kernel_launch(void* const* d_in, const int* in_sizes, int n_in, void* d_out, int out_size, void* d_ws, size_t ws_size, hipStream_t stream) {
    static int grid = 0;
    if (grid == 0) {
        if (n_in != 18 || in_sizes[0] != M * DM || out_size != M * DM || ws_size < WS_END) { fprintf(stderr, "kernel_launch: unexpected shapes / workspace (%d inputs, ws %zu)\n", n_in, ws_size); grid = -1; return; }
        int dev = 0, cus = 0, per_cu = 0;
        if (hipGetDevice(&dev) != hipSuccess || hipDeviceGetAttribute(&cus, hipDeviceAttributeMultiprocessorCount, dev) != hipSuccess) { grid = -1; return; }
        if (hipFuncSetAttribute((const void*)mega, hipFuncAttributeMaxDynamicSharedMemorySize, LDS_BYTES) != hipSuccess) { grid = -1; return; }
        if (hipOccupancyMaxActiveBlocksPerMultiprocessor(&per_cu, (const void*)mega, 512, LDS_BYTES) != hipSuccess || per_cu < 1) { fprintf(stderr, "kernel_launch: occupancy query says %d\n", per_cu); }
        (void)hipGetLastError();
        grid = cus;
    }
    if (grid < 0) return;
    (void)hipMemsetAsync((char*)d_ws + WS_CTL, 0, CTL_BYTES, stream);
    Args a{};
    for (int i = 0; i < 18; ++i) a.in[i] = (const float*)d_in[i];
    a.out = (float*)d_out; a.ws = (unsigned char*)d_ws;
#if MK_ONE_LAUNCH
    a.ph_lo = 0; a.ph_hi = DEPTH * 10;
    hipLaunchKernelGGL(mega, dim3(grid), dim3(512), LDS_BYTES, stream, a);
#else
    for (int p = 0; p < DEPTH * 10; ++p) { a.ph_lo = p; a.ph_hi = p + 1; hipLaunchKernelGGL(mega, dim3(grid), dim3(512), LDS_BYTES, stream, a); }
#endif
}
```

```cpp
#include <hip/hip_runtime.h>
#include <stdint.h>
#include <stdio.h>

#ifndef MK_ONE_LAUNCH
#define MK_ONE_LAUNCH 1
#endif
#ifndef MK_PHASE_MASK
#define MK_PHASE_MASK 0x3ff
#endif
#ifndef MK_PROBE
#define MK_PROBE -1
#endif
#ifndef MK_STAGGER
#define MK_STAGGER 0
#endif
#ifndef MK_DIAG
#define MK_DIAG 0
#endif
#ifndef MK_BUILD_MASK
#define MK_BUILD_MASK 0x3ff
#endif

#define LAS __attribute__((address_space(3)))
typedef unsigned short bf16_t;
typedef short bf16x8 __attribute__((ext_vector_type(8)));
typedef short s16x4 __attribute__((ext_vector_type(4)));
typedef float f32x4 __attribute__((ext_vector_type(4)));
typedef float f32x16 __attribute__((ext_vector_type(16)));
typedef float f32x2 __attribute__((ext_vector_type(2)));
typedef unsigned u32x4 __attribute__((ext_vector_type(4)));
typedef unsigned u32x2 __attribute__((ext_vector_type(2)));
typedef __bf16 bfv2 __attribute__((ext_vector_type(2)));

constexpr int DM = 2048, NB = 16, T = 2048, DEPTH = 4, M = NB * T, HD = 128;
constexpr int INC = 15896;
constexpr int NPC = 16128;
constexpr int PQN = 0, PKC = 1024, PVC = 1280, PKS = 1536, PVS = 1792, PKW = 2048, PVW = 2304, PQS = 2560, PKSB = 3584, PVSB = 4608,
              PQH = 5632, PFH = 6656, PIH = 7680, PGH = 8704, PGT = 9728, PGN = 15872;
constexpr int DFF = 5632, NUP = 2 * DFF;
constexpr int BW = 1024;
constexpr float EPS = 1e-6f;
constexpr float LOG2E = 1.4426950408889634f, LN2 = 0.6931471805599453f;
constexpr float QSCALE = 0.08838834764831845f;

constexpr size_t MiB = 1u << 20;
constexpr size_t WS_CTL = 0, CTL_BYTES = 1 * MiB;
constexpr size_t WS_WIN = 1 * MiB, WS_WBR = 64 * MiB, WS_WOUT = 76 * MiB, WS_WUP = 84 * MiB, WS_WDN = 128 * MiB;
constexpr size_t WS_MISC = 150 * MiB;
constexpr size_t MISC_KCMP = 0, MISC_VCMP = 1 * MiB, MISC_WC1 = 2 * MiB;
constexpr int CW_CVEC = 32768;
constexpr size_t WS_SCR = 154 * MiB;
constexpr size_t WS_P = 218 * MiB;
constexpr size_t WS_H = 1226 * MiB;
constexpr size_t WS_OBR = 1354 * MiB;
constexpr size_t WS_ORAW = 1546 * MiB;
constexpr size_t WS_XB = 1674 * MiB;
constexpr size_t WS_SSQ = 1802 * MiB;
constexpr size_t WS_RSTD = 1806 * MiB;
constexpr size_t WS_USIDE = 1807 * MiB;
constexpr size_t WS_END = 1853 * MiB;
constexpr size_t WS_ACT = WS_P + 704 * MiB;
constexpr int CW_BAR = 4096;
constexpr int CW_QUEUE = 16384;

constexpr int RING_BYTES = 131072;
constexpr int MISC_OFF = 147456 - 256;
constexpr int LDS_BYTES = 147456;

__device__ __forceinline__ float bf2f(unsigned short b) { return __uint_as_float(((unsigned)b) << 16); }
__device__ __forceinline__ float bflo(unsigned w) { return __uint_as_float(w << 16); }
__device__ __forceinline__ float bfhi(unsigned w) { return __uint_as_float(w & 0xffff0000u); }
__device__ __forceinline__ unsigned pk2(float lo, float hi) { f32x2 v = {lo, hi}; bfv2 b = __builtin_convertvector(v, bfv2); return __builtin_bit_cast(unsigned, b); }
__device__ __forceinline__ float wave_sum(float v) {
#pragma unroll
    for (int o = 1; o < 64; o <<= 1) v += __shfl_xor(v, o);
    return v;
}
__device__ __forceinline__ float fast_exp2(float x) { return __builtin_amdgcn_exp2f(x); }
__device__ __forceinline__ float fast_log2(float x) { return __builtin_amdgcn_logf(x); }
__device__ __forceinline__ float fast_rcp(float x) { return __builtin_amdgcn_rcpf(x); }
__device__ __forceinline__ float sigmoidf_(float x) { return fast_rcp(1.f + fast_exp2(-x * LOG2E)); }
#define LDS_WAIT() asm volatile("s_waitcnt lgkmcnt(0)" ::: "memory")

#define XB_TMO      128
#define XB_XCNT(j)  (256  + 64 * (j))
#define XB_XSUB(j)  (1280 + 64 * (j))
#define XB_XGEN(j)  (2304 + 64 * (j))
#define XB_TOP      3328
#define XB_TOPGEN   3392
#define XCD_BAR_WORDS 3456
#define XB_SPIN_CAP (1u << 22)
__device__ __forceinline__ unsigned xb_ld(unsigned* p)              { return __hip_atomic_load(p, __ATOMIC_RELAXED, __HIP_MEMORY_SCOPE_AGENT); }
__device__ __forceinline__ unsigned xb_add(unsigned* p, unsigned v) { return __hip_atomic_fetch_add(p, v, __ATOMIC_RELAXED, __HIP_MEMORY_SCOPE_AGENT); }
__device__ __forceinline__ unsigned xb_xcc_id() { return (unsigned)__builtin_amdgcn_s_getreg((3 << 11) | 20) & 0xFu; }
#define XB_SPIN(cond, bar) do { unsigned _sp = 0; while (cond) { __builtin_amdgcn_s_sleep(1); \
    if ((++_sp & 255u) == 0u) { if (xb_ld(&(bar)[XB_TMO])) break; if (_sp > XB_SPIN_CAP) { atomicAdd(&(bar)[XB_TMO], 1u); break; } } } } while (0)
struct XcdBarrier { unsigned* bar; unsigned x; volatile LAS unsigned* st; };
__device__ __forceinline__ XcdBarrier xcd_barrier_post(unsigned* bar, volatile LAS unsigned* st) {
    XcdBarrier b; b.bar = bar; b.x = xb_xcc_id(); b.st = st;
    if (threadIdx.x == 0) (void)xb_add(&bar[XB_XCNT(b.x)], 1u);
    return b;
}
__device__ __forceinline__ void xcd_barrier_complete(unsigned* bar, unsigned x, unsigned& nloc, unsigned& nx) {
    const unsigned G = gridDim.x * gridDim.y * gridDim.z;
    unsigned sum, cnt, mine, sp = 0u;
    for (;;) {
        sum = 0u; cnt = 0u; mine = 0u;
#pragma unroll
        for (unsigned j = 0; j < 16; ++j) { const unsigned c = xb_ld(&bar[XB_XCNT(j)]); sum += c; cnt += (c > 0u) ? 1u : 0u; mine = (j == x) ? c : mine; }
        if (sum == G) break;
        __builtin_amdgcn_s_sleep(1);
        if ((++sp & 255u) == 0u) { if (xb_ld(&bar[XB_TMO])) break; if (sp > XB_SPIN_CAP) { atomicAdd(&bar[XB_TMO], 1u); break; } }
    }
    nloc = mine > 0u ? mine : 1u; nx = cnt > 0u ? cnt : 1u;
}
__device__ __forceinline__ void xcd_barrier(const XcdBarrier& b) {
    asm volatile("s_waitcnt vmcnt(0)" ::: "memory");
    __syncthreads();
    if (threadIdx.x == 0) {
        unsigned* bar = b.bar;
        __builtin_amdgcn_s_waitcnt(0);
        unsigned nloc = b.st[0], nx = b.st[1];
        if (nloc == 0u) { xcd_barrier_complete(bar, b.x, nloc, nx); b.st[0] = nloc; b.st[1] = nx; }
        const unsigned old = xb_add(&bar[XB_XSUB(b.x)], 1u);
        const unsigned gen = old / nloc;
        if (old + 1u == (gen + 1u) * nloc) {
            __builtin_amdgcn_fence(__ATOMIC_RELEASE, "agent");
            asm volatile("s_waitcnt vmcnt(0)" ::: "memory");
            const unsigned og = xb_add(&bar[XB_TOP], 1u);
            const unsigned tg = og / nx;
            if (og + 1u == (tg + 1u) * nx) xb_add(&bar[XB_TOPGEN], 1u);
            else XB_SPIN(xb_ld(&bar[XB_TOPGEN]) == tg, bar);
            __builtin_amdgcn_fence(__ATOMIC_ACQUIRE, "agent");
            xb_add(&bar[XB_XGEN(b.x)], 1u);
            asm volatile("s_waitcnt vmcnt(0)" ::: "memory");
        } else {
            XB_SPIN(xb_ld(&bar[XB_XGEN(b.x)]) == gen, bar);
            __builtin_amdgcn_fence(__ATOMIC_ACQUIRE, "agent");
            asm volatile("s_waitcnt vmcnt(0)" ::: "memory");
        }
    }
    __syncthreads();
}

namespace pg8 {
constexpr int BM = 256, BK = 64, HALF = 128, HTB = HALF * BK * 2, STAGE_BYTES = 8 * HTB, NXCD = 8;
__host__ __device__ __forceinline__ int lds_byte(int r, int c) { const int st = (r >> 4) * 2 + (c >> 5), rr = r & 15, cc = c & 31, ob = rr * 64 + cc * 2; return st * 1024 + (ob ^ (((ob >> 9) & 1) << 5)); }
__host__ __device__ __forceinline__ void stage_rc(int b, int& R, int& C) { const int st = b / 1024, sb = b % 1024, swz = sb ^ (((sb >> 9) & 1) << 5); R = (st >> 1) * 16 + swz / 64; C = (st & 1) * 32 + (swz % 64) / 2; }
__host__ __device__ __forceinline__ int perm32(int rho) { const int n = rho >> 4, i = rho & 15; return 8 * (i >> 2) + 4 * n + (i & 3); }
struct Unit { int pm, pn, aux; };
struct Gemm { const bf16_t* A; const bf16_t* Bt; int M, N, K; int akm; };
struct StaticOrder {
    int nM, nN, nwg, G, c, WGM, rev;
    int pad_;
    __device__ void init(int M_, int N_, int G_, int c_, int wgm = 4, int rev_ = 0) { nM = M_ / BM; nN = N_ / BM; nwg = nM * nN; G = G_; c = c_; WGM = wgm; rev = rev_; pad_ = 0; }
    __device__ __forceinline__ bool tile(long L, Unit& u) const {
        if (L >= nwg) return false;
        int wgid = (int)L; { const int q = nwg / NXCD, r = nwg % NXCD, xcd = wgid % NXCD, off = wgid / NXCD; wgid = (xcd < r ? xcd * (q + 1) : r * (q + 1) + (xcd - r) * q) + off; }
        const int nig = WGM * nN, gid = wgid / nig, fm = gid * WGM, gsz = (nM - fm) < WGM ? (nM - fm) : WGM;
        u.pm = fm + ((wgid % nig) % gsz); u.pn = (wgid % nig) / gsz; u.aux = 0; if (rev) u.pm = nM - 1 - u.pm; return true;
    }
    __device__ __forceinline__ bool next(int i, Unit& u) const { return tile((long)i * G + c, u); }
    __device__ __forceinline__ const char* aptr(const Gemm& g, const Unit& u, size_t tstep) const { return (const char*)g.A + (size_t)u.pm * tstep; }
    __device__ __forceinline__ const char* bptr(const Gemm& g, const Unit& u, size_t tstep) const { return (const char*)g.Bt + (size_t)u.pn * tstep; }
    __device__ __forceinline__ void a_ready(const Unit&) const {}
    __device__ __forceinline__ void done(const Unit&) const {}
};
struct EpiStoreBf16 {
    static constexpr bool PERM = true, AFTER_DRAIN = false;
    bf16_t* O; int ldc; int sg_lo, sg_hi; const float* rs;
    __device__ __forceinline__ void operator()(const f32x4 (&acc)[2][2][4][2], const Unit& u, int wr, int wc, int fr, int fq) const {
        const int row0 = u.pm * BM + wr * 64 + fr, col0 = u.pn * BM + wc * 32 + 8 * fq; const bool sg = u.pn >= sg_lo && u.pn < sg_hi;
        float rsv[8];
#pragma unroll
        for (int g = 0; g < 8; ++g) rsv[g] = rs[row0 + (g >> 2) * HALF + (g & 3) * 16];
#pragma unroll
        for (int ai = 0; ai < 2; ++ai)
#pragma unroll
            for (int m = 0; m < 4; ++m) { bf16_t* rowp = O + (size_t)(row0 + ai * HALF + m * 16) * ldc + col0;
#pragma unroll
                for (int bj = 0; bj < 2; ++bj) { f32x4 v0 = acc[ai][bj][m][0] * rsv[ai * 4 + m], v1 = acc[ai][bj][m][1] * rsv[ai * 4 + m];
                    if (sg) {
#pragma unroll
                        for (int e = 0; e < 4; ++e) { v0[e] = sigmoidf_(v0[e]); v1[e] = sigmoidf_(v1[e]); } }
                    u32x4 w; w.x = pk2(v0[0], v0[1]); w.y = pk2(v0[2], v0[3]); w.z = pk2(v1[0], v1[1]); w.w = pk2(v1[2], v1[3]);
                    __builtin_nontemporal_store(w, (u32x4*)(rowp + bj * HALF)); } }
    }
};
struct EpiConvAct {
    static constexpr bool PERM = true, AFTER_DRAIN = false;
    bf16_t* ACT; bf16_t* side; const float* rs; const float* cw; const float* cb;
    __device__ __forceinline__ void operator()(const f32x4 (&acc)[2][2][4][2], const Unit& u, int wr, int wc, int fr, int fq) const {
        const int row0 = u.pm * BM + wr * 64 + fr, ch0 = u.pn * 128 + wc * 32 + 8 * fq;
        float rsv[8];
#pragma unroll
        for (int g = 0; g < 8; ++g) rsv[g] = rs[row0 + (g >> 2) * HALF + (g & 3) * 16];
#pragma unroll
        for (int n = 0; n < 2; ++n) {
            const f32x4 wg0 = *(const f32x4*)(cw + ch0 + 4 * n), wg1 = *(const f32x4*)(cw + NUP + ch0 + 4 * n), wg2 = *(const f32x4*)(cw + 2 * NUP + ch0 + 4 * n), bg = *(const f32x4*)(cb + ch0 + 4 * n);
            const f32x4 wv0 = *(const f32x4*)(cw + DFF + ch0 + 4 * n), wv1 = *(const f32x4*)(cw + NUP + DFF + ch0 + 4 * n), wv2 = *(const f32x4*)(cw + 2 * NUP + DFF + ch0 + 4 * n), bv = *(const f32x4*)(cb + DFF + ch0 + 4 * n);
#pragma unroll
            for (int ai = 0; ai < 2; ++ai) {
                float act[4][4];
#pragma unroll
                for (int e = 0; e < 4; ++e) {
                    float pg1 = 0.f, pg2 = 0.f, pv1 = 0.f, pv2 = 0.f;
#pragma unroll
                    for (int m = 0; m < 4; ++m) {
                        const float xg = acc[ai][0][m][n][e] * rsv[ai * 4 + m], xv = acc[ai][1][m][n][e] * rsv[ai * 4 + m];
                        const float rg1 = __int_as_float(__builtin_amdgcn_update_dpp(0, __float_as_int(xg), 0x121, 0xf, 0xf, false)), rg2 = __int_as_float(__builtin_amdgcn_update_dpp(0, __float_as_int(xg), 0x122, 0xf, 0xf, false));
                        const float rv1 = __int_as_float(__builtin_amdgcn_update_dpp(0, __float_as_int(xv), 0x121, 0xf, 0xf, false)), rv2 = __int_as_float(__builtin_amdgcn_update_dpp(0, __float_as_int(xv), 0x122, 0xf, 0xf, false));
                        const float g1 = fr == 0 ? pg1 : rg1, g2 = fr < 2 ? pg2 : rg2, v1 = fr == 0 ? pv1 : rv1, v2 = fr < 2 ? pv2 : rv2;
                        const float cg = bg[e] + wg0[e] * g2 + wg1[e] * g1 + wg2[e] * xg, cv = bv[e] + wv0[e] * v2 + wv1[e] * v1 + wv2[e] * xv;
                        act[m][e] = cg * sigmoidf_(cg) * cv;
                        pg1 = rg1; pg2 = rg2; pv1 = rv1; pv2 = rv2;
                    }
                }
#pragma unroll
                for (int m = 0; m < 4; ++m) { u32x2 w; w.x = pk2(act[m][0], act[m][1]); w.y = pk2(act[m][2], act[m][3]); *(u32x2*)(ACT + ((size_t)((ch0 + 4 * n) >> 6) * M + (size_t)(row0 + ai * HALF + m * 16)) * 64 + ((ch0 + 4 * n) & 63)) = w; }
            }
        }
        const int slot = fr < 2 ? fr : fr - 12;
        if (fr < 2 || fr >= 14) {
            const int m = fr < 2 ? 0 : 3;
#pragma unroll
            for (int ai = 0; ai < 2; ++ai) { const int blk = (u.pm * BM + ai * HALF + wr * 64) >> 6; const float r_ = fr < 2 ? rsv[ai * 4] : rsv[ai * 4 + 3];
                bf16_t* sp = side + ((size_t)blk * 4 + slot) * NUP + u.pn * 256 + wc * 32 + 8 * fq;
#pragma unroll
                for (int bj = 0; bj < 2; ++bj) { const f32x4 a0 = (fr < 2 ? acc[ai][bj][0][0] : acc[ai][bj][3][0]) * r_, a1 = (fr < 2 ? acc[ai][bj][0][1] : acc[ai][bj][3][1]) * r_;
                    *(u32x4*)(sp + bj * HALF) = (u32x4){pk2(a0[0], a0[1]), pk2(a0[2], a0[3]), pk2(a1[0], a1[1]), pk2(a1[2], a1[3])}; } }
            (void)m;
        }
    }
};
struct EpiResidBf16 {
    static constexpr bool PERM = true, AFTER_DRAIN = false;
    bf16_t* XB; float* Cout; float* ssq; int ldc;
    __device__ __forceinline__ void operator()(const f32x4 (&acc)[2][2][4][2], const Unit& u, int wr, int wc, int fr, int fq) const {
        const int row0 = u.pm * BM + wr * 64 + fr, col0 = u.pn * BM + wc * 32 + 8 * fq;
        u32x4 old[2][2]; float ssv[8];
#define ER_ROWI(g) (row0 + ((g) >> 2) * HALF + ((g) & 3) * 16)
#define ER_LOAD(g) do { const bf16_t* rp_ = XB + (size_t)ER_ROWI(g) * ldc + col0; old[(g) & 1][0] = *(const u32x4*)rp_; old[(g) & 1][1] = *(const u32x4*)(rp_ + HALF); } while (0)
        ER_LOAD(0);
#pragma unroll
        for (int g = 0; g < 8; ++g) {
            asm volatile("" ::: "memory");
            if (g < 7) ER_LOAD(g + 1);
            const size_t ro = (size_t)ER_ROWI(g) * ldc + col0; float ss = 0.f;
#pragma unroll
            for (int bj = 0; bj < 2; ++bj) { const u32x4 o_ = old[g & 1][bj];
                f32x4 v0 = acc[g >> 2][bj][g & 3][0], v1 = acc[g >> 2][bj][g & 3][1];
                v0[0] += bflo(o_.x); v0[1] += bfhi(o_.x); v0[2] += bflo(o_.y); v0[3] += bfhi(o_.y); v1[0] += bflo(o_.z); v1[1] += bfhi(o_.z); v1[2] += bflo(o_.w); v1[3] += bfhi(o_.w);
                if (Cout) { *(f32x4*)(Cout + ro + bj * HALF) = v0; *(f32x4*)(Cout + ro + bj * HALF + 4) = v1; }
                else { u32x4 w; w.x = pk2(v0[0], v0[1]); w.y = pk2(v0[2], v0[3]); w.z = pk2(v1[0], v1[1]); w.w = pk2(v1[2], v1[3]); *(u32x4*)(XB + ro + bj * HALF) = w;
                    const float r0 = bflo(w.x), r1 = bfhi(w.x), r2 = bflo(w.y), r3 = bfhi(w.y), r4 = bflo(w.z), r5 = bfhi(w.z), r6 = bflo(w.w), r7 = bfhi(w.w);
                    ss += ((r0 * r0 + r1 * r1) + (r2 * r2 + r3 * r3)) + ((r4 * r4 + r5 * r5) + (r6 * r6 + r7 * r7)); } }
            ssv[g] = ss;
        }
        if (!Cout) {
#pragma unroll
            for (int g = 0; g < 8; ++g) ssv[g] += __shfl_xor(ssv[g], 16);
#pragma unroll
            for (int g = 0; g < 8; ++g) ssv[g] += __shfl_xor(ssv[g], 32);
            if (fq == 0) {
#pragma unroll
                for (int g = 0; g < 8; ++g) ssq[(size_t)ER_ROWI(g) * 32 + u.pn * 4 + wc] = ssv[g]; } }
#undef ER_ROWI
#undef ER_LOAD
    }
};
struct EpiGated {
    static constexpr bool PERM = true, AFTER_DRAIN = false, HOOK = true; static constexpr int HOOK_KT = 16;
    const bf16_t* P; bf16_t* merged;
    static __device__ __forceinline__ float gl(unsigned w) { return fmaxf(bflo(w), 1e-30f); }
    static __device__ __forceinline__ float gh(unsigned w) { return fmaxf(bfhi(w), 1e-30f); }
    __device__ __forceinline__ void mid(f32x4 (&acc)[2][2][4][2], const Unit& u, int wr, int wc, int fr, int fq, int s) const {
        const unsigned row0 = (unsigned)(u.pm * BM + wr * 64 + fr), col0 = (unsigned)(u.pn * BM + wc * 32 + 8 * fq);
        const char* Pa = (const char*)(P + PGT + (s - 1) * DM); const char* Pb = (const char*)(P + PGT + s * DM);
#pragma unroll
        for (int hf = 0; hf < 2; ++hf) {
            u32x4 ga[4][2], gb[4][2];
#pragma unroll
            for (int gg = 0; gg < 4; ++gg) { const int g = hf * 4 + gg; const unsigned po = ((row0 + (unsigned)((g >> 2) * HALF + (g & 3) * 16)) * (unsigned)NPC + col0) * 2u;
#pragma unroll
                for (int bj = 0; bj < 2; ++bj) { ga[gg][bj] = *(const u32x4*)(Pa + (size_t)(po + bj * 256u)); gb[gg][bj] = *(const u32x4*)(Pb + (size_t)(po + bj * 256u)); } }
#pragma unroll
            for (int gg = 0; gg < 4; ++gg) { const int g = hf * 4 + gg;
#pragma unroll
                for (int bj = 0; bj < 2; ++bj) { const u32x4 a_ = ga[gg][bj], b_ = gb[gg][bj];
                    f32x4& v0 = acc[g >> 2][bj][g & 3][0]; f32x4& v1 = acc[g >> 2][bj][g & 3][1];
                    v0[0] *= gl(a_.x) * fast_rcp(gl(b_.x)); v0[1] *= gh(a_.x) * fast_rcp(gh(b_.x)); v0[2] *= gl(a_.y) * fast_rcp(gl(b_.y)); v0[3] *= gh(a_.y) * fast_rcp(gh(b_.y));
                    v1[0] *= gl(a_.z) * fast_rcp(gl(b_.z)); v1[1] *= gh(a_.z) * fast_rcp(gh(b_.z)); v1[2] *= gl(a_.w) * fast_rcp(gl(b_.w)); v1[3] *= gh(a_.w) * fast_rcp(gh(b_.w)); } }
            asm volatile("" ::: "memory"); }
    }
    __device__ __forceinline__ void operator()(const f32x4 (&acc)[2][2][4][2], const Unit& u, int wr, int wc, int fr, int fq) const {
        const unsigned row0 = (unsigned)(u.pm * BM + wr * 64 + fr), col0 = (unsigned)(u.pn * BM + wc * 32 + 8 * fq);
        const char* Pg = (const char*)(P + PGT + 2 * DM); char* mg = (char*)merged;
        u32x4 gw[8][2];
#pragma unroll
        for (int g = 0; g < 8; ++g) { const unsigned po = ((row0 + (unsigned)((g >> 2) * HALF + (g & 3) * 16)) * (unsigned)NPC + col0) * 2u;
#pragma unroll
            for (int bj = 0; bj < 2; ++bj) gw[g][bj] = *(const u32x4*)(Pg + (size_t)(po + bj * 256u)); }
#pragma unroll
        for (int g = 0; g < 8; ++g) { const unsigned moff = ((row0 + (unsigned)((g >> 2) * HALF + (g & 3) * 16)) * (unsigned)DM + col0) * 2u;
#pragma unroll
            for (int bj = 0; bj < 2; ++bj) { const u32x4 w_ = gw[g][bj]; const f32x4 v0 = acc[g >> 2][bj][g & 3][0], v1 = acc[g >> 2][bj][g & 3][1];
                u32x4 w; w.x = pk2(v0[0] * gl(w_.x), v0[1] * gh(w_.x)); w.y = pk2(v0[2] * gl(w_.y), v0[3] * gh(w_.y)); w.z = pk2(v1[0] * gl(w_.z), v1[1] * gh(w_.z)); w.w = pk2(v1[2] * gl(w_.w), v1[3] * gh(w_.w));
                *(u32x4*)(mg + (size_t)(moff + bj * 256u)) = w; } }
    }
};

template <class E, class = void> struct has_hook { static constexpr bool v = false; };
template <class E> struct has_hook<E, decltype((void)E::HOOK)> { static constexpr bool v = true; };
template <class Epi, class Sched, bool ALIGN_EPI = false, bool SP2 = false>
__device__ __forceinline__ void gemm_phase(LAS unsigned char* lds, const Gemm g, const Sched& S, const Epi& E, const int tid, unsigned long long* dg = nullptr) {
    float zf; asm volatile("v_mov_b32 %0, 0" : "=v"(zf));
    const int wid = __builtin_amdgcn_readfirstlane(tid >> 6), lane = tid & 63, wr = wid >> 2, wc = wid & 3, fr = lane & 15, fq = lane >> 4;
    const int K = g.K, nt = K / BK;
    unsigned voffA[2], voffB[2];
#pragma unroll
    for (int i = 0; i < 2; ++i) { int R, C; stage_rc(tid * 16 + i * 8192, R, C); const int Rb = Epi::PERM ? ((R & ~31) + perm32(R & 31)) : R;
        voffA[i] = (unsigned)(R * (g.akm ? BK : K) + C) * 2u; voffB[i] = (unsigned)(Rb * K + C) * 2u; }
    const size_t kstep = (size_t)(BK * 2);
    const size_t hstep = (size_t)HALF * K * 2;
    const size_t tstep = 2 * hstep;
    const size_t kstepA = g.akm ? (size_t)g.M * BK * 2 : kstep, hstepA = g.akm ? (size_t)HALF * BK * 2 : hstep, tstepA = 2 * hstepA;
    const unsigned ldsw = (unsigned)wid * 1024u;
    const int aoff = lds_byte(wr * 64 + fr, fq * 8), boff = lds_byte(wc * 32 + fr, fq * 8);
#define PG8_SA(b, h) (((b) * 2 + (h)) * HTB)
#define PG8_SB(b, h) ((4 + (b) * 2 + (h)) * HTB)
#define PG8_STAGE(bufoff, gbase, voff) do { _Pragma("unroll") for (int _i = 0; _i < 2; ++_i) \
        __builtin_amdgcn_global_load_lds((const unsigned*)((const char*)(gbase) + (voff)[_i]), (LAS unsigned*)(lds + (bufoff) + ldsw + _i * 8192), 16, 0, 0); } while (0)
#define PG8_LDA(dst, b, h) do { _Pragma("unroll") for (int m = 0; m < 4; ++m) _Pragma("unroll") for (int k = 0; k < 2; ++k) dst[m][k] = *(const LAS bf16x8*)(lds + PG8_SA(b, h) + aoff + m * 2048 + k * 1024); } while (0)
#define PG8_LDB(dst, b, h) do { _Pragma("unroll") for (int n = 0; n < 2; ++n) _Pragma("unroll") for (int k = 0; k < 2; ++k) dst[n][k] = *(const LAS bf16x8*)(lds + PG8_SB(b, h) + boff + n * 2048 + k * 1024); } while (0)
#define PG8_MMA(ai, bj, At, Bt) do { __builtin_amdgcn_s_setprio(1); _Pragma("unroll") for (int m = 0; m < 4; ++m) _Pragma("unroll") for (int n = 0; n < 2; ++n) _Pragma("unroll") for (int k = 0; k < 2; ++k) \
        acc[ai][bj][m][n] = __builtin_amdgcn_mfma_f32_16x16x32_bf16(Bt[n][k], At[m][k], acc[ai][bj][m][n], 0, 0, 0); __builtin_amdgcn_s_setprio(0); } while (0)
#define PG8_WAIT_V(n) asm volatile("s_waitcnt vmcnt(" #n ")" ::: "memory")
#define PG8_WAIT_L(n) asm volatile("s_waitcnt lgkmcnt(" #n ")" ::: "memory")
#define PG8_BAR __builtin_amdgcn_s_barrier()
#define PG8_SCHED __builtin_amdgcn_sched_barrier(0)
    Unit cur, nxt; int ui = 0;
    if (!S.next(0, cur)) return;
    f32x4 acc[2][2][4][2];
#pragma unroll
    for (int a = 0; a < 2; ++a)
#pragma unroll
        for (int b = 0; b < 2; ++b)
#pragma unroll
            for (int m = 0; m < 4; ++m)
#pragma unroll
                for (int n = 0; n < 2; ++n) acc[a][b][m][n] = (f32x4){zf, zf, zf, zf};
    bf16x8 At[4][2], B0[2][2], B1[2][2];
    const char* cA = S.aptr(g, cur, tstepA); const char* cB = S.bptr(g, cur, tstep);
    S.a_ready(cur);
    if constexpr (SP2) {
        PG8_STAGE(PG8_SB(0, 0), cB, voffB); PG8_STAGE(PG8_SB(0, 1), cB + hstep, voffB); PG8_STAGE(PG8_SA(0, 0), cA, voffA); PG8_STAGE(PG8_SA(0, 1), cA + hstepA, voffA);
        if (wr == 1) PG8_BAR;
        PG8_WAIT_V(2); PG8_BAR;
        PG8_STAGE(PG8_SB(1, 0), cB + kstep, voffB); PG8_STAGE(PG8_SA(1, 0), cA + kstepA, voffA); PG8_STAGE(PG8_SB(1, 1), cB + hstep + kstep, voffB);
        PG8_WAIT_V(6); PG8_BAR;
    } else {
        PG8_STAGE(PG8_SB(0, 0), cB, voffB); PG8_STAGE(PG8_SA(0, 0), cA, voffA); PG8_STAGE(PG8_SB(0, 1), cB + hstep, voffB); PG8_STAGE(PG8_SA(0, 1), cA + hstepA, voffA);
        if (wr == 1) PG8_BAR;
        PG8_WAIT_V(4); PG8_BAR;
        PG8_STAGE(PG8_SB(1, 0), cB + kstep, voffB); PG8_STAGE(PG8_SA(1, 0), cA + kstepA, voffA); PG8_STAGE(PG8_SB(1, 1), cB + hstep + kstep, voffB);
        PG8_WAIT_V(6); PG8_BAR;
    }
    for (;;) {
        const bool has_next = S.next(ui + 1, nxt);
        if (MK_DIAG && dg && tid == 0 && (ui == 2 || ui == 3)) dg[(ui - 2) * 2] = wall_clock64();
        const char* nA = has_next ? S.aptr(g, nxt, tstepA) : cA; const char* nB = has_next ? S.bptr(g, nxt, tstep) : cB;
        for (int t = 0; t < nt; t += 2) {
            const bool last = (t == nt - 2);
            const char* a1 = cA + (size_t)(t + 1) * kstepA;
            const char* a2 = last ? nA : cA + (size_t)(t + 2) * kstepA; const char* b2 = last ? nB : cB + (size_t)(t + 2) * kstep;
            const char* a3 = a2 + kstepA; const char* b3 = b2 + kstep;
            if (last && has_next) S.a_ready(nxt);
            if constexpr (SP2) {
            PG8_LDB(B0, 0, 0); PG8_LDB(B1, 0, 1); PG8_SCHED; PG8_LDA(At, 0, 0); PG8_STAGE(PG8_SA(1, 1), a1 + hstepA, voffA);
            PG8_WAIT_V(8); PG8_WAIT_L(0); PG8_BAR; PG8_MMA(0, 0, At, B0); PG8_MMA(0, 1, At, B1); PG8_BAR; PG8_SCHED;
            PG8_LDA(At, 0, 1); PG8_STAGE(PG8_SB(0, 0), b2, voffB); PG8_STAGE(PG8_SB(0, 1), b2 + hstep, voffB); PG8_STAGE(PG8_SA(0, 0), a2, voffA);
            PG8_WAIT_V(8); PG8_WAIT_L(0); PG8_BAR; PG8_MMA(1, 0, At, B0); PG8_MMA(1, 1, At, B1); PG8_BAR; PG8_SCHED;
            PG8_LDB(B0, 1, 0); PG8_LDB(B1, 1, 1); PG8_SCHED; PG8_LDA(At, 1, 0); PG8_STAGE(PG8_SA(0, 1), a2 + hstepA, voffA);
            PG8_WAIT_V(8); PG8_WAIT_L(0); PG8_BAR; PG8_MMA(0, 0, At, B0); PG8_MMA(0, 1, At, B1); PG8_BAR; PG8_SCHED;
            PG8_LDA(At, 1, 1); PG8_STAGE(PG8_SB(1, 0), b3, voffB); PG8_STAGE(PG8_SB(1, 1), b3 + hstep, voffB); PG8_STAGE(PG8_SA(1, 0), a3, voffA);
            PG8_WAIT_V(8); PG8_WAIT_L(0); PG8_BAR; PG8_MMA(1, 0, At, B0); PG8_MMA(1, 1, At, B1); PG8_BAR; PG8_SCHED;
            if constexpr (has_hook<Epi>::v) { if (t + 2 < nt && (t + 2) % Epi::HOOK_KT == 0) { const_cast<Epi&>(E).mid(acc, cur, wr, wc, fr, fq, (t + 2) / Epi::HOOK_KT); PG8_SCHED; } }
            } else {
            PG8_LDB(B0, 0, 0); PG8_SCHED; PG8_LDA(At, 0, 0); PG8_STAGE(PG8_SA(1, 1), a1 + hstepA, voffA);
            PG8_WAIT_L(8); PG8_BAR; PG8_WAIT_L(0); PG8_MMA(0, 0, At, B0); PG8_BAR; PG8_SCHED;
            PG8_LDB(B1, 0, 1); PG8_STAGE(PG8_SB(0, 0), b2, voffB);
            PG8_BAR; PG8_WAIT_L(0); PG8_MMA(0, 1, At, B1); PG8_BAR;
            PG8_LDA(At, 0, 1); PG8_STAGE(PG8_SA(0, 0), a2, voffA);
            PG8_BAR; PG8_WAIT_L(0); PG8_MMA(1, 0, At, B0); PG8_BAR; PG8_SCHED;
            PG8_STAGE(PG8_SB(0, 1), b2 + hstep, voffB);
            PG8_WAIT_V(6); PG8_BAR; PG8_MMA(1, 1, At, B1); PG8_BAR;
            PG8_LDB(B0, 1, 0); PG8_SCHED; PG8_LDA(At, 1, 0); PG8_STAGE(PG8_SA(0, 1), a2 + hstepA, voffA);
            PG8_WAIT_L(8); PG8_BAR; PG8_WAIT_L(0); PG8_MMA(0, 0, At, B0); PG8_BAR; PG8_SCHED;
            PG8_LDB(B1, 1, 1); PG8_STAGE(PG8_SB(1, 0), b3, voffB);
            PG8_BAR; PG8_WAIT_L(0); PG8_MMA(0, 1, At, B1); PG8_BAR;
            PG8_LDA(At, 1, 1); PG8_STAGE(PG8_SA(1, 0), a3, voffA);
            PG8_BAR; PG8_WAIT_L(0); PG8_MMA(1, 0, At, B0); PG8_BAR; PG8_SCHED;
            PG8_STAGE(PG8_SB(1, 1), b3 + hstep, voffB);
            PG8_WAIT_V(6); PG8_BAR; PG8_MMA(1, 1, At, B1); PG8_BAR;
            }
        }
        if (MK_DIAG && dg && tid == 0 && ui == 2) dg[1] = wall_clock64();
        if constexpr (ALIGN_EPI) { if (wr == 0) PG8_BAR; }
        if constexpr (!Epi::AFTER_DRAIN) { E(acc, cur, wr, wc, fr, fq); S.done(cur); }
        if (!has_next) break;
#pragma unroll
        for (int a = 0; a < 2; ++a)
#pragma unroll
            for (int b = 0; b < 2; ++b)
#pragma unroll
                for (int m = 0; m < 4; ++m)
#pragma unroll
                    for (int n = 0; n < 2; ++n) acc[a][b][m][n] = (f32x4){zf, zf, zf, zf};
        cur = nxt; cA = nA; cB = nB; ++ui;
        if constexpr (ALIGN_EPI) { if (wr == 1) PG8_BAR; }
    }
    PG8_WAIT_V(0);
    if constexpr (!ALIGN_EPI) { if (wr == 0) PG8_BAR; }
    PG8_BAR;
#undef PG8_SA
#undef PG8_SB
#undef PG8_STAGE
#undef PG8_LDA
#undef PG8_LDB
#undef PG8_MMA
#undef PG8_WAIT_V
#undef PG8_WAIT_L
#undef PG8_BAR
#undef PG8_SCHED
}
}
#define PG8_SP2 true
#define PG8_ALIGN true

struct Args { const float* in[18]; float* out; unsigned char* ws; int ph_lo, ph_hi; };
typedef const __attribute__((address_space(4))) Args* KArgs;
enum { I_X = 0, I_NATT, I_WIN, I_QG, I_KG, I_CPOS, I_CW1, I_CW2, I_RELB, I_HLB, I_HNG, I_WBR, I_WOUT, I_NFFN, I_WUP, I_CONVW, I_CONVB, I_WDN };

struct Frame {
    LAS unsigned char* lds; volatile LAS unsigned* MISC;
    unsigned* ctl; unsigned char* ws;
    int tid, lane, wave, G, bid;
};

__device__ __forceinline__ int up_src_col(int n) { const int pn = n >> 8, c = n & 255; return c < 128 ? 128 * pn + c : DFF + 128 * pn + (c - 128); }
__device__ __forceinline__ int inproj_src_col(int n) { return n < 2560 ? n : (n < 15872 ? n + 24 : (n < 15896 ? n - 15872 + 2560 : -1)); }
__device__ __forceinline__ void transpose_item(const float* W, int K, int Nsrc, bf16_t* WT, const float* gain, int mode, LAS float* scr, int item, int nblk, int lane, int ldw = 0) {
    if (ldw == 0) ldw = K;
    const int kb = item / nblk, nb = item - kb * nblk, k0 = 64 * kb, n0 = 32 * nb;
    const int nn = n0 + (lane & 7) * 4; const int sc = mode == 1 ? inproj_src_col(nn) : (mode == 2 ? up_src_col(nn) : nn);
    f32x4 v[8];
#pragma unroll
    for (int i = 0; i < 8; ++i) { const int kk = 8 * i + (lane >> 3); v[i] = sc >= 0 ? __builtin_nontemporal_load((const f32x4*)(W + (size_t)(k0 + kk) * Nsrc + sc)) : (f32x4){0.f, 0.f, 0.f, 0.f}; }
#pragma unroll
    for (int i = 0; i < 8; ++i) { const int kk = 8 * i + (lane >> 3); const float gk = gain ? gain[k0 + kk] : 1.f; LAS float* d = scr + kk * 33 + (lane & 7) * 4;
        d[0] = v[i].x * gk; d[1] = v[i].y * gk; d[2] = v[i].z * gk; d[3] = v[i].w * gk; }
    LDS_WAIT(); asm volatile("" ::: "memory");
    const int c = lane & 7;
#pragma unroll
    for (int j = 0; j < 4; ++j) { const int n = (lane >> 3) + 8 * j; const LAS float* sp = scr + (8 * c) * 33 + n;
        u32x4 o; o.x = pk2(sp[0 * 33], sp[1 * 33]); o.y = pk2(sp[2 * 33], sp[3 * 33]); o.z = pk2(sp[4 * 33], sp[5 * 33]); o.w = pk2(sp[6 * 33], sp[7 * 33]);
        *(u32x4*)(WT + (size_t)(n0 + n) * ldw + k0 + 8 * c) = o; }
    LDS_WAIT(); asm volatile("" ::: "memory");
}
__device__ __forceinline__ void rms_row0(const float* xin, bf16_t* xb, float* rstd, int lane) {
    const f32x4* xr = (const f32x4*)xin + lane;
    f32x4 v[8]; float s = 0.f;
#pragma unroll
    for (int j = 0; j < 8; ++j) { v[j] = xr[64 * j]; s += (v[j].x * v[j].x + v[j].y * v[j].y) + (v[j].z * v[j].z + v[j].w * v[j].w); }
    s = wave_sum(s);
    if (lane == 0) *rstd = rsqrtf(s * (1.f / DM) + EPS);
    u32x2* o8 = (u32x2*)xb + lane;
#pragma unroll
    for (int j = 0; j < 8; ++j) { u32x2 w; w.x = pk2(v[j].x, v[j].y); w.y = pk2(v[j].z, v[j].w); o8[64 * j] = w; }
}
__device__ __forceinline__ void rstd_rows(Frame& F) {
    const float* ssq = (const float*)(F.ws + WS_SSQ); float* rstd = (float*)(F.ws + WS_RSTD);
    for (int row = F.bid * 512 + F.tid; row < M; row += F.G * 512) { const f32x4* p = (const f32x4*)(ssq + (size_t)row * 32); float s = 0.f;
#pragma unroll
        for (int j = 0; j < 8; ++j) { const f32x4 v = p[j]; s += (v.x + v.y) + (v.z + v.w); }
        rstd[row] = rsqrtf(s * (1.f / DM) + EPS); }
}

__device__ __forceinline__ void cvec_item(Frame& F, KArgs a, int layer, int j);
__device__ __forceinline__ void phase_A(Frame& F, KArgs a, int layer) {
    LAS float* scr = (LAS float*)(F.lds + F.wave * 16384);
    const int gw = F.bid * 8 + F.wave, NGW = F.G * 8;
    bf16_t* Wt_in = (bf16_t*)(F.ws + WS_WIN); bf16_t* Wt_br = (bf16_t*)(F.ws + WS_WBR); bf16_t* Wt_out = (bf16_t*)(F.ws + WS_WOUT);
    bf16_t* Wt_up = (bf16_t*)(F.ws + WS_WUP); bf16_t* Wt_dn = (bf16_t*)(F.ws + WS_WDN);
    const float* w_in = a->in[I_WIN] + (size_t)layer * DM * INC; const float* g_att = a->in[I_NATT] + layer * DM;
    const float* w_br = a->in[I_WBR] + (size_t)layer * 3 * BW * DM; const float* w_out = a->in[I_WOUT] + (size_t)layer * DM * DM;
    const float* w_up = a->in[I_WUP] + (size_t)layer * DM * NUP; const float* g_ffn = a->in[I_NFFN] + layer * DM;
    const float* w_dn = a->in[I_WDN] + (size_t)layer * DFF * DM;
    constexpr int I_IN = (DM / 64) * (NPC / 32), I_BR1 = (BW / 64) * (DM / 32), I_OUT = (DM / 64) * (DM / 32), I_UP = (DM / 64) * (NUP / 32), I_DN = (DFF / 64) * (DM / 32);
    constexpr int I_C1 = (4096 / 64) * (HD / 32);
    constexpr int NITEMS = I_IN + 3 * I_BR1 + I_OUT + I_UP + I_DN + 2 * I_C1;
    for (int it = gw; it < NITEMS; it += NGW) {
        int r = it;
        if (r < I_IN) { transpose_item(w_in, DM, INC, Wt_in, g_att, 1, scr, r, NPC / 32, F.lane); continue; } r -= I_IN;
        if (r < 3 * I_BR1) { const int n = r / I_BR1; r -= n * I_BR1; transpose_item(w_br + (size_t)n * BW * DM, BW, DM, Wt_br + (size_t)n * BW, nullptr, 0, scr, r, DM / 32, F.lane, 3 * BW); continue; } r -= 3 * I_BR1;
        if (r < I_OUT) { transpose_item(w_out, DM, DM, Wt_out, nullptr, 0, scr, r, DM / 32, F.lane); continue; } r -= I_OUT;
        if (r < I_UP) { transpose_item(w_up, DM, NUP, Wt_up, g_ffn, 2, scr, r, NUP / 32, F.lane); continue; } r -= I_UP;
        if (r < I_DN) { transpose_item(w_dn, DFF, DM, Wt_dn, nullptr, 0, scr, r, DM / 32, F.lane); continue; } r -= I_DN;
        { const int j = r / I_C1; r -= j * I_C1; transpose_item(a->in[I_CW1] + (size_t)(layer * 2 + j) * 4096 * HD, 4096, HD, (bf16_t*)(F.ws + WS_MISC + MISC_WC1) + (size_t)j * HD * 4096, nullptr, 0, scr, r, HD / 32, F.lane); }
    }
    if (F.bid < 64) cvec_item(F, a, layer, F.bid);
    if (layer == 0) { bf16_t* XB = (bf16_t*)(F.ws + WS_XB); float* rstd = (float*)(F.ws + WS_RSTD);
        for (int m = gw; m < M; m += NGW) rms_row0(a->in[I_X] + (size_t)m * DM, XB + (size_t)m * DM, rstd + m, F.lane); }
    else rstd_rows(F);
}
__device__ __forceinline__ void phase_F(Frame& F, KArgs a) { rstd_rows(F); }
__device__ __forceinline__ void phase_H(Frame& F, KArgs a, int layer) {
    const bf16_t* SD = (const bf16_t*)(F.ws + WS_USIDE); bf16_t* ACT = (bf16_t*)(F.ws + WS_ACT);
    const float* cw = a->in[I_CONVW] + (size_t)layer * 3 * NUP; const float* cb = a->in[I_CONVB] + (size_t)layer * NUP;
    constexpr int CG = DFF / 8, NTASK = (M / 64) * 2 * CG;
    for (int task = F.bid * 512 + F.tid; task < NTASK; task += F.G * 512) {
        const int cg = task % CG, rb = task / CG, rw = rb & 1, blk = rb >> 1; if ((blk & 31) == 0) continue;
        const int c0 = cg * 8, uc = 256 * (c0 >> 7) + (c0 & 127);
        const bf16_t* t2 = rw == 0 ? SD + ((size_t)(blk - 1) * 4 + 2) * NUP : SD + ((size_t)(blk - 1) * 4 + 3) * NUP;
        const bf16_t* t1 = rw == 0 ? SD + ((size_t)(blk - 1) * 4 + 3) * NUP : SD + ((size_t)blk * 4 + 0) * NUP;
        const bf16_t* t0 = SD + ((size_t)blk * 4 + rw) * NUP;
        const u32x4 g2 = *(const u32x4*)(t2 + uc), g1 = *(const u32x4*)(t1 + uc), g0 = *(const u32x4*)(t0 + uc), v2 = *(const u32x4*)(t2 + uc + 128), v1 = *(const u32x4*)(t1 + uc + 128), v0 = *(const u32x4*)(t0 + uc + 128);
        const unsigned G2[4] = {g2.x, g2.y, g2.z, g2.w}, G1[4] = {g1.x, g1.y, g1.z, g1.w}, G0[4] = {g0.x, g0.y, g0.z, g0.w}, V2[4] = {v2.x, v2.y, v2.z, v2.w}, V1[4] = {v1.x, v1.y, v1.z, v1.w}, V0[4] = {v0.x, v0.y, v0.z, v0.w};
        float o[8];
#pragma unroll
        for (int e = 0; e < 8; ++e) { const int q = e >> 1; const bool hi = e & 1;
            const float xg2 = hi ? bfhi(G2[q]) : bflo(G2[q]), xg1 = hi ? bfhi(G1[q]) : bflo(G1[q]), xg0 = hi ? bfhi(G0[q]) : bflo(G0[q]);
            const float xv2 = hi ? bfhi(V2[q]) : bflo(V2[q]), xv1 = hi ? bfhi(V1[q]) : bflo(V1[q]), xv0 = hi ? bfhi(V0[q]) : bflo(V0[q]);
            const float cgv = cb[c0 + e] + cw[c0 + e] * xg2 + cw[NUP + c0 + e] * xg1 + cw[2 * NUP + c0 + e] * xg0;
            const float cvv = cb[DFF + c0 + e] + cw[DFF + c0 + e] * xv2 + cw[NUP + DFF + c0 + e] * xv1 + cw[2 * NUP + DFF + c0 + e] * xv0;
            o[e] = cgv * sigmoidf_(cgv) * cvv; }
        *(u32x4*)(ACT + ((size_t)(c0 >> 6) * M + (size_t)(blk * 64 + rw)) * 64 + (c0 & 63)) = (u32x4){pk2(o[0], o[1]), pk2(o[2], o[3]), pk2(o[4], o[5]), pk2(o[6], o[7])};
    }
}

__device__ __forceinline__ int q_next(Frame& F, unsigned* head) {
    __syncthreads();
    if (F.tid == 0) F.MISC[16] = __hip_atomic_fetch_add(head, 1u, __ATOMIC_RELAXED, __HIP_MEMORY_SCOPE_AGENT);
    __syncthreads();
    return __builtin_amdgcn_readfirstlane((int)F.MISC[16]);
}
__device__ __forceinline__ int t5_bucket(int n) {
    if (n < 16) return n;
    int b = 16;
    b += (n >= 19); b += (n >= 21); b += (n >= 24); b += (n >= 27); b += (n >= 31); b += (n >= 35); b += (n >= 40); b += (n >= 46);
    b += (n >= 52); b += (n >= 59); b += (n >= 67); b += (n >= 77); b += (n >= 87); b += (n >= 99); b += (n >= 113);
    return b;
}
__device__ __forceinline__ int crow(int i, int h) { return (i & 3) + 8 * (i >> 2) + 4 * h; }

#define MFMA32(a, b, c) __builtin_amdgcn_mfma_f32_32x32x16_bf16((a), (b), (c), 0, 0, 0)
__device__ __forceinline__ float sum8lanes(float v) { v += __shfl_xor(v, 1); v += __shfl_xor(v, 2); v += __shfl_xor(v, 4); return v; }
__device__ __forceinline__ void norm16(unsigned* pp, const float* gn, float sc) {
    const u32x4 w0 = *(const u32x4*)pp, w1 = *(const u32x4*)(pp + 4); const unsigned w[8] = {w0.x, w0.y, w0.z, w0.w, w1.x, w1.y, w1.z, w1.w};
    float x[16], ss = 0.f;
#pragma unroll
    for (int q = 0; q < 8; ++q) { x[2 * q] = bflo(w[q]); x[2 * q + 1] = bfhi(w[q]); ss += x[2 * q] * x[2 * q] + x[2 * q + 1] * x[2 * q + 1]; }
    const float r = rsqrtf(sum8lanes(ss) * (1.f / HD) + EPS) * sc;
    u32x4 o0, o1;
    o0.x = pk2(x[0] * r * gn[0], x[1] * r * gn[1]); o0.y = pk2(x[2] * r * gn[2], x[3] * r * gn[3]); o0.z = pk2(x[4] * r * gn[4], x[5] * r * gn[5]); o0.w = pk2(x[6] * r * gn[6], x[7] * r * gn[7]);
    o1.x = pk2(x[8] * r * gn[8], x[9] * r * gn[9]); o1.y = pk2(x[10] * r * gn[10], x[11] * r * gn[11]); o1.z = pk2(x[12] * r * gn[12], x[13] * r * gn[13]); o1.w = pk2(x[14] * r * gn[14], x[15] * r * gn[15]);
    *(u32x4*)pp = o0; *(u32x4*)(pp + 4) = o1;
}
__device__ __forceinline__ void item_norm(Frame& F, KArgs a, int layer, int it) {
    bf16_t* P = (bf16_t*)(F.ws + WS_P);
    const float* qg = a->in[I_QG] + layer * HD; const float* kg = a->in[I_KG] + layer * 3 * HD;
    const int lane = F.lane, e0 = (lane & 7) * 16;
    float gq[16], gk[16];
#pragma unroll
    for (int e = 0; e < 16; ++e) { gq[e] = qg[e0 + e]; gk[e] = kg[((lane >> 4) & 1 ? 2 : 1) * HD + e0 + e]; }
    for (int rr = 0; rr < 8; ++rr) {
        bf16_t* pr = P + (size_t)(it * 64 + F.wave * 8 + rr) * NPC;
        norm16((unsigned*)(pr + PQN + lane * 16), gq, QSCALE);
        if (lane < 32) norm16((unsigned*)(pr + (lane < 16 ? PKS + lane * 16 : PKW + (lane - 16) * 16)), gk, 1.f);
    }
}
__device__ __forceinline__ void item_hgfin(Frame& F, KArgs a, int layer, int it) {
    const bf16_t* P = (const bf16_t*)(F.ws + WS_P); const float* OR = (const float*)(F.ws + WS_ORAW); bf16_t* OH = (bf16_t*)(F.ws + WS_OBR) + 2 * BW;
    const float* ng = a->in[I_HNG] + layer * HD; const int lane = F.lane, e0 = (lane & 7) * 16;
    float gn[16];
#pragma unroll
    for (int e = 0; e < 16; ++e) gn[e] = ng[e0 + e];
    for (int rr = 0; rr < 8; ++rr) { const size_t row = (size_t)(it * 64 + F.wave * 8 + rr);
        const f32x4* op = (const f32x4*)(OR + row * BW + lane * 16); const f32x4 o0 = op[0], o1 = op[1], o2 = op[2], o3 = op[3];
        const unsigned* gp = (const unsigned*)(P + row * NPC + PGH + lane * 16); const u32x4 g0 = *(const u32x4*)gp, g1 = *(const u32x4*)(gp + 4);
        const float x[16] = {o0.x, o0.y, o0.z, o0.w, o1.x, o1.y, o1.z, o1.w, o2.x, o2.y, o2.z, o2.w, o3.x, o3.y, o3.z, o3.w}; const unsigned gw[8] = {g0.x, g0.y, g0.z, g0.w, g1.x, g1.y, g1.z, g1.w};
        float ss = 0.f;
#pragma unroll
        for (int e = 0; e < 16; ++e) ss += x[e] * x[e];
        const float r = rsqrtf(sum8lanes(ss) * (1.f / HD) + EPS);
        unsigned ow[8];
#pragma unroll
        for (int q = 0; q < 8; ++q) ow[q] = pk2(x[2 * q] * r * gn[2 * q] * sigmoidf_(bflo(gw[q])), x[2 * q + 1] * r * gn[2 * q + 1] * sigmoidf_(bfhi(gw[q])));
        unsigned* dst = (unsigned*)(OH + row * (3 * BW) + lane * 16);
        *(u32x4*)dst = (u32x4){ow[0], ow[1], ow[2], ow[3]}; *(u32x4*)(dst + 4) = (u32x4){ow[4], ow[5], ow[6], ow[7]};
    }
}
__device__ __forceinline__ void cvec_item(Frame& F, KArgs a, int layer, int blk) {
    const int j = blk >> 5, ks = blk & 31;
    const float* pos = a->in[I_CPOS] + (size_t)(layer * 2 + j) * 32 * HD; const float* w1 = a->in[I_CW1] + (size_t)(layer * 2 + j) * 32 * HD * HD;
    LAS float* red = (LAS float*)F.lds; const int e = F.tid & 127, sub = F.tid >> 7;
    float acc = 0.f;
#pragma unroll 8
    for (int k = ks * 128 + sub * 32; k < ks * 128 + sub * 32 + 32; ++k) acc += pos[k] * w1[(size_t)k * HD + e];
    __syncthreads(); red[sub * 128 + e] = acc; __syncthreads();
    if (F.tid < 128) ((float*)(F.ctl + CW_CVEC))[(j * 32 + ks) * 128 + F.tid] = (red[F.tid] + red[128 + F.tid]) + (red[256 + F.tid] + red[384 + F.tid]);
    __syncthreads();
}
__device__ __forceinline__ void item_compress(Frame& F, KArgs a, int layer, int id) {
    const int j = id >> 7, rem = id & 127, b = rem >> 3, g = (rem >> 2) & 1, n0 = (rem & 3) * 32;
    const bf16_t* P = (const bf16_t*)(F.ws + WS_P);
    LAS float* red = (LAS float*)F.lds;
    LAS float* hid = (LAS float*)(F.lds + 16384);
    LAS float* outv = (LAS float*)(F.lds + 16384 + 32 * 132 * 4);
    const int tid = F.tid, lane = F.lane, wave = F.wave, r = lane & 31, h = lane >> 5, ct = wave & 3, kh = wave >> 2;
    f32x16 acc;
#pragma unroll
    for (int i = 0; i < 16; ++i) acc[i] = 0.f;
    {
        int trow = 16 * (n0 + r) + 16 * kh; const int tmax = T - 1;
        const bf16_t* Ab = P + (size_t)(b * T) * NPC + (j ? PVC : PKC) + g * HD + 8 * h;
        const bf16_t* Bb = (const bf16_t*)(F.ws + WS_MISC + MISC_WC1) + (size_t)(j * HD + 32 * ct + r) * 4096 + (size_t)(16 * kh) * HD + 8 * h;
        for (int l = 0; l < 16; ++l) { const int t = (trow + l) < tmax ? (trow + l) : tmax; const bf16_t* ap = Ab + (size_t)t * NPC; const bf16_t* bp = Bb + l * HD;
#pragma unroll
            for (int ds = 0; ds < 8; ++ds) { const bf16x8 av = *(const bf16x8*)(ap + 16 * ds), bv = *(const bf16x8*)(bp + 16 * ds); acc = MFMA32(av, bv, acc); } }
    }
    if (kh == 1) {
#pragma unroll
        for (int i = 0; i < 16; ++i) red[(ct * 16 + i) * 64 + lane] = acc[i]; }
    __syncthreads();
    if (kh == 0) { float cv = 0.f; { const float* cp = (const float*)(F.ctl + CW_CVEC) + (size_t)(j * 32) * 128 + 32 * ct + r;
#pragma unroll 8
        for (int q = 0; q < 32; ++q) cv += cp[q * 128]; }
#pragma unroll
        for (int i = 0; i < 16; ++i) { const float x = acc[i] + red[(ct * 16 + i) * 64 + lane] + cv;
            const float y = 0.7978845608028654f * (x + 0.044715f * x * x * x);
            const float th = 1.f - 2.f * fast_rcp(1.f + fast_exp2(2.f * y * LOG2E));
            hid[crow(i, h) * 132 + 32 * ct + r] = 0.5f * x * (1.f + th); } }
    __syncthreads();
    { const int e2 = tid & 127, ng = __builtin_amdgcn_readfirstlane(tid >> 7); const float* w2 = a->in[I_CW2] + (size_t)(layer * 2 + j) * HD * HD + e2;
      float o[8];
#pragma unroll
      for (int q = 0; q < 8; ++q) o[q] = 0.f;
      for (int k = 0; k < 128; k += 4) { const float w0 = w2[(size_t)k * HD], w1 = w2[(size_t)(k + 1) * HD], w2_ = w2[(size_t)(k + 2) * HD], w3 = w2[(size_t)(k + 3) * HD];
#pragma unroll
          for (int q = 0; q < 8; ++q) { const f32x4 hv = *(const LAS f32x4*)(hid + (8 * ng + q) * 132 + k); o[q] += (hv.x * w0 + hv.y * w1) + (hv.z * w2_ + hv.w * w3); } }
#pragma unroll
      for (int q = 0; q < 8; ++q) outv[(8 * ng + q) * 132 + e2] = o[q]; }
    __syncthreads();
    const float* kg0 = a->in[I_KG] + layer * 3 * HD;
#pragma unroll
    for (int q = 0; q < 4; ++q) { const int n = 4 * wave + q; float v0 = outv[n * 132 + 2 * lane], v1 = outv[n * 132 + 2 * lane + 1];
        if (j == 0) { const float ss = wave_sum(v0 * v0 + v1 * v1); const float rr = rsqrtf(ss * (1.f / HD) + EPS); v0 *= rr * kg0[2 * lane]; v1 *= rr * kg0[2 * lane + 1]; }
        if (n0 + n >= 127) { v0 = 0.f; v1 = 0.f; }
        bf16_t* dst = (bf16_t*)(F.ws + WS_MISC + (j ? MISC_VCMP : MISC_KCMP)) + (size_t)((b * 2 + g) * 128 + n0 + n) * HD;
        *((unsigned*)dst + lane) = pk2(v0, v1); }
}
__device__ __forceinline__ float xhalf_sum(float v);
constexpr int HG_Q1 = 0, HG_K1 = 17408, HG_QI = 34816, HG_K2 = 43520, HG_K3T = 52224, HG_VT = 70656, HG_AT = 89088, HG_SB = 98304, HG_TOT = 133120, HG_LB = 135168, HG_SS = 135680;
__device__ __forceinline__ void item_hgrn(Frame& F, KArgs a, int layer, int id) {
    const int b = id >> 3, hh = id & 7;
    const bf16_t* P = (const bf16_t*)(F.ws + WS_P); bf16_t* OH = (bf16_t*)(F.ws + WS_OBR) + 2 * BW + hh * HD;
    LAS unsigned char* L = F.lds;
    LAS float* tot = (LAS float*)(L + HG_TOT); LAS float* lbs = (LAS float*)(L + HG_LB); LAS float* ssp = (LAS float*)(L + HG_SS);
    const int tid = F.tid, lane = F.lane, wave = F.wave, r = lane & 31, h = lane >> 5;
    if (tid < 128) { const float* hb = a->in[I_HLB] + hh * HD + tid; const float x0 = hb[0], x1 = hb[1024], x2 = hb[2048], x3 = hb[3072];
        const float mx = fmaxf(fmaxf(x0, x1), fmaxf(x2, x3)); const float e0 = __expf(x0 - mx), e1 = __expf(x1 - mx), e2 = __expf(x2 - mx), e3 = __expf(x3 - mx);
        const float inv = 1.f / (e0 + e1 + e2 + e3); float c = 0.f; if (layer >= 1) c += e1; if (layer >= 2) c += e2; if (layer >= 3) c += e3;
        lbs[tid] = fmaxf(c * inv, 0.f); }
    { unsigned zu; asm volatile("v_mov_b32 %0, 0" : "=v"(zu));
      for (int i = tid; i < 34816 / 16; i += 512) *(LAS u32x4*)(L + HG_SB + i * 16) = (u32x4){zu, zu, zu, zu}; }
    f32x16 Sacc[2];
#pragma unroll
    for (int q = 0; q < 2; ++q)
#pragma unroll
        for (int i = 0; i < 16; ++i) Sacc[q][i] = 0.f;
    const int pd = tid & 127, psc = __builtin_amdgcn_readfirstlane(tid >> 7);
    const int srow = tid >> 4, sch = tid & 15;
    const bf16_t* gq = P + (size_t)(b * T + srow) * NPC + PQH + hh * HD + sch * 8; const bf16_t* gf = P + (size_t)(b * T + srow) * NPC + PFH + hh * HD + sch * 8;
    const bf16_t* gv = P + (size_t)(b * T + srow) * NPC + PIH + hh * HD + sch * 8;
    u32x4 rq0 = *(const u32x4*)gq, rq1 = *(const u32x4*)(gq + (size_t)32 * NPC), rf0 = *(const u32x4*)gf, rf1 = *(const u32x4*)(gf + (size_t)32 * NPC), rv0 = *(const u32x4*)gv, rv1 = *(const u32x4*)(gv + (size_t)32 * NPC);
    const int et = wave & 3, tt2 = wave >> 2;
    for (int c = 0; c < T / 64; ++c) {
        __syncthreads();
        *(LAS u32x4*)(L + HG_Q1 + srow * 272 + sch * 16) = rq0; *(LAS u32x4*)(L + HG_Q1 + (srow + 32) * 272 + sch * 16) = rq1;
        *(LAS u32x4*)(L + HG_K1 + srow * 272 + sch * 16) = rf0; *(LAS u32x4*)(L + HG_K1 + (srow + 32) * 272 + sch * 16) = rf1;
        { const unsigned v0[4] = {rv0.x, rv0.y, rv0.z, rv0.w}, v1[4] = {rv1.x, rv1.y, rv1.z, rv1.w};
#pragma unroll
          for (int q = 0; q < 4; ++q) { LAS unsigned short* p0 = (LAS unsigned short*)(L + HG_VT + (8 * sch + 2 * q) * 144 + srow * 2); LAS unsigned short* p1 = (LAS unsigned short*)(L + HG_VT + (8 * sch + 2 * q + 1) * 144 + srow * 2);
              p0[0] = (unsigned short)(v0[q] & 0xffffu); p1[0] = (unsigned short)(v0[q] >> 16); p0[32] = (unsigned short)(v1[q] & 0xffffu); p1[32] = (unsigned short)(v1[q] >> 16); } }
        __syncthreads();
        if (c + 1 < T / 64) { const size_t adv = (size_t)(64 * (c + 1)) * NPC;
            rq0 = *(const u32x4*)(gq + adv); rq1 = *(const u32x4*)(gq + adv + (size_t)32 * NPC); rf0 = *(const u32x4*)(gf + adv); rf1 = *(const u32x4*)(gf + adv + (size_t)32 * NPC);
            rv0 = *(const u32x4*)(gv + adv); rv1 = *(const u32x4*)(gv + adv + (size_t)32 * NPC); }
        float qv[16], kv[16], bl[16];
        { const float lb = lbs[pd]; float run = 0.f;
#pragma unroll
          for (int tt = 0; tt < 16; ++tt) { const int t = 16 * psc + tt;
              qv[tt] = bf2f(*(const LAS unsigned short*)(L + HG_Q1 + t * 272 + pd * 2)); const float fp = bf2f(*(const LAS unsigned short*)(L + HG_K1 + t * 272 + pd * 2));
              const float ex = fast_exp2(-fabsf(fp) * LOG2E);
              const float sg = (fp >= 0.f ? 1.f : ex) * fast_rcp(1.f + ex);
              const float f = lb + (1.f - lb) * sg; kv[tt] = 1.f - f;
              const float lf = (layer == 0) ? (fminf(fp, 0.f) - LN2 * fast_log2(1.f + ex)) : LN2 * fast_log2(f);
              run += lf; bl[tt] = run; }
          tot[psc * 128 + pd] = run; }
        __syncthreads();
        { const float t0 = tot[pd], t1 = tot[128 + pd], t2 = tot[256 + pd], t3 = tot[384 + pd];
          const float b31 = t0 + t1, b63 = (t0 + t1) + (t2 + t3);
          const float pre = psc == 0 ? 0.f : (psc == 1 ? t0 : (psc == 2 ? b31 : b31 + t2));
          const float rref = psc >= 2 ? b31 : 0.f; const float eb31 = fast_exp2(b31 * LOG2E), c3 = fast_exp2((b63 - rref) * LOG2E);
          unsigned k3w[8];
#pragma unroll
          for (int tt = 0; tt < 16; ++tt) { const int t = 16 * psc + tt; const float bb = pre + bl[tt];
              const float e1 = fast_exp2((bb - rref) * LOG2E); const float q1 = qv[tt] * e1;
              const float k1 = kv[tt] * fast_exp2(fminf(rref - bb, 80.f) * LOG2E);
              const float k3 = k1 * c3;
              *(LAS unsigned short*)(L + HG_Q1 + t * 272 + pd * 2) = (unsigned short)(pk2(q1, 0.f) & 0xffffu);
              *(LAS unsigned short*)(L + HG_K1 + t * 272 + pd * 2) = (unsigned short)(pk2(k1, 0.f) & 0xffffu);
              if (psc >= 2) *(LAS unsigned short*)(L + HG_QI + (t - 32) * 272 + pd * 2) = (unsigned short)(pk2(q1 * eb31, 0.f) & 0xffffu);
              else *(LAS unsigned short*)(L + HG_K2 + t * 272 + pd * 2) = (unsigned short)(pk2(k1 * eb31, 0.f) & 0xffffu);
              if (tt & 1) k3w[tt >> 1] = (k3w[tt >> 1] & 0xffffu) | (pk2(0.f, k3) & 0xffff0000u); else k3w[tt >> 1] = pk2(k3, 0.f) & 0xffffu; }
          *(LAS u32x4*)(L + HG_K3T + pd * 144 + psc * 32) = (u32x4){k3w[0], k3w[1], k3w[2], k3w[3]}; *(LAS u32x4*)(L + HG_K3T + pd * 144 + psc * 32 + 16) = (u32x4){k3w[4], k3w[5], k3w[6], k3w[7]}; }
        __syncthreads();
        if (wave < 3) {
            const int st = wave == 1 ? 1 : 0, ta = wave == 0 ? 0 : 1;
            const LAS unsigned char* Kb = L + (wave == 2 ? HG_K2 : HG_K1 + st * 32 * 272) + r * 272 + 16 * h; const LAS unsigned char* Qb = L + HG_Q1 + (32 * ta + r) * 272 + 16 * h;
            f32x16 at;
#pragma unroll
            for (int i = 0; i < 16; ++i) at[i] = 0.f;
#pragma unroll
            for (int s8 = 0; s8 < 8; ++s8) at = MFMA32(*(const LAS bf16x8*)(Kb + 32 * s8), *(const LAS bf16x8*)(Qb + 32 * s8), at);
            if (wave < 2) {
#pragma unroll
                for (int i = 0; i < 16; ++i) at[i] = (crow(i, h) <= r) ? at[i] : 0.f; }
#pragma unroll
            for (int g4 = 0; g4 < 4; ++g4) { u32x2 w; w.x = pk2(at[4 * g4], at[4 * g4 + 1]); w.y = pk2(at[4 * g4 + 2], at[4 * g4 + 3]);
                *(LAS u32x2*)(L + HG_AT + (32 * ta + r) * 144 + (32 * st + 8 * g4 + 4 * h) * 2) = w; }
        }
        f32x16 oo;
#pragma unroll
        for (int i = 0; i < 16; ++i) oo[i] = 0.f;
        { const LAS unsigned char* Sb = L + HG_SB + (32 * et + r) * 272 + 16 * h; const LAS unsigned char* Qb = L + (tt2 ? HG_QI : HG_Q1) + r * 272 + 16 * h;
#pragma unroll
          for (int s8 = 0; s8 < 8; ++s8) oo = MFMA32(*(const LAS bf16x8*)(Sb + 32 * s8), *(const LAS bf16x8*)(Qb + 32 * s8), oo); }
        __syncthreads();
#pragma unroll
        for (int q = 0; q < 2; ++q) { const int dt = (wave >> 2) + 2 * q, dd = 32 * dt + r;
            const float eb63 = fast_exp2(((tot[dd] + tot[128 + dd]) + (tot[256 + dd] + tot[384 + dd])) * LOG2E);
#pragma unroll
            for (int i = 0; i < 16; ++i) Sacc[q][i] *= eb63;
            const LAS unsigned char* Vb = L + HG_VT + (32 * et + r) * 144 + 16 * h; const LAS unsigned char* Kb = L + HG_K3T + dd * 144 + 16 * h;
#pragma unroll
            for (int s4 = 0; s4 < 4; ++s4) Sacc[q] = MFMA32(*(const LAS bf16x8*)(Vb + 32 * s4), *(const LAS bf16x8*)(Kb + 32 * s4), Sacc[q]);
            LAS unsigned char* Sw = L + HG_SB + dd * 2;
#pragma unroll
            for (int i = 0; i < 16; i += 2) { const unsigned w = pk2(Sacc[q][i], Sacc[q][i + 1]);
                *(LAS unsigned short*)(Sw + (32 * et + crow(i, h)) * 272) = (unsigned short)(w & 0xffffu); *(LAS unsigned short*)(Sw + (32 * et + crow(i + 1, h)) * 272) = (unsigned short)(w >> 16); } }
        { const LAS unsigned char* Vb = L + HG_VT + (32 * et + r) * 144 + 16 * h; const LAS unsigned char* Ab = L + HG_AT + (32 * tt2 + r) * 144 + 16 * h;
          oo = MFMA32(*(const LAS bf16x8*)(Vb), *(const LAS bf16x8*)(Ab), oo); oo = MFMA32(*(const LAS bf16x8*)(Vb + 32), *(const LAS bf16x8*)(Ab + 32), oo);
          if (tt2) { oo = MFMA32(*(const LAS bf16x8*)(Vb + 64), *(const LAS bf16x8*)(Ab + 64), oo); oo = MFMA32(*(const LAS bf16x8*)(Vb + 96), *(const LAS bf16x8*)(Ab + 96), oo); } }
        { float ss = 0.f;
#pragma unroll
          for (int i = 0; i < 16; ++i) ss += oo[i] * oo[i];
          ss = xhalf_sum(ss);
          if (h == 0) ssp[(32 * tt2 + r) * 4 + et] = ss; }
        __syncthreads();
        { const f32x4 s4 = *(const LAS f32x4*)(ssp + (32 * tt2 + r) * 4); const float rn = rsqrtf(((s4.x + s4.y) + (s4.z + s4.w)) * (1.f / HD) + EPS);
          const size_t row = (size_t)(b * T + 64 * c + 32 * tt2 + r); const float* ng = a->in[I_HNG] + layer * HD;
#pragma unroll
          for (int g4 = 0; g4 < 4; ++g4) { const int e0 = 32 * et + 8 * g4 + 4 * h;
              const u32x2 gw = *(const u32x2*)(P + row * NPC + PGH + hh * HD + e0); const f32x4 gn = *(const f32x4*)(ng + e0);
              u32x2 w; w.x = pk2(oo[4 * g4] * rn * gn.x * sigmoidf_(bflo(gw.x)), oo[4 * g4 + 1] * rn * gn.y * sigmoidf_(bfhi(gw.x)));
              w.y = pk2(oo[4 * g4 + 2] * rn * gn.z * sigmoidf_(bflo(gw.y)), oo[4 * g4 + 3] * rn * gn.w * sigmoidf_(bfhi(gw.y)));
              *(u32x2*)(OH + row * (3 * BW) + e0) = w; } }
    }
}

constexpr int AT_K = 0, AT_V = 32768, AT_TAB = 73728, AT_IMP = 75776, AT_SELM = 109568, AT_MISC = 109824;
constexpr int K_TB = 16384, V_RS = 320, V_TB = 64 * V_RS;
__device__ __forceinline__ unsigned koff(int row, int ch) { return 256u * (unsigned)row + 16u * (unsigned)(ch ^ (((row & 3) << 2) | ((row >> 2) & 3))); }
struct Stg { u32x4 k0, k1, v0, v1; };
__device__ __forceinline__ void stg_load(Stg& s, const bf16_t* Kp, const bf16_t* Vp, int ld, int tid) {
    const int row = tid >> 4, ch = tid & 15;
    s.k0 = *(const u32x4*)(Kp + (size_t)row * ld + ch * 8); s.k1 = *(const u32x4*)(Kp + (size_t)(row + 32) * ld + ch * 8);
    s.v0 = *(const u32x4*)(Vp + (size_t)row * ld + ch * 8); s.v1 = *(const u32x4*)(Vp + (size_t)(row + 32) * ld + ch * 8);
}
__device__ __forceinline__ void stg_write(const Stg& s, LAS unsigned char* L, int tid, int buf) {
    const int row = tid >> 4, ch = tid & 15;
    *(LAS u32x4*)(L + AT_K + buf * K_TB + koff(row, ch)) = s.k0; *(LAS u32x4*)(L + AT_K + buf * K_TB + koff(row + 32, ch)) = s.k1;
    *(LAS u32x4*)(L + AT_V + buf * V_TB + row * V_RS + ch * 16) = s.v0; *(LAS u32x4*)(L + AT_V + buf * V_TB + (row + 32) * V_RS + ch * 16) = s.v1;
}
__device__ __forceinline__ float xhalf_max(float v) { auto rr = __builtin_amdgcn_permlane32_swap(__float_as_uint(v), __float_as_uint(v), false, false); return fmaxf(__uint_as_float(rr[0]), __uint_as_float(rr[1])); }
__device__ __forceinline__ float xhalf_sum(float v) { auto rr = __builtin_amdgcn_permlane32_swap(__float_as_uint(v), __float_as_uint(v), false, false); return __uint_as_float(rr[0]) + __uint_as_float(rr[1]); }
__device__ __forceinline__ float xhalf_get(float v, int h) { auto rr = __builtin_amdgcn_permlane32_swap(__float_as_uint(v), __float_as_uint(v), false, false); return __uint_as_float(h ? rr[0] : rr[1]); }
__device__ __forceinline__ void qk_tile(f32x16& p0, f32x16& p1, const LAS unsigned char* L, int buf, const bf16x8 (&qf)[8], int r, int h) {
#pragma unroll
    for (int i = 0; i < 16; ++i) { p0[i] = 0.f; p1[i] = 0.f; }
    const LAS unsigned char* Kb = L + AT_K + buf * K_TB;
    bf16x8 a0[8], a1[8];
#pragma unroll
    for (int s = 0; s < 8; ++s) { a0[s] = *(const LAS bf16x8*)(Kb + koff(r, 2 * s + h)); a1[s] = *(const LAS bf16x8*)(Kb + koff(r + 32, 2 * s + h)); }
#pragma unroll
    for (int s = 0; s < 8; ++s) { p0 = MFMA32(a0[s], qf[s], p0); p1 = MFMA32(a1[s], qf[s], p1); }
    __builtin_amdgcn_sched_group_barrier(0x100, 4, 0);
#pragma unroll
    for (int i = 0; i < 6; ++i) { __builtin_amdgcn_sched_group_barrier(0x008, 2, 0); __builtin_amdgcn_sched_group_barrier(0x100, 2, 0); }
    __builtin_amdgcn_sched_group_barrier(0x008, 4, 0);
}
__device__ __forceinline__ bf16x8 pack8(const f32x16& p, int s) {
    u32x4 w; w.x = pk2(p[8 * s], p[8 * s + 1]); w.y = pk2(p[8 * s + 2], p[8 * s + 3]); w.z = pk2(p[8 * s + 4], p[8 * s + 5]); w.w = pk2(p[8 * s + 6], p[8 * s + 7]);
    return __builtin_bit_cast(bf16x8, w);
}
__device__ __forceinline__ void pv_tile(f32x16 (&o)[4], const f32x16& p0, const f32x16& p1, const LAS unsigned char* L, int buf, int lane) {
    bf16x8 pb[4]; pb[0] = pack8(p0, 0); pb[1] = pack8(p0, 1); pb[2] = pack8(p1, 0); pb[3] = pack8(p1, 1);
    const LAS unsigned char* vb = L + AT_V + buf * V_TB + (4 * (lane >> 5) + ((lane & 15) >> 2)) * V_RS + ((lane >> 4) & 1) * 32 + (lane & 3) * 8;
    __builtin_amdgcn_sched_barrier(0);
    s16x4 lo[16], hi[16];
#pragma unroll
    for (int c = 0; c < 4; ++c)
#pragma unroll
        for (int s = 0; s < 4; ++s) { lo[4 * c + s] = __builtin_amdgcn_ds_read_tr16_b64_v4i16((LAS s16x4*)(vb + (16 * s) * V_RS + 64 * c)); hi[4 * c + s] = __builtin_amdgcn_ds_read_tr16_b64_v4i16((LAS s16x4*)(vb + (16 * s + 8) * V_RS + 64 * c)); }
#pragma unroll
    for (int c = 0; c < 4; ++c)
#pragma unroll
        for (int s = 0; s < 4; ++s) o[c] = MFMA32(__builtin_shufflevector(lo[4 * c + s], hi[4 * c + s], 0, 1, 2, 3, 4, 5, 6, 7), pb[s], o[c]);
    __builtin_amdgcn_sched_group_barrier(0x100, 4, 1);
#pragma unroll
    for (int i = 0; i < 14; ++i) { __builtin_amdgcn_sched_group_barrier(0x008, 1, 1); __builtin_amdgcn_sched_group_barrier(0x100, 2, 1); }
    __builtin_amdgcn_sched_group_barrier(0x008, 2, 1);
    __builtin_amdgcn_sched_barrier(0);
}
__device__ __forceinline__ void softmax_step(f32x16& p0, f32x16& p1, float& m, float& l, f32x16 (&o)[4]) {
    float mx = p0[0];
#pragma unroll
    for (int i = 1; i < 16; ++i) mx = fmaxf(mx, p0[i]);
#pragma unroll
    for (int i = 0; i < 16; ++i) mx = fmaxf(mx, p1[i]);
    mx = xhalf_max(mx);
    const float mn = fmaxf(m, mx); const float alpha = fast_exp2((m - mn) * LOG2E); m = mn;
    const float mb = mn * LOG2E; float ps = 0.f;
#pragma unroll
    for (int i = 0; i < 16; ++i) { p0[i] = fast_exp2(p0[i] * LOG2E - mb); ps += p0[i]; }
#pragma unroll
    for (int i = 0; i < 16; ++i) { p1[i] = fast_exp2(p1[i] * LOG2E - mb); ps += p1[i]; }
    ps = xhalf_sum(ps);
    l = l * alpha + ps;
    if (!__all(alpha == 1.f)) {
#pragma unroll
        for (int c = 0; c < 4; ++c)
#pragma unroll
            for (int i = 0; i < 16; ++i) o[c][i] *= alpha; }
}
__device__ __forceinline__ void store_ot(const f32x16 (&o)[4], float sc, bf16_t* dst  , int h, bool add) {
#pragma unroll
    for (int c = 0; c < 4; ++c)
#pragma unroll
        for (int g4 = 0; g4 < 4; ++g4) { u32x2* p = (u32x2*)(dst + 32 * c + 8 * g4 + 4 * h);
            float v0 = sc * o[c][4 * g4], v1 = sc * o[c][4 * g4 + 1], v2 = sc * o[c][4 * g4 + 2], v3 = sc * o[c][4 * g4 + 3];
            if (add) { const u32x2 w0 = *p; v0 += bflo(w0.x); v1 += bfhi(w0.x); v2 += bflo(w0.y); v3 += bfhi(w0.y); }
            u32x2 w; w.x = pk2(v0, v1); w.y = pk2(v2, v3); *p = w; }
}

__device__ __forceinline__ void item_sb(Frame& F, KArgs a, int item) {
    LAS unsigned char* L = F.lds;
    const int qb = 7 - (item >> 7), rem = item & 127, b = rem >> 3, hh = rem & 7, t0 = qb * 256;
    const int tid = F.tid, lane = F.lane, wave = F.wave, r = lane & 31, h = lane >> 5;
    const int tq = t0 + 32 * wave + r;
    const bf16_t* P = (const bf16_t*)(F.ws + WS_P); const size_t rowq = (size_t)(b * T + tq);
    const bf16_t* Kb = P + (size_t)(b * T) * NPC + PKSB + hh * HD; const bf16_t* Vb = P + (size_t)(b * T) * NPC + PVSB + hh * HD;
    bf16x8 qf[8];
#pragma unroll
    for (int s = 0; s < 8; ++s) qf[s] = *(const bf16x8*)(P + rowq * NPC + PQS + hh * HD + 16 * s + 8 * h);
    f32x16 o[4];
#pragma unroll
    for (int c = 0; c < 4; ++c)
#pragma unroll
        for (int i = 0; i < 16; ++i) o[c][i] = 0.f;
    float C = 0.f; bool wdone = false;
    volatile LAS unsigned* flags = (volatile LAS unsigned*)(L + AT_MISC);
    Stg st; int j = 4 * qb + 3, buf = 0, it = 0;
    stg_load(st, Kb + (size_t)(64 * j) * NPC, Vb + (size_t)(64 * j) * NPC, NPC, tid);
    __syncthreads();
    stg_write(st, L, tid, 0);
    if (j > 0) stg_load(st, Kb + (size_t)(64 * (j - 1)) * NPC, Vb + (size_t)(64 * (j - 1)) * NPC, NPC, tid);
    for (;;) {
        if (lane == 0) flags[(it & 1) * 8 + wave] = wdone ? 1u : 0u;
        __syncthreads();
        unsigned nd = 0;
#pragma unroll
        for (int w = 0; w < 8; ++w) nd += flags[(it & 1) * 8 + w];
        if (__builtin_amdgcn_readfirstlane(nd) == 8u) break;
        if (j > 0) stg_write(st, L, tid, buf ^ 1);
        if (j > 1) stg_load(st, Kb + (size_t)(64 * (j - 2)) * NPC, Vb + (size_t)(64 * (j - 2)) * NPC, NPC, tid);
        const bool active = !wdone && (64 * j <= t0 + 32 * wave + 30);
        if (active) {
            f32x16 p0, p1; qk_tile(p0, p1, L, buf, qf, r, h);
            float lm0[16], lm1[16];
            const int kb = 64 * j + 4 * h;
#pragma unroll
            for (int i = 0; i < 16; ++i) {
                const int key0 = kb + (i & 3) + 8 * (i >> 2);
                { const float z = p0[i] * QSCALE; const float sp = fmaxf(z, 0.f) + LN2 * fast_log2(1.f + fast_exp2(-fabsf(z) * LOG2E)); const bool cz = key0 < tq; lm0[i] = cz ? -sp : 0.f; p0[i] = z - sp; }
                { const float z = p1[i] * QSCALE; const float sp = fmaxf(z, 0.f) + LN2 * fast_log2(1.f + fast_exp2(-fabsf(z) * LOG2E)); const bool cz = key0 + 32 < tq; lm1[i] = cz ? -sp : 0.f; p1[i] = z - sp; }
            }
            float Tm[2][4], Tr[2][4];
#pragma unroll
            for (int g4 = 0; g4 < 4; ++g4) { Tm[0][g4] = (lm0[4 * g4] + lm0[4 * g4 + 1]) + (lm0[4 * g4 + 2] + lm0[4 * g4 + 3]); Tm[1][g4] = (lm1[4 * g4] + lm1[4 * g4 + 1]) + (lm1[4 * g4 + 2] + lm1[4 * g4 + 3]); }
#pragma unroll
            for (int k = 0; k < 2; ++k)
#pragma unroll
                for (int g4 = 0; g4 < 4; ++g4) Tr[k][g4] = xhalf_get(Tm[k][g4], h);
            float aft[2][4]; float run = C;
#pragma unroll
            for (int G = 15; G >= 0; --G) { const int k = G >> 3, g4 = (G >> 1) & 3, par = G & 1;
                const float tg = (par == 1) ? (h ? Tm[k][g4] : Tr[k][g4]) : (h ? Tr[k][g4] : Tm[k][g4]);
                if (par == 1) { if (h) aft[k][g4] = run; } else { if (!h) aft[k][g4] = run; }
                run += tg; }
            C = run;
#pragma unroll
            for (int g4 = 0; g4 < 4; ++g4) {
                { float ca = aft[0][g4];
#pragma unroll
                  for (int e = 3; e >= 0; --e) { const int i = 4 * g4 + e; const float la = p0[i] + ca; ca += lm0[i]; p0[i] = (kb + e + 8 * g4 < tq) ? fast_exp2(la * LOG2E) : 0.f; } }
                { float ca = aft[1][g4];
#pragma unroll
                  for (int e = 3; e >= 0; --e) { const int i = 4 * g4 + e; const float la = p1[i] + ca; ca += lm1[i]; p1[i] = (kb + 32 + e + 8 * g4 < tq) ? fast_exp2(la * LOG2E) : 0.f; } }
            }
            pv_tile(o, p0, p1, L, buf, lane);
            wdone = __all(C < -104.f);
        }
        if (j == 0) break;
        --j; buf ^= 1; ++it;
    }
    bf16_t* OS = (bf16_t*)(F.ws + WS_OBR) + BW;
    store_ot(o, 1.f, OS + rowq * (3 * BW) + hh * HD, h, false);
}

__device__ __forceinline__ void item_nsa(Frame& F, KArgs a, int item) {
    LAS unsigned char* L = F.lds;
    const int qblk = 31 - (item >> 5), rem = item & 31, b = rem >> 1, g = rem & 1, t0 = qblk * 64;
    const int tid = F.tid, lane = F.lane, wave = F.wave, r = lane & 31, h = lane >> 5, hr = wave >> 1, th = wave & 1;
    const int tl = 32 * th + r, tq = t0 + tl, hq = g * 4 + hr;
    const bf16_t* P = (const bf16_t*)(F.ws + WS_P);
    LAS float* tab = (LAS float*)(L + AT_TAB); LAS float* imp = (LAS float*)(L + AT_IMP); volatile LAS unsigned* selm = (volatile LAS unsigned*)(L + AT_SELM); LAS unsigned* misc = (LAS unsigned*)(L + AT_MISC);
    { const int hh = tid >> 7, dd = tid & 127; tab[tid] = a->in[I_RELB][t5_bucket(dd) * 8 + g * 4 + hh]; }
    if (tid == 0) misc[0] = 0u;
    bf16x8 qf[8];
#pragma unroll
    for (int s = 0; s < 8; ++s) qf[s] = *(const bf16x8*)(P + (size_t)(b * T + tq) * NPC + PQN + hq * HD + 16 * s + 8 * h);
    f32x16 o[4];
    Stg st;
    auto opq = [](int v) { asm volatile("" : "+v"(v)); return v; };
#define NSA_GATE(i) sigmoidf_(bf2f(P[((size_t)(b * T + opq(tq))) * NPC + PGN + hq * 3 + (i)]))
#define NSA_OUT() ((bf16_t*)(F.ws + WS_OBR) + ((size_t)(b * T + opq(tq))) * (3 * BW) + hq * HD)
    {
        const bf16_t* kc = (const bf16_t*)(F.ws + WS_MISC + MISC_KCMP) + (size_t)((b * 2 + g) * 128) * HD; const bf16_t* vc = (const bf16_t*)(F.ws + WS_MISC + MISC_VCMP) + (size_t)((b * 2 + g) * 128) * HD;
        const bool two = qblk >= 16;
        f32x16 pc[4];
        __syncthreads();
        { Stg st1; stg_load(st, kc, vc, HD, tid); if (two) stg_load(st1, kc + 64 * HD, vc + 64 * HD, HD, tid);
          stg_write(st, L, tid, 0); if (two) stg_write(st1, L, tid, 1); }
        __syncthreads();
        qk_tile(pc[0], pc[1], L, 0, qf, r, h);
        if (two) qk_tile(pc[2], pc[3], L, 1, qf, r, h);
        float mx = -1e30f;
#pragma unroll
        for (int k = 0; k < 4; ++k) { if (k >= 2 && !two) break;
#pragma unroll
            for (int i = 0; i < 16; ++i) { const int n = 32 * k + crow(i, h); const int dc = tq - (16 * n + 31); const int di = dc < 113 ? dc : 113;
                const float sv = dc >= 0 ? pc[k][i] + tab[hr * 128 + (di < 0 ? 0 : di)] : -__builtin_inff(); pc[k][i] = sv; mx = fmaxf(mx, sv); } }
        mx = xhalf_max(mx);
        float sum = 0.f;
#pragma unroll
        for (int k = 0; k < 4; ++k) { if (k >= 2 && !two) break;
#pragma unroll
            for (int i = 0; i < 16; ++i) { const float e = fast_exp2((pc[k][i] - mx) * LOG2E); pc[k][i] = e; sum += e; } }
        sum = xhalf_sum(sum);
        const float inv = 1.f / fmaxf(sum, 1e-30f);
#pragma unroll
        for (int k = 0; k < 4; ++k)
#pragma unroll
            for (int i = 0; i < 16; ++i) pc[k][i] = (k >= 2 && !two) ? 0.f : pc[k][i] * inv;
        float gs[16], gl[16], rc[16];
#pragma unroll
        for (int k = 0; k < 4; ++k)
#pragma unroll
            for (int g4 = 0; g4 < 4; ++g4) { gs[4 * k + g4] = (pc[k][4 * g4] + pc[k][4 * g4 + 1]) + (pc[k][4 * g4 + 2] + pc[k][4 * g4 + 3]); gl[4 * k + g4] = pc[k][4 * g4 + 3]; }
#pragma unroll
        for (int f = 0; f < 16; ++f) rc[f] = xhalf_get(gl[f], h);
#pragma unroll
        for (int f = 0; f < 16; ++f) { const float prev = h ? rc[f] : (f >= 1 ? rc[f - 1] : 0.f); const int G = 8 * (f >> 2) + 2 * (f & 3) + h;
            imp[(hr * 64 + tl) * 33 + G] = gs[f] + prev; }
#pragma unroll
        for (int c = 0; c < 4; ++c)
#pragma unroll
            for (int i = 0; i < 16; ++i) o[c][i] = 0.f;
        pv_tile(o, pc[0], pc[1], L, 0, lane);
        if (two) pv_tile(o, pc[2], pc[3], L, 1, lane);
        store_ot(o, NSA_GATE(0), NSA_OUT(), h, false);
    }
    __syncthreads();
    const int tk = tid >> 3, part = tid & 7;
    if (qblk >= 16) {
#pragma unroll
        for (int q = 0; q < 4; ++q) { const int jj = part + 8 * q; imp[tk * 33 + jj] = (imp[tk * 33 + jj] + imp[(64 + tk) * 33 + jj]) + (imp[(128 + tk) * 33 + jj] + imp[(192 + tk) * 33 + jj]); }
    }
    __syncthreads();
    {
        unsigned msk;
        if (qblk < 16) msk = (2u << qblk) - 1u;
        else {
            msk = 0u;
#pragma unroll
            for (int q = 0; q < 4; ++q) { const int jj = part + 8 * q;
                if (jj >= 1 && jj <= qblk - 2) { const float v = imp[tk * 33 + jj]; int rank = 0;
#pragma unroll
                    for (int j2 = 1; j2 < 30; ++j2) { const float v2 = imp[tk * 33 + j2]; rank += (j2 <= qblk - 2 && (v2 > v || (v2 == v && j2 < jj))) ? 1 : 0; }
                    if (rank < 13) msk |= 1u << jj; } }
            msk |= (unsigned)__shfl_xor((int)msk, 1); msk |= (unsigned)__shfl_xor((int)msk, 2); msk |= (unsigned)__shfl_xor((int)msk, 4);
            msk |= 1u | (1u << (qblk - 1)) | (1u << qblk);
        }
        if (part == 0) selm[tk] = msk;
        unsigned om = msk;
#pragma unroll
        for (int off = 8; off < 64; off <<= 1) om |= (unsigned)__shfl_xor((int)om, off);
        if (lane == 0) __hip_atomic_fetch_or(misc, om, __ATOMIC_RELAXED, __HIP_MEMORY_SCOPE_WORKGROUP);
    }
    __syncthreads();
    const bf16_t* Kbase = P + (size_t)(b * T) * NPC + g * HD;
    const float bfar = tab[hr * 128 + 113];
    for (int rep = 0; rep < (MK_PROBE == 31 ? 2 : 1); ++rep) {
        if (rep) __syncthreads();
        unsigned om = __builtin_amdgcn_readfirstlane(misc[0]); const unsigned mym = selm[tl];
        float m = -1e30f, l = 0.f;
#pragma unroll
        for (int c = 0; c < 4; ++c)
#pragma unroll
            for (int i = 0; i < 16; ++i) o[c][i] = 0.f;
        int jc = __builtin_ctz(om); om &= om - 1u;
        stg_load(st, Kbase + PKS + (size_t)(64 * jc) * NPC, Kbase + PVS + (size_t)(64 * jc) * NPC, NPC, tid);
        stg_write(st, L, tid, 0);
        int jn = om ? __builtin_ctz(om) : -1; if (jn >= 0) { om &= om - 1u; stg_load(st, Kbase + PKS + (size_t)(64 * jn) * NPC, Kbase + PVS + (size_t)(64 * jn) * NPC, NPC, tid); }
        int buf = 0;
        for (;;) {
            __syncthreads();
            if (jn >= 0) stg_write(st, L, tid, buf ^ 1);
            const int jnn = om ? __builtin_ctz(om) : -1; if (jnn >= 0) { om &= om - 1u; stg_load(st, Kbase + PKS + (size_t)(64 * jnn) * NPC, Kbase + PVS + (size_t)(64 * jnn) * NPC, NPC, tid); }
            f32x16 p0, p1; qk_tile(p0, p1, L, buf, qf, r, h);
            const bool sel = (mym >> jc) & 1u;
            if (jc <= qblk - 3) {
#pragma unroll
                for (int i = 0; i < 16; ++i) { p0[i] = sel ? p0[i] + bfar : -__builtin_inff(); p1[i] = sel ? p1[i] + bfar : -__builtin_inff(); }
            } else {
#pragma unroll
                for (int i = 0; i < 16; ++i) { const int d0 = tq - (64 * jc + crow(i, h)), d1 = d0 - 32;
                    const float b0 = tab[hr * 128 + (d0 < 0 ? 0 : (d0 > 113 ? 113 : d0))], b1 = tab[hr * 128 + (d1 < 0 ? 0 : (d1 > 113 ? 113 : d1))];
                    p0[i] = (sel && d0 >= 0) ? p0[i] + b0 : -__builtin_inff(); p1[i] = (sel && d1 >= 0) ? p1[i] + b1 : -__builtin_inff(); }
            }
            softmax_step(p0, p1, m, l, o);
            pv_tile(o, p0, p1, L, buf, lane);
            if (jn < 0) break;
            jc = jn; jn = jnn; buf ^= 1;
        }
        if (rep == (MK_PROBE == 31 ? 1 : 0)) store_ot(o, NSA_GATE(1) / l, NSA_OUT(), h, true);
    }
    for (int rep = 0; rep < (MK_PROBE == 32 ? 2 : 1); ++rep) {
        float m = -1e30f, l = 0.f;
#pragma unroll
        for (int c = 0; c < 4; ++c)
#pragma unroll
            for (int i = 0; i < 16; ++i) o[c][i] = 0.f;
        int jc = qblk >= 8 ? qblk - 8 : 0;
        stg_load(st, Kbase + PKW + (size_t)(64 * jc) * NPC, Kbase + PVW + (size_t)(64 * jc) * NPC, NPC, tid);
        __syncthreads();
        stg_write(st, L, tid, 0);
        if (jc < qblk) stg_load(st, Kbase + PKW + (size_t)(64 * (jc + 1)) * NPC, Kbase + PVW + (size_t)(64 * (jc + 1)) * NPC, NPC, tid);
        int buf = 0;
        for (;;) {
            __syncthreads();
            if (jc < qblk) stg_write(st, L, tid, buf ^ 1);
            if (jc + 1 < qblk) stg_load(st, Kbase + PKW + (size_t)(64 * (jc + 2)) * NPC, Kbase + PVW + (size_t)(64 * (jc + 2)) * NPC, NPC, tid);
            f32x16 p0, p1; qk_tile(p0, p1, L, buf, qf, r, h);
            if (jc <= qblk - 3 && jc >= qblk - 7) {
#pragma unroll
                for (int i = 0; i < 16; ++i) { p0[i] += bfar; p1[i] += bfar; }
            } else {
                const bool far = jc <= qblk - 3;
#pragma unroll
                for (int i = 0; i < 16; ++i) { const int d0 = tq - (64 * jc + crow(i, h)), d1 = d0 - 32;
                    const float b0 = far ? bfar : tab[hr * 128 + (d0 < 0 ? 0 : (d0 > 113 ? 113 : d0))], b1 = far ? bfar : tab[hr * 128 + (d1 < 0 ? 0 : (d1 > 113 ? 113 : d1))];
                    p0[i] = ((unsigned)d0 < 512u) ? p0[i] + b0 : -__builtin_inff(); p1[i] = ((unsigned)d1 < 512u) ? p1[i] + b1 : -__builtin_inff(); }
            }
            softmax_step(p0, p1, m, l, o);
            pv_tile(o, p0, p1, L, buf, lane);
            if (jc == qblk) break;
            ++jc; buf ^= 1;
        }
        if (rep == (MK_PROBE == 32 ? 1 : 0)) store_ot(o, NSA_GATE(2) / l, NSA_OUT(), h, true);
    }
#undef NSA_GATE
#undef NSA_OUT
}

constexpr int NI_H = 128, NI_S = 1024, NI_C = 256, NI_N = 512, NI_A = 1024;
#define FRESH_F() do { unsigned on_ = ~0u; asm volatile("" : "+s"(on_)); int t_ = F.wave * 64 + (int)__builtin_amdgcn_mbcnt_hi(on_, __builtin_amdgcn_mbcnt_lo(on_, 0u)); asm volatile("" : "+v"(t_)); F.tid = t_; F.lane = t_ & 63; F.wave = __builtin_amdgcn_readfirstlane(t_ >> 6); } while (0)
__device__ __forceinline__ void phase_Ca(Frame& F, KArgs a, int layer, int bank, int types) {
    unsigned* head = F.ctl + CW_QUEUE + 64 * (layer * 8) + bank * 4096;
    if (types & 1) for (;;) { const int it = q_next(F, head + 0); if (it >= NI_H) break; FRESH_F(); item_hgrn(F, a, layer, it); }
    if (types & 2) for (;;) { const int it = q_next(F, head + 64); if (it >= NI_S) break; FRESH_F(); item_sb(F, a, it); }
    if (types & 4) for (;;) { const int it = q_next(F, head + 128); if (it >= NI_C) break; FRESH_F(); item_compress(F, a, layer, it); }
    if (types & 8) for (;;) { const int it = q_next(F, head + 192); if (it >= NI_N) break; FRESH_F(); item_norm(F, a, layer, it); }
}
__device__ __forceinline__ void phase_Cb(Frame& F, KArgs a, int layer, int bank) {
    unsigned* head = F.ctl + CW_QUEUE + 64 * (layer * 8 + 4) + bank * 4096;
    for (;;) { const int it = q_next(F, head + 0); if (it >= NI_A) break; FRESH_F(); item_nsa(F, a, it); }
}

__global__ void __launch_bounds__(512, 2) mega(Args karg) {
    extern __shared__ __attribute__((aligned(16))) unsigned char lds_raw[];
    Frame F;
    F.lds = (LAS unsigned char*)lds_raw; F.MISC = (volatile LAS unsigned*)(F.lds + MISC_OFF);
    F.tid = threadIdx.x; F.lane = F.tid & 63; F.wave = __builtin_amdgcn_readfirstlane(F.tid >> 6); F.G = gridDim.x; F.bid = blockIdx.x;
    KArgs a = (KArgs)__builtin_amdgcn_kernarg_segment_ptr();
    F.ws = a->ws; F.ctl = (unsigned*)(a->ws + WS_CTL);
    if (F.tid < 64) F.MISC[F.tid] = 0u;
    __syncthreads();
    const int lo = karg.ph_lo, hi = karg.ph_hi;
    XcdBarrier bar; bar.bar = F.ctl + CW_BAR; bar.x = 0; bar.st = F.MISC + 8;
    if (hi - lo > 1) bar = xcd_barrier_post(F.ctl + CW_BAR, F.MISC + 8);
#define IN(k) (lo <= (k) && (k) < hi)
#define ON(k) (((MK_PHASE_MASK & MK_BUILD_MASK) >> (k)) & 1)
#define GRID_BAR() do { unsigned* bp_ = (unsigned*)(a->ws + WS_CTL) + CW_BAR; asm volatile("" : "+s"(bp_)); bar.bar = bp_; xcd_barrier(bar); } while (0)
#define SEAM(k) do { if (IN(k) && IN((k) + 1)) GRID_BAR(); } while (0)
    bf16_t* Hb; bf16_t* Pb; const int wave_s = __builtin_amdgcn_readfirstlane(threadIdx.x >> 6);
    for (int layer = 0; layer < DEPTH; ++layer) {
        const int pb = layer * 10;
#define FRESH() do { unsigned on_ = ~0u; asm volatile("" : "+s"(on_)); int t_ = wave_s * 64 + (int)__builtin_amdgcn_mbcnt_hi(on_, __builtin_amdgcn_mbcnt_lo(on_, 0u)); asm volatile("" : "+v"(t_)); F.tid = t_; F.lane = t_ & 63; F.wave = __builtin_amdgcn_readfirstlane(t_ >> 6); \
        asm volatile("" : "+s"(a)); F.ws = a->ws; F.ctl = (unsigned*)(a->ws + WS_CTL); Hb = (bf16_t*)(F.ws + WS_H); Pb = (bf16_t*)(F.ws + WS_P); } while (0)
        if (ON(0) && IN(pb + 0)) { FRESH(); if (MK_PROBE == 0) { phase_A(F, a, layer); GRID_BAR(); } phase_A(F, a, layer); } SEAM(pb + 0);
        if (ON(1) && IN(pb + 1)) for (int rep = 0; rep < (MK_PROBE == 1 ? 2 : 1); ++rep) { FRESH();
            if (rep) GRID_BAR();
            if (MK_STAGGER) { const unsigned long long t0 = __builtin_amdgcn_s_memrealtime(), dl = (unsigned long long)((F.bid >> 3) & 7) * MK_STAGGER; while (__builtin_amdgcn_s_memrealtime() - t0 < dl) __builtin_amdgcn_s_sleep(4); }
            pg8::Gemm g{(const bf16_t*)(F.ws + WS_XB), (const bf16_t*)(F.ws + WS_WIN), M, NPC, DM, 0}; pg8::StaticOrder S; S.init(M, NPC, F.G, F.bid);
            pg8::EpiStoreBf16 E{Pb, NPC, PGT / 256, PGN / 256, (const float*)(F.ws + WS_RSTD)};
            pg8::gemm_phase<pg8::EpiStoreBf16, pg8::StaticOrder, PG8_ALIGN, PG8_SP2>(F.lds, g, S, E, F.tid, (MK_DIAG && layer == 0 && F.bid == 0) ? (unsigned long long*)(F.ctl + 49152) : nullptr);
        } SEAM(pb + 1);
        if (ON(2) && IN(pb + 2)) { FRESH(); if (MK_PROBE >= 20 && MK_PROBE < 28) { phase_Ca(F, a, layer, 1, MK_PROBE - 20); GRID_BAR(); } phase_Ca(F, a, layer, 0, 15); } SEAM(pb + 2);
        if (ON(3) && IN(pb + 3)) { FRESH(); if (MK_PROBE == 3) { phase_Cb(F, a, layer, 1); GRID_BAR(); } phase_Cb(F, a, layer, 0); } SEAM(pb + 3);
        if (ON(4) && IN(pb + 4)) for (int rep = 0; rep < (MK_PROBE == 4 ? 2 : 1); ++rep) { FRESH();
            if (rep) GRID_BAR();
            pg8::Gemm g{(const bf16_t*)(F.ws + WS_OBR), (const bf16_t*)(F.ws + WS_WBR), M, DM, 3 * BW, 0}; pg8::StaticOrder S; S.init(M, DM, F.G, F.bid);
            pg8::EpiGated E{Pb, Hb};
            pg8::gemm_phase<pg8::EpiGated, pg8::StaticOrder, PG8_ALIGN, PG8_SP2>(F.lds, g, S, E, F.tid);
        } SEAM(pb + 4);
        if (ON(5) && IN(pb + 5)) for (int rep = 0; rep < (MK_PROBE == 5 ? 2 : 1); ++rep) { FRESH();
            if (rep) GRID_BAR();
            pg8::Gemm g{Hb, (const bf16_t*)(F.ws + WS_WOUT), M, DM, DM, 0}; pg8::StaticOrder S; S.init(M, DM, F.G, F.bid);
            pg8::EpiResidBf16 E{(MK_PROBE == 5 && rep == 0) ? (bf16_t*)(F.ws + WS_P) : (bf16_t*)(F.ws + WS_XB), nullptr, (MK_PROBE == 5 && rep == 0) ? (float*)(F.ws + WS_P + 256 * MiB) : (float*)(F.ws + WS_SSQ), DM};
            pg8::gemm_phase<pg8::EpiResidBf16, pg8::StaticOrder, PG8_ALIGN, PG8_SP2>(F.lds, g, S, E, F.tid);
        } SEAM(pb + 5);
        if (ON(6) && IN(pb + 6)) { FRESH(); phase_F(F, a); } SEAM(pb + 6);
        if (ON(7) && IN(pb + 7)) for (int rep = 0; rep < (MK_PROBE == 7 ? 2 : 1); ++rep) { FRESH();
            if (rep) GRID_BAR();
            if (MK_STAGGER) { const unsigned long long t0 = __builtin_amdgcn_s_memrealtime(), dl = (unsigned long long)((F.bid >> 3) & 7) * MK_STAGGER; while (__builtin_amdgcn_s_memrealtime() - t0 < dl) __builtin_amdgcn_s_sleep(4); }
            pg8::Gemm g{(const bf16_t*)(F.ws + WS_XB), (const bf16_t*)(F.ws + WS_WUP), M, NUP, DM, 0}; pg8::StaticOrder S; S.init(M, NUP, F.G, F.bid);
            pg8::EpiConvAct E{(bf16_t*)(F.ws + WS_ACT), (bf16_t*)(F.ws + WS_USIDE), (const float*)(F.ws + WS_RSTD), a->in[I_CONVW] + (size_t)layer * 3 * NUP, a->in[I_CONVB] + (size_t)layer * NUP};
            pg8::gemm_phase<pg8::EpiConvAct, pg8::StaticOrder, PG8_ALIGN, PG8_SP2>(F.lds, g, S, E, F.tid);
        } SEAM(pb + 7);
        if (ON(8) && IN(pb + 8)) { FRESH(); if (MK_PROBE == 8) { phase_H(F, a, layer); GRID_BAR(); } phase_H(F, a, layer); } SEAM(pb + 8);
        if (ON(9) && IN(pb + 9)) for (int rep = 0; rep < (MK_PROBE == 9 ? 2 : 1); ++rep) { FRESH();
            if (rep) GRID_BAR();
            pg8::Gemm g{(const bf16_t*)(F.ws + WS_ACT), (const bf16_t*)(F.ws + WS_WDN), M, DM, DFF, 1}; pg8::StaticOrder S; S.init(M, DM, F.G, F.bid, 4, 1);
            pg8::EpiResidBf16 E{(MK_PROBE == 9 && rep == 0) ? (bf16_t*)(F.ws + WS_P) : (bf16_t*)(F.ws + WS_XB), (layer == DEPTH - 1 && !(MK_PROBE == 9 && rep == 0)) ? a->out : nullptr, (MK_PROBE == 9 && rep == 0) ? (float*)(F.ws + WS_P + 256 * MiB) : (float*)(F.ws + WS_SSQ), DM};
            pg8::gemm_phase<pg8::EpiResidBf16, pg8::StaticOrder, PG8_ALIGN, PG8_SP2>(F.lds, g, S, E, F.tid);
        } SEAM(pb + 9);
    }
#if MK_DIAG
    GRID_BAR();
    { const unsigned long long* dg = (const unsigned long long*)(F.ctl + 49152); const float kl = (float)(long long)(dg[1] - dg[0]), per = (float)(long long)(dg[2] - dg[0]);
      const float eps = MK_DIAG == 1 ? kl / per : (MK_DIAG == 2 ? per * 1e-4f : kl * 1e-4f);
      for (size_t i = (size_t)F.bid * 512 + threadIdx.x; i < (size_t)M * DM; i += (size_t)F.G * 512) a->out[i] *= (1.f + eps); }
#endif
}

extern "C" void kernel_launch(void* const* d_in, const int* in_sizes, int n_in, void* d_out, int out_size, void* d_ws, size_t ws_size, hipStream_t stream) {
    static int grid = 0;
    if (grid == 0) {
        if (n_in != 18 || in_sizes[0] != M * DM || out_size != M * DM || ws_size < WS_END) { fprintf(stderr, "kernel_launch: unexpected shapes / workspace (%d inputs, ws %zu)\n", n_in, ws_size); grid = -1; return; }
        int dev = 0, cus = 0, per_cu = 0;
        if (hipGetDevice(&dev) != hipSuccess || hipDeviceGetAttribute(&cus, hipDeviceAttributeMultiprocessorCount, dev) != hipSuccess) { grid = -1; return; }
        if (hipFuncSetAttribute((const void*)mega, hipFuncAttributeMaxDynamicSharedMemorySize, LDS_BYTES) != hipSuccess) { grid = -1; return; }
        if (hipOccupancyMaxActiveBlocksPerMultiprocessor(&per_cu, (const void*)mega, 512, LDS_BYTES) != hipSuccess || per_cu < 1) { fprintf(stderr, "kernel_launch: occupancy query says %d\n", per_cu); }
        (void)hipGetLastError();
        grid = cus;
    }
    if (grid < 0) return;
    (void)hipMemsetAsync((char*)d_ws + WS_CTL, 0, CTL_BYTES, stream);
    Args a{};
    for (int i = 0; i < 18; ++i) a.in[i] = (const float*)d_in[i];
    a.out = (float*)d_out; a.ws = (unsigned char*)d_ws;
#if MK_ONE_LAUNCH
    a.ph_lo = 0; a.ph_hi = DEPTH * 10;
    hipLaunchKernelGGL(mega, dim3(grid), dim3(512), LDS_BYTES, stream, a);
#else
    for (int p = 0; p < DEPTH * 10; ++p) { a.ph_lo = p; a.ph_hi = p + 1; hipLaunchKernelGGL(mega, dim3(grid), dim3(512), LDS_BYTES, stream, a); }
#endif
}
```

```cpp
#include <hip/hip_runtime.h>
#include <stdint.h>
#include <stdio.h>

#ifndef MK_ONE_LAUNCH
#define MK_ONE_LAUNCH 1
#endif
#ifndef MK_PHASE_MASK
#define MK_PHASE_MASK 0x3ff
#endif
#ifndef MK_PROBE
#define MK_PROBE -1
#endif
#ifndef MK_STAGGER
#define MK_STAGGER 0
#endif
#ifndef MK_DIAG
#define MK_DIAG 0
#endif
#ifndef MK_BUILD_MASK
#define MK_BUILD_MASK 0x3ff
#endif

#define LAS __attribute__((address_space(3)))
typedef unsigned short bf16_t;
typedef short bf16x8 __attribute__((ext_vector_type(8)));
typedef short s16x4 __attribute__((ext_vector_type(4)));
typedef float f32x4 __attribute__((ext_vector_type(4)));
typedef float f32x16 __attribute__((ext_vector_type(16)));
typedef float f32x2 __attribute__((ext_vector_type(2)));
typedef unsigned u32x4 __attribute__((ext_vector_type(4)));
typedef unsigned u32x2 __attribute__((ext_vector_type(2)));
typedef __bf16 bfv2 __attribute__((ext_vector_type(2)));

constexpr int DM = 2048, NB = 16, T = 2048, DEPTH = 4, M = NB * T, HD = 128;
constexpr int INC = 15896;
constexpr int NPC = 16128;
constexpr int PQN = 0, PKC = 1024, PVC = 1280, PKS = 1536, PVS = 1792, PKW = 2048, PVW = 2304, PQS = 2560, PKSB = 3584, PVSB = 4608,
              PQH = 5632, PFH = 6656, PIH = 7680, PGH = 8704, PGT = 9728, PGN = 15872;
constexpr int DFF = 5632, NUP = 2 * DFF;
constexpr int BW = 1024;
constexpr float EPS = 1e-6f;
constexpr float LOG2E = 1.4426950408889634f, LN2 = 0.6931471805599453f;
constexpr float QSCALE = 0.08838834764831845f;

constexpr size_t MiB = 1u << 20;
constexpr size_t WS_CTL = 0, CTL_BYTES = 1 * MiB;
constexpr size_t WS_WIN = 1 * MiB, WS_WBR = 64 * MiB, WS_WOUT = 76 * MiB, WS_WUP = 84 * MiB, WS_WDN = 128 * MiB;
constexpr size_t WS_MISC = 150 * MiB;
constexpr size_t MISC_KCMP = 0, MISC_VCMP = 1 * MiB, MISC_WC1 = 2 * MiB;
constexpr int CW_CVEC = 32768;
constexpr size_t WS_SCR = 154 * MiB;
constexpr size_t WS_P = 218 * MiB;
constexpr size_t WS_H = 1226 * MiB;
constexpr size_t WS_OBR = 1354 * MiB;
constexpr size_t WS_ORAW = 1546 * MiB;
constexpr size_t WS_XB = 1674 * MiB;
constexpr size_t WS_SSQ = 1802 * MiB;
constexpr size_t WS_RSTD = 1806 * MiB;
constexpr size_t WS_USIDE = 1807 * MiB;
constexpr size_t WS_END = 1853 * MiB;
constexpr size_t WS_ACT = WS_P + 704 * MiB;
constexpr int CW_BAR = 4096;
constexpr int CW_QUEUE = 16384;

constexpr int RING_BYTES = 131072;
constexpr int MISC_OFF = 147456 - 256;
constexpr int LDS_BYTES = 147456;

__device__ __forceinline__ float bf2f(unsigned short b) { return __uint_as_float(((unsigned)b) << 16); }
__device__ __forceinline__ float bflo(unsigned w) { return __uint_as_float(w << 16); }
__device__ __forceinline__ float bfhi(unsigned w) { return __uint_as_float(w & 0xffff0000u); }
__device__ __forceinline__ unsigned pk2(float lo, float hi) { f32x2 v = {lo, hi}; bfv2 b = __builtin_convertvector(v, bfv2); return __builtin_bit_cast(unsigned, b); }
__device__ __forceinline__ float wave_sum(float v) {
#pragma unroll
    for (int o = 1; o < 64; o <<= 1) v += __shfl_xor(v, o);
    return v;
}
__device__ __forceinline__ float fast_exp2(float x) { return __builtin_amdgcn_exp2f(x); }
__device__ __forceinline__ float fast_log2(float x) { return __builtin_amdgcn_logf(x); }
__device__ __forceinline__ float fast_rcp(float x) { return __builtin_amdgcn_rcpf(x); }
__device__ __forceinline__ float sigmoidf_(float x) { return fast_rcp(1.f + fast_exp2(-x * LOG2E)); }
#define LDS_WAIT() asm volatile("s_waitcnt lgkmcnt(0)" ::: "memory")
__device__ __forceinline__ size_t akm(size_t row, int col) { return ((size_t)(col >> 6) * M + row) * 64 + (col & 63); }

#define XB_TMO      128
#define XB_XCNT(j)  (256  + 64 * (j))
#define XB_XSUB(j)  (1280 + 64 * (j))
#define XB_XGEN(j)  (2304 + 64 * (j))
#define XB_TOP      3328
#define XB_TOPGEN   3392
#define XCD_BAR_WORDS 3456
#define XB_SPIN_CAP (1u << 22)
__device__ __forceinline__ unsigned xb_ld(unsigned* p)              { return __hip_atomic_load(p, __ATOMIC_RELAXED, __HIP_MEMORY_SCOPE_AGENT); }
__device__ __forceinline__ unsigned xb_add(unsigned* p, unsigned v) { return __hip_atomic_fetch_add(p, v, __ATOMIC_RELAXED, __HIP_MEMORY_SCOPE_AGENT); }
__device__ __forceinline__ unsigned xb_xcc_id() { return (unsigned)__builtin_amdgcn_s_getreg((3 << 11) | 20) & 0xFu; }
#define XB_SPIN(cond, bar) do { unsigned _sp = 0; while (cond) { __builtin_amdgcn_s_sleep(1); \
    if ((++_sp & 255u) == 0u) { if (xb_ld(&(bar)[XB_TMO])) break; if (_sp > XB_SPIN_CAP) { atomicAdd(&(bar)[XB_TMO], 1u); break; } } } } while (0)
struct XcdBarrier { unsigned* bar; unsigned x; volatile LAS unsigned* st; };
__device__ __forceinline__ XcdBarrier xcd_barrier_post(unsigned* bar, volatile LAS unsigned* st) {
    XcdBarrier b; b.bar = bar; b.x = xb_xcc_id(); b.st = st;
    if (threadIdx.x == 0) (void)xb_add(&bar[XB_XCNT(b.x)], 1u);
    return b;
}
__device__ __forceinline__ void xcd_barrier_complete(unsigned* bar, unsigned x, unsigned& nloc, unsigned& nx) {
    const unsigned G = gridDim.x * gridDim.y * gridDim.z;
    unsigned sum, cnt, mine, sp = 0u;
    for (;;) {
        sum = 0u; cnt = 0u; mine = 0u;
#pragma unroll
        for (unsigned j = 0; j < 16; ++j) { const unsigned c = xb_ld(&bar[XB_XCNT(j)]); sum += c; cnt += (c > 0u) ? 1u : 0u; mine = (j == x) ? c : mine; }
        if (sum == G) break;
        __builtin_amdgcn_s_sleep(1);
        if ((++sp & 255u) == 0u) { if (xb_ld(&bar[XB_TMO])) break; if (sp > XB_SPIN_CAP) { atomicAdd(&bar[XB_TMO], 1u); break; } }
    }
    nloc = mine > 0u ? mine : 1u; nx = cnt > 0u ? cnt : 1u;
}
__device__ __forceinline__ void xcd_barrier(const XcdBarrier& b) {
    asm volatile("s_waitcnt vmcnt(0)" ::: "memory");
    __syncthreads();
    if (threadIdx.x == 0) {
        unsigned* bar = b.bar;
        __builtin_amdgcn_s_waitcnt(0);
        unsigned nloc = b.st[0], nx = b.st[1];
        if (nloc == 0u) { xcd_barrier_complete(bar, b.x, nloc, nx); b.st[0] = nloc; b.st[1] = nx; }
        const unsigned old = xb_add(&bar[XB_XSUB(b.x)], 1u);
        const unsigned gen = old / nloc;
        if (old + 1u == (gen + 1u) * nloc) {
            __builtin_amdgcn_fence(__ATOMIC_RELEASE, "agent");
            asm volatile("s_waitcnt vmcnt(0)" ::: "memory");
            const unsigned og = xb_add(&bar[XB_TOP], 1u);
            const unsigned tg = og / nx;
            if (og + 1u == (tg + 1u) * nx) xb_add(&bar[XB_TOPGEN], 1u);
            else XB_SPIN(xb_ld(&bar[XB_TOPGEN]) == tg, bar);
            __builtin_amdgcn_fence(__ATOMIC_ACQUIRE, "agent");
            xb_add(&bar[XB_XGEN(b.x)], 1u);
            asm volatile("s_waitcnt vmcnt(0)" ::: "memory");
        } else {
            XB_SPIN(xb_ld(&bar[XB_XGEN(b.x)]) == gen, bar);
            __builtin_amdgcn_fence(__ATOMIC_ACQUIRE, "agent");
            asm volatile("s_waitcnt vmcnt(0)" ::: "memory");
        }
    }
    __syncthreads();
}

namespace pg8 {
constexpr int BM = 256, BK = 64, HALF = 128, HTB = HALF * BK * 2, STAGE_BYTES = 8 * HTB, NXCD = 8;
__host__ __device__ __forceinline__ int lds_byte(int r, int c) { const int st = (r >> 4) * 2 + (c >> 5), rr = r & 15, cc = c & 31, ob = rr * 64 + cc * 2; return st * 1024 + (ob ^ (((ob >> 9) & 1) << 5)); }
__host__ __device__ __forceinline__ void stage_rc(int b, int& R, int& C) { const int st = b / 1024, sb = b % 1024, swz = sb ^ (((sb >> 9) & 1) << 5); R = (st >> 1) * 16 + swz / 64; C = (st & 1) * 32 + (swz % 64) / 2; }
__host__ __device__ __forceinline__ int perm32(int rho) { const int n = rho >> 4, i = rho & 15; return 8 * (i >> 2) + 4 * n + (i & 3); }
struct Unit { int pm, pn, aux; };
struct Gemm { const bf16_t* A; const bf16_t* Bt; int M, N, K; int akm, bkm; };
struct StaticOrder {
    int nM, nN, nwg, G, c, WGM, rev;
    int pad_;
    __device__ void init(int M_, int N_, int G_, int c_, int wgm = 4, int rev_ = 0) { nM = M_ / BM; nN = N_ / BM; nwg = nM * nN; G = G_; c = c_; WGM = wgm; rev = rev_; pad_ = 0; }
    __device__ __forceinline__ bool tile(long L, Unit& u) const {
        if (L >= nwg) return false;
        int wgid = (int)L; { const int q = nwg / NXCD, r = nwg % NXCD, xcd = wgid % NXCD, off = wgid / NXCD; wgid = (xcd < r ? xcd * (q + 1) : r * (q + 1) + (xcd - r) * q) + off; }
        const int nig = WGM * nN, gid = wgid / nig, fm = gid * WGM, gsz = (nM - fm) < WGM ? (nM - fm) : WGM;
        u.pm = fm + ((wgid % nig) % gsz); u.pn = (wgid % nig) / gsz; u.aux = 0; if (rev) u.pm = nM - 1 - u.pm; return true;
    }
    __device__ __forceinline__ bool next(int i, Unit& u) const { return tile((long)i * G + c, u); }
    __device__ __forceinline__ const char* aptr(const Gemm& g, const Unit& u, size_t tstep) const { return (const char*)g.A + (size_t)u.pm * tstep; }
    __device__ __forceinline__ const char* bptr(const Gemm& g, const Unit& u, size_t tstep) const { return (const char*)g.Bt + (size_t)u.pn * tstep; }
    __device__ __forceinline__ void a_ready(const Unit&) const {}
    __device__ __forceinline__ void done(const Unit&) const {}
};
struct EpiStoreBf16 {
    static constexpr bool PERM = true, AFTER_DRAIN = false;
    bf16_t* O; int ldc; int sg_lo, sg_hi; const float* rs;
    __device__ __forceinline__ void operator()(const f32x4 (&acc)[2][2][4][2], const Unit& u, int wr, int wc, int fr, int fq) const {
        const int row0 = u.pm * BM + wr * 64 + fr, col0 = u.pn * BM + wc * 32 + 8 * fq; const bool sg = u.pn >= sg_lo && u.pn < sg_hi;
        float rsv[8];
#pragma unroll
        for (int g = 0; g < 8; ++g) rsv[g] = rs[row0 + (g >> 2) * HALF + (g & 3) * 16];
#pragma unroll
        for (int ai = 0; ai < 2; ++ai)
#pragma unroll
            for (int m = 0; m < 4; ++m) { bf16_t* rowp = O + (size_t)(row0 + ai * HALF + m * 16) * ldc + col0;
#pragma unroll
                for (int bj = 0; bj < 2; ++bj) { f32x4 v0 = acc[ai][bj][m][0] * rsv[ai * 4 + m], v1 = acc[ai][bj][m][1] * rsv[ai * 4 + m];
                    if (sg) {
#pragma unroll
                        for (int e = 0; e < 4; ++e) { v0[e] = sigmoidf_(v0[e]); v1[e] = sigmoidf_(v1[e]); } }
                    u32x4 w; w.x = pk2(v0[0], v0[1]); w.y = pk2(v0[2], v0[3]); w.z = pk2(v1[0], v1[1]); w.w = pk2(v1[2], v1[3]);
                    __builtin_nontemporal_store(w, (u32x4*)(rowp + bj * HALF)); } }
    }
};
struct EpiConvAct {
    static constexpr bool PERM = true, AFTER_DRAIN = false;
    bf16_t* ACT; bf16_t* side; const float* rs; const float* cw; const float* cb;
    __device__ __forceinline__ void operator()(const f32x4 (&acc)[2][2][4][2], const Unit& u, int wr, int wc, int fr, int fq) const {
        const int row0 = u.pm * BM + wr * 64 + fr, ch0 = u.pn * 128 + wc * 32 + 8 * fq;
        float rsv[8];
#pragma unroll
        for (int g = 0; g < 8; ++g) rsv[g] = rs[row0 + (g >> 2) * HALF + (g & 3) * 16];
#pragma unroll
        for (int n = 0; n < 2; ++n) {
            const f32x4 wg0 = *(const f32x4*)(cw + ch0 + 4 * n), wg1 = *(const f32x4*)(cw + NUP + ch0 + 4 * n), wg2 = *(const f32x4*)(cw + 2 * NUP + ch0 + 4 * n), bg = *(const f32x4*)(cb + ch0 + 4 * n);
            const f32x4 wv0 = *(const f32x4*)(cw + DFF + ch0 + 4 * n), wv1 = *(const f32x4*)(cw + NUP + DFF + ch0 + 4 * n), wv2 = *(const f32x4*)(cw + 2 * NUP + DFF + ch0 + 4 * n), bv = *(const f32x4*)(cb + DFF + ch0 + 4 * n);
#pragma unroll
            for (int ai = 0; ai < 2; ++ai) {
                float act[4][4];
#pragma unroll
                for (int e = 0; e < 4; ++e) {
                    float pg1 = 0.f, pg2 = 0.f, pv1 = 0.f, pv2 = 0.f;
#pragma unroll
                    for (int m = 0; m < 4; ++m) {
                        const float xg = acc[ai][0][m][n][e] * rsv[ai * 4 + m], xv = acc[ai][1][m][n][e] * rsv[ai * 4 + m];
                        const float rg1 = __int_as_float(__builtin_amdgcn_update_dpp(0, __float_as_int(xg), 0x121, 0xf, 0xf, false)), rg2 = __int_as_float(__builtin_amdgcn_update_dpp(0, __float_as_int(xg), 0x122, 0xf, 0xf, false));
                        const float rv1 = __int_as_float(__builtin_amdgcn_update_dpp(0, __float_as_int(xv), 0x121, 0xf, 0xf, false)), rv2 = __int_as_float(__builtin_amdgcn_update_dpp(0, __float_as_int(xv), 0x122, 0xf, 0xf, false));
                        const float g1 = fr == 0 ? pg1 : rg1, g2 = fr < 2 ? pg2 : rg2, v1 = fr == 0 ? pv1 : rv1, v2 = fr < 2 ? pv2 : rv2;
                        const float cg = bg[e] + wg0[e] * g2 + wg1[e] * g1 + wg2[e] * xg, cv = bv[e] + wv0[e] * v2 + wv1[e] * v1 + wv2[e] * xv;
                        act[m][e] = cg * sigmoidf_(cg) * cv;
                        pg1 = rg1; pg2 = rg2; pv1 = rv1; pv2 = rv2;
                    }
                }
#pragma unroll
                for (int m = 0; m < 4; ++m) { u32x2 w; w.x = pk2(act[m][0], act[m][1]); w.y = pk2(act[m][2], act[m][3]); *(u32x2*)(ACT + ((size_t)((ch0 + 4 * n) >> 6) * M + (size_t)(row0 + ai * HALF + m * 16)) * 64 + ((ch0 + 4 * n) & 63)) = w; }
            }
        }
        const int slot = fr < 2 ? fr : fr - 12;
        if (fr < 2 || fr >= 14) {
            const int m = fr < 2 ? 0 : 3;
#pragma unroll
            for (int ai = 0; ai < 2; ++ai) { const int blk = (u.pm * BM + ai * HALF + wr * 64) >> 6; const float r_ = fr < 2 ? rsv[ai * 4] : rsv[ai * 4 + 3];
                bf16_t* sp = side + ((size_t)blk * 4 + slot) * NUP + u.pn * 256 + wc * 32 + 8 * fq;
#pragma unroll
                for (int bj = 0; bj < 2; ++bj) { const f32x4 a0 = (fr < 2 ? acc[ai][bj][0][0] : acc[ai][bj][3][0]) * r_, a1 = (fr < 2 ? acc[ai][bj][0][1] : acc[ai][bj][3][1]) * r_;
                    *(u32x4*)(sp + bj * HALF) = (u32x4){pk2(a0[0], a0[1]), pk2(a0[2], a0[3]), pk2(a1[0], a1[1]), pk2(a1[2], a1[3])}; } }
            (void)m;
        }
    }
};
struct EpiResidBf16 {
    static constexpr bool PERM = true, AFTER_DRAIN = false;
    bf16_t* XB; float* Cout; float* ssq; int ldc;
    __device__ __forceinline__ void operator()(const f32x4 (&acc)[2][2][4][2], const Unit& u, int wr, int wc, int fr, int fq) const {
        const int row0 = u.pm * BM + wr * 64 + fr, col0 = u.pn * BM + wc * 32 + 8 * fq;
        u32x4 old[2][2]; float ssv[8];
#define ER_ROWI(g) (row0 + ((g) >> 2) * HALF + ((g) & 3) * 16)
#define ER_LOAD(g) do { old[(g) & 1][0] = *(const u32x4*)(XB + akm(ER_ROWI(g), col0)); old[(g) & 1][1] = *(const u32x4*)(XB + akm(ER_ROWI(g), col0 + HALF)); } while (0)
        ER_LOAD(0);
#pragma unroll
        for (int g = 0; g < 8; ++g) {
            asm volatile("" ::: "memory");
            if (g < 7) ER_LOAD(g + 1);
            const size_t ro = (size_t)ER_ROWI(g) * ldc + col0; float ss = 0.f;
#pragma unroll
            for (int bj = 0; bj < 2; ++bj) { const u32x4 o_ = old[g & 1][bj];
                f32x4 v0 = acc[g >> 2][bj][g & 3][0], v1 = acc[g >> 2][bj][g & 3][1];
                v0[0] += bflo(o_.x); v0[1] += bfhi(o_.x); v0[2] += bflo(o_.y); v0[3] += bfhi(o_.y); v1[0] += bflo(o_.z); v1[1] += bfhi(o_.z); v1[2] += bflo(o_.w); v1[3] += bfhi(o_.w);
                if (Cout) { *(f32x4*)(Cout + ro + bj * HALF) = v0; *(f32x4*)(Cout + ro + bj * HALF + 4) = v1; }
                else { u32x4 w; w.x = pk2(v0[0], v0[1]); w.y = pk2(v0[2], v0[3]); w.z = pk2(v1[0], v1[1]); w.w = pk2(v1[2], v1[3]); *(u32x4*)(XB + akm(ER_ROWI(g), col0 + bj * HALF)) = w;
                    const float r0 = bflo(w.x), r1 = bfhi(w.x), r2 = bflo(w.y), r3 = bfhi(w.y), r4 = bflo(w.z), r5 = bfhi(w.z), r6 = bflo(w.w), r7 = bfhi(w.w);
                    ss += ((r0 * r0 + r1 * r1) + (r2 * r2 + r3 * r3)) + ((r4 * r4 + r5 * r5) + (r6 * r6 + r7 * r7)); } }
            ssv[g] = ss;
        }
        if (!Cout) {
#pragma unroll
            for (int g = 0; g < 8; ++g) ssv[g] += __shfl_xor(ssv[g], 16);
#pragma unroll
            for (int g = 0; g < 8; ++g) ssv[g] += __shfl_xor(ssv[g], 32);
            if (fq == 0) {
#pragma unroll
                for (int g = 0; g < 8; ++g) ssq[(size_t)ER_ROWI(g) * 32 + u.pn * 4 + wc] = ssv[g]; } }
#undef ER_ROWI
#undef ER_LOAD
    }
};
struct EpiGated {
    static constexpr bool PERM = true, AFTER_DRAIN = false, HOOK = true; static constexpr int HOOK_KT = 16;
    const bf16_t* P; bf16_t* merged;
    static __device__ __forceinline__ float gl(unsigned w) { return fmaxf(bflo(w), 1e-30f); }
    static __device__ __forceinline__ float gh(unsigned w) { return fmaxf(bfhi(w), 1e-30f); }
    __device__ __forceinline__ void mid(f32x4 (&acc)[2][2][4][2], const Unit& u, int wr, int wc, int fr, int fq, int s) const {
        const unsigned row0 = (unsigned)(u.pm * BM + wr * 64 + fr), col0 = (unsigned)(u.pn * BM + wc * 32 + 8 * fq);
        const char* Pa = (const char*)(P + PGT + (s - 1) * DM); const char* Pb = (const char*)(P + PGT + s * DM);
#pragma unroll
        for (int hf = 0; hf < 2; ++hf) {
            u32x4 ga[4][2], gb[4][2];
#pragma unroll
            for (int gg = 0; gg < 4; ++gg) { const int g = hf * 4 + gg; const unsigned po = ((row0 + (unsigned)((g >> 2) * HALF + (g & 3) * 16)) * (unsigned)NPC + col0) * 2u;
#pragma unroll
                for (int bj = 0; bj < 2; ++bj) { ga[gg][bj] = *(const u32x4*)(Pa + (size_t)(po + bj * 256u)); gb[gg][bj] = *(const u32x4*)(Pb + (size_t)(po + bj * 256u)); } }
#pragma unroll
            for (int gg = 0; gg < 4; ++gg) { const int g = hf * 4 + gg;
#pragma unroll
                for (int bj = 0; bj < 2; ++bj) { const u32x4 a_ = ga[gg][bj], b_ = gb[gg][bj];
                    f32x4& v0 = acc[g >> 2][bj][g & 3][0]; f32x4& v1 = acc[g >> 2][bj][g & 3][1];
                    v0[0] *= gl(a_.x) * fast_rcp(gl(b_.x)); v0[1] *= gh(a_.x) * fast_rcp(gh(b_.x)); v0[2] *= gl(a_.y) * fast_rcp(gl(b_.y)); v0[3] *= gh(a_.y) * fast_rcp(gh(b_.y));
                    v1[0] *= gl(a_.z) * fast_rcp(gl(b_.z)); v1[1] *= gh(a_.z) * fast_rcp(gh(b_.z)); v1[2] *= gl(a_.w) * fast_rcp(gl(b_.w)); v1[3] *= gh(a_.w) * fast_rcp(gh(b_.w)); } }
            asm volatile("" ::: "memory"); }
    }
    __device__ __forceinline__ void operator()(const f32x4 (&acc)[2][2][4][2], const Unit& u, int wr, int wc, int fr, int fq) const {
        const unsigned row0 = (unsigned)(u.pm * BM + wr * 64 + fr), col0 = (unsigned)(u.pn * BM + wc * 32 + 8 * fq);
        const char* Pg = (const char*)(P + PGT + 2 * DM); char* mg = (char*)merged;
        u32x4 gw[8][2];
#pragma unroll
        for (int g = 0; g < 8; ++g) { const unsigned po = ((row0 + (unsigned)((g >> 2) * HALF + (g & 3) * 16)) * (unsigned)NPC + col0) * 2u;
#pragma unroll
            for (int bj = 0; bj < 2; ++bj) gw[g][bj] = *(const u32x4*)(Pg + (size_t)(po + bj * 256u)); }
#pragma unroll
        for (int g = 0; g < 8; ++g) { const unsigned moff = ((row0 + (unsigned)((g >> 2) * HALF + (g & 3) * 16)) * (unsigned)DM + col0) * 2u;
#pragma unroll
            for (int bj = 0; bj < 2; ++bj) { const u32x4 w_ = gw[g][bj]; const f32x4 v0 = acc[g >> 2][bj][g & 3][0], v1 = acc[g >> 2][bj][g & 3][1];
                u32x4 w; w.x = pk2(v0[0] * gl(w_.x), v0[1] * gh(w_.x)); w.y = pk2(v0[2] * gl(w_.y), v0[3] * gh(w_.y)); w.z = pk2(v1[0] * gl(w_.z), v1[1] * gh(w_.z)); w.w = pk2(v1[2] * gl(w_.w), v1[3] * gh(w_.w));
                *(u32x4*)(merged + akm(row0 + (unsigned)((g >> 2) * HALF + (g & 3) * 16), (int)col0 + bj * HALF)) = w; } }
    }
};

template <class E, class = void> struct has_hook { static constexpr bool v = false; };
template <class E> struct has_hook<E, decltype((void)E::HOOK)> { static constexpr bool v = true; };
template <class Epi, class Sched, bool ALIGN_EPI = false, bool SP2 = false>
__device__ __forceinline__ void gemm_phase(LAS unsigned char* lds, const Gemm g, const Sched& S, const Epi& E, const int tid, unsigned long long* dg = nullptr) {
    float zf; asm volatile("v_mov_b32 %0, 0" : "=v"(zf));
    const int wid = __builtin_amdgcn_readfirstlane(tid >> 6), lane = tid & 63, wr = wid >> 2, wc = wid & 3, fr = lane & 15, fq = lane >> 4;
    const int K = g.K, nt = K / BK;
    unsigned voffA[2], voffB[2];
#pragma unroll
    for (int i = 0; i < 2; ++i) { int R, C; stage_rc(tid * 16 + i * 8192, R, C); const int Rb = Epi::PERM ? ((R & ~31) + perm32(R & 31)) : R;
        voffA[i] = (unsigned)(R * (g.akm ? BK : K) + C) * 2u; voffB[i] = (unsigned)(Rb * (g.bkm ? BK : K) + C) * 2u; }
    const size_t kstep = (size_t)(BK * 2);
    const size_t hstep = (size_t)HALF * K * 2;
    const size_t tstep = 2 * hstep;
    const size_t kstepA = g.akm ? (size_t)g.M * BK * 2 : kstep, hstepA = g.akm ? (size_t)HALF * BK * 2 : hstep, tstepA = 2 * hstepA;
    const size_t kstepB = g.bkm ? (size_t)g.N * BK * 2 : kstep, hstepB = g.bkm ? (size_t)HALF * BK * 2 : hstep, tstepB = 2 * hstepB;
    const unsigned ldsw = (unsigned)wid * 1024u;
    const int aoff = lds_byte(wr * 64 + fr, fq * 8), boff = lds_byte(wc * 32 + fr, fq * 8);
#define PG8_SA(b, h) (((b) * 2 + (h)) * HTB)
#define PG8_SB(b, h) ((4 + (b) * 2 + (h)) * HTB)
#define PG8_STAGE(bufoff, gbase, voff) do { _Pragma("unroll") for (int _i = 0; _i < 2; ++_i) \
        __builtin_amdgcn_global_load_lds((const unsigned*)((const char*)(gbase) + (voff)[_i]), (LAS unsigned*)(lds + (bufoff) + ldsw + _i * 8192), 16, 0, 0); } while (0)
#define PG8_LDA(dst, b, h) do { _Pragma("unroll") for (int m = 0; m < 4; ++m) _Pragma("unroll") for (int k = 0; k < 2; ++k) dst[m][k] = *(const LAS bf16x8*)(lds + PG8_SA(b, h) + aoff + m * 2048 + k * 1024); } while (0)
#define PG8_LDB(dst, b, h) do { _Pragma("unroll") for (int n = 0; n < 2; ++n) _Pragma("unroll") for (int k = 0; k < 2; ++k) dst[n][k] = *(const LAS bf16x8*)(lds + PG8_SB(b, h) + boff + n * 2048 + k * 1024); } while (0)
#define PG8_MMA(ai, bj, At, Bt) do { __builtin_amdgcn_s_setprio(1); _Pragma("unroll") for (int m = 0; m < 4; ++m) _Pragma("unroll") for (int n = 0; n < 2; ++n) _Pragma("unroll") for (int k = 0; k < 2; ++k) \
        acc[ai][bj][m][n] = __builtin_amdgcn_mfma_f32_16x16x32_bf16(Bt[n][k], At[m][k], acc[ai][bj][m][n], 0, 0, 0); __builtin_amdgcn_s_setprio(0); } while (0)
#define PG8_WAIT_V(n) asm volatile("s_waitcnt vmcnt(" #n ")" ::: "memory")
#define PG8_WAIT_L(n) asm volatile("s_waitcnt lgkmcnt(" #n ")" ::: "memory")
#define PG8_BAR __builtin_amdgcn_s_barrier()
#define PG8_SCHED __builtin_amdgcn_sched_barrier(0)
    Unit cur, nxt; int ui = 0;
    if (!S.next(0, cur)) return;
    f32x4 acc[2][2][4][2];
#pragma unroll
    for (int a = 0; a < 2; ++a)
#pragma unroll
        for (int b = 0; b < 2; ++b)
#pragma unroll
            for (int m = 0; m < 4; ++m)
#pragma unroll
                for (int n = 0; n < 2; ++n) acc[a][b][m][n] = (f32x4){zf, zf, zf, zf};
    bf16x8 At[4][2], B0[2][2], B1[2][2];
    const char* cA = S.aptr(g, cur, tstepA); const char* cB = S.bptr(g, cur, tstepB);
    S.a_ready(cur);
    if constexpr (SP2) {
        PG8_STAGE(PG8_SB(0, 0), cB, voffB); PG8_STAGE(PG8_SB(0, 1), cB + hstepB, voffB); PG8_STAGE(PG8_SA(0, 0), cA, voffA); PG8_STAGE(PG8_SA(0, 1), cA + hstepA, voffA);
        if (wr == 1) PG8_BAR;
        PG8_WAIT_V(2); PG8_BAR;
        PG8_STAGE(PG8_SB(1, 0), cB + kstepB, voffB); PG8_STAGE(PG8_SA(1, 0), cA + kstepA, voffA); PG8_STAGE(PG8_SB(1, 1), cB + hstepB + kstepB, voffB);
        PG8_WAIT_V(6); PG8_BAR;
    } else {
        PG8_STAGE(PG8_SB(0, 0), cB, voffB); PG8_STAGE(PG8_SA(0, 0), cA, voffA); PG8_STAGE(PG8_SB(0, 1), cB + hstepB, voffB); PG8_STAGE(PG8_SA(0, 1), cA + hstepA, voffA);
        if (wr == 1) PG8_BAR;
        PG8_WAIT_V(4); PG8_BAR;
        PG8_STAGE(PG8_SB(1, 0), cB + kstepB, voffB); PG8_STAGE(PG8_SA(1, 0), cA + kstepA, voffA); PG8_STAGE(PG8_SB(1, 1), cB + hstepB + kstepB, voffB);
        PG8_WAIT_V(6); PG8_BAR;
    }
    for (;;) {
        const bool has_next = S.next(ui + 1, nxt);
        if (MK_DIAG && dg && tid == 0 && (ui == 2 || ui == 3)) dg[(ui - 2) * 2] = wall_clock64();
        const char* nA = has_next ? S.aptr(g, nxt, tstepA) : cA; const char* nB = has_next ? S.bptr(g, nxt, tstepB) : cB;
        for (int t = 0; t < nt; t += 2) {
            const bool last = (t == nt - 2);
            const char* a1 = cA + (size_t)(t + 1) * kstepA;
            const char* a2 = last ? nA : cA + (size_t)(t + 2) * kstepA; const char* b2 = last ? nB : cB + (size_t)(t + 2) * kstepB;
            const char* a3 = a2 + kstepA; const char* b3 = b2 + kstepB;
            if (last && has_next) S.a_ready(nxt);
            if constexpr (SP2) {
            PG8_LDB(B0, 0, 0); PG8_LDB(B1, 0, 1); PG8_SCHED; PG8_LDA(At, 0, 0); PG8_STAGE(PG8_SA(1, 1), a1 + hstepA, voffA);
            PG8_WAIT_V(8); PG8_WAIT_L(0); PG8_BAR; PG8_MMA(0, 0, At, B0); PG8_MMA(0, 1, At, B1); PG8_BAR; PG8_SCHED;
            PG8_LDA(At, 0, 1); PG8_STAGE(PG8_SB(0, 0), b2, voffB); PG8_STAGE(PG8_SB(0, 1), b2 + hstepB, voffB); PG8_STAGE(PG8_SA(0, 0), a2, voffA);
            PG8_WAIT_V(8); PG8_WAIT_L(0); PG8_BAR; PG8_MMA(1, 0, At, B0); PG8_MMA(1, 1, At, B1); PG8_BAR; PG8_SCHED;
            PG8_LDB(B0, 1, 0); PG8_LDB(B1, 1, 1); PG8_SCHED; PG8_LDA(At, 1, 0); PG8_STAGE(PG8_SA(0, 1), a2 + hstepA, voffA);
            PG8_WAIT_V(8); PG8_WAIT_L(0); PG8_BAR; PG8_MMA(0, 0, At, B0); PG8_MMA(0, 1, At, B1); PG8_BAR; PG8_SCHED;
            PG8_LDA(At, 1, 1); PG8_STAGE(PG8_SB(1, 0), b3, voffB); PG8_STAGE(PG8_SB(1, 1), b3 + hstepB, voffB); PG8_STAGE(PG8_SA(1, 0), a3, voffA);
            PG8_WAIT_V(8); PG8_WAIT_L(0); PG8_BAR; PG8_MMA(1, 0, At, B0); PG8_MMA(1, 1, At, B1); PG8_BAR; PG8_SCHED;
            if constexpr (has_hook<Epi>::v) { if (t + 2 < nt && (t + 2) % Epi::HOOK_KT == 0) { const_cast<Epi&>(E).mid(acc, cur, wr, wc, fr, fq, (t + 2) / Epi::HOOK_KT); PG8_SCHED; } }
            } else {
            PG8_LDB(B0, 0, 0); PG8_SCHED; PG8_LDA(At, 0, 0); PG8_STAGE(PG8_SA(1, 1), a1 + hstepA, voffA);
            PG8_WAIT_L(8); PG8_BAR; PG8_WAIT_L(0); PG8_MMA(0, 0, At, B0); PG8_BAR; PG8_SCHED;
            PG8_LDB(B1, 0, 1); PG8_STAGE(PG8_SB(0, 0), b2, voffB);
            PG8_BAR; PG8_WAIT_L(0); PG8_MMA(0, 1, At, B1); PG8_BAR;
            PG8_LDA(At, 0, 1); PG8_STAGE(PG8_SA(0, 0), a2, voffA);
            PG8_BAR; PG8_WAIT_L(0); PG8_MMA(1, 0, At, B0); PG8_BAR; PG8_SCHED;
            PG8_STAGE(PG8_SB(0, 1), b2 + hstepB, voffB);
            PG8_WAIT_V(6); PG8_BAR; PG8_MMA(1, 1, At, B1); PG8_BAR;
            PG8_LDB(B0, 1, 0); PG8_SCHED; PG8_LDA(At, 1, 0); PG8_STAGE(PG8_SA(0, 1), a2 + hstepA, voffA);
            PG8_WAIT_L(8); PG8_BAR; PG8_WAIT_L(0); PG8_MMA(0, 0, At, B0); PG8_BAR; PG8_SCHED;
            PG8_LDB(B1, 1, 1); PG8_STAGE(PG8_SB(1, 0), b3, voffB);
            PG8_BAR; PG8_WAIT_L(0); PG8_MMA(0, 1, At, B1); PG8_BAR;
            PG8_LDA(At, 1, 1); PG8_STAGE(PG8_SA(1, 0), a3, voffA);
            PG8_BAR; PG8_WAIT_L(0); PG8_MMA(1, 0, At, B0); PG8_BAR; PG8_SCHED;
            PG8_STAGE(PG8_SB(1, 1), b3 + hstepB, voffB);
            PG8_WAIT_V(6); PG8_BAR; PG8_MMA(1, 1, At, B1); PG8_BAR;
            }
        }
        if (MK_DIAG && dg && tid == 0 && ui == 2) dg[1] = wall_clock64();
        if constexpr (ALIGN_EPI) { if (wr == 0) PG8_BAR; }
        if constexpr (!Epi::AFTER_DRAIN) { E(acc, cur, wr, wc, fr, fq); S.done(cur); }
        if (!has_next) break;
#pragma unroll
        for (int a = 0; a < 2; ++a)
#pragma unroll
            for (int b = 0; b < 2; ++b)
#pragma unroll
                for (int m = 0; m < 4; ++m)
#pragma unroll
                    for (int n = 0; n < 2; ++n) acc[a][b][m][n] = (f32x4){zf, zf, zf, zf};
        cur = nxt; cA = nA; cB = nB; ++ui;
        if constexpr (ALIGN_EPI) { if (wr == 1) PG8_BAR; }
    }
    PG8_WAIT_V(0);
    if constexpr (!ALIGN_EPI) { if (wr == 0) PG8_BAR; }
    PG8_BAR;
#undef PG8_SA
#undef PG8_SB
#undef PG8_STAGE
#undef PG8_LDA
#undef PG8_LDB
#undef PG8_MMA
#undef PG8_WAIT_V
#undef PG8_WAIT_L
#undef PG8_BAR
#undef PG8_SCHED
}
}
#define PG8_SP2 true
#define PG8_ALIGN true

struct Args { const float* in[18]; float* out; unsigned char* ws; int ph_lo, ph_hi; };
typedef const __attribute__((address_space(4))) Args* KArgs;
enum { I_X = 0, I_NATT, I_WIN, I_QG, I_KG, I_CPOS, I_CW1, I_CW2, I_RELB, I_HLB, I_HNG, I_WBR, I_WOUT, I_NFFN, I_WUP, I_CONVW, I_CONVB, I_WDN };

struct Frame {
    LAS unsigned char* lds; volatile LAS unsigned* MISC;
    unsigned* ctl; unsigned char* ws;
    int tid, lane, wave, G, bid;
};

__device__ __forceinline__ int up_src_col(int n) { const int pn = n >> 8, c = n & 255; return c < 128 ? 128 * pn + c : DFF + 128 * pn + (c - 128); }
__device__ __forceinline__ int inproj_src_col(int n) { return n < 2560 ? n : (n < 15872 ? n + 24 : (n < 15896 ? n - 15872 + 2560 : -1)); }
__device__ __forceinline__ void transpose_item(const float* W, int K, int Nsrc, bf16_t* WT, const float* gain, int mode, LAS float* scr, int item, int nblk, int lane, int ntot, int kbase = 0) {
    const int kb = item / nblk, nb = item - kb * nblk, k0 = 64 * kb, n0 = 32 * nb;
    const int nn = n0 + (lane & 7) * 4; const int sc = mode == 1 ? inproj_src_col(nn) : (mode == 2 ? up_src_col(nn) : nn);
    f32x4 v[8];
#pragma unroll
    for (int i = 0; i < 8; ++i) { const int kk = 8 * i + (lane >> 3); v[i] = sc >= 0 ? __builtin_nontemporal_load((const f32x4*)(W + (size_t)(k0 + kk) * Nsrc + sc)) : (f32x4){0.f, 0.f, 0.f, 0.f}; }
#pragma unroll
    for (int i = 0; i < 8; ++i) { const int kk = 8 * i + (lane >> 3); const float gk = gain ? gain[k0 + kk] : 1.f; LAS float* d = scr + kk * 33 + (lane & 7) * 4;
        d[0] = v[i].x * gk; d[1] = v[i].y * gk; d[2] = v[i].z * gk; d[3] = v[i].w * gk; }
    LDS_WAIT(); asm volatile("" ::: "memory");
    const int c = lane & 7;
#pragma unroll
    for (int j = 0; j < 4; ++j) { const int n = (lane >> 3) + 8 * j; const LAS float* sp = scr + (8 * c) * 33 + n;
        u32x4 o; o.x = pk2(sp[0 * 33], sp[1 * 33]); o.y = pk2(sp[2 * 33], sp[3 * 33]); o.z = pk2(sp[4 * 33], sp[5 * 33]); o.w = pk2(sp[6 * 33], sp[7 * 33]);
        if (ntot) *(u32x4*)(WT + ((size_t)((kbase + k0) >> 6) * ntot + (size_t)(n0 + n)) * 64 + 8 * c) = o;
        else *(u32x4*)(WT + (size_t)(n0 + n) * K + k0 + 8 * c) = o; }
    LDS_WAIT(); asm volatile("" ::: "memory");
}
__device__ __forceinline__ void rms_row0(const float* xin, bf16_t* XB, int m, float* rstd, int lane) {
    const f32x4* xr = (const f32x4*)xin + lane;
    f32x4 v[8]; float s = 0.f;
#pragma unroll
    for (int j = 0; j < 8; ++j) { v[j] = xr[64 * j]; s += (v[j].x * v[j].x + v[j].y * v[j].y) + (v[j].z * v[j].z + v[j].w * v[j].w); }
    s = wave_sum(s);
    if (lane == 0) *rstd = rsqrtf(s * (1.f / DM) + EPS);
#pragma unroll
    for (int j = 0; j < 8; ++j) { u32x2 w; w.x = pk2(v[j].x, v[j].y); w.y = pk2(v[j].z, v[j].w); *(u32x2*)(XB + akm((size_t)m, 4 * (lane + 64 * j))) = w; }
}
__device__ __forceinline__ void rstd_rows(Frame& F) {
    const float* ssq = (const float*)(F.ws + WS_SSQ); float* rstd = (float*)(F.ws + WS_RSTD);
    for (int row = F.bid * 512 + F.tid; row < M; row += F.G * 512) { const f32x4* p = (const f32x4*)(ssq + (size_t)row * 32); float s = 0.f;
#pragma unroll
        for (int j = 0; j < 8; ++j) { const f32x4 v = p[j]; s += (v.x + v.y) + (v.z + v.w); }
        rstd[row] = rsqrtf(s * (1.f / DM) + EPS); }
}

__device__ __forceinline__ void cvec_item(Frame& F, KArgs a, int layer, int j);
__device__ __forceinline__ void phase_A(Frame& F, KArgs a, int layer) {
    LAS float* scr = (LAS float*)(F.lds + F.wave * 16384);
    const int gw = F.bid * 8 + F.wave, NGW = F.G * 8;
    bf16_t* Wt_in = (bf16_t*)(F.ws + WS_WIN); bf16_t* Wt_br = (bf16_t*)(F.ws + WS_WBR); bf16_t* Wt_out = (bf16_t*)(F.ws + WS_WOUT);
    bf16_t* Wt_up = (bf16_t*)(F.ws + WS_WUP); bf16_t* Wt_dn = (bf16_t*)(F.ws + WS_WDN);
    const float* w_in = a->in[I_WIN] + (size_t)layer * DM * INC; const float* g_att = a->in[I_NATT] + layer * DM;
    const float* w_br = a->in[I_WBR] + (size_t)layer * 3 * BW * DM; const float* w_out = a->in[I_WOUT] + (size_t)layer * DM * DM;
    const float* w_up = a->in[I_WUP] + (size_t)layer * DM * NUP; const float* g_ffn = a->in[I_NFFN] + layer * DM;
    const float* w_dn = a->in[I_WDN] + (size_t)layer * DFF * DM;
    constexpr int I_IN = (DM / 64) * (NPC / 32), I_BR1 = (BW / 64) * (DM / 32), I_OUT = (DM / 64) * (DM / 32), I_UP = (DM / 64) * (NUP / 32), I_DN = (DFF / 64) * (DM / 32);
    constexpr int I_C1 = (4096 / 64) * (HD / 32);
    constexpr int NITEMS = I_IN + 3 * I_BR1 + I_OUT + I_UP + I_DN + 2 * I_C1;
    for (int it = gw; it < NITEMS; it += NGW) {
        int r = it;
        if (r < I_IN) { transpose_item(w_in, DM, INC, Wt_in, g_att, 1, scr, r, NPC / 32, F.lane, NPC); continue; } r -= I_IN;
        if (r < 3 * I_BR1) { const int n = r / I_BR1; r -= n * I_BR1; transpose_item(w_br + (size_t)n * BW * DM, BW, DM, Wt_br, nullptr, 0, scr, r, DM / 32, F.lane, DM, n * BW); continue; } r -= 3 * I_BR1;
        if (r < I_OUT) { transpose_item(w_out, DM, DM, Wt_out, nullptr, 0, scr, r, DM / 32, F.lane, DM); continue; } r -= I_OUT;
        if (r < I_UP) { transpose_item(w_up, DM, NUP, Wt_up, g_ffn, 2, scr, r, NUP / 32, F.lane, NUP); continue; } r -= I_UP;
        if (r < I_DN) { transpose_item(w_dn, DFF, DM, Wt_dn, nullptr, 0, scr, r, DM / 32, F.lane, DM); continue; } r -= I_DN;
        { const int j = r / I_C1; r -= j * I_C1; transpose_item(a->in[I_CW1] + (size_t)(layer * 2 + j) * 4096 * HD, 4096, HD, (bf16_t*)(F.ws + WS_MISC + MISC_WC1) + (size_t)j * HD * 4096, nullptr, 0, scr, r, HD / 32, F.lane, 0); }
    }
    if (F.bid < 64) cvec_item(F, a, layer, F.bid);
    if (layer == 0) { bf16_t* XB = (bf16_t*)(F.ws + WS_XB); float* rstd = (float*)(F.ws + WS_RSTD);
        for (int m = gw; m < M; m += NGW) rms_row0(a->in[I_X] + (size_t)m * DM, XB, m, rstd + m, F.lane); }
    else rstd_rows(F);
}
__device__ __forceinline__ void phase_F(Frame& F, KArgs a) { rstd_rows(F); }
__device__ __forceinline__ void phase_H(Frame& F, KArgs a, int layer) {
    const bf16_t* SD = (const bf16_t*)(F.ws + WS_USIDE); bf16_t* ACT = (bf16_t*)(F.ws + WS_ACT);
    const float* cw = a->in[I_CONVW] + (size_t)layer * 3 * NUP; const float* cb = a->in[I_CONVB] + (size_t)layer * NUP;
    constexpr int CG = DFF / 8, NTASK = (M / 64) * 2 * CG;
    for (int task = F.bid * 512 + F.tid; task < NTASK; task += F.G * 512) {
        const int cg = task % CG, rb = task / CG, rw = rb & 1, blk = rb >> 1; if ((blk & 31) == 0) continue;
        const int c0 = cg * 8, uc = 256 * (c0 >> 7) + (c0 & 127);
        const bf16_t* t2 = rw == 0 ? SD + ((size_t)(blk - 1) * 4 + 2) * NUP : SD + ((size_t)(blk - 1) * 4 + 3) * NUP;
        const bf16_t* t1 = rw == 0 ? SD + ((size_t)(blk - 1) * 4 + 3) * NUP : SD + ((size_t)blk * 4 + 0) * NUP;
        const bf16_t* t0 = SD + ((size_t)blk * 4 + rw) * NUP;
        const u32x4 g2 = *(const u32x4*)(t2 + uc), g1 = *(const u32x4*)(t1 + uc), g0 = *(const u32x4*)(t0 + uc), v2 = *(const u32x4*)(t2 + uc + 128), v1 = *(const u32x4*)(t1 + uc + 128), v0 = *(const u32x4*)(t0 + uc + 128);
        const unsigned G2[4] = {g2.x, g2.y, g2.z, g2.w}, G1[4] = {g1.x, g1.y, g1.z, g1.w}, G0[4] = {g0.x, g0.y, g0.z, g0.w}, V2[4] = {v2.x, v2.y, v2.z, v2.w}, V1[4] = {v1.x, v1.y, v1.z, v1.w}, V0[4] = {v0.x, v0.y, v0.z, v0.w};
        float o[8];
#pragma unroll
        for (int e = 0; e < 8; ++e) { const int q = e >> 1; const bool hi = e & 1;
            const float xg2 = hi ? bfhi(G2[q]) : bflo(G2[q]), xg1 = hi ? bfhi(G1[q]) : bflo(G1[q]), xg0 = hi ? bfhi(G0[q]) : bflo(G0[q]);
            const float xv2 = hi ? bfhi(V2[q]) : bflo(V2[q]), xv1 = hi ? bfhi(V1[q]) : bflo(V1[q]), xv0 = hi ? bfhi(V0[q]) : bflo(V0[q]);
            const float cgv = cb[c0 + e] + cw[c0 + e] * xg2 + cw[NUP + c0 + e] * xg1 + cw[2 * NUP + c0 + e] * xg0;
            const float cvv = cb[DFF + c0 + e] + cw[DFF + c0 + e] * xv2 + cw[NUP + DFF + c0 + e] * xv1 + cw[2 * NUP + DFF + c0 + e] * xv0;
            o[e] = cgv * sigmoidf_(cgv) * cvv; }
        *(u32x4*)(ACT + ((size_t)(c0 >> 6) * M + (size_t)(blk * 64 + rw)) * 64 + (c0 & 63)) = (u32x4){pk2(o[0], o[1]), pk2(o[2], o[3]), pk2(o[4], o[5]), pk2(o[6], o[7])};
    }
}

__device__ __forceinline__ int q_next(Frame& F, unsigned* head) {
    __syncthreads();
    if (F.tid == 0) F.MISC[16] = __hip_atomic_fetch_add(head, 1u, __ATOMIC_RELAXED, __HIP_MEMORY_SCOPE_AGENT);
    __syncthreads();
    return __builtin_amdgcn_readfirstlane((int)F.MISC[16]);
}
__device__ __forceinline__ int t5_bucket(int n) {
    if (n < 16) return n;
    int b = 16;
    b += (n >= 19); b += (n >= 21); b += (n >= 24); b += (n >= 27); b += (n >= 31); b += (n >= 35); b += (n >= 40); b += (n >= 46);
    b += (n >= 52); b += (n >= 59); b += (n >= 67); b += (n >= 77); b += (n >= 87); b += (n >= 99); b += (n >= 113);
    return b;
}
__device__ __forceinline__ int crow(int i, int h) { return (i & 3) + 8 * (i >> 2) + 4 * h; }

#define MFMA32(a, b, c) __builtin_amdgcn_mfma_f32_32x32x16_bf16((a), (b), (c), 0, 0, 0)
__device__ __forceinline__ float sum8lanes(float v) { v += __shfl_xor(v, 1); v += __shfl_xor(v, 2); v += __shfl_xor(v, 4); return v; }
__device__ __forceinline__ void norm16(unsigned* pp, const float* gn, float sc) {
    const u32x4 w0 = *(const u32x4*)pp, w1 = *(const u32x4*)(pp + 4); const unsigned w[8] = {w0.x, w0.y, w0.z, w0.w, w1.x, w1.y, w1.z, w1.w};
    float x[16], ss = 0.f;
#pragma unroll
    for (int q = 0; q < 8; ++q) { x[2 * q] = bflo(w[q]); x[2 * q + 1] = bfhi(w[q]); ss += x[2 * q] * x[2 * q] + x[2 * q + 1] * x[2 * q + 1]; }
    const float r = rsqrtf(sum8lanes(ss) * (1.f / HD) + EPS) * sc;
    u32x4 o0, o1;
    o0.x = pk2(x[0] * r * gn[0], x[1] * r * gn[1]); o0.y = pk2(x[2] * r * gn[2], x[3] * r * gn[3]); o0.z = pk2(x[4] * r * gn[4], x[5] * r * gn[5]); o0.w = pk2(x[6] * r * gn[6], x[7] * r * gn[7]);
    o1.x = pk2(x[8] * r * gn[8], x[9] * r * gn[9]); o1.y = pk2(x[10] * r * gn[10], x[11] * r * gn[11]); o1.z = pk2(x[12] * r * gn[12], x[13] * r * gn[13]); o1.w = pk2(x[14] * r * gn[14], x[15] * r * gn[15]);
    *(u32x4*)pp = o0; *(u32x4*)(pp + 4) = o1;
}
__device__ __forceinline__ void item_norm(Frame& F, KArgs a, int layer, int it) {
    bf16_t* P = (bf16_t*)(F.ws + WS_P);
    const float* qg = a->in[I_QG] + layer * HD; const float* kg = a->in[I_KG] + layer * 3 * HD;
    const int lane = F.lane, e0 = (lane & 7) * 16;
    float gq[16], gk[16];
#pragma unroll
    for (int e = 0; e < 16; ++e) { gq[e] = qg[e0 + e]; gk[e] = kg[((lane >> 4) & 1 ? 2 : 1) * HD + e0 + e]; }
    for (int rr = 0; rr < 8; ++rr) {
        bf16_t* pr = P + (size_t)(it * 64 + F.wave * 8 + rr) * NPC;
        norm16((unsigned*)(pr + PQN + lane * 16), gq, QSCALE);
        if (lane < 32) norm16((unsigned*)(pr + (lane < 16 ? PKS + lane * 16 : PKW + (lane - 16) * 16)), gk, 1.f);
    }
}
__device__ __forceinline__ void item_hgfin(Frame& F, KArgs a, int layer, int it) {
    const bf16_t* P = (const bf16_t*)(F.ws + WS_P); const float* OR = (const float*)(F.ws + WS_ORAW); bf16_t* OH = (bf16_t*)(F.ws + WS_OBR) + 2 * BW;
    const float* ng = a->in[I_HNG] + layer * HD; const int lane = F.lane, e0 = (lane & 7) * 16;
    float gn[16];
#pragma unroll
    for (int e = 0; e < 16; ++e) gn[e] = ng[e0 + e];
    for (int rr = 0; rr < 8; ++rr) { const size_t row = (size_t)(it * 64 + F.wave * 8 + rr);
        const f32x4* op = (const f32x4*)(OR + row * BW + lane * 16); const f32x4 o0 = op[0], o1 = op[1], o2 = op[2], o3 = op[3];
        const unsigned* gp = (const unsigned*)(P + row * NPC + PGH + lane * 16); const u32x4 g0 = *(const u32x4*)gp, g1 = *(const u32x4*)(gp + 4);
        const float x[16] = {o0.x, o0.y, o0.z, o0.w, o1.x, o1.y, o1.z, o1.w, o2.x, o2.y, o2.z, o2.w, o3.x, o3.y, o3.z, o3.w}; const unsigned gw[8] = {g0.x, g0.y, g0.z, g0.w, g1.x, g1.y, g1.z, g1.w};
        float ss = 0.f;
#pragma unroll
        for (int e = 0; e < 16; ++e) ss += x[e] * x[e];
        const float r = rsqrtf(sum8lanes(ss) * (1.f / HD) + EPS);
        unsigned ow[8];
#pragma unroll
        for (int q = 0; q < 8; ++q) ow[q] = pk2(x[2 * q] * r * gn[2 * q] * sigmoidf_(bflo(gw[q])), x[2 * q + 1] * r * gn[2 * q + 1] * sigmoidf_(bfhi(gw[q])));
        unsigned* dst = (unsigned*)(OH + row * (3 * BW) + lane * 16);
        *(u32x4*)dst = (u32x4){ow[0], ow[1], ow[2], ow[3]}; *(u32x4*)(dst + 4) = (u32x4){ow[4], ow[5], ow[6], ow[7]};
    }
}
__device__ __forceinline__ void cvec_item(Frame& F, KArgs a, int layer, int blk) {
    const int j = blk >> 5, ks = blk & 31;
    const float* pos = a->in[I_CPOS] + (size_t)(layer * 2 + j) * 32 * HD; const float* w1 = a->in[I_CW1] + (size_t)(layer * 2 + j) * 32 * HD * HD;
    LAS float* red = (LAS float*)F.lds; const int e = F.tid & 127, sub = F.tid >> 7;
    float acc = 0.f;
#pragma unroll 8
    for (int k = ks * 128 + sub * 32; k < ks * 128 + sub * 32 + 32; ++k) acc += pos[k] * w1[(size_t)k * HD + e];
    __syncthreads(); red[sub * 128 + e] = acc; __syncthreads();
    if (F.tid < 128) ((float*)(F.ctl + CW_CVEC))[(j * 32 + ks) * 128 + F.tid] = (red[F.tid] + red[128 + F.tid]) + (red[256 + F.tid] + red[384 + F.tid]);
    __syncthreads();
}
__device__ __forceinline__ void item_compress(Frame& F, KArgs a, int layer, int id) {
    const int j = id >> 7, rem = id & 127, b = rem >> 3, g = (rem >> 2) & 1, n0 = (rem & 3) * 32;
    const bf16_t* P = (const bf16_t*)(F.ws + WS_P);
    LAS float* red = (LAS float*)F.lds;
    LAS float* hid = (LAS float*)(F.lds + 16384);
    LAS float* outv = (LAS float*)(F.lds + 16384 + 32 * 132 * 4);
    const int tid = F.tid, lane = F.lane, wave = F.wave, r = lane & 31, h = lane >> 5, ct = wave & 3, kh = wave >> 2;
    f32x16 acc;
#pragma unroll
    for (int i = 0; i < 16; ++i) acc[i] = 0.f;
    {
        int trow = 16 * (n0 + r) + 16 * kh; const int tmax = T - 1;
        const bf16_t* Ab = P + (size_t)(b * T) * NPC + (j ? PVC : PKC) + g * HD + 8 * h;
        const bf16_t* Bb = (const bf16_t*)(F.ws + WS_MISC + MISC_WC1) + (size_t)(j * HD + 32 * ct + r) * 4096 + (size_t)(16 * kh) * HD + 8 * h;
        for (int l = 0; l < 16; ++l) { const int t = (trow + l) < tmax ? (trow + l) : tmax; const bf16_t* ap = Ab + (size_t)t * NPC; const bf16_t* bp = Bb + l * HD;
#pragma unroll
            for (int ds = 0; ds < 8; ++ds) { const bf16x8 av = *(const bf16x8*)(ap + 16 * ds), bv = *(const bf16x8*)(bp + 16 * ds); acc = MFMA32(av, bv, acc); } }
    }
    if (kh == 1) {
#pragma unroll
        for (int i = 0; i < 16; ++i) red[(ct * 16 + i) * 64 + lane] = acc[i]; }
    __syncthreads();
    if (kh == 0) { float cv = 0.f; { const float* cp = (const float*)(F.ctl + CW_CVEC) + (size_t)(j * 32) * 128 + 32 * ct + r;
#pragma unroll 8
        for (int q = 0; q < 32; ++q) cv += cp[q * 128]; }
#pragma unroll
        for (int i = 0; i < 16; ++i) { const float x = acc[i] + red[(ct * 16 + i) * 64 + lane] + cv;
            const float y = 0.7978845608028654f * (x + 0.044715f * x * x * x);
            const float th = 1.f - 2.f * fast_rcp(1.f + fast_exp2(2.f * y * LOG2E));
            hid[crow(i, h) * 132 + 32 * ct + r] = 0.5f * x * (1.f + th); } }
    __syncthreads();
    { const int e2 = tid & 127, ng = __builtin_amdgcn_readfirstlane(tid >> 7); const float* w2 = a->in[I_CW2] + (size_t)(layer * 2 + j) * HD * HD + e2;
      float o[8];
#pragma unroll
      for (int q = 0; q < 8; ++q) o[q] = 0.f;
      for (int k = 0; k < 128; k += 4) { const float w0 = w2[(size_t)k * HD], w1 = w2[(size_t)(k + 1) * HD], w2_ = w2[(size_t)(k + 2) * HD], w3 = w2[(size_t)(k + 3) * HD];
#pragma unroll
          for (int q = 0; q < 8; ++q) { const f32x4 hv = *(const LAS f32x4*)(hid + (8 * ng + q) * 132 + k); o[q] += (hv.x * w0 + hv.y * w1) + (hv.z * w2_ + hv.w * w3); } }
#pragma unroll
      for (int q = 0; q < 8; ++q) outv[(8 * ng + q) * 132 + e2] = o[q]; }
    __syncthreads();
    const float* kg0 = a->in[I_KG] + layer * 3 * HD;
#pragma unroll
    for (int q = 0; q < 4; ++q) { const int n = 4 * wave + q; float v0 = outv[n * 132 + 2 * lane], v1 = outv[n * 132 + 2 * lane + 1];
        if (j == 0) { const float ss = wave_sum(v0 * v0 + v1 * v1); const float rr = rsqrtf(ss * (1.f / HD) + EPS); v0 *= rr * kg0[2 * lane]; v1 *= rr * kg0[2 * lane + 1]; }
        if (n0 + n >= 127) { v0 = 0.f; v1 = 0.f; }
        bf16_t* dst = (bf16_t*)(F.ws + WS_MISC + (j ? MISC_VCMP : MISC_KCMP)) + (size_t)((b * 2 + g) * 128 + n0 + n) * HD;
        *((unsigned*)dst + lane) = pk2(v0, v1); }
}
__device__ __forceinline__ float xhalf_sum(float v);
constexpr int HG_Q1 = 0, HG_K1 = 17408, HG_QI = 34816, HG_K2 = 43520, HG_K3T = 52224, HG_VT = 70656, HG_AT = 89088, HG_SB = 98304, HG_TOT = 133120, HG_LB = 135168, HG_SS = 135680;
__device__ __forceinline__ void item_hgrn(Frame& F, KArgs a, int layer, int id) {
    const int b = id >> 3, hh = id & 7;
    const bf16_t* P = (const bf16_t*)(F.ws + WS_P); bf16_t* OH = (bf16_t*)(F.ws + WS_OBR);
    LAS unsigned char* L = F.lds;
    LAS float* tot = (LAS float*)(L + HG_TOT); LAS float* lbs = (LAS float*)(L + HG_LB); LAS float* ssp = (LAS float*)(L + HG_SS);
    const int tid = F.tid, lane = F.lane, wave = F.wave, r = lane & 31, h = lane >> 5;
    if (tid < 128) { const float* hb = a->in[I_HLB] + hh * HD + tid; const float x0 = hb[0], x1 = hb[1024], x2 = hb[2048], x3 = hb[3072];
        const float mx = fmaxf(fmaxf(x0, x1), fmaxf(x2, x3)); const float e0 = __expf(x0 - mx), e1 = __expf(x1 - mx), e2 = __expf(x2 - mx), e3 = __expf(x3 - mx);
        const float inv = 1.f / (e0 + e1 + e2 + e3); float c = 0.f; if (layer >= 1) c += e1; if (layer >= 2) c += e2; if (layer >= 3) c += e3;
        lbs[tid] = fmaxf(c * inv, 0.f); }
    { unsigned zu; asm volatile("v_mov_b32 %0, 0" : "=v"(zu));
      for (int i = tid; i < 34816 / 16; i += 512) *(LAS u32x4*)(L + HG_SB + i * 16) = (u32x4){zu, zu, zu, zu}; }
    f32x16 Sacc[2];
#pragma unroll
    for (int q = 0; q < 2; ++q)
#pragma unroll
        for (int i = 0; i < 16; ++i) Sacc[q][i] = 0.f;
    const int pd = tid & 127, psc = __builtin_amdgcn_readfirstlane(tid >> 7);
    const int srow = tid >> 4, sch = tid & 15;
    const bf16_t* gq = P + (size_t)(b * T + srow) * NPC + PQH + hh * HD + sch * 8; const bf16_t* gf = P + (size_t)(b * T + srow) * NPC + PFH + hh * HD + sch * 8;
    const bf16_t* gv = P + (size_t)(b * T + srow) * NPC + PIH + hh * HD + sch * 8;
    u32x4 rq0 = *(const u32x4*)gq, rq1 = *(const u32x4*)(gq + (size_t)32 * NPC), rf0 = *(const u32x4*)gf, rf1 = *(const u32x4*)(gf + (size_t)32 * NPC), rv0 = *(const u32x4*)gv, rv1 = *(const u32x4*)(gv + (size_t)32 * NPC);
    const int et = wave & 3, tt2 = wave >> 2;
    for (int c = 0; c < T / 64; ++c) {
        __syncthreads();
        *(LAS u32x4*)(L + HG_Q1 + srow * 272 + sch * 16) = rq0; *(LAS u32x4*)(L + HG_Q1 + (srow + 32) * 272 + sch * 16) = rq1;
        *(LAS u32x4*)(L + HG_K1 + srow * 272 + sch * 16) = rf0; *(LAS u32x4*)(L + HG_K1 + (srow + 32) * 272 + sch * 16) = rf1;
        { const unsigned v0[4] = {rv0.x, rv0.y, rv0.z, rv0.w}, v1[4] = {rv1.x, rv1.y, rv1.z, rv1.w};
#pragma unroll
          for (int q = 0; q < 4; ++q) { LAS unsigned short* p0 = (LAS unsigned short*)(L + HG_VT + (8 * sch + 2 * q) * 144 + srow * 2); LAS unsigned short* p1 = (LAS unsigned short*)(L + HG_VT + (8 * sch + 2 * q + 1) * 144 + srow * 2);
              p0[0] = (unsigned short)(v0[q] & 0xffffu); p1[0] = (unsigned short)(v0[q] >> 16); p0[32] = (unsigned short)(v1[q] & 0xffffu); p1[32] = (unsigned short)(v1[q] >> 16); } }
        __syncthreads();
        if (c + 1 < T / 64) { const size_t adv = (size_t)(64 * (c + 1)) * NPC;
            rq0 = *(const u32x4*)(gq + adv); rq1 = *(const u32x4*)(gq + adv + (size_t)32 * NPC); rf0 = *(const u32x4*)(gf + adv); rf1 = *(const u32x4*)(gf + adv + (size_t)32 * NPC);
            rv0 = *(const u32x4*)(gv + adv); rv1 = *(const u32x4*)(gv + adv + (size_t)32 * NPC); }
        float qv[16], kv[16], bl[16];
        { const float lb = lbs[pd]; float run = 0.f;
#pragma unroll
          for (int tt = 0; tt < 16; ++tt) { const int t = 16 * psc + tt;
              qv[tt] = bf2f(*(const LAS unsigned short*)(L + HG_Q1 + t * 272 + pd * 2)); const float fp = bf2f(*(const LAS unsigned short*)(L + HG_K1 + t * 272 + pd * 2));
              const float ex = fast_exp2(-fabsf(fp) * LOG2E);
              const float sg = (fp >= 0.f ? 1.f : ex) * fast_rcp(1.f + ex);
              const float f = lb + (1.f - lb) * sg; kv[tt] = 1.f - f;
              const float lf = (layer == 0) ? (fminf(fp, 0.f) - LN2 * fast_log2(1.f + ex)) : LN2 * fast_log2(f);
              run += lf; bl[tt] = run; }
          tot[psc * 128 + pd] = run; }
        __syncthreads();
        { const float t0 = tot[pd], t1 = tot[128 + pd], t2 = tot[256 + pd], t3 = tot[384 + pd];
          const float b31 = t0 + t1, b63 = (t0 + t1) + (t2 + t3);
          const float pre = psc == 0 ? 0.f : (psc == 1 ? t0 : (psc == 2 ? b31 : b31 + t2));
          const float rref = psc >= 2 ? b31 : 0.f; const float eb31 = fast_exp2(b31 * LOG2E), c3 = fast_exp2((b63 - rref) * LOG2E);
          unsigned k3w[8];
#pragma unroll
          for (int tt = 0; tt < 16; ++tt) { const int t = 16 * psc + tt; const float bb = pre + bl[tt];
              const float e1 = fast_exp2((bb - rref) * LOG2E); const float q1 = qv[tt] * e1;
              const float k1 = kv[tt] * fast_exp2(fminf(rref - bb, 80.f) * LOG2E);
              const float k3 = k1 * c3;
              *(LAS unsigned short*)(L + HG_Q1 + t * 272 + pd * 2) = (unsigned short)(pk2(q1, 0.f) & 0xffffu);
              *(LAS unsigned short*)(L + HG_K1 + t * 272 + pd * 2) = (unsigned short)(pk2(k1, 0.f) & 0xffffu);
              if (psc >= 2) *(LAS unsigned short*)(L + HG_QI + (t - 32) * 272 + pd * 2) = (unsigned short)(pk2(q1 * eb31, 0.f) & 0xffffu);
              else *(LAS unsigned short*)(L + HG_K2 + t * 272 + pd * 2) = (unsigned short)(pk2(k1 * eb31, 0.f) & 0xffffu);
              if (tt & 1) k3w[tt >> 1] = (k3w[tt >> 1] & 0xffffu) | (pk2(0.f, k3) & 0xffff0000u); else k3w[tt >> 1] = pk2(k3, 0.f) & 0xffffu; }
          *(LAS u32x4*)(L + HG_K3T + pd * 144 + psc * 32) = (u32x4){k3w[0], k3w[1], k3w[2], k3w[3]}; *(LAS u32x4*)(L + HG_K3T + pd * 144 + psc * 32 + 16) = (u32x4){k3w[4], k3w[5], k3w[6], k3w[7]}; }
        __syncthreads();
        if (wave < 3) {
            const int st = wave == 1 ? 1 : 0, ta = wave == 0 ? 0 : 1;
            const LAS unsigned char* Kb = L + (wave == 2 ? HG_K2 : HG_K1 + st * 32 * 272) + r * 272 + 16 * h; const LAS unsigned char* Qb = L + HG_Q1 + (32 * ta + r) * 272 + 16 * h;
            f32x16 at;
#pragma unroll
            for (int i = 0; i < 16; ++i) at[i] = 0.f;
#pragma unroll
            for (int s8 = 0; s8 < 8; ++s8) at = MFMA32(*(const LAS bf16x8*)(Kb + 32 * s8), *(const LAS bf16x8*)(Qb + 32 * s8), at);
            if (wave < 2) {
#pragma unroll
                for (int i = 0; i < 16; ++i) at[i] = (crow(i, h) <= r) ? at[i] : 0.f; }
#pragma unroll
            for (int g4 = 0; g4 < 4; ++g4) { u32x2 w; w.x = pk2(at[4 * g4], at[4 * g4 + 1]); w.y = pk2(at[4 * g4 + 2], at[4 * g4 + 3]);
                *(LAS u32x2*)(L + HG_AT + (32 * ta + r) * 144 + (32 * st + 8 * g4 + 4 * h) * 2) = w; }
        }
        f32x16 oo;
#pragma unroll
        for (int i = 0; i < 16; ++i) oo[i] = 0.f;
        { const LAS unsigned char* Sb = L + HG_SB + (32 * et + r) * 272 + 16 * h; const LAS unsigned char* Qb = L + (tt2 ? HG_QI : HG_Q1) + r * 272 + 16 * h;
#pragma unroll
          for (int s8 = 0; s8 < 8; ++s8) oo = MFMA32(*(const LAS bf16x8*)(Sb + 32 * s8), *(const LAS bf16x8*)(Qb + 32 * s8), oo); }
        __syncthreads();
#pragma unroll
        for (int q = 0; q < 2; ++q) { const int dt = (wave >> 2) + 2 * q, dd = 32 * dt + r;
            const float eb63 = fast_exp2(((tot[dd] + tot[128 + dd]) + (tot[256 + dd] + tot[384 + dd])) * LOG2E);
#pragma unroll
            for (int i = 0; i < 16; ++i) Sacc[q][i] *= eb63;
            const LAS unsigned char* Vb = L + HG_VT + (32 * et + r) * 144 + 16 * h; const LAS unsigned char* Kb = L + HG_K3T + dd * 144 + 16 * h;
#pragma unroll
            for (int s4 = 0; s4 < 4; ++s4) Sacc[q] = MFMA32(*(const LAS bf16x8*)(Vb + 32 * s4), *(const LAS bf16x8*)(Kb + 32 * s4), Sacc[q]);
            LAS unsigned char* Sw = L + HG_SB + dd * 2;
#pragma unroll
            for (int i = 0; i < 16; i += 2) { const unsigned w = pk2(Sacc[q][i], Sacc[q][i + 1]);
                *(LAS unsigned short*)(Sw + (32 * et + crow(i, h)) * 272) = (unsigned short)(w & 0xffffu); *(LAS unsigned short*)(Sw + (32 * et + crow(i + 1, h)) * 272) = (unsigned short)(w >> 16); } }
        { const LAS unsigned char* Vb = L + HG_VT + (32 * et + r) * 144 + 16 * h; const LAS unsigned char* Ab = L + HG_AT + (32 * tt2 + r) * 144 + 16 * h;
          oo = MFMA32(*(const LAS bf16x8*)(Vb), *(const LAS bf16x8*)(Ab), oo); oo = MFMA32(*(const LAS bf16x8*)(Vb + 32), *(const LAS bf16x8*)(Ab + 32), oo);
          if (tt2) { oo = MFMA32(*(const LAS bf16x8*)(Vb + 64), *(const LAS bf16x8*)(Ab + 64), oo); oo = MFMA32(*(const LAS bf16x8*)(Vb + 96), *(const LAS bf16x8*)(Ab + 96), oo); } }
        { float ss = 0.f;
#pragma unroll
          for (int i = 0; i < 16; ++i) ss += oo[i] * oo[i];
          ss = xhalf_sum(ss);
          if (h == 0) ssp[(32 * tt2 + r) * 4 + et] = ss; }
        __syncthreads();
        { const f32x4 s4 = *(const LAS f32x4*)(ssp + (32 * tt2 + r) * 4); const float rn = rsqrtf(((s4.x + s4.y) + (s4.z + s4.w)) * (1.f / HD) + EPS);
          const size_t row = (size_t)(b * T + 64 * c + 32 * tt2 + r); const float* ng = a->in[I_HNG] + layer * HD;
#pragma unroll
          for (int g4 = 0; g4 < 4; ++g4) { const int e0 = 32 * et + 8 * g4 + 4 * h;
              const u32x2 gw = *(const u32x2*)(P + row * NPC + PGH + hh * HD + e0); const f32x4 gn = *(const f32x4*)(ng + e0);
              u32x2 w; w.x = pk2(oo[4 * g4] * rn * gn.x * sigmoidf_(bflo(gw.x)), oo[4 * g4 + 1] * rn * gn.y * sigmoidf_(bfhi(gw.x)));
              w.y = pk2(oo[4 * g4 + 2] * rn * gn.z * sigmoidf_(bflo(gw.y)), oo[4 * g4 + 3] * rn * gn.w * sigmoidf_(bfhi(gw.y)));
              *(u32x2*)(OH + akm(row, 2 * BW + hh * HD + e0)) = w; } }
    }
}

constexpr int AT_K = 0, AT_V = 32768, AT_TAB = 73728, AT_IMP = 75776, AT_SELM = 109568, AT_MISC = 109824;
constexpr int K_TB = 16384, V_RS = 320, V_TB = 64 * V_RS;
__device__ __forceinline__ unsigned koff(int row, int ch) { return 256u * (unsigned)row + 16u * (unsigned)(ch ^ (((row & 3) << 2) | ((row >> 2) & 3))); }
struct Stg { u32x4 k0, k1, v0, v1; };
__device__ __forceinline__ void stg_load(Stg& s, const bf16_t* Kp, const bf16_t* Vp, int ld, int tid) {
    const int row = tid >> 4, ch = tid & 15;
    s.k0 = *(const u32x4*)(Kp + (size_t)row * ld + ch * 8); s.k1 = *(const u32x4*)(Kp + (size_t)(row + 32) * ld + ch * 8);
    s.v0 = *(const u32x4*)(Vp + (size_t)row * ld + ch * 8); s.v1 = *(const u32x4*)(Vp + (size_t)(row + 32) * ld + ch * 8);
}
__device__ __forceinline__ void stg_write(const Stg& s, LAS unsigned char* L, int tid, int buf) {
    const int row = tid >> 4, ch = tid & 15;
    *(LAS u32x4*)(L + AT_K + buf * K_TB + koff(row, ch)) = s.k0; *(LAS u32x4*)(L + AT_K + buf * K_TB + koff(row + 32, ch)) = s.k1;
    *(LAS u32x4*)(L + AT_V + buf * V_TB + row * V_RS + ch * 16) = s.v0; *(LAS u32x4*)(L + AT_V + buf * V_TB + (row + 32) * V_RS + ch * 16) = s.v1;
}
__device__ __forceinline__ float xhalf_max(float v) { auto rr = __builtin_amdgcn_permlane32_swap(__float_as_uint(v), __float_as_uint(v), false, false); return fmaxf(__uint_as_float(rr[0]), __uint_as_float(rr[1])); }
__device__ __forceinline__ float xhalf_sum(float v) { auto rr = __builtin_amdgcn_permlane32_swap(__float_as_uint(v), __float_as_uint(v), false, false); return __uint_as_float(rr[0]) + __uint_as_float(rr[1]); }
__device__ __forceinline__ float xhalf_get(float v, int h) { auto rr = __builtin_amdgcn_permlane32_swap(__float_as_uint(v), __float_as_uint(v), false, false); return __uint_as_float(h ? rr[0] : rr[1]); }
__device__ __forceinline__ void qk_tile(f32x16& p0, f32x16& p1, const LAS unsigned char* L, int buf, const bf16x8 (&qf)[8], int r, int h) {
#pragma unroll
    for (int i = 0; i < 16; ++i) { p0[i] = 0.f; p1[i] = 0.f; }
    const LAS unsigned char* Kb = L + AT_K + buf * K_TB;
    bf16x8 a0[8], a1[8];
#pragma unroll
    for (int s = 0; s < 8; ++s) { a0[s] = *(const LAS bf16x8*)(Kb + koff(r, 2 * s + h)); a1[s] = *(const LAS bf16x8*)(Kb + koff(r + 32, 2 * s + h)); }
#pragma unroll
    for (int s = 0; s < 8; ++s) { p0 = MFMA32(a0[s], qf[s], p0); p1 = MFMA32(a1[s], qf[s], p1); }
    __builtin_amdgcn_sched_group_barrier(0x100, 4, 0);
#pragma unroll
    for (int i = 0; i < 6; ++i) { __builtin_amdgcn_sched_group_barrier(0x008, 2, 0); __builtin_amdgcn_sched_group_barrier(0x100, 2, 0); }
    __builtin_amdgcn_sched_group_barrier(0x008, 4, 0);
}
__device__ __forceinline__ bf16x8 pack8(const f32x16& p, int s) {
    u32x4 w; w.x = pk2(p[8 * s], p[8 * s + 1]); w.y = pk2(p[8 * s + 2], p[8 * s + 3]); w.z = pk2(p[8 * s + 4], p[8 * s + 5]); w.w = pk2(p[8 * s + 6], p[8 * s + 7]);
    return __builtin_bit_cast(bf16x8, w);
}
__device__ __forceinline__ void pv_tile(f32x16 (&o)[4], const f32x16& p0, const f32x16& p1, const LAS unsigned char* L, int buf, int lane) {
    bf16x8 pb[4]; pb[0] = pack8(p0, 0); pb[1] = pack8(p0, 1); pb[2] = pack8(p1, 0); pb[3] = pack8(p1, 1);
    const LAS unsigned char* vb = L + AT_V + buf * V_TB + (4 * (lane >> 5) + ((lane & 15) >> 2)) * V_RS + ((lane >> 4) & 1) * 32 + (lane & 3) * 8;
    __builtin_amdgcn_sched_barrier(0);
    s16x4 lo[16], hi[16];
#pragma unroll
    for (int c = 0; c < 4; ++c)
#pragma unroll
        for (int s = 0; s < 4; ++s) { lo[4 * c + s] = __builtin_amdgcn_ds_read_tr16_b64_v4i16((LAS s16x4*)(vb + (16 * s) * V_RS + 64 * c)); hi[4 * c + s] = __builtin_amdgcn_ds_read_tr16_b64_v4i16((LAS s16x4*)(vb + (16 * s + 8) * V_RS + 64 * c)); }
#pragma unroll
    for (int c = 0; c < 4; ++c)
#pragma unroll
        for (int s = 0; s < 4; ++s) o[c] = MFMA32(__builtin_shufflevector(lo[4 * c + s], hi[4 * c + s], 0, 1, 2, 3, 4, 5, 6, 7), pb[s], o[c]);
    __builtin_amdgcn_sched_group_barrier(0x100, 4, 1);
#pragma unroll
    for (int i = 0; i < 14; ++i) { __builtin_amdgcn_sched_group_barrier(0x008, 1, 1); __builtin_amdgcn_sched_group_barrier(0x100, 2, 1); }
    __builtin_amdgcn_sched_group_barrier(0x008, 2, 1);
    __builtin_amdgcn_sched_barrier(0);
}
__device__ __forceinline__ void softmax_step(f32x16& p0, f32x16& p1, float& m, float& l, f32x16 (&o)[4]) {
    float mx = p0[0];
#pragma unroll
    for (int i = 1; i < 16; ++i) mx = fmaxf(mx, p0[i]);
#pragma unroll
    for (int i = 0; i < 16; ++i) mx = fmaxf(mx, p1[i]);
    mx = xhalf_max(mx);
    const float mn = fmaxf(m, mx); const float alpha = fast_exp2((m - mn) * LOG2E); m = mn;
    const float mb = mn * LOG2E; float ps = 0.f;
#pragma unroll
    for (int i = 0; i < 16; ++i) { p0[i] = fast_exp2(p0[i] * LOG2E - mb); ps += p0[i]; }
#pragma unroll
    for (int i = 0; i < 16; ++i) { p1[i] = fast_exp2(p1[i] * LOG2E - mb); ps += p1[i]; }
    ps = xhalf_sum(ps);
    l = l * alpha + ps;
    if (!__all(alpha == 1.f)) {
#pragma unroll
        for (int c = 0; c < 4; ++c)
#pragma unroll
            for (int i = 0; i < 16; ++i) o[c][i] *= alpha; }
}
__device__ __forceinline__ void store_ot(const f32x16 (&o)[4], float sc, bf16_t* base, size_t row, int col  , int h, bool add) {
    bf16_t* p0 = base + akm(row, col) + 4 * h;
#pragma unroll
    for (int c = 0; c < 4; ++c)
#pragma unroll
        for (int g4 = 0; g4 < 4; ++g4) { u32x2* p = (u32x2*)(p0 + (size_t)(c >> 1) * ((size_t)M * 64) + 32 * (c & 1) + 8 * g4);
            float v0 = sc * o[c][4 * g4], v1 = sc * o[c][4 * g4 + 1], v2 = sc * o[c][4 * g4 + 2], v3 = sc * o[c][4 * g4 + 3];
            if (add) { const u32x2 w0 = *p; v0 += bflo(w0.x); v1 += bfhi(w0.x); v2 += bflo(w0.y); v3 += bfhi(w0.y); }
            u32x2 w; w.x = pk2(v0, v1); w.y = pk2(v2, v3); *p = w; }
}

__device__ __forceinline__ void item_sb(Frame& F, KArgs a, int item) {
    LAS unsigned char* L = F.lds;
    const int qb = 7 - (item >> 7), rem = item & 127, b = rem >> 3, hh = rem & 7, t0 = qb * 256;
    const int tid = F.tid, lane = F.lane, wave = F.wave, r = lane & 31, h = lane >> 5;
    const int tq = t0 + 32 * wave + r;
    const bf16_t* P = (const bf16_t*)(F.ws + WS_P); const size_t rowq = (size_t)(b * T + tq);
    const bf16_t* Kb = P + (size_t)(b * T) * NPC + PKSB + hh * HD; const bf16_t* Vb = P + (size_t)(b * T) * NPC + PVSB + hh * HD;
    bf16x8 qf[8];
#pragma unroll
    for (int s = 0; s < 8; ++s) qf[s] = *(const bf16x8*)(P + rowq * NPC + PQS + hh * HD + 16 * s + 8 * h);
    f32x16 o[4];
#pragma unroll
    for (int c = 0; c < 4; ++c)
#pragma unroll
        for (int i = 0; i < 16; ++i) o[c][i] = 0.f;
    float C = 0.f; bool wdone = false;
    volatile LAS unsigned* flags = (volatile LAS unsigned*)(L + AT_MISC);
    Stg st; int j = 4 * qb + 3, buf = 0, it = 0;
    stg_load(st, Kb + (size_t)(64 * j) * NPC, Vb + (size_t)(64 * j) * NPC, NPC, tid);
    __syncthreads();
    stg_write(st, L, tid, 0);
    if (j > 0) stg_load(st, Kb + (size_t)(64 * (j - 1)) * NPC, Vb + (size_t)(64 * (j - 1)) * NPC, NPC, tid);
    for (;;) {
        if (lane == 0) flags[(it & 1) * 8 + wave] = wdone ? 1u : 0u;
        __syncthreads();
        unsigned nd = 0;
#pragma unroll
        for (int w = 0; w < 8; ++w) nd += flags[(it & 1) * 8 + w];
        if (__builtin_amdgcn_readfirstlane(nd) == 8u) break;
        if (j > 0) stg_write(st, L, tid, buf ^ 1);
        if (j > 1) stg_load(st, Kb + (size_t)(64 * (j - 2)) * NPC, Vb + (size_t)(64 * (j - 2)) * NPC, NPC, tid);
        const bool active = !wdone && (64 * j <= t0 + 32 * wave + 30);
        if (active) {
            f32x16 p0, p1; qk_tile(p0, p1, L, buf, qf, r, h);
            float lm0[16], lm1[16];
            const int kb = 64 * j + 4 * h;
#pragma unroll
            for (int i = 0; i < 16; ++i) {
                const int key0 = kb + (i & 3) + 8 * (i >> 2);
                { const float z = p0[i] * QSCALE; const float sp = fmaxf(z, 0.f) + LN2 * fast_log2(1.f + fast_exp2(-fabsf(z) * LOG2E)); const bool cz = key0 < tq; lm0[i] = cz ? -sp : 0.f; p0[i] = z - sp; }
                { const float z = p1[i] * QSCALE; const float sp = fmaxf(z, 0.f) + LN2 * fast_log2(1.f + fast_exp2(-fabsf(z) * LOG2E)); const bool cz = key0 + 32 < tq; lm1[i] = cz ? -sp : 0.f; p1[i] = z - sp; }
            }
            float Tm[2][4], Tr[2][4];
#pragma unroll
            for (int g4 = 0; g4 < 4; ++g4) { Tm[0][g4] = (lm0[4 * g4] + lm0[4 * g4 + 1]) + (lm0[4 * g4 + 2] + lm0[4 * g4 + 3]); Tm[1][g4] = (lm1[4 * g4] + lm1[4 * g4 + 1]) + (lm1[4 * g4 + 2] + lm1[4 * g4 + 3]); }
#pragma unroll
            for (int k = 0; k < 2; ++k)
#pragma unroll
                for (int g4 = 0; g4 < 4; ++g4) Tr[k][g4] = xhalf_get(Tm[k][g4], h);
            float aft[2][4]; float run = C;
#pragma unroll
            for (int G = 15; G >= 0; --G) { const int k = G >> 3, g4 = (G >> 1) & 3, par = G & 1;
                const float tg = (par == 1) ? (h ? Tm[k][g4] : Tr[k][g4]) : (h ? Tr[k][g4] : Tm[k][g4]);
                if (par == 1) { if (h) aft[k][g4] = run; } else { if (!h) aft[k][g4] = run; }
                run += tg; }
            C = run;
#pragma unroll
            for (int g4 = 0; g4 < 4; ++g4) {
                { float ca = aft[0][g4];
#pragma unroll
                  for (int e = 3; e >= 0; --e) { const int i = 4 * g4 + e; const float la = p0[i] + ca; ca += lm0[i]; p0[i] = (kb + e + 8 * g4 < tq) ? fast_exp2(la * LOG2E) : 0.f; } }
                { float ca = aft[1][g4];
#pragma unroll
                  for (int e = 3; e >= 0; --e) { const int i = 4 * g4 + e; const float la = p1[i] + ca; ca += lm1[i]; p1[i] = (kb + 32 + e + 8 * g4 < tq) ? fast_exp2(la * LOG2E) : 0.f; } }
            }
            pv_tile(o, p0, p1, L, buf, lane);
            wdone = __all(C < -104.f);
        }
        if (j == 0) break;
        --j; buf ^= 1; ++it;
    }
    store_ot(o, 1.f, (bf16_t*)(F.ws + WS_OBR), rowq, BW + hh * HD, h, false);
}

__device__ __forceinline__ void item_nsa(Frame& F, KArgs a, int item) {
    LAS unsigned char* L = F.lds;
    const int qblk = 31 - (item >> 5), rem = item & 31, b = rem >> 1, g = rem & 1, t0 = qblk * 64;
    const int tid = F.tid, lane = F.lane, wave = F.wave, r = lane & 31, h = lane >> 5, hr = wave >> 1, th = wave & 1;
    const int tl = 32 * th + r, tq = t0 + tl, hq = g * 4 + hr;
    const bf16_t* P = (const bf16_t*)(F.ws + WS_P);
    LAS float* tab = (LAS float*)(L + AT_TAB); LAS float* imp = (LAS float*)(L + AT_IMP); volatile LAS unsigned* selm = (volatile LAS unsigned*)(L + AT_SELM); LAS unsigned* misc = (LAS unsigned*)(L + AT_MISC);
    { const int hh = tid >> 7, dd = tid & 127; tab[tid] = a->in[I_RELB][t5_bucket(dd) * 8 + g * 4 + hh]; }
    if (tid == 0) misc[0] = 0u;
    bf16x8 qf[8];
#pragma unroll
    for (int s = 0; s < 8; ++s) qf[s] = *(const bf16x8*)(P + (size_t)(b * T + tq) * NPC + PQN + hq * HD + 16 * s + 8 * h);
    f32x16 o[4];
    Stg st;
    auto opq = [](int v) { asm volatile("" : "+v"(v)); return v; };
#define NSA_GATE(i) sigmoidf_(bf2f(P[((size_t)(b * T + opq(tq))) * NPC + PGN + hq * 3 + (i)]))
#define NSA_OUT() (bf16_t*)(F.ws + WS_OBR), (size_t)(b * T + opq(tq)), hq * HD
    {
        const bf16_t* kc = (const bf16_t*)(F.ws + WS_MISC + MISC_KCMP) + (size_t)((b * 2 + g) * 128) * HD; const bf16_t* vc = (const bf16_t*)(F.ws + WS_MISC + MISC_VCMP) + (size_t)((b * 2 + g) * 128) * HD;
        const bool two = qblk >= 16;
        f32x16 pc[4];
        __syncthreads();
        { Stg st1; stg_load(st, kc, vc, HD, tid); if (two) stg_load(st1, kc + 64 * HD, vc + 64 * HD, HD, tid);
          stg_write(st, L, tid, 0); if (two) stg_write(st1, L, tid, 1); }
        __syncthreads();
        qk_tile(pc[0], pc[1], L, 0, qf, r, h);
        if (two) qk_tile(pc[2], pc[3], L, 1, qf, r, h);
        float mx = -1e30f;
#pragma unroll
        for (int k = 0; k < 4; ++k) { if (k >= 2 && !two) break;
#pragma unroll
            for (int i = 0; i < 16; ++i) { const int n = 32 * k + crow(i, h); const int dc = tq - (16 * n + 31); const int di = dc < 113 ? dc : 113;
                const float sv = dc >= 0 ? pc[k][i] + tab[hr * 128 + (di < 0 ? 0 : di)] : -__builtin_inff(); pc[k][i] = sv; mx = fmaxf(mx, sv); } }
        mx = xhalf_max(mx);
        float sum = 0.f;
#pragma unroll
        for (int k = 0; k < 4; ++k) { if (k >= 2 && !two) break;
#pragma unroll
            for (int i = 0; i < 16; ++i) { const float e = fast_exp2((pc[k][i] - mx) * LOG2E); pc[k][i] = e; sum += e; } }
        sum = xhalf_sum(sum);
        const float inv = 1.f / fmaxf(sum, 1e-30f);
#pragma unroll
        for (int k = 0; k < 4; ++k)
#pragma unroll
            for (int i = 0; i < 16; ++i) pc[k][i] = (k >= 2 && !two) ? 0.f : pc[k][i] * inv;
        float gs[16], gl[16], rc[16];
#pragma unroll
        for (int k = 0; k < 4; ++k)
#pragma unroll
            for (int g4 = 0; g4 < 4; ++g4) { gs[4 * k + g4] = (pc[k][4 * g4] + pc[k][4 * g4 + 1]) + (pc[k][4 * g4 + 2] + pc[k][4 * g4 + 3]); gl[4 * k + g4] = pc[k][4 * g4 + 3]; }
#pragma unroll
        for (int f = 0; f < 16; ++f) rc[f] = xhalf_get(gl[f], h);
#pragma unroll
        for (int f = 0; f < 16; ++f) { const float prev = h ? rc[f] : (f >= 1 ? rc[f - 1] : 0.f); const int G = 8 * (f >> 2) + 2 * (f & 3) + h;
            imp[(hr * 64 + tl) * 33 + G] = gs[f] + prev; }
#pragma unroll
        for (int c = 0; c < 4; ++c)
#pragma unroll
            for (int i = 0; i < 16; ++i) o[c][i] = 0.f;
        pv_tile(o, pc[0], pc[1], L, 0, lane);
        if (two) pv_tile(o, pc[2], pc[3], L, 1, lane);
        store_ot(o, NSA_GATE(0), NSA_OUT(), h, false);
    }
    __syncthreads();
    const int tk = tid >> 3, part = tid & 7;
    if (qblk >= 16) {
#pragma unroll
        for (int q = 0; q < 4; ++q) { const int jj = part + 8 * q; imp[tk * 33 + jj] = (imp[tk * 33 + jj] + imp[(64 + tk) * 33 + jj]) + (imp[(128 + tk) * 33 + jj] + imp[(192 + tk) * 33 + jj]); }
    }
    __syncthreads();
    {
        unsigned msk;
        if (qblk < 16) msk = (2u << qblk) - 1u;
        else {
            msk = 0u;
#pragma unroll
            for (int q = 0; q < 4; ++q) { const int jj = part + 8 * q;
                if (jj >= 1 && jj <= qblk - 2) { const float v = imp[tk * 33 + jj]; int rank = 0;
#pragma unroll
                    for (int j2 = 1; j2 < 30; ++j2) { const float v2 = imp[tk * 33 + j2]; rank += (j2 <= qblk - 2 && (v2 > v || (v2 == v && j2 < jj))) ? 1 : 0; }
                    if (rank < 13) msk |= 1u << jj; } }
            msk |= (unsigned)__shfl_xor((int)msk, 1); msk |= (unsigned)__shfl_xor((int)msk, 2); msk |= (unsigned)__shfl_xor((int)msk, 4);
            msk |= 1u | (1u << (qblk - 1)) | (1u << qblk);
        }
        if (part == 0) selm[tk] = msk;
        unsigned om = msk;
#pragma unroll
        for (int off = 8; off < 64; off <<= 1) om |= (unsigned)__shfl_xor((int)om, off);
        if (lane == 0) __hip_atomic_fetch_or(misc, om, __ATOMIC_RELAXED, __HIP_MEMORY_SCOPE_WORKGROUP);
    }
    __syncthreads();
    const bf16_t* Kbase = P + (size_t)(b * T) * NPC + g * HD;
    const float bfar = tab[hr * 128 + 113];
    for (int rep = 0; rep < (MK_PROBE == 31 ? 2 : 1); ++rep) {
        if (rep) __syncthreads();
        unsigned om = __builtin_amdgcn_readfirstlane(misc[0]); const unsigned mym = selm[tl];
        float m = -1e30f, l = 0.f;
#pragma unroll
        for (int c = 0; c < 4; ++c)
#pragma unroll
            for (int i = 0; i < 16; ++i) o[c][i] = 0.f;
        int jc = __builtin_ctz(om); om &= om - 1u;
        stg_load(st, Kbase + PKS + (size_t)(64 * jc) * NPC, Kbase + PVS + (size_t)(64 * jc) * NPC, NPC, tid);
        stg_write(st, L, tid, 0);
        int jn = om ? __builtin_ctz(om) : -1; if (jn >= 0) { om &= om - 1u; stg_load(st, Kbase + PKS + (size_t)(64 * jn) * NPC, Kbase + PVS + (size_t)(64 * jn) * NPC, NPC, tid); }
        int buf = 0;
        for (;;) {
            __syncthreads();
            if (jn >= 0) stg_write(st, L, tid, buf ^ 1);
            const int jnn = om ? __builtin_ctz(om) : -1; if (jnn >= 0) { om &= om - 1u; stg_load(st, Kbase + PKS + (size_t)(64 * jnn) * NPC, Kbase + PVS + (size_t)(64 * jnn) * NPC, NPC, tid); }
            f32x16 p0, p1; qk_tile(p0, p1, L, buf, qf, r, h);
            const bool sel = (mym >> jc) & 1u;
            if (jc <= qblk - 3) {
#pragma unroll
                for (int i = 0; i < 16; ++i) { p0[i] = sel ? p0[i] + bfar : -__builtin_inff(); p1[i] = sel ? p1[i] + bfar : -__builtin_inff(); }
            } else {
#pragma unroll
                for (int i = 0; i < 16; ++i) { const int d0 = tq - (64 * jc + crow(i, h)), d1 = d0 - 32;
                    const float b0 = tab[hr * 128 + (d0 < 0 ? 0 : (d0 > 113 ? 113 : d0))], b1 = tab[hr * 128 + (d1 < 0 ? 0 : (d1 > 113 ? 113 : d1))];
                    p0[i] = (sel && d0 >= 0) ? p0[i] + b0 : -__builtin_inff(); p1[i] = (sel && d1 >= 0) ? p1[i] + b1 : -__builtin_inff(); }
            }
            softmax_step(p0, p1, m, l, o);
            pv_tile(o, p0, p1, L, buf, lane);
            if (jn < 0) break;
            jc = jn; jn = jnn; buf ^= 1;
        }
        if (rep == (MK_PROBE == 31 ? 1 : 0)) store_ot(o, NSA_GATE(1) / l, NSA_OUT(), h, true);
    }
    for (int rep = 0; rep < (MK_PROBE == 32 ? 2 : 1); ++rep) {
        float m = -1e30f, l = 0.f;
#pragma unroll
        for (int c = 0; c < 4; ++c)
#pragma unroll
            for (int i = 0; i < 16; ++i) o[c][i] = 0.f;
        int jc = qblk >= 8 ? qblk - 8 : 0;
        stg_load(st, Kbase + PKW + (size_t)(64 * jc) * NPC, Kbase + PVW + (size_t)(64 * jc) * NPC, NPC, tid);
        __syncthreads();
        stg_write(st, L, tid, 0);
        if (jc < qblk) stg_load(st, Kbase + PKW + (size_t)(64 * (jc + 1)) * NPC, Kbase + PVW + (size_t)(64 * (jc + 1)) * NPC, NPC, tid);
        int buf = 0;
        for (;;) {
            __syncthreads();
            if (jc < qblk) stg_write(st, L, tid, buf ^ 1);
            if (jc + 1 < qblk) stg_load(st, Kbase + PKW + (size_t)(64 * (jc + 2)) * NPC, Kbase + PVW + (size_t)(64 * (jc + 2)) * NPC, NPC, tid);
            f32x16 p0, p1; qk_tile(p0, p1, L, buf, qf, r, h);
            if (jc <= qblk - 3 && jc >= qblk - 7) {
#pragma unroll
                for (int i = 0; i < 16; ++i) { p0[i] += bfar; p1[i] += bfar; }
            } else {
                const bool far = jc <= qblk - 3;
#pragma unroll
                for (int i = 0; i < 16; ++i) { const int d0 = tq - (64 * jc + crow(i, h)), d1 = d0 - 32;
                    const float b0 = far ? bfar : tab[hr * 128 + (d0 < 0 ? 0 : (d0 > 113 ? 113 : d0))], b1 = far ? bfar : tab[hr * 128 + (d1 < 0 ? 0 : (d1 > 113 ? 113 : d1))];
                    p0[i] = ((unsigned)d0 < 512u) ? p0[i] + b0 : -__builtin_inff(); p1[i] = ((unsigned)d1 < 512u) ? p1[i] + b1 : -__builtin_inff(); }
            }
            softmax_step(p0, p1, m, l, o);
            pv_tile(o, p0, p1, L, buf, lane);
            if (jc == qblk) break;
            ++jc; buf ^= 1;
        }
        if (rep == (MK_PROBE == 32 ? 1 : 0)) store_ot(o, NSA_GATE(2) / l, NSA_OUT(), h, true);
    }
#undef NSA_GATE
#undef NSA_OUT
}

constexpr int NI_H = 128, NI_S = 1024, NI_C = 256, NI_N = 512, NI_A = 1024;
#define FRESH_F() do { unsigned on_ = ~0u; asm volatile("" : "+s"(on_)); int t_ = F.wave * 64 + (int)__builtin_amdgcn_mbcnt_hi(on_, __builtin_amdgcn_mbcnt_lo(on_, 0u)); asm volatile("" : "+v"(t_)); F.tid = t_; F.lane = t_ & 63; F.wave = __builtin_amdgcn_readfirstlane(t_ >> 6); } while (0)
__device__ __forceinline__ void phase_Ca(Frame& F, KArgs a, int layer, int bank, int types) {
    unsigned* head = F.ctl + CW_QUEUE + 64 * (layer * 8) + bank * 4096;
    if (types & 1) for (;;) { const int it = q_next(F, head + 0); if (it >= NI_H) break; FRESH_F(); item_hgrn(F, a, layer, it); }
    if (types & 2) for (;;) { const int it = q_next(F, head + 64); if (it >= NI_S) break; FRESH_F(); item_sb(F, a, it); }
    if (types & 4) for (;;) { const int it = q_next(F, head + 128); if (it >= NI_C) break; FRESH_F(); item_compress(F, a, layer, it); }
    if (types & 8) for (;;) { const int it = q_next(F, head + 192); if (it >= NI_N) break; FRESH_F(); item_norm(F, a, layer, it); }
}
__device__ __forceinline__ void phase_Cb(Frame& F, KArgs a, int layer, int bank) {
    unsigned* head = F.ctl + CW_QUEUE + 64 * (layer * 8 + 4) + bank * 4096;
    for (;;) { const int it = q_next(F, head + 0); if (it >= NI_A) break; FRESH_F(); item_nsa(F, a, it); }
}

__global__ void __launch_bounds__(512, 2) mega(Args karg) {
    extern __shared__ __attribute__((aligned(16))) unsigned char lds_raw[];
    Frame F;
    F.lds = (LAS unsigned char*)lds_raw; F.MISC = (volatile LAS unsigned*)(F.lds + MISC_OFF);
    F.tid = threadIdx.x; F.lane = F.tid & 63; F.wave = __builtin_amdgcn_readfirstlane(F.tid >> 6); F.G = gridDim.x; F.bid = blockIdx.x;
    KArgs a = (KArgs)__builtin_amdgcn_kernarg_segment_ptr();
    F.ws = a->ws; F.ctl = (unsigned*)(a->ws + WS_CTL);
    if (F.tid < 64) F.MISC[F.tid] = 0u;
    __syncthreads();
    const int lo = karg.ph_lo, hi = karg.ph_hi;
    XcdBarrier bar; bar.bar = F.ctl + CW_BAR; bar.x = 0; bar.st = F.MISC + 8;
    if (hi - lo > 1) bar = xcd_barrier_post(F.ctl + CW_BAR, F.MISC + 8);
#define IN(k) (lo <= (k) && (k) < hi)
#define ON(k) (((MK_PHASE_MASK & MK_BUILD_MASK) >> (k)) & 1)
#define GRID_BAR() do { unsigned* bp_ = (unsigned*)(a->ws + WS_CTL) + CW_BAR; asm volatile("" : "+s"(bp_)); bar.bar = bp_; xcd_barrier(bar); } while (0)
#define SEAM(k) do { if (IN(k) && IN((k) + 1)) GRID_BAR(); } while (0)
    bf16_t* Hb; bf16_t* Pb; const int wave_s = __builtin_amdgcn_readfirstlane(threadIdx.x >> 6);
    for (int layer = 0; layer < DEPTH; ++layer) {
        const int pb = layer * 10;
#define FRESH() do { unsigned on_ = ~0u; asm volatile("" : "+s"(on_)); int t_ = wave_s * 64 + (int)__builtin_amdgcn_mbcnt_hi(on_, __builtin_amdgcn_mbcnt_lo(on_, 0u)); asm volatile("" : "+v"(t_)); F.tid = t_; F.lane = t_ & 63; F.wave = __builtin_amdgcn_readfirstlane(t_ >> 6); \
        asm volatile("" : "+s"(a)); F.ws = a->ws; F.ctl = (unsigned*)(a->ws + WS_CTL); Hb = (bf16_t*)(F.ws + WS_H); Pb = (bf16_t*)(F.ws + WS_P); } while (0)
        if (ON(0) && IN(pb + 0)) { FRESH(); if (MK_PROBE == 0) { phase_A(F, a, layer); GRID_BAR(); } phase_A(F, a, layer); } SEAM(pb + 0);
        if (ON(1) && IN(pb + 1)) for (int rep = 0; rep < (MK_PROBE == 1 ? 2 : 1); ++rep) { FRESH();
            if (rep) GRID_BAR();
            if (MK_STAGGER) { const unsigned long long t0 = __builtin_amdgcn_s_memrealtime(), dl = (unsigned long long)((F.bid >> 3) & 7) * MK_STAGGER; while (__builtin_amdgcn_s_memrealtime() - t0 < dl) __builtin_amdgcn_s_sleep(4); }
            pg8::Gemm g{(const bf16_t*)(F.ws + WS_XB), (const bf16_t*)(F.ws + WS_WIN), M, NPC, DM, 1, 1}; pg8::StaticOrder S; S.init(M, NPC, F.G, F.bid);
            pg8::EpiStoreBf16 E{Pb, NPC, PGT / 256, PGN / 256, (const float*)(F.ws + WS_RSTD)};
            pg8::gemm_phase<pg8::EpiStoreBf16, pg8::StaticOrder, PG8_ALIGN, PG8_SP2>(F.lds, g, S, E, F.tid, (MK_DIAG && layer == 0 && F.bid == 0) ? (unsigned long long*)(F.ctl + 49152) : nullptr);
        } SEAM(pb + 1);
        if (ON(2) && IN(pb + 2)) { FRESH(); if (MK_PROBE >= 20 && MK_PROBE < 28) { phase_Ca(F, a, layer, 1, MK_PROBE - 20); GRID_BAR(); } phase_Ca(F, a, layer, 0, 15); } SEAM(pb + 2);
        if (ON(3) && IN(pb + 3)) { FRESH(); if (MK_PROBE == 3) { phase_Cb(F, a, layer, 1); GRID_BAR(); } phase_Cb(F, a, layer, 0); } SEAM(pb + 3);
        if (ON(4) && IN(pb + 4)) for (int rep = 0; rep < (MK_PROBE == 4 ? 2 : 1); ++rep) { FRESH();
            if (rep) GRID_BAR();
            pg8::Gemm g{(const bf16_t*)(F.ws + WS_OBR), (const bf16_t*)(F.ws + WS_WBR), M, DM, 3 * BW, 1, 1}; pg8::StaticOrder S; S.init(M, DM, F.G, F.bid);
            pg8::EpiGated E{Pb, Hb};
            pg8::gemm_phase<pg8::EpiGated, pg8::StaticOrder, PG8_ALIGN, PG8_SP2>(F.lds, g, S, E, F.tid);
        } SEAM(pb + 4);
        if (ON(5) && IN(pb + 5)) for (int rep = 0; rep < (MK_PROBE == 5 ? 2 : 1); ++rep) { FRESH();
            if (rep) GRID_BAR();
            pg8::Gemm g{Hb, (const bf16_t*)(F.ws + WS_WOUT), M, DM, DM, 1, 1}; pg8::StaticOrder S; S.init(M, DM, F.G, F.bid);
            pg8::EpiResidBf16 E{(MK_PROBE == 5 && rep == 0) ? (bf16_t*)(F.ws + WS_P) : (bf16_t*)(F.ws + WS_XB), nullptr, (MK_PROBE == 5 && rep == 0) ? (float*)(F.ws + WS_P + 256 * MiB) : (float*)(F.ws + WS_SSQ), DM};
            pg8::gemm_phase<pg8::EpiResidBf16, pg8::StaticOrder, PG8_ALIGN, PG8_SP2>(F.lds, g, S, E, F.tid);
        } SEAM(pb + 5);
        if (ON(6) && IN(pb + 6)) { FRESH(); phase_F(F, a); } SEAM(pb + 6);
        if (ON(7) && IN(pb + 7)) for (int rep = 0; rep < (MK_PROBE == 7 ? 2 : 1); ++rep) { FRESH();
            if (rep) GRID_BAR();
            if (MK_STAGGER) { const unsigned long long t0 = __builtin_amdgcn_s_memrealtime(), dl = (unsigned long long)((F.bid >> 3) & 7) * MK_STAGGER; while (__builtin_amdgcn_s_memrealtime() - t0 < dl) __builtin_amdgcn_s_sleep(4); }
            pg8::Gemm g{(const bf16_t*)(F.ws + WS_XB), (const bf16_t*)(F.ws + WS_WUP), M, NUP, DM, 1, 1}; pg8::StaticOrder S; S.init(M, NUP, F.G, F.bid);
            pg8::EpiConvAct E{(bf16_t*)(F.ws + WS_ACT), (bf16_t*)(F.ws + WS_USIDE), (const float*)(F.ws + WS_RSTD), a->in[I_CONVW] + (size_t)layer * 3 * NUP, a->in[I_CONVB] + (size_t)layer * NUP};
            pg8::gemm_phase<pg8::EpiConvAct, pg8::StaticOrder, PG8_ALIGN, PG8_SP2>(F.lds, g, S, E, F.tid);
        } SEAM(pb + 7);
        if (ON(8) && IN(pb + 8)) { FRESH(); if (MK_PROBE == 8) { phase_H(F, a, layer); GRID_BAR(); } phase_H(F, a, layer); } SEAM(pb + 8);
        if (ON(9) && IN(pb + 9)) for (int rep = 0; rep < (MK_PROBE == 9 ? 2 : 1); ++rep) { FRESH();
            if (rep) GRID_BAR();
            pg8::Gemm g{(const bf16_t*)(F.ws + WS_ACT), (const bf16_t*)(F.ws + WS_WDN), M, DM, DFF, 1, 1}; pg8::StaticOrder S; S.init(M, DM, F.G, F.bid, 4, 1);
            pg8::EpiResidBf16 E{(MK_PROBE == 9 && rep == 0) ? (bf16_t*)(F.ws + WS_P) : (bf16_t*)(F.ws + WS_XB), (layer == DEPTH - 1 && !(MK_PROBE == 9 && rep == 0)) ? a->out : nullptr, (MK_PROBE == 9 && rep == 0) ? (float*)(F.ws + WS_P + 256 * MiB) : (float*)(F.ws + WS_SSQ), DM};
            pg8::gemm_phase<pg8::EpiResidBf16, pg8::StaticOrder, PG8_ALIGN, PG8_SP2>(F.lds, g, S, E, F.tid);
        } SEAM(pb + 9);
    }
#if MK_DIAG
    GRID_BAR();
    { const unsigned long long* dg = (const unsigned long long*)(F.ctl + 49152); const float kl = (float)(long long)(dg[1] - dg[0]), per = (float)(long long)(dg[2] - dg[0]);
      const float eps = MK_DIAG == 1 ? kl / per : (MK_DIAG == 2 ? per * 1e-4f : kl * 1e-4f);
      for (size_t i = (size_t)F.bid * 512 + threadIdx.x; i < (size_t)M * DM; i += (size_t)F.G * 512) a->out[i] *= (1.f + eps); }
#endif
}

extern "C" void kernel_launch(void* const* d_in, const int* in_sizes, int n_in, void* d_out, int out_size, void* d_ws, size_t ws_size, hipStream_t stream) {
    static int grid = 0;
    if (grid == 0) {
        if (n_in != 18 || in_sizes[0] != M * DM || out_size != M * DM || ws_size < WS_END) { fprintf(stderr, "kernel_launch: unexpected shapes / workspace (%d inputs, ws %zu)\n", n_in, ws_size); grid = -1; return; }
        int dev = 0, cus = 0, per_cu = 0;
        if (hipGetDevice(&dev) != hipSuccess || hipDeviceGetAttribute(&cus, hipDeviceAttributeMultiprocessorCount, dev) != hipSuccess) { grid = -1; return; }
        if (hipFuncSetAttribute((const void*)mega, hipFuncAttributeMaxDynamicSharedMemorySize, LDS_BYTES) != hipSuccess) { grid = -1; return; }
        if (hipOccupancyMaxActiveBlocksPerMultiprocessor(&per_cu, (const void*)mega, 512, LDS_BYTES) != hipSuccess || per_cu < 1) { fprintf(stderr, "kernel_launch: occupancy query says %d\n", per_cu); }
        (void)hipGetLastError();
        grid = cus;
    }
    if (grid < 0) return;
    (void)hipMemsetAsync((char*)d_ws + WS_CTL, 0, CTL_BYTES, stream);
    Args a{};
    for (int i = 0; i < 18; ++i) a.in[i] = (const float*)d_in[i];
    a.out = (float*)d_out; a.ws = (unsigned char*)d_ws;
#if MK_ONE_LAUNCH
    a.ph_lo = 0; a.ph_hi = DEPTH * 10;
    hipLaunchKernelGGL(mega, dim3(grid), dim3(512), LDS_BYTES, stream, a);
#else
    for (int p = 0; p < DEPTH * 10; ++p) { a.ph_lo = p; a.ph_hi = p + 1; hipLaunchKernelGGL(mega, dim3(grid), dim3(512), LDS_BYTES, stream, a); }
#endif
}
```

```cpp
#include <hip/hip_runtime.h>
#include <stdint.h>
#include <stdio.h>

#ifndef MK_ONE_LAUNCH
#define MK_ONE_LAUNCH 1
#endif
#ifndef MK_PHASE_MASK
#define MK_PHASE_MASK 0x3ff
#endif
#ifndef MK_PROBE
#define MK_PROBE -1
#endif
#ifndef MK_STAGGER
#define MK_STAGGER 0
#endif
#ifndef MK_DIAG
#define MK_DIAG 0
#endif
#ifndef MK_BUILD_MASK
#define MK_BUILD_MASK 0x3ff
#endif

#define LAS __attribute__((address_space(3)))
typedef unsigned short bf16_t;
typedef short bf16x8 __attribute__((ext_vector_type(8)));
typedef short s16x4 __attribute__((ext_vector_type(4)));
typedef float f32x4 __attribute__((ext_vector_type(4)));
typedef float f32x16 __attribute__((ext_vector_type(16)));
typedef float f32x2 __attribute__((ext_vector_type(2)));
typedef unsigned u32x4 __attribute__((ext_vector_type(4)));
typedef unsigned u32x2 __attribute__((ext_vector_type(2)));
typedef __bf16 bfv2 __attribute__((ext_vector_type(2)));

constexpr int DM = 2048, NB = 16, T = 2048, DEPTH = 4, M = NB * T, HD = 128;
constexpr int INC = 15896;
constexpr int NPC = 16128;
constexpr int PQN = 0, PKC = 1024, PVC = 1280, PKS = 1536, PVS = 1792, PKW = 2048, PVW = 2304, PQS = 2560, PKSB = 3584, PVSB = 4608,
              PQH = 5632, PFH = 6656, PIH = 7680, PGH = 8704, PGT = 9728, PGN = 15872;
constexpr int DFF = 5632, NUP = 2 * DFF;
constexpr int BW = 1024;
constexpr float EPS = 1e-6f;
constexpr float LOG2E = 1.4426950408889634f, LN2 = 0.6931471805599453f;
constexpr float QSCALE = 0.08838834764831845f;

constexpr size_t MiB = 1u << 20;
constexpr size_t WS_CTL = 0, CTL_BYTES = 1 * MiB;
constexpr size_t WS_WIN = 1 * MiB, WS_WBR = 64 * MiB, WS_WOUT = 76 * MiB, WS_WUP = 84 * MiB, WS_WDN = 128 * MiB;
constexpr size_t WS_MISC = 150 * MiB;
constexpr size_t MISC_KCMP = 0, MISC_VCMP = 1 * MiB, MISC_WC1 = 2 * MiB;
constexpr int CW_CVEC = 32768;
constexpr size_t WS_SCR = 154 * MiB;
constexpr size_t WS_P = 218 * MiB;
constexpr size_t WS_H = 1226 * MiB;
constexpr size_t WS_OBR = 1354 * MiB;
constexpr size_t WS_ORAW = 1546 * MiB;
constexpr size_t WS_XB = 1674 * MiB;
constexpr size_t WS_SSQ = 1802 * MiB;
constexpr size_t WS_RSTD = 1806 * MiB;
constexpr size_t WS_USIDE = 1807 * MiB;
constexpr size_t WS_END = 1853 * MiB;
constexpr size_t WS_ACT = WS_P + 704 * MiB;
constexpr int CW_BAR = 4096;
constexpr int CW_QUEUE = 16384;

constexpr int RING_BYTES = 131072;
constexpr int MISC_OFF = 147456 - 256;
constexpr int LDS_BYTES = 147456;

__device__ __forceinline__ float bf2f(unsigned short b) { return __uint_as_float(((unsigned)b) << 16); }
__device__ __forceinline__ float bflo(unsigned w) { return __uint_as_float(w << 16); }
__device__ __forceinline__ float bfhi(unsigned w) { return __uint_as_float(w & 0xffff0000u); }
__device__ __forceinline__ unsigned pk2(float lo, float hi) { f32x2 v = {lo, hi}; bfv2 b = __builtin_convertvector(v, bfv2); return __builtin_bit_cast(unsigned, b); }
__device__ __forceinline__ float wave_sum(float v) {
#pragma unroll
    for (int o = 1; o < 64; o <<= 1) v += __shfl_xor(v, o);
    return v;
}
__device__ __forceinline__ float fast_exp2(float x) { return __builtin_amdgcn_exp2f(x); }
__device__ __forceinline__ float fast_log2(float x) { return __builtin_amdgcn_logf(x); }
__device__ __forceinline__ float fast_rcp(float x) { return __builtin_amdgcn_rcpf(x); }
__device__ __forceinline__ float sigmoidf_(float x) { return fast_rcp(1.f + fast_exp2(-x * LOG2E)); }
#define LDS_WAIT() asm volatile("s_waitcnt lgkmcnt(0)" ::: "memory")
__device__ __forceinline__ size_t akm(size_t row, int col) { return ((size_t)(col >> 6) * M + row) * 64 + (col & 63); }

#define XB_TMO      128
#define XB_XCNT(j)  (256  + 64 * (j))
#define XB_XSUB(j)  (1280 + 64 * (j))
#define XB_XGEN(j)  (2304 + 64 * (j))
#define XB_TOP      3328
#define XB_TOPGEN   3392
#define XCD_BAR_WORDS 3456
#define XB_SPIN_CAP (1u << 22)
__device__ __forceinline__ unsigned xb_ld(unsigned* p)              { return __hip_atomic_load(p, __ATOMIC_RELAXED, __HIP_MEMORY_SCOPE_AGENT); }
__device__ __forceinline__ unsigned xb_add(unsigned* p, unsigned v) { return __hip_atomic_fetch_add(p, v, __ATOMIC_RELAXED, __HIP_MEMORY_SCOPE_AGENT); }
__device__ __forceinline__ unsigned xb_xcc_id() { return (unsigned)__builtin_amdgcn_s_getreg((3 << 11) | 20) & 0xFu; }
#define XB_SPIN(cond, bar) do { unsigned _sp = 0; while (cond) { __builtin_amdgcn_s_sleep(1); \
    if ((++_sp & 255u) == 0u) { if (xb_ld(&(bar)[XB_TMO])) break; if (_sp > XB_SPIN_CAP) { atomicAdd(&(bar)[XB_TMO], 1u); break; } } } } while (0)
struct XcdBarrier { unsigned* bar; unsigned x; volatile LAS unsigned* st; };
__device__ __forceinline__ XcdBarrier xcd_barrier_post(unsigned* bar, volatile LAS unsigned* st) {
    XcdBarrier b; b.bar = bar; b.x = xb_xcc_id(); b.st = st;
    if (threadIdx.x == 0) (void)xb_add(&bar[XB_XCNT(b.x)], 1u);
    return b;
}
__device__ __forceinline__ void xcd_barrier_complete(unsigned* bar, unsigned x, unsigned& nloc, unsigned& nx) {
    const unsigned G = gridDim.x * gridDim.y * gridDim.z;
    unsigned sum, cnt, mine, sp = 0u;
    for (;;) {
        sum = 0u; cnt = 0u; mine = 0u;
#pragma unroll
        for (unsigned j = 0; j < 16; ++j) { const unsigned c = xb_ld(&bar[XB_XCNT(j)]); sum += c; cnt += (c > 0u) ? 1u : 0u; mine = (j == x) ? c : mine; }
        if (sum == G) break;
        __builtin_amdgcn_s_sleep(1);
        if ((++sp & 255u) == 0u) { if (xb_ld(&bar[XB_TMO])) break; if (sp > XB_SPIN_CAP) { atomicAdd(&bar[XB_TMO], 1u); break; } }
    }
    nloc = mine > 0u ? mine : 1u; nx = cnt > 0u ? cnt : 1u;
}
__device__ __forceinline__ void xcd_barrier(const XcdBarrier& b) {
    asm volatile("s_waitcnt vmcnt(0)" ::: "memory");
    __syncthreads();
    if (threadIdx.x == 0) {
        unsigned* bar = b.bar;
        __builtin_amdgcn_s_waitcnt(0);
        unsigned nloc = b.st[0], nx = b.st[1];
        if (nloc == 0u) { xcd_barrier_complete(bar, b.x, nloc, nx); b.st[0] = nloc; b.st[1] = nx; }
        const unsigned old = xb_add(&bar[XB_XSUB(b.x)], 1u);
        const unsigned gen = old / nloc;
        if (old + 1u == (gen + 1u) * nloc) {
            __builtin_amdgcn_fence(__ATOMIC_RELEASE, "agent");
            asm volatile("s_waitcnt vmcnt(0)" ::: "memory");
            const unsigned og = xb_add(&bar[XB_TOP], 1u);
            const unsigned tg = og / nx;
            if (og + 1u == (tg + 1u) * nx) xb_add(&bar[XB_TOPGEN], 1u);
            else XB_SPIN(xb_ld(&bar[XB_TOPGEN]) == tg, bar);
            __builtin_amdgcn_fence(__ATOMIC_ACQUIRE, "agent");
            xb_add(&bar[XB_XGEN(b.x)], 1u);
            asm volatile("s_waitcnt vmcnt(0)" ::: "memory");
        } else {
            XB_SPIN(xb_ld(&bar[XB_XGEN(b.x)]) == gen, bar);
            __builtin_amdgcn_fence(__ATOMIC_ACQUIRE, "agent");
            asm volatile("s_waitcnt vmcnt(0)" ::: "memory");
        }
    }
    __syncthreads();
}

struct Args { const float* in[18]; float* out; unsigned char* ws; int ph_lo, ph_hi; };
typedef const __attribute__((address_space(4))) Args* KArgs;
enum { I_X = 0, I_NATT, I_WIN, I_QG, I_KG, I_CPOS, I_CW1, I_CW2, I_RELB, I_HLB, I_HNG, I_WBR, I_WOUT, I_NFFN, I_WUP, I_CONVW, I_CONVB, I_WDN };
namespace pg8 {
constexpr int BM = 256, BK = 64, HALF = 128, HTB = HALF * BK * 2, STAGE_BYTES = 8 * HTB, NXCD = 8, LRS_OFF = STAGE_BYTES;
__host__ __device__ __forceinline__ int lds_byte(int r, int c) { const int st = (r >> 4) * 2 + (c >> 5), rr = r & 15, cc = c & 31, ob = rr * 64 + cc * 2; return st * 1024 + (ob ^ (((ob >> 9) & 1) << 5)); }
__host__ __device__ __forceinline__ void stage_rc(int b, int& R, int& C) { const int st = b / 1024, sb = b % 1024, swz = sb ^ (((sb >> 9) & 1) << 5); R = (st >> 1) * 16 + swz / 64; C = (st & 1) * 32 + (swz % 64) / 2; }
__host__ __device__ __forceinline__ int perm32(int rho) { const int n = rho >> 4, i = rho & 15; return 8 * (i >> 2) + 4 * n + (i & 3); }
struct Unit { int pm, pn, aux; };
struct Gemm { const bf16_t* A; const bf16_t* Bt; int M, N, K; int akm, bkm; };
struct StaticOrder {
    int nM, nN, nwg, G, c, WGM, rev;
    int pad_;
    __device__ void init(int M_, int N_, int G_, int c_, int wgm = 4, int rev_ = 0) { nM = M_ / BM; nN = N_ / BM; nwg = nM * nN; G = G_; c = c_; WGM = wgm; rev = rev_; pad_ = 0; }
    __device__ __forceinline__ bool tile(long L, Unit& u) const {
        if (L >= nwg) return false;
        int wgid = (int)L; { const int q = nwg / NXCD, r = nwg % NXCD, xcd = wgid % NXCD, off = wgid / NXCD; wgid = (xcd < r ? xcd * (q + 1) : r * (q + 1) + (xcd - r) * q) + off; }
        const int nig = WGM * nN, gid = wgid / nig, fm = gid * WGM, gsz = (nM - fm) < WGM ? (nM - fm) : WGM;
        u.pm = fm + ((wgid % nig) % gsz); u.pn = (wgid % nig) / gsz; u.aux = 0; if (rev) u.pm = nM - 1 - u.pm; return true;
    }
    __device__ __forceinline__ bool next(int i, Unit& u) const { return tile((long)i * G + c, u); }
    __device__ __forceinline__ const char* aptr(const Gemm& g, const Unit& u, size_t tstep) const { return (const char*)g.A + (size_t)u.pm * tstep; }
    __device__ __forceinline__ const char* bptr(const Gemm& g, const Unit& u, size_t tstep) const { return (const char*)g.Bt + (size_t)u.pn * tstep; }
    __device__ __forceinline__ void a_ready(const Unit&) const {}
    __device__ __forceinline__ void done(const Unit&) const {}
};
struct EpiStoreBf16 {
    static constexpr bool PERM = true, AFTER_DRAIN = false;
    static constexpr int PF_WAVES = 1;
    __device__ __forceinline__ void prefetch(LAS unsigned char* lds, const Unit& u, int wid, int lane) const {
        unsigned l16 = (unsigned)lane * 16u; asm volatile("" : "+v"(l16));
        __builtin_amdgcn_global_load_lds((const unsigned*)((const char*)rs + (size_t)u.pm * (BM * 4) + l16), (LAS unsigned*)(lds + LRS_OFF), 16, 0, 0); }
    static constexpr bool LDS_RS = true;
    bf16_t* O; int ldc; int sg_lo, sg_hi; const float* rs; LAS const float* lrs;
    __device__ __forceinline__ void operator()(const f32x4 (&acc)[2][2][4][2], const Unit& u, int wr, int wc, int fr, int fq) const {
        const int row0 = u.pm * BM + wr * 64 + fr, col0 = u.pn * BM + wc * 32 + 8 * fq; const bool sg = u.pn >= sg_lo && u.pn < sg_hi;
        float rsv[8];
#pragma unroll
        for (int g = 0; g < 8; ++g) rsv[g] = lrs[wr * 64 + fr + (g >> 2) * HALF + (g & 3) * 16];
#pragma unroll
        for (int ai = 0; ai < 2; ++ai)
#pragma unroll
            for (int m = 0; m < 4; ++m) { bf16_t* rowp = O + (size_t)(row0 + ai * HALF + m * 16) * ldc + col0;
#pragma unroll
                for (int bj = 0; bj < 2; ++bj) { f32x4 v0 = acc[ai][bj][m][0] * rsv[ai * 4 + m], v1 = acc[ai][bj][m][1] * rsv[ai * 4 + m];
                    if (sg) {
#pragma unroll
                        for (int e = 0; e < 4; ++e) { v0[e] = sigmoidf_(v0[e]); v1[e] = sigmoidf_(v1[e]); } }
                    u32x4 w; w.x = pk2(v0[0], v0[1]); w.y = pk2(v0[2], v0[3]); w.z = pk2(v1[0], v1[1]); w.w = pk2(v1[2], v1[3]);
                    __builtin_nontemporal_store(w, (u32x4*)(rowp + bj * HALF)); } }
    }
};
struct EpiConvAct {
    static constexpr bool PERM = true, AFTER_DRAIN = false, NO_RELAX = true;
    static constexpr bool LDS_RS = true;
    static constexpr bool APERM = true;
    static constexpr int PF_WAVES = 4;
    __device__ __forceinline__ void prefetch(LAS unsigned char* lds, const Unit& u, int wid, int lane) const {
        unsigned l_ = (unsigned)lane; asm volatile("" : "+v"(l_));
        const float* rs = (const float*)(ws + WS_RSTD); const float* cw = a->in[I_CONVW] + (size_t)layer * 3 * NUP; const float* cb = a->in[I_CONVB] + (size_t)layer * NUP;
        if (wid == 0) __builtin_amdgcn_global_load_lds((const unsigned*)((const char*)rs + (size_t)u.pm * (BM * 4) + l_ * 16u), (LAS unsigned*)(lds + LRS_OFF), 16, 0, 0);
        const unsigned sg = 2u * (unsigned)wid + (l_ >> 5), tap = sg & 3u;
        const float* src = (tap < 3u ? cw + (size_t)tap * NUP : cb) + (size_t)(sg >> 2) * DFF + (size_t)u.pn * 128 + (l_ & 31u) * 4u;
        __builtin_amdgcn_global_load_lds((const unsigned*)src, (LAS unsigned*)(lds + LRS_OFF + 1024 + wid * 1024), 16, 0, 0); }
    unsigned char* ws; KArgs a; int layer; LAS const float* lrs;
    static __device__ __forceinline__ f32x4 shr1(const f32x4 v) {
        f32x4 r;
#pragma unroll
        for (int e = 0; e < 4; ++e) r[e] = __int_as_float(__builtin_amdgcn_update_dpp(0, __float_as_int(v[e]), 0x111, 0xf, 0xf, true));
        return r; }
    __device__ __forceinline__ void operator()(const f32x4 (&acc)[2][2][4][2], const Unit& u, int wr, int wc, int fr, int fq) const {
        const int row0 = u.pm * BM + wr * 64 + 4 * fr, ch0 = u.pn * 128 + wc * 32 + 8 * fq;
        bf16_t* ACT = (bf16_t*)(ws + WS_ACT); bf16_t* side = (bf16_t*)(ws + WS_USIDE);
        f32x4 rsv[2];
#pragma unroll
        for (int ai = 0; ai < 2; ++ai) rsv[ai] = *(const LAS f32x4*)(lrs + ai * HALF + wr * 64 + 4 * fr);
        if (fr == 0 || fr == 15) {
            const bool lo = fr == 0;
#pragma unroll
            for (int ai = 0; ai < 2; ++ai) { const int blk = (u.pm * BM + ai * HALF + wr * 64) >> 6;
#pragma unroll
                for (int s2 = 0; s2 < 2; ++s2) { const float r_ = lo ? rsv[ai][s2] : rsv[ai][2 + s2];
                    bf16_t* sp = side + ((size_t)blk * 4 + (lo ? s2 : 2 + s2)) * NUP + u.pn * 256 + wc * 32 + 8 * fq;
#pragma unroll
                    for (int bj = 0; bj < 2; ++bj) { const f32x4 l0 = acc[ai][bj][s2][0], h0 = acc[ai][bj][2 + s2][0], l1 = acc[ai][bj][s2][1], h1 = acc[ai][bj][2 + s2][1]; f32x4 a0, a1;
#pragma unroll
                        for (int e = 0; e < 4; ++e) { a0[e] = (lo ? l0[e] : h0[e]) * r_; a1[e] = (lo ? l1[e] : h1[e]) * r_; }
                        *(u32x4*)(sp + bj * HALF) = (u32x4){pk2(a0[0], a0[1]), pk2(a0[2], a0[3]), pk2(a1[0], a1[1]), pk2(a1[2], a1[3])}; } } }
        }
        __builtin_amdgcn_sched_barrier(0);
#pragma unroll
        for (int n = 0; n < 2; ++n) {
            LAS const float* lw = lrs + 256 + wc * 32 + 8 * fq + 4 * n;
#pragma unroll
            for (int ai = 0; ai < 2; ++ai) {
                f32x4 sg[4];
                { const f32x4 w0 = *(const LAS f32x4*)(lw), w1 = *(const LAS f32x4*)(lw + 128), w2 = *(const LAS f32x4*)(lw + 256), bb = *(const LAS f32x4*)(lw + 384);
                  const f32x4 x0 = acc[ai][0][0][n] * rsv[ai][0], x1 = acc[ai][0][1][n] * rsv[ai][1], x2 = acc[ai][0][2][n] * rsv[ai][2], x3 = acc[ai][0][3][n] * rsv[ai][3];
                  const f32x4 p1 = shr1(x3), p2 = shr1(x2);
                  const f32x4 c0 = bb + w0 * p2 + w1 * p1 + w2 * x0, c1 = bb + w0 * p1 + w1 * x0 + w2 * x1, c2 = bb + w0 * x0 + w1 * x1 + w2 * x2, c3 = bb + w0 * x1 + w1 * x2 + w2 * x3;
#pragma unroll
                  for (int e = 0; e < 4; ++e) { sg[0][e] = c0[e] * sigmoidf_(c0[e]); sg[1][e] = c1[e] * sigmoidf_(c1[e]); sg[2][e] = c2[e] * sigmoidf_(c2[e]); sg[3][e] = c3[e] * sigmoidf_(c3[e]); } }
                __builtin_amdgcn_sched_barrier(0);
                { const f32x4 w0 = *(const LAS f32x4*)(lw + 512), w1 = *(const LAS f32x4*)(lw + 640), w2 = *(const LAS f32x4*)(lw + 768), bb = *(const LAS f32x4*)(lw + 896);
                  const f32x4 x0 = acc[ai][1][0][n] * rsv[ai][0], x1 = acc[ai][1][1][n] * rsv[ai][1], x2 = acc[ai][1][2][n] * rsv[ai][2], x3 = acc[ai][1][3][n] * rsv[ai][3];
                  const f32x4 p1 = shr1(x3), p2 = shr1(x2);
                  f32x4 cv[4]; cv[0] = bb + w0 * p2 + w1 * p1 + w2 * x0; cv[1] = bb + w0 * p1 + w1 * x0 + w2 * x1; cv[2] = bb + w0 * x0 + w1 * x1 + w2 * x2; cv[3] = bb + w0 * x1 + w1 * x2 + w2 * x3;
#pragma unroll
                  for (int m = 0; m < 4; ++m) { const f32x4 act = sg[m] * cv[m];
                      u32x2 w; w.x = pk2(act[0], act[1]); w.y = pk2(act[2], act[3]);
                      *(u32x2*)(ACT + ((size_t)((ch0 + 4 * n) >> 6) * M + (size_t)(row0 + ai * HALF + m)) * 64 + ((ch0 + 4 * n) & 63)) = w; } }
                __builtin_amdgcn_sched_barrier(0);
            }
        }
    }
};
#ifndef ER_DEPTH
#define ER_DEPTH 4
#endif
struct EpiResidBf16 {
    static constexpr bool PERM = true, AFTER_DRAIN = false;
    bf16_t* XB; float* Cout; float* ssq; int ldc;
    __device__ __forceinline__ void operator()(const f32x4 (&acc)[2][2][4][2], const Unit& u, int wr, int wc, int fr, int fq) const {
        const int row0 = u.pm * BM + wr * 64 + fr, col0 = u.pn * BM + wc * 32 + 8 * fq;
        u32x4 old[ER_DEPTH][2]; float ssv[8];
#define ER_ROWI(g) (row0 + ((g) >> 2) * HALF + ((g) & 3) * 16)
#define ER_LOAD(g) do { old[(g) % ER_DEPTH][0] = *(const u32x4*)(XB + akm(ER_ROWI(g), col0)); old[(g) % ER_DEPTH][1] = *(const u32x4*)(XB + akm(ER_ROWI(g), col0 + HALF)); } while (0)
#pragma unroll
        for (int g = 0; g < ER_DEPTH; ++g) ER_LOAD(g);
#pragma unroll
        for (int g = 0; g < 8; ++g) {
            asm volatile("" ::: "memory");
            const size_t ro = (size_t)ER_ROWI(g) * ldc + col0; float ss = 0.f;
#pragma unroll
            for (int bj = 0; bj < 2; ++bj) { const u32x4 o_ = old[g % ER_DEPTH][bj];
                f32x4 v0 = acc[g >> 2][bj][g & 3][0], v1 = acc[g >> 2][bj][g & 3][1];
                v0[0] += bflo(o_.x); v0[1] += bfhi(o_.x); v0[2] += bflo(o_.y); v0[3] += bfhi(o_.y); v1[0] += bflo(o_.z); v1[1] += bfhi(o_.z); v1[2] += bflo(o_.w); v1[3] += bfhi(o_.w);
                if (Cout) { *(f32x4*)(Cout + ro + bj * HALF) = v0; *(f32x4*)(Cout + ro + bj * HALF + 4) = v1; }
                else { u32x4 w; w.x = pk2(v0[0], v0[1]); w.y = pk2(v0[2], v0[3]); w.z = pk2(v1[0], v1[1]); w.w = pk2(v1[2], v1[3]); *(u32x4*)(XB + akm(ER_ROWI(g), col0 + bj * HALF)) = w;
                    const float r0 = bflo(w.x), r1 = bfhi(w.x), r2 = bflo(w.y), r3 = bfhi(w.y), r4 = bflo(w.z), r5 = bfhi(w.z), r6 = bflo(w.w), r7 = bfhi(w.w);
                    ss += ((r0 * r0 + r1 * r1) + (r2 * r2 + r3 * r3)) + ((r4 * r4 + r5 * r5) + (r6 * r6 + r7 * r7)); } }
            ssv[g] = ss;
            if (g + ER_DEPTH < 8) ER_LOAD(g + ER_DEPTH);
        }
        if (!Cout) {
#pragma unroll
            for (int g = 0; g < 8; ++g) ssv[g] += __shfl_xor(ssv[g], 16);
#pragma unroll
            for (int g = 0; g < 8; ++g) ssv[g] += __shfl_xor(ssv[g], 32);
            if (fq == 0) {
#pragma unroll
                for (int g = 0; g < 8; ++g) ssq[(size_t)ER_ROWI(g) * 32 + u.pn * 4 + wc] = ssv[g]; } }
#undef ER_ROWI
#undef ER_LOAD
    }
};
struct EpiGated {
    static constexpr bool PERM = true, AFTER_DRAIN = false, HOOK = true; static constexpr int HOOK_KT = 16;
    const bf16_t* P; bf16_t* merged;
    static __device__ __forceinline__ float gl(unsigned w) { return fmaxf(bflo(w), 1e-30f); }
    static __device__ __forceinline__ float gh(unsigned w) { return fmaxf(bfhi(w), 1e-30f); }
    __device__ __forceinline__ void mid(f32x4 (&acc)[2][2][4][2], const Unit& u, int wr, int wc, int fr, int fq, int s) const {
        const unsigned row0 = (unsigned)(u.pm * BM + wr * 64 + fr), col0 = (unsigned)(u.pn * BM + wc * 32 + 8 * fq);
        const char* Pa = (const char*)(P + PGT + (s - 1) * DM); const char* Pb = (const char*)(P + PGT + s * DM);
#pragma unroll
        for (int hf = 0; hf < 2; ++hf) {
            u32x4 ga[4][2], gb[4][2];
#pragma unroll
            for (int gg = 0; gg < 4; ++gg) { const int g = hf * 4 + gg; const unsigned po = ((row0 + (unsigned)((g >> 2) * HALF + (g & 3) * 16)) * (unsigned)NPC + col0) * 2u;
#pragma unroll
                for (int bj = 0; bj < 2; ++bj) { ga[gg][bj] = *(const u32x4*)(Pa + (size_t)(po + bj * 256u)); gb[gg][bj] = *(const u32x4*)(Pb + (size_t)(po + bj * 256u)); } }
#pragma unroll
            for (int gg = 0; gg < 4; ++gg) { const int g = hf * 4 + gg;
#pragma unroll
                for (int bj = 0; bj < 2; ++bj) { const u32x4 a_ = ga[gg][bj], b_ = gb[gg][bj];
                    f32x4& v0 = acc[g >> 2][bj][g & 3][0]; f32x4& v1 = acc[g >> 2][bj][g & 3][1];
                    v0[0] *= gl(a_.x) * fast_rcp(gl(b_.x)); v0[1] *= gh(a_.x) * fast_rcp(gh(b_.x)); v0[2] *= gl(a_.y) * fast_rcp(gl(b_.y)); v0[3] *= gh(a_.y) * fast_rcp(gh(b_.y));
                    v1[0] *= gl(a_.z) * fast_rcp(gl(b_.z)); v1[1] *= gh(a_.z) * fast_rcp(gh(b_.z)); v1[2] *= gl(a_.w) * fast_rcp(gl(b_.w)); v1[3] *= gh(a_.w) * fast_rcp(gh(b_.w)); } }
            asm volatile("" ::: "memory"); }
    }
    __device__ __forceinline__ void operator()(const f32x4 (&acc)[2][2][4][2], const Unit& u, int wr, int wc, int fr, int fq) const {
        const unsigned row0 = (unsigned)(u.pm * BM + wr * 64 + fr), col0 = (unsigned)(u.pn * BM + wc * 32 + 8 * fq);
        const char* Pg = (const char*)(P + PGT + 2 * DM); char* mg = (char*)merged;
        u32x4 gw[8][2];
#pragma unroll
        for (int g = 0; g < 8; ++g) { const unsigned po = ((row0 + (unsigned)((g >> 2) * HALF + (g & 3) * 16)) * (unsigned)NPC + col0) * 2u;
#pragma unroll
            for (int bj = 0; bj < 2; ++bj) gw[g][bj] = *(const u32x4*)(Pg + (size_t)(po + bj * 256u)); }
#pragma unroll
        for (int g = 0; g < 8; ++g) { const unsigned moff = ((row0 + (unsigned)((g >> 2) * HALF + (g & 3) * 16)) * (unsigned)DM + col0) * 2u;
#pragma unroll
            for (int bj = 0; bj < 2; ++bj) { const u32x4 w_ = gw[g][bj]; const f32x4 v0 = acc[g >> 2][bj][g & 3][0], v1 = acc[g >> 2][bj][g & 3][1];
                u32x4 w; w.x = pk2(v0[0] * gl(w_.x), v0[1] * gh(w_.x)); w.y = pk2(v0[2] * gl(w_.y), v0[3] * gh(w_.y)); w.z = pk2(v1[0] * gl(w_.z), v1[1] * gh(w_.z)); w.w = pk2(v1[2] * gl(w_.w), v1[3] * gh(w_.w));
                *(u32x4*)(merged + akm(row0 + (unsigned)((g >> 2) * HALF + (g & 3) * 16), (int)col0 + bj * HALF)) = w; } }
    }
};

template <class E, class = void> struct has_relax { static constexpr bool v = true; };
template <class E> struct has_relax<E, decltype((void)E::NO_RELAX)> { static constexpr bool v = false; };
template <class E, class = void> struct has_lrs { static constexpr bool v = false; };
template <class E> struct has_lrs<E, decltype((void)E::LDS_RS)> { static constexpr bool v = true; };
template <class E, class = void> struct has_aperm { static constexpr bool v = false; };
template <class E> struct has_aperm<E, decltype((void)E::APERM)> { static constexpr bool v = true; };
template <class E, class = void> struct has_hook { static constexpr bool v = false; };
template <class E> struct has_hook<E, decltype((void)E::HOOK)> { static constexpr bool v = true; };
template <class Epi, class Sched, bool ALIGN_EPI = false, bool SP2 = false>
__device__ __forceinline__ void gemm_phase(LAS unsigned char* lds, const Gemm g, const Sched& S, const Epi& E, const int tid, unsigned long long* dg = nullptr) {
    float zf; asm volatile("v_mov_b32 %0, 0" : "=v"(zf));
    const int wid = __builtin_amdgcn_readfirstlane(tid >> 6), lane = tid & 63, wr = wid >> 2, wc = wid & 3, fr = lane & 15, fq = lane >> 4;
    const int K = g.K, nt = K / BK;
    unsigned voffA[2], voffB[2];
#pragma unroll
    for (int i = 0; i < 2; ++i) { int R, C; stage_rc(tid * 16 + i * 8192, R, C); const int Rb = Epi::PERM ? ((R & ~31) + perm32(R & 31)) : R;
        const int Ra = has_aperm<Epi>::v ? ((R & ~63) + 4 * (R & 15) + ((R >> 4) & 3)) : R;
        voffA[i] = (unsigned)(Ra * (g.akm ? BK : K) + C) * 2u; voffB[i] = (unsigned)(Rb * (g.bkm ? BK : K) + C) * 2u; }
    const size_t kstep = (size_t)(BK * 2);
    const size_t hstep = (size_t)HALF * K * 2;
    const size_t tstep = 2 * hstep;
    const size_t kstepA = g.akm ? (size_t)g.M * BK * 2 : kstep, hstepA = g.akm ? (size_t)HALF * BK * 2 : hstep, tstepA = 2 * hstepA;
    const size_t kstepB = g.bkm ? (size_t)g.N * BK * 2 : kstep, hstepB = g.bkm ? (size_t)HALF * BK * 2 : hstep, tstepB = 2 * hstepB;
    const unsigned ldsw = (unsigned)wid * 1024u;
    const int aoff = lds_byte(wr * 64 + fr, fq * 8), boff = lds_byte(wc * 32 + fr, fq * 8);
#define PG8_SA(b, h) (((b) * 2 + (h)) * HTB)
#define PG8_SB(b, h) ((4 + (b) * 2 + (h)) * HTB)
#define PG8_STAGE(bufoff, gbase, voff) do { _Pragma("unroll") for (int _i = 0; _i < 2; ++_i) \
        __builtin_amdgcn_global_load_lds((const unsigned*)((const char*)(gbase) + (voff)[_i]), (LAS unsigned*)(lds + (bufoff) + ldsw + _i * 8192), 16, 0, 0); } while (0)
#define PG8_LDA(dst, b, h) do { _Pragma("unroll") for (int m = 0; m < 4; ++m) _Pragma("unroll") for (int k = 0; k < 2; ++k) dst[m][k] = *(const LAS bf16x8*)(lds + PG8_SA(b, h) + aoff + m * 2048 + k * 1024); } while (0)
#define PG8_LDB(dst, b, h) do { _Pragma("unroll") for (int n = 0; n < 2; ++n) _Pragma("unroll") for (int k = 0; k < 2; ++k) dst[n][k] = *(const LAS bf16x8*)(lds + PG8_SB(b, h) + boff + n * 2048 + k * 1024); } while (0)
#define PG8_MMA(ai, bj, At, Bt) do { __builtin_amdgcn_s_setprio(1); _Pragma("unroll") for (int m = 0; m < 4; ++m) _Pragma("unroll") for (int n = 0; n < 2; ++n) _Pragma("unroll") for (int k = 0; k < 2; ++k) \
        acc[ai][bj][m][n] = __builtin_amdgcn_mfma_f32_16x16x32_bf16(Bt[n][k], At[m][k], acc[ai][bj][m][n], 0, 0, 0); __builtin_amdgcn_s_setprio(0); } while (0)
#define PG8_WAIT_V(n) asm volatile("s_waitcnt vmcnt(" #n ")" ::: "memory")
#define PG8_WAIT_L(n) asm volatile("s_waitcnt lgkmcnt(" #n ")" ::: "memory")
#define PG8_BAR __builtin_amdgcn_s_barrier()
#define PG8_SCHED __builtin_amdgcn_sched_barrier(0)
    Unit cur, nxt; int ui = 0;
    if (!S.next(0, cur)) return;
    f32x4 acc[2][2][4][2];
#pragma unroll
    for (int a = 0; a < 2; ++a)
#pragma unroll
        for (int b = 0; b < 2; ++b)
#pragma unroll
            for (int m = 0; m < 4; ++m)
#pragma unroll
                for (int n = 0; n < 2; ++n) acc[a][b][m][n] = (f32x4){zf, zf, zf, zf};
    bf16x8 At[4][2], B0[2][2], B1[2][2];
    const char* cA = S.aptr(g, cur, tstepA); const char* cB = S.bptr(g, cur, tstepB);
    S.a_ready(cur);
    if constexpr (SP2) {
        PG8_STAGE(PG8_SB(0, 0), cB, voffB); PG8_STAGE(PG8_SB(0, 1), cB + hstepB, voffB); PG8_STAGE(PG8_SA(0, 0), cA, voffA); PG8_STAGE(PG8_SA(0, 1), cA + hstepA, voffA);
        if (wr == 1) PG8_BAR;
        PG8_WAIT_V(2); PG8_BAR;
        PG8_STAGE(PG8_SB(1, 0), cB + kstepB, voffB); PG8_STAGE(PG8_SA(1, 0), cA + kstepA, voffA); PG8_STAGE(PG8_SB(1, 1), cB + hstepB + kstepB, voffB);
        PG8_WAIT_V(6); PG8_BAR;
    } else {
        PG8_STAGE(PG8_SB(0, 0), cB, voffB); PG8_STAGE(PG8_SA(0, 0), cA, voffA); PG8_STAGE(PG8_SB(0, 1), cB + hstepB, voffB); PG8_STAGE(PG8_SA(0, 1), cA + hstepA, voffA);
        if (wr == 1) PG8_BAR;
        PG8_WAIT_V(4); PG8_BAR;
        PG8_STAGE(PG8_SB(1, 0), cB + kstepB, voffB); PG8_STAGE(PG8_SA(1, 0), cA + kstepA, voffA); PG8_STAGE(PG8_SB(1, 1), cB + hstepB + kstepB, voffB);
        PG8_WAIT_V(6); PG8_BAR;
    }
    for (;;) {
        const bool has_next = S.next(ui + 1, nxt);
        if (MK_DIAG && dg && tid == 0 && (ui == 2 || ui == 3)) dg[(ui - 2) * 2] = wall_clock64();
        const char* nA = has_next ? S.aptr(g, nxt, tstepA) : cA; const char* nB = has_next ? S.bptr(g, nxt, tstepB) : cB;
        constexpr bool RELAX_ = has_relax<Epi>::v;
#define PG8_ITER(FIRST) do { \
            const bool last = (t == nt - 2); \
            const char* a1 = cA + (size_t)(t + 1) * kstepA; \
            const char* a2 = last ? nA : cA + (size_t)(t + 2) * kstepA; const char* b2 = last ? nB : cB + (size_t)(t + 2) * kstepB; \
            const char* a3 = a2 + kstepA; const char* b3 = b2 + kstepB; \
            if (last && has_next) S.a_ready(nxt); \
            PG8_LDB(B0, 0, 0); PG8_LDB(B1, 0, 1); PG8_SCHED; PG8_LDA(At, 0, 0); if (!(FIRST)) PG8_STAGE(PG8_SA(1, 1), a1 + hstepA, voffA); \
            if constexpr (has_lrs<Epi>::v) { if (t == 4 && wid < Epi::PF_WAVES) E.prefetch(lds, cur, wid, lane); } \
            if (FIRST) PG8_WAIT_V(24); else PG8_WAIT_V(8); PG8_WAIT_L(0); PG8_BAR; PG8_MMA(0, 0, At, B0); PG8_MMA(0, 1, At, B1); PG8_BAR; PG8_SCHED; \
            PG8_LDA(At, 0, 1); PG8_STAGE(PG8_SB(0, 0), b2, voffB); PG8_STAGE(PG8_SB(0, 1), b2 + hstepB, voffB); PG8_STAGE(PG8_SA(0, 0), a2, voffA); \
            if (FIRST) PG8_WAIT_V(24); else PG8_WAIT_V(8); PG8_WAIT_L(0); PG8_BAR; PG8_MMA(1, 0, At, B0); PG8_MMA(1, 1, At, B1); PG8_BAR; PG8_SCHED; \
            PG8_LDB(B0, 1, 0); PG8_LDB(B1, 1, 1); PG8_SCHED; PG8_LDA(At, 1, 0); PG8_STAGE(PG8_SA(0, 1), a2 + hstepA, voffA); \
            if (FIRST) PG8_WAIT_V(24); else PG8_WAIT_V(8); PG8_WAIT_L(0); PG8_BAR; PG8_MMA(0, 0, At, B0); PG8_MMA(0, 1, At, B1); PG8_BAR; PG8_SCHED; \
            PG8_LDA(At, 1, 1); PG8_STAGE(PG8_SB(1, 0), b3, voffB); PG8_STAGE(PG8_SB(1, 1), b3 + hstepB, voffB); PG8_STAGE(PG8_SA(1, 0), a3, voffA); \
            PG8_WAIT_V(8); PG8_WAIT_L(0); PG8_BAR; PG8_MMA(1, 0, At, B0); PG8_MMA(1, 1, At, B1); PG8_BAR; PG8_SCHED; \
            if constexpr (has_hook<Epi>::v) { if (t + 2 < nt && (t + 2) % Epi::HOOK_KT == 0) { const_cast<Epi&>(E).mid(acc, cur, wr, wc, fr, fq, (t + 2) / Epi::HOOK_KT); PG8_SCHED; } } \
            if (RELAX_ && last && has_next) { PG8_STAGE(PG8_SA(1, 1), a3 + hstepA, voffA); PG8_SCHED; }     \
        } while (0)
        int t = 0;
        if constexpr (RELAX_) { if (ui > 0) { PG8_ITER(1); t = 2; } }
        for (; t < nt; t += 2) { PG8_ITER(0); }
#undef PG8_ITER
        if (MK_DIAG && dg && tid == 0 && ui == 2) dg[1] = wall_clock64();
        if constexpr (ALIGN_EPI) { if (wr == 0) PG8_BAR; }
        if constexpr (!Epi::AFTER_DRAIN) { E(acc, cur, wr, wc, fr, fq); S.done(cur); }
        if (!has_next) break;
#pragma unroll
        for (int a = 0; a < 2; ++a)
#pragma unroll
            for (int b = 0; b < 2; ++b)
#pragma unroll
                for (int m = 0; m < 4; ++m)
#pragma unroll
                    for (int n = 0; n < 2; ++n) acc[a][b][m][n] = (f32x4){zf, zf, zf, zf};
        cur = nxt; cA = nA; cB = nB; ++ui;
        if constexpr (ALIGN_EPI) { if (wr == 1) PG8_BAR; }
    }
    PG8_WAIT_V(0);
    if constexpr (!ALIGN_EPI) { if (wr == 0) PG8_BAR; }
    PG8_BAR;
#undef PG8_SA
#undef PG8_SB
#undef PG8_STAGE
#undef PG8_LDA
#undef PG8_LDB
#undef PG8_MMA
#undef PG8_WAIT_V
#undef PG8_WAIT_L
#undef PG8_BAR
#undef PG8_SCHED
}
}
#define PG8_SP2 true
#define PG8_ALIGN true


struct Frame {
    LAS unsigned char* lds; volatile LAS unsigned* MISC;
    unsigned* ctl; unsigned char* ws;
    int tid, lane, wave, G, bid;
};

__device__ __forceinline__ int up_src_col(int n) { const int pn = n >> 8, c = n & 255; return c < 128 ? 128 * pn + c : DFF + 128 * pn + (c - 128); }
__device__ __forceinline__ int inproj_src_col(int n) { return n < 2560 ? n : (n < 15872 ? n + 24 : (n < 15896 ? n - 15872 + 2560 : -1)); }
__device__ __forceinline__ void transpose_item(const float* W, int K, int Nsrc, bf16_t* WT, const float* gain, int mode, LAS float* scr, int item, int nblk, int lane, int ntot, int kbase = 0) {
    const int kb = item / nblk, nb = item - kb * nblk, k0 = 64 * kb, n0 = 32 * nb;
    const int nn = n0 + (lane & 7) * 4; const int sc = mode == 1 ? inproj_src_col(nn) : (mode == 2 ? up_src_col(nn) : nn);
    f32x4 v[8];
#pragma unroll
    for (int i = 0; i < 8; ++i) { const int kk = 8 * i + (lane >> 3); v[i] = sc >= 0 ? __builtin_nontemporal_load((const f32x4*)(W + (size_t)(k0 + kk) * Nsrc + sc)) : (f32x4){0.f, 0.f, 0.f, 0.f}; }
#pragma unroll
    for (int i = 0; i < 8; ++i) { const int kk = 8 * i + (lane >> 3); const float gk = gain ? gain[k0 + kk] : 1.f; LAS float* d = scr + kk * 33 + (lane & 7) * 4;
        d[0] = v[i].x * gk; d[1] = v[i].y * gk; d[2] = v[i].z * gk; d[3] = v[i].w * gk; }
    LDS_WAIT(); asm volatile("" ::: "memory");
    const int c = lane & 7;
#pragma unroll
    for (int j = 0; j < 4; ++j) { const int n = (lane >> 3) + 8 * j; const LAS float* sp = scr + (8 * c) * 33 + n;
        u32x4 o; o.x = pk2(sp[0 * 33], sp[1 * 33]); o.y = pk2(sp[2 * 33], sp[3 * 33]); o.z = pk2(sp[4 * 33], sp[5 * 33]); o.w = pk2(sp[6 * 33], sp[7 * 33]);
        if (ntot) *(u32x4*)(WT + ((size_t)((kbase + k0) >> 6) * ntot + (size_t)(n0 + n)) * 64 + 8 * c) = o;
        else *(u32x4*)(WT + (size_t)(n0 + n) * K + k0 + 8 * c) = o; }
    LDS_WAIT(); asm volatile("" ::: "memory");
}
__device__ __forceinline__ void rms_row0(const float* xin, bf16_t* XB, int m, float* rstd, int lane) {
    const f32x4* xr = (const f32x4*)xin + lane;
    f32x4 v[8]; float s = 0.f;
#pragma unroll
    for (int j = 0; j < 8; ++j) { v[j] = xr[64 * j]; s += (v[j].x * v[j].x + v[j].y * v[j].y) + (v[j].z * v[j].z + v[j].w * v[j].w); }
    s = wave_sum(s);
    if (lane == 0) *rstd = rsqrtf(s * (1.f / DM) + EPS);
#pragma unroll
    for (int j = 0; j < 8; ++j) { u32x2 w; w.x = pk2(v[j].x, v[j].y); w.y = pk2(v[j].z, v[j].w); *(u32x2*)(XB + akm((size_t)m, 4 * (lane + 64 * j))) = w; }
}
__device__ __forceinline__ void rstd_rows(Frame& F) {
    const float* ssq = (const float*)(F.ws + WS_SSQ); float* rstd = (float*)(F.ws + WS_RSTD);
    for (int row = F.bid * 512 + F.tid; row < M; row += F.G * 512) { const f32x4* p = (const f32x4*)(ssq + (size_t)row * 32); float s = 0.f;
#pragma unroll
        for (int j = 0; j < 8; ++j) { const f32x4 v = p[j]; s += (v.x + v.y) + (v.z + v.w); }
        rstd[row] = rsqrtf(s * (1.f / DM) + EPS); }
}

__device__ __forceinline__ void cvec_item(Frame& F, KArgs a, int layer, int j);
__device__ __forceinline__ void phase_A(Frame& F, KArgs a, int layer) {
    LAS float* scr = (LAS float*)(F.lds + F.wave * 16384);
    const int gw = F.bid * 8 + F.wave, NGW = F.G * 8;
    bf16_t* Wt_in = (bf16_t*)(F.ws + WS_WIN); bf16_t* Wt_br = (bf16_t*)(F.ws + WS_WBR); bf16_t* Wt_out = (bf16_t*)(F.ws + WS_WOUT);
    bf16_t* Wt_up = (bf16_t*)(F.ws + WS_WUP); bf16_t* Wt_dn = (bf16_t*)(F.ws + WS_WDN);
    const float* w_in = a->in[I_WIN] + (size_t)layer * DM * INC; const float* g_att = a->in[I_NATT] + layer * DM;
    const float* w_br = a->in[I_WBR] + (size_t)layer * 3 * BW * DM; const float* w_out = a->in[I_WOUT] + (size_t)layer * DM * DM;
    const float* w_up = a->in[I_WUP] + (size_t)layer * DM * NUP; const float* g_ffn = a->in[I_NFFN] + layer * DM;
    const float* w_dn = a->in[I_WDN] + (size_t)layer * DFF * DM;
    constexpr int I_IN = (DM / 64) * (NPC / 32), I_BR1 = (BW / 64) * (DM / 32), I_OUT = (DM / 64) * (DM / 32), I_UP = (DM / 64) * (NUP / 32), I_DN = (DFF / 64) * (DM / 32);
    constexpr int I_C1 = (4096 / 64) * (HD / 32);
    constexpr int NITEMS = I_IN + 3 * I_BR1 + I_OUT + I_UP + I_DN + 2 * I_C1;
    for (int it = gw; it < NITEMS; it += NGW) {
        int r = it;
        if (r < I_IN) { transpose_item(w_in, DM, INC, Wt_in, g_att, 1, scr, r, NPC / 32, F.lane, NPC); continue; } r -= I_IN;
        if (r < 3 * I_BR1) { const int n = r / I_BR1; r -= n * I_BR1; transpose_item(w_br + (size_t)n * BW * DM, BW, DM, Wt_br, nullptr, 0, scr, r, DM / 32, F.lane, DM, n * BW); continue; } r -= 3 * I_BR1;
        if (r < I_OUT) { transpose_item(w_out, DM, DM, Wt_out, nullptr, 0, scr, r, DM / 32, F.lane, DM); continue; } r -= I_OUT;
        if (r < I_UP) { transpose_item(w_up, DM, NUP, Wt_up, g_ffn, 2, scr, r, NUP / 32, F.lane, NUP); continue; } r -= I_UP;
        if (r < I_DN) { transpose_item(w_dn, DFF, DM, Wt_dn, nullptr, 0, scr, r, DM / 32, F.lane, DM); continue; } r -= I_DN;
        { const int j = r / I_C1; r -= j * I_C1; transpose_item(a->in[I_CW1] + (size_t)(layer * 2 + j) * 4096 * HD, 4096, HD, (bf16_t*)(F.ws + WS_MISC + MISC_WC1) + (size_t)j * HD * 4096, nullptr, 0, scr, r, HD / 32, F.lane, 0); }
    }
    if (F.bid < 64) cvec_item(F, a, layer, F.bid);
    if (layer == 0) { bf16_t* XB = (bf16_t*)(F.ws + WS_XB); float* rstd = (float*)(F.ws + WS_RSTD);
        for (int m = gw; m < M; m += NGW) rms_row0(a->in[I_X] + (size_t)m * DM, XB, m, rstd + m, F.lane); }
    else rstd_rows(F);
}
__device__ __forceinline__ void phase_F(Frame& F, KArgs a) { rstd_rows(F); }
__device__ __forceinline__ void phase_H(Frame& F, KArgs a, int layer) {
    const bf16_t* SD = (const bf16_t*)(F.ws + WS_USIDE); bf16_t* ACT = (bf16_t*)(F.ws + WS_ACT);
    const float* cw = a->in[I_CONVW] + (size_t)layer * 3 * NUP; const float* cb = a->in[I_CONVB] + (size_t)layer * NUP;
    constexpr int CG = DFF / 8, NTASK = (M / 64) * 2 * CG;
    for (int task = F.bid * 512 + F.tid; task < NTASK; task += F.G * 512) {
        const int cg = task % CG, rb = task / CG, rw = rb & 1, blk = rb >> 1; if ((blk & 31) == 0) continue;
        const int c0 = cg * 8, uc = 256 * (c0 >> 7) + (c0 & 127);
        const bf16_t* t2 = rw == 0 ? SD + ((size_t)(blk - 1) * 4 + 2) * NUP : SD + ((size_t)(blk - 1) * 4 + 3) * NUP;
        const bf16_t* t1 = rw == 0 ? SD + ((size_t)(blk - 1) * 4 + 3) * NUP : SD + ((size_t)blk * 4 + 0) * NUP;
        const bf16_t* t0 = SD + ((size_t)blk * 4 + rw) * NUP;
        const u32x4 g2 = *(const u32x4*)(t2 + uc), g1 = *(const u32x4*)(t1 + uc), g0 = *(const u32x4*)(t0 + uc), v2 = *(const u32x4*)(t2 + uc + 128), v1 = *(const u32x4*)(t1 + uc + 128), v0 = *(const u32x4*)(t0 + uc + 128);
        const unsigned G2[4] = {g2.x, g2.y, g2.z, g2.w}, G1[4] = {g1.x, g1.y, g1.z, g1.w}, G0[4] = {g0.x, g0.y, g0.z, g0.w}, V2[4] = {v2.x, v2.y, v2.z, v2.w}, V1[4] = {v1.x, v1.y, v1.z, v1.w}, V0[4] = {v0.x, v0.y, v0.z, v0.w};
        float o[8];
#pragma unroll
        for (int e = 0; e < 8; ++e) { const int q = e >> 1; const bool hi = e & 1;
            const float xg2 = hi ? bfhi(G2[q]) : bflo(G2[q]), xg1 = hi ? bfhi(G1[q]) : bflo(G1[q]), xg0 = hi ? bfhi(G0[q]) : bflo(G0[q]);
            const float xv2 = hi ? bfhi(V2[q]) : bflo(V2[q]), xv1 = hi ? bfhi(V1[q]) : bflo(V1[q]), xv0 = hi ? bfhi(V0[q]) : bflo(V0[q]);
            const float cgv = cb[c0 + e] + cw[c0 + e] * xg2 + cw[NUP + c0 + e] * xg1 + cw[2 * NUP + c0 + e] * xg0;
            const float cvv = cb[DFF + c0 + e] + cw[DFF + c0 + e] * xv2 + cw[NUP + DFF + c0 + e] * xv1 + cw[2 * NUP + DFF + c0 + e] * xv0;
            o[e] = cgv * sigmoidf_(cgv) * cvv; }
        *(u32x4*)(ACT + ((size_t)(c0 >> 6) * M + (size_t)(blk * 64 + rw)) * 64 + (c0 & 63)) = (u32x4){pk2(o[0], o[1]), pk2(o[2], o[3]), pk2(o[4], o[5]), pk2(o[6], o[7])};
    }
}

__device__ __forceinline__ int q_next(Frame& F, unsigned* head) {
    __syncthreads();
    if (F.tid == 0) F.MISC[16] = __hip_atomic_fetch_add(head, 1u, __ATOMIC_RELAXED, __HIP_MEMORY_SCOPE_AGENT);
    __syncthreads();
    return __builtin_amdgcn_readfirstlane((int)F.MISC[16]);
}
__device__ __forceinline__ int t5_bucket(int n) {
    if (n < 16) return n;
    int b = 16;
    b += (n >= 19); b += (n >= 21); b += (n >= 24); b += (n >= 27); b += (n >= 31); b += (n >= 35); b += (n >= 40); b += (n >= 46);
    b += (n >= 52); b += (n >= 59); b += (n >= 67); b += (n >= 77); b += (n >= 87); b += (n >= 99); b += (n >= 113);
    return b;
}
__device__ __forceinline__ int crow(int i, int h) { return (i & 3) + 8 * (i >> 2) + 4 * h; }

#define MFMA32(a, b, c) __builtin_amdgcn_mfma_f32_32x32x16_bf16((a), (b), (c), 0, 0, 0)
__device__ __forceinline__ float sum8lanes(float v) { v += __shfl_xor(v, 1); v += __shfl_xor(v, 2); v += __shfl_xor(v, 4); return v; }
__device__ __forceinline__ void norm16(unsigned* pp, const float* gn, float sc) {
    const u32x4 w0 = *(const u32x4*)pp, w1 = *(const u32x4*)(pp + 4); const unsigned w[8] = {w0.x, w0.y, w0.z, w0.w, w1.x, w1.y, w1.z, w1.w};
    float x[16], ss = 0.f;
#pragma unroll
    for (int q = 0; q < 8; ++q) { x[2 * q] = bflo(w[q]); x[2 * q + 1] = bfhi(w[q]); ss += x[2 * q] * x[2 * q] + x[2 * q + 1] * x[2 * q + 1]; }
    const float r = rsqrtf(sum8lanes(ss) * (1.f / HD) + EPS) * sc;
    u32x4 o0, o1;
    o0.x = pk2(x[0] * r * gn[0], x[1] * r * gn[1]); o0.y = pk2(x[2] * r * gn[2], x[3] * r * gn[3]); o0.z = pk2(x[4] * r * gn[4], x[5] * r * gn[5]); o0.w = pk2(x[6] * r * gn[6], x[7] * r * gn[7]);
    o1.x = pk2(x[8] * r * gn[8], x[9] * r * gn[9]); o1.y = pk2(x[10] * r * gn[10], x[11] * r * gn[11]); o1.z = pk2(x[12] * r * gn[12], x[13] * r * gn[13]); o1.w = pk2(x[14] * r * gn[14], x[15] * r * gn[15]);
    *(u32x4*)pp = o0; *(u32x4*)(pp + 4) = o1;
}
__device__ __forceinline__ void item_norm(Frame& F, KArgs a, int layer, int it) {
    bf16_t* P = (bf16_t*)(F.ws + WS_P);
    const float* qg = a->in[I_QG] + layer * HD; const float* kg = a->in[I_KG] + layer * 3 * HD;
    const int lane = F.lane, e0 = (lane & 7) * 16;
    float gq[16], gk[16];
#pragma unroll
    for (int e = 0; e < 16; ++e) { gq[e] = qg[e0 + e]; gk[e] = kg[((lane >> 4) & 1 ? 2 : 1) * HD + e0 + e]; }
    for (int rr = 0; rr < 8; ++rr) {
        bf16_t* pr = P + (size_t)(it * 64 + F.wave * 8 + rr) * NPC;
        norm16((unsigned*)(pr + PQN + lane * 16), gq, QSCALE);
        if (lane < 32) norm16((unsigned*)(pr + (lane < 16 ? PKS + lane * 16 : PKW + (lane - 16) * 16)), gk, 1.f);
    }
}
__device__ __forceinline__ void item_hgfin(Frame& F, KArgs a, int layer, int it) {
    const bf16_t* P = (const bf16_t*)(F.ws + WS_P); const float* OR = (const float*)(F.ws + WS_ORAW); bf16_t* OH = (bf16_t*)(F.ws + WS_OBR) + 2 * BW;
    const float* ng = a->in[I_HNG] + layer * HD; const int lane = F.lane, e0 = (lane & 7) * 16;
    float gn[16];
#pragma unroll
    for (int e = 0; e < 16; ++e) gn[e] = ng[e0 + e];
    for (int rr = 0; rr < 8; ++rr) { const size_t row = (size_t)(it * 64 + F.wave * 8 + rr);
        const f32x4* op = (const f32x4*)(OR + row * BW + lane * 16); const f32x4 o0 = op[0], o1 = op[1], o2 = op[2], o3 = op[3];
        const unsigned* gp = (const unsigned*)(P + row * NPC + PGH + lane * 16); const u32x4 g0 = *(const u32x4*)gp, g1 = *(const u32x4*)(gp + 4);
        const float x[16] = {o0.x, o0.y, o0.z, o0.w, o1.x, o1.y, o1.z, o1.w, o2.x, o2.y, o2.z, o2.w, o3.x, o3.y, o3.z, o3.w}; const unsigned gw[8] = {g0.x, g0.y, g0.z, g0.w, g1.x, g1.y, g1.z, g1.w};
        float ss = 0.f;
#pragma unroll
        for (int e = 0; e < 16; ++e) ss += x[e] * x[e];
        const float r = rsqrtf(sum8lanes(ss) * (1.f / HD) + EPS);
        unsigned ow[8];
#pragma unroll
        for (int q = 0; q < 8; ++q) ow[q] = pk2(x[2 * q] * r * gn[2 * q] * sigmoidf_(bflo(gw[q])), x[2 * q + 1] * r * gn[2 * q + 1] * sigmoidf_(bfhi(gw[q])));
        unsigned* dst = (unsigned*)(OH + row * (3 * BW) + lane * 16);
        *(u32x4*)dst = (u32x4){ow[0], ow[1], ow[2], ow[3]}; *(u32x4*)(dst + 4) = (u32x4){ow[4], ow[5], ow[6], ow[7]};
    }
}
__device__ __forceinline__ void cvec_item(Frame& F, KArgs a, int layer, int blk) {
    const int j = blk >> 5, ks = blk & 31;
    const float* pos = a->in[I_CPOS] + (size_t)(layer * 2 + j) * 32 * HD; const float* w1 = a->in[I_CW1] + (size_t)(layer * 2 + j) * 32 * HD * HD;
    LAS float* red = (LAS float*)F.lds; const int e = F.tid & 127, sub = F.tid >> 7;
    float acc = 0.f;
#pragma unroll 8
    for (int k = ks * 128 + sub * 32; k < ks * 128 + sub * 32 + 32; ++k) acc += pos[k] * w1[(size_t)k * HD + e];
    __syncthreads(); red[sub * 128 + e] = acc; __syncthreads();
    if (F.tid < 128) ((float*)(F.ctl + CW_CVEC))[(j * 32 + ks) * 128 + F.tid] = (red[F.tid] + red[128 + F.tid]) + (red[256 + F.tid] + red[384 + F.tid]);
    __syncthreads();
}
__device__ __forceinline__ void item_compress(Frame& F, KArgs a, int layer, int id) {
    const int j = id >> 7, rem = id & 127, b = rem >> 3, g = (rem >> 2) & 1, n0 = (rem & 3) * 32;
    const bf16_t* P = (const bf16_t*)(F.ws + WS_P);
    LAS float* red = (LAS float*)F.lds;
    LAS float* hid = (LAS float*)(F.lds + 16384);
    LAS float* outv = (LAS float*)(F.lds + 16384 + 32 * 132 * 4);
    const int tid = F.tid, lane = F.lane, wave = F.wave, r = lane & 31, h = lane >> 5, ct = wave & 3, kh = wave >> 2;
    f32x16 acc;
#pragma unroll
    for (int i = 0; i < 16; ++i) acc[i] = 0.f;
    {
        int trow = 16 * (n0 + r) + 16 * kh; const int tmax = T - 1;
        const bf16_t* Ab = P + (size_t)(b * T) * NPC + (j ? PVC : PKC) + g * HD + 8 * h;
        const bf16_t* Bb = (const bf16_t*)(F.ws + WS_MISC + MISC_WC1) + (size_t)(j * HD + 32 * ct + r) * 4096 + (size_t)(16 * kh) * HD + 8 * h;
        for (int l = 0; l < 16; ++l) { const int t = (trow + l) < tmax ? (trow + l) : tmax; const bf16_t* ap = Ab + (size_t)t * NPC; const bf16_t* bp = Bb + l * HD;
#pragma unroll
            for (int ds = 0; ds < 8; ++ds) { const bf16x8 av = *(const bf16x8*)(ap + 16 * ds), bv = *(const bf16x8*)(bp + 16 * ds); acc = MFMA32(av, bv, acc); } }
    }
    if (kh == 1) {
#pragma unroll
        for (int i = 0; i < 16; ++i) red[(ct * 16 + i) * 64 + lane] = acc[i]; }
    __syncthreads();
    if (kh == 0) { float cv = 0.f; { const float* cp = (const float*)(F.ctl + CW_CVEC) + (size_t)(j * 32) * 128 + 32 * ct + r;
#pragma unroll 8
        for (int q = 0; q < 32; ++q) cv += cp[q * 128]; }
#pragma unroll
        for (int i = 0; i < 16; ++i) { const float x = acc[i] + red[(ct * 16 + i) * 64 + lane] + cv;
            const float y = 0.7978845608028654f * (x + 0.044715f * x * x * x);
            const float th = 1.f - 2.f * fast_rcp(1.f + fast_exp2(2.f * y * LOG2E));
            hid[crow(i, h) * 132 + 32 * ct + r] = 0.5f * x * (1.f + th); } }
    __syncthreads();
    { const int e2 = tid & 127, ng = __builtin_amdgcn_readfirstlane(tid >> 7); const float* w2 = a->in[I_CW2] + (size_t)(layer * 2 + j) * HD * HD + e2;
      float o[8];
#pragma unroll
      for (int q = 0; q < 8; ++q) o[q] = 0.f;
      for (int k = 0; k < 128; k += 4) { const float w0 = w2[(size_t)k * HD], w1 = w2[(size_t)(k + 1) * HD], w2_ = w2[(size_t)(k + 2) * HD], w3 = w2[(size_t)(k + 3) * HD];
#pragma unroll
          for (int q = 0; q < 8; ++q) { const f32x4 hv = *(const LAS f32x4*)(hid + (8 * ng + q) * 132 + k); o[q] += (hv.x * w0 + hv.y * w1) + (hv.z * w2_ + hv.w * w3); } }
#pragma unroll
      for (int q = 0; q < 8; ++q) outv[(8 * ng + q) * 132 + e2] = o[q]; }
    __syncthreads();
    const float* kg0 = a->in[I_KG] + layer * 3 * HD;
#pragma unroll
    for (int q = 0; q < 4; ++q) { const int n = 4 * wave + q; float v0 = outv[n * 132 + 2 * lane], v1 = outv[n * 132 + 2 * lane + 1];
        if (j == 0) { const float ss = wave_sum(v0 * v0 + v1 * v1); const float rr = rsqrtf(ss * (1.f / HD) + EPS); v0 *= rr * kg0[2 * lane]; v1 *= rr * kg0[2 * lane + 1]; }
        if (n0 + n >= 127) { v0 = 0.f; v1 = 0.f; }
        bf16_t* dst = (bf16_t*)(F.ws + WS_MISC + (j ? MISC_VCMP : MISC_KCMP)) + (size_t)((b * 2 + g) * 128 + n0 + n) * HD;
        *((unsigned*)dst + lane) = pk2(v0, v1); }
}
__device__ __forceinline__ float xhalf_sum(float v);
constexpr int HG_Q1 = 0, HG_K1 = 17408, HG_QI = 34816, HG_K2 = 43520, HG_K3T = 52224, HG_VT = 70656, HG_AT = 89088, HG_SB = 98304, HG_TOT = 133120, HG_LB = 135168, HG_SS = 135680;
__device__ __forceinline__ void item_hgrn(Frame& F, KArgs a, int layer, int id) {
    const int b = id >> 3, hh = id & 7;
    const bf16_t* P = (const bf16_t*)(F.ws + WS_P); bf16_t* OH = (bf16_t*)(F.ws + WS_OBR);
    LAS unsigned char* L = F.lds;
    LAS float* tot = (LAS float*)(L + HG_TOT); LAS float* lbs = (LAS float*)(L + HG_LB); LAS float* ssp = (LAS float*)(L + HG_SS);
    const int tid = F.tid, lane = F.lane, wave = F.wave, r = lane & 31, h = lane >> 5;
    if (tid < 128) { const float* hb = a->in[I_HLB] + hh * HD + tid; const float x0 = hb[0], x1 = hb[1024], x2 = hb[2048], x3 = hb[3072];
        const float mx = fmaxf(fmaxf(x0, x1), fmaxf(x2, x3)); const float e0 = __expf(x0 - mx), e1 = __expf(x1 - mx), e2 = __expf(x2 - mx), e3 = __expf(x3 - mx);
        const float inv = 1.f / (e0 + e1 + e2 + e3); float c = 0.f; if (layer >= 1) c += e1; if (layer >= 2) c += e2; if (layer >= 3) c += e3;
        lbs[tid] = fmaxf(c * inv, 0.f); }
    { unsigned zu; asm volatile("v_mov_b32 %0, 0" : "=v"(zu));
      for (int i = tid; i < 34816 / 16; i += 512) *(LAS u32x4*)(L + HG_SB + i * 16) = (u32x4){zu, zu, zu, zu}; }
    f32x16 Sacc[2];
#pragma unroll
    for (int q = 0; q < 2; ++q)
#pragma unroll
        for (int i = 0; i < 16; ++i) Sacc[q][i] = 0.f;
    const int pd = tid & 127, psc = __builtin_amdgcn_readfirstlane(tid >> 7);
    const int srow = tid >> 4, sch = tid & 15;
    const bf16_t* gq = P + (size_t)(b * T + srow) * NPC + PQH + hh * HD + sch * 8; const bf16_t* gf = P + (size_t)(b * T + srow) * NPC + PFH + hh * HD + sch * 8;
    const bf16_t* gv = P + (size_t)(b * T + srow) * NPC + PIH + hh * HD + sch * 8;
    u32x4 rq0 = *(const u32x4*)gq, rq1 = *(const u32x4*)(gq + (size_t)32 * NPC), rf0 = *(const u32x4*)gf, rf1 = *(const u32x4*)(gf + (size_t)32 * NPC), rv0 = *(const u32x4*)gv, rv1 = *(const u32x4*)(gv + (size_t)32 * NPC);
    const int et = wave & 3, tt2 = wave >> 2;
    f32x4 gn4[4]; { const float* ng = a->in[I_HNG] + layer * HD;
#pragma unroll
      for (int g4 = 0; g4 < 4; ++g4) gn4[g4] = *(const f32x4*)(ng + 32 * et + 8 * g4 + 4 * h); }
    u32x2 gw4[4];
    for (int c = 0; c < T / 64; ++c) {
        __syncthreads();
        *(LAS u32x4*)(L + HG_Q1 + srow * 272 + sch * 16) = rq0; *(LAS u32x4*)(L + HG_Q1 + (srow + 32) * 272 + sch * 16) = rq1;
        *(LAS u32x4*)(L + HG_K1 + srow * 272 + sch * 16) = rf0; *(LAS u32x4*)(L + HG_K1 + (srow + 32) * 272 + sch * 16) = rf1;
        { const unsigned v0[4] = {rv0.x, rv0.y, rv0.z, rv0.w}, v1[4] = {rv1.x, rv1.y, rv1.z, rv1.w};
#pragma unroll
          for (int q = 0; q < 4; ++q) { LAS unsigned short* p0 = (LAS unsigned short*)(L + HG_VT + (8 * sch + 2 * q) * 144 + srow * 2); LAS unsigned short* p1 = (LAS unsigned short*)(L + HG_VT + (8 * sch + 2 * q + 1) * 144 + srow * 2);
              p0[0] = (unsigned short)(v0[q] & 0xffffu); p1[0] = (unsigned short)(v0[q] >> 16); p0[32] = (unsigned short)(v1[q] & 0xffffu); p1[32] = (unsigned short)(v1[q] >> 16); } }
        __syncthreads();
        { const bf16_t* gp = P + (size_t)(b * T + 64 * c + 32 * tt2 + r) * NPC + PGH + hh * HD + 32 * et + 4 * h;
#pragma unroll
          for (int g4 = 0; g4 < 4; ++g4) gw4[g4] = *(const u32x2*)(gp + 8 * g4); }
        if (c + 1 < T / 64) { const size_t adv = (size_t)(64 * (c + 1)) * NPC;
            rq0 = *(const u32x4*)(gq + adv); rq1 = *(const u32x4*)(gq + adv + (size_t)32 * NPC); rf0 = *(const u32x4*)(gf + adv); rf1 = *(const u32x4*)(gf + adv + (size_t)32 * NPC);
            rv0 = *(const u32x4*)(gv + adv); rv1 = *(const u32x4*)(gv + adv + (size_t)32 * NPC); }
        float qv[16], kv[16], bl[16];
        { const float lb = lbs[pd]; float run = 0.f;
#pragma unroll
          for (int tt = 0; tt < 16; ++tt) { const int t = 16 * psc + tt;
              qv[tt] = bf2f(*(const LAS unsigned short*)(L + HG_Q1 + t * 272 + pd * 2)); const float fp = bf2f(*(const LAS unsigned short*)(L + HG_K1 + t * 272 + pd * 2));
              const float ex = fast_exp2(-fabsf(fp) * LOG2E);
              const float sg = (fp >= 0.f ? 1.f : ex) * fast_rcp(1.f + ex);
              const float f = lb + (1.f - lb) * sg; kv[tt] = 1.f - f;
              const float lf = (layer == 0) ? (fminf(fp, 0.f) - LN2 * fast_log2(1.f + ex)) : LN2 * fast_log2(f);
              run += lf; bl[tt] = run; }
          tot[psc * 128 + pd] = run; }
        __syncthreads();
        { const float t0 = tot[pd], t1 = tot[128 + pd], t2 = tot[256 + pd], t3 = tot[384 + pd];
          const float b31 = t0 + t1, b63 = (t0 + t1) + (t2 + t3);
          const float pre = psc == 0 ? 0.f : (psc == 1 ? t0 : (psc == 2 ? b31 : b31 + t2));
          const float rref = psc >= 2 ? b31 : 0.f; const float eb31 = fast_exp2(b31 * LOG2E), c3 = fast_exp2((b63 - rref) * LOG2E);
          unsigned k3w[8];
#pragma unroll
          for (int tt = 0; tt < 16; ++tt) { const int t = 16 * psc + tt; const float bb = pre + bl[tt];
              const float e1 = fast_exp2((bb - rref) * LOG2E); const float q1 = qv[tt] * e1;
              const float k1 = kv[tt] * fast_exp2(fminf(rref - bb, 80.f) * LOG2E);
              const float k3 = k1 * c3;
              *(LAS unsigned short*)(L + HG_Q1 + t * 272 + pd * 2) = (unsigned short)(pk2(q1, 0.f) & 0xffffu);
              *(LAS unsigned short*)(L + HG_K1 + t * 272 + pd * 2) = (unsigned short)(pk2(k1, 0.f) & 0xffffu);
              if (psc >= 2) *(LAS unsigned short*)(L + HG_QI + (t - 32) * 272 + pd * 2) = (unsigned short)(pk2(q1 * eb31, 0.f) & 0xffffu);
              else *(LAS unsigned short*)(L + HG_K2 + t * 272 + pd * 2) = (unsigned short)(pk2(k1 * eb31, 0.f) & 0xffffu);
              if (tt & 1) k3w[tt >> 1] = (k3w[tt >> 1] & 0xffffu) | (pk2(0.f, k3) & 0xffff0000u); else k3w[tt >> 1] = pk2(k3, 0.f) & 0xffffu; }
          *(LAS u32x4*)(L + HG_K3T + pd * 144 + psc * 32) = (u32x4){k3w[0], k3w[1], k3w[2], k3w[3]}; *(LAS u32x4*)(L + HG_K3T + pd * 144 + psc * 32 + 16) = (u32x4){k3w[4], k3w[5], k3w[6], k3w[7]}; }
        __syncthreads();
        if (wave < 3) {
            const int st = wave == 1 ? 1 : 0, ta = wave == 0 ? 0 : 1;
            const LAS unsigned char* Kb = L + (wave == 2 ? HG_K2 : HG_K1 + st * 32 * 272) + r * 272 + 16 * h; const LAS unsigned char* Qb = L + HG_Q1 + (32 * ta + r) * 272 + 16 * h;
            f32x16 at;
#pragma unroll
            for (int i = 0; i < 16; ++i) at[i] = 0.f;
#pragma unroll
            for (int s8 = 0; s8 < 8; ++s8) at = MFMA32(*(const LAS bf16x8*)(Kb + 32 * s8), *(const LAS bf16x8*)(Qb + 32 * s8), at);
            if (wave < 2) {
#pragma unroll
                for (int i = 0; i < 16; ++i) at[i] = (crow(i, h) <= r) ? at[i] : 0.f; }
#pragma unroll
            for (int g4 = 0; g4 < 4; ++g4) { u32x2 w; w.x = pk2(at[4 * g4], at[4 * g4 + 1]); w.y = pk2(at[4 * g4 + 2], at[4 * g4 + 3]);
                *(LAS u32x2*)(L + HG_AT + (32 * ta + r) * 144 + (32 * st + 8 * g4 + 4 * h) * 2) = w; }
        }
        f32x16 oo;
#pragma unroll
        for (int i = 0; i < 16; ++i) oo[i] = 0.f;
        { const LAS unsigned char* Sb = L + HG_SB + (32 * et + r) * 272 + 16 * h; const LAS unsigned char* Qb = L + (tt2 ? HG_QI : HG_Q1) + r * 272 + 16 * h;
#pragma unroll
          for (int s8 = 0; s8 < 8; ++s8) oo = MFMA32(*(const LAS bf16x8*)(Sb + 32 * s8), *(const LAS bf16x8*)(Qb + 32 * s8), oo); }
        __syncthreads();
#pragma unroll
        for (int q = 0; q < 2; ++q) { const int dt = (wave >> 2) + 2 * q, dd = 32 * dt + r;
            const float eb63 = fast_exp2(((tot[dd] + tot[128 + dd]) + (tot[256 + dd] + tot[384 + dd])) * LOG2E);
#pragma unroll
            for (int i = 0; i < 16; ++i) Sacc[q][i] *= eb63;
            const LAS unsigned char* Vb = L + HG_VT + (32 * et + r) * 144 + 16 * h; const LAS unsigned char* Kb = L + HG_K3T + dd * 144 + 16 * h;
#pragma unroll
            for (int s4 = 0; s4 < 4; ++s4) Sacc[q] = MFMA32(*(const LAS bf16x8*)(Vb + 32 * s4), *(const LAS bf16x8*)(Kb + 32 * s4), Sacc[q]);
            LAS unsigned char* Sw = L + HG_SB + dd * 2;
#pragma unroll
            for (int i = 0; i < 16; i += 2) { const unsigned w = pk2(Sacc[q][i], Sacc[q][i + 1]);
                *(LAS unsigned short*)(Sw + (32 * et + crow(i, h)) * 272) = (unsigned short)(w & 0xffffu); *(LAS unsigned short*)(Sw + (32 * et + crow(i + 1, h)) * 272) = (unsigned short)(w >> 16); } }
        { const LAS unsigned char* Vb = L + HG_VT + (32 * et + r) * 144 + 16 * h; const LAS unsigned char* Ab = L + HG_AT + (32 * tt2 + r) * 144 + 16 * h;
          oo = MFMA32(*(const LAS bf16x8*)(Vb), *(const LAS bf16x8*)(Ab), oo); oo = MFMA32(*(const LAS bf16x8*)(Vb + 32), *(const LAS bf16x8*)(Ab + 32), oo);
          if (tt2) { oo = MFMA32(*(const LAS bf16x8*)(Vb + 64), *(const LAS bf16x8*)(Ab + 64), oo); oo = MFMA32(*(const LAS bf16x8*)(Vb + 96), *(const LAS bf16x8*)(Ab + 96), oo); } }
        { float ss = 0.f;
#pragma unroll
          for (int i = 0; i < 16; ++i) ss += oo[i] * oo[i];
          ss = xhalf_sum(ss);
          if (h == 0) ssp[(32 * tt2 + r) * 4 + et] = ss; }
        __syncthreads();
        { const f32x4 s4 = *(const LAS f32x4*)(ssp + (32 * tt2 + r) * 4); const float rn = rsqrtf(((s4.x + s4.y) + (s4.z + s4.w)) * (1.f / HD) + EPS);
          const size_t row = (size_t)(b * T + 64 * c + 32 * tt2 + r);
#pragma unroll
          for (int g4 = 0; g4 < 4; ++g4) { const int e0 = 32 * et + 8 * g4 + 4 * h;
              const u32x2 gw = gw4[g4]; const f32x4 gn = gn4[g4];
              u32x2 w; w.x = pk2(oo[4 * g4] * rn * gn.x * sigmoidf_(bflo(gw.x)), oo[4 * g4 + 1] * rn * gn.y * sigmoidf_(bfhi(gw.x)));
              w.y = pk2(oo[4 * g4 + 2] * rn * gn.z * sigmoidf_(bflo(gw.y)), oo[4 * g4 + 3] * rn * gn.w * sigmoidf_(bfhi(gw.y)));
              *(u32x2*)(OH + akm(row, 2 * BW + hh * HD + e0)) = w; } }
    }
}

constexpr int AT_K = 0, AT_V = 32768, AT_TAB = 73728, AT_IMP = 75776, AT_SELM = 109568, AT_MISC = 109824;
constexpr int K_TB = 16384, V_RS = 320, V_TB = 64 * V_RS;
__device__ __forceinline__ unsigned koff(int row, int ch) { return 256u * (unsigned)row + 16u * (unsigned)(ch ^ (((row & 3) << 2) | ((row >> 2) & 3))); }
struct Stg { u32x4 k0, k1, v0, v1; };
__device__ __forceinline__ void stg_load(Stg& s, const bf16_t* Kp, const bf16_t* Vp, int ld, int tid) {
    const int row = tid >> 4, ch = tid & 15;
    s.k0 = *(const u32x4*)(Kp + (size_t)row * ld + ch * 8); s.k1 = *(const u32x4*)(Kp + (size_t)(row + 32) * ld + ch * 8);
    s.v0 = *(const u32x4*)(Vp + (size_t)row * ld + ch * 8); s.v1 = *(const u32x4*)(Vp + (size_t)(row + 32) * ld + ch * 8);
}
__device__ __forceinline__ void stg_write(const Stg& s, LAS unsigned char* L, int tid, int buf) {
    const int row = tid >> 4, ch = tid & 15;
    *(LAS u32x4*)(L + AT_K + buf * K_TB + koff(row, ch)) = s.k0; *(LAS u32x4*)(L + AT_K + buf * K_TB + koff(row + 32, ch)) = s.k1;
    *(LAS u32x4*)(L + AT_V + buf * V_TB + row * V_RS + ch * 16) = s.v0; *(LAS u32x4*)(L + AT_V + buf * V_TB + (row + 32) * V_RS + ch * 16) = s.v1;
}
__device__ __forceinline__ float xhalf_max(float v) { auto rr = __builtin_amdgcn_permlane32_swap(__float_as_uint(v), __float_as_uint(v), false, false); return fmaxf(__uint_as_float(rr[0]), __uint_as_float(rr[1])); }
__device__ __forceinline__ float xhalf_sum(float v) { auto rr = __builtin_amdgcn_permlane32_swap(__float_as_uint(v), __float_as_uint(v), false, false); return __uint_as_float(rr[0]) + __uint_as_float(rr[1]); }
__device__ __forceinline__ float xhalf_get(float v, int h) { auto rr = __builtin_amdgcn_permlane32_swap(__float_as_uint(v), __float_as_uint(v), false, false); return __uint_as_float(h ? rr[0] : rr[1]); }
__device__ __forceinline__ void qk_tile(f32x16& p0, f32x16& p1, const LAS unsigned char* L, int buf, const bf16x8 (&qf)[8], int r, int h) {
#pragma unroll
    for (int i = 0; i < 16; ++i) { p0[i] = 0.f; p1[i] = 0.f; }
    const LAS unsigned char* Kb = L + AT_K + buf * K_TB;
    bf16x8 a0[8], a1[8];
#pragma unroll
    for (int s = 0; s < 8; ++s) { a0[s] = *(const LAS bf16x8*)(Kb + koff(r, 2 * s + h)); a1[s] = *(const LAS bf16x8*)(Kb + koff(r + 32, 2 * s + h)); }
#pragma unroll
    for (int s = 0; s < 8; ++s) { p0 = MFMA32(a0[s], qf[s], p0); p1 = MFMA32(a1[s], qf[s], p1); }
    __builtin_amdgcn_sched_group_barrier(0x100, 4, 0);
#pragma unroll
    for (int i = 0; i < 6; ++i) { __builtin_amdgcn_sched_group_barrier(0x008, 2, 0); __builtin_amdgcn_sched_group_barrier(0x100, 2, 0); }
    __builtin_amdgcn_sched_group_barrier(0x008, 4, 0);
}
__device__ __forceinline__ bf16x8 pack8(const f32x16& p, int s) {
    u32x4 w; w.x = pk2(p[8 * s], p[8 * s + 1]); w.y = pk2(p[8 * s + 2], p[8 * s + 3]); w.z = pk2(p[8 * s + 4], p[8 * s + 5]); w.w = pk2(p[8 * s + 6], p[8 * s + 7]);
    return __builtin_bit_cast(bf16x8, w);
}
__device__ __forceinline__ void pv_tile(f32x16 (&o)[4], const f32x16& p0, const f32x16& p1, const LAS unsigned char* L, int buf, int lane) {
    bf16x8 pb[4]; pb[0] = pack8(p0, 0); pb[1] = pack8(p0, 1); pb[2] = pack8(p1, 0); pb[3] = pack8(p1, 1);
    const LAS unsigned char* vb = L + AT_V + buf * V_TB + (4 * (lane >> 5) + ((lane & 15) >> 2)) * V_RS + ((lane >> 4) & 1) * 32 + (lane & 3) * 8;
    __builtin_amdgcn_sched_barrier(0);
    s16x4 lo[16], hi[16];
#pragma unroll
    for (int c = 0; c < 4; ++c)
#pragma unroll
        for (int s = 0; s < 4; ++s) { lo[4 * c + s] = __builtin_amdgcn_ds_read_tr16_b64_v4i16((LAS s16x4*)(vb + (16 * s) * V_RS + 64 * c)); hi[4 * c + s] = __builtin_amdgcn_ds_read_tr16_b64_v4i16((LAS s16x4*)(vb + (16 * s + 8) * V_RS + 64 * c)); }
#pragma unroll
    for (int c = 0; c < 4; ++c)
#pragma unroll
        for (int s = 0; s < 4; ++s) o[c] = MFMA32(__builtin_shufflevector(lo[4 * c + s], hi[4 * c + s], 0, 1, 2, 3, 4, 5, 6, 7), pb[s], o[c]);
    __builtin_amdgcn_sched_group_barrier(0x100, 4, 1);
#pragma unroll
    for (int i = 0; i < 14; ++i) { __builtin_amdgcn_sched_group_barrier(0x008, 1, 1); __builtin_amdgcn_sched_group_barrier(0x100, 2, 1); }
    __builtin_amdgcn_sched_group_barrier(0x008, 2, 1);
    __builtin_amdgcn_sched_barrier(0);
}
__device__ __forceinline__ void softmax_step(f32x16& p0, f32x16& p1, float& m, float& l, f32x16 (&o)[4]) {
    float mx = p0[0];
#pragma unroll
    for (int i = 1; i < 16; ++i) mx = fmaxf(mx, p0[i]);
#pragma unroll
    for (int i = 0; i < 16; ++i) mx = fmaxf(mx, p1[i]);
    mx = xhalf_max(mx);
    const float mn = fmaxf(m, mx); const float alpha = fast_exp2((m - mn) * LOG2E); m = mn;
    const float mb = mn * LOG2E; float ps = 0.f;
#pragma unroll
    for (int i = 0; i < 16; ++i) { p0[i] = fast_exp2(p0[i] * LOG2E - mb); ps += p0[i]; }
#pragma unroll
    for (int i = 0; i < 16; ++i) { p1[i] = fast_exp2(p1[i] * LOG2E - mb); ps += p1[i]; }
    ps = xhalf_sum(ps);
    l = l * alpha + ps;
    if (!__all(alpha == 1.f)) {
#pragma unroll
        for (int c = 0; c < 4; ++c)
#pragma unroll
            for (int i = 0; i < 16; ++i) o[c][i] *= alpha; }
}
__device__ __forceinline__ void store_ot(const f32x16 (&o)[4], float sc, bf16_t* base, size_t row, int col  , int h, bool add) {
    bf16_t* p0 = base + akm(row, col) + 4 * h;
#pragma unroll
    for (int c = 0; c < 4; ++c)
#pragma unroll
        for (int g4 = 0; g4 < 4; ++g4) { u32x2* p = (u32x2*)(p0 + (size_t)(c >> 1) * ((size_t)M * 64) + 32 * (c & 1) + 8 * g4);
            float v0 = sc * o[c][4 * g4], v1 = sc * o[c][4 * g4 + 1], v2 = sc * o[c][4 * g4 + 2], v3 = sc * o[c][4 * g4 + 3];
            if (add) { const u32x2 w0 = *p; v0 += bflo(w0.x); v1 += bfhi(w0.x); v2 += bflo(w0.y); v3 += bfhi(w0.y); }
            u32x2 w; w.x = pk2(v0, v1); w.y = pk2(v2, v3); *p = w; }
}

__device__ __forceinline__ void item_sb(Frame& F, KArgs a, int item) {
    LAS unsigned char* L = F.lds;
    const int qb = 7 - (item >> 7), rem = item & 127, b = rem >> 3, hh = rem & 7, t0 = qb * 256;
    const int tid = F.tid, lane = F.lane, wave = F.wave, r = lane & 31, h = lane >> 5;
    const int tq = t0 + 32 * wave + r;
    const bf16_t* P = (const bf16_t*)(F.ws + WS_P); const size_t rowq = (size_t)(b * T + tq);
    const bf16_t* Kb = P + (size_t)(b * T) * NPC + PKSB + hh * HD; const bf16_t* Vb = P + (size_t)(b * T) * NPC + PVSB + hh * HD;
    bf16x8 qf[8];
#pragma unroll
    for (int s = 0; s < 8; ++s) qf[s] = *(const bf16x8*)(P + rowq * NPC + PQS + hh * HD + 16 * s + 8 * h);
    f32x16 o[4];
#pragma unroll
    for (int c = 0; c < 4; ++c)
#pragma unroll
        for (int i = 0; i < 16; ++i) o[c][i] = 0.f;
    float C = 0.f; bool wdone = false;
    volatile LAS unsigned* flags = (volatile LAS unsigned*)(L + AT_MISC);
    Stg st; int j = 4 * qb + 3, buf = 0, it = 0;
    stg_load(st, Kb + (size_t)(64 * j) * NPC, Vb + (size_t)(64 * j) * NPC, NPC, tid);
    __syncthreads();
    stg_write(st, L, tid, 0);
    if (j > 0) stg_load(st, Kb + (size_t)(64 * (j - 1)) * NPC, Vb + (size_t)(64 * (j - 1)) * NPC, NPC, tid);
    for (;;) {
        if (lane == 0) flags[(it & 1) * 8 + wave] = wdone ? 1u : 0u;
        __syncthreads();
        unsigned nd = 0;
#pragma unroll
        for (int w = 0; w < 8; ++w) nd += flags[(it & 1) * 8 + w];
        if (__builtin_amdgcn_readfirstlane(nd) == 8u) break;
        if (j > 0) stg_write(st, L, tid, buf ^ 1);
        if (j > 1) stg_load(st, Kb + (size_t)(64 * (j - 2)) * NPC, Vb + (size_t)(64 * (j - 2)) * NPC, NPC, tid);
        const bool active = !wdone && (64 * j <= t0 + 32 * wave + 30);
        if (active) {
            f32x16 p0, p1; qk_tile(p0, p1, L, buf, qf, r, h);
            float lm0[16], lm1[16];
            const int kb = 64 * j + 4 * h;
#pragma unroll
            for (int i = 0; i < 16; ++i) {
                const int key0 = kb + (i & 3) + 8 * (i >> 2);
                { const float z = p0[i] * QSCALE; const float sp = fmaxf(z, 0.f) + LN2 * fast_log2(1.f + fast_exp2(-fabsf(z) * LOG2E)); const bool cz = key0 < tq; lm0[i] = cz ? -sp : 0.f; p0[i] = z - sp; }
                { const float z = p1[i] * QSCALE; const float sp = fmaxf(z, 0.f) + LN2 * fast_log2(1.f + fast_exp2(-fabsf(z) * LOG2E)); const bool cz = key0 + 32 < tq; lm1[i] = cz ? -sp : 0.f; p1[i] = z - sp; }
            }
            float Tm[2][4], Tr[2][4];
#pragma unroll
            for (int g4 = 0; g4 < 4; ++g4) { Tm[0][g4] = (lm0[4 * g4] + lm0[4 * g4 + 1]) + (lm0[4 * g4 + 2] + lm0[4 * g4 + 3]); Tm[1][g4] = (lm1[4 * g4] + lm1[4 * g4 + 1]) + (lm1[4 * g4 + 2] + lm1[4 * g4 + 3]); }
#pragma unroll
            for (int k = 0; k < 2; ++k)
#pragma unroll
                for (int g4 = 0; g4 < 4; ++g4) Tr[k][g4] = xhalf_get(Tm[k][g4], h);
            float aft[2][4]; float run = C;
#pragma unroll
            for (int G = 15; G >= 0; --G) { const int k = G >> 3, g4 = (G >> 1) & 3, par = G & 1;
                const float tg = (par == 1) ? (h ? Tm[k][g4] : Tr[k][g4]) : (h ? Tr[k][g4] : Tm[k][g4]);
                if (par == 1) { if (h) aft[k][g4] = run; } else { if (!h) aft[k][g4] = run; }
                run += tg; }
            C = run;
#pragma unroll
            for (int g4 = 0; g4 < 4; ++g4) {
                { float ca = aft[0][g4];
#pragma unroll
                  for (int e = 3; e >= 0; --e) { const int i = 4 * g4 + e; const float la = p0[i] + ca; ca += lm0[i]; p0[i] = (kb + e + 8 * g4 < tq) ? fast_exp2(la * LOG2E) : 0.f; } }
                { float ca = aft[1][g4];
#pragma unroll
                  for (int e = 3; e >= 0; --e) { const int i = 4 * g4 + e; const float la = p1[i] + ca; ca += lm1[i]; p1[i] = (kb + 32 + e + 8 * g4 < tq) ? fast_exp2(la * LOG2E) : 0.f; } }
            }
            pv_tile(o, p0, p1, L, buf, lane);
            wdone = __all(C < -104.f);
        }
        if (j == 0) break;
        --j; buf ^= 1; ++it;
    }
    store_ot(o, 1.f, (bf16_t*)(F.ws + WS_OBR), rowq, BW + hh * HD, h, false);
}

__device__ __forceinline__ void item_nsa(Frame& F, KArgs a, int item) {
    LAS unsigned char* L = F.lds;
    const int qblk = 31 - (item >> 5), rem = item & 31, b = rem >> 1, g = rem & 1, t0 = qblk * 64;
    const int tid = F.tid, lane = F.lane, wave = F.wave, r = lane & 31, h = lane >> 5, hr = wave >> 1, th = wave & 1;
    const int tl = 32 * th + r, tq = t0 + tl, hq = g * 4 + hr;
    const bf16_t* P = (const bf16_t*)(F.ws + WS_P);
    LAS float* tab = (LAS float*)(L + AT_TAB); LAS float* imp = (LAS float*)(L + AT_IMP); volatile LAS unsigned* selm = (volatile LAS unsigned*)(L + AT_SELM); LAS unsigned* misc = (LAS unsigned*)(L + AT_MISC);
    { const int hh = tid >> 7, dd = tid & 127; tab[tid] = a->in[I_RELB][t5_bucket(dd) * 8 + g * 4 + hh]; }
    if (tid == 0) misc[0] = 0u;
    bf16x8 qf[8];
#pragma unroll
    for (int s = 0; s < 8; ++s) qf[s] = *(const bf16x8*)(P + (size_t)(b * T + tq) * NPC + PQN + hq * HD + 16 * s + 8 * h);
    f32x16 o[4];
    Stg st;
    auto opq = [](int v) { asm volatile("" : "+v"(v)); return v; };
#define NSA_GATE(i) sigmoidf_(bf2f(P[((size_t)(b * T + opq(tq))) * NPC + PGN + hq * 3 + (i)]))
#define NSA_OUT() (bf16_t*)(F.ws + WS_OBR), (size_t)(b * T + opq(tq)), hq * HD
    {
        const bf16_t* kc = (const bf16_t*)(F.ws + WS_MISC + MISC_KCMP) + (size_t)((b * 2 + g) * 128) * HD; const bf16_t* vc = (const bf16_t*)(F.ws + WS_MISC + MISC_VCMP) + (size_t)((b * 2 + g) * 128) * HD;
        const bool two = qblk >= 16;
        f32x16 pc[4];
        __syncthreads();
        { Stg st1; stg_load(st, kc, vc, HD, tid); if (two) stg_load(st1, kc + 64 * HD, vc + 64 * HD, HD, tid);
          stg_write(st, L, tid, 0); if (two) stg_write(st1, L, tid, 1); }
        __syncthreads();
        qk_tile(pc[0], pc[1], L, 0, qf, r, h);
        if (two) qk_tile(pc[2], pc[3], L, 1, qf, r, h);
        float mx = -1e30f;
#pragma unroll
        for (int k = 0; k < 4; ++k) { if (k >= 2 && !two) break;
#pragma unroll
            for (int i = 0; i < 16; ++i) { const int n = 32 * k + crow(i, h); const int dc = tq - (16 * n + 31); const int di = dc < 113 ? dc : 113;
                const float sv = dc >= 0 ? pc[k][i] + tab[hr * 128 + (di < 0 ? 0 : di)] : -__builtin_inff(); pc[k][i] = sv; mx = fmaxf(mx, sv); } }
        mx = xhalf_max(mx);
        float sum = 0.f;
#pragma unroll
        for (int k = 0; k < 4; ++k) { if (k >= 2 && !two) break;
#pragma unroll
            for (int i = 0; i < 16; ++i) { const float e = fast_exp2((pc[k][i] - mx) * LOG2E); pc[k][i] = e; sum += e; } }
        sum = xhalf_sum(sum);
        const float inv = 1.f / fmaxf(sum, 1e-30f);
#pragma unroll
        for (int k = 0; k < 4; ++k)
#pragma unroll
            for (int i = 0; i < 16; ++i) pc[k][i] = (k >= 2 && !two) ? 0.f : pc[k][i] * inv;
        float gs[16], gl[16], rc[16];
#pragma unroll
        for (int k = 0; k < 4; ++k)
#pragma unroll
            for (int g4 = 0; g4 < 4; ++g4) { gs[4 * k + g4] = (pc[k][4 * g4] + pc[k][4 * g4 + 1]) + (pc[k][4 * g4 + 2] + pc[k][4 * g4 + 3]); gl[4 * k + g4] = pc[k][4 * g4 + 3]; }
#pragma unroll
        for (int f = 0; f < 16; ++f) rc[f] = xhalf_get(gl[f], h);
#pragma unroll
        for (int f = 0; f < 16; ++f) { const float prev = h ? rc[f] : (f >= 1 ? rc[f - 1] : 0.f); const int G = 8 * (f >> 2) + 2 * (f & 3) + h;
            imp[(hr * 64 + tl) * 33 + G] = gs[f] + prev; }
#pragma unroll
        for (int c = 0; c < 4; ++c)
#pragma unroll
            for (int i = 0; i < 16; ++i) o[c][i] = 0.f;
        pv_tile(o, pc[0], pc[1], L, 0, lane);
        if (two) pv_tile(o, pc[2], pc[3], L, 1, lane);
        store_ot(o, NSA_GATE(0), NSA_OUT(), h, false);
    }
    __syncthreads();
    const int tk = tid >> 3, part = tid & 7;
    if (qblk >= 16) {
#pragma unroll
        for (int q = 0; q < 4; ++q) { const int jj = part + 8 * q; imp[tk * 33 + jj] = (imp[tk * 33 + jj] + imp[(64 + tk) * 33 + jj]) + (imp[(128 + tk) * 33 + jj] + imp[(192 + tk) * 33 + jj]); }
    }
    __syncthreads();
    {
        unsigned msk;
        if (qblk < 16) msk = (2u << qblk) - 1u;
        else {
            msk = 0u;
#pragma unroll
            for (int q = 0; q < 4; ++q) { const int jj = part + 8 * q;
                if (jj >= 1 && jj <= qblk - 2) { const float v = imp[tk * 33 + jj]; int rank = 0;
#pragma unroll
                    for (int j2 = 1; j2 < 30; ++j2) { const float v2 = imp[tk * 33 + j2]; rank += (j2 <= qblk - 2 && (v2 > v || (v2 == v && j2 < jj))) ? 1 : 0; }
                    if (rank < 13) msk |= 1u << jj; } }
            msk |= (unsigned)__shfl_xor((int)msk, 1); msk |= (unsigned)__shfl_xor((int)msk, 2); msk |= (unsigned)__shfl_xor((int)msk, 4);
            msk |= 1u | (1u << (qblk - 1)) | (1u << qblk);
        }
        if (part == 0) selm[tk] = msk;
        unsigned om = msk;
#pragma unroll
        for (int off = 8; off < 64; off <<= 1) om |= (unsigned)__shfl_xor((int)om, off);
        if (lane == 0) __hip_atomic_fetch_or(misc, om, __ATOMIC_RELAXED, __HIP_MEMORY_SCOPE_WORKGROUP);
    }
    __syncthreads();
    const bf16_t* Kbase = P + (size_t)(b * T) * NPC + g * HD;
    const float bfar = tab[hr * 128 + 113];
    for (int rep = 0; rep < (MK_PROBE == 31 ? 2 : 1); ++rep) {
        if (rep) __syncthreads();
        unsigned om = __builtin_amdgcn_readfirstlane(misc[0]); const unsigned mym = selm[tl];
        float m = -1e30f, l = 0.f;
#pragma unroll
        for (int c = 0; c < 4; ++c)
#pragma unroll
            for (int i = 0; i < 16; ++i) o[c][i] = 0.f;
        int jc = __builtin_ctz(om); om &= om - 1u;
        stg_load(st, Kbase + PKS + (size_t)(64 * jc) * NPC, Kbase + PVS + (size_t)(64 * jc) * NPC, NPC, tid);
        stg_write(st, L, tid, 0);
        int jn = om ? __builtin_ctz(om) : -1; if (jn >= 0) { om &= om - 1u; stg_load(st, Kbase + PKS + (size_t)(64 * jn) * NPC, Kbase + PVS + (size_t)(64 * jn) * NPC, NPC, tid); }
        int buf = 0;
        for (;;) {
            __syncthreads();
            if (jn >= 0) stg_write(st, L, tid, buf ^ 1);
            const int jnn = om ? __builtin_ctz(om) : -1; if (jnn >= 0) { om &= om - 1u; stg_load(st, Kbase + PKS + (size_t)(64 * jnn) * NPC, Kbase + PVS + (size_t)(64 * jnn) * NPC, NPC, tid); }
            f32x16 p0, p1; qk_tile(p0, p1, L, buf, qf, r, h);
            const bool sel = (mym >> jc) & 1u;
            if (jc <= qblk - 3) {
#pragma unroll
                for (int i = 0; i < 16; ++i) { p0[i] = sel ? p0[i] + bfar : -__builtin_inff(); p1[i] = sel ? p1[i] + bfar : -__builtin_inff(); }
            } else {
#pragma unroll
                for (int i = 0; i < 16; ++i) { const int d0 = tq - (64 * jc + crow(i, h)), d1 = d0 - 32;
                    const float b0 = tab[hr * 128 + (d0 < 0 ? 0 : (d0 > 113 ? 113 : d0))], b1 = tab[hr * 128 + (d1 < 0 ? 0 : (d1 > 113 ? 113 : d1))];
                    p0[i] = (sel && d0 >= 0) ? p0[i] + b0 : -__builtin_inff(); p1[i] = (sel && d1 >= 0) ? p1[i] + b1 : -__builtin_inff(); }
            }
            softmax_step(p0, p1, m, l, o);
            pv_tile(o, p0, p1, L, buf, lane);
            if (jn < 0) break;
            jc = jn; jn = jnn; buf ^= 1;
        }
        if (rep == (MK_PROBE == 31 ? 1 : 0)) store_ot(o, NSA_GATE(1) / l, NSA_OUT(), h, true);
    }
    for (int rep = 0; rep < (MK_PROBE == 32 ? 2 : 1); ++rep) {
        float m = -1e30f, l = 0.f;
#pragma unroll
        for (int c = 0; c < 4; ++c)
#pragma unroll
            for (int i = 0; i < 16; ++i) o[c][i] = 0.f;
        int jc = qblk >= 8 ? qblk - 8 : 0;
        stg_load(st, Kbase + PKW + (size_t)(64 * jc) * NPC, Kbase + PVW + (size_t)(64 * jc) * NPC, NPC, tid);
        __syncthreads();
        stg_write(st, L, tid, 0);
        if (jc < qblk) stg_load(st, Kbase + PKW + (size_t)(64 * (jc + 1)) * NPC, Kbase + PVW + (size_t)(64 * (jc + 1)) * NPC, NPC, tid);
        int buf = 0;
        for (;;) {
            __syncthreads();
            if (jc < qblk) stg_write(st, L, tid, buf ^ 1);
            if (jc + 1 < qblk) stg_load(st, Kbase + PKW + (size_t)(64 * (jc + 2)) * NPC, Kbase + PVW + (size_t)(64 * (jc + 2)) * NPC, NPC, tid);
            f32x16 p0, p1; qk_tile(p0, p1, L, buf, qf, r, h);
            if (jc <= qblk - 3 && jc >= qblk - 7) {
#pragma unroll
                for (int i = 0; i < 16; ++i) { p0[i] += bfar; p1[i] += bfar; }
            } else {
                const bool far = jc <= qblk - 3;
#pragma unroll
                for (int i = 0; i < 16; ++i) { const int d0 = tq - (64 * jc + crow(i, h)), d1 = d0 - 32;
                    const float b0 = far ? bfar : tab[hr * 128 + (d0 < 0 ? 0 : (d0 > 113 ? 113 : d0))], b1 = far ? bfar : tab[hr * 128 + (d1 < 0 ? 0 : (d1 > 113 ? 113 : d1))];
                    p0[i] = ((unsigned)d0 < 512u) ? p0[i] + b0 : -__builtin_inff(); p1[i] = ((unsigned)d1 < 512u) ? p1[i] + b1 : -__builtin_inff(); }
            }
            softmax_step(p0, p1, m, l, o);
            pv_tile(o, p0, p1, L, buf, lane);
            if (jc == qblk) break;
            ++jc; buf ^= 1;
        }
        if (rep == (MK_PROBE == 32 ? 1 : 0)) store_ot(o, NSA_GATE(2) / l, NSA_OUT(), h, true);
    }
#undef NSA_GATE
#undef NSA_OUT
}

constexpr int NI_H = 128, NI_S = 1024, NI_C = 256, NI_N = 512, NI_A = 1024;
#define FRESH_F() do { unsigned on_ = ~0u; asm volatile("" : "+s"(on_)); int t_ = F.wave * 64 + (int)__builtin_amdgcn_mbcnt_hi(on_, __builtin_amdgcn_mbcnt_lo(on_, 0u)); asm volatile("" : "+v"(t_)); F.tid = t_; F.lane = t_ & 63; F.wave = __builtin_amdgcn_readfirstlane(t_ >> 6); } while (0)
__device__ __forceinline__ void phase_Ca(Frame& F, KArgs a, int layer, int bank, int types) {
    unsigned* head = F.ctl + CW_QUEUE + 64 * (layer * 8) + bank * 4096;
    if (types & 1) for (;;) { const int it = q_next(F, head + 0); if (it >= NI_H) break; FRESH_F(); item_hgrn(F, a, layer, it); }
    if (types & 2) for (;;) { const int it = q_next(F, head + 64); if (it >= NI_S) break; FRESH_F(); item_sb(F, a, it); }
    if (types & 4) for (;;) { const int it = q_next(F, head + 128); if (it >= NI_C) break; FRESH_F(); item_compress(F, a, layer, it); }
    if (types & 8) for (;;) { const int it = q_next(F, head + 192); if (it >= NI_N) break; FRESH_F(); item_norm(F, a, layer, it); }
}
__device__ __forceinline__ void phase_Cb(Frame& F, KArgs a, int layer, int bank) {
    unsigned* head = F.ctl + CW_QUEUE + 64 * (layer * 8 + 4) + bank * 4096;
    for (;;) { const int it = q_next(F, head + 0); if (it >= NI_A) break; FRESH_F(); item_nsa(F, a, it); }
}

__global__ void __launch_bounds__(512, 2) mega(Args karg) {
    extern __shared__ __attribute__((aligned(16))) unsigned char lds_raw[];
    Frame F;
    F.lds = (LAS unsigned char*)lds_raw; F.MISC = (volatile LAS unsigned*)(F.lds + MISC_OFF);
    F.tid = threadIdx.x; F.lane = F.tid & 63; F.wave = __builtin_amdgcn_readfirstlane(F.tid >> 6); F.G = gridDim.x; F.bid = blockIdx.x;
    KArgs a = (KArgs)__builtin_amdgcn_kernarg_segment_ptr();
    F.ws = a->ws; F.ctl = (unsigned*)(a->ws + WS_CTL);
    if (F.tid < 64) F.MISC[F.tid] = 0u;
    __syncthreads();
    const int lo = karg.ph_lo, hi = karg.ph_hi;
    XcdBarrier bar; bar.bar = F.ctl + CW_BAR; bar.x = 0; bar.st = F.MISC + 8;
    if (hi - lo > 1) bar = xcd_barrier_post(F.ctl + CW_BAR, F.MISC + 8);
#define IN(k) (lo <= (k) && (k) < hi)
#define ON(k) (((MK_PHASE_MASK & MK_BUILD_MASK) >> (k)) & 1)
#define GRID_BAR() do { unsigned* bp_ = (unsigned*)(a->ws + WS_CTL) + CW_BAR; asm volatile("" : "+s"(bp_)); bar.bar = bp_; xcd_barrier(bar); } while (0)
#define SEAM(k) do { if (IN(k) && IN((k) + 1)) GRID_BAR(); } while (0)
    bf16_t* Hb; bf16_t* Pb; const int wave_s = __builtin_amdgcn_readfirstlane(threadIdx.x >> 6);
    for (int layer = 0; layer < DEPTH; ++layer) {
        const int pb = layer * 10;
#define FRESH() do { unsigned on_ = ~0u; asm volatile("" : "+s"(on_)); int t_ = wave_s * 64 + (int)__builtin_amdgcn_mbcnt_hi(on_, __builtin_amdgcn_mbcnt_lo(on_, 0u)); asm volatile("" : "+v"(t_)); F.tid = t_; F.lane = t_ & 63; F.wave = __builtin_amdgcn_readfirstlane(t_ >> 6); \
        asm volatile("" : "+s"(a)); F.ws = a->ws; F.ctl = (unsigned*)(a->ws + WS_CTL); Hb = (bf16_t*)(F.ws + WS_H); Pb = (bf16_t*)(F.ws + WS_P); } while (0)
        if (ON(0) && IN(pb + 0)) { FRESH(); if (MK_PROBE == 0) { phase_A(F, a, layer); GRID_BAR(); } phase_A(F, a, layer); } SEAM(pb + 0);
        if (ON(1) && IN(pb + 1)) for (int rep = 0; rep < (MK_PROBE == 1 ? 2 : 1); ++rep) { FRESH();
            if (rep) GRID_BAR();
            if (MK_STAGGER) { const unsigned long long t0 = __builtin_amdgcn_s_memrealtime(), dl = (unsigned long long)((F.bid >> 3) & 7) * MK_STAGGER; while (__builtin_amdgcn_s_memrealtime() - t0 < dl) __builtin_amdgcn_s_sleep(4); }
            pg8::Gemm g{(const bf16_t*)(F.ws + WS_XB), (const bf16_t*)(F.ws + WS_WIN), M, NPC, DM, 1, 1}; pg8::StaticOrder S; S.init(M, NPC, F.G, F.bid);
            pg8::EpiStoreBf16 E{Pb, NPC, PGT / 256, PGN / 256, (const float*)(F.ws + WS_RSTD), (LAS const float*)(F.lds + pg8::LRS_OFF)};
            pg8::gemm_phase<pg8::EpiStoreBf16, pg8::StaticOrder, PG8_ALIGN, PG8_SP2>(F.lds, g, S, E, F.tid, (MK_DIAG && layer == 0 && F.bid == 0) ? (unsigned long long*)(F.ctl + 49152) : nullptr);
        } SEAM(pb + 1);
        if (ON(2) && IN(pb + 2)) { FRESH(); if (MK_PROBE >= 20 && MK_PROBE < 28) { phase_Ca(F, a, layer, 1, MK_PROBE - 20); GRID_BAR(); } phase_Ca(F, a, layer, 0, 15); } SEAM(pb + 2);
        if (ON(3) && IN(pb + 3)) { FRESH(); if (MK_PROBE == 3) { phase_Cb(F, a, layer, 1); GRID_BAR(); } phase_Cb(F, a, layer, 0); } SEAM(pb + 3);
        if (ON(4) && IN(pb + 4)) for (int rep = 0; rep < (MK_PROBE == 4 ? 2 : 1); ++rep) { FRESH();
            if (rep) GRID_BAR();
            pg8::Gemm g{(const bf16_t*)(F.ws + WS_OBR), (const bf16_t*)(F.ws + WS_WBR), M, DM, 3 * BW, 1, 1}; pg8::StaticOrder S; S.init(M, DM, F.G, F.bid);
            pg8::EpiGated E{Pb, Hb};
            pg8::gemm_phase<pg8::EpiGated, pg8::StaticOrder, PG8_ALIGN, PG8_SP2>(F.lds, g, S, E, F.tid);
        } SEAM(pb + 4);
        if (ON(5) && IN(pb + 5)) for (int rep = 0; rep < (MK_PROBE == 5 ? 2 : 1); ++rep) { FRESH();
            if (rep) GRID_BAR();
            pg8::Gemm g{Hb, (const bf16_t*)(F.ws + WS_WOUT), M, DM, DM, 1, 1}; pg8::StaticOrder S; S.init(M, DM, F.G, F.bid);
            pg8::EpiResidBf16 E{(MK_PROBE == 5 && rep == 0) ? (bf16_t*)(F.ws + WS_P) : (bf16_t*)(F.ws + WS_XB), nullptr, (MK_PROBE == 5 && rep == 0) ? (float*)(F.ws + WS_P + 256 * MiB) : (float*)(F.ws + WS_SSQ), DM};
            pg8::gemm_phase<pg8::EpiResidBf16, pg8::StaticOrder, PG8_ALIGN, PG8_SP2>(F.lds, g, S, E, F.tid);
        } SEAM(pb + 5);
        if (ON(6) && IN(pb + 6)) { FRESH(); if (MK_PROBE == 60) { GRID_BAR(); GRID_BAR(); GRID_BAR(); GRID_BAR(); } if (MK_PROBE == 6) { phase_F(F, a); GRID_BAR(); } phase_F(F, a); } SEAM(pb + 6);
        if (ON(7) && IN(pb + 7)) for (int rep = 0; rep < (MK_PROBE == 7 ? 2 : 1); ++rep) { FRESH();
            if (rep) GRID_BAR();
            if (MK_STAGGER) { const unsigned long long t0 = __builtin_amdgcn_s_memrealtime(), dl = (unsigned long long)((F.bid >> 3) & 7) * MK_STAGGER; while (__builtin_amdgcn_s_memrealtime() - t0 < dl) __builtin_amdgcn_s_sleep(4); }
            pg8::Gemm g{(const bf16_t*)(F.ws + WS_XB), (const bf16_t*)(F.ws + WS_WUP), M, NUP, DM, 1, 1}; pg8::StaticOrder S; S.init(M, NUP, F.G, F.bid);
            pg8::EpiConvAct E{F.ws, a, layer, (LAS const float*)(F.lds + pg8::LRS_OFF)};
            pg8::gemm_phase<pg8::EpiConvAct, pg8::StaticOrder, PG8_ALIGN, PG8_SP2>(F.lds, g, S, E, F.tid);
        } SEAM(pb + 7);
        if (ON(8) && IN(pb + 8)) { FRESH(); if (MK_PROBE == 8) { phase_H(F, a, layer); GRID_BAR(); } phase_H(F, a, layer); } SEAM(pb + 8);
        if (ON(9) && IN(pb + 9)) for (int rep = 0; rep < (MK_PROBE == 9 ? 2 : 1); ++rep) { FRESH();
            if (rep) GRID_BAR();
            pg8::Gemm g{(const bf16_t*)(F.ws + WS_ACT), (const bf16_t*)(F.ws + WS_WDN), M, DM, DFF, 1, 1}; pg8::StaticOrder S; S.init(M, DM, F.G, F.bid, 4, 1);
            pg8::EpiResidBf16 E{(MK_PROBE == 9 && rep == 0) ? (bf16_t*)(F.ws + WS_P) : (bf16_t*)(F.ws + WS_XB), (layer == DEPTH - 1 && !(MK_PROBE == 9 && rep == 0)) ? a->out : nullptr, (MK_PROBE == 9 && rep == 0) ? (float*)(F.ws + WS_P + 256 * MiB) : (float*)(F.ws + WS_SSQ), DM};
            pg8::gemm_phase<pg8::EpiResidBf16, pg8::StaticOrder, PG8_ALIGN, PG8_SP2>(F.lds, g, S, E, F.tid);
        } SEAM(pb + 9);
    }
#if MK_DIAG
    GRID_BAR();
    { const unsigned long long* dg = (const unsigned long long*)(F.ctl + 49152); const float kl = (float)(long long)(dg[1] - dg[0]), per = (float)(long long)(dg[2] - dg[0]);
      const float eps = MK_DIAG == 1 ? kl / per : (MK_DIAG == 2 ? per * 1e-4f : kl * 1e-4f);
      for (size_t i = (size_t)F.bid * 512 + threadIdx.x; i < (size_t)M * DM; i += (size_t)F.G * 512) a->out[i] *= (1.f + eps); }
#endif
}

extern "C" void kernel_launch(void* const* d_in, const int* in_sizes, int n_in, void* d_out, int out_size, void* d_ws, size_t ws_size, hipStream_t stream) {
    static int grid = 0;
    if (grid == 0) {
        if (n_in != 18 || in_sizes[0] != M * DM || out_size != M * DM || ws_size < WS_END) { fprintf(stderr, "kernel_launch: unexpected shapes / workspace (%d inputs, ws %zu)\n", n_in, ws_size); grid = -1; return; }
        int dev = 0, cus = 0, per_cu = 0;
        if (hipGetDevice(&dev) != hipSuccess || hipDeviceGetAttribute(&cus, hipDeviceAttributeMultiprocessorCount, dev) != hipSuccess) { grid = -1; return; }
        if (hipFuncSetAttribute((const void*)mega, hipFuncAttributeMaxDynamicSharedMemorySize, LDS_BYTES) != hipSuccess) { grid = -1; return; }
        if (hipOccupancyMaxActiveBlocksPerMultiprocessor(&per_cu, (const void*)mega, 512, LDS_BYTES) != hipSuccess || per_cu < 1) { fprintf(stderr, "kernel_launch: occupancy query says %d\n", per_cu); }
        (void)hipGetLastError();
        grid = cus;
    }
    if (grid < 0) return;
    (void)hipMemsetAsync((char*)d_ws + WS_CTL, 0, CTL_BYTES, stream);
    Args a{};
    for (int i = 0; i < 18; ++i) a.in[i] = (const float*)d_in[i];
    a.out = (float*)d_out; a.ws = (unsigned char*)d_ws;
#if MK_ONE_LAUNCH
    a.ph_lo = 0; a.ph_hi = DEPTH * 10;
    hipLaunchKernelGGL(mega, dim3(grid), dim3(512), LDS_BYTES, stream, a);
#else
    for (int p = 0; p < DEPTH * 10; ++p) { a.ph_lo = p; a.ph_hi = p + 1; hipLaunchKernelGGL(mega, dim3(grid), dim3(512), LDS_BYTES, stream, a); }
#endif
}
```

```cpp
#include <hip/hip_runtime.h>
#include <stdint.h>
#include <stdio.h>

#ifndef MK_ONE_LAUNCH
#define MK_ONE_LAUNCH 1
#endif
#ifndef MK_PHASE_MASK
#define MK_PHASE_MASK 0x3ff
#endif
#ifndef MK_PROBE
#define MK_PROBE -1
#endif
#ifndef MK_STAGGER
#define MK_STAGGER 0
#endif
#ifndef MK_DIAG
#define MK_DIAG 0
#endif
#ifndef MK_BUILD_MASK
#define MK_BUILD_MASK 0x3ff
#endif

#define LAS __attribute__((address_space(3)))
typedef unsigned short bf16_t;
typedef short bf16x8 __attribute__((ext_vector_type(8)));
typedef short s16x4 __attribute__((ext_vector_type(4)));
typedef float f32x4 __attribute__((ext_vector_type(4)));
typedef float f32x16 __attribute__((ext_vector_type(16)));
typedef float f32x2 __attribute__((ext_vector_type(2)));
typedef unsigned u32x4 __attribute__((ext_vector_type(4)));
typedef unsigned u32x2 __attribute__((ext_vector_type(2)));
typedef __bf16 bfv2 __attribute__((ext_vector_type(2)));

constexpr int DM = 2048, NB = 16, T = 2048, DEPTH = 4, M = NB * T, HD = 128;
constexpr int INC = 15896;
constexpr int NPC = 16128;
constexpr int PQN = 0, PKC = 1024, PVC = 1280, PKS = 1536, PVS = 1792, PKW = 2048, PVW = 2304, PQS = 2560, PKSB = 3584, PVSB = 4608,
              PQH = 5632, PFH = 6656, PIH = 7680, PGH = 8704, PGT = 9728, PGN = 15872;
constexpr int DFF = 5632, NUP = 2 * DFF;
constexpr int BW = 1024;
constexpr float EPS = 1e-6f;
constexpr float LOG2E = 1.4426950408889634f, LN2 = 0.6931471805599453f;
constexpr float QSCALE = 0.08838834764831845f;

constexpr size_t MiB = 1u << 20;
constexpr size_t WS_CTL = 0, CTL_BYTES = 1 * MiB;
constexpr size_t WS_WIN = 1 * MiB, WS_WBR = 64 * MiB, WS_WOUT = 76 * MiB, WS_WUP = 84 * MiB, WS_WDN = 128 * MiB;
constexpr size_t WS_MISC = 150 * MiB;
constexpr size_t MISC_KCMP = 0, MISC_VCMP = 1 * MiB, MISC_WC1 = 2 * MiB;
constexpr int CW_CVEC = 32768;
constexpr size_t WS_SCR = 154 * MiB;
constexpr size_t WS_P = 218 * MiB;
constexpr size_t WS_H = 1226 * MiB;
constexpr size_t WS_OBR = 1354 * MiB;
constexpr size_t WS_ORAW = 1546 * MiB;
constexpr size_t WS_XB = 1674 * MiB;
constexpr size_t WS_SSQ = 1802 * MiB;
constexpr size_t WS_RSTD = 1806 * MiB;
constexpr size_t WS_USIDE = 1807 * MiB;
constexpr size_t WS_END = 1853 * MiB;
constexpr size_t WS_ACT = WS_P + 704 * MiB;
constexpr int CW_BAR = 4096;
constexpr int CW_QUEUE = 16384;

constexpr int RING_BYTES = 131072;
constexpr int MISC_OFF = 147456 - 256;
constexpr int LDS_BYTES = 147456;

__device__ __forceinline__ float bf2f(unsigned short b) { return __uint_as_float(((unsigned)b) << 16); }
__device__ __forceinline__ float bflo(unsigned w) { return __uint_as_float(w << 16); }
__device__ __forceinline__ float bfhi(unsigned w) { return __uint_as_float(w & 0xffff0000u); }
__device__ __forceinline__ unsigned pk2(float lo, float hi) { f32x2 v = {lo, hi}; bfv2 b = __builtin_convertvector(v, bfv2); return __builtin_bit_cast(unsigned, b); }
__device__ __forceinline__ float wave_sum(float v) {
#pragma unroll
    for (int o = 1; o < 64; o <<= 1) v += __shfl_xor(v, o);
    return v;
}
__device__ __forceinline__ float fast_exp2(float x) { return __builtin_amdgcn_exp2f(x); }
__device__ __forceinline__ float fast_log2(float x) { return __builtin_amdgcn_logf(x); }
__device__ __forceinline__ float fast_rcp(float x) { return __builtin_amdgcn_rcpf(x); }
__device__ __forceinline__ float sigmoidf_(float x) { return fast_rcp(1.f + fast_exp2(-x * LOG2E)); }
#define LDS_WAIT() asm volatile("s_waitcnt lgkmcnt(0)" ::: "memory")
__device__ __forceinline__ size_t akm(size_t row, int col) { return ((size_t)(col >> 6) * M + row) * 64 + (col & 63); }

#define XB_TMO      128
#define XB_XCNT(j)  (256  + 64 * (j))
#define XB_XSUB(j)  (1280 + 64 * (j))
#define XB_XGEN(j)  (2304 + 64 * (j))
#define XB_TOP      3328
#define XB_TOPGEN   3392
#define XCD_BAR_WORDS 3456
#define XB_SPIN_CAP (1u << 22)
__device__ __forceinline__ unsigned xb_ld(unsigned* p)              { return __hip_atomic_load(p, __ATOMIC_RELAXED, __HIP_MEMORY_SCOPE_AGENT); }
__device__ __forceinline__ unsigned xb_add(unsigned* p, unsigned v) { return __hip_atomic_fetch_add(p, v, __ATOMIC_RELAXED, __HIP_MEMORY_SCOPE_AGENT); }
__device__ __forceinline__ unsigned xb_xcc_id() { return (unsigned)__builtin_amdgcn_s_getreg((3 << 11) | 20) & 0xFu; }
#define XB_SPIN(cond, bar) do { unsigned _sp = 0; while (cond) { __builtin_amdgcn_s_sleep(1); \
    if ((++_sp & 255u) == 0u) { if (xb_ld(&(bar)[XB_TMO])) break; if (_sp > XB_SPIN_CAP) { atomicAdd(&(bar)[XB_TMO], 1u); break; } } } } while (0)
struct XcdBarrier { unsigned* bar; unsigned x; volatile LAS unsigned* st; };
__device__ __forceinline__ XcdBarrier xcd_barrier_post(unsigned* bar, volatile LAS unsigned* st) {
    XcdBarrier b; b.bar = bar; b.x = xb_xcc_id(); b.st = st;
    if (threadIdx.x == 0) (void)xb_add(&bar[XB_XCNT(b.x)], 1u);
    return b;
}
__device__ __forceinline__ void xcd_barrier_complete(unsigned* bar, unsigned x, unsigned& nloc, unsigned& nx) {
    const unsigned G = gridDim.x * gridDim.y * gridDim.z;
    unsigned sum, cnt, mine, sp = 0u;
    for (;;) {
        sum = 0u; cnt = 0u; mine = 0u;
#pragma unroll
        for (unsigned j = 0; j < 16; ++j) { const unsigned c = xb_ld(&bar[XB_XCNT(j)]); sum += c; cnt += (c > 0u) ? 1u : 0u; mine = (j == x) ? c : mine; }
        if (sum == G) break;
        __builtin_amdgcn_s_sleep(1);
        if ((++sp & 255u) == 0u) { if (xb_ld(&bar[XB_TMO])) break; if (sp > XB_SPIN_CAP) { atomicAdd(&bar[XB_TMO], 1u); break; } }
    }
    nloc = mine > 0u ? mine : 1u; nx = cnt > 0u ? cnt : 1u;
}
__device__ __forceinline__ void xcd_barrier(const XcdBarrier& b) {
    asm volatile("s_waitcnt vmcnt(0)" ::: "memory");
    __syncthreads();
    if (threadIdx.x == 0) {
        unsigned* bar = b.bar;
        __builtin_amdgcn_s_waitcnt(0);
        unsigned nloc = b.st[0], nx = b.st[1];
        if (nloc == 0u) { xcd_barrier_complete(bar, b.x, nloc, nx); b.st[0] = nloc; b.st[1] = nx; }
        const unsigned old = xb_add(&bar[XB_XSUB(b.x)], 1u);
        const unsigned gen = old / nloc;
        if (old + 1u == (gen + 1u) * nloc) {
            __builtin_amdgcn_fence(__ATOMIC_RELEASE, "agent");
            asm volatile("s_waitcnt vmcnt(0)" ::: "memory");
            const unsigned og = xb_add(&bar[XB_TOP], 1u);
            const unsigned tg = og / nx;
            if (og + 1u == (tg + 1u) * nx) xb_add(&bar[XB_TOPGEN], 1u);
            else XB_SPIN(xb_ld(&bar[XB_TOPGEN]) == tg, bar);
            __builtin_amdgcn_fence(__ATOMIC_ACQUIRE, "agent");
            xb_add(&bar[XB_XGEN(b.x)], 1u);
            asm volatile("s_waitcnt vmcnt(0)" ::: "memory");
        } else {
            XB_SPIN(xb_ld(&bar[XB_XGEN(b.x)]) == gen, bar);
            __builtin_amdgcn_fence(__ATOMIC_ACQUIRE, "agent");
            asm volatile("s_waitcnt vmcnt(0)" ::: "memory");
        }
    }
    __syncthreads();
}

struct Args { const float* in[18]; float* out; unsigned char* ws; int ph_lo, ph_hi; };
typedef const __attribute__((address_space(4))) Args* KArgs;
enum { I_X = 0, I_NATT, I_WIN, I_QG, I_KG, I_CPOS, I_CW1, I_CW2, I_RELB, I_HLB, I_HNG, I_WBR, I_WOUT, I_NFFN, I_WUP, I_CONVW, I_CONVB, I_WDN };
namespace pg8 {
constexpr int BM = 256, BK = 64, HALF = 128, HTB = HALF * BK * 2, STAGE_BYTES = 8 * HTB, NXCD = 8, LRS_OFF = STAGE_BYTES;
__host__ __device__ __forceinline__ int lds_byte(int r, int c) { const int st = (r >> 4) * 2 + (c >> 5), rr = r & 15, cc = c & 31, ob = rr * 64 + cc * 2; return st * 1024 + (ob ^ (((ob >> 9) & 1) << 5)); }
__host__ __device__ __forceinline__ void stage_rc(int b, int& R, int& C) { const int st = b / 1024, sb = b % 1024, swz = sb ^ (((sb >> 9) & 1) << 5); R = (st >> 1) * 16 + swz / 64; C = (st & 1) * 32 + (swz % 64) / 2; }
__host__ __device__ __forceinline__ int perm32(int rho) { const int n = rho >> 4, i = rho & 15; return 8 * (i >> 2) + 4 * n + (i & 3); }
struct Unit { int pm, pn, aux; };
struct Gemm { const bf16_t* A; const bf16_t* Bt; int M, N, K; int akm, bkm; };
struct StaticOrder {
    int nM, nN, nwg, G, c, WGM, rev;
    int pad_;
    __device__ void init(int M_, int N_, int G_, int c_, int wgm = 4, int rev_ = 0) { nM = M_ / BM; nN = N_ / BM; nwg = nM * nN; G = G_; c = c_; WGM = wgm; rev = rev_; pad_ = 0; }
    __device__ __forceinline__ bool tile(long L, Unit& u) const {
        if (L >= nwg) return false;
        int wgid = (int)L; { const int q = nwg / NXCD, r = nwg % NXCD, xcd = wgid % NXCD, off = wgid / NXCD; wgid = (xcd < r ? xcd * (q + 1) : r * (q + 1) + (xcd - r) * q) + off; }
        const int nig = WGM * nN, gid = wgid / nig, fm = gid * WGM, gsz = (nM - fm) < WGM ? (nM - fm) : WGM;
        u.pm = fm + ((wgid % nig) % gsz); u.pn = (wgid % nig) / gsz; u.aux = 0; if (rev) u.pm = nM - 1 - u.pm; return true;
    }
    __device__ __forceinline__ bool next(int i, Unit& u) const { return tile((long)i * G + c, u); }
    __device__ __forceinline__ const char* aptr(const Gemm& g, const Unit& u, size_t tstep) const { return (const char*)g.A + (size_t)u.pm * tstep; }
    __device__ __forceinline__ const char* bptr(const Gemm& g, const Unit& u, size_t tstep) const { return (const char*)g.Bt + (size_t)u.pn * tstep; }
    __device__ __forceinline__ void a_ready(const Unit&) const {}
    __device__ __forceinline__ void done(const Unit&) const {}
};
struct EpiStoreBf16 {
    static constexpr bool PERM = true, AFTER_DRAIN = false;
    static constexpr int PF_WAVES = 1;
    __device__ __forceinline__ void prefetch(LAS unsigned char* lds, const Unit& u, int wid, int lane) const {
        unsigned l16 = (unsigned)lane * 16u; asm volatile("" : "+v"(l16));
        __builtin_amdgcn_global_load_lds((const unsigned*)((const char*)rs + (size_t)u.pm * (BM * 4) + l16), (LAS unsigned*)(lds + LRS_OFF), 16, 0, 0); }
    static constexpr bool LDS_RS = true;
    bf16_t* O; int ldc; int sg_lo, sg_hi; const float* rs; LAS const float* lrs;
    __device__ __forceinline__ void operator()(const f32x4 (&acc)[2][2][4][2], const Unit& u, int wr, int wc, int fr, int fq) const {
        const int row0 = u.pm * BM + wr * 64 + fr, col0 = u.pn * BM + wc * 32 + 8 * fq; const bool sg = u.pn >= sg_lo && u.pn < sg_hi;
        float rsv[8];
#pragma unroll
        for (int g = 0; g < 8; ++g) rsv[g] = lrs[wr * 64 + fr + (g >> 2) * HALF + (g & 3) * 16];
#pragma unroll
        for (int ai = 0; ai < 2; ++ai)
#pragma unroll
            for (int m = 0; m < 4; ++m) { bf16_t* rowp = O + (size_t)(row0 + ai * HALF + m * 16) * ldc + col0;
#pragma unroll
                for (int bj = 0; bj < 2; ++bj) { f32x4 v0 = acc[ai][bj][m][0] * rsv[ai * 4 + m], v1 = acc[ai][bj][m][1] * rsv[ai * 4 + m];
                    if (sg) {
#pragma unroll
                        for (int e = 0; e < 4; ++e) { v0[e] = sigmoidf_(v0[e]); v1[e] = sigmoidf_(v1[e]); } }
                    u32x4 w; w.x = pk2(v0[0], v0[1]); w.y = pk2(v0[2], v0[3]); w.z = pk2(v1[0], v1[1]); w.w = pk2(v1[2], v1[3]);
                    __builtin_nontemporal_store(w, (u32x4*)(rowp + bj * HALF)); } }
    }
};
struct EpiConvAct {
    static constexpr bool PERM = true, AFTER_DRAIN = false, NO_RELAX = true;
    static constexpr bool LDS_RS = true;
    static constexpr bool APERM = true;
    static constexpr int PF_WAVES = 4;
    __device__ __forceinline__ void prefetch(LAS unsigned char* lds, const Unit& u, int wid, int lane) const {
        unsigned l_ = (unsigned)lane; asm volatile("" : "+v"(l_));
        const float* rs = (const float*)(ws + WS_RSTD); const float* cw = a->in[I_CONVW] + (size_t)layer * 3 * NUP; const float* cb = a->in[I_CONVB] + (size_t)layer * NUP;
        if (wid == 0) __builtin_amdgcn_global_load_lds((const unsigned*)((const char*)rs + (size_t)u.pm * (BM * 4) + l_ * 16u), (LAS unsigned*)(lds + LRS_OFF), 16, 0, 0);
        const unsigned sg = 2u * (unsigned)wid + (l_ >> 5), tap = sg & 3u;
        const float* src = (tap < 3u ? cw + (size_t)tap * NUP : cb) + (size_t)(sg >> 2) * DFF + (size_t)u.pn * 128 + (l_ & 31u) * 4u;
        __builtin_amdgcn_global_load_lds((const unsigned*)src, (LAS unsigned*)(lds + LRS_OFF + 1024 + wid * 1024), 16, 0, 0); }
    unsigned char* ws; KArgs a; int layer; LAS const float* lrs;
    static __device__ __forceinline__ f32x4 shr1(const f32x4 v) {
        f32x4 r;
#pragma unroll
        for (int e = 0; e < 4; ++e) r[e] = __int_as_float(__builtin_amdgcn_update_dpp(0, __float_as_int(v[e]), 0x111, 0xf, 0xf, true));
        return r; }
    __device__ __forceinline__ void operator()(const f32x4 (&acc)[2][2][4][2], const Unit& u, int wr, int wc, int fr, int fq) const {
        const int row0 = u.pm * BM + wr * 64 + 4 * fr, ch0 = u.pn * 128 + wc * 32 + 8 * fq;
        bf16_t* ACT = (bf16_t*)(ws + WS_ACT); bf16_t* side = (bf16_t*)(ws + WS_USIDE);
        f32x4 rsv[2];
#pragma unroll
        for (int ai = 0; ai < 2; ++ai) rsv[ai] = *(const LAS f32x4*)(lrs + ai * HALF + wr * 64 + 4 * fr);
        if (fr == 0 || fr == 15) {
            const bool lo = fr == 0;
#pragma unroll
            for (int ai = 0; ai < 2; ++ai) { const int blk = (u.pm * BM + ai * HALF + wr * 64) >> 6;
#pragma unroll
                for (int s2 = 0; s2 < 2; ++s2) { const float r_ = lo ? rsv[ai][s2] : rsv[ai][2 + s2];
                    bf16_t* sp = side + ((size_t)blk * 4 + (lo ? s2 : 2 + s2)) * NUP + u.pn * 256 + wc * 32 + 8 * fq;
#pragma unroll
                    for (int bj = 0; bj < 2; ++bj) { const f32x4 l0 = acc[ai][bj][s2][0], h0 = acc[ai][bj][2 + s2][0], l1 = acc[ai][bj][s2][1], h1 = acc[ai][bj][2 + s2][1]; f32x4 a0, a1;
#pragma unroll
                        for (int e = 0; e < 4; ++e) { a0[e] = (lo ? l0[e] : h0[e]) * r_; a1[e] = (lo ? l1[e] : h1[e]) * r_; }
                        *(u32x4*)(sp + bj * HALF) = (u32x4){pk2(a0[0], a0[1]), pk2(a0[2], a0[3]), pk2(a1[0], a1[1]), pk2(a1[2], a1[3])}; } } }
        }
        __builtin_amdgcn_sched_barrier(0);
#pragma unroll
        for (int n = 0; n < 2; ++n) {
            LAS const float* lw = lrs + 256 + wc * 32 + 8 * fq + 4 * n;
#pragma unroll
            for (int ai = 0; ai < 2; ++ai) {
                f32x4 sg[4];
                { const f32x4 w0 = *(const LAS f32x4*)(lw), w1 = *(const LAS f32x4*)(lw + 128), w2 = *(const LAS f32x4*)(lw + 256), bb = *(const LAS f32x4*)(lw + 384);
                  const f32x4 x0 = acc[ai][0][0][n] * rsv[ai][0], x1 = acc[ai][0][1][n] * rsv[ai][1], x2 = acc[ai][0][2][n] * rsv[ai][2], x3 = acc[ai][0][3][n] * rsv[ai][3];
                  const f32x4 p1 = shr1(x3), p2 = shr1(x2);
                  const f32x4 c0 = bb + w0 * p2 + w1 * p1 + w2 * x0, c1 = bb + w0 * p1 + w1 * x0 + w2 * x1, c2 = bb + w0 * x0 + w1 * x1 + w2 * x2, c3 = bb + w0 * x1 + w1 * x2 + w2 * x3;
#pragma unroll
                  for (int e = 0; e < 4; ++e) { sg[0][e] = c0[e] * sigmoidf_(c0[e]); sg[1][e] = c1[e] * sigmoidf_(c1[e]); sg[2][e] = c2[e] * sigmoidf_(c2[e]); sg[3][e] = c3[e] * sigmoidf_(c3[e]); } }
                __builtin_amdgcn_sched_barrier(0);
                { const f32x4 w0 = *(const LAS f32x4*)(lw + 512), w1 = *(const LAS f32x4*)(lw + 640), w2 = *(const LAS f32x4*)(lw + 768), bb = *(const LAS f32x4*)(lw + 896);
                  const f32x4 x0 = acc[ai][1][0][n] * rsv[ai][0], x1 = acc[ai][1][1][n] * rsv[ai][1], x2 = acc[ai][1][2][n] * rsv[ai][2], x3 = acc[ai][1][3][n] * rsv[ai][3];
                  const f32x4 p1 = shr1(x3), p2 = shr1(x2);
                  f32x4 cv[4]; cv[0] = bb + w0 * p2 + w1 * p1 + w2 * x0; cv[1] = bb + w0 * p1 + w1 * x0 + w2 * x1; cv[2] = bb + w0 * x0 + w1 * x1 + w2 * x2; cv[3] = bb + w0 * x1 + w1 * x2 + w2 * x3;
#pragma unroll
                  for (int m = 0; m < 4; ++m) { const f32x4 act = sg[m] * cv[m];
                      u32x2 w; w.x = pk2(act[0], act[1]); w.y = pk2(act[2], act[3]);
                      *(u32x2*)(ACT + ((size_t)((ch0 + 4 * n) >> 6) * M + (size_t)(row0 + ai * HALF + m)) * 64 + ((ch0 + 4 * n) & 63)) = w; } }
                __builtin_amdgcn_sched_barrier(0);
            }
        }
    }
};
#ifndef ER_DEPTH
#define ER_DEPTH 4
#endif
struct EpiResidBf16 {
    static constexpr bool PERM = true, AFTER_DRAIN = false;
    bf16_t* XB; float* Cout; float* ssq; int ldc;
    __device__ __forceinline__ void operator()(const f32x4 (&acc)[2][2][4][2], const Unit& u, int wr, int wc, int fr, int fq) const {
        const int row0 = u.pm * BM + wr * 64 + fr, col0 = u.pn * BM + wc * 32 + 8 * fq;
        u32x4 old[ER_DEPTH][2]; float ssv[8];
#define ER_ROWI(g) (row0 + ((g) >> 2) * HALF + ((g) & 3) * 16)
#define ER_LOAD(g) do { old[(g) % ER_DEPTH][0] = *(const u32x4*)(XB + akm(ER_ROWI(g), col0)); old[(g) % ER_DEPTH][1] = *(const u32x4*)(XB + akm(ER_ROWI(g), col0 + HALF)); } while (0)
#pragma unroll
        for (int g = 0; g < ER_DEPTH; ++g) ER_LOAD(g);
#pragma unroll
        for (int g = 0; g < 8; ++g) {
            asm volatile("" ::: "memory");
            const size_t ro = (size_t)ER_ROWI(g) * ldc + col0; float ss = 0.f;
#pragma unroll
            for (int bj = 0; bj < 2; ++bj) { const u32x4 o_ = old[g % ER_DEPTH][bj];
                f32x4 v0 = acc[g >> 2][bj][g & 3][0], v1 = acc[g >> 2][bj][g & 3][1];
                v0[0] += bflo(o_.x); v0[1] += bfhi(o_.x); v0[2] += bflo(o_.y); v0[3] += bfhi(o_.y); v1[0] += bflo(o_.z); v1[1] += bfhi(o_.z); v1[2] += bflo(o_.w); v1[3] += bfhi(o_.w);
                if (Cout) { *(f32x4*)(Cout + ro + bj * HALF) = v0; *(f32x4*)(Cout + ro + bj * HALF + 4) = v1; }
                else { u32x4 w; w.x = pk2(v0[0], v0[1]); w.y = pk2(v0[2], v0[3]); w.z = pk2(v1[0], v1[1]); w.w = pk2(v1[2], v1[3]); *(u32x4*)(XB + akm(ER_ROWI(g), col0 + bj * HALF)) = w;
                    const float r0 = bflo(w.x), r1 = bfhi(w.x), r2 = bflo(w.y), r3 = bfhi(w.y), r4 = bflo(w.z), r5 = bfhi(w.z), r6 = bflo(w.w), r7 = bfhi(w.w);
                    ss += ((r0 * r0 + r1 * r1) + (r2 * r2 + r3 * r3)) + ((r4 * r4 + r5 * r5) + (r6 * r6 + r7 * r7)); } }
            ssv[g] = ss;
            if (g + ER_DEPTH < 8) ER_LOAD(g + ER_DEPTH);
        }
        if (!Cout) {
#pragma unroll
            for (int g = 0; g < 8; ++g) ssv[g] += __shfl_xor(ssv[g], 16);
#pragma unroll
            for (int g = 0; g < 8; ++g) ssv[g] += __shfl_xor(ssv[g], 32);
            if (fq == 0) {
#pragma unroll
                for (int g = 0; g < 8; ++g) ssq[(size_t)ER_ROWI(g) * 32 + u.pn * 4 + wc] = ssv[g]; } }
#undef ER_ROWI
#undef ER_LOAD
    }
};
struct EpiGated {
    static constexpr bool PERM = true, AFTER_DRAIN = false, HOOK = true; static constexpr int HOOK_KT = 16;
    const bf16_t* P; bf16_t* merged;
    static __device__ __forceinline__ float gl(unsigned w) { return fmaxf(bflo(w), 1e-30f); }
    static __device__ __forceinline__ float gh(unsigned w) { return fmaxf(bfhi(w), 1e-30f); }
    __device__ __forceinline__ void mid(f32x4 (&acc)[2][2][4][2], const Unit& u, int wr, int wc, int fr, int fq, int s) const {
        const unsigned row0 = (unsigned)(u.pm * BM + wr * 64 + fr), col0 = (unsigned)(u.pn * BM + wc * 32 + 8 * fq);
        const char* Pa = (const char*)(P + PGT + (s - 1) * DM); const char* Pb = (const char*)(P + PGT + s * DM);
#pragma unroll
        for (int hf = 0; hf < 2; ++hf) {
            u32x4 ga[4][2], gb[4][2];
#pragma unroll
            for (int gg = 0; gg < 4; ++gg) { const int g = hf * 4 + gg; const unsigned po = ((row0 + (unsigned)((g >> 2) * HALF + (g & 3) * 16)) * (unsigned)NPC + col0) * 2u;
#pragma unroll
                for (int bj = 0; bj < 2; ++bj) { ga[gg][bj] = *(const u32x4*)(Pa + (size_t)(po + bj * 256u)); gb[gg][bj] = *(const u32x4*)(Pb + (size_t)(po + bj * 256u)); } }
#pragma unroll
            for (int gg = 0; gg < 4; ++gg) { const int g = hf * 4 + gg;
#pragma unroll
                for (int bj = 0; bj < 2; ++bj) { const u32x4 a_ = ga[gg][bj], b_ = gb[gg][bj];
                    f32x4& v0 = acc[g >> 2][bj][g & 3][0]; f32x4& v1 = acc[g >> 2][bj][g & 3][1];
                    v0[0] *= gl(a_.x) * fast_rcp(gl(b_.x)); v0[1] *= gh(a_.x) * fast_rcp(gh(b_.x)); v0[2] *= gl(a_.y) * fast_rcp(gl(b_.y)); v0[3] *= gh(a_.y) * fast_rcp(gh(b_.y));
                    v1[0] *= gl(a_.z) * fast_rcp(gl(b_.z)); v1[1] *= gh(a_.z) * fast_rcp(gh(b_.z)); v1[2] *= gl(a_.w) * fast_rcp(gl(b_.w)); v1[3] *= gh(a_.w) * fast_rcp(gh(b_.w)); } }
            asm volatile("" ::: "memory"); }
    }
    __device__ __forceinline__ void operator()(const f32x4 (&acc)[2][2][4][2], const Unit& u, int wr, int wc, int fr, int fq) const {
        const unsigned row0 = (unsigned)(u.pm * BM + wr * 64 + fr), col0 = (unsigned)(u.pn * BM + wc * 32 + 8 * fq);
        const char* Pg = (const char*)(P + PGT + 2 * DM); char* mg = (char*)merged;
        u32x4 gw[8][2];
#pragma unroll
        for (int g = 0; g < 8; ++g) { const unsigned po = ((row0 + (unsigned)((g >> 2) * HALF + (g & 3) * 16)) * (unsigned)NPC + col0) * 2u;
#pragma unroll
            for (int bj = 0; bj < 2; ++bj) gw[g][bj] = *(const u32x4*)(Pg + (size_t)(po + bj * 256u)); }
#pragma unroll
        for (int g = 0; g < 8; ++g) { const unsigned moff = ((row0 + (unsigned)((g >> 2) * HALF + (g & 3) * 16)) * (unsigned)DM + col0) * 2u;
#pragma unroll
            for (int bj = 0; bj < 2; ++bj) { const u32x4 w_ = gw[g][bj]; const f32x4 v0 = acc[g >> 2][bj][g & 3][0], v1 = acc[g >> 2][bj][g & 3][1];
                u32x4 w; w.x = pk2(v0[0] * gl(w_.x), v0[1] * gh(w_.x)); w.y = pk2(v0[2] * gl(w_.y), v0[3] * gh(w_.y)); w.z = pk2(v1[0] * gl(w_.z), v1[1] * gh(w_.z)); w.w = pk2(v1[2] * gl(w_.w), v1[3] * gh(w_.w));
                *(u32x4*)(merged + akm(row0 + (unsigned)((g >> 2) * HALF + (g & 3) * 16), (int)col0 + bj * HALF)) = w; } }
    }
};

template <class E, class = void> struct has_relax { static constexpr bool v = true; };
template <class E> struct has_relax<E, decltype((void)E::NO_RELAX)> { static constexpr bool v = false; };
template <class E, class = void> struct has_lrs { static constexpr bool v = false; };
template <class E> struct has_lrs<E, decltype((void)E::LDS_RS)> { static constexpr bool v = true; };
template <class E, class = void> struct has_aperm { static constexpr bool v = false; };
template <class E> struct has_aperm<E, decltype((void)E::APERM)> { static constexpr bool v = true; };
template <class E, class = void> struct has_hook { static constexpr bool v = false; };
template <class E> struct has_hook<E, decltype((void)E::HOOK)> { static constexpr bool v = true; };
template <class Epi, class Sched, bool ALIGN_EPI = false, bool SP2 = false>
__device__ __forceinline__ void gemm_phase(LAS unsigned char* lds, const Gemm g, const Sched& S, const Epi& E, const int tid, unsigned long long* dg = nullptr) {
    float zf; asm volatile("v_mov_b32 %0, 0" : "=v"(zf));
    const int wid = __builtin_amdgcn_readfirstlane(tid >> 6), lane = tid & 63, wr = wid >> 2, wc = wid & 3, fr = lane & 15, fq = lane >> 4;
    const int K = g.K, nt = K / BK;
    unsigned voffA[2], voffB[2];
#pragma unroll
    for (int i = 0; i < 2; ++i) { int R, C; stage_rc(tid * 16 + i * 8192, R, C); const int Rb = Epi::PERM ? ((R & ~31) + perm32(R & 31)) : R;
        const int Ra = has_aperm<Epi>::v ? ((R & ~63) + 4 * (R & 15) + ((R >> 4) & 3)) : R;
        voffA[i] = (unsigned)(Ra * (g.akm ? BK : K) + C) * 2u; voffB[i] = (unsigned)(Rb * (g.bkm ? BK : K) + C) * 2u; }
    const size_t kstep = (size_t)(BK * 2);
    const size_t hstep = (size_t)HALF * K * 2;
    const size_t tstep = 2 * hstep;
    const size_t kstepA = g.akm ? (size_t)g.M * BK * 2 : kstep, hstepA = g.akm ? (size_t)HALF * BK * 2 : hstep, tstepA = 2 * hstepA;
    const size_t kstepB = g.bkm ? (size_t)g.N * BK * 2 : kstep, hstepB = g.bkm ? (size_t)HALF * BK * 2 : hstep, tstepB = 2 * hstepB;
    const unsigned ldsw = (unsigned)wid * 1024u;
    const int aoff = lds_byte(wr * 64 + fr, fq * 8), boff = lds_byte(wc * 32 + fr, fq * 8);
#define PG8_SA(b, h) (((b) * 2 + (h)) * HTB)
#define PG8_SB(b, h) ((4 + (b) * 2 + (h)) * HTB)
#define PG8_STAGE(bufoff, gbase, voff) do { _Pragma("unroll") for (int _i = 0; _i < 2; ++_i) \
        __builtin_amdgcn_global_load_lds((const unsigned*)((const char*)(gbase) + (voff)[_i]), (LAS unsigned*)(lds + (bufoff) + ldsw + _i * 8192), 16, 0, 0); } while (0)
#define PG8_LDA(dst, b, h) do { _Pragma("unroll") for (int m = 0; m < 4; ++m) _Pragma("unroll") for (int k = 0; k < 2; ++k) dst[m][k] = *(const LAS bf16x8*)(lds + PG8_SA(b, h) + aoff + m * 2048 + k * 1024); } while (0)
#define PG8_LDB(dst, b, h) do { _Pragma("unroll") for (int n = 0; n < 2; ++n) _Pragma("unroll") for (int k = 0; k < 2; ++k) dst[n][k] = *(const LAS bf16x8*)(lds + PG8_SB(b, h) + boff + n * 2048 + k * 1024); } while (0)
#define PG8_MMA(ai, bj, At, Bt) do { __builtin_amdgcn_s_setprio(1); _Pragma("unroll") for (int m = 0; m < 4; ++m) _Pragma("unroll") for (int n = 0; n < 2; ++n) _Pragma("unroll") for (int k = 0; k < 2; ++k) \
        acc[ai][bj][m][n] = __builtin_amdgcn_mfma_f32_16x16x32_bf16(Bt[n][k], At[m][k], acc[ai][bj][m][n], 0, 0, 0); __builtin_amdgcn_s_setprio(0); } while (0)
#define PG8_WAIT_V(n) asm volatile("s_waitcnt vmcnt(" #n ")" ::: "memory")
#define PG8_WAIT_L(n) asm volatile("s_waitcnt lgkmcnt(" #n ")" ::: "memory")
#define PG8_BAR __builtin_amdgcn_s_barrier()
#define PG8_SCHED __builtin_amdgcn_sched_barrier(0)
    Unit cur, nxt; int ui = 0;
    if (!S.next(0, cur)) return;
    f32x4 acc[2][2][4][2];
#pragma unroll
    for (int a = 0; a < 2; ++a)
#pragma unroll
        for (int b = 0; b < 2; ++b)
#pragma unroll
            for (int m = 0; m < 4; ++m)
#pragma unroll
                for (int n = 0; n < 2; ++n) acc[a][b][m][n] = (f32x4){zf, zf, zf, zf};
    bf16x8 At[4][2], B0[2][2], B1[2][2];
    const char* cA = S.aptr(g, cur, tstepA); const char* cB = S.bptr(g, cur, tstepB);
    S.a_ready(cur);
    if constexpr (SP2) {
        PG8_STAGE(PG8_SB(0, 0), cB, voffB); PG8_STAGE(PG8_SB(0, 1), cB + hstepB, voffB); PG8_STAGE(PG8_SA(0, 0), cA, voffA); PG8_STAGE(PG8_SA(0, 1), cA + hstepA, voffA);
        if (wr == 1) PG8_BAR;
        PG8_WAIT_V(2); PG8_BAR;
        PG8_STAGE(PG8_SB(1, 0), cB + kstepB, voffB); PG8_STAGE(PG8_SA(1, 0), cA + kstepA, voffA); PG8_STAGE(PG8_SB(1, 1), cB + hstepB + kstepB, voffB);
        PG8_WAIT_V(6); PG8_BAR;
    } else {
        PG8_STAGE(PG8_SB(0, 0), cB, voffB); PG8_STAGE(PG8_SA(0, 0), cA, voffA); PG8_STAGE(PG8_SB(0, 1), cB + hstepB, voffB); PG8_STAGE(PG8_SA(0, 1), cA + hstepA, voffA);
        if (wr == 1) PG8_BAR;
        PG8_WAIT_V(4); PG8_BAR;
        PG8_STAGE(PG8_SB(1, 0), cB + kstepB, voffB); PG8_STAGE(PG8_SA(1, 0), cA + kstepA, voffA); PG8_STAGE(PG8_SB(1, 1), cB + hstepB + kstepB, voffB);
        PG8_WAIT_V(6); PG8_BAR;
    }
    for (;;) {
        const bool has_next = S.next(ui + 1, nxt);
        if (MK_DIAG && dg && tid == 0 && (ui == 2 || ui == 3)) dg[(ui - 2) * 2] = wall_clock64();
        const char* nA = has_next ? S.aptr(g, nxt, tstepA) : cA; const char* nB = has_next ? S.bptr(g, nxt, tstepB) : cB;
        constexpr bool RELAX_ = has_relax<Epi>::v;
#define PG8_ITER(FIRST) do { \
            const bool last = (t == nt - 2); \
            const char* a1 = cA + (size_t)(t + 1) * kstepA; \
            const char* a2 = last ? nA : cA + (size_t)(t + 2) * kstepA; const char* b2 = last ? nB : cB + (size_t)(t + 2) * kstepB; \
            const char* a3 = a2 + kstepA; const char* b3 = b2 + kstepB; \
            if (last && has_next) S.a_ready(nxt); \
            PG8_LDB(B0, 0, 0); PG8_LDB(B1, 0, 1); PG8_SCHED; PG8_LDA(At, 0, 0); if (!(FIRST)) PG8_STAGE(PG8_SA(1, 1), a1 + hstepA, voffA); \
            if constexpr (has_lrs<Epi>::v) { if (t == 4 && wid < Epi::PF_WAVES) E.prefetch(lds, cur, wid, lane); } \
            if (FIRST) PG8_WAIT_V(24); else PG8_WAIT_V(8); PG8_WAIT_L(0); PG8_BAR; PG8_MMA(0, 0, At, B0); PG8_MMA(0, 1, At, B1); PG8_BAR; PG8_SCHED; \
            PG8_LDA(At, 0, 1); PG8_STAGE(PG8_SB(0, 0), b2, voffB); PG8_STAGE(PG8_SB(0, 1), b2 + hstepB, voffB); PG8_STAGE(PG8_SA(0, 0), a2, voffA); \
            if (FIRST) PG8_WAIT_V(24); else PG8_WAIT_V(8); PG8_WAIT_L(0); PG8_BAR; PG8_MMA(1, 0, At, B0); PG8_MMA(1, 1, At, B1); PG8_BAR; PG8_SCHED; \
            PG8_LDB(B0, 1, 0); PG8_LDB(B1, 1, 1); PG8_SCHED; PG8_LDA(At, 1, 0); PG8_STAGE(PG8_SA(0, 1), a2 + hstepA, voffA); \
            if (FIRST) PG8_WAIT_V(24); else PG8_WAIT_V(8); PG8_WAIT_L(0); PG8_BAR; PG8_MMA(0, 0, At, B0); PG8_MMA(0, 1, At, B1); PG8_BAR; PG8_SCHED; \
            PG8_LDA(At, 1, 1); PG8_STAGE(PG8_SB(1, 0), b3, voffB); PG8_STAGE(PG8_SB(1, 1), b3 + hstepB, voffB); PG8_STAGE(PG8_SA(1, 0), a3, voffA); \
            PG8_WAIT_V(8); PG8_WAIT_L(0); PG8_BAR; PG8_MMA(1, 0, At, B0); PG8_MMA(1, 1, At, B1); PG8_BAR; PG8_SCHED; \
            if constexpr (has_hook<Epi>::v) { if (t + 2 < nt && (t + 2) % Epi::HOOK_KT == 0) { int fr_ = fr, fq_ = fq; asm volatile("" : "+v"(fr_), "+v"(fq_)); const_cast<Epi&>(E).mid(acc, cur, wr, wc, fr_, fq_, (t + 2) / Epi::HOOK_KT); PG8_SCHED; } } \
            if (RELAX_ && last && has_next) { PG8_STAGE(PG8_SA(1, 1), a3 + hstepA, voffA); PG8_SCHED; }     \
        } while (0)
        int t = 0;
        if constexpr (RELAX_) { if (ui > 0) { PG8_ITER(1); t = 2; } }
        for (; t < nt; t += 2) { PG8_ITER(0); }
#undef PG8_ITER
        if (MK_DIAG && dg && tid == 0 && ui == 2) dg[1] = wall_clock64();
        if constexpr (ALIGN_EPI) { if (wr == 0) PG8_BAR; }
        if constexpr (!Epi::AFTER_DRAIN) { int fr_ = fr, fq_ = fq; asm volatile("" : "+v"(fr_), "+v"(fq_));
            E(acc, cur, wr, wc, fr_, fq_); S.done(cur); }
        if (!has_next) break;
#pragma unroll
        for (int a = 0; a < 2; ++a)
#pragma unroll
            for (int b = 0; b < 2; ++b)
#pragma unroll
                for (int m = 0; m < 4; ++m)
#pragma unroll
                    for (int n = 0; n < 2; ++n) acc[a][b][m][n] = (f32x4){zf, zf, zf, zf};
        cur = nxt; cA = nA; cB = nB; ++ui;
        if constexpr (ALIGN_EPI) { if (wr == 1) PG8_BAR; }
    }
    PG8_WAIT_V(0);
    if constexpr (!ALIGN_EPI) { if (wr == 0) PG8_BAR; }
    PG8_BAR;
#undef PG8_SA
#undef PG8_SB
#undef PG8_STAGE
#undef PG8_LDA
#undef PG8_LDB
#undef PG8_MMA
#undef PG8_WAIT_V
#undef PG8_WAIT_L
#undef PG8_BAR
#undef PG8_SCHED
}
}
#define PG8_SP2 true
#define PG8_ALIGN true


struct Frame {
    LAS unsigned char* lds; volatile LAS unsigned* MISC;
    unsigned* ctl; unsigned char* ws;
    int tid, lane, wave, G, bid;
};

__device__ __forceinline__ int up_src_col(int n) { const int pn = n >> 8, c = n & 255; return c < 128 ? 128 * pn + c : DFF + 128 * pn + (c - 128); }
__device__ __forceinline__ int inproj_src_col(int n) { return n < 2560 ? n : (n < 15872 ? n + 24 : (n < 15896 ? n - 15872 + 2560 : -1)); }
__device__ __forceinline__ void transpose_item(const float* W, int K, int Nsrc, bf16_t* WT, const float* gain, int mode, LAS float* scr, int item, int nblk, int lane, int ntot, int kbase = 0) {
    const int kb = item / nblk, nb = item - kb * nblk, k0 = 64 * kb, n0 = 32 * nb;
    const int nn = n0 + (lane & 7) * 4; const int sc = mode == 1 ? inproj_src_col(nn) : (mode == 2 ? up_src_col(nn) : nn);
    f32x4 v[8];
#pragma unroll
    for (int i = 0; i < 8; ++i) { const int kk = 8 * i + (lane >> 3); v[i] = sc >= 0 ? __builtin_nontemporal_load((const f32x4*)(W + (size_t)(k0 + kk) * Nsrc + sc)) : (f32x4){0.f, 0.f, 0.f, 0.f}; }
#pragma unroll
    for (int i = 0; i < 8; ++i) { const int kk = 8 * i + (lane >> 3); const float gk = gain ? gain[k0 + kk] : 1.f; LAS float* d = scr + kk * 33 + (lane & 7) * 4;
        d[0] = v[i].x * gk; d[1] = v[i].y * gk; d[2] = v[i].z * gk; d[3] = v[i].w * gk; }
    LDS_WAIT(); asm volatile("" ::: "memory");
    const int c = lane & 7;
#pragma unroll
    for (int j = 0; j < 4; ++j) { const int n = (lane >> 3) + 8 * j; const LAS float* sp = scr + (8 * c) * 33 + n;
        u32x4 o; o.x = pk2(sp[0 * 33], sp[1 * 33]); o.y = pk2(sp[2 * 33], sp[3 * 33]); o.z = pk2(sp[4 * 33], sp[5 * 33]); o.w = pk2(sp[6 * 33], sp[7 * 33]);
        if (ntot) *(u32x4*)(WT + ((size_t)((kbase + k0) >> 6) * ntot + (size_t)(n0 + n)) * 64 + 8 * c) = o;
        else *(u32x4*)(WT + (size_t)(n0 + n) * K + k0 + 8 * c) = o; }
    LDS_WAIT(); asm volatile("" ::: "memory");
}
__device__ __forceinline__ void rms_row0(const float* xin, bf16_t* XB, int m, float* rstd, int lane) {
    const f32x4* xr = (const f32x4*)xin + lane;
    f32x4 v[8]; float s = 0.f;
#pragma unroll
    for (int j = 0; j < 8; ++j) { v[j] = xr[64 * j]; s += (v[j].x * v[j].x + v[j].y * v[j].y) + (v[j].z * v[j].z + v[j].w * v[j].w); }
    s = wave_sum(s);
    if (lane == 0) *rstd = rsqrtf(s * (1.f / DM) + EPS);
#pragma unroll
    for (int j = 0; j < 8; ++j) { u32x2 w; w.x = pk2(v[j].x, v[j].y); w.y = pk2(v[j].z, v[j].w); *(u32x2*)(XB + akm((size_t)m, 4 * (lane + 64 * j))) = w; }
}
__device__ __forceinline__ void rstd_rows(Frame& F) {
    const float* ssq = (const float*)(F.ws + WS_SSQ); float* rstd = (float*)(F.ws + WS_RSTD);
    for (int row = F.bid * 512 + F.tid; row < M; row += F.G * 512) { const f32x4* p = (const f32x4*)(ssq + (size_t)row * 32); float s = 0.f;
#pragma unroll
        for (int j = 0; j < 8; ++j) { const f32x4 v = p[j]; s += (v.x + v.y) + (v.z + v.w); }
        rstd[row] = rsqrtf(s * (1.f / DM) + EPS); }
}

__device__ __forceinline__ void cvec_item(Frame& F, KArgs a, int layer, int j);
__device__ __forceinline__ void phase_A(Frame& F, KArgs a, int layer) {
    LAS float* scr = (LAS float*)(F.lds + F.wave * 16384);
    const int gw = F.bid * 8 + F.wave, NGW = F.G * 8;
    bf16_t* Wt_in = (bf16_t*)(F.ws + WS_WIN); bf16_t* Wt_br = (bf16_t*)(F.ws + WS_WBR); bf16_t* Wt_out = (bf16_t*)(F.ws + WS_WOUT);
    bf16_t* Wt_up = (bf16_t*)(F.ws + WS_WUP); bf16_t* Wt_dn = (bf16_t*)(F.ws + WS_WDN);
    const float* w_in = a->in[I_WIN] + (size_t)layer * DM * INC; const float* g_att = a->in[I_NATT] + layer * DM;
    const float* w_br = a->in[I_WBR] + (size_t)layer * 3 * BW * DM; const float* w_out = a->in[I_WOUT] + (size_t)layer * DM * DM;
    const float* w_up = a->in[I_WUP] + (size_t)layer * DM * NUP; const float* g_ffn = a->in[I_NFFN] + layer * DM;
    const float* w_dn = a->in[I_WDN] + (size_t)layer * DFF * DM;
    constexpr int I_IN = (DM / 64) * (NPC / 32), I_BR1 = (BW / 64) * (DM / 32), I_OUT = (DM / 64) * (DM / 32), I_UP = (DM / 64) * (NUP / 32), I_DN = (DFF / 64) * (DM / 32);
    constexpr int I_C1 = (4096 / 64) * (HD / 32);
    constexpr int NITEMS = I_IN + 3 * I_BR1 + I_OUT + I_UP + I_DN + 2 * I_C1;
    for (int it = gw; it < NITEMS; it += NGW) {
        int r = it;
        if (r < I_IN) { transpose_item(w_in, DM, INC, Wt_in, g_att, 1, scr, r, NPC / 32, F.lane, NPC); continue; } r -= I_IN;
        if (r < 3 * I_BR1) { const int n = r / I_BR1; r -= n * I_BR1; transpose_item(w_br + (size_t)n * BW * DM, BW, DM, Wt_br, nullptr, 0, scr, r, DM / 32, F.lane, DM, n * BW); continue; } r -= 3 * I_BR1;
        if (r < I_OUT) { transpose_item(w_out, DM, DM, Wt_out, nullptr, 0, scr, r, DM / 32, F.lane, DM); continue; } r -= I_OUT;
        if (r < I_UP) { transpose_item(w_up, DM, NUP, Wt_up, g_ffn, 2, scr, r, NUP / 32, F.lane, NUP); continue; } r -= I_UP;
        if (r < I_DN) { transpose_item(w_dn, DFF, DM, Wt_dn, nullptr, 0, scr, r, DM / 32, F.lane, DM); continue; } r -= I_DN;
        { const int j = r / I_C1; r -= j * I_C1; transpose_item(a->in[I_CW1] + (size_t)(layer * 2 + j) * 4096 * HD, 4096, HD, (bf16_t*)(F.ws + WS_MISC + MISC_WC1) + (size_t)j * HD * 4096, nullptr, 0, scr, r, HD / 32, F.lane, 0); }
    }
    if (F.bid < 64) cvec_item(F, a, layer, F.bid);
    if (layer == 0) { bf16_t* XB = (bf16_t*)(F.ws + WS_XB); float* rstd = (float*)(F.ws + WS_RSTD);
        for (int m = gw; m < M; m += NGW) rms_row0(a->in[I_X] + (size_t)m * DM, XB, m, rstd + m, F.lane); }
    else rstd_rows(F);
}
__device__ __forceinline__ void phase_F(Frame& F, KArgs a) { rstd_rows(F); }
__device__ __forceinline__ void phase_H(Frame& F, KArgs a, int layer) {
    const bf16_t* SD = (const bf16_t*)(F.ws + WS_USIDE); bf16_t* ACT = (bf16_t*)(F.ws + WS_ACT);
    const float* cw = a->in[I_CONVW] + (size_t)layer * 3 * NUP; const float* cb = a->in[I_CONVB] + (size_t)layer * NUP;
    constexpr int CG = DFF / 8, NTASK = (M / 64) * 2 * CG;
    for (int task = F.bid * 512 + F.tid; task < NTASK; task += F.G * 512) {
        const int cg = task % CG, rb = task / CG, rw = rb & 1, blk = rb >> 1; if ((blk & 31) == 0) continue;
        const int c0 = cg * 8, uc = 256 * (c0 >> 7) + (c0 & 127);
        const bf16_t* t2 = rw == 0 ? SD + ((size_t)(blk - 1) * 4 + 2) * NUP : SD + ((size_t)(blk - 1) * 4 + 3) * NUP;
        const bf16_t* t1 = rw == 0 ? SD + ((size_t)(blk - 1) * 4 + 3) * NUP : SD + ((size_t)blk * 4 + 0) * NUP;
        const bf16_t* t0 = SD + ((size_t)blk * 4 + rw) * NUP;
        const u32x4 g2 = *(const u32x4*)(t2 + uc), g1 = *(const u32x4*)(t1 + uc), g0 = *(const u32x4*)(t0 + uc), v2 = *(const u32x4*)(t2 + uc + 128), v1 = *(const u32x4*)(t1 + uc + 128), v0 = *(const u32x4*)(t0 + uc + 128);
        const unsigned G2[4] = {g2.x, g2.y, g2.z, g2.w}, G1[4] = {g1.x, g1.y, g1.z, g1.w}, G0[4] = {g0.x, g0.y, g0.z, g0.w}, V2[4] = {v2.x, v2.y, v2.z, v2.w}, V1[4] = {v1.x, v1.y, v1.z, v1.w}, V0[4] = {v0.x, v0.y, v0.z, v0.w};
        float o[8];
#pragma unroll
        for (int e = 0; e < 8; ++e) { const int q = e >> 1; const bool hi = e & 1;
            const float xg2 = hi ? bfhi(G2[q]) : bflo(G2[q]), xg1 = hi ? bfhi(G1[q]) : bflo(G1[q]), xg0 = hi ? bfhi(G0[q]) : bflo(G0[q]);
            const float xv2 = hi ? bfhi(V2[q]) : bflo(V2[q]), xv1 = hi ? bfhi(V1[q]) : bflo(V1[q]), xv0 = hi ? bfhi(V0[q]) : bflo(V0[q]);
            const float cgv = cb[c0 + e] + cw[c0 + e] * xg2 + cw[NUP + c0 + e] * xg1 + cw[2 * NUP + c0 + e] * xg0;
            const float cvv = cb[DFF + c0 + e] + cw[DFF + c0 + e] * xv2 + cw[NUP + DFF + c0 + e] * xv1 + cw[2 * NUP + DFF + c0 + e] * xv0;
            o[e] = cgv * sigmoidf_(cgv) * cvv; }
        *(u32x4*)(ACT + ((size_t)(c0 >> 6) * M + (size_t)(blk * 64 + rw)) * 64 + (c0 & 63)) = (u32x4){pk2(o[0], o[1]), pk2(o[2], o[3]), pk2(o[4], o[5]), pk2(o[6], o[7])};
    }
}

__device__ __forceinline__ int q_next(Frame& F, unsigned* head) {
    __syncthreads();
    if (F.tid == 0) F.MISC[16] = __hip_atomic_fetch_add(head, 1u, __ATOMIC_RELAXED, __HIP_MEMORY_SCOPE_AGENT);
    __syncthreads();
    return __builtin_amdgcn_readfirstlane((int)F.MISC[16]);
}
__device__ __forceinline__ int t5_bucket(int n) {
    if (n < 16) return n;
    int b = 16;
    b += (n >= 19); b += (n >= 21); b += (n >= 24); b += (n >= 27); b += (n >= 31); b += (n >= 35); b += (n >= 40); b += (n >= 46);
    b += (n >= 52); b += (n >= 59); b += (n >= 67); b += (n >= 77); b += (n >= 87); b += (n >= 99); b += (n >= 113);
    return b;
}
__device__ __forceinline__ int crow(int i, int h) { return (i & 3) + 8 * (i >> 2) + 4 * h; }

#define MFMA32(a, b, c) __builtin_amdgcn_mfma_f32_32x32x16_bf16((a), (b), (c), 0, 0, 0)
__device__ __forceinline__ float sum8lanes(float v) { v += __shfl_xor(v, 1); v += __shfl_xor(v, 2); v += __shfl_xor(v, 4); return v; }
__device__ __forceinline__ void norm16(unsigned* pp, const float* gn, float sc) {
    const u32x4 w0 = *(const u32x4*)pp, w1 = *(const u32x4*)(pp + 4); const unsigned w[8] = {w0.x, w0.y, w0.z, w0.w, w1.x, w1.y, w1.z, w1.w};
    float x[16], ss = 0.f;
#pragma unroll
    for (int q = 0; q < 8; ++q) { x[2 * q] = bflo(w[q]); x[2 * q + 1] = bfhi(w[q]); ss += x[2 * q] * x[2 * q] + x[2 * q + 1] * x[2 * q + 1]; }
    const float r = rsqrtf(sum8lanes(ss) * (1.f / HD) + EPS) * sc;
    u32x4 o0, o1;
    o0.x = pk2(x[0] * r * gn[0], x[1] * r * gn[1]); o0.y = pk2(x[2] * r * gn[2], x[3] * r * gn[3]); o0.z = pk2(x[4] * r * gn[4], x[5] * r * gn[5]); o0.w = pk2(x[6] * r * gn[6], x[7] * r * gn[7]);
    o1.x = pk2(x[8] * r * gn[8], x[9] * r * gn[9]); o1.y = pk2(x[10] * r * gn[10], x[11] * r * gn[11]); o1.z = pk2(x[12] * r * gn[12], x[13] * r * gn[13]); o1.w = pk2(x[14] * r * gn[14], x[15] * r * gn[15]);
    *(u32x4*)pp = o0; *(u32x4*)(pp + 4) = o1;
}
__device__ __forceinline__ void item_norm(Frame& F, KArgs a, int layer, int it) {
    bf16_t* P = (bf16_t*)(F.ws + WS_P);
    const float* qg = a->in[I_QG] + layer * HD; const float* kg = a->in[I_KG] + layer * 3 * HD;
    const int lane = F.lane, e0 = (lane & 7) * 16;
    float gq[16], gk[16];
#pragma unroll
    for (int e = 0; e < 16; ++e) { gq[e] = qg[e0 + e]; gk[e] = kg[((lane >> 4) & 1 ? 2 : 1) * HD + e0 + e]; }
    for (int rr = 0; rr < 8; ++rr) {
        bf16_t* pr = P + (size_t)(it * 64 + F.wave * 8 + rr) * NPC;
        norm16((unsigned*)(pr + PQN + lane * 16), gq, QSCALE);
        if (lane < 32) norm16((unsigned*)(pr + (lane < 16 ? PKS + lane * 16 : PKW + (lane - 16) * 16)), gk, 1.f);
    }
}
__device__ __forceinline__ void item_hgfin(Frame& F, KArgs a, int layer, int it) {
    const bf16_t* P = (const bf16_t*)(F.ws + WS_P); const float* OR = (const float*)(F.ws + WS_ORAW); bf16_t* OH = (bf16_t*)(F.ws + WS_OBR) + 2 * BW;
    const float* ng = a->in[I_HNG] + layer * HD; const int lane = F.lane, e0 = (lane & 7) * 16;
    float gn[16];
#pragma unroll
    for (int e = 0; e < 16; ++e) gn[e] = ng[e0 + e];
    for (int rr = 0; rr < 8; ++rr) { const size_t row = (size_t)(it * 64 + F.wave * 8 + rr);
        const f32x4* op = (const f32x4*)(OR + row * BW + lane * 16); const f32x4 o0 = op[0], o1 = op[1], o2 = op[2], o3 = op[3];
        const unsigned* gp = (const unsigned*)(P + row * NPC + PGH + lane * 16); const u32x4 g0 = *(const u32x4*)gp, g1 = *(const u32x4*)(gp + 4);
        const float x[16] = {o0.x, o0.y, o0.z, o0.w, o1.x, o1.y, o1.z, o1.w, o2.x, o2.y, o2.z, o2.w, o3.x, o3.y, o3.z, o3.w}; const unsigned gw[8] = {g0.x, g0.y, g0.z, g0.w, g1.x, g1.y, g1.z, g1.w};
        float ss = 0.f;
#pragma unroll
        for (int e = 0; e < 16; ++e) ss += x[e] * x[e];
        const float r = rsqrtf(sum8lanes(ss) * (1.f / HD) + EPS);
        unsigned ow[8];
#pragma unroll
        for (int q = 0; q < 8; ++q) ow[q] = pk2(x[2 * q] * r * gn[2 * q] * sigmoidf_(bflo(gw[q])), x[2 * q + 1] * r * gn[2 * q + 1] * sigmoidf_(bfhi(gw[q])));
        unsigned* dst = (unsigned*)(OH + row * (3 * BW) + lane * 16);
        *(u32x4*)dst = (u32x4){ow[0], ow[1], ow[2], ow[3]}; *(u32x4*)(dst + 4) = (u32x4){ow[4], ow[5], ow[6], ow[7]};
    }
}
__device__ __forceinline__ void cvec_item(Frame& F, KArgs a, int layer, int blk) {
    const int j = blk >> 5, ks = blk & 31;
    const float* pos = a->in[I_CPOS] + (size_t)(layer * 2 + j) * 32 * HD; const float* w1 = a->in[I_CW1] + (size_t)(layer * 2 + j) * 32 * HD * HD;
    LAS float* red = (LAS float*)F.lds; const int e = F.tid & 127, sub = F.tid >> 7;
    float acc = 0.f;
#pragma unroll 8
    for (int k = ks * 128 + sub * 32; k < ks * 128 + sub * 32 + 32; ++k) acc += pos[k] * w1[(size_t)k * HD + e];
    __syncthreads(); red[sub * 128 + e] = acc; __syncthreads();
    if (F.tid < 128) ((float*)(F.ctl + CW_CVEC))[(j * 32 + ks) * 128 + F.tid] = (red[F.tid] + red[128 + F.tid]) + (red[256 + F.tid] + red[384 + F.tid]);
    __syncthreads();
}
__device__ __forceinline__ void item_compress(Frame& F, KArgs a, int layer, int id) {
    const int j = id >> 7, rem = id & 127, b = rem >> 3, g = (rem >> 2) & 1, n0 = (rem & 3) * 32;
    const bf16_t* P = (const bf16_t*)(F.ws + WS_P);
    LAS float* red = (LAS float*)F.lds;
    LAS float* hid = (LAS float*)(F.lds + 16384);
    LAS float* outv = (LAS float*)(F.lds + 16384 + 32 * 132 * 4);
    const int tid = F.tid, lane = F.lane, wave = F.wave, r = lane & 31, h = lane >> 5, ct = wave & 3, kh = wave >> 2;
    f32x16 acc;
#pragma unroll
    for (int i = 0; i < 16; ++i) acc[i] = 0.f;
    {
        int trow = 16 * (n0 + r) + 16 * kh; const int tmax = T - 1;
        const bf16_t* Ab = P + (size_t)(b * T) * NPC + (j ? PVC : PKC) + g * HD + 8 * h;
        const bf16_t* Bb = (const bf16_t*)(F.ws + WS_MISC + MISC_WC1) + (size_t)(j * HD + 32 * ct + r) * 4096 + (size_t)(16 * kh) * HD + 8 * h;
        for (int l = 0; l < 16; ++l) { const int t = (trow + l) < tmax ? (trow + l) : tmax; const bf16_t* ap = Ab + (size_t)t * NPC; const bf16_t* bp = Bb + l * HD;
#pragma unroll
            for (int ds = 0; ds < 8; ++ds) { const bf16x8 av = *(const bf16x8*)(ap + 16 * ds), bv = *(const bf16x8*)(bp + 16 * ds); acc = MFMA32(av, bv, acc); } }
    }
    if (kh == 1) {
#pragma unroll
        for (int i = 0; i < 16; ++i) red[(ct * 16 + i) * 64 + lane] = acc[i]; }
    __syncthreads();
    if (kh == 0) { float cv = 0.f; { const float* cp = (const float*)(F.ctl + CW_CVEC) + (size_t)(j * 32) * 128 + 32 * ct + r;
#pragma unroll 8
        for (int q = 0; q < 32; ++q) cv += cp[q * 128]; }
#pragma unroll
        for (int i = 0; i < 16; ++i) { const float x = acc[i] + red[(ct * 16 + i) * 64 + lane] + cv;
            const float y = 0.7978845608028654f * (x + 0.044715f * x * x * x);
            const float th = 1.f - 2.f * fast_rcp(1.f + fast_exp2(2.f * y * LOG2E));
            hid[crow(i, h) * 132 + 32 * ct + r] = 0.5f * x * (1.f + th); } }
    __syncthreads();
    { const int e2 = tid & 127, ng = __builtin_amdgcn_readfirstlane(tid >> 7); const float* w2 = a->in[I_CW2] + (size_t)(layer * 2 + j) * HD * HD + e2;
      float o[8];
#pragma unroll
      for (int q = 0; q < 8; ++q) o[q] = 0.f;
      for (int k = 0; k < 128; k += 4) { const float w0 = w2[(size_t)k * HD], w1 = w2[(size_t)(k + 1) * HD], w2_ = w2[(size_t)(k + 2) * HD], w3 = w2[(size_t)(k + 3) * HD];
#pragma unroll
          for (int q = 0; q < 8; ++q) { const f32x4 hv = *(const LAS f32x4*)(hid + (8 * ng + q) * 132 + k); o[q] += (hv.x * w0 + hv.y * w1) + (hv.z * w2_ + hv.w * w3); } }
#pragma unroll
      for (int q = 0; q < 8; ++q) outv[(8 * ng + q) * 132 + e2] = o[q]; }
    __syncthreads();
    const float* kg0 = a->in[I_KG] + layer * 3 * HD;
#pragma unroll
    for (int q = 0; q < 4; ++q) { const int n = 4 * wave + q; float v0 = outv[n * 132 + 2 * lane], v1 = outv[n * 132 + 2 * lane + 1];
        if (j == 0) { const float ss = wave_sum(v0 * v0 + v1 * v1); const float rr = rsqrtf(ss * (1.f / HD) + EPS); v0 *= rr * kg0[2 * lane]; v1 *= rr * kg0[2 * lane + 1]; }
        if (n0 + n >= 127) { v0 = 0.f; v1 = 0.f; }
        bf16_t* dst = (bf16_t*)(F.ws + WS_MISC + (j ? MISC_VCMP : MISC_KCMP)) + (size_t)((b * 2 + g) * 128 + n0 + n) * HD;
        *((unsigned*)dst + lane) = pk2(v0, v1); }
}
__device__ __forceinline__ float xhalf_sum(float v);
constexpr int HG_Q1 = 0, HG_K1 = 17408, HG_QI = 34816, HG_K2 = 43520, HG_K3T = 52224, HG_VT = 70656, HG_AT = 89088, HG_SB = 98304, HG_TOT = 133120, HG_LB = 135168, HG_SS = 135680;
__device__ __forceinline__ void item_hgrn(Frame& F, KArgs a, int layer, int id) {
    const int b = id >> 3, hh = id & 7;
    const bf16_t* P = (const bf16_t*)(F.ws + WS_P); bf16_t* OH = (bf16_t*)(F.ws + WS_OBR);
    LAS unsigned char* L = F.lds;
    LAS float* tot = (LAS float*)(L + HG_TOT); LAS float* lbs = (LAS float*)(L + HG_LB); LAS float* ssp = (LAS float*)(L + HG_SS);
    const int tid = F.tid, lane = F.lane, wave = F.wave, r = lane & 31, h = lane >> 5;
    if (tid < 128) { const float* hb = a->in[I_HLB] + hh * HD + tid; const float x0 = hb[0], x1 = hb[1024], x2 = hb[2048], x3 = hb[3072];
        const float mx = fmaxf(fmaxf(x0, x1), fmaxf(x2, x3)); const float e0 = __expf(x0 - mx), e1 = __expf(x1 - mx), e2 = __expf(x2 - mx), e3 = __expf(x3 - mx);
        const float inv = 1.f / (e0 + e1 + e2 + e3); float c = 0.f; if (layer >= 1) c += e1; if (layer >= 2) c += e2; if (layer >= 3) c += e3;
        lbs[tid] = fmaxf(c * inv, 0.f); }
    { unsigned zu; asm volatile("v_mov_b32 %0, 0" : "=v"(zu));
      for (int i = tid; i < 34816 / 16; i += 512) *(LAS u32x4*)(L + HG_SB + i * 16) = (u32x4){zu, zu, zu, zu}; }
    f32x16 Sacc[2];
#pragma unroll
    for (int q = 0; q < 2; ++q)
#pragma unroll
        for (int i = 0; i < 16; ++i) Sacc[q][i] = 0.f;
    const int pd = tid & 127, psc = __builtin_amdgcn_readfirstlane(tid >> 7);
    const int srow = tid >> 4, sch = tid & 15;
    const bf16_t* gq = P + (size_t)(b * T + srow) * NPC + PQH + hh * HD + sch * 8; const bf16_t* gf = P + (size_t)(b * T + srow) * NPC + PFH + hh * HD + sch * 8;
    const bf16_t* gv = P + (size_t)(b * T + srow) * NPC + PIH + hh * HD + sch * 8;
    u32x4 rq0 = *(const u32x4*)gq, rq1 = *(const u32x4*)(gq + (size_t)32 * NPC), rf0 = *(const u32x4*)gf, rf1 = *(const u32x4*)(gf + (size_t)32 * NPC), rv0 = *(const u32x4*)gv, rv1 = *(const u32x4*)(gv + (size_t)32 * NPC);
    const int et = wave & 3, tt2 = wave >> 2;
    f32x4 gn4[4]; { const float* ng = a->in[I_HNG] + layer * HD;
#pragma unroll
      for (int g4 = 0; g4 < 4; ++g4) gn4[g4] = *(const f32x4*)(ng + 32 * et + 8 * g4 + 4 * h); }
    u32x2 gw4[4];
    for (int c = 0; c < T / 64; ++c) {
        __syncthreads();
        *(LAS u32x4*)(L + HG_Q1 + srow * 272 + sch * 16) = rq0; *(LAS u32x4*)(L + HG_Q1 + (srow + 32) * 272 + sch * 16) = rq1;
        *(LAS u32x4*)(L + HG_K1 + srow * 272 + sch * 16) = rf0; *(LAS u32x4*)(L + HG_K1 + (srow + 32) * 272 + sch * 16) = rf1;
        { const unsigned v0[4] = {rv0.x, rv0.y, rv0.z, rv0.w}, v1[4] = {rv1.x, rv1.y, rv1.z, rv1.w};
#pragma unroll
          for (int q = 0; q < 4; ++q) { LAS unsigned short* p0 = (LAS unsigned short*)(L + HG_VT + (8 * sch + 2 * q) * 144 + srow * 2); LAS unsigned short* p1 = (LAS unsigned short*)(L + HG_VT + (8 * sch + 2 * q + 1) * 144 + srow * 2);
              p0[0] = (unsigned short)(v0[q] & 0xffffu); p1[0] = (unsigned short)(v0[q] >> 16); p0[32] = (unsigned short)(v1[q] & 0xffffu); p1[32] = (unsigned short)(v1[q] >> 16); } }
        __syncthreads();
        { const bf16_t* gp = P + (size_t)(b * T + 64 * c + 32 * tt2 + r) * NPC + PGH + hh * HD + 32 * et + 4 * h;
#pragma unroll
          for (int g4 = 0; g4 < 4; ++g4) gw4[g4] = *(const u32x2*)(gp + 8 * g4); }
        if (c + 1 < T / 64) { const size_t adv = (size_t)(64 * (c + 1)) * NPC;
            rq0 = *(const u32x4*)(gq + adv); rq1 = *(const u32x4*)(gq + adv + (size_t)32 * NPC); rf0 = *(const u32x4*)(gf + adv); rf1 = *(const u32x4*)(gf + adv + (size_t)32 * NPC);
            rv0 = *(const u32x4*)(gv + adv); rv1 = *(const u32x4*)(gv + adv + (size_t)32 * NPC); }
        float qv[16], kv[16], bl[16];
        { const float lb = lbs[pd]; float run = 0.f;
#pragma unroll
          for (int tt = 0; tt < 16; ++tt) { const int t = 16 * psc + tt;
              qv[tt] = bf2f(*(const LAS unsigned short*)(L + HG_Q1 + t * 272 + pd * 2)); const float fp = bf2f(*(const LAS unsigned short*)(L + HG_K1 + t * 272 + pd * 2));
              const float ex = fast_exp2(-fabsf(fp) * LOG2E);
              const float sg = (fp >= 0.f ? 1.f : ex) * fast_rcp(1.f + ex);
              const float f = lb + (1.f - lb) * sg; kv[tt] = 1.f - f;
              const float lf = (layer == 0) ? (fminf(fp, 0.f) - LN2 * fast_log2(1.f + ex)) : LN2 * fast_log2(f);
              run += lf; bl[tt] = run; }
          tot[psc * 128 + pd] = run; }
        __syncthreads();
        { const float t0 = tot[pd], t1 = tot[128 + pd], t2 = tot[256 + pd], t3 = tot[384 + pd];
          const float b31 = t0 + t1, b63 = (t0 + t1) + (t2 + t3);
          const float pre = psc == 0 ? 0.f : (psc == 1 ? t0 : (psc == 2 ? b31 : b31 + t2));
          const float rref = psc >= 2 ? b31 : 0.f; const float eb31 = fast_exp2(b31 * LOG2E), c3 = fast_exp2((b63 - rref) * LOG2E);
          unsigned k3w[8];
#pragma unroll
          for (int tt = 0; tt < 16; ++tt) { const int t = 16 * psc + tt; const float bb = pre + bl[tt];
              const float e1 = fast_exp2((bb - rref) * LOG2E); const float q1 = qv[tt] * e1;
              const float k1 = kv[tt] * fast_exp2(fminf(rref - bb, 80.f) * LOG2E);
              const float k3 = k1 * c3;
              *(LAS unsigned short*)(L + HG_Q1 + t * 272 + pd * 2) = (unsigned short)(pk2(q1, 0.f) & 0xffffu);
              *(LAS unsigned short*)(L + HG_K1 + t * 272 + pd * 2) = (unsigned short)(pk2(k1, 0.f) & 0xffffu);
              if (psc >= 2) *(LAS unsigned short*)(L + HG_QI + (t - 32) * 272 + pd * 2) = (unsigned short)(pk2(q1 * eb31, 0.f) & 0xffffu);
              else *(LAS unsigned short*)(L + HG_K2 + t * 272 + pd * 2) = (unsigned short)(pk2(k1 * eb31, 0.f) & 0xffffu);
              if (tt & 1) k3w[tt >> 1] = (k3w[tt >> 1] & 0xffffu) | (pk2(0.f, k3) & 0xffff0000u); else k3w[tt >> 1] = pk2(k3, 0.f) & 0xffffu; }
          *(LAS u32x4*)(L + HG_K3T + pd * 144 + psc * 32) = (u32x4){k3w[0], k3w[1], k3w[2], k3w[3]}; *(LAS u32x4*)(L + HG_K3T + pd * 144 + psc * 32 + 16) = (u32x4){k3w[4], k3w[5], k3w[6], k3w[7]}; }
        __syncthreads();
        if (wave < 3) {
            const int st = wave == 1 ? 1 : 0, ta = wave == 0 ? 0 : 1;
            const LAS unsigned char* Kb = L + (wave == 2 ? HG_K2 : HG_K1 + st * 32 * 272) + r * 272 + 16 * h; const LAS unsigned char* Qb = L + HG_Q1 + (32 * ta + r) * 272 + 16 * h;
            f32x16 at;
#pragma unroll
            for (int i = 0; i < 16; ++i) at[i] = 0.f;
#pragma unroll
            for (int s8 = 0; s8 < 8; ++s8) at = MFMA32(*(const LAS bf16x8*)(Kb + 32 * s8), *(const LAS bf16x8*)(Qb + 32 * s8), at);
            if (wave < 2) {
#pragma unroll
                for (int i = 0; i < 16; ++i) at[i] = (crow(i, h) <= r) ? at[i] : 0.f; }
#pragma unroll
            for (int g4 = 0; g4 < 4; ++g4) { u32x2 w; w.x = pk2(at[4 * g4], at[4 * g4 + 1]); w.y = pk2(at[4 * g4 + 2], at[4 * g4 + 3]);
                *(LAS u32x2*)(L + HG_AT + (32 * ta + r) * 144 + (32 * st + 8 * g4 + 4 * h) * 2) = w; }
        }
        f32x16 oo;
#pragma unroll
        for (int i = 0; i < 16; ++i) oo[i] = 0.f;
        { const LAS unsigned char* Sb = L + HG_SB + (32 * et + r) * 272 + 16 * h; const LAS unsigned char* Qb = L + (tt2 ? HG_QI : HG_Q1) + r * 272 + 16 * h;
#pragma unroll
          for (int s8 = 0; s8 < 8; ++s8) oo = MFMA32(*(const LAS bf16x8*)(Sb + 32 * s8), *(const LAS bf16x8*)(Qb + 32 * s8), oo); }
        __syncthreads();
#pragma unroll
        for (int q = 0; q < 2; ++q) { const int dt = (wave >> 2) + 2 * q, dd = 32 * dt + r;
            const float eb63 = fast_exp2(((tot[dd] + tot[128 + dd]) + (tot[256 + dd] + tot[384 + dd])) * LOG2E);
#pragma unroll
            for (int i = 0; i < 16; ++i) Sacc[q][i] *= eb63;
            const LAS unsigned char* Vb = L + HG_VT + (32 * et + r) * 144 + 16 * h; const LAS unsigned char* Kb = L + HG_K3T + dd * 144 + 16 * h;
#pragma unroll
            for (int s4 = 0; s4 < 4; ++s4) Sacc[q] = MFMA32(*(const LAS bf16x8*)(Vb + 32 * s4), *(const LAS bf16x8*)(Kb + 32 * s4), Sacc[q]);
            LAS unsigned char* Sw = L + HG_SB + dd * 2;
#pragma unroll
            for (int i = 0; i < 16; i += 2) { const unsigned w = pk2(Sacc[q][i], Sacc[q][i + 1]);
                *(LAS unsigned short*)(Sw + (32 * et + crow(i, h)) * 272) = (unsigned short)(w & 0xffffu); *(LAS unsigned short*)(Sw + (32 * et + crow(i + 1, h)) * 272) = (unsigned short)(w >> 16); } }
        { const LAS unsigned char* Vb = L + HG_VT + (32 * et + r) * 144 + 16 * h; const LAS unsigned char* Ab = L + HG_AT + (32 * tt2 + r) * 144 + 16 * h;
          oo = MFMA32(*(const LAS bf16x8*)(Vb), *(const LAS bf16x8*)(Ab), oo); oo = MFMA32(*(const LAS bf16x8*)(Vb + 32), *(const LAS bf16x8*)(Ab + 32), oo);
          if (tt2) { oo = MFMA32(*(const LAS bf16x8*)(Vb + 64), *(const LAS bf16x8*)(Ab + 64), oo); oo = MFMA32(*(const LAS bf16x8*)(Vb + 96), *(const LAS bf16x8*)(Ab + 96), oo); } }
        { float ss = 0.f;
#pragma unroll
          for (int i = 0; i < 16; ++i) ss += oo[i] * oo[i];
          ss = xhalf_sum(ss);
          if (h == 0) ssp[(32 * tt2 + r) * 4 + et] = ss; }
        __syncthreads();
        { const f32x4 s4 = *(const LAS f32x4*)(ssp + (32 * tt2 + r) * 4); const float rn = rsqrtf(((s4.x + s4.y) + (s4.z + s4.w)) * (1.f / HD) + EPS);
          const size_t row = (size_t)(b * T + 64 * c + 32 * tt2 + r);
#pragma unroll
          for (int g4 = 0; g4 < 4; ++g4) { const int e0 = 32 * et + 8 * g4 + 4 * h;
              const u32x2 gw = gw4[g4]; const f32x4 gn = gn4[g4];
              u32x2 w; w.x = pk2(oo[4 * g4] * rn * gn.x * sigmoidf_(bflo(gw.x)), oo[4 * g4 + 1] * rn * gn.y * sigmoidf_(bfhi(gw.x)));
              w.y = pk2(oo[4 * g4 + 2] * rn * gn.z * sigmoidf_(bflo(gw.y)), oo[4 * g4 + 3] * rn * gn.w * sigmoidf_(bfhi(gw.y)));
              *(u32x2*)(OH + akm(row, 2 * BW + hh * HD + e0)) = w; } }
    }
}

constexpr int AT_K = 0, AT_V = 32768, AT_TAB = 73728, AT_IMP = 75776, AT_SELM = 109568, AT_MISC = 109824;
constexpr int K_TB = 16384, V_RS = 320, V_TB = 64 * V_RS;
__device__ __forceinline__ unsigned koff(int row, int ch) { return 256u * (unsigned)row + 16u * (unsigned)(ch ^ (((row & 3) << 2) | ((row >> 2) & 3))); }
struct Stg { u32x4 k0, k1, v0, v1; };
__device__ __forceinline__ void stg_load(Stg& s, const bf16_t* Kp, const bf16_t* Vp, int ld, int tid) {
    const int row = tid >> 4, ch = tid & 15;
    s.k0 = *(const u32x4*)(Kp + (size_t)row * ld + ch * 8); s.k1 = *(const u32x4*)(Kp + (size_t)(row + 32) * ld + ch * 8);
    s.v0 = *(const u32x4*)(Vp + (size_t)row * ld + ch * 8); s.v1 = *(const u32x4*)(Vp + (size_t)(row + 32) * ld + ch * 8);
}
__device__ __forceinline__ void stg_write(const Stg& s, LAS unsigned char* L, int tid, int buf) {
    const int row = tid >> 4, ch = tid & 15;
    *(LAS u32x4*)(L + AT_K + buf * K_TB + koff(row, ch)) = s.k0; *(LAS u32x4*)(L + AT_K + buf * K_TB + koff(row + 32, ch)) = s.k1;
    *(LAS u32x4*)(L + AT_V + buf * V_TB + row * V_RS + ch * 16) = s.v0; *(LAS u32x4*)(L + AT_V + buf * V_TB + (row + 32) * V_RS + ch * 16) = s.v1;
}
__device__ __forceinline__ float xhalf_max(float v) { auto rr = __builtin_amdgcn_permlane32_swap(__float_as_uint(v), __float_as_uint(v), false, false); return fmaxf(__uint_as_float(rr[0]), __uint_as_float(rr[1])); }
__device__ __forceinline__ float xhalf_sum(float v) { auto rr = __builtin_amdgcn_permlane32_swap(__float_as_uint(v), __float_as_uint(v), false, false); return __uint_as_float(rr[0]) + __uint_as_float(rr[1]); }
__device__ __forceinline__ float xhalf_get(float v, int h) { auto rr = __builtin_amdgcn_permlane32_swap(__float_as_uint(v), __float_as_uint(v), false, false); return __uint_as_float(h ? rr[0] : rr[1]); }
__device__ __forceinline__ void qk_tile(f32x16& p0, f32x16& p1, const LAS unsigned char* L, int buf, const bf16x8 (&qf)[8], int r, int h, const float init = 0.f) {
#pragma unroll
    for (int i = 0; i < 16; ++i) { p0[i] = init; p1[i] = init; }
    const LAS unsigned char* Kb = L + AT_K + buf * K_TB;
    bf16x8 a0[8], a1[8];
#pragma unroll
    for (int s = 0; s < 8; ++s) { a0[s] = *(const LAS bf16x8*)(Kb + koff(r, 2 * s + h)); a1[s] = *(const LAS bf16x8*)(Kb + koff(r + 32, 2 * s + h)); }
#pragma unroll
    for (int s = 0; s < 8; ++s) { p0 = MFMA32(a0[s], qf[s], p0); p1 = MFMA32(a1[s], qf[s], p1); }
    __builtin_amdgcn_sched_group_barrier(0x100, 4, 0);
#pragma unroll
    for (int i = 0; i < 6; ++i) { __builtin_amdgcn_sched_group_barrier(0x008, 2, 0); __builtin_amdgcn_sched_group_barrier(0x100, 2, 0); }
    __builtin_amdgcn_sched_group_barrier(0x008, 4, 0);
}
__device__ __forceinline__ bf16x8 pack8(const f32x16& p, int s) {
    u32x4 w; w.x = pk2(p[8 * s], p[8 * s + 1]); w.y = pk2(p[8 * s + 2], p[8 * s + 3]); w.z = pk2(p[8 * s + 4], p[8 * s + 5]); w.w = pk2(p[8 * s + 6], p[8 * s + 7]);
    return __builtin_bit_cast(bf16x8, w);
}
__device__ __forceinline__ void pv_tile(f32x16 (&o)[4], const f32x16& p0, const f32x16& p1, const LAS unsigned char* L, int buf, int lane) {
    bf16x8 pb[4]; pb[0] = pack8(p0, 0); pb[1] = pack8(p0, 1); pb[2] = pack8(p1, 0); pb[3] = pack8(p1, 1);
    const LAS unsigned char* vb = L + AT_V + buf * V_TB + (4 * (lane >> 5) + ((lane & 15) >> 2)) * V_RS + ((lane >> 4) & 1) * 32 + (lane & 3) * 8;
    __builtin_amdgcn_sched_barrier(0);
    s16x4 lo[16], hi[16];
#pragma unroll
    for (int c = 0; c < 4; ++c)
#pragma unroll
        for (int s = 0; s < 4; ++s) { lo[4 * c + s] = __builtin_amdgcn_ds_read_tr16_b64_v4i16((LAS s16x4*)(vb + (16 * s) * V_RS + 64 * c)); hi[4 * c + s] = __builtin_amdgcn_ds_read_tr16_b64_v4i16((LAS s16x4*)(vb + (16 * s + 8) * V_RS + 64 * c)); }
#pragma unroll
    for (int c = 0; c < 4; ++c)
#pragma unroll
        for (int s = 0; s < 4; ++s) o[c] = MFMA32(__builtin_shufflevector(lo[4 * c + s], hi[4 * c + s], 0, 1, 2, 3, 4, 5, 6, 7), pb[s], o[c]);
    __builtin_amdgcn_sched_group_barrier(0x100, 4, 1);
#pragma unroll
    for (int i = 0; i < 14; ++i) { __builtin_amdgcn_sched_group_barrier(0x008, 1, 1); __builtin_amdgcn_sched_group_barrier(0x100, 2, 1); }
    __builtin_amdgcn_sched_group_barrier(0x008, 2, 1);
    __builtin_amdgcn_sched_barrier(0);
}
__device__ __forceinline__ void softmax_step(f32x16& p0, f32x16& p1, float& m, float& l, f32x16 (&o)[4]) {
    float mx = p0[0];
#pragma unroll
    for (int i = 1; i < 16; ++i) mx = fmaxf(mx, p0[i]);
#pragma unroll
    for (int i = 0; i < 16; ++i) mx = fmaxf(mx, p1[i]);
    mx = xhalf_max(mx);
    const float mn = fmaxf(m, mx); const float alpha = fast_exp2((m - mn) * LOG2E); m = mn;
    const float mb = mn * LOG2E; float ps = 0.f;
#pragma unroll
    for (int i = 0; i < 16; ++i) { p0[i] = fast_exp2(p0[i] * LOG2E - mb); ps += p0[i]; }
#pragma unroll
    for (int i = 0; i < 16; ++i) { p1[i] = fast_exp2(p1[i] * LOG2E - mb); ps += p1[i]; }
    ps = xhalf_sum(ps);
    l = l * alpha + ps;
    if (!__all(alpha == 1.f)) {
#pragma unroll
        for (int c = 0; c < 4; ++c)
#pragma unroll
            for (int i = 0; i < 16; ++i) o[c][i] *= alpha; }
}
__device__ __forceinline__ void store_ot(const f32x16 (&o)[4], float sc, bf16_t* base, size_t row, int col  , int h, bool add) {
    bf16_t* p0 = base + akm(row, col) + 4 * h;
#pragma unroll
    for (int c = 0; c < 4; ++c)
#pragma unroll
        for (int g4 = 0; g4 < 4; ++g4) { u32x2* p = (u32x2*)(p0 + (size_t)(c >> 1) * ((size_t)M * 64) + 32 * (c & 1) + 8 * g4);
            float v0 = sc * o[c][4 * g4], v1 = sc * o[c][4 * g4 + 1], v2 = sc * o[c][4 * g4 + 2], v3 = sc * o[c][4 * g4 + 3];
            if (add) { const u32x2 w0 = *p; v0 += bflo(w0.x); v1 += bfhi(w0.x); v2 += bflo(w0.y); v3 += bfhi(w0.y); }
            u32x2 w; w.x = pk2(v0, v1); w.y = pk2(v2, v3); *p = w; }
}

__device__ __forceinline__ void item_sb(Frame& F, KArgs a, int item) {
    LAS unsigned char* L = F.lds;
    const int qb = 7 - (item >> 7), rem = item & 127, b = rem >> 3, hh = rem & 7, t0 = qb * 256;
    const int tid = F.tid, lane = F.lane, wave = F.wave, r = lane & 31, h = lane >> 5;
    const int tq = t0 + 32 * wave + r;
    const bf16_t* P = (const bf16_t*)(F.ws + WS_P); const size_t rowq = (size_t)(b * T + tq);
    const bf16_t* Kb = P + (size_t)(b * T) * NPC + PKSB + hh * HD; const bf16_t* Vb = P + (size_t)(b * T) * NPC + PVSB + hh * HD;
    bf16x8 qf[8];
#pragma unroll
    for (int s = 0; s < 8; ++s) qf[s] = *(const bf16x8*)(P + rowq * NPC + PQS + hh * HD + 16 * s + 8 * h);
    f32x16 o[4];
#pragma unroll
    for (int c = 0; c < 4; ++c)
#pragma unroll
        for (int i = 0; i < 16; ++i) o[c][i] = 0.f;
    float C = 1.f; bool wdone = false;
    volatile LAS unsigned* flags = (volatile LAS unsigned*)(L + AT_MISC);
    Stg st; int j = 4 * qb + 3, buf = 0, it = 0;
    stg_load(st, Kb + (size_t)(64 * j) * NPC, Vb + (size_t)(64 * j) * NPC, NPC, tid);
    __syncthreads();
    stg_write(st, L, tid, 0);
    if (j > 0) stg_load(st, Kb + (size_t)(64 * (j - 1)) * NPC, Vb + (size_t)(64 * (j - 1)) * NPC, NPC, tid);
    for (;;) {
        if (lane == 0) flags[(it & 1) * 8 + wave] = wdone ? 1u : 0u;
        __syncthreads();
        unsigned nd = 0;
#pragma unroll
        for (int w = 0; w < 8; ++w) nd += flags[(it & 1) * 8 + w];
        if (__builtin_amdgcn_readfirstlane(nd) == 8u) break;
        if (j > 0) stg_write(st, L, tid, buf ^ 1);
        if (j > 1) stg_load(st, Kb + (size_t)(64 * (j - 2)) * NPC, Vb + (size_t)(64 * (j - 2)) * NPC, NPC, tid);
        const bool active = !wdone && (64 * j <= t0 + 32 * wave + 30);
        if (active) {
            f32x16 p0, p1; qk_tile(p0, p1, L, buf, qf, r, h);
            float om0[16], om1[16];
            const int kb = 64 * j + 4 * h;
#define SB_ELEM(MASK) do { _Pragma("unroll") for (int i = 0; i < 16; ++i) { const int key0 = kb + (i & 3) + 8 * (i >> 2); \
                { const float pz = p0[i]; const float ex = fast_exp2(-fabsf(pz) * (QSCALE * LOG2E)); const float rr = fast_rcp(1.f + ex), er = ex * rr; const bool pos = pz >= 0.f; \
                  float be = pos ? rr : er, om = pos ? er : rr; if (MASK) { const bool cz = key0 < tq; om = cz ? om : 1.f; be = cz ? be : 0.f; } om0[i] = om; p0[i] = be; } \
                { const float pz = p1[i]; const float ex = fast_exp2(-fabsf(pz) * (QSCALE * LOG2E)); const float rr = fast_rcp(1.f + ex), er = ex * rr; const bool pos = pz >= 0.f; \
                  float be = pos ? rr : er, om = pos ? er : rr; if (MASK) { const bool cz = key0 + 32 < tq; om = cz ? om : 1.f; be = cz ? be : 0.f; } om1[i] = om; p1[i] = be; } } } while (0)
            SB_ELEM(false);
#undef SB_ELEM
            if (64 * j + 63 >= t0 + 32 * wave) {
#pragma unroll
                for (int i = 0; i < 16; ++i) { const int key0 = kb + (i & 3) + 8 * (i >> 2); const bool c0 = key0 < tq, c1 = key0 + 32 < tq;
                    om0[i] = c0 ? om0[i] : 1.f; p0[i] = c0 ? p0[i] : 0.f; om1[i] = c1 ? om1[i] : 1.f; p1[i] = c1 ? p1[i] : 0.f; } }
            float Tm[2][4], Tr[2][4];
#pragma unroll
            for (int g4 = 0; g4 < 4; ++g4) { Tm[0][g4] = (om0[4 * g4] * om0[4 * g4 + 1]) * (om0[4 * g4 + 2] * om0[4 * g4 + 3]); Tm[1][g4] = (om1[4 * g4] * om1[4 * g4 + 1]) * (om1[4 * g4 + 2] * om1[4 * g4 + 3]); }
#pragma unroll
            for (int k = 0; k < 2; ++k)
#pragma unroll
                for (int g4 = 0; g4 < 4; ++g4) Tr[k][g4] = xhalf_get(Tm[k][g4], h);
            float aft[2][4]; float run = C;
#pragma unroll
            for (int G = 15; G >= 0; --G) { const int k = G >> 3, g4 = (G >> 1) & 3, par = G & 1;
                const float tg = (par == 1) ? (h ? Tm[k][g4] : Tr[k][g4]) : (h ? Tr[k][g4] : Tm[k][g4]);
                if (par == 1) { if (h) aft[k][g4] = run; } else { if (!h) aft[k][g4] = run; }
                run *= tg; }
            C = run;
#pragma unroll
            for (int g4 = 0; g4 < 4; ++g4) {
                { float ca = aft[0][g4];
#pragma unroll
                  for (int e = 3; e >= 0; --e) { const int i = 4 * g4 + e; const float w_ = p0[i] * ca; ca *= om0[i]; p0[i] = w_; } }
                { float ca = aft[1][g4];
#pragma unroll
                  for (int e = 3; e >= 0; --e) { const int i = 4 * g4 + e; const float w_ = p1[i] * ca; ca *= om1[i]; p1[i] = w_; } }
            }
            pv_tile(o, p0, p1, L, buf, lane);
            wdone = __all(C < 1e-30f);
        }
        if (j == 0) break;
        --j; buf ^= 1; ++it;
    }
    store_ot(o, 1.f, (bf16_t*)(F.ws + WS_OBR), rowq, BW + hh * HD, h, false);
}

__device__ __forceinline__ void item_nsa(Frame& F, KArgs a, int item) {
    LAS unsigned char* L = F.lds;
    const int qblk = 31 - (item >> 5), rem = item & 31, b = rem >> 1, g = rem & 1, t0 = qblk * 64;
    const int tid = F.tid, lane = F.lane, wave = F.wave, r = lane & 31, h = lane >> 5, hr = wave >> 1, th = wave & 1;
    const int tl = 32 * th + r, tq = t0 + tl, hq = g * 4 + hr;
    const bf16_t* P = (const bf16_t*)(F.ws + WS_P);
    LAS float* tab = (LAS float*)(L + AT_TAB); LAS float* imp = (LAS float*)(L + AT_IMP); volatile LAS unsigned* selm = (volatile LAS unsigned*)(L + AT_SELM); LAS unsigned* misc = (LAS unsigned*)(L + AT_MISC);
    { const int hh = tid >> 7, dd = tid & 127; tab[tid] = a->in[I_RELB][t5_bucket(dd) * 8 + g * 4 + hh]; }
    if (tid == 0) misc[0] = 0u;
    bf16x8 qf[8];
#pragma unroll
    for (int s = 0; s < 8; ++s) qf[s] = *(const bf16x8*)(P + (size_t)(b * T + tq) * NPC + PQN + hq * HD + 16 * s + 8 * h);
    f32x16 o[4];
    Stg st;
    auto opq = [](int v) { asm volatile("" : "+v"(v)); return v; };
#define NSA_GATE(i) sigmoidf_(bf2f(P[((size_t)(b * T + opq(tq))) * NPC + PGN + hq * 3 + (i)]))
#define NSA_OUT() (bf16_t*)(F.ws + WS_OBR), (size_t)(b * T + opq(tq)), hq * HD
    {
        const bf16_t* kc = (const bf16_t*)(F.ws + WS_MISC + MISC_KCMP) + (size_t)((b * 2 + g) * 128) * HD; const bf16_t* vc = (const bf16_t*)(F.ws + WS_MISC + MISC_VCMP) + (size_t)((b * 2 + g) * 128) * HD;
        const bool two = qblk >= 16;
        f32x16 pc[4];
        __syncthreads();
        { Stg st1; stg_load(st, kc, vc, HD, tid); if (two) stg_load(st1, kc + 64 * HD, vc + 64 * HD, HD, tid);
          stg_write(st, L, tid, 0); if (two) stg_write(st1, L, tid, 1); }
        __syncthreads();
        qk_tile(pc[0], pc[1], L, 0, qf, r, h);
        if (two) qk_tile(pc[2], pc[3], L, 1, qf, r, h);
        float mx = -1e30f;
#pragma unroll
        for (int k = 0; k < 4; ++k) { if (k >= 2 && !two) break;
#pragma unroll
            for (int i = 0; i < 16; ++i) { const int n = 32 * k + crow(i, h); const int dc = tq - (16 * n + 31); const int di = dc < 113 ? dc : 113;
                const float sv = dc >= 0 ? pc[k][i] + tab[hr * 128 + (di < 0 ? 0 : di)] : -__builtin_inff(); pc[k][i] = sv; mx = fmaxf(mx, sv); } }
        mx = xhalf_max(mx);
        float sum = 0.f;
#pragma unroll
        for (int k = 0; k < 4; ++k) { if (k >= 2 && !two) break;
#pragma unroll
            for (int i = 0; i < 16; ++i) { const float e = fast_exp2((pc[k][i] - mx) * LOG2E); pc[k][i] = e; sum += e; } }
        sum = xhalf_sum(sum);
        const float inv = 1.f / fmaxf(sum, 1e-30f);
#pragma unroll
        for (int k = 0; k < 4; ++k)
#pragma unroll
            for (int i = 0; i < 16; ++i) pc[k][i] = (k >= 2 && !two) ? 0.f : pc[k][i] * inv;
        float gs[16], gl[16], rc[16];
#pragma unroll
        for (int k = 0; k < 4; ++k)
#pragma unroll
            for (int g4 = 0; g4 < 4; ++g4) { gs[4 * k + g4] = (pc[k][4 * g4] + pc[k][4 * g4 + 1]) + (pc[k][4 * g4 + 2] + pc[k][4 * g4 + 3]); gl[4 * k + g4] = pc[k][4 * g4 + 3]; }
#pragma unroll
        for (int f = 0; f < 16; ++f) rc[f] = xhalf_get(gl[f], h);
#pragma unroll
        for (int f = 0; f < 16; ++f) { const float prev = h ? rc[f] : (f >= 1 ? rc[f - 1] : 0.f); const int G = 8 * (f >> 2) + 2 * (f & 3) + h;
            imp[(hr * 64 + tl) * 33 + G] = gs[f] + prev; }
#pragma unroll
        for (int c = 0; c < 4; ++c)
#pragma unroll
            for (int i = 0; i < 16; ++i) o[c][i] = 0.f;
        pv_tile(o, pc[0], pc[1], L, 0, lane);
        if (two) pv_tile(o, pc[2], pc[3], L, 1, lane);
        store_ot(o, NSA_GATE(0), NSA_OUT(), h, false);
    }
    __syncthreads();
    const int tk = tid >> 3, part = tid & 7;
    if (qblk >= 16) {
#pragma unroll
        for (int q = 0; q < 4; ++q) { const int jj = part + 8 * q; imp[tk * 33 + jj] = (imp[tk * 33 + jj] + imp[(64 + tk) * 33 + jj]) + (imp[(128 + tk) * 33 + jj] + imp[(192 + tk) * 33 + jj]); }
    }
    __syncthreads();
    {
        unsigned msk;
        if (qblk < 16) msk = (2u << qblk) - 1u;
        else {
            msk = 0u;
#pragma unroll
            for (int q = 0; q < 4; ++q) { const int jj = part + 8 * q;
                if (jj >= 1 && jj <= qblk - 2) { const float v = imp[tk * 33 + jj]; int rank = 0;
#pragma unroll
                    for (int j2 = 1; j2 < 30; ++j2) { const float v2 = imp[tk * 33 + j2]; rank += (j2 <= qblk - 2 && (v2 > v || (v2 == v && j2 < jj))) ? 1 : 0; }
                    if (rank < 13) msk |= 1u << jj; } }
            msk |= (unsigned)__shfl_xor((int)msk, 1); msk |= (unsigned)__shfl_xor((int)msk, 2); msk |= (unsigned)__shfl_xor((int)msk, 4);
            msk |= 1u | (1u << (qblk - 1)) | (1u << qblk);
        }
        if (part == 0) selm[tk] = msk;
        unsigned om = msk;
#pragma unroll
        for (int off = 8; off < 64; off <<= 1) om |= (unsigned)__shfl_xor((int)om, off);
        if (lane == 0) __hip_atomic_fetch_or(misc, om, __ATOMIC_RELAXED, __HIP_MEMORY_SCOPE_WORKGROUP);
    }
    __syncthreads();
    const bf16_t* Kbase = P + (size_t)(b * T) * NPC + g * HD;
    const float bfar = tab[hr * 128 + 113];
    for (int rep = 0; rep < (MK_PROBE == 31 ? 2 : 1); ++rep) {
        if (rep) __syncthreads();
        unsigned om = __builtin_amdgcn_readfirstlane(misc[0]); const unsigned mym = selm[tl];
        float m = -1e30f, l = 0.f;
#pragma unroll
        for (int c = 0; c < 4; ++c)
#pragma unroll
            for (int i = 0; i < 16; ++i) o[c][i] = 0.f;
        int jc = __builtin_ctz(om); om &= om - 1u;
        stg_load(st, Kbase + PKS + (size_t)(64 * jc) * NPC, Kbase + PVS + (size_t)(64 * jc) * NPC, NPC, tid);
        stg_write(st, L, tid, 0);
        int jn = om ? __builtin_ctz(om) : -1; if (jn >= 0) { om &= om - 1u; stg_load(st, Kbase + PKS + (size_t)(64 * jn) * NPC, Kbase + PVS + (size_t)(64 * jn) * NPC, NPC, tid); }
        int buf = 0;
        for (;;) {
            __syncthreads();
            if (jn >= 0) stg_write(st, L, tid, buf ^ 1);
            const int jnn = om ? __builtin_ctz(om) : -1; if (jnn >= 0) { om &= om - 1u; stg_load(st, Kbase + PKS + (size_t)(64 * jnn) * NPC, Kbase + PVS + (size_t)(64 * jnn) * NPC, NPC, tid); }
            const bool sel = (mym >> jc) & 1u; const bool farsel = jc <= qblk - 3;
            f32x16 p0, p1; qk_tile(p0, p1, L, buf, qf, r, h, farsel ? (sel ? bfar : -__builtin_inff()) : 0.f);
            if (!farsel) {
#pragma unroll
                for (int i = 0; i < 16; ++i) { const int d0 = tq - (64 * jc + crow(i, h)), d1 = d0 - 32;
                    const float b0 = tab[hr * 128 + (d0 < 0 ? 0 : (d0 > 113 ? 113 : d0))], b1 = tab[hr * 128 + (d1 < 0 ? 0 : (d1 > 113 ? 113 : d1))];
                    p0[i] = (sel && d0 >= 0) ? p0[i] + b0 : -__builtin_inff(); p1[i] = (sel && d1 >= 0) ? p1[i] + b1 : -__builtin_inff(); }
            }
            softmax_step(p0, p1, m, l, o);
            pv_tile(o, p0, p1, L, buf, lane);
            if (jn < 0) break;
            jc = jn; jn = jnn; buf ^= 1;
        }
        if (rep == (MK_PROBE == 31 ? 1 : 0)) store_ot(o, NSA_GATE(1) / l, NSA_OUT(), h, true);
    }
    for (int rep = 0; rep < (MK_PROBE == 32 ? 2 : 1); ++rep) {
        float m = -1e30f, l = 0.f;
#pragma unroll
        for (int c = 0; c < 4; ++c)
#pragma unroll
            for (int i = 0; i < 16; ++i) o[c][i] = 0.f;
        int jc = qblk >= 8 ? qblk - 8 : 0;
        stg_load(st, Kbase + PKW + (size_t)(64 * jc) * NPC, Kbase + PVW + (size_t)(64 * jc) * NPC, NPC, tid);
        __syncthreads();
        stg_write(st, L, tid, 0);
        if (jc < qblk) stg_load(st, Kbase + PKW + (size_t)(64 * (jc + 1)) * NPC, Kbase + PVW + (size_t)(64 * (jc + 1)) * NPC, NPC, tid);
        int buf = 0;
        for (;;) {
            __syncthreads();
            if (jc < qblk) stg_write(st, L, tid, buf ^ 1);
            if (jc + 1 < qblk) stg_load(st, Kbase + PKW + (size_t)(64 * (jc + 2)) * NPC, Kbase + PVW + (size_t)(64 * (jc + 2)) * NPC, NPC, tid);
            const bool interior = jc <= qblk - 3 && jc >= qblk - 7;
            f32x16 p0, p1; qk_tile(p0, p1, L, buf, qf, r, h, interior ? bfar : 0.f);
            if (!interior) {
                const bool far = jc <= qblk - 3;
#pragma unroll
                for (int i = 0; i < 16; ++i) { const int d0 = tq - (64 * jc + crow(i, h)), d1 = d0 - 32;
                    const float b0 = far ? bfar : tab[hr * 128 + (d0 < 0 ? 0 : (d0 > 113 ? 113 : d0))], b1 = far ? bfar : tab[hr * 128 + (d1 < 0 ? 0 : (d1 > 113 ? 113 : d1))];
                    p0[i] = ((unsigned)d0 < 512u) ? p0[i] + b0 : -__builtin_inff(); p1[i] = ((unsigned)d1 < 512u) ? p1[i] + b1 : -__builtin_inff(); }
            }
            softmax_step(p0, p1, m, l, o);
            pv_tile(o, p0, p1, L, buf, lane);
            if (jc == qblk) break;
            ++jc; buf ^= 1;
        }
        if (rep == (MK_PROBE == 32 ? 1 : 0)) store_ot(o, NSA_GATE(2) / l, NSA_OUT(), h, true);
    }
#undef NSA_GATE
#undef NSA_OUT
}

constexpr int NI_H = 128, NI_S = 1024, NI_C = 256, NI_N = 512, NI_A = 1024;
#define FRESH_F() do { unsigned on_ = ~0u; asm volatile("" : "+s"(on_)); int t_ = F.wave * 64 + (int)__builtin_amdgcn_mbcnt_hi(on_, __builtin_amdgcn_mbcnt_lo(on_, 0u)); asm volatile("" : "+v"(t_)); F.tid = t_; F.lane = t_ & 63; F.wave = __builtin_amdgcn_readfirstlane(t_ >> 6); } while (0)
__device__ __forceinline__ void phase_Ca(Frame& F, KArgs a, int layer, int bank, int types) {
    unsigned* head = F.ctl + CW_QUEUE + 64 * (layer * 8) + bank * 4096;
    if (types & 1) for (;;) { const int it = q_next(F, head + 0); if (it >= NI_H) break; FRESH_F(); item_hgrn(F, a, layer, it); }
    if (types & 2) for (;;) { const int it = q_next(F, head + 64); if (it >= NI_S) break; FRESH_F(); item_sb(F, a, it); }
    if (types & 4) for (;;) { const int it = q_next(F, head + 128); if (it >= NI_C) break; FRESH_F(); item_compress(F, a, layer, it); }
    if (types & 8) for (;;) { const int it = q_next(F, head + 192); if (it >= NI_N) break; FRESH_F(); item_norm(F, a, layer, it); }
}
__device__ __forceinline__ void phase_Cb(Frame& F, KArgs a, int layer, int bank) {
    unsigned* head = F.ctl + CW_QUEUE + 64 * (layer * 8 + 4) + bank * 4096;
    for (;;) { const int it = q_next(F, head + 0); if (it >= NI_A) break; FRESH_F(); item_nsa(F, a, it); }
}

__global__ void __launch_bounds__(512, 2) mega(Args karg) {
    extern __shared__ __attribute__((aligned(16))) unsigned char lds_raw[];
    Frame F;
    F.lds = (LAS unsigned char*)lds_raw; F.MISC = (volatile LAS unsigned*)(F.lds + MISC_OFF);
    F.tid = threadIdx.x; F.lane = F.tid & 63; F.wave = __builtin_amdgcn_readfirstlane(F.tid >> 6); F.G = gridDim.x; F.bid = blockIdx.x;
    KArgs a = (KArgs)__builtin_amdgcn_kernarg_segment_ptr();
    F.ws = a->ws; F.ctl = (unsigned*)(a->ws + WS_CTL);
    if (F.tid < 64) F.MISC[F.tid] = 0u;
    __syncthreads();
    const int lo = karg.ph_lo, hi = karg.ph_hi;
    XcdBarrier bar; bar.bar = F.ctl + CW_BAR; bar.x = 0; bar.st = F.MISC + 8;
    if (hi - lo > 1) bar = xcd_barrier_post(F.ctl + CW_BAR, F.MISC + 8);
#define IN(k) (lo <= (k) && (k) < hi)
#define ON(k) (((MK_PHASE_MASK & MK_BUILD_MASK) >> (k)) & 1)
#define GRID_BAR() do { unsigned* bp_ = (unsigned*)(a->ws + WS_CTL) + CW_BAR; asm volatile("" : "+s"(bp_)); bar.bar = bp_; xcd_barrier(bar); } while (0)
#define SEAM(k) do { if (IN(k) && IN((k) + 1)) GRID_BAR(); } while (0)
    bf16_t* Hb; bf16_t* Pb; const int wave_s = __builtin_amdgcn_readfirstlane(threadIdx.x >> 6);
    for (int layer = 0; layer < DEPTH; ++layer) {
        const int pb = layer * 10;
#define FRESH() do { unsigned on_ = ~0u; asm volatile("" : "+s"(on_)); int t_ = wave_s * 64 + (int)__builtin_amdgcn_mbcnt_hi(on_, __builtin_amdgcn_mbcnt_lo(on_, 0u)); asm volatile("" : "+v"(t_)); F.tid = t_; F.lane = t_ & 63; F.wave = __builtin_amdgcn_readfirstlane(t_ >> 6); \
        asm volatile("" : "+s"(a)); F.ws = a->ws; F.ctl = (unsigned*)(a->ws + WS_CTL); Hb = (bf16_t*)(F.ws + WS_H); Pb = (bf16_t*)(F.ws + WS_P); } while (0)
        if (ON(0) && IN(pb + 0)) { FRESH(); if (MK_PROBE == 0) { phase_A(F, a, layer); GRID_BAR(); } phase_A(F, a, layer); } SEAM(pb + 0);
        if (ON(1) && IN(pb + 1)) for (int rep = 0; rep < (MK_PROBE == 1 ? 2 : 1); ++rep) { FRESH();
            if (rep) GRID_BAR();
            if (MK_STAGGER) { const unsigned long long t0 = __builtin_amdgcn_s_memrealtime(), dl = (unsigned long long)((F.bid >> 3) & 7) * MK_STAGGER; while (__builtin_amdgcn_s_memrealtime() - t0 < dl) __builtin_amdgcn_s_sleep(4); }
            pg8::Gemm g{(const bf16_t*)(F.ws + WS_XB), (const bf16_t*)(F.ws + WS_WIN), M, NPC, DM, 1, 1}; pg8::StaticOrder S; S.init(M, NPC, F.G, F.bid);
            pg8::EpiStoreBf16 E{Pb, NPC, PGT / 256, PGN / 256, (const float*)(F.ws + WS_RSTD), (LAS const float*)(F.lds + pg8::LRS_OFF)};
            pg8::gemm_phase<pg8::EpiStoreBf16, pg8::StaticOrder, PG8_ALIGN, PG8_SP2>(F.lds, g, S, E, F.tid, (MK_DIAG && layer == 0 && F.bid == 0) ? (unsigned long long*)(F.ctl + 49152) : nullptr);
        } SEAM(pb + 1);
        if (ON(2) && IN(pb + 2)) { FRESH(); if (MK_PROBE >= 20 && MK_PROBE < 28) { phase_Ca(F, a, layer, 1, MK_PROBE - 20); GRID_BAR(); } phase_Ca(F, a, layer, 0, 15); } SEAM(pb + 2);
        if (ON(3) && IN(pb + 3)) { FRESH(); if (MK_PROBE == 3) { phase_Cb(F, a, layer, 1); GRID_BAR(); } phase_Cb(F, a, layer, 0); } SEAM(pb + 3);
        if (ON(4) && IN(pb + 4)) for (int rep = 0; rep < (MK_PROBE == 4 ? 2 : 1); ++rep) { FRESH();
            if (rep) GRID_BAR();
            pg8::Gemm g{(const bf16_t*)(F.ws + WS_OBR), (const bf16_t*)(F.ws + WS_WBR), M, DM, 3 * BW, 1, 1}; pg8::StaticOrder S; S.init(M, DM, F.G, F.bid);
            pg8::EpiGated E{Pb, Hb};
            pg8::gemm_phase<pg8::EpiGated, pg8::StaticOrder, PG8_ALIGN, PG8_SP2>(F.lds, g, S, E, F.tid);
        } SEAM(pb + 4);
        if (ON(5) && IN(pb + 5)) for (int rep = 0; rep < (MK_PROBE == 5 ? 2 : 1); ++rep) { FRESH();
            if (rep) GRID_BAR();
            pg8::Gemm g{Hb, (const bf16_t*)(F.ws + WS_WOUT), M, DM, DM, 1, 1}; pg8::StaticOrder S; S.init(M, DM, F.G, F.bid);
            pg8::EpiResidBf16 E{(MK_PROBE == 5 && rep == 0) ? (bf16_t*)(F.ws + WS_P) : (bf16_t*)(F.ws + WS_XB), nullptr, (MK_PROBE == 5 && rep == 0) ? (float*)(F.ws + WS_P + 256 * MiB) : (float*)(F.ws + WS_SSQ), DM};
            pg8::gemm_phase<pg8::EpiResidBf16, pg8::StaticOrder, PG8_ALIGN, PG8_SP2>(F.lds, g, S, E, F.tid);
        } SEAM(pb + 5);
        if (ON(6) && IN(pb + 6)) { FRESH(); if (MK_PROBE == 60) { GRID_BAR(); GRID_BAR(); GRID_BAR(); GRID_BAR(); } if (MK_PROBE == 6) { phase_F(F, a); GRID_BAR(); } phase_F(F, a); } SEAM(pb + 6);
        if (ON(7) && IN(pb + 7)) for (int rep = 0; rep < (MK_PROBE == 7 ? 2 : 1); ++rep) { FRESH();
            if (rep) GRID_BAR();
            if (MK_STAGGER) { const unsigned long long t0 = __builtin_amdgcn_s_memrealtime(), dl = (unsigned long long)((F.bid >> 3) & 7) * MK_STAGGER; while (__builtin_amdgcn_s_memrealtime() - t0 < dl) __builtin_amdgcn_s_sleep(4); }
            pg8::Gemm g{(const bf16_t*)(F.ws + WS_XB), (const bf16_t*)(F.ws + WS_WUP), M, NUP, DM, 1, 1}; pg8::StaticOrder S; S.init(M, NUP, F.G, F.bid);
            pg8::EpiConvAct E{F.ws, a, layer, (LAS const float*)(F.lds + pg8::LRS_OFF)};
            pg8::gemm_phase<pg8::EpiConvAct, pg8::StaticOrder, PG8_ALIGN, PG8_SP2>(F.lds, g, S, E, F.tid);
        } SEAM(pb + 7);
        if (ON(8) && IN(pb + 8)) { FRESH(); if (MK_PROBE == 8) { phase_H(F, a, layer); GRID_BAR(); } phase_H(F, a, layer); } SEAM(pb + 8);
        if (ON(9) && IN(pb + 9)) for (int rep = 0; rep < (MK_PROBE == 9 ? 2 : 1); ++rep) { FRESH();
            if (rep) GRID_BAR();
            pg8::Gemm g{(const bf16_t*)(F.ws + WS_ACT), (const bf16_t*)(F.ws + WS_WDN), M, DM, DFF, 1, 1}; pg8::StaticOrder S; S.init(M, DM, F.G, F.bid, 4, 1);
            pg8::EpiResidBf16 E{(MK_PROBE == 9 && rep == 0) ? (bf16_t*)(F.ws + WS_P) : (bf16_t*)(F.ws + WS_XB), (layer == DEPTH - 1 && !(MK_PROBE == 9 && rep == 0)) ? a->out : nullptr, (MK_PROBE == 9 && rep == 0) ? (float*)(F.ws + WS_P + 256 * MiB) : (float*)(F.ws + WS_SSQ), DM};
            pg8::gemm_phase<pg8::EpiResidBf16, pg8::StaticOrder, PG8_ALIGN, PG8_SP2>(F.lds, g, S, E, F.tid);
        } SEAM(pb + 9);
    }
#if MK_DIAG
    GRID_BAR();
    { const unsigned long long* dg = (const unsigned long long*)(F.ctl + 49152); const float kl = (float)(long long)(dg[1] - dg[0]), per = (float)(long long)(dg[2] - dg[0]);
      const float eps = MK_DIAG == 1 ? kl / per : (MK_DIAG == 2 ? per * 1e-4f : kl * 1e-4f);
      for (size_t i = (size_t)F.bid * 512 + threadIdx.x; i < (size_t)M * DM; i += (size_t)F.G * 512) a->out[i] *= (1.f + eps); }
#endif
}

extern "C" void kernel_launch(void* const* d_in, const int* in_sizes, int n_in, void* d_out, int out_size, void* d_ws, size_t ws_size, hipStream_t stream) {
    static int grid = 0;
    if (grid == 0) {
        if (n_in != 18 || in_sizes[0] != M * DM || out_size != M * DM || ws_size < WS_END) { fprintf(stderr, "kernel_launch: unexpected shapes / workspace (%d inputs, ws %zu)\n", n_in, ws_size); grid = -1; return; }
        int dev = 0, cus = 0, per_cu = 0;
        if (hipGetDevice(&dev) != hipSuccess || hipDeviceGetAttribute(&cus, hipDeviceAttributeMultiprocessorCount, dev) != hipSuccess) { grid = -1; return; }
        if (hipFuncSetAttribute((const void*)mega, hipFuncAttributeMaxDynamicSharedMemorySize, LDS_BYTES) != hipSuccess) { grid = -1; return; }
        if (hipOccupancyMaxActiveBlocksPerMultiprocessor(&per_cu, (const void*)mega, 512, LDS_BYTES) != hipSuccess || per_cu < 1) { fprintf(stderr, "kernel_launch: occupancy query says %d\n", per_cu); }
        (void)hipGetLastError();
        grid = cus;
    }
    if (grid < 0) return;
    (void)hipMemsetAsync((char*)d_ws + WS_CTL, 0, CTL_BYTES, stream);
    Args a{};
    for (int i = 0; i < 18; ++i) a.in[i] = (const float*)d_in[i];
    a.out = (float*)d_out; a.ws = (unsigned char*)d_ws;
#if MK_ONE_LAUNCH
    a.ph_lo = 0; a.ph_hi = DEPTH * 10;
    hipLaunchKernelGGL(mega, dim3(grid), dim3(512), LDS_BYTES, stream, a);
#else
    for (int p = 0; p < DEPTH * 10; ++p) { a.ph_lo = p; a.ph_hi = p + 1; hipLaunchKernelGGL(mega, dim3(grid), dim3(512), LDS_BYTES, stream, a); }
#endif
}
```

```cpp
#include <hip/hip_runtime.h>
#include <stdint.h>
#include <stdio.h>

#ifndef MK_ONE_LAUNCH
#define MK_ONE_LAUNCH 1
#endif
#ifndef MK_PHASE_MASK
#define MK_PHASE_MASK 0x3ff
#endif
#ifndef MK_PROBE
#define MK_PROBE -1
#endif
#ifndef MK_STAGGER
#define MK_STAGGER 0
#endif
#ifndef MK_DIAG
#define MK_DIAG 0
#endif
#ifndef MK_BUILD_MASK
#define MK_BUILD_MASK 0x3ff
#endif

#define LAS __attribute__((address_space(3)))
typedef unsigned short bf16_t;
typedef short bf16x8 __attribute__((ext_vector_type(8)));
typedef short s16x4 __attribute__((ext_vector_type(4)));
typedef float f32x4 __attribute__((ext_vector_type(4)));
typedef float f32x16 __attribute__((ext_vector_type(16)));
typedef float f32x2 __attribute__((ext_vector_type(2)));
typedef unsigned u32x4 __attribute__((ext_vector_type(4)));
typedef unsigned u32x2 __attribute__((ext_vector_type(2)));
typedef __bf16 bfv2 __attribute__((ext_vector_type(2)));

constexpr int DM = 2048, NB = 16, T = 2048, DEPTH = 4, M = NB * T, HD = 128;
constexpr int INC = 15896;
constexpr int NPC = 16128;
constexpr int PQN = 0, PKC = 1024, PVC = 1280, PKS = 1536, PVS = 1792, PKW = 2048, PVW = 2304, PQS = 2560, PKSB = 3584, PVSB = 4608,
              PQH = 5632, PFH = 6656, PIH = 7680, PGH = 8704, PGT = 9728, PGN = 15872;
constexpr int DFF = 5632, NUP = 2 * DFF;
constexpr int BW = 1024;
constexpr float EPS = 1e-6f;
constexpr float LOG2E = 1.4426950408889634f, LN2 = 0.6931471805599453f;
constexpr float QSCALE = 0.08838834764831845f;

constexpr size_t MiB = 1u << 20;
constexpr size_t WS_CTL = 0, CTL_BYTES = 1 * MiB;
constexpr size_t WS_WIN = 1 * MiB, WS_WBR = 64 * MiB, WS_WOUT = 76 * MiB, WS_WUP = 84 * MiB, WS_WDN = 128 * MiB;
constexpr size_t WS_MISC = 150 * MiB;
constexpr size_t MISC_KCMP = 0, MISC_VCMP = 1 * MiB, MISC_WC1 = 2 * MiB;
constexpr int CW_CVEC = 32768;
constexpr size_t WS_SCR = 154 * MiB;
constexpr size_t WS_P = 218 * MiB;
constexpr size_t WS_H = 1226 * MiB;
constexpr size_t WS_OBR = 1354 * MiB;
constexpr size_t WS_ORAW = 1546 * MiB;
constexpr size_t WS_XB = 1674 * MiB;
constexpr size_t WS_SSQ = 1802 * MiB;
constexpr size_t WS_RSTD = 1806 * MiB;
constexpr size_t WS_USIDE = 1807 * MiB;
constexpr size_t WS_END = 1853 * MiB;
constexpr size_t WS_ACT = WS_P + 704 * MiB;
constexpr int CW_BAR = 4096;
constexpr int CW_QUEUE = 16384;

constexpr int RING_BYTES = 131072;
constexpr int MISC_OFF = 147456 - 256;
constexpr int LDS_BYTES = 147456;

__device__ __forceinline__ float bf2f(unsigned short b) { return __uint_as_float(((unsigned)b) << 16); }
__device__ __forceinline__ float bflo(unsigned w) { return __uint_as_float(w << 16); }
__device__ __forceinline__ float bfhi(unsigned w) { return __uint_as_float(w & 0xffff0000u); }
__device__ __forceinline__ unsigned pk2(float lo, float hi) { f32x2 v = {lo, hi}; bfv2 b = __builtin_convertvector(v, bfv2); return __builtin_bit_cast(unsigned, b); }
__device__ __forceinline__ float wave_sum(float v) {
#pragma unroll
    for (int o = 1; o < 64; o <<= 1) v += __shfl_xor(v, o);
    return v;
}
__device__ __forceinline__ float fast_exp2(float x) { return __builtin_amdgcn_exp2f(x); }
__device__ __forceinline__ float fast_log2(float x) { return __builtin_amdgcn_logf(x); }
__device__ __forceinline__ float fast_rcp(float x) { return __builtin_amdgcn_rcpf(x); }
__device__ __forceinline__ float sigmoidf_(float x) { return fast_rcp(1.f + fast_exp2(-x * LOG2E)); }
#define LDS_WAIT() asm volatile("s_waitcnt lgkmcnt(0)" ::: "memory")
__device__ __forceinline__ size_t akm(size_t row, int col) { return ((size_t)(col >> 6) * M + row) * 64 + (col & 63); }

#define XB_TMO      128
#define XB_XCNT(j)  (256  + 64 * (j))
#define XB_XSUB(j)  (1280 + 64 * (j))
#define XB_XGEN(j)  (2304 + 64 * (j))
#define XB_TOP      3328
#define XB_TOPGEN   3392
#define XCD_BAR_WORDS 3456
#define XB_SPIN_CAP (1u << 22)
__device__ __forceinline__ unsigned xb_ld(unsigned* p)              { return __hip_atomic_load(p, __ATOMIC_RELAXED, __HIP_MEMORY_SCOPE_AGENT); }
__device__ __forceinline__ unsigned xb_add(unsigned* p, unsigned v) { return __hip_atomic_fetch_add(p, v, __ATOMIC_RELAXED, __HIP_MEMORY_SCOPE_AGENT); }
__device__ __forceinline__ unsigned xb_xcc_id() { return (unsigned)__builtin_amdgcn_s_getreg((3 << 11) | 20) & 0xFu; }
#define XB_SPIN(cond, bar) do { unsigned _sp = 0; while (cond) { __builtin_amdgcn_s_sleep(1); \
    if ((++_sp & 255u) == 0u) { if (xb_ld(&(bar)[XB_TMO])) break; if (_sp > XB_SPIN_CAP) { atomicAdd(&(bar)[XB_TMO], 1u); break; } } } } while (0)
struct XcdBarrier { unsigned* bar; unsigned x; volatile LAS unsigned* st; };
__device__ __forceinline__ XcdBarrier xcd_barrier_post(unsigned* bar, volatile LAS unsigned* st) {
    XcdBarrier b; b.bar = bar; b.x = xb_xcc_id(); b.st = st;
    if (threadIdx.x == 0) (void)xb_add(&bar[XB_XCNT(b.x)], 1u);
    return b;
}
__device__ __forceinline__ void xcd_barrier_complete(unsigned* bar, unsigned x, unsigned& nloc, unsigned& nx) {
    const unsigned G = gridDim.x * gridDim.y * gridDim.z;
    unsigned sum, cnt, mine, sp = 0u;
    for (;;) {
        sum = 0u; cnt = 0u; mine = 0u;
#pragma unroll
        for (unsigned j = 0; j < 16; ++j) { const unsigned c = xb_ld(&bar[XB_XCNT(j)]); sum += c; cnt += (c > 0u) ? 1u : 0u; mine = (j == x) ? c : mine; }
        if (sum == G) break;
        __builtin_amdgcn_s_sleep(1);
        if ((++sp & 255u) == 0u) { if (xb_ld(&bar[XB_TMO])) break; if (sp > XB_SPIN_CAP) { atomicAdd(&bar[XB_TMO], 1u); break; } }
    }
    nloc = mine > 0u ? mine : 1u; nx = cnt > 0u ? cnt : 1u;
}
__device__ __forceinline__ void xcd_barrier(const XcdBarrier& b) {
    asm volatile("s_waitcnt vmcnt(0)" ::: "memory");
    __syncthreads();
    if (threadIdx.x == 0) {
        unsigned* bar = b.bar;
        __builtin_amdgcn_s_waitcnt(0);
        unsigned nloc = b.st[0], nx = b.st[1];
        if (nloc == 0u) { xcd_barrier_complete(bar, b.x, nloc, nx); b.st[0] = nloc; b.st[1] = nx; }
        const unsigned old = xb_add(&bar[XB_XSUB(b.x)], 1u);
        const unsigned gen = old / nloc;
        if (old + 1u == (gen + 1u) * nloc) {
            __builtin_amdgcn_fence(__ATOMIC_RELEASE, "agent");
            asm volatile("s_waitcnt vmcnt(0)" ::: "memory");
            const unsigned og = xb_add(&bar[XB_TOP], 1u);
            const unsigned tg = og / nx;
            if (og + 1u == (tg + 1u) * nx) xb_add(&bar[XB_TOPGEN], 1u);
            else XB_SPIN(xb_ld(&bar[XB_TOPGEN]) == tg, bar);
            __builtin_amdgcn_fence(__ATOMIC_ACQUIRE, "agent");
            xb_add(&bar[XB_XGEN(b.x)], 1u);
            asm volatile("s_waitcnt vmcnt(0)" ::: "memory");
        } else {
            XB_SPIN(xb_ld(&bar[XB_XGEN(b.x)]) == gen, bar);
            __builtin_amdgcn_fence(__ATOMIC_ACQUIRE, "agent");
            asm volatile("s_waitcnt vmcnt(0)" ::: "memory");
        }
    }
    __syncthreads();
}

struct Args { const float* in[18]; float* out; unsigned char* ws; int ph_lo, ph_hi; };
typedef const __attribute__((address_space(4))) Args* KArgs;
enum { I_X = 0, I_NATT, I_WIN, I_QG, I_KG, I_CPOS, I_CW1, I_CW2, I_RELB, I_HLB, I_HNG, I_WBR, I_WOUT, I_NFFN, I_WUP, I_CONVW, I_CONVB, I_WDN };
namespace pg8 {
constexpr int BM = 256, BK = 64, HALF = 128, HTB = HALF * BK * 2, STAGE_BYTES = 8 * HTB, NXCD = 8, LRS_OFF = STAGE_BYTES;
__host__ __device__ __forceinline__ int lds_byte(int r, int c) { const int st = (r >> 4) * 2 + (c >> 5), rr = r & 15, cc = c & 31, ob = rr * 64 + cc * 2; return st * 1024 + (ob ^ (((ob >> 9) & 1) << 5)); }
__host__ __device__ __forceinline__ void stage_rc(int b, int& R, int& C) { const int st = b / 1024, sb = b % 1024, swz = sb ^ (((sb >> 9) & 1) << 5); R = (st >> 1) * 16 + swz / 64; C = (st & 1) * 32 + (swz % 64) / 2; }
__host__ __device__ __forceinline__ int perm32(int rho) { const int n = rho >> 4, i = rho & 15; return 8 * (i >> 2) + 4 * n + (i & 3); }
struct Unit { int pm, pn, aux; };
constexpr int WCS = 64, BJS = 32;
struct Gemm { const bf16_t* A; const bf16_t* Bt; int M, N, K; int akm, bkm; };
struct StaticOrder {
    int nM, nN, nwg, G, c, WGM, rev;
    int pad_;
    __device__ void init(int M_, int N_, int G_, int c_, int wgm = 4, int rev_ = 0) { nM = M_ / BM; nN = N_ / BM; nwg = nM * nN; G = G_; c = c_; WGM = wgm; rev = rev_; pad_ = 0; }
    __device__ __forceinline__ bool tile(long L, Unit& u) const {
        if (L >= nwg) return false;
        int wgid = (int)L; { const int q = nwg / NXCD, r = nwg % NXCD, xcd = wgid % NXCD, off = wgid / NXCD; wgid = (xcd < r ? xcd * (q + 1) : r * (q + 1) + (xcd - r) * q) + off; }
        const int nig = WGM * nN, gid = wgid / nig, fm = gid * WGM, gsz = (nM - fm) < WGM ? (nM - fm) : WGM;
        u.pm = fm + ((wgid % nig) % gsz); u.pn = (wgid % nig) / gsz; u.aux = 0; if (rev) u.pm = nM - 1 - u.pm; return true;
    }
    __device__ __forceinline__ bool next(int i, Unit& u) const { return tile((long)i * G + c, u); }
    __device__ __forceinline__ const char* aptr(const Gemm& g, const Unit& u, size_t tstep) const { return (const char*)g.A + (size_t)u.pm * tstep; }
    __device__ __forceinline__ const char* bptr(const Gemm& g, const Unit& u, size_t tstep) const { return (const char*)g.Bt + (size_t)u.pn * tstep; }
    __device__ __forceinline__ void a_ready(const Unit&) const {}
    __device__ __forceinline__ void done(const Unit&) const {}
};
struct EpiStoreBf16 {
    static constexpr bool PERM = true, AFTER_DRAIN = false;
    static constexpr bool BPERM2 = true;
    static constexpr int PF_WAVES = 1;
    __device__ __forceinline__ void prefetch(LAS unsigned char* lds, const Unit& u, int wid, int lane) const {
        unsigned l16 = (unsigned)lane * 16u; asm volatile("" : "+v"(l16));
        __builtin_amdgcn_global_load_lds((const unsigned*)((const char*)rs + (size_t)u.pm * (BM * 4) + l16), (LAS unsigned*)(lds + LRS_OFF), 16, 0, 0); }
    static constexpr bool LDS_RS = true;
    bf16_t* O; int ldc; int sg_lo, sg_hi; const float* rs; LAS const float* lrs;
    __device__ __forceinline__ void operator()(const f32x4 (&acc)[2][2][4][2], const Unit& u, int wr, int wc, int fr, int fq) const {
        const int row0 = u.pm * BM + wr * 64 + fr, col0 = u.pn * BM + wc * WCS + 8 * fq; const bool sg = u.pn >= sg_lo && u.pn < sg_hi;
        float rsv[8];
#pragma unroll
        for (int g = 0; g < 8; ++g) rsv[g] = lrs[wr * 64 + fr + (g >> 2) * HALF + (g & 3) * 16];
#pragma unroll
        for (int ai = 0; ai < 2; ++ai)
#pragma unroll
            for (int m = 0; m < 4; ++m) { bf16_t* rowp = O + (size_t)(row0 + ai * HALF + m * 16) * ldc + col0;
                bf16_t* rowg = O + (size_t)(u.pm * BM + (ai * 4 + m) * 32 + (wr * 4 + wc) * 2 + (fq >> 1)) * ldc + u.pn * BM + ((fq & 1) * 16 + fr) * 8;
#pragma unroll
                for (int bj = 0; bj < 2; ++bj) { f32x4 v0 = acc[ai][bj][m][0] * rsv[ai * 4 + m], v1 = acc[ai][bj][m][1] * rsv[ai * 4 + m];
                    if (sg) {
#pragma unroll
                        for (int e = 0; e < 4; ++e) { v0[e] = sigmoidf_(v0[e]); v1[e] = sigmoidf_(v1[e]); } }
                    u32x4 w; w.x = pk2(v0[0], v0[1]); w.y = pk2(v0[2], v0[3]); w.z = pk2(v1[0], v1[1]); w.w = pk2(v1[2], v1[3]);
                    __builtin_nontemporal_store(w, (u32x4*)(sg ? rowg + (size_t)(bj * 16) * ldc : rowp + bj * BJS)); } }
    }
};
struct EpiConvAct {
    static constexpr bool PERM = true, AFTER_DRAIN = false, NO_RELAX = true;
    static constexpr bool LDS_RS = true;
    static constexpr bool APERM = true;
    static constexpr int PF_WAVES = 4;
    __device__ __forceinline__ void prefetch(LAS unsigned char* lds, const Unit& u, int wid, int lane) const {
        unsigned l_ = (unsigned)lane; asm volatile("" : "+v"(l_));
        const float* rs = (const float*)(ws + WS_RSTD); const float* cw = a->in[I_CONVW] + (size_t)layer * 3 * NUP; const float* cb = a->in[I_CONVB] + (size_t)layer * NUP;
        if (wid == 0) __builtin_amdgcn_global_load_lds((const unsigned*)((const char*)rs + (size_t)u.pm * (BM * 4) + l_ * 16u), (LAS unsigned*)(lds + LRS_OFF), 16, 0, 0);
        const unsigned sg = 2u * (unsigned)wid + (l_ >> 5), tap = sg & 3u;
        const float* src = (tap < 3u ? cw + (size_t)tap * NUP : cb) + (size_t)(sg >> 2) * DFF + (size_t)u.pn * 128 + (l_ & 31u) * 4u;
        __builtin_amdgcn_global_load_lds((const unsigned*)src, (LAS unsigned*)(lds + LRS_OFF + 1024 + wid * 1024), 16, 0, 0); }
    unsigned char* ws; KArgs a; int layer; LAS const float* lrs;
    static __device__ __forceinline__ f32x4 shr1(const f32x4 v) {
        f32x4 r;
#pragma unroll
        for (int e = 0; e < 4; ++e) r[e] = __int_as_float(__builtin_amdgcn_update_dpp(0, __float_as_int(v[e]), 0x111, 0xf, 0xf, true));
        return r; }
    __device__ __forceinline__ void operator()(const f32x4 (&acc)[2][2][4][2], const Unit& u, int wr, int wc, int fr, int fq) const {
        const int row0 = u.pm * BM + wr * 64 + 4 * fr, ch0 = u.pn * 128 + wc * 32 + 8 * fq;
        bf16_t* ACT = (bf16_t*)(ws + WS_ACT); bf16_t* side = (bf16_t*)(ws + WS_USIDE);
        f32x4 rsv[2];
#pragma unroll
        for (int ai = 0; ai < 2; ++ai) rsv[ai] = *(const LAS f32x4*)(lrs + ai * HALF + wr * 64 + 4 * fr);
        if (fr == 0 || fr == 15) {
            const bool lo = fr == 0;
#pragma unroll
            for (int ai = 0; ai < 2; ++ai) { const int blk = (u.pm * BM + ai * HALF + wr * 64) >> 6;
#pragma unroll
                for (int s2 = 0; s2 < 2; ++s2) { const float r_ = lo ? rsv[ai][s2] : rsv[ai][2 + s2];
                    bf16_t* sp = side + ((size_t)blk * 4 + (lo ? s2 : 2 + s2)) * NUP + u.pn * 256 + wc * 32 + 8 * fq;
#pragma unroll
                    for (int bj = 0; bj < 2; ++bj) { const f32x4 l0 = acc[ai][bj][s2][0], h0 = acc[ai][bj][2 + s2][0], l1 = acc[ai][bj][s2][1], h1 = acc[ai][bj][2 + s2][1]; f32x4 a0, a1;
#pragma unroll
                        for (int e = 0; e < 4; ++e) { a0[e] = (lo ? l0[e] : h0[e]) * r_; a1[e] = (lo ? l1[e] : h1[e]) * r_; }
                        *(u32x4*)(sp + bj * HALF) = (u32x4){pk2(a0[0], a0[1]), pk2(a0[2], a0[3]), pk2(a1[0], a1[1]), pk2(a1[2], a1[3])}; } } }
        }
        __builtin_amdgcn_sched_barrier(0);
#pragma unroll
        for (int ai = 0; ai < 2; ++ai) {
            u32x2 keep[4];
#pragma unroll
            for (int n = 0; n < 2; ++n) {
                LAS const float* lw = lrs + 256 + wc * 32 + 8 * fq + 4 * n;
                f32x4 sg[4];
                { const f32x4 w0 = *(const LAS f32x4*)(lw), w1 = *(const LAS f32x4*)(lw + 128), w2 = *(const LAS f32x4*)(lw + 256), bb = *(const LAS f32x4*)(lw + 384);
                  const f32x4 x0 = acc[ai][0][0][n] * rsv[ai][0], x1 = acc[ai][0][1][n] * rsv[ai][1], x2 = acc[ai][0][2][n] * rsv[ai][2], x3 = acc[ai][0][3][n] * rsv[ai][3];
                  const f32x4 p1 = shr1(x3), p2 = shr1(x2);
                  const f32x4 c0 = bb + w0 * p2 + w1 * p1 + w2 * x0, c1 = bb + w0 * p1 + w1 * x0 + w2 * x1, c2 = bb + w0 * x0 + w1 * x1 + w2 * x2, c3 = bb + w0 * x1 + w1 * x2 + w2 * x3;
#pragma unroll
                  for (int e = 0; e < 4; ++e) { sg[0][e] = c0[e] * sigmoidf_(c0[e]); sg[1][e] = c1[e] * sigmoidf_(c1[e]); sg[2][e] = c2[e] * sigmoidf_(c2[e]); sg[3][e] = c3[e] * sigmoidf_(c3[e]); } }
                __builtin_amdgcn_sched_barrier(0);
                { const f32x4 w0 = *(const LAS f32x4*)(lw + 512), w1 = *(const LAS f32x4*)(lw + 640), w2 = *(const LAS f32x4*)(lw + 768), bb = *(const LAS f32x4*)(lw + 896);
                  const f32x4 x0 = acc[ai][1][0][n] * rsv[ai][0], x1 = acc[ai][1][1][n] * rsv[ai][1], x2 = acc[ai][1][2][n] * rsv[ai][2], x3 = acc[ai][1][3][n] * rsv[ai][3];
                  const f32x4 p1 = shr1(x3), p2 = shr1(x2);
                  f32x4 cv[4]; cv[0] = bb + w0 * p2 + w1 * p1 + w2 * x0; cv[1] = bb + w0 * p1 + w1 * x0 + w2 * x1; cv[2] = bb + w0 * x0 + w1 * x1 + w2 * x2; cv[3] = bb + w0 * x1 + w1 * x2 + w2 * x3;
#pragma unroll
                  for (int m = 0; m < 4; ++m) { const f32x4 act = sg[m] * cv[m];
                      u32x2 w; w.x = pk2(act[0], act[1]); w.y = pk2(act[2], act[3]);
                      if (n == 0) keep[m] = w;
                      else *(u32x4*)(ACT + ((size_t)(ch0 >> 6) * M + (size_t)(row0 + ai * HALF + m)) * 64 + (ch0 & 63)) = (u32x4){keep[m].x, keep[m].y, w.x, w.y}; } }
                __builtin_amdgcn_sched_barrier(0);
            }
        }
    }
};
#ifndef ER_DEPTH
#define ER_DEPTH 4
#endif
struct EpiResidBf16 {
    static constexpr bool BPERM2 = true;
    static constexpr bool PERM = true, AFTER_DRAIN = false;
    bf16_t* XB; float* Cout; float* ssq; int ldc;
    __device__ __forceinline__ void operator()(const f32x4 (&acc)[2][2][4][2], const Unit& u, int wr, int wc, int fr, int fq) const {
        const int row0 = u.pm * BM + wr * 64 + fr, col0 = u.pn * BM + wc * WCS + 8 * fq;
        u32x4 old[ER_DEPTH][2]; float ssv[8];
#define ER_ROWI(g) (row0 + ((g) >> 2) * HALF + ((g) & 3) * 16)
#define ER_LOAD(g) do { old[(g) % ER_DEPTH][0] = *(const u32x4*)(XB + akm(ER_ROWI(g), col0)); old[(g) % ER_DEPTH][1] = *(const u32x4*)(XB + akm(ER_ROWI(g), col0 + BJS)); } while (0)
#pragma unroll
        for (int g = 0; g < ER_DEPTH; ++g) ER_LOAD(g);
#pragma unroll
        for (int g = 0; g < 8; ++g) {
            asm volatile("" ::: "memory");
            const size_t ro = (size_t)ER_ROWI(g) * ldc + col0; float ss = 0.f;
#pragma unroll
            for (int bj = 0; bj < 2; ++bj) { const u32x4 o_ = old[g % ER_DEPTH][bj];
                f32x4 v0 = acc[g >> 2][bj][g & 3][0], v1 = acc[g >> 2][bj][g & 3][1];
                v0[0] += bflo(o_.x); v0[1] += bfhi(o_.x); v0[2] += bflo(o_.y); v0[3] += bfhi(o_.y); v1[0] += bflo(o_.z); v1[1] += bfhi(o_.z); v1[2] += bflo(o_.w); v1[3] += bfhi(o_.w);
                if (Cout) { *(f32x4*)(Cout + ro + bj * BJS) = v0; *(f32x4*)(Cout + ro + bj * BJS + 4) = v1; }
                else { u32x4 w; w.x = pk2(v0[0], v0[1]); w.y = pk2(v0[2], v0[3]); w.z = pk2(v1[0], v1[1]); w.w = pk2(v1[2], v1[3]); *(u32x4*)(XB + akm(ER_ROWI(g), col0 + bj * BJS)) = w;
                    const float r0 = bflo(w.x), r1 = bfhi(w.x), r2 = bflo(w.y), r3 = bfhi(w.y), r4 = bflo(w.z), r5 = bfhi(w.z), r6 = bflo(w.w), r7 = bfhi(w.w);
                    ss += ((r0 * r0 + r1 * r1) + (r2 * r2 + r3 * r3)) + ((r4 * r4 + r5 * r5) + (r6 * r6 + r7 * r7)); } }
            ssv[g] = ss;
            if (g + ER_DEPTH < 8) ER_LOAD(g + ER_DEPTH);
        }
        if (!Cout) {
#pragma unroll
            for (int g = 0; g < 8; ++g) ssv[g] += __shfl_xor(ssv[g], 16);
#pragma unroll
            for (int g = 0; g < 8; ++g) ssv[g] += __shfl_xor(ssv[g], 32);
            if (fq == 0) {
#pragma unroll
                for (int g = 0; g < 8; ++g) ssq[(size_t)ER_ROWI(g) * 32 + u.pn * 4 + wc] = ssv[g]; } }
#undef ER_ROWI
#undef ER_LOAD
    }
};
struct EpiGated {
    static constexpr bool PERM = true, AFTER_DRAIN = false, HOOK = true, BPERM2 = true; static constexpr int HOOK_KT = 16;
    const bf16_t* P; bf16_t* merged;
    static __device__ __forceinline__ float gl(unsigned w) { return fmaxf(bflo(w), 1e-30f); }
    static __device__ __forceinline__ float gh(unsigned w) { return fmaxf(bfhi(w), 1e-30f); }
    __device__ __forceinline__ void mid(f32x4 (&acc)[2][2][4][2], const Unit& u, int wr, int wc, int fr, int fq, int s) const {
        const unsigned grow0 = (unsigned)(u.pm * BM + (wr * 4 + wc) * 2 + (fq >> 1)), gcol0 = (unsigned)(u.pn * BM + ((fq & 1) * 16 + fr) * 8);
        const char* Pa = (const char*)(P + PGT + (s - 1) * DM); const char* Pb = (const char*)(P + PGT + s * DM);
#pragma unroll
        for (int hf = 0; hf < 2; ++hf) {
            u32x4 ga[4][2], gb[4][2];
#pragma unroll
            for (int gg = 0; gg < 4; ++gg) { const int g = hf * 4 + gg; const unsigned po = ((grow0 + (unsigned)(g * 32)) * (unsigned)NPC + gcol0) * 2u;
#pragma unroll
                for (int bj = 0; bj < 2; ++bj) { ga[gg][bj] = *(const u32x4*)(Pa + (size_t)(po + bj * (16u * NPC * 2u))); gb[gg][bj] = *(const u32x4*)(Pb + (size_t)(po + bj * (16u * NPC * 2u))); } }
#pragma unroll
            for (int gg = 0; gg < 4; ++gg) { const int g = hf * 4 + gg;
#pragma unroll
                for (int bj = 0; bj < 2; ++bj) { const u32x4 a_ = ga[gg][bj], b_ = gb[gg][bj];
                    f32x4& v0 = acc[g >> 2][bj][g & 3][0]; f32x4& v1 = acc[g >> 2][bj][g & 3][1];
                    v0[0] *= gl(a_.x) * fast_rcp(gl(b_.x)); v0[1] *= gh(a_.x) * fast_rcp(gh(b_.x)); v0[2] *= gl(a_.y) * fast_rcp(gl(b_.y)); v0[3] *= gh(a_.y) * fast_rcp(gh(b_.y));
                    v1[0] *= gl(a_.z) * fast_rcp(gl(b_.z)); v1[1] *= gh(a_.z) * fast_rcp(gh(b_.z)); v1[2] *= gl(a_.w) * fast_rcp(gl(b_.w)); v1[3] *= gh(a_.w) * fast_rcp(gh(b_.w)); } }
            asm volatile("" ::: "memory"); }
    }
    __device__ __forceinline__ void operator()(const f32x4 (&acc)[2][2][4][2], const Unit& u, int wr, int wc, int fr, int fq) const {
        const unsigned row0 = (unsigned)(u.pm * BM + wr * 64 + fr), col0 = (unsigned)(u.pn * BM + wc * WCS + 8 * fq);
        const char* Pg = (const char*)(P + PGT + 2 * DM); char* mg = (char*)merged;
        u32x4 gw[8][2];
        const unsigned grow0 = (unsigned)(u.pm * BM + (wr * 4 + wc) * 2 + (fq >> 1)), gcol0 = (unsigned)(u.pn * BM + ((fq & 1) * 16 + fr) * 8);
#pragma unroll
        for (int g = 0; g < 8; ++g) { const unsigned po = ((grow0 + (unsigned)(g * 32)) * (unsigned)NPC + gcol0) * 2u;
#pragma unroll
            for (int bj = 0; bj < 2; ++bj) gw[g][bj] = *(const u32x4*)(Pg + (size_t)(po + bj * (16u * NPC * 2u))); }
#pragma unroll
        for (int g = 0; g < 8; ++g) { const unsigned moff = ((row0 + (unsigned)((g >> 2) * HALF + (g & 3) * 16)) * (unsigned)DM + col0) * 2u;
#pragma unroll
            for (int bj = 0; bj < 2; ++bj) { const u32x4 w_ = gw[g][bj]; const f32x4 v0 = acc[g >> 2][bj][g & 3][0], v1 = acc[g >> 2][bj][g & 3][1];
                u32x4 w; w.x = pk2(v0[0] * gl(w_.x), v0[1] * gh(w_.x)); w.y = pk2(v0[2] * gl(w_.y), v0[3] * gh(w_.y)); w.z = pk2(v1[0] * gl(w_.z), v1[1] * gh(w_.z)); w.w = pk2(v1[2] * gl(w_.w), v1[3] * gh(w_.w));
                *(u32x4*)(merged + akm(row0 + (unsigned)((g >> 2) * HALF + (g & 3) * 16), (int)col0 + bj * BJS)) = w; } }
    }
};

template <class E, class = void> struct has_relax { static constexpr bool v = true; };
template <class E> struct has_relax<E, decltype((void)E::NO_RELAX)> { static constexpr bool v = false; };
template <class E, class = void> struct has_lrs { static constexpr bool v = false; };
template <class E> struct has_lrs<E, decltype((void)E::LDS_RS)> { static constexpr bool v = true; };
template <class E, class = void> struct has_aperm { static constexpr bool v = false; };
template <class E> struct has_aperm<E, decltype((void)E::APERM)> { static constexpr bool v = true; };
template <class E, class = void> struct has_bperm2 { static constexpr bool v = false; };
template <class E> struct has_bperm2<E, decltype((void)E::BPERM2)> { static constexpr bool v = true; };
template <class E, class = void> struct has_hook { static constexpr bool v = false; };
template <class E> struct has_hook<E, decltype((void)E::HOOK)> { static constexpr bool v = true; };
template <class Epi, class Sched, bool ALIGN_EPI = false, bool SP2 = false>
__device__ __forceinline__ void gemm_phase(LAS unsigned char* lds, const Gemm g, const Sched& S, const Epi& E, const int tid, unsigned long long* dg = nullptr) {
    float zf; asm volatile("v_mov_b32 %0, 0" : "=v"(zf));
    const int wid = __builtin_amdgcn_readfirstlane(tid >> 6), lane = tid & 63, wr = wid >> 2, wc = wid & 3, fr = lane & 15, fq = lane >> 4;
    const int K = g.K, nt = K / BK;
    unsigned voffA[2], voffB[2];
#pragma unroll
    for (int i = 0; i < 2; ++i) { int R, C; stage_rc(tid * 16 + i * 8192, R, C); const int Rb = has_bperm2<Epi>::v ? (2 * (R & ~31) + perm32(R & 31)) : (Epi::PERM ? ((R & ~31) + perm32(R & 31)) : R);
        const int Ra = has_aperm<Epi>::v ? ((R & ~63) + 4 * (R & 15) + ((R >> 4) & 3)) : R;
        voffA[i] = (unsigned)(Ra * (g.akm ? BK : K) + C) * 2u; voffB[i] = (unsigned)(Rb * (g.bkm ? BK : K) + C) * 2u; }
    const size_t kstep = (size_t)(BK * 2);
    const size_t hstep = (size_t)HALF * K * 2;
    const size_t tstep = 2 * hstep;
    const size_t kstepA = g.akm ? (size_t)g.M * BK * 2 : kstep, hstepA = g.akm ? (size_t)HALF * BK * 2 : hstep, tstepA = 2 * hstepA;
    const size_t kstepB = g.bkm ? (size_t)g.N * BK * 2 : kstep, hstepB = has_bperm2<Epi>::v ? (g.bkm ? (size_t)32 * BK * 2 : (size_t)32 * K * 2) : (g.bkm ? (size_t)HALF * BK * 2 : hstep), tstepB = g.bkm ? (size_t)BM * BK * 2 : tstep;
    const unsigned ldsw = (unsigned)wid * 1024u;
    const int aoff = lds_byte(wr * 64 + fr, fq * 8), boff = lds_byte(wc * 32 + fr, fq * 8);
#define PG8_SA(b, h) (((b) * 2 + (h)) * HTB)
#define PG8_SB(b, h) ((4 + (b) * 2 + (h)) * HTB)
#define PG8_STAGE(bufoff, gbase, voff) do { _Pragma("unroll") for (int _i = 0; _i < 2; ++_i) \
        __builtin_amdgcn_global_load_lds((const unsigned*)((const char*)(gbase) + (voff)[_i]), (LAS unsigned*)(lds + (bufoff) + ldsw + _i * 8192), 16, 0, 0); } while (0)
#define PG8_LDA(dst, b, h) do { _Pragma("unroll") for (int m = 0; m < 4; ++m) _Pragma("unroll") for (int k = 0; k < 2; ++k) dst[m][k] = *(const LAS bf16x8*)(lds + PG8_SA(b, h) + aoff + m * 2048 + k * 1024); } while (0)
#define PG8_LDB(dst, b, h) do { _Pragma("unroll") for (int n = 0; n < 2; ++n) _Pragma("unroll") for (int k = 0; k < 2; ++k) dst[n][k] = *(const LAS bf16x8*)(lds + PG8_SB(b, h) + boff + n * 2048 + k * 1024); } while (0)
#define PG8_MMA(ai, bj, At, Bt) do { __builtin_amdgcn_s_setprio(1); _Pragma("unroll") for (int m = 0; m < 4; ++m) _Pragma("unroll") for (int n = 0; n < 2; ++n) _Pragma("unroll") for (int k = 0; k < 2; ++k) \
        acc[ai][bj][m][n] = __builtin_amdgcn_mfma_f32_16x16x32_bf16(Bt[n][k], At[m][k], acc[ai][bj][m][n], 0, 0, 0); __builtin_amdgcn_s_setprio(0); } while (0)
#define PG8_WAIT_V(n) asm volatile("s_waitcnt vmcnt(" #n ")" ::: "memory")
#define PG8_WAIT_L(n) asm volatile("s_waitcnt lgkmcnt(" #n ")" ::: "memory")
#define PG8_BAR __builtin_amdgcn_s_barrier()
#define PG8_SCHED __builtin_amdgcn_sched_barrier(0)
    Unit cur, nxt; int ui = 0;
    if (!S.next(0, cur)) return;
    f32x4 acc[2][2][4][2];
#pragma unroll
    for (int a = 0; a < 2; ++a)
#pragma unroll
        for (int b = 0; b < 2; ++b)
#pragma unroll
            for (int m = 0; m < 4; ++m)
#pragma unroll
                for (int n = 0; n < 2; ++n) acc[a][b][m][n] = (f32x4){zf, zf, zf, zf};
    bf16x8 At[4][2], B0[2][2], B1[2][2];
    const char* cA = S.aptr(g, cur, tstepA); const char* cB = S.bptr(g, cur, tstepB);
    S.a_ready(cur);
    if constexpr (SP2) {
        PG8_STAGE(PG8_SB(0, 0), cB, voffB); PG8_STAGE(PG8_SB(0, 1), cB + hstepB, voffB); PG8_STAGE(PG8_SA(0, 0), cA, voffA); PG8_STAGE(PG8_SA(0, 1), cA + hstepA, voffA);
        if (wr == 1) PG8_BAR;
        PG8_WAIT_V(2); PG8_BAR;
        PG8_STAGE(PG8_SB(1, 0), cB + kstepB, voffB); PG8_STAGE(PG8_SA(1, 0), cA + kstepA, voffA); PG8_STAGE(PG8_SB(1, 1), cB + hstepB + kstepB, voffB);
        PG8_WAIT_V(6); PG8_BAR;
    } else {
        PG8_STAGE(PG8_SB(0, 0), cB, voffB); PG8_STAGE(PG8_SA(0, 0), cA, voffA); PG8_STAGE(PG8_SB(0, 1), cB + hstepB, voffB); PG8_STAGE(PG8_SA(0, 1), cA + hstepA, voffA);
        if (wr == 1) PG8_BAR;
        PG8_WAIT_V(4); PG8_BAR;
        PG8_STAGE(PG8_SB(1, 0), cB + kstepB, voffB); PG8_STAGE(PG8_SA(1, 0), cA + kstepA, voffA); PG8_STAGE(PG8_SB(1, 1), cB + hstepB + kstepB, voffB);
        PG8_WAIT_V(6); PG8_BAR;
    }
    for (;;) {
        const bool has_next = S.next(ui + 1, nxt);
        if (MK_DIAG && dg && tid == 0 && (ui == 2 || ui == 3)) dg[(ui - 2) * 2] = wall_clock64();
        const char* nA = has_next ? S.aptr(g, nxt, tstepA) : cA; const char* nB = has_next ? S.bptr(g, nxt, tstepB) : cB;
        constexpr bool RELAX_ = has_relax<Epi>::v;
#define PG8_ITER(FIRST) do { \
            const bool last = (t == nt - 2); \
            const char* a1 = cA + (size_t)(t + 1) * kstepA; \
            const char* a2 = last ? nA : cA + (size_t)(t + 2) * kstepA; const char* b2 = last ? nB : cB + (size_t)(t + 2) * kstepB; \
            const char* a3 = a2 + kstepA; const char* b3 = b2 + kstepB; \
            if (last && has_next) S.a_ready(nxt); \
            PG8_LDB(B0, 0, 0); PG8_LDB(B1, 0, 1); PG8_SCHED; PG8_LDA(At, 0, 0); if (!(FIRST)) PG8_STAGE(PG8_SA(1, 1), a1 + hstepA, voffA); \
            if constexpr (has_lrs<Epi>::v) { if (t == 4 && wid < Epi::PF_WAVES) E.prefetch(lds, cur, wid, lane); } \
            if (FIRST) PG8_WAIT_V(24); else PG8_WAIT_V(8); PG8_WAIT_L(0); PG8_BAR; PG8_MMA(0, 0, At, B0); PG8_MMA(0, 1, At, B1); PG8_BAR; PG8_SCHED; \
            PG8_LDA(At, 0, 1); PG8_STAGE(PG8_SB(0, 0), b2, voffB); PG8_STAGE(PG8_SB(0, 1), b2 + hstepB, voffB); PG8_STAGE(PG8_SA(0, 0), a2, voffA); \
            if (FIRST) PG8_WAIT_V(24); else PG8_WAIT_V(8); PG8_WAIT_L(0); PG8_BAR; PG8_MMA(1, 0, At, B0); PG8_MMA(1, 1, At, B1); PG8_BAR; PG8_SCHED; \
            PG8_LDB(B0, 1, 0); PG8_LDB(B1, 1, 1); PG8_SCHED; PG8_LDA(At, 1, 0); PG8_STAGE(PG8_SA(0, 1), a2 + hstepA, voffA); \
            if (FIRST) PG8_WAIT_V(24); else PG8_WAIT_V(8); PG8_WAIT_L(0); PG8_BAR; PG8_MMA(0, 0, At, B0); PG8_MMA(0, 1, At, B1); PG8_BAR; PG8_SCHED; \
            PG8_LDA(At, 1, 1); PG8_STAGE(PG8_SB(1, 0), b3, voffB); PG8_STAGE(PG8_SB(1, 1), b3 + hstepB, voffB); PG8_STAGE(PG8_SA(1, 0), a3, voffA); \
            PG8_WAIT_V(8); PG8_WAIT_L(0); PG8_BAR; PG8_MMA(1, 0, At, B0); PG8_MMA(1, 1, At, B1); PG8_BAR; PG8_SCHED; \
            if constexpr (has_hook<Epi>::v) { if (t + 2 < nt && (t + 2) % Epi::HOOK_KT == 0) { int fr_ = fr, fq_ = fq; asm volatile("" : "+v"(fr_), "+v"(fq_)); const_cast<Epi&>(E).mid(acc, cur, wr, wc, fr_, fq_, (t + 2) / Epi::HOOK_KT); PG8_SCHED; } } \
            if (RELAX_ && last && has_next) { PG8_STAGE(PG8_SA(1, 1), a3 + hstepA, voffA); PG8_SCHED; }     \
        } while (0)
        int t = 0;
        if constexpr (RELAX_) { if (ui > 0) { PG8_ITER(1); t = 2; } }
        for (; t < nt; t += 2) { PG8_ITER(0); }
#undef PG8_ITER
        if (MK_DIAG && dg && tid == 0 && ui == 2) dg[1] = wall_clock64();
        if constexpr (ALIGN_EPI) { if (wr == 0) PG8_BAR; }
        if constexpr (!Epi::AFTER_DRAIN) { int fr_ = fr, fq_ = fq; asm volatile("" : "+v"(fr_), "+v"(fq_));
            E(acc, cur, wr, wc, fr_, fq_); S.done(cur); }
        if (!has_next) break;
#pragma unroll
        for (int a = 0; a < 2; ++a)
#pragma unroll
            for (int b = 0; b < 2; ++b)
#pragma unroll
                for (int m = 0; m < 4; ++m)
#pragma unroll
                    for (int n = 0; n < 2; ++n) acc[a][b][m][n] = (f32x4){zf, zf, zf, zf};
        cur = nxt; cA = nA; cB = nB; ++ui;
        if constexpr (ALIGN_EPI) { if (wr == 1) PG8_BAR; }
    }
    PG8_WAIT_V(0);
    if constexpr (!ALIGN_EPI) { if (wr == 0) PG8_BAR; }
    PG8_BAR;
#undef PG8_SA
#undef PG8_SB
#undef PG8_STAGE
#undef PG8_LDA
#undef PG8_LDB
#undef PG8_MMA
#undef PG8_WAIT_V
#undef PG8_WAIT_L
#undef PG8_BAR
#undef PG8_SCHED
}
}
#define PG8_SP2 true
#define PG8_ALIGN true


struct Frame {
    LAS unsigned char* lds; volatile LAS unsigned* MISC;
    unsigned* ctl; unsigned char* ws;
    int tid, lane, wave, G, bid;
};

__device__ __forceinline__ int up_src_col(int n) { const int pn = n >> 8, c = n & 255; return c < 128 ? 128 * pn + c : DFF + 128 * pn + (c - 128); }
__device__ __forceinline__ int inproj_src_col(int n) { return n < 2560 ? n : (n < 15872 ? n + 24 : (n < 15896 ? n - 15872 + 2560 : -1)); }
__device__ __forceinline__ void transpose_item(const float* W, int K, int Nsrc, bf16_t* WT, const float* gain, int mode, LAS float* scr, int item, int nblk, int lane, int ntot, int kbase = 0) {
    const int kb = item / nblk, nb = item - kb * nblk, k0 = 64 * kb, n0 = 32 * nb;
    const int nn = n0 + (lane & 7) * 4; const int sc = mode == 1 ? inproj_src_col(nn) : (mode == 2 ? up_src_col(nn) : nn);
    f32x4 v[8];
#pragma unroll
    for (int i = 0; i < 8; ++i) { const int kk = 8 * i + (lane >> 3); v[i] = sc >= 0 ? __builtin_nontemporal_load((const f32x4*)(W + (size_t)(k0 + kk) * Nsrc + sc)) : (f32x4){0.f, 0.f, 0.f, 0.f}; }
#pragma unroll
    for (int i = 0; i < 8; ++i) { const int kk = 8 * i + (lane >> 3); const float gk = gain ? gain[k0 + kk] : 1.f; LAS float* d = scr + kk * 33 + (lane & 7) * 4;
        d[0] = v[i].x * gk; d[1] = v[i].y * gk; d[2] = v[i].z * gk; d[3] = v[i].w * gk; }
    LDS_WAIT(); asm volatile("" ::: "memory");
    const int c = lane & 7;
#pragma unroll
    for (int j = 0; j < 4; ++j) { const int n = (lane >> 3) + 8 * j; const LAS float* sp = scr + (8 * c) * 33 + n;
        u32x4 o; o.x = pk2(sp[0 * 33], sp[1 * 33]); o.y = pk2(sp[2 * 33], sp[3 * 33]); o.z = pk2(sp[4 * 33], sp[5 * 33]); o.w = pk2(sp[6 * 33], sp[7 * 33]);
        if (ntot) *(u32x4*)(WT + ((size_t)((kbase + k0) >> 6) * ntot + (size_t)(n0 + n)) * 64 + 8 * c) = o;
        else *(u32x4*)(WT + (size_t)(n0 + n) * K + k0 + 8 * c) = o; }
    LDS_WAIT(); asm volatile("" ::: "memory");
}
__device__ __forceinline__ void rms_row0(const float* xin, bf16_t* XB, int m, float* rstd, int lane) {
    const f32x4* xr = (const f32x4*)xin + lane;
    f32x4 v[8]; float s = 0.f;
#pragma unroll
    for (int j = 0; j < 8; ++j) { v[j] = xr[64 * j]; s += (v[j].x * v[j].x + v[j].y * v[j].y) + (v[j].z * v[j].z + v[j].w * v[j].w); }
    s = wave_sum(s);
    if (lane == 0) *rstd = rsqrtf(s * (1.f / DM) + EPS);
#pragma unroll
    for (int j = 0; j < 8; ++j) { u32x2 w; w.x = pk2(v[j].x, v[j].y); w.y = pk2(v[j].z, v[j].w); *(u32x2*)(XB + akm((size_t)m, 4 * (lane + 64 * j))) = w; }
}
__device__ __forceinline__ void rstd_rows(Frame& F) {
    const float* ssq = (const float*)(F.ws + WS_SSQ); float* rstd = (float*)(F.ws + WS_RSTD);
    for (int row = F.bid * 512 + F.tid; row < M; row += F.G * 512) { const f32x4* p = (const f32x4*)(ssq + (size_t)row * 32); float s = 0.f;
#pragma unroll
        for (int j = 0; j < 8; ++j) { const f32x4 v = p[j]; s += (v.x + v.y) + (v.z + v.w); }
        rstd[row] = rsqrtf(s * (1.f / DM) + EPS); }
}

__device__ __forceinline__ void cvec_item(Frame& F, KArgs a, int layer, int j);
__device__ __forceinline__ void phase_A(Frame& F, KArgs a, int layer) {
    LAS float* scr = (LAS float*)(F.lds + F.wave * 16384);
    const int gw = F.bid * 8 + F.wave, NGW = F.G * 8;
    bf16_t* Wt_in = (bf16_t*)(F.ws + WS_WIN); bf16_t* Wt_br = (bf16_t*)(F.ws + WS_WBR); bf16_t* Wt_out = (bf16_t*)(F.ws + WS_WOUT);
    bf16_t* Wt_up = (bf16_t*)(F.ws + WS_WUP); bf16_t* Wt_dn = (bf16_t*)(F.ws + WS_WDN);
    const float* w_in = a->in[I_WIN] + (size_t)layer * DM * INC; const float* g_att = a->in[I_NATT] + layer * DM;
    const float* w_br = a->in[I_WBR] + (size_t)layer * 3 * BW * DM; const float* w_out = a->in[I_WOUT] + (size_t)layer * DM * DM;
    const float* w_up = a->in[I_WUP] + (size_t)layer * DM * NUP; const float* g_ffn = a->in[I_NFFN] + layer * DM;
    const float* w_dn = a->in[I_WDN] + (size_t)layer * DFF * DM;
    constexpr int I_IN = (DM / 64) * (NPC / 32), I_BR1 = (BW / 64) * (DM / 32), I_OUT = (DM / 64) * (DM / 32), I_UP = (DM / 64) * (NUP / 32), I_DN = (DFF / 64) * (DM / 32);
    constexpr int I_C1 = (4096 / 64) * (HD / 32);
    constexpr int NITEMS = I_IN + 3 * I_BR1 + I_OUT + I_UP + I_DN + 2 * I_C1;
    for (int it = gw; it < NITEMS; it += NGW) {
        int r = it;
        if (r < I_IN) { transpose_item(w_in, DM, INC, Wt_in, g_att, 1, scr, r, NPC / 32, F.lane, NPC); continue; } r -= I_IN;
        if (r < 3 * I_BR1) { const int n = r / I_BR1; r -= n * I_BR1; transpose_item(w_br + (size_t)n * BW * DM, BW, DM, Wt_br, nullptr, 0, scr, r, DM / 32, F.lane, DM, n * BW); continue; } r -= 3 * I_BR1;
        if (r < I_OUT) { transpose_item(w_out, DM, DM, Wt_out, nullptr, 0, scr, r, DM / 32, F.lane, DM); continue; } r -= I_OUT;
        if (r < I_UP) { transpose_item(w_up, DM, NUP, Wt_up, g_ffn, 2, scr, r, NUP / 32, F.lane, NUP); continue; } r -= I_UP;
        if (r < I_DN) { transpose_item(w_dn, DFF, DM, Wt_dn, nullptr, 0, scr, r, DM / 32, F.lane, DM); continue; } r -= I_DN;
        { const int j = r / I_C1; r -= j * I_C1; transpose_item(a->in[I_CW1] + (size_t)(layer * 2 + j) * 4096 * HD, 4096, HD, (bf16_t*)(F.ws + WS_MISC + MISC_WC1) + (size_t)j * HD * 4096, nullptr, 0, scr, r, HD / 32, F.lane, 0); }
    }
    if (F.bid < 64) cvec_item(F, a, layer, F.bid);
    if (layer == 0) { bf16_t* XB = (bf16_t*)(F.ws + WS_XB); float* rstd = (float*)(F.ws + WS_RSTD);
        for (int m = gw; m < M; m += NGW) rms_row0(a->in[I_X] + (size_t)m * DM, XB, m, rstd + m, F.lane); }
    else rstd_rows(F);
}
__device__ __forceinline__ void phase_F(Frame& F, KArgs a) { rstd_rows(F); }
__device__ __forceinline__ void phase_H(Frame& F, KArgs a, int layer) {
    const bf16_t* SD = (const bf16_t*)(F.ws + WS_USIDE); bf16_t* ACT = (bf16_t*)(F.ws + WS_ACT);
    const float* cw = a->in[I_CONVW] + (size_t)layer * 3 * NUP; const float* cb = a->in[I_CONVB] + (size_t)layer * NUP;
    constexpr int CG = DFF / 8, NTASK = (M / 64) * 2 * CG;
    for (int task = F.bid * 512 + F.tid; task < NTASK; task += F.G * 512) {
        const int cg = task % CG, rb = task / CG, rw = rb & 1, blk = rb >> 1; if ((blk & 31) == 0) continue;
        const int c0 = cg * 8, uc = 256 * (c0 >> 7) + (c0 & 127);
        const bf16_t* t2 = rw == 0 ? SD + ((size_t)(blk - 1) * 4 + 2) * NUP : SD + ((size_t)(blk - 1) * 4 + 3) * NUP;
        const bf16_t* t1 = rw == 0 ? SD + ((size_t)(blk - 1) * 4 + 3) * NUP : SD + ((size_t)blk * 4 + 0) * NUP;
        const bf16_t* t0 = SD + ((size_t)blk * 4 + rw) * NUP;
        const u32x4 g2 = *(const u32x4*)(t2 + uc), g1 = *(const u32x4*)(t1 + uc), g0 = *(const u32x4*)(t0 + uc), v2 = *(const u32x4*)(t2 + uc + 128), v1 = *(const u32x4*)(t1 + uc + 128), v0 = *(const u32x4*)(t0 + uc + 128);
        const unsigned G2[4] = {g2.x, g2.y, g2.z, g2.w}, G1[4] = {g1.x, g1.y, g1.z, g1.w}, G0[4] = {g0.x, g0.y, g0.z, g0.w}, V2[4] = {v2.x, v2.y, v2.z, v2.w}, V1[4] = {v1.x, v1.y, v1.z, v1.w}, V0[4] = {v0.x, v0.y, v0.z, v0.w};
        float o[8];
#pragma unroll
        for (int e = 0; e < 8; ++e) { const int q = e >> 1; const bool hi = e & 1;
            const float xg2 = hi ? bfhi(G2[q]) : bflo(G2[q]), xg1 = hi ? bfhi(G1[q]) : bflo(G1[q]), xg0 = hi ? bfhi(G0[q]) : bflo(G0[q]);
            const float xv2 = hi ? bfhi(V2[q]) : bflo(V2[q]), xv1 = hi ? bfhi(V1[q]) : bflo(V1[q]), xv0 = hi ? bfhi(V0[q]) : bflo(V0[q]);
            const float cgv = cb[c0 + e] + cw[c0 + e] * xg2 + cw[NUP + c0 + e] * xg1 + cw[2 * NUP + c0 + e] * xg0;
            const float cvv = cb[DFF + c0 + e] + cw[DFF + c0 + e] * xv2 + cw[NUP + DFF + c0 + e] * xv1 + cw[2 * NUP + DFF + c0 + e] * xv0;
            o[e] = cgv * sigmoidf_(cgv) * cvv; }
        *(u32x4*)(ACT + ((size_t)(c0 >> 6) * M + (size_t)(blk * 64 + rw)) * 64 + (c0 & 63)) = (u32x4){pk2(o[0], o[1]), pk2(o[2], o[3]), pk2(o[4], o[5]), pk2(o[6], o[7])};
    }
}

__device__ __forceinline__ int q_next(Frame& F, unsigned* head) {
    __syncthreads();
    if (F.tid == 0) F.MISC[16] = __hip_atomic_fetch_add(head, 1u, __ATOMIC_RELAXED, __HIP_MEMORY_SCOPE_AGENT);
    __syncthreads();
    return __builtin_amdgcn_readfirstlane((int)F.MISC[16]);
}
__device__ __forceinline__ int t5_bucket(int n) {
    if (n < 16) return n;
    int b = 16;
    b += (n >= 19); b += (n >= 21); b += (n >= 24); b += (n >= 27); b += (n >= 31); b += (n >= 35); b += (n >= 40); b += (n >= 46);
    b += (n >= 52); b += (n >= 59); b += (n >= 67); b += (n >= 77); b += (n >= 87); b += (n >= 99); b += (n >= 113);
    return b;
}
__device__ __forceinline__ int crow(int i, int h) { return (i & 3) + 8 * (i >> 2) + 4 * h; }

#define MFMA32(a, b, c) __builtin_amdgcn_mfma_f32_32x32x16_bf16((a), (b), (c), 0, 0, 0)
__device__ __forceinline__ float sum8lanes(float v) { v += __shfl_xor(v, 1); v += __shfl_xor(v, 2); v += __shfl_xor(v, 4); return v; }
__device__ __forceinline__ void norm16(unsigned* pp, const float* gn, float sc) {
    const u32x4 w0 = *(const u32x4*)pp, w1 = *(const u32x4*)(pp + 4); const unsigned w[8] = {w0.x, w0.y, w0.z, w0.w, w1.x, w1.y, w1.z, w1.w};
    float x[16], ss = 0.f;
#pragma unroll
    for (int q = 0; q < 8; ++q) { x[2 * q] = bflo(w[q]); x[2 * q + 1] = bfhi(w[q]); ss += x[2 * q] * x[2 * q] + x[2 * q + 1] * x[2 * q + 1]; }
    const float r = rsqrtf(sum8lanes(ss) * (1.f / HD) + EPS) * sc;
    u32x4 o0, o1;
    o0.x = pk2(x[0] * r * gn[0], x[1] * r * gn[1]); o0.y = pk2(x[2] * r * gn[2], x[3] * r * gn[3]); o0.z = pk2(x[4] * r * gn[4], x[5] * r * gn[5]); o0.w = pk2(x[6] * r * gn[6], x[7] * r * gn[7]);
    o1.x = pk2(x[8] * r * gn[8], x[9] * r * gn[9]); o1.y = pk2(x[10] * r * gn[10], x[11] * r * gn[11]); o1.z = pk2(x[12] * r * gn[12], x[13] * r * gn[13]); o1.w = pk2(x[14] * r * gn[14], x[15] * r * gn[15]);
    *(u32x4*)pp = o0; *(u32x4*)(pp + 4) = o1;
}
__device__ __forceinline__ void item_norm(Frame& F, KArgs a, int layer, int it) {
    bf16_t* P = (bf16_t*)(F.ws + WS_P);
    const float* qg = a->in[I_QG] + layer * HD; const float* kg = a->in[I_KG] + layer * 3 * HD;
    const int lane = F.lane, e0 = (lane & 7) * 16;
    float gq[16], gk[16];
#pragma unroll
    for (int e = 0; e < 16; ++e) { gq[e] = qg[e0 + e]; gk[e] = kg[((lane >> 4) & 1 ? 2 : 1) * HD + e0 + e]; }
    for (int rr = 0; rr < 8; ++rr) {
        bf16_t* pr = P + (size_t)(it * 64 + F.wave * 8 + rr) * NPC;
        norm16((unsigned*)(pr + PQN + lane * 16), gq, QSCALE);
        if (lane < 32) norm16((unsigned*)(pr + (lane < 16 ? PKS + lane * 16 : PKW + (lane - 16) * 16)), gk, 1.f);
    }
}
__device__ __forceinline__ void item_hgfin(Frame& F, KArgs a, int layer, int it) {
    const bf16_t* P = (const bf16_t*)(F.ws + WS_P); const float* OR = (const float*)(F.ws + WS_ORAW); bf16_t* OH = (bf16_t*)(F.ws + WS_OBR) + 2 * BW;
    const float* ng = a->in[I_HNG] + layer * HD; const int lane = F.lane, e0 = (lane & 7) * 16;
    float gn[16];
#pragma unroll
    for (int e = 0; e < 16; ++e) gn[e] = ng[e0 + e];
    for (int rr = 0; rr < 8; ++rr) { const size_t row = (size_t)(it * 64 + F.wave * 8 + rr);
        const f32x4* op = (const f32x4*)(OR + row * BW + lane * 16); const f32x4 o0 = op[0], o1 = op[1], o2 = op[2], o3 = op[3];
        const unsigned* gp = (const unsigned*)(P + row * NPC + PGH + lane * 16); const u32x4 g0 = *(const u32x4*)gp, g1 = *(const u32x4*)(gp + 4);
        const float x[16] = {o0.x, o0.y, o0.z, o0.w, o1.x, o1.y, o1.z, o1.w, o2.x, o2.y, o2.z, o2.w, o3.x, o3.y, o3.z, o3.w}; const unsigned gw[8] = {g0.x, g0.y, g0.z, g0.w, g1.x, g1.y, g1.z, g1.w};
        float ss = 0.f;
#pragma unroll
        for (int e = 0; e < 16; ++e) ss += x[e] * x[e];
        const float r = rsqrtf(sum8lanes(ss) * (1.f / HD) + EPS);
        unsigned ow[8];
#pragma unroll
        for (int q = 0; q < 8; ++q) ow[q] = pk2(x[2 * q] * r * gn[2 * q] * sigmoidf_(bflo(gw[q])), x[2 * q + 1] * r * gn[2 * q + 1] * sigmoidf_(bfhi(gw[q])));
        unsigned* dst = (unsigned*)(OH + row * (3 * BW) + lane * 16);
        *(u32x4*)dst = (u32x4){ow[0], ow[1], ow[2], ow[3]}; *(u32x4*)(dst + 4) = (u32x4){ow[4], ow[5], ow[6], ow[7]};
    }
}
__device__ __forceinline__ void cvec_item(Frame& F, KArgs a, int layer, int blk) {
    const int j = blk >> 5, ks = blk & 31;
    const float* pos = a->in[I_CPOS] + (size_t)(layer * 2 + j) * 32 * HD; const float* w1 = a->in[I_CW1] + (size_t)(layer * 2 + j) * 32 * HD * HD;
    LAS float* red = (LAS float*)F.lds; const int e = F.tid & 127, sub = F.tid >> 7;
    float acc = 0.f;
#pragma unroll 8
    for (int k = ks * 128 + sub * 32; k < ks * 128 + sub * 32 + 32; ++k) acc += pos[k] * w1[(size_t)k * HD + e];
    __syncthreads(); red[sub * 128 + e] = acc; __syncthreads();
    if (F.tid < 128) ((float*)(F.ctl + CW_CVEC))[(j * 32 + ks) * 128 + F.tid] = (red[F.tid] + red[128 + F.tid]) + (red[256 + F.tid] + red[384 + F.tid]);
    __syncthreads();
}
__device__ __forceinline__ void item_compress(Frame& F, KArgs a, int layer, int id) {
    const int j = id >> 7, rem = id & 127, b = rem >> 3, g = (rem >> 2) & 1, n0 = (rem & 3) * 32;
    const bf16_t* P = (const bf16_t*)(F.ws + WS_P);
    LAS float* red = (LAS float*)F.lds;
    LAS float* hid = (LAS float*)(F.lds + 16384);
    LAS float* outv = (LAS float*)(F.lds + 16384 + 32 * 132 * 4);
    const int tid = F.tid, lane = F.lane, wave = F.wave, r = lane & 31, h = lane >> 5, ct = wave & 3, kh = wave >> 2;
    f32x16 acc;
#pragma unroll
    for (int i = 0; i < 16; ++i) acc[i] = 0.f;
    {
        int trow = 16 * (n0 + r) + 16 * kh; const int tmax = T - 1;
        const bf16_t* Ab = P + (size_t)(b * T) * NPC + (j ? PVC : PKC) + g * HD + 8 * h;
        const bf16_t* Bb = (const bf16_t*)(F.ws + WS_MISC + MISC_WC1) + (size_t)(j * HD + 32 * ct + r) * 4096 + (size_t)(16 * kh) * HD + 8 * h;
        for (int l = 0; l < 16; ++l) { const int t = (trow + l) < tmax ? (trow + l) : tmax; const bf16_t* ap = Ab + (size_t)t * NPC; const bf16_t* bp = Bb + l * HD;
#pragma unroll
            for (int ds = 0; ds < 8; ++ds) { const bf16x8 av = *(const bf16x8*)(ap + 16 * ds), bv = *(const bf16x8*)(bp + 16 * ds); acc = MFMA32(av, bv, acc); } }
    }
    if (kh == 1) {
#pragma unroll
        for (int i = 0; i < 16; ++i) red[(ct * 16 + i) * 64 + lane] = acc[i]; }
    __syncthreads();
    if (kh == 0) { float cv = 0.f; { const float* cp = (const float*)(F.ctl + CW_CVEC) + (size_t)(j * 32) * 128 + 32 * ct + r;
#pragma unroll 8
        for (int q = 0; q < 32; ++q) cv += cp[q * 128]; }
#pragma unroll
        for (int i = 0; i < 16; ++i) { const float x = acc[i] + red[(ct * 16 + i) * 64 + lane] + cv;
            const float y = 0.7978845608028654f * (x + 0.044715f * x * x * x);
            const float th = 1.f - 2.f * fast_rcp(1.f + fast_exp2(2.f * y * LOG2E));
            hid[crow(i, h) * 132 + 32 * ct + r] = 0.5f * x * (1.f + th); } }
    __syncthreads();
    { const int e2 = tid & 127, ng = __builtin_amdgcn_readfirstlane(tid >> 7); const float* w2 = a->in[I_CW2] + (size_t)(layer * 2 + j) * HD * HD + e2;
      float o[8];
#pragma unroll
      for (int q = 0; q < 8; ++q) o[q] = 0.f;
      for (int k = 0; k < 128; k += 4) { const float w0 = w2[(size_t)k * HD], w1 = w2[(size_t)(k + 1) * HD], w2_ = w2[(size_t)(k + 2) * HD], w3 = w2[(size_t)(k + 3) * HD];
#pragma unroll
          for (int q = 0; q < 8; ++q) { const f32x4 hv = *(const LAS f32x4*)(hid + (8 * ng + q) * 132 + k); o[q] += (hv.x * w0 + hv.y * w1) + (hv.z * w2_ + hv.w * w3); } }
#pragma unroll
      for (int q = 0; q < 8; ++q) outv[(8 * ng + q) * 132 + e2] = o[q]; }
    __syncthreads();
    const float* kg0 = a->in[I_KG] + layer * 3 * HD;
#pragma unroll
    for (int q = 0; q < 4; ++q) { const int n = 4 * wave + q; float v0 = outv[n * 132 + 2 * lane], v1 = outv[n * 132 + 2 * lane + 1];
        if (j == 0) { const float ss = wave_sum(v0 * v0 + v1 * v1); const float rr = rsqrtf(ss * (1.f / HD) + EPS); v0 *= rr * kg0[2 * lane]; v1 *= rr * kg0[2 * lane + 1]; }
        if (n0 + n >= 127) { v0 = 0.f; v1 = 0.f; }
        bf16_t* dst = (bf16_t*)(F.ws + WS_MISC + (j ? MISC_VCMP : MISC_KCMP)) + (size_t)((b * 2 + g) * 128 + n0 + n) * HD;
        *((unsigned*)dst + lane) = pk2(v0, v1); }
}
__device__ __forceinline__ float xhalf_sum(float v);
constexpr int HG_Q1 = 0, HG_K1 = 17408, HG_QI = 34816, HG_K2 = 43520, HG_K3T = 52224, HG_VT = 70656, HG_AT = 89088, HG_SB = 98304, HG_TOT = 133120, HG_LB = 135168, HG_SS = 135680;
__device__ __forceinline__ void item_hgrn(Frame& F, KArgs a, int layer, int id) {
    const int b = id >> 3, hh = id & 7;
    const bf16_t* P = (const bf16_t*)(F.ws + WS_P); bf16_t* OH = (bf16_t*)(F.ws + WS_OBR);
    LAS unsigned char* L = F.lds;
    LAS float* tot = (LAS float*)(L + HG_TOT); LAS float* lbs = (LAS float*)(L + HG_LB); LAS float* ssp = (LAS float*)(L + HG_SS);
    const int tid = F.tid, lane = F.lane, wave = F.wave, r = lane & 31, h = lane >> 5;
    if (tid < 128) { const float* hb = a->in[I_HLB] + hh * HD + tid; const float x0 = hb[0], x1 = hb[1024], x2 = hb[2048], x3 = hb[3072];
        const float mx = fmaxf(fmaxf(x0, x1), fmaxf(x2, x3)); const float e0 = __expf(x0 - mx), e1 = __expf(x1 - mx), e2 = __expf(x2 - mx), e3 = __expf(x3 - mx);
        const float inv = 1.f / (e0 + e1 + e2 + e3); float c = 0.f; if (layer >= 1) c += e1; if (layer >= 2) c += e2; if (layer >= 3) c += e3;
        lbs[tid] = fmaxf(c * inv, 0.f); }
    { unsigned zu; asm volatile("v_mov_b32 %0, 0" : "=v"(zu));
      for (int i = tid; i < 34816 / 16; i += 512) *(LAS u32x4*)(L + HG_SB + i * 16) = (u32x4){zu, zu, zu, zu}; }
    f32x16 Sacc[2];
#pragma unroll
    for (int q = 0; q < 2; ++q)
#pragma unroll
        for (int i = 0; i < 16; ++i) Sacc[q][i] = 0.f;
    const int pd = tid & 127, psc = __builtin_amdgcn_readfirstlane(tid >> 7);
    const int srow = tid >> 4, sch = tid & 15;
    const bf16_t* gq = P + (size_t)(b * T + srow) * NPC + PQH + hh * HD + sch * 8; const bf16_t* gf = P + (size_t)(b * T + srow) * NPC + PFH + hh * HD + sch * 8;
    const bf16_t* gv = P + (size_t)(b * T + srow) * NPC + PIH + hh * HD + sch * 8;
    u32x4 rq0 = *(const u32x4*)gq, rq1 = *(const u32x4*)(gq + (size_t)32 * NPC), rf0 = *(const u32x4*)gf, rf1 = *(const u32x4*)(gf + (size_t)32 * NPC), rv0 = *(const u32x4*)gv, rv1 = *(const u32x4*)(gv + (size_t)32 * NPC);
    const int et = wave & 3, tt2 = wave >> 2;
    f32x4 gn4[4]; { const float* ng = a->in[I_HNG] + layer * HD;
#pragma unroll
      for (int g4 = 0; g4 < 4; ++g4) gn4[g4] = *(const f32x4*)(ng + 32 * et + 8 * g4 + 4 * h); }
    u32x2 gw4[4];
    for (int c = 0; c < T / 64; ++c) {
        __syncthreads();
        *(LAS u32x4*)(L + HG_Q1 + srow * 272 + sch * 16) = rq0; *(LAS u32x4*)(L + HG_Q1 + (srow + 32) * 272 + sch * 16) = rq1;
        *(LAS u32x4*)(L + HG_K1 + srow * 272 + sch * 16) = rf0; *(LAS u32x4*)(L + HG_K1 + (srow + 32) * 272 + sch * 16) = rf1;
        { const unsigned v0[4] = {rv0.x, rv0.y, rv0.z, rv0.w}, v1[4] = {rv1.x, rv1.y, rv1.z, rv1.w};
#pragma unroll
          for (int q = 0; q < 4; ++q) { LAS unsigned short* p0 = (LAS unsigned short*)(L + HG_VT + (8 * sch + 2 * q) * 144 + srow * 2); LAS unsigned short* p1 = (LAS unsigned short*)(L + HG_VT + (8 * sch + 2 * q + 1) * 144 + srow * 2);
              p0[0] = (unsigned short)(v0[q] & 0xffffu); p1[0] = (unsigned short)(v0[q] >> 16); p0[32] = (unsigned short)(v1[q] & 0xffffu); p1[32] = (unsigned short)(v1[q] >> 16); } }
        __syncthreads();
        { const bf16_t* gp = P + (size_t)(b * T + 64 * c + 32 * tt2 + r) * NPC + PGH + hh * HD + 32 * et + 4 * h;
#pragma unroll
          for (int g4 = 0; g4 < 4; ++g4) gw4[g4] = *(const u32x2*)(gp + 8 * g4); }
        if (c + 1 < T / 64) { const size_t adv = (size_t)(64 * (c + 1)) * NPC;
            rq0 = *(const u32x4*)(gq + adv); rq1 = *(const u32x4*)(gq + adv + (size_t)32 * NPC); rf0 = *(const u32x4*)(gf + adv); rf1 = *(const u32x4*)(gf + adv + (size_t)32 * NPC);
            rv0 = *(const u32x4*)(gv + adv); rv1 = *(const u32x4*)(gv + adv + (size_t)32 * NPC); }
        float qv[16], kv[16], bl[16];
        { const float lb = lbs[pd]; float run = 0.f;
#pragma unroll
          for (int tt = 0; tt < 16; ++tt) { const int t = 16 * psc + tt;
              qv[tt] = bf2f(*(const LAS unsigned short*)(L + HG_Q1 + t * 272 + pd * 2)); const float fp = bf2f(*(const LAS unsigned short*)(L + HG_K1 + t * 272 + pd * 2));
              const float ex = fast_exp2(-fabsf(fp) * LOG2E);
              const float sg = (fp >= 0.f ? 1.f : ex) * fast_rcp(1.f + ex);
              const float f = lb + (1.f - lb) * sg; kv[tt] = 1.f - f;
              const float lf = (layer == 0) ? (fminf(fp, 0.f) - LN2 * fast_log2(1.f + ex)) : LN2 * fast_log2(f);
              run += lf; bl[tt] = run; }
          tot[psc * 128 + pd] = run; }
        __syncthreads();
        { const float t0 = tot[pd], t1 = tot[128 + pd], t2 = tot[256 + pd], t3 = tot[384 + pd];
          const float b31 = t0 + t1, b63 = (t0 + t1) + (t2 + t3);
          const float pre = psc == 0 ? 0.f : (psc == 1 ? t0 : (psc == 2 ? b31 : b31 + t2));
          const float rref = psc >= 2 ? b31 : 0.f; const float eb31 = fast_exp2(b31 * LOG2E), c3 = fast_exp2((b63 - rref) * LOG2E);
          unsigned k3w[8];
#pragma unroll
          for (int tt = 0; tt < 16; ++tt) { const int t = 16 * psc + tt; const float bb = pre + bl[tt];
              const float e1 = fast_exp2((bb - rref) * LOG2E); const float q1 = qv[tt] * e1;
              const float k1 = kv[tt] * fast_exp2(fminf(rref - bb, 80.f) * LOG2E);
              const float k3 = k1 * c3;
              *(LAS unsigned short*)(L + HG_Q1 + t * 272 + pd * 2) = (unsigned short)(pk2(q1, 0.f) & 0xffffu);
              *(LAS unsigned short*)(L + HG_K1 + t * 272 + pd * 2) = (unsigned short)(pk2(k1, 0.f) & 0xffffu);
              if (psc >= 2) *(LAS unsigned short*)(L + HG_QI + (t - 32) * 272 + pd * 2) = (unsigned short)(pk2(q1 * eb31, 0.f) & 0xffffu);
              else *(LAS unsigned short*)(L + HG_K2 + t * 272 + pd * 2) = (unsigned short)(pk2(k1 * eb31, 0.f) & 0xffffu);
              if (tt & 1) k3w[tt >> 1] = (k3w[tt >> 1] & 0xffffu) | (pk2(0.f, k3) & 0xffff0000u); else k3w[tt >> 1] = pk2(k3, 0.f) & 0xffffu; }
          *(LAS u32x4*)(L + HG_K3T + pd * 144 + psc * 32) = (u32x4){k3w[0], k3w[1], k3w[2], k3w[3]}; *(LAS u32x4*)(L + HG_K3T + pd * 144 + psc * 32 + 16) = (u32x4){k3w[4], k3w[5], k3w[6], k3w[7]}; }
        __syncthreads();
        if (wave < 3) {
            const int st = wave == 1 ? 1 : 0, ta = wave == 0 ? 0 : 1;
            const LAS unsigned char* Kb = L + (wave == 2 ? HG_K2 : HG_K1 + st * 32 * 272) + r * 272 + 16 * h; const LAS unsigned char* Qb = L + HG_Q1 + (32 * ta + r) * 272 + 16 * h;
            f32x16 at;
#pragma unroll
            for (int i = 0; i < 16; ++i) at[i] = 0.f;
#pragma unroll
            for (int s8 = 0; s8 < 8; ++s8) at = MFMA32(*(const LAS bf16x8*)(Kb + 32 * s8), *(const LAS bf16x8*)(Qb + 32 * s8), at);
            if (wave < 2) {
#pragma unroll
                for (int i = 0; i < 16; ++i) at[i] = (crow(i, h) <= r) ? at[i] : 0.f; }
#pragma unroll
            for (int g4 = 0; g4 < 4; ++g4) { u32x2 w; w.x = pk2(at[4 * g4], at[4 * g4 + 1]); w.y = pk2(at[4 * g4 + 2], at[4 * g4 + 3]);
                *(LAS u32x2*)(L + HG_AT + (32 * ta + r) * 144 + (32 * st + 8 * g4 + 4 * h) * 2) = w; }
        }
        f32x16 oo;
#pragma unroll
        for (int i = 0; i < 16; ++i) oo[i] = 0.f;
        { const LAS unsigned char* Sb = L + HG_SB + (32 * et + r) * 272 + 16 * h; const LAS unsigned char* Qb = L + (tt2 ? HG_QI : HG_Q1) + r * 272 + 16 * h;
#pragma unroll
          for (int s8 = 0; s8 < 8; ++s8) oo = MFMA32(*(const LAS bf16x8*)(Sb + 32 * s8), *(const LAS bf16x8*)(Qb + 32 * s8), oo); }
        __syncthreads();
#pragma unroll
        for (int q = 0; q < 2; ++q) { const int dt = (wave >> 2) + 2 * q, dd = 32 * dt + r;
            const float eb63 = fast_exp2(((tot[dd] + tot[128 + dd]) + (tot[256 + dd] + tot[384 + dd])) * LOG2E);
#pragma unroll
            for (int i = 0; i < 16; ++i) Sacc[q][i] *= eb63;
            const LAS unsigned char* Vb = L + HG_VT + (32 * et + r) * 144 + 16 * h; const LAS unsigned char* Kb = L + HG_K3T + dd * 144 + 16 * h;
#pragma unroll
            for (int s4 = 0; s4 < 4; ++s4) Sacc[q] = MFMA32(*(const LAS bf16x8*)(Vb + 32 * s4), *(const LAS bf16x8*)(Kb + 32 * s4), Sacc[q]);
            LAS unsigned char* Sw = L + HG_SB + dd * 2;
#pragma unroll
            for (int i = 0; i < 16; i += 2) { const unsigned w = pk2(Sacc[q][i], Sacc[q][i + 1]);
                *(LAS unsigned short*)(Sw + (32 * et + crow(i, h)) * 272) = (unsigned short)(w & 0xffffu); *(LAS unsigned short*)(Sw + (32 * et + crow(i + 1, h)) * 272) = (unsigned short)(w >> 16); } }
        { const LAS unsigned char* Vb = L + HG_VT + (32 * et + r) * 144 + 16 * h; const LAS unsigned char* Ab = L + HG_AT + (32 * tt2 + r) * 144 + 16 * h;
          oo = MFMA32(*(const LAS bf16x8*)(Vb), *(const LAS bf16x8*)(Ab), oo); oo = MFMA32(*(const LAS bf16x8*)(Vb + 32), *(const LAS bf16x8*)(Ab + 32), oo);
          if (tt2) { oo = MFMA32(*(const LAS bf16x8*)(Vb + 64), *(const LAS bf16x8*)(Ab + 64), oo); oo = MFMA32(*(const LAS bf16x8*)(Vb + 96), *(const LAS bf16x8*)(Ab + 96), oo); } }
        { float ss = 0.f;
#pragma unroll
          for (int i = 0; i < 16; ++i) ss += oo[i] * oo[i];
          ss = xhalf_sum(ss);
          if (h == 0) ssp[(32 * tt2 + r) * 4 + et] = ss; }
        __syncthreads();
        { const f32x4 s4 = *(const LAS f32x4*)(ssp + (32 * tt2 + r) * 4); const float rn = rsqrtf(((s4.x + s4.y) + (s4.z + s4.w)) * (1.f / HD) + EPS);
          const size_t row = (size_t)(b * T + 64 * c + 32 * tt2 + r);
#pragma unroll
          for (int g4 = 0; g4 < 4; ++g4) { const int e0 = 32 * et + 8 * g4 + 4 * h;
              const u32x2 gw = gw4[g4]; const f32x4 gn = gn4[g4];
              u32x2 w; w.x = pk2(oo[4 * g4] * rn * gn.x * sigmoidf_(bflo(gw.x)), oo[4 * g4 + 1] * rn * gn.y * sigmoidf_(bfhi(gw.x)));
              w.y = pk2(oo[4 * g4 + 2] * rn * gn.z * sigmoidf_(bflo(gw.y)), oo[4 * g4 + 3] * rn * gn.w * sigmoidf_(bfhi(gw.y)));
              *(u32x2*)(OH + akm(row, 2 * BW + hh * HD + e0)) = w; } }
    }
}

constexpr int AT_K = 0, AT_V = 32768, AT_TAB = 73728, AT_IMP = 75776, AT_SELM = 109568, AT_MISC = 109824;
constexpr int K_TB = 16384, V_RS = 320, V_TB = 64 * V_RS;
__device__ __forceinline__ unsigned koff(int row, int ch) { return 256u * (unsigned)row + 16u * (unsigned)(ch ^ (((row & 3) << 2) | ((row >> 2) & 3))); }
struct Stg { u32x4 k0, k1, v0, v1; };
__device__ __forceinline__ void stg_load(Stg& s, const bf16_t* Kp, const bf16_t* Vp, int ld, int tid) {
    const int row = tid >> 4, ch = tid & 15;
    s.k0 = *(const u32x4*)(Kp + (size_t)row * ld + ch * 8); s.k1 = *(const u32x4*)(Kp + (size_t)(row + 32) * ld + ch * 8);
    s.v0 = *(const u32x4*)(Vp + (size_t)row * ld + ch * 8); s.v1 = *(const u32x4*)(Vp + (size_t)(row + 32) * ld + ch * 8);
}
__device__ __forceinline__ void stg_write(const Stg& s, LAS unsigned char* L, int tid, int buf) {
    const int row = tid >> 4, ch = tid & 15;
    *(LAS u32x4*)(L + AT_K + buf * K_TB + koff(row, ch)) = s.k0; *(LAS u32x4*)(L + AT_K + buf * K_TB + koff(row + 32, ch)) = s.k1;
    *(LAS u32x4*)(L + AT_V + buf * V_TB + row * V_RS + ch * 16) = s.v0; *(LAS u32x4*)(L + AT_V + buf * V_TB + (row + 32) * V_RS + ch * 16) = s.v1;
}
__device__ __forceinline__ float xhalf_max(float v) { auto rr = __builtin_amdgcn_permlane32_swap(__float_as_uint(v), __float_as_uint(v), false, false); return fmaxf(__uint_as_float(rr[0]), __uint_as_float(rr[1])); }
__device__ __forceinline__ float xhalf_sum(float v) { auto rr = __builtin_amdgcn_permlane32_swap(__float_as_uint(v), __float_as_uint(v), false, false); return __uint_as_float(rr[0]) + __uint_as_float(rr[1]); }
__device__ __forceinline__ float xhalf_get(float v, int h) { auto rr = __builtin_amdgcn_permlane32_swap(__float_as_uint(v), __float_as_uint(v), false, false); return __uint_as_float(h ? rr[0] : rr[1]); }
__device__ __forceinline__ void qk_tile(f32x16& p0, f32x16& p1, const LAS unsigned char* L, int buf, const bf16x8 (&qf)[8], int r, int h, const float init = 0.f) {
#pragma unroll
    for (int i = 0; i < 16; ++i) { p0[i] = init; p1[i] = init; }
    const LAS unsigned char* Kb = L + AT_K + buf * K_TB;
    bf16x8 a0[8], a1[8];
#pragma unroll
    for (int s = 0; s < 8; ++s) { a0[s] = *(const LAS bf16x8*)(Kb + koff(r, 2 * s + h)); a1[s] = *(const LAS bf16x8*)(Kb + koff(r + 32, 2 * s + h)); }
#pragma unroll
    for (int s = 0; s < 8; ++s) { p0 = MFMA32(a0[s], qf[s], p0); p1 = MFMA32(a1[s], qf[s], p1); }
    __builtin_amdgcn_sched_group_barrier(0x100, 4, 0);
#pragma unroll
    for (int i = 0; i < 6; ++i) { __builtin_amdgcn_sched_group_barrier(0x008, 2, 0); __builtin_amdgcn_sched_group_barrier(0x100, 2, 0); }
    __builtin_amdgcn_sched_group_barrier(0x008, 4, 0);
}
__device__ __forceinline__ bf16x8 pack8(const f32x16& p, int s) {
    u32x4 w; w.x = pk2(p[8 * s], p[8 * s + 1]); w.y = pk2(p[8 * s + 2], p[8 * s + 3]); w.z = pk2(p[8 * s + 4], p[8 * s + 5]); w.w = pk2(p[8 * s + 6], p[8 * s + 7]);
    return __builtin_bit_cast(bf16x8, w);
}
__device__ __forceinline__ void pv_tile(f32x16 (&o)[4], const f32x16& p0, const f32x16& p1, const LAS unsigned char* L, int buf, int lane) {
    bf16x8 pb[4]; pb[0] = pack8(p0, 0); pb[1] = pack8(p0, 1); pb[2] = pack8(p1, 0); pb[3] = pack8(p1, 1);
    const LAS unsigned char* vb = L + AT_V + buf * V_TB + (4 * (lane >> 5) + ((lane & 15) >> 2)) * V_RS + ((lane >> 4) & 1) * 32 + (lane & 3) * 8;
    __builtin_amdgcn_sched_barrier(0);
    s16x4 lo[16], hi[16];
#pragma unroll
    for (int c = 0; c < 4; ++c)
#pragma unroll
        for (int s = 0; s < 4; ++s) { lo[4 * c + s] = __builtin_amdgcn_ds_read_tr16_b64_v4i16((LAS s16x4*)(vb + (16 * s) * V_RS + 64 * c)); hi[4 * c + s] = __builtin_amdgcn_ds_read_tr16_b64_v4i16((LAS s16x4*)(vb + (16 * s + 8) * V_RS + 64 * c)); }
#pragma unroll
    for (int c = 0; c < 4; ++c)
#pragma unroll
        for (int s = 0; s < 4; ++s) o[c] = MFMA32(__builtin_shufflevector(lo[4 * c + s], hi[4 * c + s], 0, 1, 2, 3, 4, 5, 6, 7), pb[s], o[c]);
    __builtin_amdgcn_sched_group_barrier(0x100, 4, 1);
#pragma unroll
    for (int i = 0; i < 14; ++i) { __builtin_amdgcn_sched_group_barrier(0x008, 1, 1); __builtin_amdgcn_sched_group_barrier(0x100, 2, 1); }
    __builtin_amdgcn_sched_group_barrier(0x008, 2, 1);
    __builtin_amdgcn_sched_barrier(0);
}
__device__ __forceinline__ void softmax_step(f32x16& p0, f32x16& p1, float& m, float& l, f32x16 (&o)[4]) {
    float mx = p0[0];
#pragma unroll
    for (int i = 1; i < 16; ++i) mx = fmaxf(mx, p0[i]);
#pragma unroll
    for (int i = 0; i < 16; ++i) mx = fmaxf(mx, p1[i]);
    mx = xhalf_max(mx);
    const float mn = fmaxf(m, mx); const float alpha = fast_exp2((m - mn) * LOG2E); m = mn;
    const float mb = mn * LOG2E; float ps = 0.f;
#pragma unroll
    for (int i = 0; i < 16; ++i) { p0[i] = fast_exp2(p0[i] * LOG2E - mb); ps += p0[i]; }
#pragma unroll
    for (int i = 0; i < 16; ++i) { p1[i] = fast_exp2(p1[i] * LOG2E - mb); ps += p1[i]; }
    ps = xhalf_sum(ps);
    l = l * alpha + ps;
    if (!__all(alpha == 1.f)) {
#pragma unroll
        for (int c = 0; c < 4; ++c)
#pragma unroll
            for (int i = 0; i < 16; ++i) o[c][i] *= alpha; }
}
__device__ __forceinline__ void store_ot(const f32x16 (&o)[4], float sc, bf16_t* base, size_t row, int col  , int h, bool add) {
    bf16_t* p0 = base + akm(row, col) + 4 * h;
#pragma unroll
    for (int c = 0; c < 4; ++c)
#pragma unroll
        for (int g4 = 0; g4 < 4; ++g4) { u32x2* p = (u32x2*)(p0 + (size_t)(c >> 1) * ((size_t)M * 64) + 32 * (c & 1) + 8 * g4);
            float v0 = sc * o[c][4 * g4], v1 = sc * o[c][4 * g4 + 1], v2 = sc * o[c][4 * g4 + 2], v3 = sc * o[c][4 * g4 + 3];
            if (add) { const u32x2 w0 = *p; v0 += bflo(w0.x); v1 += bfhi(w0.x); v2 += bflo(w0.y); v3 += bfhi(w0.y); }
            u32x2 w; w.x = pk2(v0, v1); w.y = pk2(v2, v3); *p = w; }
}

__device__ __forceinline__ void item_sb(Frame& F, KArgs a, int item) {
    LAS unsigned char* L = F.lds;
    const int qb = 7 - (item >> 7), rem = item & 127, b = rem >> 3, hh = rem & 7, t0 = qb * 256;
    const int tid = F.tid, lane = F.lane, wave = F.wave, r = lane & 31, h = lane >> 5;
    const int tq = t0 + 32 * wave + r;
    const bf16_t* P = (const bf16_t*)(F.ws + WS_P); const size_t rowq = (size_t)(b * T + tq);
    const bf16_t* Kb = P + (size_t)(b * T) * NPC + PKSB + hh * HD; const bf16_t* Vb = P + (size_t)(b * T) * NPC + PVSB + hh * HD;
    bf16x8 qf[8];
#pragma unroll
    for (int s = 0; s < 8; ++s) qf[s] = *(const bf16x8*)(P + rowq * NPC + PQS + hh * HD + 16 * s + 8 * h);
    f32x16 o[4];
#pragma unroll
    for (int c = 0; c < 4; ++c)
#pragma unroll
        for (int i = 0; i < 16; ++i) o[c][i] = 0.f;
    float C = 1.f; bool wdone = false;
    volatile LAS unsigned* flags = (volatile LAS unsigned*)(L + AT_MISC);
    Stg st; int j = 4 * qb + 3, buf = 0, it = 0;
    stg_load(st, Kb + (size_t)(64 * j) * NPC, Vb + (size_t)(64 * j) * NPC, NPC, tid);
    __syncthreads();
    stg_write(st, L, tid, 0);
    if (j > 0) stg_load(st, Kb + (size_t)(64 * (j - 1)) * NPC, Vb + (size_t)(64 * (j - 1)) * NPC, NPC, tid);
    for (;;) {
        if (lane == 0) flags[(it & 1) * 8 + wave] = wdone ? 1u : 0u;
        __syncthreads();
        unsigned nd = 0;
#pragma unroll
        for (int w = 0; w < 8; ++w) nd += flags[(it & 1) * 8 + w];
        if (__builtin_amdgcn_readfirstlane(nd) == 8u) break;
        if (j > 0) stg_write(st, L, tid, buf ^ 1);
        if (j > 1) stg_load(st, Kb + (size_t)(64 * (j - 2)) * NPC, Vb + (size_t)(64 * (j - 2)) * NPC, NPC, tid);
        const bool active = !wdone && (64 * j <= t0 + 32 * wave + 30);
        if (active) {
            f32x16 p0, p1; qk_tile(p0, p1, L, buf, qf, r, h);
            float om0[16], om1[16];
            const int kb = 64 * j + 4 * h;
#define SB_ELEM(MASK) do { _Pragma("unroll") for (int i = 0; i < 16; ++i) { const int key0 = kb + (i & 3) + 8 * (i >> 2); \
                { const float pz = p0[i]; const float ex = fast_exp2(-fabsf(pz) * (QSCALE * LOG2E)); const float rr = fast_rcp(1.f + ex), er = ex * rr; const bool pos = pz >= 0.f; \
                  float be = pos ? rr : er, om = pos ? er : rr; if (MASK) { const bool cz = key0 < tq; om = cz ? om : 1.f; be = cz ? be : 0.f; } om0[i] = om; p0[i] = be; } \
                { const float pz = p1[i]; const float ex = fast_exp2(-fabsf(pz) * (QSCALE * LOG2E)); const float rr = fast_rcp(1.f + ex), er = ex * rr; const bool pos = pz >= 0.f; \
                  float be = pos ? rr : er, om = pos ? er : rr; if (MASK) { const bool cz = key0 + 32 < tq; om = cz ? om : 1.f; be = cz ? be : 0.f; } om1[i] = om; p1[i] = be; } } } while (0)
            SB_ELEM(false);
#undef SB_ELEM
            if (64 * j + 63 >= t0 + 32 * wave) {
#pragma unroll
                for (int i = 0; i < 16; ++i) { const int key0 = kb + (i & 3) + 8 * (i >> 2); const bool c0 = key0 < tq, c1 = key0 + 32 < tq;
                    om0[i] = c0 ? om0[i] : 1.f; p0[i] = c0 ? p0[i] : 0.f; om1[i] = c1 ? om1[i] : 1.f; p1[i] = c1 ? p1[i] : 0.f; } }
            float Tm[2][4], Tr[2][4];
#pragma unroll
            for (int g4 = 0; g4 < 4; ++g4) { Tm[0][g4] = (om0[4 * g4] * om0[4 * g4 + 1]) * (om0[4 * g4 + 2] * om0[4 * g4 + 3]); Tm[1][g4] = (om1[4 * g4] * om1[4 * g4 + 1]) * (om1[4 * g4 + 2] * om1[4 * g4 + 3]); }
#pragma unroll
            for (int k = 0; k < 2; ++k)
#pragma unroll
                for (int g4 = 0; g4 < 4; ++g4) Tr[k][g4] = xhalf_get(Tm[k][g4], h);
            float aft[2][4]; float run = C;
#pragma unroll
            for (int G = 15; G >= 0; --G) { const int k = G >> 3, g4 = (G >> 1) & 3, par = G & 1;
                const float tg = (par == 1) ? (h ? Tm[k][g4] : Tr[k][g4]) : (h ? Tr[k][g4] : Tm[k][g4]);
                if (par == 1) { if (h) aft[k][g4] = run; } else { if (!h) aft[k][g4] = run; }
                run *= tg; }
            C = run;
#pragma unroll
            for (int g4 = 0; g4 < 4; ++g4) {
                { float ca = aft[0][g4];
#pragma unroll
                  for (int e = 3; e >= 0; --e) { const int i = 4 * g4 + e; const float w_ = p0[i] * ca; ca *= om0[i]; p0[i] = w_; } }
                { float ca = aft[1][g4];
#pragma unroll
                  for (int e = 3; e >= 0; --e) { const int i = 4 * g4 + e; const float w_ = p1[i] * ca; ca *= om1[i]; p1[i] = w_; } }
            }
            pv_tile(o, p0, p1, L, buf, lane);
            wdone = __all(C < 1e-30f);
        }
        if (j == 0) break;
        --j; buf ^= 1; ++it;
    }
    store_ot(o, 1.f, (bf16_t*)(F.ws + WS_OBR), rowq, BW + hh * HD, h, false);
}

__device__ __forceinline__ void item_nsa(Frame& F, KArgs a, int item) {
    LAS unsigned char* L = F.lds;
    const int qblk = 31 - (item >> 5), rem = item & 31, b = rem >> 1, g = rem & 1, t0 = qblk * 64;
    const int tid = F.tid, lane = F.lane, wave = F.wave, r = lane & 31, h = lane >> 5, hr = wave >> 1, th = wave & 1;
    const int tl = 32 * th + r, tq = t0 + tl, hq = g * 4 + hr;
    const bf16_t* P = (const bf16_t*)(F.ws + WS_P);
    LAS float* tab = (LAS float*)(L + AT_TAB); LAS float* imp = (LAS float*)(L + AT_IMP); volatile LAS unsigned* selm = (volatile LAS unsigned*)(L + AT_SELM); LAS unsigned* misc = (LAS unsigned*)(L + AT_MISC);
    { const int hh = tid >> 7, dd = tid & 127; tab[tid] = a->in[I_RELB][t5_bucket(dd) * 8 + g * 4 + hh]; }
    if (tid == 0) misc[0] = 0u;
    bf16x8 qf[8];
#pragma unroll
    for (int s = 0; s < 8; ++s) qf[s] = *(const bf16x8*)(P + (size_t)(b * T + tq) * NPC + PQN + hq * HD + 16 * s + 8 * h);
    f32x16 o[4];
    Stg st;
    auto opq = [](int v) { asm volatile("" : "+v"(v)); return v; };
#define NSA_GATE(i) sigmoidf_(bf2f(P[((size_t)(b * T + opq(tq))) * NPC + PGN + hq * 3 + (i)]))
#define NSA_OUT() (bf16_t*)(F.ws + WS_OBR), (size_t)(b * T + opq(tq)), hq * HD
    {
        const bf16_t* kc = (const bf16_t*)(F.ws + WS_MISC + MISC_KCMP) + (size_t)((b * 2 + g) * 128) * HD; const bf16_t* vc = (const bf16_t*)(F.ws + WS_MISC + MISC_VCMP) + (size_t)((b * 2 + g) * 128) * HD;
        const bool two = qblk >= 16;
        f32x16 pc[4];
        __syncthreads();
        { Stg st1; stg_load(st, kc, vc, HD, tid); if (two) stg_load(st1, kc + 64 * HD, vc + 64 * HD, HD, tid);
          stg_write(st, L, tid, 0); if (two) stg_write(st1, L, tid, 1); }
        __syncthreads();
        qk_tile(pc[0], pc[1], L, 0, qf, r, h);
        if (two) qk_tile(pc[2], pc[3], L, 1, qf, r, h);
        float mx = -1e30f;
#pragma unroll
        for (int k = 0; k < 4; ++k) { if (k >= 2 && !two) break;
#pragma unroll
            for (int i = 0; i < 16; ++i) { const int n = 32 * k + crow(i, h); const int dc = tq - (16 * n + 31); const int di = dc < 113 ? dc : 113;
                const float sv = dc >= 0 ? pc[k][i] + tab[hr * 128 + (di < 0 ? 0 : di)] : -__builtin_inff(); pc[k][i] = sv; mx = fmaxf(mx, sv); } }
        mx = xhalf_max(mx);
        float sum = 0.f;
#pragma unroll
        for (int k = 0; k < 4; ++k) { if (k >= 2 && !two) break;
#pragma unroll
            for (int i = 0; i < 16; ++i) { const float e = fast_exp2((pc[k][i] - mx) * LOG2E); pc[k][i] = e; sum += e; } }
        sum = xhalf_sum(sum);
        const float inv = 1.f / fmaxf(sum, 1e-30f);
#pragma unroll
        for (int k = 0; k < 4; ++k)
#pragma unroll
            for (int i = 0; i < 16; ++i) pc[k][i] = (k >= 2 && !two) ? 0.f : pc[k][i] * inv;
        float gs[16], gl[16], rc[16];
#pragma unroll
        for (int k = 0; k < 4; ++k)
#pragma unroll
            for (int g4 = 0; g4 < 4; ++g4) { gs[4 * k + g4] = (pc[k][4 * g4] + pc[k][4 * g4 + 1]) + (pc[k][4 * g4 + 2] + pc[k][4 * g4 + 3]); gl[4 * k + g4] = pc[k][4 * g4 + 3]; }
#pragma unroll
        for (int f = 0; f < 16; ++f) rc[f] = xhalf_get(gl[f], h);
#pragma unroll
        for (int f = 0; f < 16; ++f) { const float prev = h ? rc[f] : (f >= 1 ? rc[f - 1] : 0.f); const int G = 8 * (f >> 2) + 2 * (f & 3) + h;
            imp[(hr * 64 + tl) * 33 + G] = gs[f] + prev; }
#pragma unroll
        for (int c = 0; c < 4; ++c)
#pragma unroll
            for (int i = 0; i < 16; ++i) o[c][i] = 0.f;
        pv_tile(o, pc[0], pc[1], L, 0, lane);
        if (two) pv_tile(o, pc[2], pc[3], L, 1, lane);
        store_ot(o, NSA_GATE(0), NSA_OUT(), h, false);
    }
    __syncthreads();
    const int tk = tid >> 3, part = tid & 7;
    if (qblk >= 16) {
#pragma unroll
        for (int q = 0; q < 4; ++q) { const int jj = part + 8 * q; imp[tk * 33 + jj] = (imp[tk * 33 + jj] + imp[(64 + tk) * 33 + jj]) + (imp[(128 + tk) * 33 + jj] + imp[(192 + tk) * 33 + jj]); }
    }
    __syncthreads();
    {
        unsigned msk;
        if (qblk < 16) msk = (2u << qblk) - 1u;
        else {
            msk = 0u;
#pragma unroll
            for (int q = 0; q < 4; ++q) { const int jj = part + 8 * q;
                if (jj >= 1 && jj <= qblk - 2) { const float v = imp[tk * 33 + jj]; int rank = 0;
#pragma unroll
                    for (int j2 = 1; j2 < 30; ++j2) { const float v2 = imp[tk * 33 + j2]; rank += (j2 <= qblk - 2 && (v2 > v || (v2 == v && j2 < jj))) ? 1 : 0; }
                    if (rank < 13) msk |= 1u << jj; } }
            msk |= (unsigned)__shfl_xor((int)msk, 1); msk |= (unsigned)__shfl_xor((int)msk, 2); msk |= (unsigned)__shfl_xor((int)msk, 4);
            msk |= 1u | (1u << (qblk - 1)) | (1u << qblk);
        }
        if (part == 0) selm[tk] = msk;
        unsigned om = msk;
#pragma unroll
        for (int off = 8; off < 64; off <<= 1) om |= (unsigned)__shfl_xor((int)om, off);
        if (lane == 0) __hip_atomic_fetch_or(misc, om, __ATOMIC_RELAXED, __HIP_MEMORY_SCOPE_WORKGROUP);
    }
    __syncthreads();
    const bf16_t* Kbase = P + (size_t)(b * T) * NPC + g * HD;
    const float bfar = tab[hr * 128 + 113];
    for (int rep = 0; rep < (MK_PROBE == 31 ? 2 : 1); ++rep) {
        if (rep) __syncthreads();
        unsigned om = __builtin_amdgcn_readfirstlane(misc[0]); const unsigned mym = selm[tl];
        float m = -1e30f, l = 0.f;
#pragma unroll
        for (int c = 0; c < 4; ++c)
#pragma unroll
            for (int i = 0; i < 16; ++i) o[c][i] = 0.f;
        int jc = __builtin_ctz(om); om &= om - 1u;
        stg_load(st, Kbase + PKS + (size_t)(64 * jc) * NPC, Kbase + PVS + (size_t)(64 * jc) * NPC, NPC, tid);
        stg_write(st, L, tid, 0);
        int jn = om ? __builtin_ctz(om) : -1; if (jn >= 0) { om &= om - 1u; stg_load(st, Kbase + PKS + (size_t)(64 * jn) * NPC, Kbase + PVS + (size_t)(64 * jn) * NPC, NPC, tid); }
        int buf = 0;
        for (;;) {
            __syncthreads();
            if (jn >= 0) stg_write(st, L, tid, buf ^ 1);
            const int jnn = om ? __builtin_ctz(om) : -1; if (jnn >= 0) { om &= om - 1u; stg_load(st, Kbase + PKS + (size_t)(64 * jnn) * NPC, Kbase + PVS + (size_t)(64 * jnn) * NPC, NPC, tid); }
            const bool sel = (mym >> jc) & 1u; const bool farsel = jc <= qblk - 3;
            f32x16 p0, p1; qk_tile(p0, p1, L, buf, qf, r, h, farsel ? (sel ? bfar : -__builtin_inff()) : 0.f);
            if (!farsel) {
#pragma unroll
                for (int i = 0; i < 16; ++i) { const int d0 = tq - (64 * jc + crow(i, h)), d1 = d0 - 32;
                    const float b0 = tab[hr * 128 + (d0 < 0 ? 0 : (d0 > 113 ? 113 : d0))], b1 = tab[hr * 128 + (d1 < 0 ? 0 : (d1 > 113 ? 113 : d1))];
                    p0[i] = (sel && d0 >= 0) ? p0[i] + b0 : -__builtin_inff(); p1[i] = (sel && d1 >= 0) ? p1[i] + b1 : -__builtin_inff(); }
            }
            softmax_step(p0, p1, m, l, o);
            pv_tile(o, p0, p1, L, buf, lane);
            if (jn < 0) break;
            jc = jn; jn = jnn; buf ^= 1;
        }
        if (rep == (MK_PROBE == 31 ? 1 : 0)) store_ot(o, NSA_GATE(1) / l, NSA_OUT(), h, true);
    }
    for (int rep = 0; rep < (MK_PROBE == 32 ? 2 : 1); ++rep) {
        float m = -1e30f, l = 0.f;
#pragma unroll
        for (int c = 0; c < 4; ++c)
#pragma unroll
            for (int i = 0; i < 16; ++i) o[c][i] = 0.f;
        int jc = qblk >= 8 ? qblk - 8 : 0;
        stg_load(st, Kbase + PKW + (size_t)(64 * jc) * NPC, Kbase + PVW + (size_t)(64 * jc) * NPC, NPC, tid);
        __syncthreads();
        stg_write(st, L, tid, 0);
        if (jc < qblk) stg_load(st, Kbase + PKW + (size_t)(64 * (jc + 1)) * NPC, Kbase + PVW + (size_t)(64 * (jc + 1)) * NPC, NPC, tid);
        int buf = 0;
        for (;;) {
            __syncthreads();
            if (jc < qblk) stg_write(st, L, tid, buf ^ 1);
            if (jc + 1 < qblk) stg_load(st, Kbase + PKW + (size_t)(64 * (jc + 2)) * NPC, Kbase + PVW + (size_t)(64 * (jc + 2)) * NPC, NPC, tid);
            const bool interior = jc <= qblk - 3 && jc >= qblk - 7;
            f32x16 p0, p1; qk_tile(p0, p1, L, buf, qf, r, h, interior ? bfar : 0.f);
            if (!interior) {
                const bool far = jc <= qblk - 3;
#pragma unroll
                for (int i = 0; i < 16; ++i) { const int d0 = tq - (64 * jc + crow(i, h)), d1 = d0 - 32;
                    const float b0 = far ? bfar : tab[hr * 128 + (d0 < 0 ? 0 : (d0 > 113 ? 113 : d0))], b1 = far ? bfar : tab[hr * 128 + (d1 < 0 ? 0 : (d1 > 113 ? 113 : d1))];
                    p0[i] = ((unsigned)d0 < 512u) ? p0[i] + b0 : -__builtin_inff(); p1[i] = ((unsigned)d1 < 512u) ? p1[i] + b1 : -__builtin_inff(); }
            }
            softmax_step(p0, p1, m, l, o);
            pv_tile(o, p0, p1, L, buf, lane);
            if (jc == qblk) break;
            ++jc; buf ^= 1;
        }
        if (rep == (MK_PROBE == 32 ? 1 : 0)) store_ot(o, NSA_GATE(2) / l, NSA_OUT(), h, true);
    }
#undef NSA_GATE
#undef NSA_OUT
}

constexpr int NI_H = 128, NI_S = 1024, NI_C = 256, NI_N = 512, NI_A = 1024;
#define FRESH_F() do { unsigned on_ = ~0u; asm volatile("" : "+s"(on_)); int t_ = F.wave * 64 + (int)__builtin_amdgcn_mbcnt_hi(on_, __builtin_amdgcn_mbcnt_lo(on_, 0u)); asm volatile("" : "+v"(t_)); F.tid = t_; F.lane = t_ & 63; F.wave = __builtin_amdgcn_readfirstlane(t_ >> 6); } while (0)
__device__ __forceinline__ void phase_Ca(Frame& F, KArgs a, int layer, int bank, int types) {
    unsigned* head = F.ctl + CW_QUEUE + 64 * (layer * 8) + bank * 4096;
    if (types & 1) for (;;) { const int it = q_next(F, head + 0); if (it >= NI_H) break; FRESH_F(); item_hgrn(F, a, layer, it); }
    if (types & 2) for (;;) { const int it = q_next(F, head + 64); if (it >= NI_S) break; FRESH_F(); item_sb(F, a, it); }
    if (types & 4) for (;;) { const int it = q_next(F, head + 128); if (it >= NI_C) break; FRESH_F(); item_compress(F, a, layer, it); }
    if (types & 8) for (;;) { const int it = q_next(F, head + 192); if (it >= NI_N) break; FRESH_F(); item_norm(F, a, layer, it); }
}
__device__ __forceinline__ void phase_Cb(Frame& F, KArgs a, int layer, int bank) {
    unsigned* head = F.ctl + CW_QUEUE + 64 * (layer * 8 + 4) + bank * 4096;
    for (;;) { const int it = q_next(F, head + 0); if (it >= NI_A) break; FRESH_F(); item_nsa(F, a, it); }
}

__global__ void __launch_bounds__(512, 2) mega(Args karg) {
    extern __shared__ __attribute__((aligned(16))) unsigned char lds_raw[];
    Frame F;
    F.lds = (LAS unsigned char*)lds_raw; F.MISC = (volatile LAS unsigned*)(F.lds + MISC_OFF);
    F.tid = threadIdx.x; F.lane = F.tid & 63; F.wave = __builtin_amdgcn_readfirstlane(F.tid >> 6); F.G = gridDim.x; F.bid = blockIdx.x;
    KArgs a = (KArgs)__builtin_amdgcn_kernarg_segment_ptr();
    F.ws = a->ws; F.ctl = (unsigned*)(a->ws + WS_CTL);
    if (F.tid < 64) F.MISC[F.tid] = 0u;
    __syncthreads();
    const int lo = karg.ph_lo, hi = karg.ph_hi;
    XcdBarrier bar; bar.bar = F.ctl + CW_BAR; bar.x = 0; bar.st = F.MISC + 8;
    if (hi - lo > 1) bar = xcd_barrier_post(F.ctl + CW_BAR, F.MISC + 8);
#define IN(k) (lo <= (k) && (k) < hi)
#define ON(k) (((MK_PHASE_MASK & MK_BUILD_MASK) >> (k)) & 1)
#define GRID_BAR() do { unsigned* bp_ = (unsigned*)(a->ws + WS_CTL) + CW_BAR; asm volatile("" : "+s"(bp_)); bar.bar = bp_; xcd_barrier(bar); } while (0)
#define SEAM(k) do { if (IN(k) && IN((k) + 1)) GRID_BAR(); } while (0)
    bf16_t* Hb; bf16_t* Pb; const int wave_s = __builtin_amdgcn_readfirstlane(threadIdx.x >> 6);
    for (int layer = 0; layer < DEPTH; ++layer) {
        const int pb = layer * 10;
#define FRESH() do { unsigned on_ = ~0u; asm volatile("" : "+s"(on_)); int t_ = wave_s * 64 + (int)__builtin_amdgcn_mbcnt_hi(on_, __builtin_amdgcn_mbcnt_lo(on_, 0u)); asm volatile("" : "+v"(t_)); F.tid = t_; F.lane = t_ & 63; F.wave = __builtin_amdgcn_readfirstlane(t_ >> 6); \
        asm volatile("" : "+s"(a)); F.ws = a->ws; F.ctl = (unsigned*)(a->ws + WS_CTL); Hb = (bf16_t*)(F.ws + WS_H); Pb = (bf16_t*)(F.ws + WS_P); } while (0)
        if (ON(0) && IN(pb + 0)) { FRESH(); if (MK_PROBE == 0) { phase_A(F, a, layer); GRID_BAR(); } phase_A(F, a, layer); } SEAM(pb + 0);
        if (ON(1) && IN(pb + 1)) for (int rep = 0; rep < (MK_PROBE == 1 ? 2 : 1); ++rep) { FRESH();
            if (rep) GRID_BAR();
            if (MK_STAGGER) { const unsigned long long t0 = __builtin_amdgcn_s_memrealtime(), dl = (unsigned long long)((F.bid >> 3) & 7) * MK_STAGGER; while (__builtin_amdgcn_s_memrealtime() - t0 < dl) __builtin_amdgcn_s_sleep(4); }
            pg8::Gemm g{(const bf16_t*)(F.ws + WS_XB), (const bf16_t*)(F.ws + WS_WIN), M, NPC, DM, 1, 1}; pg8::StaticOrder S; S.init(M, NPC, F.G, F.bid);
            pg8::EpiStoreBf16 E{Pb, NPC, PGT / 256, PGN / 256, (const float*)(F.ws + WS_RSTD), (LAS const float*)(F.lds + pg8::LRS_OFF)};
            pg8::gemm_phase<pg8::EpiStoreBf16, pg8::StaticOrder, PG8_ALIGN, PG8_SP2>(F.lds, g, S, E, F.tid, (MK_DIAG && layer == 0 && F.bid == 0) ? (unsigned long long*)(F.ctl + 49152) : nullptr);
        } SEAM(pb + 1);
        if (ON(2) && IN(pb + 2)) { FRESH(); if (MK_PROBE >= 20 && MK_PROBE < 28) { phase_Ca(F, a, layer, 1, MK_PROBE - 20); GRID_BAR(); } phase_Ca(F, a, layer, 0, 15); } SEAM(pb + 2);
        if (ON(3) && IN(pb + 3)) { FRESH(); if (MK_PROBE == 3) { phase_Cb(F, a, layer, 1); GRID_BAR(); } phase_Cb(F, a, layer, 0); } SEAM(pb + 3);
        if (ON(4) && IN(pb + 4)) for (int rep = 0; rep < (MK_PROBE == 4 ? 2 : 1); ++rep) { FRESH();
            if (rep) GRID_BAR();
            pg8::Gemm g{(const bf16_t*)(F.ws + WS_OBR), (const bf16_t*)(F.ws + WS_WBR), M, DM, 3 * BW, 1, 1}; pg8::StaticOrder S; S.init(M, DM, F.G, F.bid);
            pg8::EpiGated E{Pb, Hb};
            pg8::gemm_phase<pg8::EpiGated, pg8::StaticOrder, PG8_ALIGN, PG8_SP2>(F.lds, g, S, E, F.tid);
        } SEAM(pb + 4);
        if (ON(5) && IN(pb + 5)) for (int rep = 0; rep < (MK_PROBE == 5 ? 2 : 1); ++rep) { FRESH();
            if (rep) GRID_BAR();
            pg8::Gemm g{Hb, (const bf16_t*)(F.ws + WS_WOUT), M, DM, DM, 1, 1}; pg8::StaticOrder S; S.init(M, DM, F.G, F.bid);
            pg8::EpiResidBf16 E{(MK_PROBE == 5 && rep == 0) ? (bf16_t*)(F.ws + WS_P) : (bf16_t*)(F.ws + WS_XB), nullptr, (MK_PROBE == 5 && rep == 0) ? (float*)(F.ws + WS_P + 256 * MiB) : (float*)(F.ws + WS_SSQ), DM};
            pg8::gemm_phase<pg8::EpiResidBf16, pg8::StaticOrder, PG8_ALIGN, PG8_SP2>(F.lds, g, S, E, F.tid);
        } SEAM(pb + 5);
        if (ON(6) && IN(pb + 6)) { FRESH(); if (MK_PROBE == 60) { GRID_BAR(); GRID_BAR(); GRID_BAR(); GRID_BAR(); } if (MK_PROBE == 6) { phase_F(F, a); GRID_BAR(); } phase_F(F, a); } SEAM(pb + 6);
        if (ON(7) && IN(pb + 7)) for (int rep = 0; rep < (MK_PROBE == 7 ? 2 : 1); ++rep) { FRESH();
            if (rep) GRID_BAR();
            if (MK_STAGGER) { const unsigned long long t0 = __builtin_amdgcn_s_memrealtime(), dl = (unsigned long long)((F.bid >> 3) & 7) * MK_STAGGER; while (__builtin_amdgcn_s_memrealtime() - t0 < dl) __builtin_amdgcn_s_sleep(4); }
            pg8::Gemm g{(const bf16_t*)(F.ws + WS_XB), (const bf16_t*)(F.ws + WS_WUP), M, NUP, DM, 1, 1}; pg8::StaticOrder S; S.init(M, NUP, F.G, F.bid);
            pg8::EpiConvAct E{F.ws, a, layer, (LAS const float*)(F.lds + pg8::LRS_OFF)};
            pg8::gemm_phase<pg8::EpiConvAct, pg8::StaticOrder, PG8_ALIGN, PG8_SP2>(F.lds, g, S, E, F.tid);
        } SEAM(pb + 7);
        if (ON(8) && IN(pb + 8)) { FRESH(); if (MK_PROBE == 8) { phase_H(F, a, layer); GRID_BAR(); } phase_H(F, a, layer); } SEAM(pb + 8);
        if (ON(9) && IN(pb + 9)) for (int rep = 0; rep < (MK_PROBE == 9 ? 2 : 1); ++rep) { FRESH();
            if (rep) GRID_BAR();
            pg8::Gemm g{(const bf16_t*)(F.ws + WS_ACT), (const bf16_t*)(F.ws + WS_WDN), M, DM, DFF, 1, 1}; pg8::StaticOrder S; S.init(M, DM, F.G, F.bid, 4, 1);
            pg8::EpiResidBf16 E{(MK_PROBE == 9 && rep == 0) ? (bf16_t*)(F.ws + WS_P) : (bf16_t*)(F.ws + WS_XB), (layer == DEPTH - 1 && !(MK_PROBE == 9 && rep == 0)) ? a->out : nullptr, (MK_PROBE == 9 && rep == 0) ? (float*)(F.ws + WS_P + 256 * MiB) : (float*)(F.ws + WS_SSQ), DM};
            pg8::gemm_phase<pg8::EpiResidBf16, pg8::StaticOrder, PG8_ALIGN, PG8_SP2>(F.lds, g, S, E, F.tid);
        } SEAM(pb + 9);
    }
#if MK_DIAG
    GRID_BAR();
    { const unsigned long long* dg = (const unsigned long long*)(F.ctl + 49152); const float kl = (float)(long long)(dg[1] - dg[0]), per = (float)(long long)(dg[2] - dg[0]);
      const float eps = MK_DIAG == 1 ? kl / per : (MK_DIAG == 2 ? per * 1e-4f : kl * 1e-4f);
      for (size_t i = (size_t)F.bid * 512 + threadIdx.x; i < (size_t)M * DM; i += (size_t)F.G * 512) a->out[i] *= (1.f + eps); }
#endif
}

extern "C" void kernel_launch(void* const* d_in, const int* in_sizes, int n_in, void* d_out, int out_size, void* d_ws, size_t ws_size, hipStream_t stream) {
    static int grid = 0;
    if (grid == 0) {
        if (n_in != 18 || in_sizes[0] != M * DM || out_size != M * DM || ws_size < WS_END) { fprintf(stderr, "kernel_launch: unexpected shapes / workspace (%d inputs, ws %zu)\n", n_in, ws_size); grid = -1; return; }
        int dev = 0, cus = 0, per_cu = 0;
        if (hipGetDevice(&dev) != hipSuccess || hipDeviceGetAttribute(&cus, hipDeviceAttributeMultiprocessorCount, dev) != hipSuccess) { grid = -1; return; }
        if (hipFuncSetAttribute((const void*)mega, hipFuncAttributeMaxDynamicSharedMemorySize, LDS_BYTES) != hipSuccess) { grid = -1; return; }
        if (hipOccupancyMaxActiveBlocksPerMultiprocessor(&per_cu, (const void*)mega, 512, LDS_BYTES) != hipSuccess || per_cu < 1) { fprintf(stderr, "kernel_launch: occupancy query says %d\n", per_cu); }
        (void)hipGetLastError();
        grid = cus;
    }
    if (grid < 0) return;
    (void)hipMemsetAsync((char*)d_ws + WS_CTL, 0, CTL_BYTES, stream);
    Args a{};
    for (int i = 0; i < 18; ++i) a.in[i] = (const float*)d_in[i];
    a.out = (float*)d_out; a.ws = (unsigned char*)d_ws;
#if MK_ONE_LAUNCH
    a.ph_lo = 0; a.ph_hi = DEPTH * 10;
    hipLaunchKernelGGL(mega, dim3(grid), dim3(512), LDS_BYTES, stream, a);
#else
    for (int p = 0; p < DEPTH * 10; ++p) { a.ph_lo = p; a.ph_hi = p + 1; hipLaunchKernelGGL(mega, dim3(grid), dim3(512), LDS_BYTES, stream, a); }
#endif
}
```

```cpp
#include <hip/hip_runtime.h>
#include <stdint.h>
#include <stdio.h>

#ifndef MK_ONE_LAUNCH
#define MK_ONE_LAUNCH 1
#endif
#ifndef MK_PHASE_MASK
#define MK_PHASE_MASK 0x3ff
#endif
#ifndef MK_PROBE
#define MK_PROBE -1
#endif
#ifndef MK_STAGGER
#define MK_STAGGER 0
#endif
#ifndef MK_DIAG
#define MK_DIAG 0
#endif
#ifndef MK_BUILD_MASK
#define MK_BUILD_MASK 0x3ff
#endif

#define LAS __attribute__((address_space(3)))
typedef unsigned short bf16_t;
typedef short bf16x8 __attribute__((ext_vector_type(8)));
typedef short s16x4 __attribute__((ext_vector_type(4)));
typedef float f32x4 __attribute__((ext_vector_type(4)));
typedef float f32x16 __attribute__((ext_vector_type(16)));
typedef float f32x2 __attribute__((ext_vector_type(2)));
typedef unsigned u32x4 __attribute__((ext_vector_type(4)));
typedef unsigned u32x2 __attribute__((ext_vector_type(2)));
typedef __bf16 bfv2 __attribute__((ext_vector_type(2)));

constexpr int DM = 2048, NB = 16, T = 2048, DEPTH = 4, M = NB * T, HD = 128;
constexpr int INC = 15896;
constexpr int NPC = 16128;
constexpr int PQN = 0, PKC = 1024, PVC = 1280, PKS = 1536, PVS = 1792, PKW = 2048, PVW = 2304, PQS = 2560, PKSB = 3584, PVSB = 4608,
              PQH = 5632, PFH = 6656, PIH = 7680, PGH = 8704, PGT = 9728, PGN = 15872;
constexpr int DFF = 5632, NUP = 2 * DFF;
constexpr int BW = 1024;
constexpr float EPS = 1e-6f;
constexpr float LOG2E = 1.4426950408889634f, LN2 = 0.6931471805599453f;
constexpr float QSCALE = 0.08838834764831845f;

constexpr size_t MiB = 1u << 20;
constexpr size_t WS_CTL = 0, CTL_BYTES = 1 * MiB;
constexpr size_t WS_WIN = 1 * MiB, WS_WBR = 64 * MiB, WS_WOUT = 76 * MiB, WS_WUP = 84 * MiB, WS_WDN = 128 * MiB;
constexpr size_t WS_MISC = 150 * MiB;
constexpr size_t MISC_KCMP = 0, MISC_VCMP = 1 * MiB, MISC_WC1 = 2 * MiB;
constexpr int CW_CVEC = 32768;
constexpr size_t WS_SCR = 154 * MiB;
constexpr size_t WS_P = 218 * MiB;
constexpr size_t WS_H = 1226 * MiB;
constexpr size_t WS_OBR = 1354 * MiB;
constexpr size_t WS_ORAW = 1546 * MiB;
constexpr size_t WS_XB = 1674 * MiB;
constexpr size_t WS_SSQ = 1802 * MiB;
constexpr size_t WS_RSTD = 1806 * MiB;
constexpr size_t WS_USIDE = 1807 * MiB;
constexpr size_t WS_END = 1853 * MiB;
constexpr size_t WS_ACT = WS_P + 704 * MiB;
constexpr int CW_BAR = 4096;
constexpr int CW_QUEUE = 16384;

constexpr int RING_BYTES = 131072;
constexpr int MISC_OFF = 147456 - 256;
constexpr int LDS_BYTES = 147456;

__device__ __forceinline__ float bf2f(unsigned short b) { return __uint_as_float(((unsigned)b) << 16); }
__device__ __forceinline__ float bflo(unsigned w) { return __uint_as_float(w << 16); }
__device__ __forceinline__ float bfhi(unsigned w) { return __uint_as_float(w & 0xffff0000u); }
__device__ __forceinline__ unsigned pk2(float lo, float hi) { f32x2 v = {lo, hi}; bfv2 b = __builtin_convertvector(v, bfv2); return __builtin_bit_cast(unsigned, b); }
__device__ __forceinline__ float wave_sum(float v) {
#pragma unroll
    for (int o = 1; o < 64; o <<= 1) v += __shfl_xor(v, o);
    return v;
}
__device__ __forceinline__ float fast_exp2(float x) { return __builtin_amdgcn_exp2f(x); }
__device__ __forceinline__ float fast_log2(float x) { return __builtin_amdgcn_logf(x); }
__device__ __forceinline__ float fast_rcp(float x) { return __builtin_amdgcn_rcpf(x); }
__device__ __forceinline__ float sigmoidf_(float x) { return fast_rcp(1.f + fast_exp2(-x * LOG2E)); }
#define LDS_WAIT() asm volatile("s_waitcnt lgkmcnt(0)" ::: "memory")
__device__ __forceinline__ size_t akm(size_t row, int col) { return ((size_t)(col >> 6) * M + row) * 64 + (col & 63); }

#define XB_TMO      128
#define XB_XCNT(j)  (256  + 64 * (j))
#define XB_XSUB(j)  (1280 + 64 * (j))
#define XB_XGEN(j)  (2304 + 64 * (j))
#define XB_TOP      3328
#define XB_TOPGEN   3392
#define XCD_BAR_WORDS 3456
#define XB_SPIN_CAP (1u << 22)
__device__ __forceinline__ unsigned xb_ld(unsigned* p)              { return __hip_atomic_load(p, __ATOMIC_RELAXED, __HIP_MEMORY_SCOPE_AGENT); }
__device__ __forceinline__ unsigned xb_add(unsigned* p, unsigned v) { return __hip_atomic_fetch_add(p, v, __ATOMIC_RELAXED, __HIP_MEMORY_SCOPE_AGENT); }
__device__ __forceinline__ unsigned xb_xcc_id() { return (unsigned)__builtin_amdgcn_s_getreg((3 << 11) | 20) & 0xFu; }
#define XB_SPIN(cond, bar) do { unsigned _sp = 0; while (cond) { __builtin_amdgcn_s_sleep(1); \
    if ((++_sp & 255u) == 0u) { if (xb_ld(&(bar)[XB_TMO])) break; if (_sp > XB_SPIN_CAP) { atomicAdd(&(bar)[XB_TMO], 1u); break; } } } } while (0)
struct XcdBarrier { unsigned* bar; unsigned x; volatile LAS unsigned* st; };
__device__ __forceinline__ XcdBarrier xcd_barrier_post(unsigned* bar, volatile LAS unsigned* st) {
    XcdBarrier b; b.bar = bar; b.x = xb_xcc_id(); b.st = st;
    if (threadIdx.x == 0) (void)xb_add(&bar[XB_XCNT(b.x)], 1u);
    return b;
}
__device__ __forceinline__ void xcd_barrier_complete(unsigned* bar, unsigned x, unsigned& nloc, unsigned& nx) {
    const unsigned G = gridDim.x * gridDim.y * gridDim.z;
    unsigned sum, cnt, mine, sp = 0u;
    for (;;) {
        sum = 0u; cnt = 0u; mine = 0u;
#pragma unroll
        for (unsigned j = 0; j < 16; ++j) { const unsigned c = xb_ld(&bar[XB_XCNT(j)]); sum += c; cnt += (c > 0u) ? 1u : 0u; mine = (j == x) ? c : mine; }
        if (sum == G) break;
        __builtin_amdgcn_s_sleep(1);
        if ((++sp & 255u) == 0u) { if (xb_ld(&bar[XB_TMO])) break; if (sp > XB_SPIN_CAP) { atomicAdd(&bar[XB_TMO], 1u); break; } }
    }
    nloc = mine > 0u ? mine : 1u; nx = cnt > 0u ? cnt : 1u;
}
__device__ __forceinline__ void xcd_barrier(const XcdBarrier& b) {
    asm volatile("s_waitcnt vmcnt(0)" ::: "memory");
    __syncthreads();
    if (threadIdx.x == 0) {
        unsigned* bar = b.bar;
        __builtin_amdgcn_s_waitcnt(0);
        unsigned nloc = b.st[0], nx = b.st[1];
        if (nloc == 0u) { xcd_barrier_complete(bar, b.x, nloc, nx); b.st[0] = nloc; b.st[1] = nx; }
        const unsigned old = xb_add(&bar[XB_XSUB(b.x)], 1u);
        const unsigned gen = old / nloc;
        if (old + 1u == (gen + 1u) * nloc) {
            __builtin_amdgcn_fence(__ATOMIC_RELEASE, "agent");
            asm volatile("s_waitcnt vmcnt(0)" ::: "memory");
            const unsigned og = xb_add(&bar[XB_TOP], 1u);
            const unsigned tg = og / nx;
            if (og + 1u == (tg + 1u) * nx) xb_add(&bar[XB_TOPGEN], 1u);
            else XB_SPIN(xb_ld(&bar[XB_TOPGEN]) == tg, bar);
            __builtin_amdgcn_fence(__ATOMIC_ACQUIRE, "agent");
            xb_add(&bar[XB_XGEN(b.x)], 1u);
            asm volatile("s_waitcnt vmcnt(0)" ::: "memory");
        } else {
            XB_SPIN(xb_ld(&bar[XB_XGEN(b.x)]) == gen, bar);
            __builtin_amdgcn_fence(__ATOMIC_ACQUIRE, "agent");
            asm volatile("s_waitcnt vmcnt(0)" ::: "memory");
        }
    }
    __syncthreads();
}

struct Args { const float* in[18]; float* out; unsigned char* ws; int ph_lo, ph_hi; };
typedef const __attribute__((address_space(4))) Args* KArgs;
enum { I_X = 0, I_NATT, I_WIN, I_QG, I_KG, I_CPOS, I_CW1, I_CW2, I_RELB, I_HLB, I_HNG, I_WBR, I_WOUT, I_NFFN, I_WUP, I_CONVW, I_CONVB, I_WDN };
namespace pg8 {
constexpr int BM = 256, BK = 64, HALF = 128, HTB = HALF * BK * 2, STAGE_BYTES = 8 * HTB, NXCD = 8, LRS_OFF = STAGE_BYTES;
__host__ __device__ __forceinline__ int lds_byte(int r, int c) { const int st = (r >> 4) * 2 + (c >> 5), rr = r & 15, cc = c & 31, ob = rr * 64 + cc * 2; return st * 1024 + (ob ^ (((ob >> 9) & 1) << 5)); }
__host__ __device__ __forceinline__ void stage_rc(int b, int& R, int& C) { const int st = b / 1024, sb = b % 1024, swz = sb ^ (((sb >> 9) & 1) << 5); R = (st >> 1) * 16 + swz / 64; C = (st & 1) * 32 + (swz % 64) / 2; }
__host__ __device__ __forceinline__ int perm32(int rho) { const int n = rho >> 4, i = rho & 15; return 8 * (i >> 2) + 4 * n + (i & 3); }
struct Unit { int pm, pn, aux; };
constexpr int WCS = 64, BJS = 32;
struct Gemm { const bf16_t* A; const bf16_t* Bt; int M, N, K; int akm, bkm; };
struct StaticOrder {
    int nM, nN, nwg, G, c, WGM, rev;
    int pad_;
    __device__ void init(int M_, int N_, int G_, int c_, int wgm = 4, int rev_ = 0) { nM = M_ / BM; nN = N_ / BM; nwg = nM * nN; G = G_; c = c_; WGM = wgm; rev = rev_; pad_ = 0; }
    __device__ __forceinline__ bool tile(long L, Unit& u) const {
        if (L >= nwg) return false;
        int wgid = (int)L; { const int q = nwg / NXCD, r = nwg % NXCD, xcd = wgid % NXCD, off = wgid / NXCD; wgid = (xcd < r ? xcd * (q + 1) : r * (q + 1) + (xcd - r) * q) + off; }
        const int nig = WGM * nN, gid = wgid / nig, fm = gid * WGM, gsz = (nM - fm) < WGM ? (nM - fm) : WGM;
        u.pm = fm + ((wgid % nig) % gsz); u.pn = (wgid % nig) / gsz; u.aux = 0; if (rev) u.pm = nM - 1 - u.pm; return true;
    }
    __device__ __forceinline__ bool next(int i, Unit& u) const { return tile((long)i * G + c, u); }
    __device__ __forceinline__ const char* aptr(const Gemm& g, const Unit& u, size_t tstep) const { return (const char*)g.A + (size_t)u.pm * tstep; }
    __device__ __forceinline__ const char* bptr(const Gemm& g, const Unit& u, size_t tstep) const { return (const char*)g.Bt + (size_t)u.pn * tstep; }
    __device__ __forceinline__ void a_ready(const Unit&) const {}
    __device__ __forceinline__ void done(const Unit&) const {}
};
struct EpiStoreBf16 {
    static constexpr bool PERM = true, AFTER_DRAIN = false;
    static constexpr bool BPERM2 = true;
    static constexpr int PF_WAVES = 1;
    __device__ __forceinline__ void prefetch(LAS unsigned char* lds, const Unit& u, int wid, int lane) const {
        unsigned l16 = (unsigned)lane * 16u; asm volatile("" : "+v"(l16));
        __builtin_amdgcn_global_load_lds((const unsigned*)((const char*)rs + (size_t)u.pm * (BM * 4) + l16), (LAS unsigned*)(lds + LRS_OFF), 16, 0, 0); }
    static constexpr bool LDS_RS = true;
    bf16_t* O; int ldc; int sg_lo, sg_hi; const float* rs; LAS const float* lrs;
    __device__ __forceinline__ void operator()(const f32x4 (&acc)[2][2][4][2], const Unit& u, int wr, int wc, int fr, int fq) const {
        const int row0 = u.pm * BM + wr * 64 + fr, col0 = u.pn * BM + wc * WCS + 8 * fq; const bool sg = u.pn >= sg_lo && u.pn < sg_hi;
        float rsv[8];
#pragma unroll
        for (int g = 0; g < 8; ++g) rsv[g] = lrs[wr * 64 + fr + (g >> 2) * HALF + (g & 3) * 16];
#pragma unroll
        for (int ai = 0; ai < 2; ++ai)
#pragma unroll
            for (int m = 0; m < 4; ++m) { bf16_t* rowp = O + (size_t)(row0 + ai * HALF + m * 16) * ldc + col0;
                bf16_t* rowg = O + (size_t)(u.pm * BM + (ai * 4 + m) * 32 + (wr * 4 + wc) * 2 + (fq >> 1)) * ldc + u.pn * BM + ((fq & 1) * 16 + fr) * 8;
#pragma unroll
                for (int bj = 0; bj < 2; ++bj) { f32x4 v0 = acc[ai][bj][m][0] * rsv[ai * 4 + m], v1 = acc[ai][bj][m][1] * rsv[ai * 4 + m];
                    if (sg) {
#pragma unroll
                        for (int e = 0; e < 4; ++e) { v0[e] = sigmoidf_(v0[e]); v1[e] = sigmoidf_(v1[e]); } }
                    u32x4 w; w.x = pk2(v0[0], v0[1]); w.y = pk2(v0[2], v0[3]); w.z = pk2(v1[0], v1[1]); w.w = pk2(v1[2], v1[3]);
                    __builtin_nontemporal_store(w, (u32x4*)(sg ? rowg + (size_t)(bj * 16) * ldc : rowp + bj * BJS)); } }
    }
};
struct EpiConvAct {
    static constexpr bool PERM = true, AFTER_DRAIN = false, NO_RELAX = true;
    static constexpr bool LDS_RS = true;
    static constexpr bool APERM = true;
    static constexpr int PF_WAVES = 4;
    __device__ __forceinline__ void prefetch(LAS unsigned char* lds, const Unit& u, int wid, int lane) const {
        unsigned l_ = (unsigned)lane; asm volatile("" : "+v"(l_));
        const float* rs = (const float*)(ws + WS_RSTD); const float* cw = a->in[I_CONVW] + (size_t)layer * 3 * NUP; const float* cb = a->in[I_CONVB] + (size_t)layer * NUP;
        if (wid == 0) __builtin_amdgcn_global_load_lds((const unsigned*)((const char*)rs + (size_t)u.pm * (BM * 4) + l_ * 16u), (LAS unsigned*)(lds + LRS_OFF), 16, 0, 0);
        const unsigned sg = 2u * (unsigned)wid + (l_ >> 5), tap = sg & 3u;
        const float* src = (tap < 3u ? cw + (size_t)tap * NUP : cb) + (size_t)(sg >> 2) * DFF + (size_t)u.pn * 128 + (l_ & 31u) * 4u;
        __builtin_amdgcn_global_load_lds((const unsigned*)src, (LAS unsigned*)(lds + LRS_OFF + 1024 + wid * 1024), 16, 0, 0); }
    unsigned char* ws; KArgs a; int layer; LAS const float* lrs;
    static __device__ __forceinline__ f32x4 shr1(const f32x4 v) {
        f32x4 r;
#pragma unroll
        for (int e = 0; e < 4; ++e) r[e] = __int_as_float(__builtin_amdgcn_update_dpp(0, __float_as_int(v[e]), 0x111, 0xf, 0xf, true));
        return r; }
    __device__ __forceinline__ void operator()(const f32x4 (&acc)[2][2][4][2], const Unit& u, int wr, int wc, int fr, int fq) const {
        const int row0 = u.pm * BM + wr * 64 + 4 * fr, ch0 = u.pn * 128 + wc * 32 + 8 * fq;
        bf16_t* ACT = (bf16_t*)(ws + WS_ACT); bf16_t* side = (bf16_t*)(ws + WS_USIDE);
        f32x4 rsv[2];
#pragma unroll
        for (int ai = 0; ai < 2; ++ai) rsv[ai] = *(const LAS f32x4*)(lrs + ai * HALF + wr * 64 + 4 * fr);
        if (fr == 0 || fr == 15) {
            const bool lo = fr == 0;
#pragma unroll
            for (int ai = 0; ai < 2; ++ai) { const int blk = (u.pm * BM + ai * HALF + wr * 64) >> 6;
#pragma unroll
                for (int s2 = 0; s2 < 2; ++s2) { const float r_ = lo ? rsv[ai][s2] : rsv[ai][2 + s2];
                    bf16_t* sp = side + ((size_t)blk * 4 + (lo ? s2 : 2 + s2)) * NUP + u.pn * 256 + wc * 32 + 8 * fq;
#pragma unroll
                    for (int bj = 0; bj < 2; ++bj) { const f32x4 l0 = acc[ai][bj][s2][0], h0 = acc[ai][bj][2 + s2][0], l1 = acc[ai][bj][s2][1], h1 = acc[ai][bj][2 + s2][1]; f32x4 a0, a1;
#pragma unroll
                        for (int e = 0; e < 4; ++e) { a0[e] = (lo ? l0[e] : h0[e]) * r_; a1[e] = (lo ? l1[e] : h1[e]) * r_; }
                        *(u32x4*)(sp + bj * HALF) = (u32x4){pk2(a0[0], a0[1]), pk2(a0[2], a0[3]), pk2(a1[0], a1[1]), pk2(a1[2], a1[3])}; } } }
        }
        __builtin_amdgcn_sched_barrier(0);
#pragma unroll
        for (int ai = 0; ai < 2; ++ai) {
            u32x2 keep[4];
#pragma unroll
            for (int n = 0; n < 2; ++n) {
                LAS const float* lw = lrs + 256 + wc * 32 + 8 * fq + 4 * n;
                f32x4 sg[4];
                { const f32x4 w0 = *(const LAS f32x4*)(lw), w1 = *(const LAS f32x4*)(lw + 128), w2 = *(const LAS f32x4*)(lw + 256), bb = *(const LAS f32x4*)(lw + 384);
                  const f32x4 x0 = acc[ai][0][0][n] * rsv[ai][0], x1 = acc[ai][0][1][n] * rsv[ai][1], x2 = acc[ai][0][2][n] * rsv[ai][2], x3 = acc[ai][0][3][n] * rsv[ai][3];
                  const f32x4 p1 = shr1(x3), p2 = shr1(x2);
                  const f32x4 c0 = bb + w0 * p2 + w1 * p1 + w2 * x0, c1 = bb + w0 * p1 + w1 * x0 + w2 * x1, c2 = bb + w0 * x0 + w1 * x1 + w2 * x2, c3 = bb + w0 * x1 + w1 * x2 + w2 * x3;
#pragma unroll
                  for (int e = 0; e < 4; ++e) { sg[0][e] = c0[e] * sigmoidf_(c0[e]); sg[1][e] = c1[e] * sigmoidf_(c1[e]); sg[2][e] = c2[e] * sigmoidf_(c2[e]); sg[3][e] = c3[e] * sigmoidf_(c3[e]); } }
                __builtin_amdgcn_sched_barrier(0);
                { const f32x4 w0 = *(const LAS f32x4*)(lw + 512), w1 = *(const LAS f32x4*)(lw + 640), w2 = *(const LAS f32x4*)(lw + 768), bb = *(const LAS f32x4*)(lw + 896);
                  const f32x4 x0 = acc[ai][1][0][n] * rsv[ai][0], x1 = acc[ai][1][1][n] * rsv[ai][1], x2 = acc[ai][1][2][n] * rsv[ai][2], x3 = acc[ai][1][3][n] * rsv[ai][3];
                  const f32x4 p1 = shr1(x3), p2 = shr1(x2);
                  f32x4 cv[4]; cv[0] = bb + w0 * p2 + w1 * p1 + w2 * x0; cv[1] = bb + w0 * p1 + w1 * x0 + w2 * x1; cv[2] = bb + w0 * x0 + w1 * x1 + w2 * x2; cv[3] = bb + w0 * x1 + w1 * x2 + w2 * x3;
#pragma unroll
                  for (int m = 0; m < 4; ++m) { const f32x4 act = sg[m] * cv[m];
                      u32x2 w; w.x = pk2(act[0], act[1]); w.y = pk2(act[2], act[3]);
                      if (n == 0) keep[m] = w;
                      else *(u32x4*)(ACT + ((size_t)(ch0 >> 6) * M + (size_t)(row0 + ai * HALF + m)) * 64 + (ch0 & 63)) = (u32x4){keep[m].x, keep[m].y, w.x, w.y}; } }
                __builtin_amdgcn_sched_barrier(0);
            }
        }
    }
};
#ifndef ER_DEPTH
#define ER_DEPTH 4
#endif
struct EpiResidBf16 {
    static constexpr bool BPERM2 = true;
    static constexpr bool PERM = true, AFTER_DRAIN = false;
    bf16_t* XB; float* Cout; float* ssq; int ldc;
    __device__ __forceinline__ void operator()(const f32x4 (&acc)[2][2][4][2], const Unit& u, int wr, int wc, int fr, int fq) const {
        const int row0 = u.pm * BM + wr * 64 + fr, col0 = u.pn * BM + wc * WCS + 8 * fq;
        u32x4 old[ER_DEPTH][2]; float ssv[8];
#define ER_ROWI(g) (row0 + ((g) >> 2) * HALF + ((g) & 3) * 16)
#define ER_LOAD(g) do { old[(g) % ER_DEPTH][0] = *(const u32x4*)(XB + akm(ER_ROWI(g), col0)); old[(g) % ER_DEPTH][1] = *(const u32x4*)(XB + akm(ER_ROWI(g), col0 + BJS)); } while (0)
#pragma unroll
        for (int g = 0; g < ER_DEPTH; ++g) ER_LOAD(g);
#pragma unroll
        for (int g = 0; g < 8; ++g) {
            asm volatile("" ::: "memory");
            const size_t ro = (size_t)ER_ROWI(g) * ldc + col0; float ss = 0.f;
#pragma unroll
            for (int bj = 0; bj < 2; ++bj) { const u32x4 o_ = old[g % ER_DEPTH][bj];
                f32x4 v0 = acc[g >> 2][bj][g & 3][0], v1 = acc[g >> 2][bj][g & 3][1];
                v0[0] += bflo(o_.x); v0[1] += bfhi(o_.x); v0[2] += bflo(o_.y); v0[3] += bfhi(o_.y); v1[0] += bflo(o_.z); v1[1] += bfhi(o_.z); v1[2] += bflo(o_.w); v1[3] += bfhi(o_.w);
                if (Cout) { *(f32x4*)(Cout + ro + bj * BJS) = v0; *(f32x4*)(Cout + ro + bj * BJS + 4) = v1; }
                else { u32x4 w; w.x = pk2(v0[0], v0[1]); w.y = pk2(v0[2], v0[3]); w.z = pk2(v1[0], v1[1]); w.w = pk2(v1[2], v1[3]); *(u32x4*)(XB + akm(ER_ROWI(g), col0 + bj * BJS)) = w;
                    const float r0 = bflo(w.x), r1 = bfhi(w.x), r2 = bflo(w.y), r3 = bfhi(w.y), r4 = bflo(w.z), r5 = bfhi(w.z), r6 = bflo(w.w), r7 = bfhi(w.w);
                    ss += ((r0 * r0 + r1 * r1) + (r2 * r2 + r3 * r3)) + ((r4 * r4 + r5 * r5) + (r6 * r6 + r7 * r7)); } }
            ssv[g] = ss;
            if (g + ER_DEPTH < 8) ER_LOAD(g + ER_DEPTH);
        }
        if (!Cout) {
#pragma unroll
            for (int g = 0; g < 8; ++g) ssv[g] += __shfl_xor(ssv[g], 16);
#pragma unroll
            for (int g = 0; g < 8; ++g) ssv[g] += __shfl_xor(ssv[g], 32);
            if (fq == 0) {
#pragma unroll
                for (int g = 0; g < 8; ++g) ssq[(size_t)ER_ROWI(g) * 32 + u.pn * 4 + wc] = ssv[g]; } }
#undef ER_ROWI
#undef ER_LOAD
    }
};
struct EpiGated {
    static constexpr bool PERM = true, AFTER_DRAIN = false, HOOK = true, BPERM2 = true; static constexpr int HOOK_KT = 16;
    const bf16_t* P; bf16_t* merged;
    static __device__ __forceinline__ float gl(unsigned w) { return fmaxf(bflo(w), 1e-30f); }
    static __device__ __forceinline__ float gh(unsigned w) { return fmaxf(bfhi(w), 1e-30f); }
    __device__ __forceinline__ void mid(f32x4 (&acc)[2][2][4][2], const Unit& u, int wr, int wc, int fr, int fq, int s) const {
        const unsigned grow0 = (unsigned)(u.pm * BM + (wr * 4 + wc) * 2 + (fq >> 1)), gcol0 = (unsigned)(u.pn * BM + ((fq & 1) * 16 + fr) * 8);
        const char* Pa = (const char*)(P + PGT + (s - 1) * DM); const char* Pb = (const char*)(P + PGT + s * DM);
#pragma unroll
        for (int hf = 0; hf < 2; ++hf) {
            u32x4 ga[4][2], gb[4][2];
#pragma unroll
            for (int gg = 0; gg < 4; ++gg) { const int g = hf * 4 + gg; const unsigned po = ((grow0 + (unsigned)(g * 32)) * (unsigned)NPC + gcol0) * 2u;
#pragma unroll
                for (int bj = 0; bj < 2; ++bj) { ga[gg][bj] = *(const u32x4*)(Pa + (size_t)(po + bj * (16u * NPC * 2u))); gb[gg][bj] = *(const u32x4*)(Pb + (size_t)(po + bj * (16u * NPC * 2u))); } }
#pragma unroll
            for (int gg = 0; gg < 4; ++gg) { const int g = hf * 4 + gg;
#pragma unroll
                for (int bj = 0; bj < 2; ++bj) { const u32x4 a_ = ga[gg][bj], b_ = gb[gg][bj];
                    f32x4& v0 = acc[g >> 2][bj][g & 3][0]; f32x4& v1 = acc[g >> 2][bj][g & 3][1];
                    v0[0] *= gl(a_.x) * fast_rcp(gl(b_.x)); v0[1] *= gh(a_.x) * fast_rcp(gh(b_.x)); v0[2] *= gl(a_.y) * fast_rcp(gl(b_.y)); v0[3] *= gh(a_.y) * fast_rcp(gh(b_.y));
                    v1[0] *= gl(a_.z) * fast_rcp(gl(b_.z)); v1[1] *= gh(a_.z) * fast_rcp(gh(b_.z)); v1[2] *= gl(a_.w) * fast_rcp(gl(b_.w)); v1[3] *= gh(a_.w) * fast_rcp(gh(b_.w)); } }
            asm volatile("" ::: "memory"); }
    }
    __device__ __forceinline__ void operator()(const f32x4 (&acc)[2][2][4][2], const Unit& u, int wr, int wc, int fr, int fq) const {
        const unsigned row0 = (unsigned)(u.pm * BM + wr * 64 + fr), col0 = (unsigned)(u.pn * BM + wc * WCS + 8 * fq);
        const char* Pg = (const char*)(P + PGT + 2 * DM); char* mg = (char*)merged;
        u32x4 gw[8][2];
        const unsigned grow0 = (unsigned)(u.pm * BM + (wr * 4 + wc) * 2 + (fq >> 1)), gcol0 = (unsigned)(u.pn * BM + ((fq & 1) * 16 + fr) * 8);
#pragma unroll
        for (int g = 0; g < 8; ++g) { const unsigned po = ((grow0 + (unsigned)(g * 32)) * (unsigned)NPC + gcol0) * 2u;
#pragma unroll
            for (int bj = 0; bj < 2; ++bj) gw[g][bj] = *(const u32x4*)(Pg + (size_t)(po + bj * (16u * NPC * 2u))); }
#pragma unroll
        for (int g = 0; g < 8; ++g) { const unsigned moff = ((row0 + (unsigned)((g >> 2) * HALF + (g & 3) * 16)) * (unsigned)DM + col0) * 2u;
#pragma unroll
            for (int bj = 0; bj < 2; ++bj) { const u32x4 w_ = gw[g][bj]; const f32x4 v0 = acc[g >> 2][bj][g & 3][0], v1 = acc[g >> 2][bj][g & 3][1];
                u32x4 w; w.x = pk2(v0[0] * gl(w_.x), v0[1] * gh(w_.x)); w.y = pk2(v0[2] * gl(w_.y), v0[3] * gh(w_.y)); w.z = pk2(v1[0] * gl(w_.z), v1[1] * gh(w_.z)); w.w = pk2(v1[2] * gl(w_.w), v1[3] * gh(w_.w));
                *(u32x4*)(merged + akm(row0 + (unsigned)((g >> 2) * HALF + (g & 3) * 16), (int)col0 + bj * BJS)) = w; } }
    }
};

template <class E, class = void> struct has_relax { static constexpr bool v = true; };
template <class E> struct has_relax<E, decltype((void)E::NO_RELAX)> { static constexpr bool v = false; };
template <class E, class = void> struct has_lrs { static constexpr bool v = false; };
template <class E> struct has_lrs<E, decltype((void)E::LDS_RS)> { static constexpr bool v = true; };
template <class E, class = void> struct has_aperm { static constexpr bool v = false; };
template <class E> struct has_aperm<E, decltype((void)E::APERM)> { static constexpr bool v = true; };
template <class E, class = void> struct has_bperm2 { static constexpr bool v = false; };
template <class E> struct has_bperm2<E, decltype((void)E::BPERM2)> { static constexpr bool v = true; };
template <class E, class = void> struct has_hook { static constexpr bool v = false; };
template <class E> struct has_hook<E, decltype((void)E::HOOK)> { static constexpr bool v = true; };
template <class Epi, class Sched, bool ALIGN_EPI = false, bool SP2 = false>
__device__ __forceinline__ void gemm_phase(LAS unsigned char* lds, const Gemm g, const Sched& S, const Epi& E, const int tid, unsigned long long* dg = nullptr) {
    float zf; asm volatile("v_mov_b32 %0, 0" : "=v"(zf));
    const int wid = __builtin_amdgcn_readfirstlane(tid >> 6), lane = tid & 63, wr = wid >> 2, wc = wid & 3, fr = lane & 15, fq = lane >> 4;
    const int K = g.K, nt = K / BK;
    unsigned voffA[2], voffB[2];
#pragma unroll
    for (int i = 0; i < 2; ++i) { int R, C; stage_rc(tid * 16 + i * 8192, R, C); const int Rb = has_bperm2<Epi>::v ? (2 * (R & ~31) + perm32(R & 31)) : (Epi::PERM ? ((R & ~31) + perm32(R & 31)) : R);
        const int Ra = has_aperm<Epi>::v ? ((R & ~63) + 4 * (R & 15) + ((R >> 4) & 3)) : R;
        voffA[i] = (unsigned)(Ra * (g.akm ? BK : K) + C) * 2u; voffB[i] = (unsigned)(Rb * (g.bkm ? BK : K) + C) * 2u; }
    const size_t kstep = (size_t)(BK * 2);
    const size_t hstep = (size_t)HALF * K * 2;
    const size_t tstep = 2 * hstep;
    const size_t kstepA = g.akm ? (size_t)g.M * BK * 2 : kstep, hstepA = g.akm ? (size_t)HALF * BK * 2 : hstep, tstepA = 2 * hstepA;
    const size_t kstepB = g.bkm ? (size_t)g.N * BK * 2 : kstep, hstepB = has_bperm2<Epi>::v ? (g.bkm ? (size_t)32 * BK * 2 : (size_t)32 * K * 2) : (g.bkm ? (size_t)HALF * BK * 2 : hstep), tstepB = g.bkm ? (size_t)BM * BK * 2 : tstep;
    const unsigned ldsw = (unsigned)wid * 1024u;
    const int aoff = lds_byte(wr * 64 + fr, fq * 8), boff = lds_byte(wc * 32 + fr, fq * 8);
#define PG8_SA(b, h) (((b) * 2 + (h)) * HTB)
#define PG8_SB(b, h) ((4 + (b) * 2 + (h)) * HTB)
#define PG8_STAGE(bufoff, gbase, voff) do { _Pragma("unroll") for (int _i = 0; _i < 2; ++_i) \
        __builtin_amdgcn_global_load_lds((const unsigned*)((const char*)(gbase) + (voff)[_i]), (LAS unsigned*)(lds + (bufoff) + ldsw + _i * 8192), 16, 0, 0); } while (0)
#define PG8_LDA(dst, b, h) do { _Pragma("unroll") for (int m = 0; m < 4; ++m) _Pragma("unroll") for (int k = 0; k < 2; ++k) dst[m][k] = *(const LAS bf16x8*)(lds + PG8_SA(b, h) + aoff + m * 2048 + k * 1024); } while (0)
#define PG8_LDB(dst, b, h) do { _Pragma("unroll") for (int n = 0; n < 2; ++n) _Pragma("unroll") for (int k = 0; k < 2; ++k) dst[n][k] = *(const LAS bf16x8*)(lds + PG8_SB(b, h) + boff + n * 2048 + k * 1024); } while (0)
#define PG8_MMA(ai, bj, At, Bt) do { __builtin_amdgcn_s_setprio(1); _Pragma("unroll") for (int m = 0; m < 4; ++m) _Pragma("unroll") for (int n = 0; n < 2; ++n) _Pragma("unroll") for (int k = 0; k < 2; ++k) \
        acc[ai][bj][m][n] = __builtin_amdgcn_mfma_f32_16x16x32_bf16(Bt[n][k], At[m][k], acc[ai][bj][m][n], 0, 0, 0); __builtin_amdgcn_s_setprio(0); } while (0)
#define PG8_WAIT_V(n) asm volatile("s_waitcnt vmcnt(" #n ")" ::: "memory")
#define PG8_WAIT_L(n) asm volatile("s_waitcnt lgkmcnt(" #n ")" ::: "memory")
#define PG8_BAR __builtin_amdgcn_s_barrier()
#define PG8_SCHED __builtin_amdgcn_sched_barrier(0)
    Unit cur, nxt; int ui = 0;
    if (!S.next(0, cur)) return;
    f32x4 acc[2][2][4][2];
#pragma unroll
    for (int a = 0; a < 2; ++a)
#pragma unroll
        for (int b = 0; b < 2; ++b)
#pragma unroll
            for (int m = 0; m < 4; ++m)
#pragma unroll
                for (int n = 0; n < 2; ++n) acc[a][b][m][n] = (f32x4){zf, zf, zf, zf};
    bf16x8 At[4][2], B0[2][2], B1[2][2];
    const char* cA = S.aptr(g, cur, tstepA); const char* cB = S.bptr(g, cur, tstepB);
    S.a_ready(cur);
    if constexpr (SP2) {
        PG8_STAGE(PG8_SB(0, 0), cB, voffB); PG8_STAGE(PG8_SB(0, 1), cB + hstepB, voffB); PG8_STAGE(PG8_SA(0, 0), cA, voffA); PG8_STAGE(PG8_SA(0, 1), cA + hstepA, voffA);
        if (wr == 1) PG8_BAR;
        PG8_WAIT_V(2); PG8_BAR;
        PG8_STAGE(PG8_SB(1, 0), cB + kstepB, voffB); PG8_STAGE(PG8_SA(1, 0), cA + kstepA, voffA); PG8_STAGE(PG8_SB(1, 1), cB + hstepB + kstepB, voffB);
        PG8_WAIT_V(6); PG8_BAR;
    } else {
        PG8_STAGE(PG8_SB(0, 0), cB, voffB); PG8_STAGE(PG8_SA(0, 0), cA, voffA); PG8_STAGE(PG8_SB(0, 1), cB + hstepB, voffB); PG8_STAGE(PG8_SA(0, 1), cA + hstepA, voffA);
        if (wr == 1) PG8_BAR;
        PG8_WAIT_V(4); PG8_BAR;
        PG8_STAGE(PG8_SB(1, 0), cB + kstepB, voffB); PG8_STAGE(PG8_SA(1, 0), cA + kstepA, voffA); PG8_STAGE(PG8_SB(1, 1), cB + hstepB + kstepB, voffB);
        PG8_WAIT_V(6); PG8_BAR;
    }
    for (;;) {
        const bool has_next = S.next(ui + 1, nxt);
        if (MK_DIAG && dg && tid == 0 && (ui == 2 || ui == 3)) dg[(ui - 2) * 2] = wall_clock64();
        const char* nA = has_next ? S.aptr(g, nxt, tstepA) : cA; const char* nB = has_next ? S.bptr(g, nxt, tstepB) : cB;
        constexpr bool RELAX_ = has_relax<Epi>::v;
#define PG8_ITER(FIRST) do { \
            const bool last = (t == nt - 2); \
            const char* a1 = cA + (size_t)(t + 1) * kstepA; \
            const char* a2 = last ? nA : cA + (size_t)(t + 2) * kstepA; const char* b2 = last ? nB : cB + (size_t)(t + 2) * kstepB; \
            const char* a3 = a2 + kstepA; const char* b3 = b2 + kstepB; \
            if (last && has_next) S.a_ready(nxt); \
            PG8_LDB(B0, 0, 0); PG8_LDB(B1, 0, 1); PG8_SCHED; PG8_LDA(At, 0, 0); if (!(FIRST)) PG8_STAGE(PG8_SA(1, 1), a1 + hstepA, voffA); \
            if constexpr (has_lrs<Epi>::v) { if (t == 4 && wid < Epi::PF_WAVES) E.prefetch(lds, cur, wid, lane); } \
            if (FIRST) PG8_WAIT_V(24); else PG8_WAIT_V(8); PG8_WAIT_L(0); PG8_BAR; PG8_MMA(0, 0, At, B0); PG8_MMA(0, 1, At, B1); PG8_BAR; PG8_SCHED; \
            PG8_LDA(At, 0, 1); PG8_STAGE(PG8_SB(0, 0), b2, voffB); PG8_STAGE(PG8_SB(0, 1), b2 + hstepB, voffB); PG8_STAGE(PG8_SA(0, 0), a2, voffA); \
            if (FIRST) PG8_WAIT_V(24); else PG8_WAIT_V(8); PG8_WAIT_L(0); PG8_BAR; PG8_MMA(1, 0, At, B0); PG8_MMA(1, 1, At, B1); PG8_BAR; PG8_SCHED; \
            PG8_LDB(B0, 1, 0); PG8_LDB(B1, 1, 1); PG8_SCHED; PG8_LDA(At, 1, 0); PG8_STAGE(PG8_SA(0, 1), a2 + hstepA, voffA); \
            if (FIRST) PG8_WAIT_V(24); else PG8_WAIT_V(8); PG8_WAIT_L(0); PG8_BAR; PG8_MMA(0, 0, At, B0); PG8_MMA(0, 1, At, B1); PG8_BAR; PG8_SCHED; \
            PG8_LDA(At, 1, 1); PG8_STAGE(PG8_SB(1, 0), b3, voffB); PG8_STAGE(PG8_SB(1, 1), b3 + hstepB, voffB); PG8_STAGE(PG8_SA(1, 0), a3, voffA); \
            PG8_WAIT_V(8); PG8_WAIT_L(0); PG8_BAR; PG8_MMA(1, 0, At, B0); PG8_MMA(1, 1, At, B1); PG8_BAR; PG8_SCHED; \
            if constexpr (has_hook<Epi>::v) { if (t + 2 < nt && (t + 2) % Epi::HOOK_KT == 0) { int fr_ = fr, fq_ = fq; asm volatile("" : "+v"(fr_), "+v"(fq_)); const_cast<Epi&>(E).mid(acc, cur, wr, wc, fr_, fq_, (t + 2) / Epi::HOOK_KT); PG8_SCHED; } } \
            if (RELAX_ && last && has_next) { PG8_STAGE(PG8_SA(1, 1), a3 + hstepA, voffA); PG8_SCHED; }     \
        } while (0)
        int t = 0;
        if constexpr (RELAX_) { if (ui > 0) { PG8_ITER(1); t = 2; } }
        for (; t < nt; t += 2) { PG8_ITER(0); }
#undef PG8_ITER
        if (MK_DIAG && dg && tid == 0 && ui == 2) dg[1] = wall_clock64();
        if constexpr (ALIGN_EPI) { if (wr == 0) PG8_BAR; }
        if constexpr (!Epi::AFTER_DRAIN) { int fr_ = fr, fq_ = fq; asm volatile("" : "+v"(fr_), "+v"(fq_));
            E(acc, cur, wr, wc, fr_, fq_); S.done(cur); }
        if (!has_next) break;
#pragma unroll
        for (int a = 0; a < 2; ++a)
#pragma unroll
            for (int b = 0; b < 2; ++b)
#pragma unroll
                for (int m = 0; m < 4; ++m)
#pragma unroll
                    for (int n = 0; n < 2; ++n) acc[a][b][m][n] = (f32x4){zf, zf, zf, zf};
        cur = nxt; cA = nA; cB = nB; ++ui;
        if constexpr (ALIGN_EPI) { if (wr == 1) PG8_BAR; }
    }
    PG8_WAIT_V(0);
    if constexpr (!ALIGN_EPI) { if (wr == 0) PG8_BAR; }
    PG8_BAR;
#undef PG8_SA
#undef PG8_SB
#undef PG8_STAGE
#undef PG8_LDA
#undef PG8_LDB
#undef PG8_MMA
#undef PG8_WAIT_V
#undef PG8_WAIT_L
#undef PG8_BAR
#undef PG8_SCHED
}
}
#define PG8_SP2 true
#define PG8_ALIGN true


struct Frame {
    LAS unsigned char* lds; volatile LAS unsigned* MISC;
    unsigned* ctl; unsigned char* ws;
    int tid, lane, wave, G, bid;
};

__device__ __forceinline__ int up_src_col(int n) { const int pn = n >> 8, c = n & 255; return c < 128 ? 128 * pn + c : DFF + 128 * pn + (c - 128); }
__device__ __forceinline__ int inproj_src_col(int n) { return n < 2560 ? n : (n < 15872 ? n + 24 : (n < 15896 ? n - 15872 + 2560 : -1)); }
__device__ __forceinline__ void transpose_item(const float* W, int K, int Nsrc, bf16_t* WT, const float* gain, int mode, LAS float* scr, int item, int nblk, int lane, int ntot, int kbase = 0) {
    const int kb = item / nblk, nb = item - kb * nblk, k0 = 64 * kb, n0 = 32 * nb;
    const int nn = n0 + (lane & 7) * 4; const int sc = mode == 1 ? inproj_src_col(nn) : (mode == 2 ? up_src_col(nn) : nn);
    f32x4 v[8];
#pragma unroll
    for (int i = 0; i < 8; ++i) { const int kk = 8 * i + (lane >> 3); v[i] = sc >= 0 ? __builtin_nontemporal_load((const f32x4*)(W + (size_t)(k0 + kk) * Nsrc + sc)) : (f32x4){0.f, 0.f, 0.f, 0.f}; }
#pragma unroll
    for (int i = 0; i < 8; ++i) { const int kk = 8 * i + (lane >> 3); const float gk = gain ? gain[k0 + kk] : 1.f; LAS float* d = scr + kk * 33 + (lane & 7) * 4;
        d[0] = v[i].x * gk; d[1] = v[i].y * gk; d[2] = v[i].z * gk; d[3] = v[i].w * gk; }
    LDS_WAIT(); asm volatile("" ::: "memory");
    const int c = lane & 7;
#pragma unroll
    for (int j = 0; j < 4; ++j) { const int n = (lane >> 3) + 8 * j; const LAS float* sp = scr + (8 * c) * 33 + n;
        u32x4 o; o.x = pk2(sp[0 * 33], sp[1 * 33]); o.y = pk2(sp[2 * 33], sp[3 * 33]); o.z = pk2(sp[4 * 33], sp[5 * 33]); o.w = pk2(sp[6 * 33], sp[7 * 33]);
        if (ntot) *(u32x4*)(WT + ((size_t)((kbase + k0) >> 6) * ntot + (size_t)(n0 + n)) * 64 + 8 * c) = o;
        else *(u32x4*)(WT + (size_t)(n0 + n) * K + k0 + 8 * c) = o; }
    LDS_WAIT(); asm volatile("" ::: "memory");
}
__device__ __forceinline__ void rms_row0(const float* xin, bf16_t* XB, int m, float* rstd, int lane) {
    const f32x4* xr = (const f32x4*)xin + lane;
    f32x4 v[8]; float s = 0.f;
#pragma unroll
    for (int j = 0; j < 8; ++j) { v[j] = xr[64 * j]; s += (v[j].x * v[j].x + v[j].y * v[j].y) + (v[j].z * v[j].z + v[j].w * v[j].w); }
    s = wave_sum(s);
    if (lane == 0) *rstd = rsqrtf(s * (1.f / DM) + EPS);
#pragma unroll
    for (int j = 0; j < 8; ++j) { u32x2 w; w.x = pk2(v[j].x, v[j].y); w.y = pk2(v[j].z, v[j].w); *(u32x2*)(XB + akm((size_t)m, 4 * (lane + 64 * j))) = w; }
}
__device__ __forceinline__ void rstd_rows(Frame& F) {
    const float* ssq = (const float*)(F.ws + WS_SSQ); float* rstd = (float*)(F.ws + WS_RSTD);
    for (int row = F.bid * 512 + F.tid; row < M; row += F.G * 512) { const f32x4* p = (const f32x4*)(ssq + (size_t)row * 32); float s = 0.f;
#pragma unroll
        for (int j = 0; j < 8; ++j) { const f32x4 v = p[j]; s += (v.x + v.y) + (v.z + v.w); }
        rstd[row] = rsqrtf(s * (1.f / DM) + EPS); }
}

__device__ __forceinline__ void cvec_item(Frame& F, KArgs a, int layer, int j);
__device__ __forceinline__ void phase_A(Frame& F, KArgs a, int layer) {
    LAS float* scr = (LAS float*)(F.lds + F.wave * 16384);
    const int gw = F.bid * 8 + F.wave, NGW = F.G * 8;
    bf16_t* Wt_in = (bf16_t*)(F.ws + WS_WIN); bf16_t* Wt_br = (bf16_t*)(F.ws + WS_WBR); bf16_t* Wt_out = (bf16_t*)(F.ws + WS_WOUT);
    bf16_t* Wt_up = (bf16_t*)(F.ws + WS_WUP); bf16_t* Wt_dn = (bf16_t*)(F.ws + WS_WDN);
    const float* w_in = a->in[I_WIN] + (size_t)layer * DM * INC; const float* g_att = a->in[I_NATT] + layer * DM;
    const float* w_br = a->in[I_WBR] + (size_t)layer * 3 * BW * DM; const float* w_out = a->in[I_WOUT] + (size_t)layer * DM * DM;
    const float* w_up = a->in[I_WUP] + (size_t)layer * DM * NUP; const float* g_ffn = a->in[I_NFFN] + layer * DM;
    const float* w_dn = a->in[I_WDN] + (size_t)layer * DFF * DM;
    constexpr int I_IN = (DM / 64) * (NPC / 32), I_BR1 = (BW / 64) * (DM / 32), I_OUT = (DM / 64) * (DM / 32), I_UP = (DM / 64) * (NUP / 32), I_DN = (DFF / 64) * (DM / 32);
    constexpr int I_C1 = (4096 / 64) * (HD / 32);
    constexpr int NITEMS = I_IN + 3 * I_BR1 + I_OUT + I_UP + I_DN + 2 * I_C1;
    for (int it = gw; it < NITEMS; it += NGW) {
        int r = it;
        if (r < I_IN) { transpose_item(w_in, DM, INC, Wt_in, g_att, 1, scr, r, NPC / 32, F.lane, NPC); continue; } r -= I_IN;
        if (r < 3 * I_BR1) { const int n = r / I_BR1; r -= n * I_BR1; transpose_item(w_br + (size_t)n * BW * DM, BW, DM, Wt_br, nullptr, 0, scr, r, DM / 32, F.lane, DM, n * BW); continue; } r -= 3 * I_BR1;
        if (r < I_OUT) { transpose_item(w_out, DM, DM, Wt_out, nullptr, 0, scr, r, DM / 32, F.lane, DM); continue; } r -= I_OUT;
        if (r < I_UP) { transpose_item(w_up, DM, NUP, Wt_up, g_ffn, 2, scr, r, NUP / 32, F.lane, NUP); continue; } r -= I_UP;
        if (r < I_DN) { transpose_item(w_dn, DFF, DM, Wt_dn, nullptr, 0, scr, r, DM / 32, F.lane, DM); continue; } r -= I_DN;
        { const int j = r / I_C1; r -= j * I_C1; transpose_item(a->in[I_CW1] + (size_t)(layer * 2 + j) * 4096 * HD, 4096, HD, (bf16_t*)(F.ws + WS_MISC + MISC_WC1) + (size_t)j * HD * 4096, nullptr, 0, scr, r, HD / 32, F.lane, 0); }
    }
    if (F.bid < 64) cvec_item(F, a, layer, F.bid);
    if (layer == 0) { bf16_t* XB = (bf16_t*)(F.ws + WS_XB); float* rstd = (float*)(F.ws + WS_RSTD);
        for (int m = gw; m < M; m += NGW) rms_row0(a->in[I_X] + (size_t)m * DM, XB, m, rstd + m, F.lane); }
    else rstd_rows(F);
}
__device__ __forceinline__ void phase_F(Frame& F, KArgs a) { rstd_rows(F); }
__device__ __forceinline__ void phase_H(Frame& F, KArgs a, int layer) {
    const bf16_t* SD = (const bf16_t*)(F.ws + WS_USIDE); bf16_t* ACT = (bf16_t*)(F.ws + WS_ACT);
    const float* cw = a->in[I_CONVW] + (size_t)layer * 3 * NUP; const float* cb = a->in[I_CONVB] + (size_t)layer * NUP;
    constexpr int CG = DFF / 8, NTASK = (M / 64) * 2 * CG;
    for (int task = F.bid * 512 + F.tid; task < NTASK; task += F.G * 512) {
        const int cg = task % CG, rb = task / CG, rw = rb & 1, blk = rb >> 1; if ((blk & 31) == 0) continue;
        const int c0 = cg * 8, uc = 256 * (c0 >> 7) + (c0 & 127);
        const bf16_t* t2 = rw == 0 ? SD + ((size_t)(blk - 1) * 4 + 2) * NUP : SD + ((size_t)(blk - 1) * 4 + 3) * NUP;
        const bf16_t* t1 = rw == 0 ? SD + ((size_t)(blk - 1) * 4 + 3) * NUP : SD + ((size_t)blk * 4 + 0) * NUP;
        const bf16_t* t0 = SD + ((size_t)blk * 4 + rw) * NUP;
        const u32x4 g2 = *(const u32x4*)(t2 + uc), g1 = *(const u32x4*)(t1 + uc), g0 = *(const u32x4*)(t0 + uc), v2 = *(const u32x4*)(t2 + uc + 128), v1 = *(const u32x4*)(t1 + uc + 128), v0 = *(const u32x4*)(t0 + uc + 128);
        const unsigned G2[4] = {g2.x, g2.y, g2.z, g2.w}, G1[4] = {g1.x, g1.y, g1.z, g1.w}, G0[4] = {g0.x, g0.y, g0.z, g0.w}, V2[4] = {v2.x, v2.y, v2.z, v2.w}, V1[4] = {v1.x, v1.y, v1.z, v1.w}, V0[4] = {v0.x, v0.y, v0.z, v0.w};
        float o[8];
#pragma unroll
        for (int e = 0; e < 8; ++e) { const int q = e >> 1; const bool hi = e & 1;
            const float xg2 = hi ? bfhi(G2[q]) : bflo(G2[q]), xg1 = hi ? bfhi(G1[q]) : bflo(G1[q]), xg0 = hi ? bfhi(G0[q]) : bflo(G0[q]);
            const float xv2 = hi ? bfhi(V2[q]) : bflo(V2[q]), xv1 = hi ? bfhi(V1[q]) : bflo(V1[q]), xv0 = hi ? bfhi(V0[q]) : bflo(V0[q]);
            const float cgv = cb[c0 + e] + cw[c0 + e] * xg2 + cw[NUP + c0 + e] * xg1 + cw[2 * NUP + c0 + e] * xg0;
            const float cvv = cb[DFF + c0 + e] + cw[DFF + c0 + e] * xv2 + cw[NUP + DFF + c0 + e] * xv1 + cw[2 * NUP + DFF + c0 + e] * xv0;
            o[e] = cgv * sigmoidf_(cgv) * cvv; }
        *(u32x4*)(ACT + ((size_t)(c0 >> 6) * M + (size_t)(blk * 64 + rw)) * 64 + (c0 & 63)) = (u32x4){pk2(o[0], o[1]), pk2(o[2], o[3]), pk2(o[4], o[5]), pk2(o[6], o[7])};
    }
}

__device__ __forceinline__ int q_next(Frame& F, unsigned* head) {
    __syncthreads();
    if (F.tid == 0) F.MISC[16] = __hip_atomic_fetch_add(head, 1u, __ATOMIC_RELAXED, __HIP_MEMORY_SCOPE_AGENT);
    __syncthreads();
    return __builtin_amdgcn_readfirstlane((int)F.MISC[16]);
}
__device__ __forceinline__ int t5_bucket(int n) {
    if (n < 16) return n;
    int b = 16;
    b += (n >= 19); b += (n >= 21); b += (n >= 24); b += (n >= 27); b += (n >= 31); b += (n >= 35); b += (n >= 40); b += (n >= 46);
    b += (n >= 52); b += (n >= 59); b += (n >= 67); b += (n >= 77); b += (n >= 87); b += (n >= 99); b += (n >= 113);
    return b;
}
__device__ __forceinline__ int crow(int i, int h) { return (i & 3) + 8 * (i >> 2) + 4 * h; }

#define MFMA32(a, b, c) __builtin_amdgcn_mfma_f32_32x32x16_bf16((a), (b), (c), 0, 0, 0)
__device__ __forceinline__ float sum8lanes(float v) { v += __shfl_xor(v, 1); v += __shfl_xor(v, 2); v += __shfl_xor(v, 4); return v; }
__device__ __forceinline__ void norm16(unsigned* pp, const float* gn, float sc) {
    const u32x4 w0 = *(const u32x4*)pp, w1 = *(const u32x4*)(pp + 4); const unsigned w[8] = {w0.x, w0.y, w0.z, w0.w, w1.x, w1.y, w1.z, w1.w};
    float x[16], ss = 0.f;
#pragma unroll
    for (int q = 0; q < 8; ++q) { x[2 * q] = bflo(w[q]); x[2 * q + 1] = bfhi(w[q]); ss += x[2 * q] * x[2 * q] + x[2 * q + 1] * x[2 * q + 1]; }
    const float r = rsqrtf(sum8lanes(ss) * (1.f / HD) + EPS) * sc;
    u32x4 o0, o1;
    o0.x = pk2(x[0] * r * gn[0], x[1] * r * gn[1]); o0.y = pk2(x[2] * r * gn[2], x[3] * r * gn[3]); o0.z = pk2(x[4] * r * gn[4], x[5] * r * gn[5]); o0.w = pk2(x[6] * r * gn[6], x[7] * r * gn[7]);
    o1.x = pk2(x[8] * r * gn[8], x[9] * r * gn[9]); o1.y = pk2(x[10] * r * gn[10], x[11] * r * gn[11]); o1.z = pk2(x[12] * r * gn[12], x[13] * r * gn[13]); o1.w = pk2(x[14] * r * gn[14], x[15] * r * gn[15]);
    *(u32x4*)pp = o0; *(u32x4*)(pp + 4) = o1;
}
__device__ __forceinline__ void item_norm(Frame& F, KArgs a, int layer, int it) {
    bf16_t* P = (bf16_t*)(F.ws + WS_P);
    const float* qg = a->in[I_QG] + layer * HD; const float* kg = a->in[I_KG] + layer * 3 * HD;
    const int lane = F.lane, e0 = (lane & 7) * 16;
    float gq[16], gk[16];
#pragma unroll
    for (int e = 0; e < 16; ++e) { gq[e] = qg[e0 + e]; gk[e] = kg[((lane >> 4) & 1 ? 2 : 1) * HD + e0 + e]; }
    for (int rr = 0; rr < 8; ++rr) {
        bf16_t* pr = P + (size_t)(it * 64 + F.wave * 8 + rr) * NPC;
        norm16((unsigned*)(pr + PQN + lane * 16), gq, QSCALE);
        if (lane < 32) norm16((unsigned*)(pr + (lane < 16 ? PKS + lane * 16 : PKW + (lane - 16) * 16)), gk, 1.f);
    }
}
__device__ __forceinline__ void item_hgfin(Frame& F, KArgs a, int layer, int it) {
    const bf16_t* P = (const bf16_t*)(F.ws + WS_P); const float* OR = (const float*)(F.ws + WS_ORAW); bf16_t* OH = (bf16_t*)(F.ws + WS_OBR) + 2 * BW;
    const float* ng = a->in[I_HNG] + layer * HD; const int lane = F.lane, e0 = (lane & 7) * 16;
    float gn[16];
#pragma unroll
    for (int e = 0; e < 16; ++e) gn[e] = ng[e0 + e];
    for (int rr = 0; rr < 8; ++rr) { const size_t row = (size_t)(it * 64 + F.wave * 8 + rr);
        const f32x4* op = (const f32x4*)(OR + row * BW + lane * 16); const f32x4 o0 = op[0], o1 = op[1], o2 = op[2], o3 = op[3];
        const unsigned* gp = (const unsigned*)(P + row * NPC + PGH + lane * 16); const u32x4 g0 = *(const u32x4*)gp, g1 = *(const u32x4*)(gp + 4);
        const float x[16] = {o0.x, o0.y, o0.z, o0.w, o1.x, o1.y, o1.z, o1.w, o2.x, o2.y, o2.z, o2.w, o3.x, o3.y, o3.z, o3.w}; const unsigned gw[8] = {g0.x, g0.y, g0.z, g0.w, g1.x, g1.y, g1.z, g1.w};
        float ss = 0.f;
#pragma unroll
        for (int e = 0; e < 16; ++e) ss += x[e] * x[e];
        const float r = rsqrtf(sum8lanes(ss) * (1.f / HD) + EPS);
        unsigned ow[8];
#pragma unroll
        for (int q = 0; q < 8; ++q) ow[q] = pk2(x[2 * q] * r * gn[2 * q] * sigmoidf_(bflo(gw[q])), x[2 * q + 1] * r * gn[2 * q + 1] * sigmoidf_(bfhi(gw[q])));
        unsigned* dst = (unsigned*)(OH + row * (3 * BW) + lane * 16);
        *(u32x4*)dst = (u32x4){ow[0], ow[1], ow[2], ow[3]}; *(u32x4*)(dst + 4) = (u32x4){ow[4], ow[5], ow[6], ow[7]};
    }
}
__device__ __forceinline__ void cvec_item(Frame& F, KArgs a, int layer, int blk) {
    const int j = blk >> 5, ks = blk & 31;
    const float* pos = a->in[I_CPOS] + (size_t)(layer * 2 + j) * 32 * HD; const float* w1 = a->in[I_CW1] + (size_t)(layer * 2 + j) * 32 * HD * HD;
    LAS float* red = (LAS float*)F.lds; const int e = F.tid & 127, sub = F.tid >> 7;
    float acc = 0.f;
#pragma unroll 8
    for (int k = ks * 128 + sub * 32; k < ks * 128 + sub * 32 + 32; ++k) acc += pos[k] * w1[(size_t)k * HD + e];
    __syncthreads(); red[sub * 128 + e] = acc; __syncthreads();
    if (F.tid < 128) ((float*)(F.ctl + CW_CVEC))[(j * 32 + ks) * 128 + F.tid] = (red[F.tid] + red[128 + F.tid]) + (red[256 + F.tid] + red[384 + F.tid]);
    __syncthreads();
}
__device__ __forceinline__ void item_compress(Frame& F, KArgs a, int layer, int id) {
    const int j = id >> 7, rem = id & 127, b = rem >> 3, g = (rem >> 2) & 1, n0 = (rem & 3) * 32;
    const bf16_t* P = (const bf16_t*)(F.ws + WS_P);
    LAS float* red = (LAS float*)F.lds;
    LAS float* hid = (LAS float*)(F.lds + 16384);
    LAS float* outv = (LAS float*)(F.lds + 16384 + 32 * 132 * 4);
    const int tid = F.tid, lane = F.lane, wave = F.wave, r = lane & 31, h = lane >> 5, ct = wave & 3, kh = wave >> 2;
    f32x16 acc;
#pragma unroll
    for (int i = 0; i < 16; ++i) acc[i] = 0.f;
    {
        int trow = 16 * (n0 + r) + 16 * kh; const int tmax = T - 1;
        const bf16_t* Ab = P + (size_t)(b * T) * NPC + (j ? PVC : PKC) + g * HD + 8 * h;
        const bf16_t* Bb = (const bf16_t*)(F.ws + WS_MISC + MISC_WC1) + (size_t)(j * HD + 32 * ct + r) * 4096 + (size_t)(16 * kh) * HD + 8 * h;
        for (int l = 0; l < 16; ++l) { const int t = (trow + l) < tmax ? (trow + l) : tmax; const bf16_t* ap = Ab + (size_t)t * NPC; const bf16_t* bp = Bb + l * HD;
#pragma unroll
            for (int ds = 0; ds < 8; ++ds) { const bf16x8 av = *(const bf16x8*)(ap + 16 * ds), bv = *(const bf16x8*)(bp + 16 * ds); acc = MFMA32(av, bv, acc); } }
    }
    if (kh == 1) {
#pragma unroll
        for (int i = 0; i < 16; ++i) red[(ct * 16 + i) * 64 + lane] = acc[i]; }
    __syncthreads();
    if (kh == 0) { float cv = 0.f; { const float* cp = (const float*)(F.ctl + CW_CVEC) + (size_t)(j * 32) * 128 + 32 * ct + r;
#pragma unroll 8
        for (int q = 0; q < 32; ++q) cv += cp[q * 128]; }
#pragma unroll
        for (int i = 0; i < 16; ++i) { const float x = acc[i] + red[(ct * 16 + i) * 64 + lane] + cv;
            const float y = 0.7978845608028654f * (x + 0.044715f * x * x * x);
            const float th = 1.f - 2.f * fast_rcp(1.f + fast_exp2(2.f * y * LOG2E));
            hid[crow(i, h) * 132 + 32 * ct + r] = 0.5f * x * (1.f + th); } }
    __syncthreads();
    { const int e2 = tid & 127, ng = __builtin_amdgcn_readfirstlane(tid >> 7); const float* w2 = a->in[I_CW2] + (size_t)(layer * 2 + j) * HD * HD + e2;
      float o[8];
#pragma unroll
      for (int q = 0; q < 8; ++q) o[q] = 0.f;
      for (int k = 0; k < 128; k += 4) { const float w0 = w2[(size_t)k * HD], w1 = w2[(size_t)(k + 1) * HD], w2_ = w2[(size_t)(k + 2) * HD], w3 = w2[(size_t)(k + 3) * HD];
#pragma unroll
          for (int q = 0; q < 8; ++q) { const f32x4 hv = *(const LAS f32x4*)(hid + (8 * ng + q) * 132 + k); o[q] += (hv.x * w0 + hv.y * w1) + (hv.z * w2_ + hv.w * w3); } }
#pragma unroll
      for (int q = 0; q < 8; ++q) outv[(8 * ng + q) * 132 + e2] = o[q]; }
    __syncthreads();
    const float* kg0 = a->in[I_KG] + layer * 3 * HD;
#pragma unroll
    for (int q = 0; q < 4; ++q) { const int n = 4 * wave + q; float v0 = outv[n * 132 + 2 * lane], v1 = outv[n * 132 + 2 * lane + 1];
        if (j == 0) { const float ss = wave_sum(v0 * v0 + v1 * v1); const float rr = rsqrtf(ss * (1.f / HD) + EPS); v0 *= rr * kg0[2 * lane]; v1 *= rr * kg0[2 * lane + 1]; }
        if (n0 + n >= 127) { v0 = 0.f; v1 = 0.f; }
        bf16_t* dst = (bf16_t*)(F.ws + WS_MISC + (j ? MISC_VCMP : MISC_KCMP)) + (size_t)((b * 2 + g) * 128 + n0 + n) * HD;
        *((unsigned*)dst + lane) = pk2(v0, v1); }
}
__device__ __forceinline__ float xhalf_sum(float v);
constexpr int HG_Q1 = 0, HG_K1 = 17408, HG_QI = 34816, HG_K2 = 43520, HG_K3T = 52224, HG_VT = 70656, HG_AT = 89088, HG_SB = 98304, HG_TOT = 133120, HG_LB = 135168, HG_SS = 135680;
__device__ __forceinline__ void item_hgrn(Frame& F, KArgs a, int layer, int id) {
    const int b = id >> 3, hh = id & 7;
    const bf16_t* P = (const bf16_t*)(F.ws + WS_P); bf16_t* OH = (bf16_t*)(F.ws + WS_OBR);
    LAS unsigned char* L = F.lds;
    LAS float* tot = (LAS float*)(L + HG_TOT); LAS float* lbs = (LAS float*)(L + HG_LB); LAS float* ssp = (LAS float*)(L + HG_SS);
    const int tid = F.tid, lane = F.lane, wave = F.wave, r = lane & 31, h = lane >> 5;
    if (tid < 128) { const float* hb = a->in[I_HLB] + hh * HD + tid; const float x0 = hb[0], x1 = hb[1024], x2 = hb[2048], x3 = hb[3072];
        const float mx = fmaxf(fmaxf(x0, x1), fmaxf(x2, x3)); const float e0 = __expf(x0 - mx), e1 = __expf(x1 - mx), e2 = __expf(x2 - mx), e3 = __expf(x3 - mx);
        const float inv = 1.f / (e0 + e1 + e2 + e3); float c = 0.f; if (layer >= 1) c += e1; if (layer >= 2) c += e2; if (layer >= 3) c += e3;
        lbs[tid] = fmaxf(c * inv, 0.f); }
    { unsigned zu; asm volatile("v_mov_b32 %0, 0" : "=v"(zu));
      for (int i = tid; i < 34816 / 16; i += 512) *(LAS u32x4*)(L + HG_SB + i * 16) = (u32x4){zu, zu, zu, zu}; }
    f32x16 Sacc[2];
#pragma unroll
    for (int q = 0; q < 2; ++q)
#pragma unroll
        for (int i = 0; i < 16; ++i) Sacc[q][i] = 0.f;
    const int pd = tid & 127, psc = __builtin_amdgcn_readfirstlane(tid >> 7);
    const int srow = tid >> 4, sch = tid & 15;
    const bf16_t* gq = P + (size_t)(b * T + srow) * NPC + PQH + hh * HD + sch * 8; const bf16_t* gf = P + (size_t)(b * T + srow) * NPC + PFH + hh * HD + sch * 8;
    const bf16_t* gv = P + (size_t)(b * T + srow) * NPC + PIH + hh * HD + sch * 8;
    u32x4 rq0 = *(const u32x4*)gq, rq1 = *(const u32x4*)(gq + (size_t)32 * NPC), rf0 = *(const u32x4*)gf, rf1 = *(const u32x4*)(gf + (size_t)32 * NPC), rv0 = *(const u32x4*)gv, rv1 = *(const u32x4*)(gv + (size_t)32 * NPC);
    const int et = wave & 3, tt2 = wave >> 2;
    f32x4 gn4[4]; { const float* ng = a->in[I_HNG] + layer * HD;
#pragma unroll
      for (int g4 = 0; g4 < 4; ++g4) gn4[g4] = *(const f32x4*)(ng + 32 * et + 8 * g4 + 4 * h); }
    u32x2 gw4[4];
    for (int c = 0; c < T / 64; ++c) {
        __syncthreads();
        *(LAS u32x4*)(L + HG_Q1 + srow * 272 + sch * 16) = rq0; *(LAS u32x4*)(L + HG_Q1 + (srow + 32) * 272 + sch * 16) = rq1;
        *(LAS u32x4*)(L + HG_K1 + srow * 272 + sch * 16) = rf0; *(LAS u32x4*)(L + HG_K1 + (srow + 32) * 272 + sch * 16) = rf1;
        { const unsigned v0[4] = {rv0.x, rv0.y, rv0.z, rv0.w}, v1[4] = {rv1.x, rv1.y, rv1.z, rv1.w};
#pragma unroll
          for (int q = 0; q < 4; ++q) { LAS unsigned short* p0 = (LAS unsigned short*)(L + HG_VT + (8 * sch + 2 * q) * 144 + srow * 2); LAS unsigned short* p1 = (LAS unsigned short*)(L + HG_VT + (8 * sch + 2 * q + 1) * 144 + srow * 2);
              p0[0] = (unsigned short)(v0[q] & 0xffffu); p1[0] = (unsigned short)(v0[q] >> 16); p0[32] = (unsigned short)(v1[q] & 0xffffu); p1[32] = (unsigned short)(v1[q] >> 16); } }
        __syncthreads();
        { const bf16_t* gp = P + (size_t)(b * T + 64 * c + 32 * tt2 + r) * NPC + PGH + hh * HD + 32 * et + 4 * h;
#pragma unroll
          for (int g4 = 0; g4 < 4; ++g4) gw4[g4] = *(const u32x2*)(gp + 8 * g4); }
        if (c + 1 < T / 64) { const size_t adv = (size_t)(64 * (c + 1)) * NPC;
            rq0 = *(const u32x4*)(gq + adv); rq1 = *(const u32x4*)(gq + adv + (size_t)32 * NPC); rf0 = *(const u32x4*)(gf + adv); rf1 = *(const u32x4*)(gf + adv + (size_t)32 * NPC);
            rv0 = *(const u32x4*)(gv + adv); rv1 = *(const u32x4*)(gv + adv + (size_t)32 * NPC); }
        float qv[16], kv[16], bl[16];
        { const float lb = lbs[pd]; float run = 0.f;
#pragma unroll
          for (int tt = 0; tt < 16; ++tt) { const int t = 16 * psc + tt;
              qv[tt] = bf2f(*(const LAS unsigned short*)(L + HG_Q1 + t * 272 + pd * 2)); const float fp = bf2f(*(const LAS unsigned short*)(L + HG_K1 + t * 272 + pd * 2));
              const float ex = fast_exp2(-fabsf(fp) * LOG2E);
              const float sg = (fp >= 0.f ? 1.f : ex) * fast_rcp(1.f + ex);
              const float f = lb + (1.f - lb) * sg; kv[tt] = 1.f - f;
              const float lf = (layer == 0) ? (fminf(fp, 0.f) - LN2 * fast_log2(1.f + ex)) : LN2 * fast_log2(f);
              run += lf; bl[tt] = run; }
          tot[psc * 128 + pd] = run; }
        __syncthreads();
        { const float t0 = tot[pd], t1 = tot[128 + pd], t2 = tot[256 + pd], t3 = tot[384 + pd];
          const float b31 = t0 + t1, b63 = (t0 + t1) + (t2 + t3);
          const float pre = psc == 0 ? 0.f : (psc == 1 ? t0 : (psc == 2 ? b31 : b31 + t2));
          const float rref = psc >= 2 ? b31 : 0.f; const float eb31 = fast_exp2(b31 * LOG2E), c3 = fast_exp2((b63 - rref) * LOG2E);
          unsigned k3w[8];
#pragma unroll
          for (int tt = 0; tt < 16; ++tt) { const int t = 16 * psc + tt; const float bb = pre + bl[tt];
              const float e1 = fast_exp2((bb - rref) * LOG2E); const float q1 = qv[tt] * e1;
              const float k1 = kv[tt] * fast_exp2(fminf(rref - bb, 80.f) * LOG2E);
              const float k3 = k1 * c3;
              *(LAS unsigned short*)(L + HG_Q1 + t * 272 + pd * 2) = (unsigned short)(pk2(q1, 0.f) & 0xffffu);
              *(LAS unsigned short*)(L + HG_K1 + t * 272 + pd * 2) = (unsigned short)(pk2(k1, 0.f) & 0xffffu);
              if (psc >= 2) *(LAS unsigned short*)(L + HG_QI + (t - 32) * 272 + pd * 2) = (unsigned short)(pk2(q1 * eb31, 0.f) & 0xffffu);
              else *(LAS unsigned short*)(L + HG_K2 + t * 272 + pd * 2) = (unsigned short)(pk2(k1 * eb31, 0.f) & 0xffffu);
              if (tt & 1) k3w[tt >> 1] = (k3w[tt >> 1] & 0xffffu) | (pk2(0.f, k3) & 0xffff0000u); else k3w[tt >> 1] = pk2(k3, 0.f) & 0xffffu; }
          *(LAS u32x4*)(L + HG_K3T + pd * 144 + psc * 32) = (u32x4){k3w[0], k3w[1], k3w[2], k3w[3]}; *(LAS u32x4*)(L + HG_K3T + pd * 144 + psc * 32 + 16) = (u32x4){k3w[4], k3w[5], k3w[6], k3w[7]}; }
        __syncthreads();
        if (wave < 3) {
            const int st = wave == 1 ? 1 : 0, ta = wave == 0 ? 0 : 1;
            const LAS unsigned char* Kb = L + (wave == 2 ? HG_K2 : HG_K1 + st * 32 * 272) + r * 272 + 16 * h; const LAS unsigned char* Qb = L + HG_Q1 + (32 * ta + r) * 272 + 16 * h;
            f32x16 at;
#pragma unroll
            for (int i = 0; i < 16; ++i) at[i] = 0.f;
#pragma unroll
            for (int s8 = 0; s8 < 8; ++s8) at = MFMA32(*(const LAS bf16x8*)(Kb + 32 * s8), *(const LAS bf16x8*)(Qb + 32 * s8), at);
            if (wave < 2) {
#pragma unroll
                for (int i = 0; i < 16; ++i) at[i] = (crow(i, h) <= r) ? at[i] : 0.f; }
#pragma unroll
            for (int g4 = 0; g4 < 4; ++g4) { u32x2 w; w.x = pk2(at[4 * g4], at[4 * g4 + 1]); w.y = pk2(at[4 * g4 + 2], at[4 * g4 + 3]);
                *(LAS u32x2*)(L + HG_AT + (32 * ta + r) * 144 + (32 * st + 8 * g4 + 4 * h) * 2) = w; }
        }
        f32x16 oo;
#pragma unroll
        for (int i = 0; i < 16; ++i) oo[i] = 0.f;
        { const LAS unsigned char* Sb = L + HG_SB + (32 * et + r) * 272 + 16 * h; const LAS unsigned char* Qb = L + (tt2 ? HG_QI : HG_Q1) + r * 272 + 16 * h;
#pragma unroll
          for (int s8 = 0; s8 < 8; ++s8) oo = MFMA32(*(const LAS bf16x8*)(Sb + 32 * s8), *(const LAS bf16x8*)(Qb + 32 * s8), oo); }
        __syncthreads();
#pragma unroll
        for (int q = 0; q < 2; ++q) { const int dt = (wave >> 2) + 2 * q, dd = 32 * dt + r;
            const float eb63 = fast_exp2(((tot[dd] + tot[128 + dd]) + (tot[256 + dd] + tot[384 + dd])) * LOG2E);
#pragma unroll
            for (int i = 0; i < 16; ++i) Sacc[q][i] *= eb63;
            const LAS unsigned char* Vb = L + HG_VT + (32 * et + r) * 144 + 16 * h; const LAS unsigned char* Kb = L + HG_K3T + dd * 144 + 16 * h;
#pragma unroll
            for (int s4 = 0; s4 < 4; ++s4) Sacc[q] = MFMA32(*(const LAS bf16x8*)(Vb + 32 * s4), *(const LAS bf16x8*)(Kb + 32 * s4), Sacc[q]);
            LAS unsigned char* Sw = L + HG_SB + dd * 2;
#pragma unroll
            for (int i = 0; i < 16; i += 2) { const unsigned w = pk2(Sacc[q][i], Sacc[q][i + 1]);
                *(LAS unsigned short*)(Sw + (32 * et + crow(i, h)) * 272) = (unsigned short)(w & 0xffffu); *(LAS unsigned short*)(Sw + (32 * et + crow(i + 1, h)) * 272) = (unsigned short)(w >> 16); } }
        { const LAS unsigned char* Vb = L + HG_VT + (32 * et + r) * 144 + 16 * h; const LAS unsigned char* Ab = L + HG_AT + (32 * tt2 + r) * 144 + 16 * h;
          oo = MFMA32(*(const LAS bf16x8*)(Vb), *(const LAS bf16x8*)(Ab), oo); oo = MFMA32(*(const LAS bf16x8*)(Vb + 32), *(const LAS bf16x8*)(Ab + 32), oo);
          if (tt2) { oo = MFMA32(*(const LAS bf16x8*)(Vb + 64), *(const LAS bf16x8*)(Ab + 64), oo); oo = MFMA32(*(const LAS bf16x8*)(Vb + 96), *(const LAS bf16x8*)(Ab + 96), oo); } }
        { float ss = 0.f;
#pragma unroll
          for (int i = 0; i < 16; ++i) ss += oo[i] * oo[i];
          ss = xhalf_sum(ss);
          if (h == 0) ssp[(32 * tt2 + r) * 4 + et] = ss; }
        __syncthreads();
        { const f32x4 s4 = *(const LAS f32x4*)(ssp + (32 * tt2 + r) * 4); const float rn = rsqrtf(((s4.x + s4.y) + (s4.z + s4.w)) * (1.f / HD) + EPS);
          const size_t row = (size_t)(b * T + 64 * c + 32 * tt2 + r);
#pragma unroll
          for (int g4 = 0; g4 < 4; ++g4) { const int e0 = 32 * et + 8 * g4 + 4 * h;
              const u32x2 gw = gw4[g4]; const f32x4 gn = gn4[g4];
              u32x2 w; w.x = pk2(oo[4 * g4] * rn * gn.x * sigmoidf_(bflo(gw.x)), oo[4 * g4 + 1] * rn * gn.y * sigmoidf_(bfhi(gw.x)));
              w.y = pk2(oo[4 * g4 + 2] * rn * gn.z * sigmoidf_(bflo(gw.y)), oo[4 * g4 + 3] * rn * gn.w * sigmoidf_(bfhi(gw.y)));
              *(u32x2*)(OH + akm(row, 2 * BW + hh * HD + e0)) = w; } }
    }
}

constexpr int AT_K = 0, AT_V = 32768, AT_TAB = 73728, AT_IMP = 75776, AT_SELM = 109568, AT_MISC = 109824;
constexpr int K_TB = 16384, V_RS = 320, V_TB = 64 * V_RS;
__device__ __forceinline__ unsigned koff(int row, int ch) { return 256u * (unsigned)row + 16u * (unsigned)(ch ^ (((row & 3) << 2) | ((row >> 2) & 3))); }
struct Stg { u32x4 k0, k1, v0, v1; };
__device__ __forceinline__ void stg_load(Stg& s, const bf16_t* Kp, const bf16_t* Vp, int ld, int tid) {
    const int row = tid >> 4, ch = tid & 15;
    s.k0 = *(const u32x4*)(Kp + (size_t)row * ld + ch * 8); s.k1 = *(const u32x4*)(Kp + (size_t)(row + 32) * ld + ch * 8);
    s.v0 = *(const u32x4*)(Vp + (size_t)row * ld + ch * 8); s.v1 = *(const u32x4*)(Vp + (size_t)(row + 32) * ld + ch * 8);
}
__device__ __forceinline__ void stg_write(const Stg& s, LAS unsigned char* L, int tid, int buf) {
    const int row = tid >> 4, ch = tid & 15;
    *(LAS u32x4*)(L + AT_K + buf * K_TB + koff(row, ch)) = s.k0; *(LAS u32x4*)(L + AT_K + buf * K_TB + koff(row + 32, ch)) = s.k1;
    *(LAS u32x4*)(L + AT_V + buf * V_TB + row * V_RS + ch * 16) = s.v0; *(LAS u32x4*)(L + AT_V + buf * V_TB + (row + 32) * V_RS + ch * 16) = s.v1;
}
__device__ __forceinline__ float xhalf_max(float v) { auto rr = __builtin_amdgcn_permlane32_swap(__float_as_uint(v), __float_as_uint(v), false, false); return fmaxf(__uint_as_float(rr[0]), __uint_as_float(rr[1])); }
__device__ __forceinline__ float xhalf_sum(float v) { auto rr = __builtin_amdgcn_permlane32_swap(__float_as_uint(v), __float_as_uint(v), false, false); return __uint_as_float(rr[0]) + __uint_as_float(rr[1]); }
__device__ __forceinline__ float xhalf_get(float v, int h) { auto rr = __builtin_amdgcn_permlane32_swap(__float_as_uint(v), __float_as_uint(v), false, false); return __uint_as_float(h ? rr[0] : rr[1]); }
__device__ __forceinline__ void qk_tile(f32x16& p0, f32x16& p1, const LAS unsigned char* L, int buf, const bf16x8 (&qf)[8], int r, int h, const float init = 0.f) {
#pragma unroll
    for (int i = 0; i < 16; ++i) { p0[i] = init; p1[i] = init; }
    const LAS unsigned char* Kb = L + AT_K + buf * K_TB;
    bf16x8 a0[8], a1[8];
#pragma unroll
    for (int s = 0; s < 8; ++s) { a0[s] = *(const LAS bf16x8*)(Kb + koff(r, 2 * s + h)); a1[s] = *(const LAS bf16x8*)(Kb + koff(r + 32, 2 * s + h)); }
#pragma unroll
    for (int s = 0; s < 8; ++s) { p0 = MFMA32(a0[s], qf[s], p0); p1 = MFMA32(a1[s], qf[s], p1); }
    __builtin_amdgcn_sched_group_barrier(0x100, 4, 0);
#pragma unroll
    for (int i = 0; i < 6; ++i) { __builtin_amdgcn_sched_group_barrier(0x008, 2, 0); __builtin_amdgcn_sched_group_barrier(0x100, 2, 0); }
    __builtin_amdgcn_sched_group_barrier(0x008, 4, 0);
}
__device__ __forceinline__ bf16x8 pack8(const f32x16& p, int s) {
    u32x4 w; w.x = pk2(p[8 * s], p[8 * s + 1]); w.y = pk2(p[8 * s + 2], p[8 * s + 3]); w.z = pk2(p[8 * s + 4], p[8 * s + 5]); w.w = pk2(p[8 * s + 6], p[8 * s + 7]);
    return __builtin_bit_cast(bf16x8, w);
}
__device__ __forceinline__ void pv_tile(f32x16 (&o)[4], const f32x16& p0, const f32x16& p1, const LAS unsigned char* L, int buf, int lane) {
    bf16x8 pb[4]; pb[0] = pack8(p0, 0); pb[1] = pack8(p0, 1); pb[2] = pack8(p1, 0); pb[3] = pack8(p1, 1);
    const LAS unsigned char* vb = L + AT_V + buf * V_TB + (4 * (lane >> 5) + ((lane & 15) >> 2)) * V_RS + ((lane >> 4) & 1) * 32 + (lane & 3) * 8;
    __builtin_amdgcn_sched_barrier(0);
    s16x4 lo[16], hi[16];
#pragma unroll
    for (int c = 0; c < 4; ++c)
#pragma unroll
        for (int s = 0; s < 4; ++s) { lo[4 * c + s] = __builtin_amdgcn_ds_read_tr16_b64_v4i16((LAS s16x4*)(vb + (16 * s) * V_RS + 64 * c)); hi[4 * c + s] = __builtin_amdgcn_ds_read_tr16_b64_v4i16((LAS s16x4*)(vb + (16 * s + 8) * V_RS + 64 * c)); }
#pragma unroll
    for (int c = 0; c < 4; ++c)
#pragma unroll
        for (int s = 0; s < 4; ++s) o[c] = MFMA32(__builtin_shufflevector(lo[4 * c + s], hi[4 * c + s], 0, 1, 2, 3, 4, 5, 6, 7), pb[s], o[c]);
    __builtin_amdgcn_sched_group_barrier(0x100, 4, 1);
#pragma unroll
    for (int i = 0; i < 14; ++i) { __builtin_amdgcn_sched_group_barrier(0x008, 1, 1); __builtin_amdgcn_sched_group_barrier(0x100, 2, 1); }
    __builtin_amdgcn_sched_group_barrier(0x008, 2, 1);
    __builtin_amdgcn_sched_barrier(0);
}
#ifndef SM_THR
#define SM_THR 6.f
#endif
__device__ __forceinline__ void softmax_step(f32x16& p0, f32x16& p1, float& m, float& l, f32x16 (&o)[4]) {
    float mx = p0[0];
#pragma unroll
    for (int i = 1; i < 16; ++i) mx = fmaxf(mx, p0[i]);
#pragma unroll
    for (int i = 0; i < 16; ++i) mx = fmaxf(mx, p1[i]);
    mx = xhalf_max(mx);
    float alpha = 1.f;
    if (!__all(mx - m <= SM_THR)) { const float mn = fmaxf(m, mx); alpha = fast_exp2((m - mn) * LOG2E); m = mn; }
    const float mb = m * LOG2E; float ps = 0.f;
#pragma unroll
    for (int i = 0; i < 16; ++i) { p0[i] = fast_exp2(p0[i] * LOG2E - mb); ps += p0[i]; }
#pragma unroll
    for (int i = 0; i < 16; ++i) { p1[i] = fast_exp2(p1[i] * LOG2E - mb); ps += p1[i]; }
    ps = xhalf_sum(ps);
    l = l * alpha + ps;
    if (!__all(alpha == 1.f)) {
#pragma unroll
        for (int c = 0; c < 4; ++c)
#pragma unroll
            for (int i = 0; i < 16; ++i) o[c][i] *= alpha; }
}
__device__ __forceinline__ void store_ot(const f32x16 (&o)[4], float sc, bf16_t* base, size_t row, int col  , int h, bool add) {
    bf16_t* p0 = base + akm(row, col) + 4 * h;
#pragma unroll
    for (int c = 0; c < 4; ++c)
#pragma unroll
        for (int g4 = 0; g4 < 4; ++g4) { u32x2* p = (u32x2*)(p0 + (size_t)(c >> 1) * ((size_t)M * 64) + 32 * (c & 1) + 8 * g4);
            float v0 = sc * o[c][4 * g4], v1 = sc * o[c][4 * g4 + 1], v2 = sc * o[c][4 * g4 + 2], v3 = sc * o[c][4 * g4 + 3];
            if (add) { const u32x2 w0 = *p; v0 += bflo(w0.x); v1 += bfhi(w0.x); v2 += bflo(w0.y); v3 += bfhi(w0.y); }
            u32x2 w; w.x = pk2(v0, v1); w.y = pk2(v2, v3); *p = w; }
}

__device__ __forceinline__ void item_sb(Frame& F, KArgs a, int item) {
    LAS unsigned char* L = F.lds;
    const int qb = 7 - (item >> 7), rem = item & 127, b = rem >> 3, hh = rem & 7, t0 = qb * 256;
    const int tid = F.tid, lane = F.lane, wave = F.wave, r = lane & 31, h = lane >> 5;
    const int tq = t0 + 32 * wave + r;
    const bf16_t* P = (const bf16_t*)(F.ws + WS_P); const size_t rowq = (size_t)(b * T + tq);
    const bf16_t* Kb = P + (size_t)(b * T) * NPC + PKSB + hh * HD; const bf16_t* Vb = P + (size_t)(b * T) * NPC + PVSB + hh * HD;
    bf16x8 qf[8];
#pragma unroll
    for (int s = 0; s < 8; ++s) qf[s] = *(const bf16x8*)(P + rowq * NPC + PQS + hh * HD + 16 * s + 8 * h);
    f32x16 o[4];
#pragma unroll
    for (int c = 0; c < 4; ++c)
#pragma unroll
        for (int i = 0; i < 16; ++i) o[c][i] = 0.f;
    float C = 1.f; bool wdone = false;
    volatile LAS unsigned* flags = (volatile LAS unsigned*)(L + AT_MISC);
    Stg st; int j = 4 * qb + 3, buf = 0, it = 0;
    stg_load(st, Kb + (size_t)(64 * j) * NPC, Vb + (size_t)(64 * j) * NPC, NPC, tid);
    __syncthreads();
    stg_write(st, L, tid, 0);
    if (j > 0) stg_load(st, Kb + (size_t)(64 * (j - 1)) * NPC, Vb + (size_t)(64 * (j - 1)) * NPC, NPC, tid);
    for (;;) {
        if (lane == 0) flags[(it & 1) * 8 + wave] = wdone ? 1u : 0u;
        __syncthreads();
        unsigned nd = 0;
#pragma unroll
        for (int w = 0; w < 8; ++w) nd += flags[(it & 1) * 8 + w];
        if (__builtin_amdgcn_readfirstlane(nd) == 8u) break;
        if (j > 0) stg_write(st, L, tid, buf ^ 1);
        if (j > 1) stg_load(st, Kb + (size_t)(64 * (j - 2)) * NPC, Vb + (size_t)(64 * (j - 2)) * NPC, NPC, tid);
        const bool active = !wdone && (64 * j <= t0 + 32 * wave + 30);
        if (active) {
            f32x16 p0, p1; qk_tile(p0, p1, L, buf, qf, r, h);
            float om0[16], om1[16];
            const int kb = 64 * j + 4 * h;
#define SB_ELEM(MASK) do { _Pragma("unroll") for (int i = 0; i < 16; ++i) { const int key0 = kb + (i & 3) + 8 * (i >> 2); \
                { const float pz = p0[i]; const float ex = fast_exp2(-fabsf(pz) * (QSCALE * LOG2E)); const float rr = fast_rcp(1.f + ex), er = ex * rr; const bool pos = pz >= 0.f; \
                  float be = pos ? rr : er, om = pos ? er : rr; if (MASK) { const bool cz = key0 < tq; om = cz ? om : 1.f; be = cz ? be : 0.f; } om0[i] = om; p0[i] = be; } \
                { const float pz = p1[i]; const float ex = fast_exp2(-fabsf(pz) * (QSCALE * LOG2E)); const float rr = fast_rcp(1.f + ex), er = ex * rr; const bool pos = pz >= 0.f; \
                  float be = pos ? rr : er, om = pos ? er : rr; if (MASK) { const bool cz = key0 + 32 < tq; om = cz ? om : 1.f; be = cz ? be : 0.f; } om1[i] = om; p1[i] = be; } } } while (0)
            SB_ELEM(false);
#undef SB_ELEM
            if (64 * j + 63 >= t0 + 32 * wave) {
#pragma unroll
                for (int i = 0; i < 16; ++i) { const int key0 = kb + (i & 3) + 8 * (i >> 2); const bool c0 = key0 < tq, c1 = key0 + 32 < tq;
                    om0[i] = c0 ? om0[i] : 1.f; p0[i] = c0 ? p0[i] : 0.f; om1[i] = c1 ? om1[i] : 1.f; p1[i] = c1 ? p1[i] : 0.f; } }
            float Tm[2][4], Tr[2][4];
#pragma unroll
            for (int g4 = 0; g4 < 4; ++g4) { Tm[0][g4] = (om0[4 * g4] * om0[4 * g4 + 1]) * (om0[4 * g4 + 2] * om0[4 * g4 + 3]); Tm[1][g4] = (om1[4 * g4] * om1[4 * g4 + 1]) * (om1[4 * g4 + 2] * om1[4 * g4 + 3]); }
#pragma unroll
            for (int k = 0; k < 2; ++k)
#pragma unroll
                for (int g4 = 0; g4 < 4; ++g4) Tr[k][g4] = xhalf_get(Tm[k][g4], h);
            float aft[2][4]; float run = C;
#pragma unroll
            for (int G = 15; G >= 0; --G) { const int k = G >> 3, g4 = (G >> 1) & 3, par = G & 1;
                const float tg = (par == 1) ? (h ? Tm[k][g4] : Tr[k][g4]) : (h ? Tr[k][g4] : Tm[k][g4]);
                if (par == 1) { if (h) aft[k][g4] = run; } else { if (!h) aft[k][g4] = run; }
                run *= tg; }
            C = run;
#pragma unroll
            for (int g4 = 0; g4 < 4; ++g4) {
                { float ca = aft[0][g4];
#pragma unroll
                  for (int e = 3; e >= 0; --e) { const int i = 4 * g4 + e; const float w_ = p0[i] * ca; ca *= om0[i]; p0[i] = w_; } }
                { float ca = aft[1][g4];
#pragma unroll
                  for (int e = 3; e >= 0; --e) { const int i = 4 * g4 + e; const float w_ = p1[i] * ca; ca *= om1[i]; p1[i] = w_; } }
            }
            pv_tile(o, p0, p1, L, buf, lane);
            wdone = __all(C < 1e-30f);
        }
        if (j == 0) break;
        --j; buf ^= 1; ++it;
    }
    store_ot(o, 1.f, (bf16_t*)(F.ws + WS_OBR), rowq, BW + hh * HD, h, false);
}

__device__ __forceinline__ void item_nsa(Frame& F, KArgs a, int item) {
    LAS unsigned char* L = F.lds;
    const int qblk = 31 - (item >> 5), rem = item & 31, b = rem >> 1, g = rem & 1, t0 = qblk * 64;
    const int tid = F.tid, lane = F.lane, wave = F.wave, r = lane & 31, h = lane >> 5, hr = wave >> 1, th = wave & 1;
    const int tl = 32 * th + r, tq = t0 + tl, hq = g * 4 + hr;
    const bf16_t* P = (const bf16_t*)(F.ws + WS_P);
    LAS float* tab = (LAS float*)(L + AT_TAB); LAS float* imp = (LAS float*)(L + AT_IMP); volatile LAS unsigned* selm = (volatile LAS unsigned*)(L + AT_SELM); LAS unsigned* misc = (LAS unsigned*)(L + AT_MISC);
    { const int hh = tid >> 7, dd = tid & 127; tab[tid] = a->in[I_RELB][t5_bucket(dd) * 8 + g * 4 + hh]; }
    if (tid == 0) misc[0] = 0u;
    bf16x8 qf[8];
#pragma unroll
    for (int s = 0; s < 8; ++s) qf[s] = *(const bf16x8*)(P + (size_t)(b * T + tq) * NPC + PQN + hq * HD + 16 * s + 8 * h);
    f32x16 o[4];
    Stg st;
    auto opq = [](int v) { asm volatile("" : "+v"(v)); return v; };
#define NSA_GATE(i) sigmoidf_(bf2f(P[((size_t)(b * T + opq(tq))) * NPC + PGN + hq * 3 + (i)]))
#define NSA_OUT() (bf16_t*)(F.ws + WS_OBR), (size_t)(b * T + opq(tq)), hq * HD
    {
        const bf16_t* kc = (const bf16_t*)(F.ws + WS_MISC + MISC_KCMP) + (size_t)((b * 2 + g) * 128) * HD; const bf16_t* vc = (const bf16_t*)(F.ws + WS_MISC + MISC_VCMP) + (size_t)((b * 2 + g) * 128) * HD;
        const bool two = qblk >= 16;
        f32x16 pc[4];
        __syncthreads();
        { Stg st1; stg_load(st, kc, vc, HD, tid); if (two) stg_load(st1, kc + 64 * HD, vc + 64 * HD, HD, tid);
          stg_write(st, L, tid, 0); if (two) stg_write(st1, L, tid, 1); }
        __syncthreads();
        qk_tile(pc[0], pc[1], L, 0, qf, r, h);
        if (two) qk_tile(pc[2], pc[3], L, 1, qf, r, h);
        float mx = -1e30f;
#pragma unroll
        for (int k = 0; k < 4; ++k) { if (k >= 2 && !two) break;
#pragma unroll
            for (int i = 0; i < 16; ++i) { const int n = 32 * k + crow(i, h); const int dc = tq - (16 * n + 31); const int di = dc < 113 ? dc : 113;
                const float sv = dc >= 0 ? pc[k][i] + tab[hr * 128 + (di < 0 ? 0 : di)] : -__builtin_inff(); pc[k][i] = sv; mx = fmaxf(mx, sv); } }
        mx = xhalf_max(mx);
        float sum = 0.f;
#pragma unroll
        for (int k = 0; k < 4; ++k) { if (k >= 2 && !two) break;
#pragma unroll
            for (int i = 0; i < 16; ++i) { const float e = fast_exp2((pc[k][i] - mx) * LOG2E); pc[k][i] = e; sum += e; } }
        sum = xhalf_sum(sum);
        const float inv = 1.f / fmaxf(sum, 1e-30f);
#pragma unroll
        for (int k = 0; k < 4; ++k)
#pragma unroll
            for (int i = 0; i < 16; ++i) pc[k][i] = (k >= 2 && !two) ? 0.f : pc[k][i] * inv;
        float gs[16], gl[16], rc[16];
#pragma unroll
        for (int k = 0; k < 4; ++k)
#pragma unroll
            for (int g4 = 0; g4 < 4; ++g4) { gs[4 * k + g4] = (pc[k][4 * g4] + pc[k][4 * g4 + 1]) + (pc[k][4 * g4 + 2] + pc[k][4 * g4 + 3]); gl[4 * k + g4] = pc[k][4 * g4 + 3]; }
#pragma unroll
        for (int f = 0; f < 16; ++f) rc[f] = xhalf_get(gl[f], h);
#pragma unroll
        for (int f = 0; f < 16; ++f) { const float prev = h ? rc[f] : (f >= 1 ? rc[f - 1] : 0.f); const int G = 8 * (f >> 2) + 2 * (f & 3) + h;
            imp[(hr * 64 + tl) * 33 + G] = gs[f] + prev; }
#pragma unroll
        for (int c = 0; c < 4; ++c)
#pragma unroll
            for (int i = 0; i < 16; ++i) o[c][i] = 0.f;
        pv_tile(o, pc[0], pc[1], L, 0, lane);
        if (two) pv_tile(o, pc[2], pc[3], L, 1, lane);
        store_ot(o, NSA_GATE(0), NSA_OUT(), h, false);
    }
    __syncthreads();
    const int tk = tid >> 3, part = tid & 7;
    if (qblk >= 16) {
#pragma unroll
        for (int q = 0; q < 4; ++q) { const int jj = part + 8 * q; imp[tk * 33 + jj] = (imp[tk * 33 + jj] + imp[(64 + tk) * 33 + jj]) + (imp[(128 + tk) * 33 + jj] + imp[(192 + tk) * 33 + jj]); }
    }
    __syncthreads();
    {
        unsigned msk;
        if (qblk < 16) msk = (2u << qblk) - 1u;
        else {
            msk = 0u;
#pragma unroll
            for (int q = 0; q < 4; ++q) { const int jj = part + 8 * q;
                if (jj >= 1 && jj <= qblk - 2) { const float v = imp[tk * 33 + jj]; int rank = 0;
#pragma unroll
                    for (int j2 = 1; j2 < 30; ++j2) { const float v2 = imp[tk * 33 + j2]; rank += (j2 <= qblk - 2 && (v2 > v || (v2 == v && j2 < jj))) ? 1 : 0; }
                    if (rank < 13) msk |= 1u << jj; } }
            msk |= (unsigned)__shfl_xor((int)msk, 1); msk |= (unsigned)__shfl_xor((int)msk, 2); msk |= (unsigned)__shfl_xor((int)msk, 4);
            msk |= 1u | (1u << (qblk - 1)) | (1u << qblk);
        }
        if (part == 0) selm[tk] = msk;
        unsigned om = msk;
#pragma unroll
        for (int off = 8; off < 64; off <<= 1) om |= (unsigned)__shfl_xor((int)om, off);
        if (lane == 0) __hip_atomic_fetch_or(misc, om, __ATOMIC_RELAXED, __HIP_MEMORY_SCOPE_WORKGROUP);
    }
    __syncthreads();
    const bf16_t* Kbase = P + (size_t)(b * T) * NPC + g * HD;
    const float bfar = tab[hr * 128 + 113];
    for (int rep = 0; rep < (MK_PROBE == 31 ? 2 : 1); ++rep) {
        if (rep) __syncthreads();
        unsigned om = __builtin_amdgcn_readfirstlane(misc[0]); const unsigned mym = selm[tl];
        float m = -1e30f, l = 0.f;
#pragma unroll
        for (int c = 0; c < 4; ++c)
#pragma unroll
            for (int i = 0; i < 16; ++i) o[c][i] = 0.f;
        int jc = __builtin_ctz(om); om &= om - 1u;
        stg_load(st, Kbase + PKS + (size_t)(64 * jc) * NPC, Kbase + PVS + (size_t)(64 * jc) * NPC, NPC, tid);
        stg_write(st, L, tid, 0);
        int jn = om ? __builtin_ctz(om) : -1; if (jn >= 0) { om &= om - 1u; stg_load(st, Kbase + PKS + (size_t)(64 * jn) * NPC, Kbase + PVS + (size_t)(64 * jn) * NPC, NPC, tid); }
        int buf = 0;
        for (;;) {
            __syncthreads();
            if (jn >= 0) stg_write(st, L, tid, buf ^ 1);
            const int jnn = om ? __builtin_ctz(om) : -1; if (jnn >= 0) { om &= om - 1u; stg_load(st, Kbase + PKS + (size_t)(64 * jnn) * NPC, Kbase + PVS + (size_t)(64 * jnn) * NPC, NPC, tid); }
            const bool sel = (mym >> jc) & 1u; const bool farsel = jc <= qblk - 3;
            f32x16 p0, p1; qk_tile(p0, p1, L, buf, qf, r, h, farsel ? (sel ? bfar : -__builtin_inff()) : 0.f);
            if (!farsel) {
#pragma unroll
                for (int i = 0; i < 16; ++i) { const int d0 = tq - (64 * jc + crow(i, h)), d1 = d0 - 32;
                    const float b0 = tab[hr * 128 + (d0 < 0 ? 0 : (d0 > 113 ? 113 : d0))], b1 = tab[hr * 128 + (d1 < 0 ? 0 : (d1 > 113 ? 113 : d1))];
                    p0[i] = (sel && d0 >= 0) ? p0[i] + b0 : -__builtin_inff(); p1[i] = (sel && d1 >= 0) ? p1[i] + b1 : -__builtin_inff(); }
            }
            softmax_step(p0, p1, m, l, o);
            pv_tile(o, p0, p1, L, buf, lane);
            if (jn < 0) break;
            jc = jn; jn = jnn; buf ^= 1;
        }
        if (rep == (MK_PROBE == 31 ? 1 : 0)) store_ot(o, NSA_GATE(1) / l, NSA_OUT(), h, true);
    }
    for (int rep = 0; rep < (MK_PROBE == 32 ? 2 : 1); ++rep) {
        float m = -1e30f, l = 0.f;
#pragma unroll
        for (int c = 0; c < 4; ++c)
#pragma unroll
            for (int i = 0; i < 16; ++i) o[c][i] = 0.f;
        int jc = qblk >= 8 ? qblk - 8 : 0;
        stg_load(st, Kbase + PKW + (size_t)(64 * jc) * NPC, Kbase + PVW + (size_t)(64 * jc) * NPC, NPC, tid);
        __syncthreads();
        stg_write(st, L, tid, 0);
        if (jc < qblk) stg_load(st, Kbase + PKW + (size_t)(64 * (jc + 1)) * NPC, Kbase + PVW + (size_t)(64 * (jc + 1)) * NPC, NPC, tid);
        int buf = 0;
        for (;;) {
            __syncthreads();
            if (jc < qblk) stg_write(st, L, tid, buf ^ 1);
            if (jc + 1 < qblk) stg_load(st, Kbase + PKW + (size_t)(64 * (jc + 2)) * NPC, Kbase + PVW + (size_t)(64 * (jc + 2)) * NPC, NPC, tid);
            const bool interior = jc <= qblk - 3 && jc >= qblk - 7;
            f32x16 p0, p1; qk_tile(p0, p1, L, buf, qf, r, h, interior ? bfar : 0.f);
            if (!interior) {
                const bool far = jc <= qblk - 3;
#pragma unroll
                for (int i = 0; i < 16; ++i) { const int d0 = tq - (64 * jc + crow(i, h)), d1 = d0 - 32;
                    const float b0 = far ? bfar : tab[hr * 128 + (d0 < 0 ? 0 : (d0 > 113 ? 113 : d0))], b1 = far ? bfar : tab[hr * 128 + (d1 < 0 ? 0 : (d1 > 113 ? 113 : d1))];
                    p0[i] = ((unsigned)d0 < 512u) ? p0[i] + b0 : -__builtin_inff(); p1[i] = ((unsigned)d1 < 512u) ? p1[i] + b1 : -__builtin_inff(); }
            }
            softmax_step(p0, p1, m, l, o);
            pv_tile(o, p0, p1, L, buf, lane);
            if (jc == qblk) break;
            ++jc; buf ^= 1;
        }
        if (rep == (MK_PROBE == 32 ? 1 : 0)) store_ot(o, NSA_GATE(2) / l, NSA_OUT(), h, true);
    }
#undef NSA_GATE
#undef NSA_OUT
}

constexpr int NI_H = 128, NI_S = 1024, NI_C = 256, NI_N = 512, NI_A = 1024;
#define FRESH_F() do { unsigned on_ = ~0u; asm volatile("" : "+s"(on_)); int t_ = F.wave * 64 + (int)__builtin_amdgcn_mbcnt_hi(on_, __builtin_amdgcn_mbcnt_lo(on_, 0u)); asm volatile("" : "+v"(t_)); F.tid = t_; F.lane = t_ & 63; F.wave = __builtin_amdgcn_readfirstlane(t_ >> 6); } while (0)
__device__ __forceinline__ void phase_Ca(Frame& F, KArgs a, int layer, int bank, int types) {
    unsigned* head = F.ctl + CW_QUEUE + 64 * (layer * 8) + bank * 4096;
    if (types & 1) for (;;) { const int it = q_next(F, head + 0); if (it >= NI_H) break; FRESH_F(); item_hgrn(F, a, layer, it); }
    if (types & 2) for (;;) { const int it = q_next(F, head + 64); if (it >= NI_S) break; FRESH_F(); item_sb(F, a, it); }
    if (types & 4) for (;;) { const int it = q_next(F, head + 128); if (it >= NI_C) break; FRESH_F(); item_compress(F, a, layer, it); }
    if (types & 8) for (;;) { const int it = q_next(F, head + 192); if (it >= NI_N) break; FRESH_F(); item_norm(F, a, layer, it); }
}
__device__ __forceinline__ void phase_Cb(Frame& F, KArgs a, int layer, int bank) {
    unsigned* head = F.ctl + CW_QUEUE + 64 * (layer * 8 + 4) + bank * 4096;
    for (;;) { const int it = q_next(F, head + 0); if (it >= NI_A) break; FRESH_F(); item_nsa(F, a, it); }
}

__global__ void __launch_bounds__(512, 2) mega(Args karg) {
    extern __shared__ __attribute__((aligned(16))) unsigned char lds_raw[];
    Frame F;
    F.lds = (LAS unsigned char*)lds_raw; F.MISC = (volatile LAS unsigned*)(F.lds + MISC_OFF);
    F.tid = threadIdx.x; F.lane = F.tid & 63; F.wave = __builtin_amdgcn_readfirstlane(F.tid >> 6); F.G = gridDim.x; F.bid = blockIdx.x;
    KArgs a = (KArgs)__builtin_amdgcn_kernarg_segment_ptr();
    F.ws = a->ws; F.ctl = (unsigned*)(a->ws + WS_CTL);
    if (F.tid < 64) F.MISC[F.tid] = 0u;
    __syncthreads();
    const int lo = karg.ph_lo, hi = karg.ph_hi;
    XcdBarrier bar; bar.bar = F.ctl + CW_BAR; bar.x = 0; bar.st = F.MISC + 8;
    if (hi - lo > 1) bar = xcd_barrier_post(F.ctl + CW_BAR, F.MISC + 8);
#define IN(k) (lo <= (k) && (k) < hi)
#define ON(k) (((MK_PHASE_MASK & MK_BUILD_MASK) >> (k)) & 1)
#define GRID_BAR() do { unsigned* bp_ = (unsigned*)(a->ws + WS_CTL) + CW_BAR; asm volatile("" : "+s"(bp_)); bar.bar = bp_; xcd_barrier(bar); } while (0)
#define SEAM(k) do { if (IN(k) && IN((k) + 1)) GRID_BAR(); } while (0)
    bf16_t* Hb; bf16_t* Pb; const int wave_s = __builtin_amdgcn_readfirstlane(threadIdx.x >> 6);
    for (int layer = 0; layer < DEPTH; ++layer) {
        const int pb = layer * 10;
#define FRESH() do { unsigned on_ = ~0u; asm volatile("" : "+s"(on_)); int t_ = wave_s * 64 + (int)__builtin_amdgcn_mbcnt_hi(on_, __builtin_amdgcn_mbcnt_lo(on_, 0u)); asm volatile("" : "+v"(t_)); F.tid = t_; F.lane = t_ & 63; F.wave = __builtin_amdgcn_readfirstlane(t_ >> 6); \
        asm volatile("" : "+s"(a)); F.ws = a->ws; F.ctl = (unsigned*)(a->ws + WS_CTL); Hb = (bf16_t*)(F.ws + WS_H); Pb = (bf16_t*)(F.ws + WS_P); } while (0)
        if (ON(0) && IN(pb + 0)) { FRESH(); if (MK_PROBE == 0) { phase_A(F, a, layer); GRID_BAR(); } phase_A(F, a, layer); } SEAM(pb + 0);
        if (ON(1) && IN(pb + 1)) for (int rep = 0; rep < (MK_PROBE == 1 ? 2 : 1); ++rep) { FRESH();
            if (rep) GRID_BAR();
            if (MK_STAGGER) { const unsigned long long t0 = __builtin_amdgcn_s_memrealtime(), dl = (unsigned long long)((F.bid >> 3) & 7) * MK_STAGGER; while (__builtin_amdgcn_s_memrealtime() - t0 < dl) __builtin_amdgcn_s_sleep(4); }
            pg8::Gemm g{(const bf16_t*)(F.ws + WS_XB), (const bf16_t*)(F.ws + WS_WIN), M, NPC, DM, 1, 1}; pg8::StaticOrder S; S.init(M, NPC, F.G, F.bid);
            pg8::EpiStoreBf16 E{Pb, NPC, PGT / 256, PGN / 256, (const float*)(F.ws + WS_RSTD), (LAS const float*)(F.lds + pg8::LRS_OFF)};
            pg8::gemm_phase<pg8::EpiStoreBf16, pg8::StaticOrder, PG8_ALIGN, PG8_SP2>(F.lds, g, S, E, F.tid, (MK_DIAG && layer == 0 && F.bid == 0) ? (unsigned long long*)(F.ctl + 49152) : nullptr);
        } SEAM(pb + 1);
        if (ON(2) && IN(pb + 2)) { FRESH(); if (MK_PROBE >= 20 && MK_PROBE < 28) { phase_Ca(F, a, layer, 1, MK_PROBE - 20); GRID_BAR(); } phase_Ca(F, a, layer, 0, 15); } SEAM(pb + 2);
        if (ON(3) && IN(pb + 3)) { FRESH(); if (MK_PROBE == 3) { phase_Cb(F, a, layer, 1); GRID_BAR(); } phase_Cb(F, a, layer, 0); } SEAM(pb + 3);
        if (ON(4) && IN(pb + 4)) for (int rep = 0; rep < (MK_PROBE == 4 ? 2 : 1); ++rep) { FRESH();
            if (rep) GRID_BAR();
            pg8::Gemm g{(const bf16_t*)(F.ws + WS_OBR), (const bf16_t*)(F.ws + WS_WBR), M, DM, 3 * BW, 1, 1}; pg8::StaticOrder S; S.init(M, DM, F.G, F.bid);
            pg8::EpiGated E{Pb, Hb};
            pg8::gemm_phase<pg8::EpiGated, pg8::StaticOrder, PG8_ALIGN, PG8_SP2>(F.lds, g, S, E, F.tid);
        } SEAM(pb + 4);
        if (ON(5) && IN(pb + 5)) for (int rep = 0; rep < (MK_PROBE == 5 ? 2 : 1); ++rep) { FRESH();
            if (rep) GRID_BAR();
            pg8::Gemm g{Hb, (const bf16_t*)(F.ws + WS_WOUT), M, DM, DM, 1, 1}; pg8::StaticOrder S; S.init(M, DM, F.G, F.bid);
            pg8::EpiResidBf16 E{(MK_PROBE == 5 && rep == 0) ? (bf16_t*)(F.ws + WS_P) : (bf16_t*)(F.ws + WS_XB), nullptr, (MK_PROBE == 5 && rep == 0) ? (float*)(F.ws + WS_P + 256 * MiB) : (float*)(F.ws + WS_SSQ), DM};
            pg8::gemm_phase<pg8::EpiResidBf16, pg8::StaticOrder, PG8_ALIGN, PG8_SP2>(F.lds, g, S, E, F.tid);
        } SEAM(pb + 5);
        if (ON(6) && IN(pb + 6)) { FRESH(); if (MK_PROBE == 60) { GRID_BAR(); GRID_BAR(); GRID_BAR(); GRID_BAR(); } if (MK_PROBE == 6) { phase_F(F, a); GRID_BAR(); } phase_F(F, a); } SEAM(pb + 6);
        if (ON(7) && IN(pb + 7)) for (int rep = 0; rep < (MK_PROBE == 7 ? 2 : 1); ++rep) { FRESH();
            if (rep) GRID_BAR();
            if (MK_STAGGER) { const unsigned long long t0 = __builtin_amdgcn_s_memrealtime(), dl = (unsigned long long)((F.bid >> 3) & 7) * MK_STAGGER; while (__builtin_amdgcn_s_memrealtime() - t0 < dl) __builtin_amdgcn_s_sleep(4); }
            pg8::Gemm g{(const bf16_t*)(F.ws + WS_XB), (const bf16_t*)(F.ws + WS_WUP), M, NUP, DM, 1, 1}; pg8::StaticOrder S; S.init(M, NUP, F.G, F.bid);
            pg8::EpiConvAct E{F.ws, a, layer, (LAS const float*)(F.lds + pg8::LRS_OFF)};
            pg8::gemm_phase<pg8::EpiConvAct, pg8::StaticOrder, PG8_ALIGN, PG8_SP2>(F.lds, g, S, E, F.tid);
        } SEAM(pb + 7);
        if (ON(8) && IN(pb + 8)) { FRESH(); if (MK_PROBE == 8) { phase_H(F, a, layer); GRID_BAR(); } phase_H(F, a, layer); } SEAM(pb + 8);
        if (ON(9) && IN(pb + 9)) for (int rep = 0; rep < (MK_PROBE == 9 ? 2 : 1); ++rep) { FRESH();
            if (rep) GRID_BAR();
            pg8::Gemm g{(const bf16_t*)(F.ws + WS_ACT), (const bf16_t*)(F.ws + WS_WDN), M, DM, DFF, 1, 1}; pg8::StaticOrder S; S.init(M, DM, F.G, F.bid, 4, 1);
            pg8::EpiResidBf16 E{(MK_PROBE == 9 && rep == 0) ? (bf16_t*)(F.ws + WS_P) : (bf16_t*)(F.ws + WS_XB), (layer == DEPTH - 1 && !(MK_PROBE == 9 && rep == 0)) ? a->out : nullptr, (MK_PROBE == 9 && rep == 0) ? (float*)(F.ws + WS_P + 256 * MiB) : (float*)(F.ws + WS_SSQ), DM};
            pg8::gemm_phase<pg8::EpiResidBf16, pg8::StaticOrder, PG8_ALIGN, PG8_SP2>(F.lds, g, S, E, F.tid);
        } SEAM(pb + 9);
    }
#if MK_DIAG
    GRID_BAR();
    { const unsigned long long* dg = (const unsigned long long*)(F.ctl + 49152); const float kl = (float)(long long)(dg[1] - dg[0]), per = (float)(long long)(dg[2] - dg[0]);
      const float eps = MK_DIAG == 1 ? kl / per : (MK_DIAG == 2 ? per * 1e-4f : kl * 1e-4f);
      for (size_t i = (size_t)F.bid * 512 + threadIdx.x; i < (size_t)M * DM; i += (size_t)F.G * 512) a->out[i] *= (1.f + eps); }
#endif
}

extern "C" void kernel_launch(void* const* d_in, const int* in_sizes, int n_in, void* d_out, int out_size, void* d_ws, size_t ws_size, hipStream_t stream) {
    static int grid = 0;
    if (grid == 0) {
        if (n_in != 18 || in_sizes[0] != M * DM || out_size != M * DM || ws_size < WS_END) { fprintf(stderr, "kernel_launch: unexpected shapes / workspace (%d inputs, ws %zu)\n", n_in, ws_size); grid = -1; return; }
        int dev = 0, cus = 0, per_cu = 0;
        if (hipGetDevice(&dev) != hipSuccess || hipDeviceGetAttribute(&cus, hipDeviceAttributeMultiprocessorCount, dev) != hipSuccess) { grid = -1; return; }
        if (hipFuncSetAttribute((const void*)mega, hipFuncAttributeMaxDynamicSharedMemorySize, LDS_BYTES) != hipSuccess) { grid = -1; return; }
        if (hipOccupancyMaxActiveBlocksPerMultiprocessor(&per_cu, (const void*)mega, 512, LDS_BYTES) != hipSuccess || per_cu < 1) { fprintf(stderr, "kernel_launch: occupancy query says %d\n", per_cu); }
        (void)hipGetLastError();
        grid = cus;
    }
    if (grid < 0) return;
    (void)hipMemsetAsync((char*)d_ws + WS_CTL, 0, CTL_BYTES, stream);
    Args a{};
    for (int i = 0; i < 18; ++i) a.in[i] = (const float*)d_in[i];
    a.out = (float*)d_out; a.ws = (unsigned char*)d_ws;
#if MK_ONE_LAUNCH
    a.ph_lo = 0; a.ph_hi = DEPTH * 10;
    hipLaunchKernelGGL(mega, dim3(grid), dim3(512), LDS_BYTES, stream, a);
#else
    for (int p = 0; p < DEPTH * 10; ++p) { a.ph_lo = p; a.ph_hi = p + 1; hipLaunchKernelGGL(mega, dim3(grid), dim3(512), LDS_BYTES, stream, a); }
#endif
}
```

```cpp
#include <hip/hip_runtime.h>
#include <stdint.h>
#include <stdio.h>

#ifndef MK_ONE_LAUNCH
#define MK_ONE_LAUNCH 1
#endif
#ifndef MK_PHASE_MASK
#define MK_PHASE_MASK 0x3ff
#endif
#ifndef MK_PROBE
#define MK_PROBE -1
#endif
#ifndef MK_STAGGER
#define MK_STAGGER 0
#endif
#ifndef MK_DIAG
#define MK_DIAG 0
#endif
#ifndef MK_BUILD_MASK
#define MK_BUILD_MASK 0x3ff
#endif

#define LAS __attribute__((address_space(3)))
typedef unsigned short bf16_t;
typedef short bf16x8 __attribute__((ext_vector_type(8)));
typedef short s16x4 __attribute__((ext_vector_type(4)));
typedef float f32x4 __attribute__((ext_vector_type(4)));
typedef float f32x16 __attribute__((ext_vector_type(16)));
typedef float f32x2 __attribute__((ext_vector_type(2)));
typedef unsigned u32x4 __attribute__((ext_vector_type(4)));
typedef unsigned u32x2 __attribute__((ext_vector_type(2)));
typedef __bf16 bfv2 __attribute__((ext_vector_type(2)));

constexpr int DM = 2048, NB = 16, T = 2048, DEPTH = 4, M = NB * T, HD = 128;
constexpr int INC = 15896;
constexpr int NPC = 16128;
constexpr int PQN = 0, PKC = 1024, PVC = 1280, PKS = 1536, PVS = 1792, PKW = 2048, PVW = 2304, PQS = 2560, PKSB = 3584, PVSB = 4608,
              PQH = 5632, PFH = 6656, PIH = 7680, PGH = 8704, PGT = 9728, PGN = 15872;
constexpr int DFF = 5632, NUP = 2 * DFF;
constexpr int BW = 1024;
constexpr float EPS = 1e-6f;
constexpr float LOG2E = 1.4426950408889634f, LN2 = 0.6931471805599453f;
constexpr float QSCALE = 0.08838834764831845f;

constexpr size_t MiB = 1u << 20;
constexpr size_t WS_CTL = 0, CTL_BYTES = 1 * MiB;
constexpr size_t WS_WIN = 1 * MiB, WS_WBR = 64 * MiB, WS_WOUT = 76 * MiB, WS_WUP = 84 * MiB, WS_WDN = 128 * MiB;
constexpr size_t WS_MISC = 150 * MiB;
constexpr size_t MISC_KCMP = 0, MISC_VCMP = 1 * MiB, MISC_WC1 = 2 * MiB;
constexpr int CW_CVEC = 32768;
constexpr size_t WS_SCR = 154 * MiB;
constexpr size_t WS_P = 218 * MiB;
constexpr size_t WS_H = 1226 * MiB;
constexpr size_t WS_OBR = 1354 * MiB;
constexpr size_t WS_ORAW = 1546 * MiB;
constexpr size_t WS_XB = 1674 * MiB;
constexpr size_t WS_SSQ = 1802 * MiB;
constexpr size_t WS_RSTD = 1806 * MiB;
constexpr size_t WS_USIDE = 1807 * MiB;
constexpr size_t WS_END = 1853 * MiB;
constexpr size_t WS_ACT = WS_P + 704 * MiB;
constexpr int CW_BAR = 4096;
constexpr int CW_QUEUE = 16384;

constexpr int RING_BYTES = 131072;
constexpr int MISC_OFF = 147456 - 256;
constexpr int LDS_BYTES = 147456;

__device__ __forceinline__ float bf2f(unsigned short b) { return __uint_as_float(((unsigned)b) << 16); }
__device__ __forceinline__ float bflo(unsigned w) { return __uint_as_float(w << 16); }
__device__ __forceinline__ float bfhi(unsigned w) { return __uint_as_float(w & 0xffff0000u); }
__device__ __forceinline__ unsigned pk2(float lo, float hi) { f32x2 v = {lo, hi}; bfv2 b = __builtin_convertvector(v, bfv2); return __builtin_bit_cast(unsigned, b); }
__device__ __forceinline__ float wave_sum(float v) {
#pragma unroll
    for (int o = 1; o < 64; o <<= 1) v += __shfl_xor(v, o);
    return v;
}
__device__ __forceinline__ float fast_exp2(float x) { return __builtin_amdgcn_exp2f(x); }
__device__ __forceinline__ float fast_log2(float x) { return __builtin_amdgcn_logf(x); }
__device__ __forceinline__ float fast_rcp(float x) { return __builtin_amdgcn_rcpf(x); }
__device__ __forceinline__ float sigmoidf_(float x) { return fast_rcp(1.f + fast_exp2(-x * LOG2E)); }
#define LDS_WAIT() asm volatile("s_waitcnt lgkmcnt(0)" ::: "memory")
__device__ __forceinline__ size_t akm(size_t row, int col) { return ((size_t)(col >> 6) * M + row) * 64 + (col & 63); }

#define XB_TMO      128
#define XB_XCNT(j)  (256  + 64 * (j))
#define XB_XSUB(j)  (1280 + 64 * (j))
#define XB_XGEN(j)  (2304 + 64 * (j))
#define XB_TOP      3328
#define XB_TOPGEN   3392
#define XCD_BAR_WORDS 3456
#define XB_SPIN_CAP (1u << 22)
__device__ __forceinline__ unsigned xb_ld(unsigned* p)              { return __hip_atomic_load(p, __ATOMIC_RELAXED, __HIP_MEMORY_SCOPE_AGENT); }
__device__ __forceinline__ unsigned xb_add(unsigned* p, unsigned v) { return __hip_atomic_fetch_add(p, v, __ATOMIC_RELAXED, __HIP_MEMORY_SCOPE_AGENT); }
__device__ __forceinline__ unsigned xb_xcc_id() { return (unsigned)__builtin_amdgcn_s_getreg((3 << 11) | 20) & 0xFu; }
#define XB_SPIN(cond, bar) do { unsigned _sp = 0; while (cond) { __builtin_amdgcn_s_sleep(1); \
    if ((++_sp & 255u) == 0u) { if (xb_ld(&(bar)[XB_TMO])) break; if (_sp > XB_SPIN_CAP) { atomicAdd(&(bar)[XB_TMO], 1u); break; } } } } while (0)
struct XcdBarrier { unsigned* bar; unsigned x; volatile LAS unsigned* st; };
__device__ __forceinline__ XcdBarrier xcd_barrier_post(unsigned* bar, volatile LAS unsigned* st) {
    XcdBarrier b; b.bar = bar; b.x = xb_xcc_id(); b.st = st;
    if (threadIdx.x == 0) (void)xb_add(&bar[XB_XCNT(b.x)], 1u);
    return b;
}
__device__ __forceinline__ void xcd_barrier_complete(unsigned* bar, unsigned x, unsigned& nloc, unsigned& nx) {
    const unsigned G = gridDim.x * gridDim.y * gridDim.z;
    unsigned sum, cnt, mine, sp = 0u;
    for (;;) {
        sum = 0u; cnt = 0u; mine = 0u;
#pragma unroll
        for (unsigned j = 0; j < 16; ++j) { const unsigned c = xb_ld(&bar[XB_XCNT(j)]); sum += c; cnt += (c > 0u) ? 1u : 0u; mine = (j == x) ? c : mine; }
        if (sum == G) break;
        __builtin_amdgcn_s_sleep(1);
        if ((++sp & 255u) == 0u) { if (xb_ld(&bar[XB_TMO])) break; if (sp > XB_SPIN_CAP) { atomicAdd(&bar[XB_TMO], 1u); break; } }
    }
    nloc = mine > 0u ? mine : 1u; nx = cnt > 0u ? cnt : 1u;
}
__device__ __forceinline__ void xcd_barrier(const XcdBarrier& b) {
    asm volatile("s_waitcnt vmcnt(0)" ::: "memory");
    __syncthreads();
    if (threadIdx.x == 0) {
        unsigned* bar = b.bar;
        __builtin_amdgcn_s_waitcnt(0);
        unsigned nloc = b.st[0], nx = b.st[1];
        if (nloc == 0u) { xcd_barrier_complete(bar, b.x, nloc, nx); b.st[0] = nloc; b.st[1] = nx; }
        const unsigned old = xb_add(&bar[XB_XSUB(b.x)], 1u);
        const unsigned gen = old / nloc;
        if (old + 1u == (gen + 1u) * nloc) {
            __builtin_amdgcn_fence(__ATOMIC_RELEASE, "agent");
            asm volatile("s_waitcnt vmcnt(0)" ::: "memory");
            const unsigned og = xb_add(&bar[XB_TOP], 1u);
            const unsigned tg = og / nx;
            if (og + 1u == (tg + 1u) * nx) xb_add(&bar[XB_TOPGEN], 1u);
            else XB_SPIN(xb_ld(&bar[XB_TOPGEN]) == tg, bar);
            __builtin_amdgcn_fence(__ATOMIC_ACQUIRE, "agent");
            xb_add(&bar[XB_XGEN(b.x)], 1u);
            asm volatile("s_waitcnt vmcnt(0)" ::: "memory");
        } else {
            XB_SPIN(xb_ld(&bar[XB_XGEN(b.x)]) == gen, bar);
            __builtin_amdgcn_fence(__ATOMIC_ACQUIRE, "agent");
            asm volatile("s_waitcnt vmcnt(0)" ::: "memory");
        }
    }
    __syncthreads();
}

struct Args { const float* in[18]; float* out; unsigned char* ws; int ph_lo, ph_hi; };
typedef const __attribute__((address_space(4))) Args* KArgs;
enum { I_X = 0, I_NATT, I_WIN, I_QG, I_KG, I_CPOS, I_CW1, I_CW2, I_RELB, I_HLB, I_HNG, I_WBR, I_WOUT, I_NFFN, I_WUP, I_CONVW, I_CONVB, I_WDN };
namespace pg8 {
constexpr int BM = 256, BK = 64, HALF = 128, HTB = HALF * BK * 2, STAGE_BYTES = 8 * HTB, NXCD = 8, LRS_OFF = STAGE_BYTES;
__host__ __device__ __forceinline__ int lds_byte(int r, int c) { const int st = (r >> 4) * 2 + (c >> 5), rr = r & 15, cc = c & 31, ob = rr * 64 + cc * 2; return st * 1024 + (ob ^ (((ob >> 9) & 1) << 5)); }
__host__ __device__ __forceinline__ void stage_rc(int b, int& R, int& C) { const int st = b / 1024, sb = b % 1024, swz = sb ^ (((sb >> 9) & 1) << 5); R = (st >> 1) * 16 + swz / 64; C = (st & 1) * 32 + (swz % 64) / 2; }
__host__ __device__ __forceinline__ int perm32(int rho) { const int n = rho >> 4, i = rho & 15; return 8 * (i >> 2) + 4 * n + (i & 3); }
struct Unit { int pm, pn, aux; };
constexpr int WCS = 64, BJS = 32;
struct Gemm { const bf16_t* A; const bf16_t* Bt; int M, N, K; int akm, bkm; };
struct StaticOrder {
    int nM, nN, nwg, G, c, WGM, rev;
    int pad_;
    __device__ void init(int M_, int N_, int G_, int c_, int wgm = 4, int rev_ = 0) { nM = M_ / BM; nN = N_ / BM; nwg = nM * nN; G = G_; c = c_; WGM = wgm; rev = rev_; pad_ = 0; }
    __device__ __forceinline__ bool tile(long L, Unit& u) const {
        if (L >= nwg) return false;
        int wgid = (int)L; { const int q = nwg / NXCD, r = nwg % NXCD, xcd = wgid % NXCD, off = wgid / NXCD; wgid = (xcd < r ? xcd * (q + 1) : r * (q + 1) + (xcd - r) * q) + off; }
        const int nig = WGM * nN, gid = wgid / nig, fm = gid * WGM, gsz = (nM - fm) < WGM ? (nM - fm) : WGM;
        u.pm = fm + ((wgid % nig) % gsz); u.pn = (wgid % nig) / gsz; u.aux = 0; if (rev) u.pm = nM - 1 - u.pm; return true;
    }
    __device__ __forceinline__ bool next(int i, Unit& u) const { return tile((long)i * G + c, u); }
    __device__ __forceinline__ const char* aptr(const Gemm& g, const Unit& u, size_t tstep) const { return (const char*)g.A + (size_t)u.pm * tstep; }
    __device__ __forceinline__ const char* bptr(const Gemm& g, const Unit& u, size_t tstep) const { return (const char*)g.Bt + (size_t)u.pn * tstep; }
    __device__ __forceinline__ void a_ready(const Unit&) const {}
    __device__ __forceinline__ void done(const Unit&) const {}
};
struct EpiStoreBf16 {
    static constexpr bool PERM = true, AFTER_DRAIN = false;
    static constexpr bool BPERM2 = true;
    static constexpr int PF_WAVES = 1;
    __device__ __forceinline__ void prefetch(LAS unsigned char* lds, const Unit& u, int wid, int lane) const {
        unsigned l16 = (unsigned)lane * 16u; asm volatile("" : "+v"(l16));
        __builtin_amdgcn_global_load_lds((const unsigned*)((const char*)rs + (size_t)u.pm * (BM * 4) + l16), (LAS unsigned*)(lds + LRS_OFF), 16, 0, 0); }
    static constexpr bool LDS_RS = true;
    bf16_t* O; int ldc; int sg_lo, sg_hi; const float* rs; LAS const float* lrs;
    __device__ __forceinline__ void operator()(const f32x4 (&acc)[2][2][4][2], const Unit& u, int wr, int wc, int fr, int fq) const {
        const int row0 = u.pm * BM + wr * 64 + fr, col0 = u.pn * BM + wc * WCS + 8 * fq; const bool sg = u.pn >= sg_lo && u.pn < sg_hi;
        float rsv[8];
#pragma unroll
        for (int g = 0; g < 8; ++g) rsv[g] = lrs[wr * 64 + fr + (g >> 2) * HALF + (g & 3) * 16];
#pragma unroll
        for (int ai = 0; ai < 2; ++ai)
#pragma unroll
            for (int m = 0; m < 4; ++m) { bf16_t* rowp = O + (size_t)(row0 + ai * HALF + m * 16) * ldc + col0;
                bf16_t* rowg = O + (size_t)(u.pm * BM + (ai * 4 + m) * 32 + (wr * 4 + wc) * 2 + (fq >> 1)) * ldc + u.pn * BM + ((fq & 1) * 16 + fr) * 8;
#pragma unroll
                for (int bj = 0; bj < 2; ++bj) { f32x4 v0 = acc[ai][bj][m][0] * rsv[ai * 4 + m], v1 = acc[ai][bj][m][1] * rsv[ai * 4 + m];
                    if (sg) {
#pragma unroll
                        for (int e = 0; e < 4; ++e) { v0[e] = sigmoidf_(v0[e]); v1[e] = sigmoidf_(v1[e]); } }
                    u32x4 w; w.x = pk2(v0[0], v0[1]); w.y = pk2(v0[2], v0[3]); w.z = pk2(v1[0], v1[1]); w.w = pk2(v1[2], v1[3]);
                    __builtin_nontemporal_store(w, (u32x4*)(sg ? rowg + (size_t)(bj * 16) * ldc : rowp + bj * BJS)); } }
    }
};
struct EpiConvAct {
    static constexpr bool PERM = true, AFTER_DRAIN = false, NO_RELAX = true;
    static constexpr bool LDS_RS = true;
    static constexpr bool APERM = true;
    static constexpr int PF_WAVES = 4;
    __device__ __forceinline__ void prefetch(LAS unsigned char* lds, const Unit& u, int wid, int lane) const {
        unsigned l_ = (unsigned)lane; asm volatile("" : "+v"(l_));
        const float* rs = (const float*)(ws + WS_RSTD); const float* cw = a->in[I_CONVW] + (size_t)layer * 3 * NUP; const float* cb = a->in[I_CONVB] + (size_t)layer * NUP;
        if (wid == 0) __builtin_amdgcn_global_load_lds((const unsigned*)((const char*)rs + (size_t)u.pm * (BM * 4) + l_ * 16u), (LAS unsigned*)(lds + LRS_OFF), 16, 0, 0);
        const unsigned sg = 2u * (unsigned)wid + (l_ >> 5), tap = sg & 3u;
        const float* src = (tap < 3u ? cw + (size_t)tap * NUP : cb) + (size_t)(sg >> 2) * DFF + (size_t)u.pn * 128 + (l_ & 31u) * 4u;
        __builtin_amdgcn_global_load_lds((const unsigned*)src, (LAS unsigned*)(lds + LRS_OFF + 1024 + wid * 1024), 16, 0, 0); }
    unsigned char* ws; KArgs a; int layer; LAS const float* lrs;
    static __device__ __forceinline__ f32x4 shr1(const f32x4 v) {
        f32x4 r;
#pragma unroll
        for (int e = 0; e < 4; ++e) r[e] = __int_as_float(__builtin_amdgcn_update_dpp(0, __float_as_int(v[e]), 0x111, 0xf, 0xf, true));
        return r; }
    __device__ __forceinline__ void operator()(const f32x4 (&acc)[2][2][4][2], const Unit& u, int wr, int wc, int fr, int fq) const {
        const int row0 = u.pm * BM + wr * 64 + 4 * fr, ch0 = u.pn * 128 + wc * 32 + 8 * fq;
        bf16_t* ACT = (bf16_t*)(ws + WS_ACT); bf16_t* side = (bf16_t*)(ws + WS_USIDE);
        f32x4 rsv[2];
#pragma unroll
        for (int ai = 0; ai < 2; ++ai) rsv[ai] = *(const LAS f32x4*)(lrs + ai * HALF + wr * 64 + 4 * fr);
        if (fr == 0 || fr == 15) {
            const bool lo = fr == 0;
#pragma unroll
            for (int ai = 0; ai < 2; ++ai) { const int blk = (u.pm * BM + ai * HALF + wr * 64) >> 6;
#pragma unroll
                for (int s2 = 0; s2 < 2; ++s2) { const float r_ = lo ? rsv[ai][s2] : rsv[ai][2 + s2];
                    bf16_t* sp = side + ((size_t)blk * 4 + (lo ? s2 : 2 + s2)) * NUP + u.pn * 256 + wc * 32 + 8 * fq;
#pragma unroll
                    for (int bj = 0; bj < 2; ++bj) { const f32x4 l0 = acc[ai][bj][s2][0], h0 = acc[ai][bj][2 + s2][0], l1 = acc[ai][bj][s2][1], h1 = acc[ai][bj][2 + s2][1]; f32x4 a0, a1;
#pragma unroll
                        for (int e = 0; e < 4; ++e) { a0[e] = (lo ? l0[e] : h0[e]) * r_; a1[e] = (lo ? l1[e] : h1[e]) * r_; }
                        *(u32x4*)(sp + bj * HALF) = (u32x4){pk2(a0[0], a0[1]), pk2(a0[2], a0[3]), pk2(a1[0], a1[1]), pk2(a1[2], a1[3])}; } } }
        }
        __builtin_amdgcn_sched_barrier(0);
#pragma unroll
        for (int ai = 0; ai < 2; ++ai) {
            u32x2 keep[4];
#pragma unroll
            for (int n = 0; n < 2; ++n) {
                LAS const float* lw = lrs + 256 + wc * 32 + 8 * fq + 4 * n;
                f32x4 sg[4];
                { const f32x4 w0 = *(const LAS f32x4*)(lw), w1 = *(const LAS f32x4*)(lw + 128), w2 = *(const LAS f32x4*)(lw + 256), bb = *(const LAS f32x4*)(lw + 384);
                  const f32x4 x0 = acc[ai][0][0][n] * rsv[ai][0], x1 = acc[ai][0][1][n] * rsv[ai][1], x2 = acc[ai][0][2][n] * rsv[ai][2], x3 = acc[ai][0][3][n] * rsv[ai][3];
                  const f32x4 p1 = shr1(x3), p2 = shr1(x2);
                  const f32x4 c0 = bb + w0 * p2 + w1 * p1 + w2 * x0, c1 = bb + w0 * p1 + w1 * x0 + w2 * x1, c2 = bb + w0 * x0 + w1 * x1 + w2 * x2, c3 = bb + w0 * x1 + w1 * x2 + w2 * x3;
#pragma unroll
                  for (int e = 0; e < 4; ++e) { sg[0][e] = c0[e] * sigmoidf_(c0[e]); sg[1][e] = c1[e] * sigmoidf_(c1[e]); sg[2][e] = c2[e] * sigmoidf_(c2[e]); sg[3][e] = c3[e] * sigmoidf_(c3[e]); } }
                __builtin_amdgcn_sched_barrier(0);
                { const f32x4 w0 = *(const LAS f32x4*)(lw + 512), w1 = *(const LAS f32x4*)(lw + 640), w2 = *(const LAS f32x4*)(lw + 768), bb = *(const LAS f32x4*)(lw + 896);
                  const f32x4 x0 = acc[ai][1][0][n] * rsv[ai][0], x1 = acc[ai][1][1][n] * rsv[ai][1], x2 = acc[ai][1][2][n] * rsv[ai][2], x3 = acc[ai][1][3][n] * rsv[ai][3];
                  const f32x4 p1 = shr1(x3), p2 = shr1(x2);
                  f32x4 cv[4]; cv[0] = bb + w0 * p2 + w1 * p1 + w2 * x0; cv[1] = bb + w0 * p1 + w1 * x0 + w2 * x1; cv[2] = bb + w0 * x0 + w1 * x1 + w2 * x2; cv[3] = bb + w0 * x1 + w1 * x2 + w2 * x3;
#pragma unroll
                  for (int m = 0; m < 4; ++m) { const f32x4 act = sg[m] * cv[m];
                      u32x2 w; w.x = pk2(act[0], act[1]); w.y = pk2(act[2], act[3]);
                      if (n == 0) keep[m] = w;
                      else *(u32x4*)(ACT + ((size_t)(ch0 >> 6) * M + (size_t)(row0 + ai * HALF + m)) * 64 + (ch0 & 63)) = (u32x4){keep[m].x, keep[m].y, w.x, w.y}; } }
                __builtin_amdgcn_sched_barrier(0);
            }
        }
    }
};
#ifndef ER_DEPTH
#define ER_DEPTH 4
#endif
struct EpiResidBf16 {
    static constexpr bool BPERM2 = true;
    static constexpr bool PERM = true, AFTER_DRAIN = false;
    bf16_t* XB; float* Cout; float* ssq; int ldc;
    __device__ __forceinline__ void operator()(const f32x4 (&acc)[2][2][4][2], const Unit& u, int wr, int wc, int fr, int fq) const {
        const int row0 = u.pm * BM + wr * 64 + fr, col0 = u.pn * BM + wc * WCS + 8 * fq;
        u32x4 old[ER_DEPTH][2]; float ssv[8];
#define ER_ROWI(g) (row0 + ((g) >> 2) * HALF + ((g) & 3) * 16)
#define ER_LOAD(g) do { old[(g) % ER_DEPTH][0] = *(const u32x4*)(XB + akm(ER_ROWI(g), col0)); old[(g) % ER_DEPTH][1] = *(const u32x4*)(XB + akm(ER_ROWI(g), col0 + BJS)); } while (0)
#pragma unroll
        for (int g = 0; g < ER_DEPTH; ++g) ER_LOAD(g);
#pragma unroll
        for (int g = 0; g < 8; ++g) {
            asm volatile("" ::: "memory");
            const size_t ro = (size_t)ER_ROWI(g) * ldc + col0; float ss = 0.f;
#pragma unroll
            for (int bj = 0; bj < 2; ++bj) { const u32x4 o_ = old[g % ER_DEPTH][bj];
                f32x4 v0 = acc[g >> 2][bj][g & 3][0], v1 = acc[g >> 2][bj][g & 3][1];
                v0[0] += bflo(o_.x); v0[1] += bfhi(o_.x); v0[2] += bflo(o_.y); v0[3] += bfhi(o_.y); v1[0] += bflo(o_.z); v1[1] += bfhi(o_.z); v1[2] += bflo(o_.w); v1[3] += bfhi(o_.w);
                if (Cout) { *(f32x4*)(Cout + ro + bj * BJS) = v0; *(f32x4*)(Cout + ro + bj * BJS + 4) = v1; }
                else { u32x4 w; w.x = pk2(v0[0], v0[1]); w.y = pk2(v0[2], v0[3]); w.z = pk2(v1[0], v1[1]); w.w = pk2(v1[2], v1[3]); *(u32x4*)(XB + akm(ER_ROWI(g), col0 + bj * BJS)) = w;
                    const float r0 = bflo(w.x), r1 = bfhi(w.x), r2 = bflo(w.y), r3 = bfhi(w.y), r4 = bflo(w.z), r5 = bfhi(w.z), r6 = bflo(w.w), r7 = bfhi(w.w);
                    ss += ((r0 * r0 + r1 * r1) + (r2 * r2 + r3 * r3)) + ((r4 * r4 + r5 * r5) + (r6 * r6 + r7 * r7)); } }
            ssv[g] = ss;
            if (g + ER_DEPTH < 8) ER_LOAD(g + ER_DEPTH);
        }
        if (!Cout) {
#pragma unroll
            for (int g = 0; g < 8; ++g) ssv[g] += __shfl_xor(ssv[g], 16);
#pragma unroll
            for (int g = 0; g < 8; ++g) ssv[g] += __shfl_xor(ssv[g], 32);
            if (fq == 0) {
#pragma unroll
                for (int g = 0; g < 8; ++g) ssq[(size_t)ER_ROWI(g) * 32 + u.pn * 4 + wc] = ssv[g]; } }
#undef ER_ROWI
#undef ER_LOAD
    }
};
struct EpiGated {
    static constexpr bool PERM = true, AFTER_DRAIN = false, HOOK = true, BPERM2 = true; static constexpr int HOOK_KT = 16;
    const bf16_t* P; bf16_t* merged;
    static __device__ __forceinline__ float gl(unsigned w) { return fmaxf(bflo(w), 1e-30f); }
    static __device__ __forceinline__ float gh(unsigned w) { return fmaxf(bfhi(w), 1e-30f); }
    __device__ __forceinline__ void mid(f32x4 (&acc)[2][2][4][2], const Unit& u, int wr, int wc, int fr, int fq, int s) const {
        const unsigned grow0 = (unsigned)(u.pm * BM + (wr * 4 + wc) * 2 + (fq >> 1)), gcol0 = (unsigned)(u.pn * BM + ((fq & 1) * 16 + fr) * 8);
        const char* Pa = (const char*)(P + PGT + (s - 1) * DM); const char* Pb = (const char*)(P + PGT + s * DM);
#pragma unroll
        for (int hf = 0; hf < 2; ++hf) {
            u32x4 ga[4][2], gb[4][2];
#pragma unroll
            for (int gg = 0; gg < 4; ++gg) { const int g = hf * 4 + gg; const unsigned po = ((grow0 + (unsigned)(g * 32)) * (unsigned)NPC + gcol0) * 2u;
#pragma unroll
                for (int bj = 0; bj < 2; ++bj) { ga[gg][bj] = *(const u32x4*)(Pa + (size_t)(po + bj * (16u * NPC * 2u))); gb[gg][bj] = *(const u32x4*)(Pb + (size_t)(po + bj * (16u * NPC * 2u))); } }
#pragma unroll
            for (int gg = 0; gg < 4; ++gg) { const int g = hf * 4 + gg;
#pragma unroll
                for (int bj = 0; bj < 2; ++bj) { const u32x4 a_ = ga[gg][bj], b_ = gb[gg][bj];
                    f32x4& v0 = acc[g >> 2][bj][g & 3][0]; f32x4& v1 = acc[g >> 2][bj][g & 3][1];
                    v0[0] *= gl(a_.x) * fast_rcp(gl(b_.x)); v0[1] *= gh(a_.x) * fast_rcp(gh(b_.x)); v0[2] *= gl(a_.y) * fast_rcp(gl(b_.y)); v0[3] *= gh(a_.y) * fast_rcp(gh(b_.y));
                    v1[0] *= gl(a_.z) * fast_rcp(gl(b_.z)); v1[1] *= gh(a_.z) * fast_rcp(gh(b_.z)); v1[2] *= gl(a_.w) * fast_rcp(gl(b_.w)); v1[3] *= gh(a_.w) * fast_rcp(gh(b_.w)); } }
            asm volatile("" ::: "memory"); }
    }
    __device__ __forceinline__ void operator()(const f32x4 (&acc)[2][2][4][2], const Unit& u, int wr, int wc, int fr, int fq) const {
        const unsigned row0 = (unsigned)(u.pm * BM + wr * 64 + fr), col0 = (unsigned)(u.pn * BM + wc * WCS + 8 * fq);
        const char* Pg = (const char*)(P + PGT + 2 * DM); char* mg = (char*)merged;
        u32x4 gw[8][2];
        const unsigned grow0 = (unsigned)(u.pm * BM + (wr * 4 + wc) * 2 + (fq >> 1)), gcol0 = (unsigned)(u.pn * BM + ((fq & 1) * 16 + fr) * 8);
#pragma unroll
        for (int g = 0; g < 8; ++g) { const unsigned po = ((grow0 + (unsigned)(g * 32)) * (unsigned)NPC + gcol0) * 2u;
#pragma unroll
            for (int bj = 0; bj < 2; ++bj) gw[g][bj] = *(const u32x4*)(Pg + (size_t)(po + bj * (16u * NPC * 2u))); }
#pragma unroll
        for (int g = 0; g < 8; ++g) { const unsigned moff = ((row0 + (unsigned)((g >> 2) * HALF + (g & 3) * 16)) * (unsigned)DM + col0) * 2u;
#pragma unroll
            for (int bj = 0; bj < 2; ++bj) { const u32x4 w_ = gw[g][bj]; const f32x4 v0 = acc[g >> 2][bj][g & 3][0], v1 = acc[g >> 2][bj][g & 3][1];
                u32x4 w; w.x = pk2(v0[0] * gl(w_.x), v0[1] * gh(w_.x)); w.y = pk2(v0[2] * gl(w_.y), v0[3] * gh(w_.y)); w.z = pk2(v1[0] * gl(w_.z), v1[1] * gh(w_.z)); w.w = pk2(v1[2] * gl(w_.w), v1[3] * gh(w_.w));
                *(u32x4*)(merged + akm(row0 + (unsigned)((g >> 2) * HALF + (g & 3) * 16), (int)col0 + bj * BJS)) = w; } }
    }
};

template <class E, class = void> struct has_relax { static constexpr bool v = true; };
template <class E> struct has_relax<E, decltype((void)E::NO_RELAX)> { static constexpr bool v = false; };
template <class E, class = void> struct has_lrs { static constexpr bool v = false; };
template <class E> struct has_lrs<E, decltype((void)E::LDS_RS)> { static constexpr bool v = true; };
template <class E, class = void> struct has_aperm { static constexpr bool v = false; };
template <class E> struct has_aperm<E, decltype((void)E::APERM)> { static constexpr bool v = true; };
template <class E, class = void> struct has_bperm2 { static constexpr bool v = false; };
template <class E> struct has_bperm2<E, decltype((void)E::BPERM2)> { static constexpr bool v = true; };
template <class E, class = void> struct has_hook { static constexpr bool v = false; };
template <class E> struct has_hook<E, decltype((void)E::HOOK)> { static constexpr bool v = true; };
template <class Epi, class Sched, bool ALIGN_EPI = false, bool SP2 = false>
__device__ __forceinline__ void gemm_phase(LAS unsigned char* lds, const Gemm g, const Sched& S, const Epi& E, const int tid, unsigned long long* dg = nullptr) {
    float zf; asm volatile("v_mov_b32 %0, 0" : "=v"(zf));
    const int wid = __builtin_amdgcn_readfirstlane(tid >> 6), lane = tid & 63, wr = wid >> 2, wc = wid & 3, fr = lane & 15, fq = lane >> 4;
    const int K = g.K, nt = K / BK;
    unsigned voffA[2], voffB[2];
#pragma unroll
    for (int i = 0; i < 2; ++i) { int R, C; stage_rc(tid * 16 + i * 8192, R, C); const int Rb = has_bperm2<Epi>::v ? (2 * (R & ~31) + perm32(R & 31)) : (Epi::PERM ? ((R & ~31) + perm32(R & 31)) : R);
        const int Ra = has_aperm<Epi>::v ? ((R & ~63) + 4 * (R & 15) + ((R >> 4) & 3)) : R;
        voffA[i] = (unsigned)(Ra * (g.akm ? BK : K) + C) * 2u; voffB[i] = (unsigned)(Rb * (g.bkm ? BK : K) + C) * 2u; }
    const size_t kstep = (size_t)(BK * 2);
    const size_t hstep = (size_t)HALF * K * 2;
    const size_t tstep = 2 * hstep;
    const size_t kstepA = g.akm ? (size_t)g.M * BK * 2 : kstep, hstepA = g.akm ? (size_t)HALF * BK * 2 : hstep, tstepA = 2 * hstepA;
    const size_t kstepB = g.bkm ? (size_t)g.N * BK * 2 : kstep, hstepB = has_bperm2<Epi>::v ? (g.bkm ? (size_t)32 * BK * 2 : (size_t)32 * K * 2) : (g.bkm ? (size_t)HALF * BK * 2 : hstep), tstepB = g.bkm ? (size_t)BM * BK * 2 : tstep;
    const unsigned ldsw = (unsigned)wid * 1024u;
    const int aoff = lds_byte(wr * 64 + fr, fq * 8), boff = lds_byte(wc * 32 + fr, fq * 8);
#define PG8_SA(b, h) (((b) * 2 + (h)) * HTB)
#define PG8_SB(b, h) ((4 + (b) * 2 + (h)) * HTB)
#define PG8_STAGE(bufoff, gbase, voff) do { _Pragma("unroll") for (int _i = 0; _i < 2; ++_i) \
        __builtin_amdgcn_global_load_lds((const unsigned*)((const char*)(gbase) + (voff)[_i]), (LAS unsigned*)(lds + (bufoff) + ldsw + _i * 8192), 16, 0, 0); } while (0)
#define PG8_LDA(dst, b, h) do { _Pragma("unroll") for (int m = 0; m < 4; ++m) _Pragma("unroll") for (int k = 0; k < 2; ++k) dst[m][k] = *(const LAS bf16x8*)(lds + PG8_SA(b, h) + aoff + m * 2048 + k * 1024); } while (0)
#define PG8_LDB(dst, b, h) do { _Pragma("unroll") for (int n = 0; n < 2; ++n) _Pragma("unroll") for (int k = 0; k < 2; ++k) dst[n][k] = *(const LAS bf16x8*)(lds + PG8_SB(b, h) + boff + n * 2048 + k * 1024); } while (0)
#define PG8_MMA(ai, bj, At, Bt) do { __builtin_amdgcn_s_setprio(1); _Pragma("unroll") for (int m = 0; m < 4; ++m) _Pragma("unroll") for (int n = 0; n < 2; ++n) _Pragma("unroll") for (int k = 0; k < 2; ++k) \
        acc[ai][bj][m][n] = __builtin_amdgcn_mfma_f32_16x16x32_bf16(Bt[n][k], At[m][k], acc[ai][bj][m][n], 0, 0, 0); __builtin_amdgcn_s_setprio(0); } while (0)
#define PG8_WAIT_V(n) asm volatile("s_waitcnt vmcnt(" #n ")" ::: "memory")
#define PG8_WAIT_L(n) asm volatile("s_waitcnt lgkmcnt(" #n ")" ::: "memory")
#define PG8_BAR __builtin_amdgcn_s_barrier()
#define PG8_SCHED __builtin_amdgcn_sched_barrier(0)
    Unit cur, nxt; int ui = 0;
    if (!S.next(0, cur)) return;
    f32x4 acc[2][2][4][2];
#pragma unroll
    for (int a = 0; a < 2; ++a)
#pragma unroll
        for (int b = 0; b < 2; ++b)
#pragma unroll
            for (int m = 0; m < 4; ++m)
#pragma unroll
                for (int n = 0; n < 2; ++n) acc[a][b][m][n] = (f32x4){zf, zf, zf, zf};
    bf16x8 At[4][2], B0[2][2], B1[2][2];
    const char* cA = S.aptr(g, cur, tstepA); const char* cB = S.bptr(g, cur, tstepB);
    S.a_ready(cur);
    if constexpr (SP2) {
        PG8_STAGE(PG8_SB(0, 0), cB, voffB); PG8_STAGE(PG8_SB(0, 1), cB + hstepB, voffB); PG8_STAGE(PG8_SA(0, 0), cA, voffA); PG8_STAGE(PG8_SA(0, 1), cA + hstepA, voffA);
        if (wr == 1) PG8_BAR;
        PG8_WAIT_V(2); PG8_BAR;
        PG8_STAGE(PG8_SB(1, 0), cB + kstepB, voffB); PG8_STAGE(PG8_SA(1, 0), cA + kstepA, voffA); PG8_STAGE(PG8_SB(1, 1), cB + hstepB + kstepB, voffB);
        PG8_WAIT_V(6); PG8_BAR;
    } else {
        PG8_STAGE(PG8_SB(0, 0), cB, voffB); PG8_STAGE(PG8_SA(0, 0), cA, voffA); PG8_STAGE(PG8_SB(0, 1), cB + hstepB, voffB); PG8_STAGE(PG8_SA(0, 1), cA + hstepA, voffA);
        if (wr == 1) PG8_BAR;
        PG8_WAIT_V(4); PG8_BAR;
        PG8_STAGE(PG8_SB(1, 0), cB + kstepB, voffB); PG8_STAGE(PG8_SA(1, 0), cA + kstepA, voffA); PG8_STAGE(PG8_SB(1, 1), cB + hstepB + kstepB, voffB);
        PG8_WAIT_V(6); PG8_BAR;
    }
    for (;;) {
        const bool has_next = S.next(ui + 1, nxt);
        if (MK_DIAG && dg && tid == 0 && (ui == 2 || ui == 3)) dg[(ui - 2) * 2] = wall_clock64();
        const char* nA = has_next ? S.aptr(g, nxt, tstepA) : cA; const char* nB = has_next ? S.bptr(g, nxt, tstepB) : cB;
        constexpr bool RELAX_ = has_relax<Epi>::v;
#define PG8_ITER(FIRST) do { \
            const bool last = (t == nt - 2); \
            const char* a1 = cA + (size_t)(t + 1) * kstepA; \
            const char* a2 = last ? nA : cA + (size_t)(t + 2) * kstepA; const char* b2 = last ? nB : cB + (size_t)(t + 2) * kstepB; \
            const char* a3 = a2 + kstepA; const char* b3 = b2 + kstepB; \
            if (last && has_next) S.a_ready(nxt); \
            PG8_LDB(B0, 0, 0); PG8_LDB(B1, 0, 1); PG8_SCHED; PG8_LDA(At, 0, 0); if (!(FIRST)) PG8_STAGE(PG8_SA(1, 1), a1 + hstepA, voffA); \
            if constexpr (has_lrs<Epi>::v) { if (t == 4 && wid < Epi::PF_WAVES) E.prefetch(lds, cur, wid, lane); } \
            if (FIRST) PG8_WAIT_V(24); else PG8_WAIT_V(8); PG8_WAIT_L(0); PG8_BAR; PG8_MMA(0, 0, At, B0); PG8_MMA(0, 1, At, B1); PG8_BAR; PG8_SCHED; \
            PG8_LDA(At, 0, 1); PG8_STAGE(PG8_SB(0, 0), b2, voffB); PG8_STAGE(PG8_SB(0, 1), b2 + hstepB, voffB); PG8_STAGE(PG8_SA(0, 0), a2, voffA); \
            if (FIRST) PG8_WAIT_V(24); else PG8_WAIT_V(8); PG8_WAIT_L(0); PG8_BAR; PG8_MMA(1, 0, At, B0); PG8_MMA(1, 1, At, B1); PG8_BAR; PG8_SCHED; \
            PG8_LDB(B0, 1, 0); PG8_LDB(B1, 1, 1); PG8_SCHED; PG8_LDA(At, 1, 0); PG8_STAGE(PG8_SA(0, 1), a2 + hstepA, voffA); \
            if (FIRST) PG8_WAIT_V(24); else PG8_WAIT_V(8); PG8_WAIT_L(0); PG8_BAR; PG8_MMA(0, 0, At, B0); PG8_MMA(0, 1, At, B1); PG8_BAR; PG8_SCHED; \
            PG8_LDA(At, 1, 1); PG8_STAGE(PG8_SB(1, 0), b3, voffB); PG8_STAGE(PG8_SB(1, 1), b3 + hstepB, voffB); PG8_STAGE(PG8_SA(1, 0), a3, voffA); \
            PG8_WAIT_V(8); PG8_WAIT_L(0); PG8_BAR; PG8_MMA(1, 0, At, B0); PG8_MMA(1, 1, At, B1); PG8_BAR; PG8_SCHED; \
            if constexpr (has_hook<Epi>::v) { if (t + 2 < nt && (t + 2) % Epi::HOOK_KT == 0) { int fr_ = fr, fq_ = fq; asm volatile("" : "+v"(fr_), "+v"(fq_)); const_cast<Epi&>(E).mid(acc, cur, wr, wc, fr_, fq_, (t + 2) / Epi::HOOK_KT); PG8_SCHED; } } \
            if (RELAX_ && last && has_next) { PG8_STAGE(PG8_SA(1, 1), a3 + hstepA, voffA); PG8_SCHED; }     \
        } while (0)
        int t = 0;
        if constexpr (RELAX_) { if (ui > 0) { PG8_ITER(1); t = 2; } }
        for (; t < nt; t += 2) { PG8_ITER(0); }
#undef PG8_ITER
        if (MK_DIAG && dg && tid == 0 && ui == 2) dg[1] = wall_clock64();
        if constexpr (ALIGN_EPI) { if (wr == 0) PG8_BAR; }
        if constexpr (!Epi::AFTER_DRAIN) { int fr_ = fr, fq_ = fq; asm volatile("" : "+v"(fr_), "+v"(fq_));
            E(acc, cur, wr, wc, fr_, fq_); S.done(cur); }
        if (!has_next) break;
#pragma unroll
        for (int a = 0; a < 2; ++a)
#pragma unroll
            for (int b = 0; b < 2; ++b)
#pragma unroll
                for (int m = 0; m < 4; ++m)
#pragma unroll
                    for (int n = 0; n < 2; ++n) acc[a][b][m][n] = (f32x4){zf, zf, zf, zf};
        cur = nxt; cA = nA; cB = nB; ++ui;
        if constexpr (ALIGN_EPI) { if (wr == 1) PG8_BAR; }
    }
    PG8_WAIT_V(0);
    if constexpr (!ALIGN_EPI) { if (wr == 0) PG8_BAR; }
    PG8_BAR;
#undef PG8_SA
#undef PG8_SB
#undef PG8_STAGE
#undef PG8_LDA
#undef PG8_LDB
#undef PG8_MMA
#undef PG8_WAIT_V
#undef PG8_WAIT_L
#undef PG8_BAR
#undef PG8_SCHED
}
}
#define PG8_SP2 true
#define PG8_ALIGN true


struct Frame {
    LAS unsigned char* lds; volatile LAS unsigned* MISC;
    unsigned* ctl; unsigned char* ws;
    int tid, lane, wave, G, bid;
};

__device__ __forceinline__ int up_src_col(int n) { const int pn = n >> 8, c = n & 255; return c < 128 ? 128 * pn + c : DFF + 128 * pn + (c - 128); }
__device__ __forceinline__ int inproj_src_col(int n) { return n < 2560 ? n : (n < 15872 ? n + 24 : (n < 15896 ? n - 15872 + 2560 : -1)); }
__device__ __forceinline__ void transpose_item(const float* W, int K, int Nsrc, bf16_t* WT, const float* gain, int mode, LAS float* scr, int item, int nblk, int lane, int ntot, int kbase = 0) {
    const int kb = item / nblk, nb = item - kb * nblk, k0 = 64 * kb, n0 = 32 * nb;
    const int nn = n0 + (lane & 7) * 4; const int sc = mode == 1 ? inproj_src_col(nn) : (mode == 2 ? up_src_col(nn) : nn);
    f32x4 v[8];
#pragma unroll
    for (int i = 0; i < 8; ++i) { const int kk = 8 * i + (lane >> 3); v[i] = sc >= 0 ? __builtin_nontemporal_load((const f32x4*)(W + (size_t)(k0 + kk) * Nsrc + sc)) : (f32x4){0.f, 0.f, 0.f, 0.f}; }
#pragma unroll
    for (int i = 0; i < 8; ++i) { const int kk = 8 * i + (lane >> 3); const float gk = gain ? gain[k0 + kk] : 1.f; LAS float* d = scr + kk * 33 + (lane & 7) * 4;
        d[0] = v[i].x * gk; d[1] = v[i].y * gk; d[2] = v[i].z * gk; d[3] = v[i].w * gk; }
    LDS_WAIT(); asm volatile("" ::: "memory");
    const int c = lane & 7;
#pragma unroll
    for (int j = 0; j < 4; ++j) { const int n = (lane >> 3) + 8 * j; const LAS float* sp = scr + (8 * c) * 33 + n;
        u32x4 o; o.x = pk2(sp[0 * 33], sp[1 * 33]); o.y = pk2(sp[2 * 33], sp[3 * 33]); o.z = pk2(sp[4 * 33], sp[5 * 33]); o.w = pk2(sp[6 * 33], sp[7 * 33]);
        if (ntot) *(u32x4*)(WT + ((size_t)((kbase + k0) >> 6) * ntot + (size_t)(n0 + n)) * 64 + 8 * c) = o;
        else *(u32x4*)(WT + (size_t)(n0 + n) * K + k0 + 8 * c) = o; }
    LDS_WAIT(); asm volatile("" ::: "memory");
}
__device__ __forceinline__ void rms_row0(const float* xin, bf16_t* XB, int m, float* rstd, int lane) {
    const f32x4* xr = (const f32x4*)xin + lane;
    f32x4 v[8]; float s = 0.f;
#pragma unroll
    for (int j = 0; j < 8; ++j) { v[j] = xr[64 * j]; s += (v[j].x * v[j].x + v[j].y * v[j].y) + (v[j].z * v[j].z + v[j].w * v[j].w); }
    s = wave_sum(s);
    if (lane == 0) *rstd = rsqrtf(s * (1.f / DM) + EPS);
#pragma unroll
    for (int j = 0; j < 8; ++j) { u32x2 w; w.x = pk2(v[j].x, v[j].y); w.y = pk2(v[j].z, v[j].w); *(u32x2*)(XB + akm((size_t)m, 4 * (lane + 64 * j))) = w; }
}
__device__ __forceinline__ void rstd_rows(Frame& F) {
    const float* ssq = (const float*)(F.ws + WS_SSQ); float* rstd = (float*)(F.ws + WS_RSTD);
    for (int row = F.bid * 512 + F.tid; row < M; row += F.G * 512) { const f32x4* p = (const f32x4*)(ssq + (size_t)row * 32); float s = 0.f;
#pragma unroll
        for (int j = 0; j < 8; ++j) { const f32x4 v = p[j]; s += (v.x + v.y) + (v.z + v.w); }
        rstd[row] = rsqrtf(s * (1.f / DM) + EPS); }
}

__device__ __forceinline__ void cvec_item(Frame& F, KArgs a, int layer, int j);
__device__ __forceinline__ void phase_A(Frame& F, KArgs a, int layer) {
    LAS float* scr = (LAS float*)(F.lds + F.wave * 16384);
    const int gw = F.bid * 8 + F.wave, NGW = F.G * 8;
    bf16_t* Wt_in = (bf16_t*)(F.ws + WS_WIN); bf16_t* Wt_br = (bf16_t*)(F.ws + WS_WBR); bf16_t* Wt_out = (bf16_t*)(F.ws + WS_WOUT);
    bf16_t* Wt_up = (bf16_t*)(F.ws + WS_WUP); bf16_t* Wt_dn = (bf16_t*)(F.ws + WS_WDN);
    const float* w_in = a->in[I_WIN] + (size_t)layer * DM * INC; const float* g_att = a->in[I_NATT] + layer * DM;
    const float* w_br = a->in[I_WBR] + (size_t)layer * 3 * BW * DM; const float* w_out = a->in[I_WOUT] + (size_t)layer * DM * DM;
    const float* w_up = a->in[I_WUP] + (size_t)layer * DM * NUP; const float* g_ffn = a->in[I_NFFN] + layer * DM;
    const float* w_dn = a->in[I_WDN] + (size_t)layer * DFF * DM;
    constexpr int I_IN = (DM / 64) * (NPC / 32), I_BR1 = (BW / 64) * (DM / 32), I_OUT = (DM / 64) * (DM / 32), I_UP = (DM / 64) * (NUP / 32), I_DN = (DFF / 64) * (DM / 32);
    constexpr int I_C1 = (4096 / 64) * (HD / 32);
    constexpr int NITEMS = I_IN + 3 * I_BR1 + I_OUT + I_UP + I_DN + 2 * I_C1;
    for (int it = gw; it < NITEMS; it += NGW) {
        int r = it;
        if (r < I_IN) { transpose_item(w_in, DM, INC, Wt_in, g_att, 1, scr, r, NPC / 32, F.lane, NPC); continue; } r -= I_IN;
        if (r < 3 * I_BR1) { const int n = r / I_BR1; r -= n * I_BR1; transpose_item(w_br + (size_t)n * BW * DM, BW, DM, Wt_br, nullptr, 0, scr, r, DM / 32, F.lane, DM, n * BW); continue; } r -= 3 * I_BR1;
        if (r < I_OUT) { transpose_item(w_out, DM, DM, Wt_out, nullptr, 0, scr, r, DM / 32, F.lane, DM); continue; } r -= I_OUT;
        if (r < I_UP) { transpose_item(w_up, DM, NUP, Wt_up, g_ffn, 2, scr, r, NUP / 32, F.lane, NUP); continue; } r -= I_UP;
        if (r < I_DN) { transpose_item(w_dn, DFF, DM, Wt_dn, nullptr, 0, scr, r, DM / 32, F.lane, DM); continue; } r -= I_DN;
        { const int j = r / I_C1; r -= j * I_C1; transpose_item(a->in[I_CW1] + (size_t)(layer * 2 + j) * 4096 * HD, 4096, HD, (bf16_t*)(F.ws + WS_MISC + MISC_WC1) + (size_t)j * HD * 4096, nullptr, 0, scr, r, HD / 32, F.lane, 0); }
    }
    if (F.bid < 64) cvec_item(F, a, layer, F.bid);
    if (layer == 0) { bf16_t* XB = (bf16_t*)(F.ws + WS_XB); float* rstd = (float*)(F.ws + WS_RSTD);
        for (int m = gw; m < M; m += NGW) rms_row0(a->in[I_X] + (size_t)m * DM, XB, m, rstd + m, F.lane); }
    else rstd_rows(F);
}
__device__ __forceinline__ void phase_F(Frame& F, KArgs a) { rstd_rows(F); }
__device__ __forceinline__ void phase_H(Frame& F, KArgs a, int layer) {
    const bf16_t* SD = (const bf16_t*)(F.ws + WS_USIDE); bf16_t* ACT = (bf16_t*)(F.ws + WS_ACT);
    const float* cw = a->in[I_CONVW] + (size_t)layer * 3 * NUP; const float* cb = a->in[I_CONVB] + (size_t)layer * NUP;
    constexpr int CG = DFF / 8, NTASK = (M / 64) * 2 * CG;
    for (int task = F.bid * 512 + F.tid; task < NTASK; task += F.G * 512) {
        const int cg = task % CG, rb = task / CG, rw = rb & 1, blk = rb >> 1; if ((blk & 31) == 0) continue;
        const int c0 = cg * 8, uc = 256 * (c0 >> 7) + (c0 & 127);
        const bf16_t* t2 = rw == 0 ? SD + ((size_t)(blk - 1) * 4 + 2) * NUP : SD + ((size_t)(blk - 1) * 4 + 3) * NUP;
        const bf16_t* t1 = rw == 0 ? SD + ((size_t)(blk - 1) * 4 + 3) * NUP : SD + ((size_t)blk * 4 + 0) * NUP;
        const bf16_t* t0 = SD + ((size_t)blk * 4 + rw) * NUP;
        const u32x4 g2 = *(const u32x4*)(t2 + uc), g1 = *(const u32x4*)(t1 + uc), g0 = *(const u32x4*)(t0 + uc), v2 = *(const u32x4*)(t2 + uc + 128), v1 = *(const u32x4*)(t1 + uc + 128), v0 = *(const u32x4*)(t0 + uc + 128);
        const unsigned G2[4] = {g2.x, g2.y, g2.z, g2.w}, G1[4] = {g1.x, g1.y, g1.z, g1.w}, G0[4] = {g0.x, g0.y, g0.z, g0.w}, V2[4] = {v2.x, v2.y, v2.z, v2.w}, V1[4] = {v1.x, v1.y, v1.z, v1.w}, V0[4] = {v0.x, v0.y, v0.z, v0.w};
        float o[8];
#pragma unroll
        for (int e = 0; e < 8; ++e) { const int q = e >> 1; const bool hi = e & 1;
            const float xg2 = hi ? bfhi(G2[q]) : bflo(G2[q]), xg1 = hi ? bfhi(G1[q]) : bflo(G1[q]), xg0 = hi ? bfhi(G0[q]) : bflo(G0[q]);
            const float xv2 = hi ? bfhi(V2[q]) : bflo(V2[q]), xv1 = hi ? bfhi(V1[q]) : bflo(V1[q]), xv0 = hi ? bfhi(V0[q]) : bflo(V0[q]);
            const float cgv = cb[c0 + e] + cw[c0 + e] * xg2 + cw[NUP + c0 + e] * xg1 + cw[2 * NUP + c0 + e] * xg0;
            const float cvv = cb[DFF + c0 + e] + cw[DFF + c0 + e] * xv2 + cw[NUP + DFF + c0 + e] * xv1 + cw[2 * NUP + DFF + c0 + e] * xv0;
            o[e] = cgv * sigmoidf_(cgv) * cvv; }
        *(u32x4*)(ACT + ((size_t)(c0 >> 6) * M + (size_t)(blk * 64 + rw)) * 64 + (c0 & 63)) = (u32x4){pk2(o[0], o[1]), pk2(o[2], o[3]), pk2(o[4], o[5]), pk2(o[6], o[7])};
    }
}

__device__ __forceinline__ int q_next(Frame& F, unsigned* head) {
    __syncthreads();
    if (F.tid == 0) F.MISC[16] = __hip_atomic_fetch_add(head, 1u, __ATOMIC_RELAXED, __HIP_MEMORY_SCOPE_AGENT);
    __syncthreads();
    return __builtin_amdgcn_readfirstlane((int)F.MISC[16]);
}
__device__ __forceinline__ int t5_bucket(int n) {
    if (n < 16) return n;
    int b = 16;
    b += (n >= 19); b += (n >= 21); b += (n >= 24); b += (n >= 27); b += (n >= 31); b += (n >= 35); b += (n >= 40); b += (n >= 46);
    b += (n >= 52); b += (n >= 59); b += (n >= 67); b += (n >= 77); b += (n >= 87); b += (n >= 99); b += (n >= 113);
    return b;
}
__device__ __forceinline__ int crow(int i, int h) { return (i & 3) + 8 * (i >> 2) + 4 * h; }

#define MFMA32(a, b, c) __builtin_amdgcn_mfma_f32_32x32x16_bf16((a), (b), (c), 0, 0, 0)
__device__ __forceinline__ float sum8lanes(float v) { v += __shfl_xor(v, 1); v += __shfl_xor(v, 2); v += __shfl_xor(v, 4); return v; }
__device__ __forceinline__ void norm16(unsigned* pp, const float* gn, float sc) {
    const u32x4 w0 = *(const u32x4*)pp, w1 = *(const u32x4*)(pp + 4); const unsigned w[8] = {w0.x, w0.y, w0.z, w0.w, w1.x, w1.y, w1.z, w1.w};
    float x[16], ss = 0.f;
#pragma unroll
    for (int q = 0; q < 8; ++q) { x[2 * q] = bflo(w[q]); x[2 * q + 1] = bfhi(w[q]); ss += x[2 * q] * x[2 * q] + x[2 * q + 1] * x[2 * q + 1]; }
    const float r = rsqrtf(sum8lanes(ss) * (1.f / HD) + EPS) * sc;
    u32x4 o0, o1;
    o0.x = pk2(x[0] * r * gn[0], x[1] * r * gn[1]); o0.y = pk2(x[2] * r * gn[2], x[3] * r * gn[3]); o0.z = pk2(x[4] * r * gn[4], x[5] * r * gn[5]); o0.w = pk2(x[6] * r * gn[6], x[7] * r * gn[7]);
    o1.x = pk2(x[8] * r * gn[8], x[9] * r * gn[9]); o1.y = pk2(x[10] * r * gn[10], x[11] * r * gn[11]); o1.z = pk2(x[12] * r * gn[12], x[13] * r * gn[13]); o1.w = pk2(x[14] * r * gn[14], x[15] * r * gn[15]);
    *(u32x4*)pp = o0; *(u32x4*)(pp + 4) = o1;
}
__device__ __forceinline__ void item_norm(Frame& F, KArgs a, int layer, int it) {
    bf16_t* P = (bf16_t*)(F.ws + WS_P);
    const float* qg = a->in[I_QG] + layer * HD; const float* kg = a->in[I_KG] + layer * 3 * HD;
    const int lane = F.lane, e0 = (lane & 7) * 16;
    float gq[16], gk[16];
#pragma unroll
    for (int e = 0; e < 16; ++e) { gq[e] = qg[e0 + e]; gk[e] = kg[((lane >> 4) & 1 ? 2 : 1) * HD + e0 + e]; }
    for (int rr = 0; rr < 8; ++rr) {
        bf16_t* pr = P + (size_t)(it * 64 + F.wave * 8 + rr) * NPC;
        norm16((unsigned*)(pr + PQN + lane * 16), gq, QSCALE * LOG2E);
        if (lane < 32) norm16((unsigned*)(pr + (lane < 16 ? PKS + lane * 16 : PKW + (lane - 16) * 16)), gk, 1.f);
    }
}
__device__ __forceinline__ void item_hgfin(Frame& F, KArgs a, int layer, int it) {
    const bf16_t* P = (const bf16_t*)(F.ws + WS_P); const float* OR = (const float*)(F.ws + WS_ORAW); bf16_t* OH = (bf16_t*)(F.ws + WS_OBR) + 2 * BW;
    const float* ng = a->in[I_HNG] + layer * HD; const int lane = F.lane, e0 = (lane & 7) * 16;
    float gn[16];
#pragma unroll
    for (int e = 0; e < 16; ++e) gn[e] = ng[e0 + e];
    for (int rr = 0; rr < 8; ++rr) { const size_t row = (size_t)(it * 64 + F.wave * 8 + rr);
        const f32x4* op = (const f32x4*)(OR + row * BW + lane * 16); const f32x4 o0 = op[0], o1 = op[1], o2 = op[2], o3 = op[3];
        const unsigned* gp = (const unsigned*)(P + row * NPC + PGH + lane * 16); const u32x4 g0 = *(const u32x4*)gp, g1 = *(const u32x4*)(gp + 4);
        const float x[16] = {o0.x, o0.y, o0.z, o0.w, o1.x, o1.y, o1.z, o1.w, o2.x, o2.y, o2.z, o2.w, o3.x, o3.y, o3.z, o3.w}; const unsigned gw[8] = {g0.x, g0.y, g0.z, g0.w, g1.x, g1.y, g1.z, g1.w};
        float ss = 0.f;
#pragma unroll
        for (int e = 0; e < 16; ++e) ss += x[e] * x[e];
        const float r = rsqrtf(sum8lanes(ss) * (1.f / HD) + EPS);
        unsigned ow[8];
#pragma unroll
        for (int q = 0; q < 8; ++q) ow[q] = pk2(x[2 * q] * r * gn[2 * q] * sigmoidf_(bflo(gw[q])), x[2 * q + 1] * r * gn[2 * q + 1] * sigmoidf_(bfhi(gw[q])));
        unsigned* dst = (unsigned*)(OH + row * (3 * BW) + lane * 16);
        *(u32x4*)dst = (u32x4){ow[0], ow[1], ow[2], ow[3]}; *(u32x4*)(dst + 4) = (u32x4){ow[4], ow[5], ow[6], ow[7]};
    }
}
__device__ __forceinline__ void cvec_item(Frame& F, KArgs a, int layer, int blk) {
    const int j = blk >> 5, ks = blk & 31;
    const float* pos = a->in[I_CPOS] + (size_t)(layer * 2 + j) * 32 * HD; const float* w1 = a->in[I_CW1] + (size_t)(layer * 2 + j) * 32 * HD * HD;
    LAS float* red = (LAS float*)F.lds; const int e = F.tid & 127, sub = F.tid >> 7;
    float acc = 0.f;
#pragma unroll 8
    for (int k = ks * 128 + sub * 32; k < ks * 128 + sub * 32 + 32; ++k) acc += pos[k] * w1[(size_t)k * HD + e];
    __syncthreads(); red[sub * 128 + e] = acc; __syncthreads();
    if (F.tid < 128) ((float*)(F.ctl + CW_CVEC))[(j * 32 + ks) * 128 + F.tid] = (red[F.tid] + red[128 + F.tid]) + (red[256 + F.tid] + red[384 + F.tid]);
    __syncthreads();
}
__device__ __forceinline__ void item_compress(Frame& F, KArgs a, int layer, int id) {
    const int j = id >> 7, rem = id & 127, b = rem >> 3, g = (rem >> 2) & 1, n0 = (rem & 3) * 32;
    const bf16_t* P = (const bf16_t*)(F.ws + WS_P);
    LAS float* red = (LAS float*)F.lds;
    LAS float* hid = (LAS float*)(F.lds + 16384);
    LAS float* outv = (LAS float*)(F.lds + 16384 + 32 * 132 * 4);
    const int tid = F.tid, lane = F.lane, wave = F.wave, r = lane & 31, h = lane >> 5, ct = wave & 3, kh = wave >> 2;
    f32x16 acc;
#pragma unroll
    for (int i = 0; i < 16; ++i) acc[i] = 0.f;
    {
        int trow = 16 * (n0 + r) + 16 * kh; const int tmax = T - 1;
        const bf16_t* Ab = P + (size_t)(b * T) * NPC + (j ? PVC : PKC) + g * HD + 8 * h;
        const bf16_t* Bb = (const bf16_t*)(F.ws + WS_MISC + MISC_WC1) + (size_t)(j * HD + 32 * ct + r) * 4096 + (size_t)(16 * kh) * HD + 8 * h;
        for (int l = 0; l < 16; ++l) { const int t = (trow + l) < tmax ? (trow + l) : tmax; const bf16_t* ap = Ab + (size_t)t * NPC; const bf16_t* bp = Bb + l * HD;
#pragma unroll
            for (int ds = 0; ds < 8; ++ds) { const bf16x8 av = *(const bf16x8*)(ap + 16 * ds), bv = *(const bf16x8*)(bp + 16 * ds); acc = MFMA32(av, bv, acc); } }
    }
    if (kh == 1) {
#pragma unroll
        for (int i = 0; i < 16; ++i) red[(ct * 16 + i) * 64 + lane] = acc[i]; }
    __syncthreads();
    if (kh == 0) { float cv = 0.f; { const float* cp = (const float*)(F.ctl + CW_CVEC) + (size_t)(j * 32) * 128 + 32 * ct + r;
#pragma unroll 8
        for (int q = 0; q < 32; ++q) cv += cp[q * 128]; }
#pragma unroll
        for (int i = 0; i < 16; ++i) { const float x = acc[i] + red[(ct * 16 + i) * 64 + lane] + cv;
            const float y = 0.7978845608028654f * (x + 0.044715f * x * x * x);
            const float th = 1.f - 2.f * fast_rcp(1.f + fast_exp2(2.f * y * LOG2E));
            hid[crow(i, h) * 132 + 32 * ct + r] = 0.5f * x * (1.f + th); } }
    __syncthreads();
    { const int e2 = tid & 127, ng = __builtin_amdgcn_readfirstlane(tid >> 7); const float* w2 = a->in[I_CW2] + (size_t)(layer * 2 + j) * HD * HD + e2;
      float o[8];
#pragma unroll
      for (int q = 0; q < 8; ++q) o[q] = 0.f;
      for (int k = 0; k < 128; k += 4) { const float w0 = w2[(size_t)k * HD], w1 = w2[(size_t)(k + 1) * HD], w2_ = w2[(size_t)(k + 2) * HD], w3 = w2[(size_t)(k + 3) * HD];
#pragma unroll
          for (int q = 0; q < 8; ++q) { const f32x4 hv = *(const LAS f32x4*)(hid + (8 * ng + q) * 132 + k); o[q] += (hv.x * w0 + hv.y * w1) + (hv.z * w2_ + hv.w * w3); } }
#pragma unroll
      for (int q = 0; q < 8; ++q) outv[(8 * ng + q) * 132 + e2] = o[q]; }
    __syncthreads();
    const float* kg0 = a->in[I_KG] + layer * 3 * HD;
#pragma unroll
    for (int q = 0; q < 4; ++q) { const int n = 4 * wave + q; float v0 = outv[n * 132 + 2 * lane], v1 = outv[n * 132 + 2 * lane + 1];
        if (j == 0) { const float ss = wave_sum(v0 * v0 + v1 * v1); const float rr = rsqrtf(ss * (1.f / HD) + EPS); v0 *= rr * kg0[2 * lane]; v1 *= rr * kg0[2 * lane + 1]; }
        if (n0 + n >= 127) { v0 = 0.f; v1 = 0.f; }
        bf16_t* dst = (bf16_t*)(F.ws + WS_MISC + (j ? MISC_VCMP : MISC_KCMP)) + (size_t)((b * 2 + g) * 128 + n0 + n) * HD;
        *((unsigned*)dst + lane) = pk2(v0, v1); }
}
__device__ __forceinline__ float xhalf_sum(float v);
constexpr int HG_Q1 = 0, HG_K1 = 17408, HG_QI = 34816, HG_K2 = 43520, HG_K3T = 52224, HG_VT = 70656, HG_AT = 89088, HG_SB = 98304, HG_TOT = 133120, HG_LB = 135168, HG_SS = 135680;
__device__ __forceinline__ void item_hgrn(Frame& F, KArgs a, int layer, int id) {
    const int b = id >> 3, hh = id & 7;
    const bf16_t* P = (const bf16_t*)(F.ws + WS_P); bf16_t* OH = (bf16_t*)(F.ws + WS_OBR);
    LAS unsigned char* L = F.lds;
    LAS float* tot = (LAS float*)(L + HG_TOT); LAS float* lbs = (LAS float*)(L + HG_LB); LAS float* ssp = (LAS float*)(L + HG_SS);
    const int tid = F.tid, lane = F.lane, wave = F.wave, r = lane & 31, h = lane >> 5;
    if (tid < 128) { const float* hb = a->in[I_HLB] + hh * HD + tid; const float x0 = hb[0], x1 = hb[1024], x2 = hb[2048], x3 = hb[3072];
        const float mx = fmaxf(fmaxf(x0, x1), fmaxf(x2, x3)); const float e0 = __expf(x0 - mx), e1 = __expf(x1 - mx), e2 = __expf(x2 - mx), e3 = __expf(x3 - mx);
        const float inv = 1.f / (e0 + e1 + e2 + e3); float c = 0.f; if (layer >= 1) c += e1; if (layer >= 2) c += e2; if (layer >= 3) c += e3;
        lbs[tid] = fmaxf(c * inv, 0.f); }
    { unsigned zu; asm volatile("v_mov_b32 %0, 0" : "=v"(zu));
      for (int i = tid; i < 34816 / 16; i += 512) *(LAS u32x4*)(L + HG_SB + i * 16) = (u32x4){zu, zu, zu, zu}; }
    f32x16 Sacc[2];
#pragma unroll
    for (int q = 0; q < 2; ++q)
#pragma unroll
        for (int i = 0; i < 16; ++i) Sacc[q][i] = 0.f;
    const int pd = tid & 127, psc = __builtin_amdgcn_readfirstlane(tid >> 7);
    const int srow = tid >> 4, sch = tid & 15;
    const bf16_t* gq = P + (size_t)(b * T + srow) * NPC + PQH + hh * HD + sch * 8; const bf16_t* gf = P + (size_t)(b * T + srow) * NPC + PFH + hh * HD + sch * 8;
    const bf16_t* gv = P + (size_t)(b * T + srow) * NPC + PIH + hh * HD + sch * 8;
    u32x4 rq0 = *(const u32x4*)gq, rq1 = *(const u32x4*)(gq + (size_t)32 * NPC), rf0 = *(const u32x4*)gf, rf1 = *(const u32x4*)(gf + (size_t)32 * NPC), rv0 = *(const u32x4*)gv, rv1 = *(const u32x4*)(gv + (size_t)32 * NPC);
    const int et = wave & 3, tt2 = wave >> 2;
    f32x4 gn4[4]; { const float* ng = a->in[I_HNG] + layer * HD;
#pragma unroll
      for (int g4 = 0; g4 < 4; ++g4) gn4[g4] = *(const f32x4*)(ng + 32 * et + 8 * g4 + 4 * h); }
    u32x2 gw4[4];
    for (int c = 0; c < T / 64; ++c) {
        __syncthreads();
        *(LAS u32x4*)(L + HG_Q1 + srow * 272 + sch * 16) = rq0; *(LAS u32x4*)(L + HG_Q1 + (srow + 32) * 272 + sch * 16) = rq1;
        *(LAS u32x4*)(L + HG_K1 + srow * 272 + sch * 16) = rf0; *(LAS u32x4*)(L + HG_K1 + (srow + 32) * 272 + sch * 16) = rf1;
        { const unsigned v0[4] = {rv0.x, rv0.y, rv0.z, rv0.w}, v1[4] = {rv1.x, rv1.y, rv1.z, rv1.w};
#pragma unroll
          for (int q = 0; q < 4; ++q) { LAS unsigned short* p0 = (LAS unsigned short*)(L + HG_VT + (8 * sch + 2 * q) * 144 + srow * 2); LAS unsigned short* p1 = (LAS unsigned short*)(L + HG_VT + (8 * sch + 2 * q + 1) * 144 + srow * 2);
              p0[0] = (unsigned short)(v0[q] & 0xffffu); p1[0] = (unsigned short)(v0[q] >> 16); p0[32] = (unsigned short)(v1[q] & 0xffffu); p1[32] = (unsigned short)(v1[q] >> 16); } }
        __syncthreads();
        { const bf16_t* gp = P + (size_t)(b * T + 64 * c + 32 * tt2 + r) * NPC + PGH + hh * HD + 32 * et + 4 * h;
#pragma unroll
          for (int g4 = 0; g4 < 4; ++g4) gw4[g4] = *(const u32x2*)(gp + 8 * g4); }
        if (c + 1 < T / 64) { const size_t adv = (size_t)(64 * (c + 1)) * NPC;
            rq0 = *(const u32x4*)(gq + adv); rq1 = *(const u32x4*)(gq + adv + (size_t)32 * NPC); rf0 = *(const u32x4*)(gf + adv); rf1 = *(const u32x4*)(gf + adv + (size_t)32 * NPC);
            rv0 = *(const u32x4*)(gv + adv); rv1 = *(const u32x4*)(gv + adv + (size_t)32 * NPC); }
        float qv[16], kv[16], bl[16];
        { const float lb = lbs[pd]; float run = 0.f;
#pragma unroll
          for (int tt = 0; tt < 16; ++tt) { const int t = 16 * psc + tt;
              qv[tt] = bf2f(*(const LAS unsigned short*)(L + HG_Q1 + t * 272 + pd * 2)); const float fp = bf2f(*(const LAS unsigned short*)(L + HG_K1 + t * 272 + pd * 2));
              const float ex = fast_exp2(-fabsf(fp) * LOG2E);
              const float sg = (fp >= 0.f ? 1.f : ex) * fast_rcp(1.f + ex);
              const float f = lb + (1.f - lb) * sg; kv[tt] = 1.f - f;
              const float lf = (layer == 0) ? (fminf(fp, 0.f) - LN2 * fast_log2(1.f + ex)) : LN2 * fast_log2(f);
              run += lf; bl[tt] = run; }
          tot[psc * 128 + pd] = run; }
        __syncthreads();
        { const float t0 = tot[pd], t1 = tot[128 + pd], t2 = tot[256 + pd], t3 = tot[384 + pd];
          const float b31 = t0 + t1, b63 = (t0 + t1) + (t2 + t3);
          const float pre = psc == 0 ? 0.f : (psc == 1 ? t0 : (psc == 2 ? b31 : b31 + t2));
          const float rref = psc >= 2 ? b31 : 0.f; const float eb31 = fast_exp2(b31 * LOG2E), c3 = fast_exp2((b63 - rref) * LOG2E);
          unsigned k3w[8];
#pragma unroll
          for (int tt = 0; tt < 16; ++tt) { const int t = 16 * psc + tt; const float bb = pre + bl[tt];
              const float e1 = fast_exp2((bb - rref) * LOG2E); const float q1 = qv[tt] * e1;
              const float k1 = kv[tt] * fast_exp2(fminf(rref - bb, 80.f) * LOG2E);
              const float k3 = k1 * c3;
              *(LAS unsigned short*)(L + HG_Q1 + t * 272 + pd * 2) = (unsigned short)(pk2(q1, 0.f) & 0xffffu);
              *(LAS unsigned short*)(L + HG_K1 + t * 272 + pd * 2) = (unsigned short)(pk2(k1, 0.f) & 0xffffu);
              if (psc >= 2) *(LAS unsigned short*)(L + HG_QI + (t - 32) * 272 + pd * 2) = (unsigned short)(pk2(q1 * eb31, 0.f) & 0xffffu);
              else *(LAS unsigned short*)(L + HG_K2 + t * 272 + pd * 2) = (unsigned short)(pk2(k1 * eb31, 0.f) & 0xffffu);
              if (tt & 1) k3w[tt >> 1] = (k3w[tt >> 1] & 0xffffu) | (pk2(0.f, k3) & 0xffff0000u); else k3w[tt >> 1] = pk2(k3, 0.f) & 0xffffu; }
          *(LAS u32x4*)(L + HG_K3T + pd * 144 + psc * 32) = (u32x4){k3w[0], k3w[1], k3w[2], k3w[3]}; *(LAS u32x4*)(L + HG_K3T + pd * 144 + psc * 32 + 16) = (u32x4){k3w[4], k3w[5], k3w[6], k3w[7]}; }
        __syncthreads();
        if (wave < 3) {
            const int st = wave == 1 ? 1 : 0, ta = wave == 0 ? 0 : 1;
            const LAS unsigned char* Kb = L + (wave == 2 ? HG_K2 : HG_K1 + st * 32 * 272) + r * 272 + 16 * h; const LAS unsigned char* Qb = L + HG_Q1 + (32 * ta + r) * 272 + 16 * h;
            f32x16 at;
#pragma unroll
            for (int i = 0; i < 16; ++i) at[i] = 0.f;
#pragma unroll
            for (int s8 = 0; s8 < 8; ++s8) at = MFMA32(*(const LAS bf16x8*)(Kb + 32 * s8), *(const LAS bf16x8*)(Qb + 32 * s8), at);
            if (wave < 2) {
#pragma unroll
                for (int i = 0; i < 16; ++i) at[i] = (crow(i, h) <= r) ? at[i] : 0.f; }
#pragma unroll
            for (int g4 = 0; g4 < 4; ++g4) { u32x2 w; w.x = pk2(at[4 * g4], at[4 * g4 + 1]); w.y = pk2(at[4 * g4 + 2], at[4 * g4 + 3]);
                *(LAS u32x2*)(L + HG_AT + (32 * ta + r) * 144 + (32 * st + 8 * g4 + 4 * h) * 2) = w; }
        }
        f32x16 oo;
#pragma unroll
        for (int i = 0; i < 16; ++i) oo[i] = 0.f;
        { const LAS unsigned char* Sb = L + HG_SB + (32 * et + r) * 272 + 16 * h; const LAS unsigned char* Qb = L + (tt2 ? HG_QI : HG_Q1) + r * 272 + 16 * h;
#pragma unroll
          for (int s8 = 0; s8 < 8; ++s8) oo = MFMA32(*(const LAS bf16x8*)(Sb + 32 * s8), *(const LAS bf16x8*)(Qb + 32 * s8), oo); }
        __syncthreads();
#pragma unroll
        for (int q = 0; q < 2; ++q) { const int dt = (wave >> 2) + 2 * q, dd = 32 * dt + r;
            const float eb63 = fast_exp2(((tot[dd] + tot[128 + dd]) + (tot[256 + dd] + tot[384 + dd])) * LOG2E);
#pragma unroll
            for (int i = 0; i < 16; ++i) Sacc[q][i] *= eb63;
            const LAS unsigned char* Vb = L + HG_VT + (32 * et + r) * 144 + 16 * h; const LAS unsigned char* Kb = L + HG_K3T + dd * 144 + 16 * h;
#pragma unroll
            for (int s4 = 0; s4 < 4; ++s4) Sacc[q] = MFMA32(*(const LAS bf16x8*)(Vb + 32 * s4), *(const LAS bf16x8*)(Kb + 32 * s4), Sacc[q]);
            LAS unsigned char* Sw = L + HG_SB + dd * 2;
#pragma unroll
            for (int i = 0; i < 16; i += 2) { const unsigned w = pk2(Sacc[q][i], Sacc[q][i + 1]);
                *(LAS unsigned short*)(Sw + (32 * et + crow(i, h)) * 272) = (unsigned short)(w & 0xffffu); *(LAS unsigned short*)(Sw + (32 * et + crow(i + 1, h)) * 272) = (unsigned short)(w >> 16); } }
        { const LAS unsigned char* Vb = L + HG_VT + (32 * et + r) * 144 + 16 * h; const LAS unsigned char* Ab = L + HG_AT + (32 * tt2 + r) * 144 + 16 * h;
          oo = MFMA32(*(const LAS bf16x8*)(Vb), *(const LAS bf16x8*)(Ab), oo); oo = MFMA32(*(const LAS bf16x8*)(Vb + 32), *(const LAS bf16x8*)(Ab + 32), oo);
          if (tt2) { oo = MFMA32(*(const LAS bf16x8*)(Vb + 64), *(const LAS bf16x8*)(Ab + 64), oo); oo = MFMA32(*(const LAS bf16x8*)(Vb + 96), *(const LAS bf16x8*)(Ab + 96), oo); } }
        { float ss = 0.f;
#pragma unroll
          for (int i = 0; i < 16; ++i) ss += oo[i] * oo[i];
          ss = xhalf_sum(ss);
          if (h == 0) ssp[(32 * tt2 + r) * 4 + et] = ss; }
        __syncthreads();
        { const f32x4 s4 = *(const LAS f32x4*)(ssp + (32 * tt2 + r) * 4); const float rn = rsqrtf(((s4.x + s4.y) + (s4.z + s4.w)) * (1.f / HD) + EPS);
          const size_t row = (size_t)(b * T + 64 * c + 32 * tt2 + r);
#pragma unroll
          for (int g4 = 0; g4 < 4; ++g4) { const int e0 = 32 * et + 8 * g4 + 4 * h;
              const u32x2 gw = gw4[g4]; const f32x4 gn = gn4[g4];
              u32x2 w; w.x = pk2(oo[4 * g4] * rn * gn.x * sigmoidf_(bflo(gw.x)), oo[4 * g4 + 1] * rn * gn.y * sigmoidf_(bfhi(gw.x)));
              w.y = pk2(oo[4 * g4 + 2] * rn * gn.z * sigmoidf_(bflo(gw.y)), oo[4 * g4 + 3] * rn * gn.w * sigmoidf_(bfhi(gw.y)));
              *(u32x2*)(OH + akm(row, 2 * BW + hh * HD + e0)) = w; } }
    }
}

constexpr int AT_K = 0, AT_V = 32768, AT_TAB = 73728, AT_IMP = 75776, AT_SELM = 109568, AT_MISC = 109824;
constexpr int AT_BT = AT_MISC + 4096, BT_N = 704;
constexpr int K_TB = 16384, V_RS = 320, V_TB = 64 * V_RS;
__device__ __forceinline__ unsigned koff(int row, int ch) { return 256u * (unsigned)row + 16u * (unsigned)(ch ^ (((row & 3) << 2) | ((row >> 2) & 3))); }
struct Stg { u32x4 k0, k1, v0, v1; };
__device__ __forceinline__ void stg_load(Stg& s, const bf16_t* Kp, const bf16_t* Vp, int ld, int tid) {
    const int row = tid >> 4, ch = tid & 15;
    s.k0 = *(const u32x4*)(Kp + (size_t)row * ld + ch * 8); s.k1 = *(const u32x4*)(Kp + (size_t)(row + 32) * ld + ch * 8);
    s.v0 = *(const u32x4*)(Vp + (size_t)row * ld + ch * 8); s.v1 = *(const u32x4*)(Vp + (size_t)(row + 32) * ld + ch * 8);
}
__device__ __forceinline__ void stg_write(const Stg& s, LAS unsigned char* L, int tid, int buf) {
    const int row = tid >> 4, ch = tid & 15;
    *(LAS u32x4*)(L + AT_K + buf * K_TB + koff(row, ch)) = s.k0; *(LAS u32x4*)(L + AT_K + buf * K_TB + koff(row + 32, ch)) = s.k1;
    *(LAS u32x4*)(L + AT_V + buf * V_TB + row * V_RS + ch * 16) = s.v0; *(LAS u32x4*)(L + AT_V + buf * V_TB + (row + 32) * V_RS + ch * 16) = s.v1;
}
__device__ __forceinline__ float xhalf_max(float v) { auto rr = __builtin_amdgcn_permlane32_swap(__float_as_uint(v), __float_as_uint(v), false, false); return fmaxf(__uint_as_float(rr[0]), __uint_as_float(rr[1])); }
__device__ __forceinline__ float xhalf_sum(float v) { auto rr = __builtin_amdgcn_permlane32_swap(__float_as_uint(v), __float_as_uint(v), false, false); return __uint_as_float(rr[0]) + __uint_as_float(rr[1]); }
__device__ __forceinline__ float xhalf_get(float v, int h) { auto rr = __builtin_amdgcn_permlane32_swap(__float_as_uint(v), __float_as_uint(v), false, false); return __uint_as_float(h ? rr[0] : rr[1]); }
__device__ __forceinline__ void qk_tile(f32x16& p0, f32x16& p1, const LAS unsigned char* L, int buf, const bf16x8 (&qf)[8], int r, int h, const float init = 0.f) {
#pragma unroll
    for (int i = 0; i < 16; ++i) { p0[i] = init; p1[i] = init; }
    const LAS unsigned char* Kb = L + AT_K + buf * K_TB;
    bf16x8 a0[8], a1[8];
#pragma unroll
    for (int s = 0; s < 8; ++s) { a0[s] = *(const LAS bf16x8*)(Kb + koff(r, 2 * s + h)); a1[s] = *(const LAS bf16x8*)(Kb + koff(r + 32, 2 * s + h)); }
#pragma unroll
    for (int s = 0; s < 8; ++s) { p0 = MFMA32(a0[s], qf[s], p0); p1 = MFMA32(a1[s], qf[s], p1); }
    __builtin_amdgcn_sched_group_barrier(0x100, 4, 0);
#pragma unroll
    for (int i = 0; i < 6; ++i) { __builtin_amdgcn_sched_group_barrier(0x008, 2, 0); __builtin_amdgcn_sched_group_barrier(0x100, 2, 0); }
    __builtin_amdgcn_sched_group_barrier(0x008, 4, 0);
}
__device__ __forceinline__ bf16x8 pack8(const f32x16& p, int s) {
    u32x4 w; w.x = pk2(p[8 * s], p[8 * s + 1]); w.y = pk2(p[8 * s + 2], p[8 * s + 3]); w.z = pk2(p[8 * s + 4], p[8 * s + 5]); w.w = pk2(p[8 * s + 6], p[8 * s + 7]);
    return __builtin_bit_cast(bf16x8, w);
}
__device__ __forceinline__ void pv_tile(f32x16 (&o)[4], const f32x16& p0, const f32x16& p1, const LAS unsigned char* L, int buf, int lane) {
    bf16x8 pb[4]; pb[0] = pack8(p0, 0); pb[1] = pack8(p0, 1); pb[2] = pack8(p1, 0); pb[3] = pack8(p1, 1);
    const LAS unsigned char* vb = L + AT_V + buf * V_TB + (4 * (lane >> 5) + ((lane & 15) >> 2)) * V_RS + ((lane >> 4) & 1) * 32 + (lane & 3) * 8;
    __builtin_amdgcn_sched_barrier(0);
    s16x4 lo[16], hi[16];
#pragma unroll
    for (int c = 0; c < 4; ++c)
#pragma unroll
        for (int s = 0; s < 4; ++s) { lo[4 * c + s] = __builtin_amdgcn_ds_read_tr16_b64_v4i16((LAS s16x4*)(vb + (16 * s) * V_RS + 64 * c)); hi[4 * c + s] = __builtin_amdgcn_ds_read_tr16_b64_v4i16((LAS s16x4*)(vb + (16 * s + 8) * V_RS + 64 * c)); }
#pragma unroll
    for (int c = 0; c < 4; ++c)
#pragma unroll
        for (int s = 0; s < 4; ++s) o[c] = MFMA32(__builtin_shufflevector(lo[4 * c + s], hi[4 * c + s], 0, 1, 2, 3, 4, 5, 6, 7), pb[s], o[c]);
    __builtin_amdgcn_sched_group_barrier(0x100, 4, 1);
#pragma unroll
    for (int i = 0; i < 14; ++i) { __builtin_amdgcn_sched_group_barrier(0x008, 1, 1); __builtin_amdgcn_sched_group_barrier(0x100, 2, 1); }
    __builtin_amdgcn_sched_group_barrier(0x008, 2, 1);
    __builtin_amdgcn_sched_barrier(0);
}
#ifndef SM_THR
#define SM_THR 6.f
#endif
__device__ __forceinline__ void softmax_step(f32x16& p0, f32x16& p1, float& m, float& l, f32x16 (&o)[4]) {
    float mx = p0[0];
#pragma unroll
    for (int i = 1; i < 16; ++i) mx = fmaxf(mx, p0[i]);
#pragma unroll
    for (int i = 0; i < 16; ++i) mx = fmaxf(mx, p1[i]);
    mx = xhalf_max(mx);
    const bool live = mx > -3.0e38f;
    if (__any(live && (l == 0.f || mx > SM_THR * LOG2E))) {
        const float d = live ? (l == 0.f ? mx : fmaxf(mx, 0.f)) : 0.f;
        const float alpha = l == 0.f ? 1.f : fast_exp2(-d); m += d; l *= alpha;
#pragma unroll
        for (int i = 0; i < 16; ++i) { p0[i] -= d; p1[i] -= d; }
        if (!__all(alpha == 1.f)) {
#pragma unroll
            for (int c = 0; c < 4; ++c)
#pragma unroll
                for (int i = 0; i < 16; ++i) o[c][i] *= alpha; }
    }
    float ps = 0.f;
#pragma unroll
    for (int i = 0; i < 16; ++i) { p0[i] = fast_exp2(p0[i]); ps += p0[i]; }
#pragma unroll
    for (int i = 0; i < 16; ++i) { p1[i] = fast_exp2(p1[i]); ps += p1[i]; }
    l += xhalf_sum(ps);
}
__device__ __forceinline__ void store_ot(const f32x16 (&o)[4], float sc, bf16_t* base, size_t row, int col  , int h, bool add) {
    bf16_t* p0 = base + akm(row, col) + 4 * h;
#pragma unroll
    for (int c = 0; c < 4; ++c)
#pragma unroll
        for (int g4 = 0; g4 < 4; ++g4) { u32x2* p = (u32x2*)(p0 + (size_t)(c >> 1) * ((size_t)M * 64) + 32 * (c & 1) + 8 * g4);
            float v0 = sc * o[c][4 * g4], v1 = sc * o[c][4 * g4 + 1], v2 = sc * o[c][4 * g4 + 2], v3 = sc * o[c][4 * g4 + 3];
            if (add) { const u32x2 w0 = *p; v0 += bflo(w0.x); v1 += bfhi(w0.x); v2 += bflo(w0.y); v3 += bfhi(w0.y); }
            u32x2 w; w.x = pk2(v0, v1); w.y = pk2(v2, v3); *p = w; }
}

__device__ __forceinline__ void item_sb(Frame& F, KArgs a, int item) {
    LAS unsigned char* L = F.lds;
    const int qb = 7 - (item >> 7), rem = item & 127, b = rem >> 3, hh = rem & 7, t0 = qb * 256;
    const int tid = F.tid, lane = F.lane, wave = F.wave, r = lane & 31, h = lane >> 5;
    const int tq = t0 + 32 * wave + r;
    const bf16_t* P = (const bf16_t*)(F.ws + WS_P); const size_t rowq = (size_t)(b * T + tq);
    const bf16_t* Kb = P + (size_t)(b * T) * NPC + PKSB + hh * HD; const bf16_t* Vb = P + (size_t)(b * T) * NPC + PVSB + hh * HD;
    bf16x8 qf[8];
#pragma unroll
    for (int s = 0; s < 8; ++s) qf[s] = *(const bf16x8*)(P + rowq * NPC + PQS + hh * HD + 16 * s + 8 * h);
    f32x16 o[4];
#pragma unroll
    for (int c = 0; c < 4; ++c)
#pragma unroll
        for (int i = 0; i < 16; ++i) o[c][i] = 0.f;
    float C = 1.f; bool wdone = false;
    volatile LAS unsigned* flags = (volatile LAS unsigned*)(L + AT_MISC);
    Stg st; int j = 4 * qb + 3, buf = 0, it = 0;
    stg_load(st, Kb + (size_t)(64 * j) * NPC, Vb + (size_t)(64 * j) * NPC, NPC, tid);
    __syncthreads();
    stg_write(st, L, tid, 0);
    if (j > 0) stg_load(st, Kb + (size_t)(64 * (j - 1)) * NPC, Vb + (size_t)(64 * (j - 1)) * NPC, NPC, tid);
    for (;;) {
        if (lane == 0) flags[(it & 1) * 8 + wave] = wdone ? 1u : 0u;
        __syncthreads();
        unsigned nd = 0;
#pragma unroll
        for (int w = 0; w < 8; ++w) nd += flags[(it & 1) * 8 + w];
        if (__builtin_amdgcn_readfirstlane(nd) == 8u) break;
        if (j > 0) stg_write(st, L, tid, buf ^ 1);
        if (j > 1) stg_load(st, Kb + (size_t)(64 * (j - 2)) * NPC, Vb + (size_t)(64 * (j - 2)) * NPC, NPC, tid);
        const bool active = !wdone && (64 * j <= t0 + 32 * wave + 30);
        if (active) {
            f32x16 p0, p1; qk_tile(p0, p1, L, buf, qf, r, h);
            float om0[16], om1[16];
            const int kb = 64 * j + 4 * h;
#define SB_ELEM(MASK) do { _Pragma("unroll") for (int i = 0; i < 16; ++i) { const int key0 = kb + (i & 3) + 8 * (i >> 2); \
                { const float pz = p0[i]; const float ex = fast_exp2(-fabsf(pz) * (QSCALE * LOG2E)); const float rr = fast_rcp(1.f + ex), er = ex * rr; const bool pos = pz >= 0.f; \
                  float be = pos ? rr : er, om = pos ? er : rr; if (MASK) { const bool cz = key0 < tq; om = cz ? om : 1.f; be = cz ? be : 0.f; } om0[i] = om; p0[i] = be; } \
                { const float pz = p1[i]; const float ex = fast_exp2(-fabsf(pz) * (QSCALE * LOG2E)); const float rr = fast_rcp(1.f + ex), er = ex * rr; const bool pos = pz >= 0.f; \
                  float be = pos ? rr : er, om = pos ? er : rr; if (MASK) { const bool cz = key0 + 32 < tq; om = cz ? om : 1.f; be = cz ? be : 0.f; } om1[i] = om; p1[i] = be; } } } while (0)
            SB_ELEM(false);
#undef SB_ELEM
            if (64 * j + 63 >= t0 + 32 * wave) {
#pragma unroll
                for (int i = 0; i < 16; ++i) { const int key0 = kb + (i & 3) + 8 * (i >> 2); const bool c0 = key0 < tq, c1 = key0 + 32 < tq;
                    om0[i] = c0 ? om0[i] : 1.f; p0[i] = c0 ? p0[i] : 0.f; om1[i] = c1 ? om1[i] : 1.f; p1[i] = c1 ? p1[i] : 0.f; } }
            float Tm[2][4], Tr[2][4];
#pragma unroll
            for (int g4 = 0; g4 < 4; ++g4) { Tm[0][g4] = (om0[4 * g4] * om0[4 * g4 + 1]) * (om0[4 * g4 + 2] * om0[4 * g4 + 3]); Tm[1][g4] = (om1[4 * g4] * om1[4 * g4 + 1]) * (om1[4 * g4 + 2] * om1[4 * g4 + 3]); }
#pragma unroll
            for (int k = 0; k < 2; ++k)
#pragma unroll
                for (int g4 = 0; g4 < 4; ++g4) Tr[k][g4] = xhalf_get(Tm[k][g4], h);
            float aft[2][4]; float run = C;
#pragma unroll
            for (int G = 15; G >= 0; --G) { const int k = G >> 3, g4 = (G >> 1) & 3, par = G & 1;
                const float tg = (par == 1) ? (h ? Tm[k][g4] : Tr[k][g4]) : (h ? Tr[k][g4] : Tm[k][g4]);
                if (par == 1) { if (h) aft[k][g4] = run; } else { if (!h) aft[k][g4] = run; }
                run *= tg; }
            C = run;
#pragma unroll
            for (int g4 = 0; g4 < 4; ++g4) {
                { float ca = aft[0][g4];
#pragma unroll
                  for (int e = 3; e >= 0; --e) { const int i = 4 * g4 + e; const float w_ = p0[i] * ca; ca *= om0[i]; p0[i] = w_; } }
                { float ca = aft[1][g4];
#pragma unroll
                  for (int e = 3; e >= 0; --e) { const int i = 4 * g4 + e; const float w_ = p1[i] * ca; ca *= om1[i]; p1[i] = w_; } }
            }
            pv_tile(o, p0, p1, L, buf, lane);
            wdone = __all(C < 1e-30f);
        }
        if (j == 0) break;
        --j; buf ^= 1; ++it;
    }
    store_ot(o, 1.f, (bf16_t*)(F.ws + WS_OBR), rowq, BW + hh * HD, h, false);
}

__device__ __forceinline__ void item_nsa(Frame& F, KArgs a, int item) {
    LAS unsigned char* L = F.lds;
    const int qblk = 31 - (item >> 5), rem = item & 31, b = rem >> 1, g = rem & 1, t0 = qblk * 64;
    const int tid = F.tid, lane = F.lane, wave = F.wave, r = lane & 31, h = lane >> 5, hr = wave >> 1, th = wave & 1;
    const int tl = 32 * th + r, tq = t0 + tl, hq = g * 4 + hr;
    const bf16_t* P = (const bf16_t*)(F.ws + WS_P);
    LAS float* tab = (LAS float*)(L + AT_TAB); LAS float* imp = (LAS float*)(L + AT_IMP); volatile LAS unsigned* selm = (volatile LAS unsigned*)(L + AT_SELM); LAS unsigned* misc = (LAS unsigned*)(L + AT_MISC);
    { const int hh = tid >> 7, dd = tid & 127; tab[tid] = a->in[I_RELB][t5_bucket(dd) * 8 + g * 4 + hh] * LOG2E; }
    if (tid == 0) misc[0] = 0u;
    bf16x8 qf[8];
#pragma unroll
    for (int s = 0; s < 8; ++s) qf[s] = *(const bf16x8*)(P + (size_t)(b * T + tq) * NPC + PQN + hq * HD + 16 * s + 8 * h);
    f32x16 o[4];
    Stg st;
    auto opq = [](int v) { asm volatile("" : "+v"(v)); return v; };
#define NSA_GATE(i) sigmoidf_(bf2f(P[((size_t)(b * T + opq(tq))) * NPC + PGN + hq * 3 + (i)]))
#define NSA_OUT() (bf16_t*)(F.ws + WS_OBR), (size_t)(b * T + opq(tq)), hq * HD
    {
        const bf16_t* kc = (const bf16_t*)(F.ws + WS_MISC + MISC_KCMP) + (size_t)((b * 2 + g) * 128) * HD; const bf16_t* vc = (const bf16_t*)(F.ws + WS_MISC + MISC_VCMP) + (size_t)((b * 2 + g) * 128) * HD;
        const bool two = qblk >= 16;
        f32x16 pc[4];
        __syncthreads();
        { Stg st1; stg_load(st, kc, vc, HD, tid); if (two) stg_load(st1, kc + 64 * HD, vc + 64 * HD, HD, tid);
          stg_write(st, L, tid, 0); if (two) stg_write(st1, L, tid, 1); }
        { LAS float* bt = (LAS float*)(L + AT_BT);
          for (int idx = tid; idx < 4 * BT_N; idx += 512) { const int hh = idx / BT_N, d = idx - hh * BT_N - 64;
              bt[idx] = (d < 0 || d >= 512) ? -__builtin_inff() : tab[hh * 128 + (d > 113 ? 113 : d)]; } }
        __syncthreads();
        qk_tile(pc[0], pc[1], L, 0, qf, r, h);
        if (two) qk_tile(pc[2], pc[3], L, 1, qf, r, h);
        float mx = -1e30f;
#pragma unroll
        for (int k = 0; k < 4; ++k) { if (k >= 2 && !two) break;
#pragma unroll
            for (int i = 0; i < 16; ++i) { const int n = 32 * k + crow(i, h); const int dc = tq - (16 * n + 31); const int di = dc < 113 ? dc : 113;
                const float sv = dc >= 0 ? pc[k][i] + tab[hr * 128 + (di < 0 ? 0 : di)] : -__builtin_inff(); pc[k][i] = sv; mx = fmaxf(mx, sv); } }
        mx = xhalf_max(mx);
        float sum = 0.f;
#pragma unroll
        for (int k = 0; k < 4; ++k) { if (k >= 2 && !two) break;
#pragma unroll
            for (int i = 0; i < 16; ++i) { const float e = fast_exp2(pc[k][i] - mx); pc[k][i] = e; sum += e; } }
        sum = xhalf_sum(sum);
        const float inv = 1.f / fmaxf(sum, 1e-30f);
#pragma unroll
        for (int k = 0; k < 4; ++k)
#pragma unroll
            for (int i = 0; i < 16; ++i) pc[k][i] = (k >= 2 && !two) ? 0.f : pc[k][i] * inv;
        float gs[16], gl[16], rc[16];
#pragma unroll
        for (int k = 0; k < 4; ++k)
#pragma unroll
            for (int g4 = 0; g4 < 4; ++g4) { gs[4 * k + g4] = (pc[k][4 * g4] + pc[k][4 * g4 + 1]) + (pc[k][4 * g4 + 2] + pc[k][4 * g4 + 3]); gl[4 * k + g4] = pc[k][4 * g4 + 3]; }
#pragma unroll
        for (int f = 0; f < 16; ++f) rc[f] = xhalf_get(gl[f], h);
#pragma unroll
        for (int f = 0; f < 16; ++f) { const float prev = h ? rc[f] : (f >= 1 ? rc[f - 1] : 0.f); const int G = 8 * (f >> 2) + 2 * (f & 3) + h;
            imp[(hr * 64 + tl) * 33 + G] = gs[f] + prev; }
#pragma unroll
        for (int c = 0; c < 4; ++c)
#pragma unroll
            for (int i = 0; i < 16; ++i) o[c][i] = 0.f;
        pv_tile(o, pc[0], pc[1], L, 0, lane);
        if (two) pv_tile(o, pc[2], pc[3], L, 1, lane);
        store_ot(o, NSA_GATE(0), NSA_OUT(), h, false);
    }
    __syncthreads();
    const int tk = tid >> 3, part = tid & 7;
    if (qblk >= 16) {
#pragma unroll
        for (int q = 0; q < 4; ++q) { const int jj = part + 8 * q; imp[tk * 33 + jj] = (imp[tk * 33 + jj] + imp[(64 + tk) * 33 + jj]) + (imp[(128 + tk) * 33 + jj] + imp[(192 + tk) * 33 + jj]); }
    }
    __syncthreads();
    {
        unsigned msk;
        if (qblk < 16) msk = (2u << qblk) - 1u;
        else {
            msk = 0u;
#pragma unroll
            for (int q = 0; q < 4; ++q) { const int jj = part + 8 * q;
                if (jj >= 1 && jj <= qblk - 2) { const float v = imp[tk * 33 + jj]; int rank = 0;
#pragma unroll
                    for (int j2 = 1; j2 < 30; ++j2) { const float v2 = imp[tk * 33 + j2]; rank += (j2 <= qblk - 2 && (v2 > v || (v2 == v && j2 < jj))) ? 1 : 0; }
                    if (rank < 13) msk |= 1u << jj; } }
            msk |= (unsigned)__shfl_xor((int)msk, 1); msk |= (unsigned)__shfl_xor((int)msk, 2); msk |= (unsigned)__shfl_xor((int)msk, 4);
            msk |= 1u | (1u << (qblk - 1)) | (1u << qblk);
        }
        if (part == 0) selm[tk] = msk;
        unsigned om = msk;
#pragma unroll
        for (int off = 8; off < 64; off <<= 1) om |= (unsigned)__shfl_xor((int)om, off);
        if (lane == 0) __hip_atomic_fetch_or(misc, om, __ATOMIC_RELAXED, __HIP_MEMORY_SCOPE_WORKGROUP);
    }
    __syncthreads();
    const bf16_t* Kbase = P + (size_t)(b * T) * NPC + g * HD;
    const float bfar = tab[hr * 128 + 113];
    for (int rep = 0; rep < (MK_PROBE == 31 ? 2 : 1); ++rep) {
        if (rep) __syncthreads();
        unsigned om = __builtin_amdgcn_readfirstlane(misc[0]); const unsigned mym = selm[tl];
        float m = 0.f, l = 0.f;
#pragma unroll
        for (int c = 0; c < 4; ++c)
#pragma unroll
            for (int i = 0; i < 16; ++i) o[c][i] = 0.f;
        int jc = __builtin_ctz(om); om &= om - 1u;
        stg_load(st, Kbase + PKS + (size_t)(64 * jc) * NPC, Kbase + PVS + (size_t)(64 * jc) * NPC, NPC, tid);
        stg_write(st, L, tid, 0);
        int jn = om ? __builtin_ctz(om) : -1; if (jn >= 0) { om &= om - 1u; stg_load(st, Kbase + PKS + (size_t)(64 * jn) * NPC, Kbase + PVS + (size_t)(64 * jn) * NPC, NPC, tid); }
        int buf = 0;
        for (;;) {
            __syncthreads();
            if (jn >= 0) stg_write(st, L, tid, buf ^ 1);
            const int jnn = om ? __builtin_ctz(om) : -1; if (jnn >= 0) { om &= om - 1u; stg_load(st, Kbase + PKS + (size_t)(64 * jnn) * NPC, Kbase + PVS + (size_t)(64 * jnn) * NPC, NPC, tid); }
            const bool sel = (mym >> jc) & 1u; const bool farsel = jc <= qblk - 3;
            f32x16 p0, p1; qk_tile(p0, p1, L, buf, qf, r, h, sel ? (farsel ? bfar - m : -m) : -__builtin_inff());
            if (!farsel) {
                const LAS float* bp = (const LAS float*)(L + AT_BT) + hr * BT_N + (tq - 64 * jc + 5 - 4 * h);
#pragma unroll
                for (int i = 0; i < 16; ++i) { const int cc = 27 - ((i & 3) + 8 * (i >> 2)); p0[i] += bp[cc + 32]; p1[i] += bp[cc]; }
            }
            softmax_step(p0, p1, m, l, o);
            pv_tile(o, p0, p1, L, buf, lane);
            if (jn < 0) break;
            jc = jn; jn = jnn; buf ^= 1;
        }
        if (rep == (MK_PROBE == 31 ? 1 : 0)) store_ot(o, NSA_GATE(1) / l, NSA_OUT(), h, true);
    }
    for (int rep = 0; rep < (MK_PROBE == 32 ? 2 : 1); ++rep) {
        float m = 0.f, l = 0.f;
#pragma unroll
        for (int c = 0; c < 4; ++c)
#pragma unroll
            for (int i = 0; i < 16; ++i) o[c][i] = 0.f;
        int jc = qblk >= 8 ? qblk - 8 : 0;
        stg_load(st, Kbase + PKW + (size_t)(64 * jc) * NPC, Kbase + PVW + (size_t)(64 * jc) * NPC, NPC, tid);
        __syncthreads();
        stg_write(st, L, tid, 0);
        if (jc < qblk) stg_load(st, Kbase + PKW + (size_t)(64 * (jc + 1)) * NPC, Kbase + PVW + (size_t)(64 * (jc + 1)) * NPC, NPC, tid);
        int buf = 0;
        for (;;) {
            __syncthreads();
            if (jc < qblk) stg_write(st, L, tid, buf ^ 1);
            if (jc + 1 < qblk) stg_load(st, Kbase + PKW + (size_t)(64 * (jc + 2)) * NPC, Kbase + PVW + (size_t)(64 * (jc + 2)) * NPC, NPC, tid);
            const bool interior = jc <= qblk - 3 && jc >= qblk - 7;
            f32x16 p0, p1; qk_tile(p0, p1, L, buf, qf, r, h, interior ? bfar - m : -m);
            if (!interior) {
                const LAS float* bp = (const LAS float*)(L + AT_BT) + hr * BT_N + (tq - 64 * jc + 5 - 4 * h);
#pragma unroll
                for (int i = 0; i < 16; ++i) { const int cc = 27 - ((i & 3) + 8 * (i >> 2)); p0[i] += bp[cc + 32]; p1[i] += bp[cc]; }
            }
            softmax_step(p0, p1, m, l, o);
            pv_tile(o, p0, p1, L, buf, lane);
            if (jc == qblk) break;
            ++jc; buf ^= 1;
        }
        if (rep == (MK_PROBE == 32 ? 1 : 0)) store_ot(o, NSA_GATE(2) / l, NSA_OUT(), h, true);
    }
#undef NSA_GATE
#undef NSA_OUT
}

constexpr int NI_H = 128, NI_S = 1024, NI_C = 256, NI_N = 512, NI_A = 1024;
#define FRESH_F() do { unsigned on_ = ~0u; asm volatile("" : "+s"(on_)); int t_ = F.wave * 64 + (int)__builtin_amdgcn_mbcnt_hi(on_, __builtin_amdgcn_mbcnt_lo(on_, 0u)); asm volatile("" : "+v"(t_)); F.tid = t_; F.lane = t_ & 63; F.wave = __builtin_amdgcn_readfirstlane(t_ >> 6); } while (0)
__device__ __forceinline__ void phase_Ca(Frame& F, KArgs a, int layer, int bank, int types) {
    unsigned* head = F.ctl + CW_QUEUE + 64 * (layer * 8) + bank * 4096;
    if (types & 1) for (;;) { const int it = q_next(F, head + 0); if (it >= NI_H) break; FRESH_F(); item_hgrn(F, a, layer, it); }
    if (types & 2) for (;;) { const int it = q_next(F, head + 64); if (it >= NI_S) break; FRESH_F(); item_sb(F, a, it); }
    if (types & 4) for (;;) { const int it = q_next(F, head + 128); if (it >= NI_C) break; FRESH_F(); item_compress(F, a, layer, it); }
    if (types & 8) for (;;) { const int it = q_next(F, head + 192); if (it >= NI_N) break; FRESH_F(); item_norm(F, a, layer, it); }
}
__device__ __forceinline__ void phase_Cb(Frame& F, KArgs a, int layer, int bank) {
    unsigned* head = F.ctl + CW_QUEUE + 64 * (layer * 8 + 4) + bank * 4096;
    for (;;) { const int it = q_next(F, head + 0); if (it >= NI_A) break; FRESH_F(); item_nsa(F, a, it); }
}

__global__ void __launch_bounds__(512, 2) mega(Args karg) {
    extern __shared__ __attribute__((aligned(16))) unsigned char lds_raw[];
    Frame F;
    F.lds = (LAS unsigned char*)lds_raw; F.MISC = (volatile LAS unsigned*)(F.lds + MISC_OFF);
    F.tid = threadIdx.x; F.lane = F.tid & 63; F.wave = __builtin_amdgcn_readfirstlane(F.tid >> 6); F.G = gridDim.x; F.bid = blockIdx.x;
    KArgs a = (KArgs)__builtin_amdgcn_kernarg_segment_ptr();
    F.ws = a->ws; F.ctl = (unsigned*)(a->ws + WS_CTL);
    if (F.tid < 64) F.MISC[F.tid] = 0u;
    __syncthreads();
    const int lo = karg.ph_lo, hi = karg.ph_hi;
    XcdBarrier bar; bar.bar = F.ctl + CW_BAR; bar.x = 0; bar.st = F.MISC + 8;
    if (hi - lo > 1) bar = xcd_barrier_post(F.ctl + CW_BAR, F.MISC + 8);
#define IN(k) (lo <= (k) && (k) < hi)
#define ON(k) (((MK_PHASE_MASK & MK_BUILD_MASK) >> (k)) & 1)
#define GRID_BAR() do { unsigned* bp_ = (unsigned*)(a->ws + WS_CTL) + CW_BAR; asm volatile("" : "+s"(bp_)); bar.bar = bp_; xcd_barrier(bar); } while (0)
#define SEAM(k) do { if (IN(k) && IN((k) + 1)) GRID_BAR(); } while (0)
    bf16_t* Hb; bf16_t* Pb; const int wave_s = __builtin_amdgcn_readfirstlane(threadIdx.x >> 6);
    for (int layer = 0; layer < DEPTH; ++layer) {
        const int pb = layer * 10;
#define FRESH() do { unsigned on_ = ~0u; asm volatile("" : "+s"(on_)); int t_ = wave_s * 64 + (int)__builtin_amdgcn_mbcnt_hi(on_, __builtin_amdgcn_mbcnt_lo(on_, 0u)); asm volatile("" : "+v"(t_)); F.tid = t_; F.lane = t_ & 63; F.wave = __builtin_amdgcn_readfirstlane(t_ >> 6); \
        asm volatile("" : "+s"(a)); F.ws = a->ws; F.ctl = (unsigned*)(a->ws + WS_CTL); Hb = (bf16_t*)(F.ws + WS_H); Pb = (bf16_t*)(F.ws + WS_P); } while (0)
        if (ON(0) && IN(pb + 0)) { FRESH(); if (MK_PROBE == 0) { phase_A(F, a, layer); GRID_BAR(); } phase_A(F, a, layer); } SEAM(pb + 0);
        if (ON(1) && IN(pb + 1)) for (int rep = 0; rep < (MK_PROBE == 1 ? 2 : 1); ++rep) { FRESH();
            if (rep) GRID_BAR();
            if (MK_STAGGER) { const unsigned long long t0 = __builtin_amdgcn_s_memrealtime(), dl = (unsigned long long)((F.bid >> 3) & 7) * MK_STAGGER; while (__builtin_amdgcn_s_memrealtime() - t0 < dl) __builtin_amdgcn_s_sleep(4); }
            pg8::Gemm g{(const bf16_t*)(F.ws + WS_XB), (const bf16_t*)(F.ws + WS_WIN), M, NPC, DM, 1, 1}; pg8::StaticOrder S; S.init(M, NPC, F.G, F.bid);
            pg8::EpiStoreBf16 E{Pb, NPC, PGT / 256, PGN / 256, (const float*)(F.ws + WS_RSTD), (LAS const float*)(F.lds + pg8::LRS_OFF)};
            pg8::gemm_phase<pg8::EpiStoreBf16, pg8::StaticOrder, PG8_ALIGN, PG8_SP2>(F.lds, g, S, E, F.tid, (MK_DIAG && layer == 0 && F.bid == 0) ? (unsigned long long*)(F.ctl + 49152) : nullptr);
        } SEAM(pb + 1);
        if (ON(2) && IN(pb + 2)) { FRESH(); if (MK_PROBE >= 20 && MK_PROBE < 28) { phase_Ca(F, a, layer, 1, MK_PROBE - 20); GRID_BAR(); } phase_Ca(F, a, layer, 0, 15); } SEAM(pb + 2);
        if (ON(3) && IN(pb + 3)) { FRESH(); if (MK_PROBE == 3) { phase_Cb(F, a, layer, 1); GRID_BAR(); } phase_Cb(F, a, layer, 0); } SEAM(pb + 3);
        if (ON(4) && IN(pb + 4)) for (int rep = 0; rep < (MK_PROBE == 4 ? 2 : 1); ++rep) { FRESH();
            if (rep) GRID_BAR();
            pg8::Gemm g{(const bf16_t*)(F.ws + WS_OBR), (const bf16_t*)(F.ws + WS_WBR), M, DM, 3 * BW, 1, 1}; pg8::StaticOrder S; S.init(M, DM, F.G, F.bid);
            pg8::EpiGated E{Pb, Hb};
            pg8::gemm_phase<pg8::EpiGated, pg8::StaticOrder, PG8_ALIGN, PG8_SP2>(F.lds, g, S, E, F.tid);
        } SEAM(pb + 4);
        if (ON(5) && IN(pb + 5)) for (int rep = 0; rep < (MK_PROBE == 5 ? 2 : 1); ++rep) { FRESH();
            if (rep) GRID_BAR();
            pg8::Gemm g{Hb, (const bf16_t*)(F.ws + WS_WOUT), M, DM, DM, 1, 1}; pg8::StaticOrder S; S.init(M, DM, F.G, F.bid);
            pg8::EpiResidBf16 E{(MK_PROBE == 5 && rep == 0) ? (bf16_t*)(F.ws + WS_P) : (bf16_t*)(F.ws + WS_XB), nullptr, (MK_PROBE == 5 && rep == 0) ? (float*)(F.ws + WS_P + 256 * MiB) : (float*)(F.ws + WS_SSQ), DM};
            pg8::gemm_phase<pg8::EpiResidBf16, pg8::StaticOrder, PG8_ALIGN, PG8_SP2>(F.lds, g, S, E, F.tid);
        } SEAM(pb + 5);
        if (ON(6) && IN(pb + 6)) { FRESH(); if (MK_PROBE == 60) { GRID_BAR(); GRID_BAR(); GRID_BAR(); GRID_BAR(); } if (MK_PROBE == 6) { phase_F(F, a); GRID_BAR(); } phase_F(F, a); } SEAM(pb + 6);
        if (ON(7) && IN(pb + 7)) for (int rep = 0; rep < (MK_PROBE == 7 ? 2 : 1); ++rep) { FRESH();
            if (rep) GRID_BAR();
            if (MK_STAGGER) { const unsigned long long t0 = __builtin_amdgcn_s_memrealtime(), dl = (unsigned long long)((F.bid >> 3) & 7) * MK_STAGGER; while (__builtin_amdgcn_s_memrealtime() - t0 < dl) __builtin_amdgcn_s_sleep(4); }
            pg8::Gemm g{(const bf16_t*)(F.ws + WS_XB), (const bf16_t*)(F.ws + WS_WUP), M, NUP, DM, 1, 1}; pg8::StaticOrder S; S.init(M, NUP, F.G, F.bid);
            pg8::EpiConvAct E{F.ws, a, layer, (LAS const float*)(F.lds + pg8::LRS_OFF)};
            pg8::gemm_phase<pg8::EpiConvAct, pg8::StaticOrder, PG8_ALIGN, PG8_SP2>(F.lds, g, S, E, F.tid);
        } SEAM(pb + 7);
        if (ON(8) && IN(pb + 8)) { FRESH(); if (MK_PROBE == 8) { phase_H(F, a, layer); GRID_BAR(); } phase_H(F, a, layer); } SEAM(pb + 8);
        if (ON(9) && IN(pb + 9)) for (int rep = 0; rep < (MK_PROBE == 9 ? 2 : 1); ++rep) { FRESH();
            if (rep) GRID_BAR();
            pg8::Gemm g{(const bf16_t*)(F.ws + WS_ACT), (const bf16_t*)(F.ws + WS_WDN), M, DM, DFF, 1, 1}; pg8::StaticOrder S; S.init(M, DM, F.G, F.bid, 4, 1);
            pg8::EpiResidBf16 E{(MK_PROBE == 9 && rep == 0) ? (bf16_t*)(F.ws + WS_P) : (bf16_t*)(F.ws + WS_XB), (layer == DEPTH - 1 && !(MK_PROBE == 9 && rep == 0)) ? a->out : nullptr, (MK_PROBE == 9 && rep == 0) ? (float*)(F.ws + WS_P + 256 * MiB) : (float*)(F.ws + WS_SSQ), DM};
            pg8::gemm_phase<pg8::EpiResidBf16, pg8::StaticOrder, PG8_ALIGN, PG8_SP2>(F.lds, g, S, E, F.tid);
        } SEAM(pb + 9);
    }
#if MK_DIAG
    GRID_BAR();
    { const unsigned long long* dg = (const unsigned long long*)(F.ctl + 49152); const float kl = (float)(long long)(dg[1] - dg[0]), per = (float)(long long)(dg[2] - dg[0]);
      const float eps = MK_DIAG == 1 ? kl / per : (MK_DIAG == 2 ? per * 1e-4f : kl * 1e-4f);
      for (size_t i = (size_t)F.bid * 512 + threadIdx.x; i < (size_t)M * DM; i += (size_t)F.G * 512) a->out[i] *= (1.f + eps); }
#endif
}

extern "C" void kernel_launch(void* const* d_in, const int* in_sizes, int n_in, void* d_out, int out_size, void* d_ws, size_t ws_size, hipStream_t stream) {
    static int grid = 0;
    if (grid == 0) {
        if (n_in != 18 || in_sizes[0] != M * DM || out_size != M * DM || ws_size < WS_END) { fprintf(stderr, "kernel_launch: unexpected shapes / workspace (%d inputs, ws %zu)\n", n_in, ws_size); grid = -1; return; }
        int dev = 0, cus = 0, per_cu = 0;
        if (hipGetDevice(&dev) != hipSuccess || hipDeviceGetAttribute(&cus, hipDeviceAttributeMultiprocessorCount, dev) != hipSuccess) { grid = -1; return; }
        if (hipFuncSetAttribute((const void*)mega, hipFuncAttributeMaxDynamicSharedMemorySize, LDS_BYTES) != hipSuccess) { grid = -1; return; }
        if (hipOccupancyMaxActiveBlocksPerMultiprocessor(&per_cu, (const void*)mega, 512, LDS_BYTES) != hipSuccess || per_cu < 1) { fprintf(stderr, "kernel_launch: occupancy query says %d\n", per_cu); }
        (void)hipGetLastError();
        grid = cus;
    }
    if (grid < 0) return;
    (void)hipMemsetAsync((char*)d_ws + WS_CTL, 0, CTL_BYTES, stream);
    Args a{};
    for (int i = 0; i < 18; ++i) a.in[i] = (const float*)d_in[i];
    a.out = (float*)d_out; a.ws = (unsigned char*)d_ws;
#if MK_ONE_LAUNCH
    a.ph_lo = 0; a.ph_hi = DEPTH * 10;
    hipLaunchKernelGGL(mega, dim3(grid), dim3(512), LDS_BYTES, stream, a);
#else
    for (int p = 0; p < DEPTH * 10; ++p) { a.ph_lo = p; a.ph_hi = p + 1; hipLaunchKernelGGL(mega, dim3(grid), dim3(512), LDS_BYTES, stream, a); }
#endif
}
```

```cpp
#include <hip/hip_runtime.h>
#include <stdint.h>
#include <stdio.h>

#ifndef MK_ONE_LAUNCH
#define MK_ONE_LAUNCH 1
#endif
#ifndef MK_PHASE_MASK
#define MK_PHASE_MASK 0x3ff
#endif
#ifndef MK_PROBE
#define MK_PROBE -1
#endif
#ifndef MK_STAGGER
#define MK_STAGGER 0
#endif
#ifndef MK_DIAG
#define MK_DIAG 0
#endif
#ifndef MK_BUILD_MASK
#define MK_BUILD_MASK 0x3ff
#endif

#define LAS __attribute__((address_space(3)))
typedef unsigned short bf16_t;
typedef short bf16x8 __attribute__((ext_vector_type(8)));
typedef short s16x4 __attribute__((ext_vector_type(4)));
typedef float f32x4 __attribute__((ext_vector_type(4)));
typedef float f32x16 __attribute__((ext_vector_type(16)));
typedef float f32x2 __attribute__((ext_vector_type(2)));
typedef unsigned u32x4 __attribute__((ext_vector_type(4)));
typedef unsigned u32x2 __attribute__((ext_vector_type(2)));
typedef __bf16 bfv2 __attribute__((ext_vector_type(2)));

constexpr int DM = 2048, NB = 16, T = 2048, DEPTH = 4, M = NB * T, HD = 128;
constexpr int INC = 15896;
constexpr int NPC = 16128;
constexpr int PQN = 0, PKC = 1024, PVC = 1280, PKS = 1536, PVS = 1792, PKW = 2048, PVW = 2304, PQS = 2560, PKSB = 3584, PVSB = 4608,
              PQH = 5632, PFH = 6656, PIH = 7680, PGH = 8704, PGT = 9728, PGN = 15872;
constexpr int DFF = 5632, NUP = 2 * DFF;
constexpr int BW = 1024;
constexpr float EPS = 1e-6f;
constexpr float LOG2E = 1.4426950408889634f, LN2 = 0.6931471805599453f;
constexpr float QSCALE = 0.08838834764831845f;

constexpr size_t MiB = 1u << 20;
constexpr size_t WS_CTL = 0, CTL_BYTES = 1 * MiB;
constexpr size_t WS_WIN = 1 * MiB, WS_WBR = 64 * MiB, WS_WOUT = 76 * MiB, WS_WUP = 84 * MiB, WS_WDN = 128 * MiB;
constexpr size_t WS_MISC = 150 * MiB;
constexpr size_t MISC_KCMP = 0, MISC_VCMP = 1 * MiB, MISC_WC1 = 2 * MiB;
constexpr int CW_CVEC = 32768;
constexpr size_t WS_SCR = 154 * MiB;
constexpr size_t WS_P = 218 * MiB;
constexpr size_t WS_H = 1226 * MiB;
constexpr size_t WS_OBR = 1354 * MiB;
constexpr size_t WS_ORAW = 1546 * MiB;
constexpr size_t WS_XB = 1674 * MiB;
constexpr size_t WS_SSQ = 1802 * MiB;
constexpr size_t WS_RSTD = 1806 * MiB;
constexpr size_t WS_USIDE = 1807 * MiB;
constexpr size_t WS_END = 1853 * MiB;
constexpr size_t WS_ACT = WS_P + 704 * MiB;
constexpr int CW_BAR = 4096;
constexpr int CW_QUEUE = 16384;

constexpr int RING_BYTES = 131072;
constexpr int MISC_OFF = 147456 - 256;
constexpr int LDS_BYTES = 147456;

__device__ __forceinline__ float bf2f(unsigned short b) { return __uint_as_float(((unsigned)b) << 16); }
__device__ __forceinline__ float bflo(unsigned w) { return __uint_as_float(w << 16); }
__device__ __forceinline__ float bfhi(unsigned w) { return __uint_as_float(w & 0xffff0000u); }
__device__ __forceinline__ unsigned pk2(float lo, float hi) { f32x2 v = {lo, hi}; bfv2 b = __builtin_convertvector(v, bfv2); return __builtin_bit_cast(unsigned, b); }
__device__ __forceinline__ float wave_sum(float v) {
#pragma unroll
    for (int o = 1; o < 64; o <<= 1) v += __shfl_xor(v, o);
    return v;
}
__device__ __forceinline__ float fast_exp2(float x) { return __builtin_amdgcn_exp2f(x); }
__device__ __forceinline__ float fast_log2(float x) { return __builtin_amdgcn_logf(x); }
__device__ __forceinline__ float fast_rcp(float x) { return __builtin_amdgcn_rcpf(x); }
__device__ __forceinline__ float sigmoidf_(float x) { return fast_rcp(1.f + fast_exp2(-x * LOG2E)); }
#define LDS_WAIT() asm volatile("s_waitcnt lgkmcnt(0)" ::: "memory")
__device__ __forceinline__ size_t akm(size_t row, int col) { return ((size_t)(col >> 6) * M + row) * 64 + (col & 63); }

#define XB_TMO      128
#define XB_XCNT(j)  (256  + 64 * (j))
#define XB_XSUB(j)  (1280 + 64 * (j))
#define XB_XGEN(j)  (2304 + 64 * (j))
#define XB_TOP      3328
#define XB_TOPGEN   3392
#define XCD_BAR_WORDS 3456
#define XB_SPIN_CAP (1u << 22)
__device__ __forceinline__ unsigned xb_ld(unsigned* p)              { return __hip_atomic_load(p, __ATOMIC_RELAXED, __HIP_MEMORY_SCOPE_AGENT); }
__device__ __forceinline__ unsigned xb_add(unsigned* p, unsigned v) { return __hip_atomic_fetch_add(p, v, __ATOMIC_RELAXED, __HIP_MEMORY_SCOPE_AGENT); }
__device__ __forceinline__ unsigned xb_xcc_id() { return (unsigned)__builtin_amdgcn_s_getreg((3 << 11) | 20) & 0xFu; }
#define XB_SPIN(cond, bar) do { unsigned _sp = 0; while (cond) { __builtin_amdgcn_s_sleep(1); \
    if ((++_sp & 255u) == 0u) { if (xb_ld(&(bar)[XB_TMO])) break; if (_sp > XB_SPIN_CAP) { atomicAdd(&(bar)[XB_TMO], 1u); break; } } } } while (0)
struct XcdBarrier { unsigned* bar; unsigned x; volatile LAS unsigned* st; };
__device__ __forceinline__ XcdBarrier xcd_barrier_post(unsigned* bar, volatile LAS unsigned* st) {
    XcdBarrier b; b.bar = bar; b.x = xb_xcc_id(); b.st = st;
    if (threadIdx.x == 0) (void)xb_add(&bar[XB_XCNT(b.x)], 1u);
    return b;
}
__device__ __forceinline__ void xcd_barrier_complete(unsigned* bar, unsigned x, unsigned& nloc, unsigned& nx) {
    const unsigned G = gridDim.x * gridDim.y * gridDim.z;
    unsigned sum, cnt, mine, sp = 0u;
    for (;;) {
        sum = 0u; cnt = 0u; mine = 0u;
#pragma unroll
        for (unsigned j = 0; j < 16; ++j) { const unsigned c = xb_ld(&bar[XB_XCNT(j)]); sum += c; cnt += (c > 0u) ? 1u : 0u; mine = (j == x) ? c : mine; }
        if (sum == G) break;
        __builtin_amdgcn_s_sleep(1);
        if ((++sp & 255u) == 0u) { if (xb_ld(&bar[XB_TMO])) break; if (sp > XB_SPIN_CAP) { atomicAdd(&bar[XB_TMO], 1u); break; } }
    }
    nloc = mine > 0u ? mine : 1u; nx = cnt > 0u ? cnt : 1u;
}
__device__ __forceinline__ void xcd_barrier(const XcdBarrier& b) {
    asm volatile("s_waitcnt vmcnt(0)" ::: "memory");
    __syncthreads();
    if (threadIdx.x == 0) {
        unsigned* bar = b.bar;
        __builtin_amdgcn_s_waitcnt(0);
        unsigned nloc = b.st[0], nx = b.st[1];
        if (nloc == 0u) { xcd_barrier_complete(bar, b.x, nloc, nx); b.st[0] = nloc; b.st[1] = nx; }
        const unsigned old = xb_add(&bar[XB_XSUB(b.x)], 1u);
        const unsigned gen = old / nloc;
        if (old + 1u == (gen + 1u) * nloc) {
            __builtin_amdgcn_fence(__ATOMIC_RELEASE, "agent");
            asm volatile("s_waitcnt vmcnt(0)" ::: "memory");
            const unsigned og = xb_add(&bar[XB_TOP], 1u);
            const unsigned tg = og / nx;
            if (og + 1u == (tg + 1u) * nx) xb_add(&bar[XB_TOPGEN], 1u);
            else XB_SPIN(xb_ld(&bar[XB_TOPGEN]) == tg, bar);
            __builtin_amdgcn_fence(__ATOMIC_ACQUIRE, "agent");
            xb_add(&bar[XB_XGEN(b.x)], 1u);
            asm volatile("s_waitcnt vmcnt(0)" ::: "memory");
        } else {
            XB_SPIN(xb_ld(&bar[XB_XGEN(b.x)]) == gen, bar);
            __builtin_amdgcn_fence(__ATOMIC_ACQUIRE, "agent");
            asm volatile("s_waitcnt vmcnt(0)" ::: "memory");
        }
    }
    __syncthreads();
}

struct Args { const float* in[18]; float* out; unsigned char* ws; int ph_lo, ph_hi; };
typedef const __attribute__((address_space(4))) Args* KArgs;
enum { I_X = 0, I_NATT, I_WIN, I_QG, I_KG, I_CPOS, I_CW1, I_CW2, I_RELB, I_HLB, I_HNG, I_WBR, I_WOUT, I_NFFN, I_WUP, I_CONVW, I_CONVB, I_WDN };
namespace pg8 {
constexpr int BM = 256, BK = 64, HALF = 128, HTB = HALF * BK * 2, STAGE_BYTES = 8 * HTB, NXCD = 8, LRS_OFF = STAGE_BYTES;
__host__ __device__ __forceinline__ int lds_byte(int r, int c) { const int st = (r >> 4) * 2 + (c >> 5), rr = r & 15, cc = c & 31, ob = rr * 64 + cc * 2; return st * 1024 + (ob ^ (((ob >> 9) & 1) << 5)); }
__host__ __device__ __forceinline__ void stage_rc(int b, int& R, int& C) { const int st = b / 1024, sb = b % 1024, swz = sb ^ (((sb >> 9) & 1) << 5); R = (st >> 1) * 16 + swz / 64; C = (st & 1) * 32 + (swz % 64) / 2; }
__host__ __device__ __forceinline__ int perm32(int rho) { const int n = rho >> 4, i = rho & 15; return 8 * (i >> 2) + 4 * n + (i & 3); }
struct Unit { int pm, pn, aux; };
constexpr int WCS = 64, BJS = 32;
struct Gemm { const bf16_t* A; const bf16_t* Bt; int M, N, K; int akm, bkm; };
struct StaticOrder {
    int nM, nN, nwg, G, c, WGM, rev;
    int pad_;
    __device__ void init(int M_, int N_, int G_, int c_, int wgm = 4, int rev_ = 0) { nM = M_ / BM; nN = N_ / BM; nwg = nM * nN; G = G_; c = c_; WGM = wgm; rev = rev_; pad_ = 0; }
    __device__ __forceinline__ bool tile(long L, Unit& u) const {
        if (L >= nwg) return false;
        int wgid = (int)L; { const int q = nwg / NXCD, r = nwg % NXCD, xcd = wgid % NXCD, off = wgid / NXCD; wgid = (xcd < r ? xcd * (q + 1) : r * (q + 1) + (xcd - r) * q) + off; }
        const int nig = WGM * nN, gid = wgid / nig, fm = gid * WGM, gsz = (nM - fm) < WGM ? (nM - fm) : WGM;
        u.pm = fm + ((wgid % nig) % gsz); u.pn = (wgid % nig) / gsz; u.aux = 0; if (rev) u.pm = nM - 1 - u.pm; return true;
    }
    __device__ __forceinline__ bool next(int i, Unit& u) const { return tile((long)i * G + c, u); }
    __device__ __forceinline__ const char* aptr(const Gemm& g, const Unit& u, size_t tstep) const { return (const char*)g.A + (size_t)u.pm * tstep; }
    __device__ __forceinline__ const char* bptr(const Gemm& g, const Unit& u, size_t tstep) const { return (const char*)g.Bt + (size_t)u.pn * tstep; }
    __device__ __forceinline__ void a_ready(const Unit&) const {}
    __device__ __forceinline__ void done(const Unit&) const {}
};
struct EpiStoreBf16 {
    static constexpr bool PERM = true, AFTER_DRAIN = false;
    static constexpr bool BPERM2 = true;
    static constexpr int PF_WAVES = 1;
    __device__ __forceinline__ void prefetch(LAS unsigned char* lds, const Unit& u, int wid, int lane) const {
        unsigned l16 = (unsigned)lane * 16u; asm volatile("" : "+v"(l16));
        __builtin_amdgcn_global_load_lds((const unsigned*)((const char*)rs + (size_t)u.pm * (BM * 4) + l16), (LAS unsigned*)(lds + LRS_OFF), 16, 0, 0); }
    static constexpr bool LDS_RS = true;
    bf16_t* O; int ldc; int sg_lo, sg_hi; const float* rs; LAS const float* lrs;
    __device__ __forceinline__ void operator()(const f32x4 (&acc)[2][2][4][2], const Unit& u, int wr, int wc, int fr, int fq) const {
        const int row0 = u.pm * BM + wr * 64 + fr, col0 = u.pn * BM + wc * WCS + 8 * fq; const bool sg = u.pn >= sg_lo && u.pn < sg_hi;
        float rsv[8];
#pragma unroll
        for (int g = 0; g < 8; ++g) rsv[g] = lrs[wr * 64 + fr + (g >> 2) * HALF + (g & 3) * 16];
#pragma unroll
        for (int ai = 0; ai < 2; ++ai)
#pragma unroll
            for (int m = 0; m < 4; ++m) { bf16_t* rowp = O + (size_t)(row0 + ai * HALF + m * 16) * ldc + col0;
                bf16_t* rowg = O + (size_t)(u.pm * BM + (ai * 4 + m) * 32 + (wr * 4 + wc) * 2 + (fq >> 1)) * ldc + u.pn * BM + ((fq & 1) * 16 + fr) * 8;
#pragma unroll
                for (int bj = 0; bj < 2; ++bj) { f32x4 v0 = acc[ai][bj][m][0] * rsv[ai * 4 + m], v1 = acc[ai][bj][m][1] * rsv[ai * 4 + m];
                    if (sg) {
#pragma unroll
                        for (int e = 0; e < 4; ++e) { v0[e] = fast_rcp(1.f + fast_exp2(v0[e])); v1[e] = fast_rcp(1.f + fast_exp2(v1[e])); } }
                    u32x4 w; w.x = pk2(v0[0], v0[1]); w.y = pk2(v0[2], v0[3]); w.z = pk2(v1[0], v1[1]); w.w = pk2(v1[2], v1[3]);
                    __builtin_nontemporal_store(w, (u32x4*)(sg ? rowg + (size_t)(bj * 16) * ldc : rowp + bj * BJS)); } }
    }
};
struct EpiConvAct {
    static constexpr bool PERM = true, AFTER_DRAIN = false, NO_RELAX = true;
    static constexpr bool LDS_RS = true;
    static constexpr bool APERM = true;
    static constexpr int PF_WAVES = 4;
    __device__ __forceinline__ void prefetch(LAS unsigned char* lds, const Unit& u, int wid, int lane) const {
        unsigned l_ = (unsigned)lane; asm volatile("" : "+v"(l_));
        const float* rs = (const float*)(ws + WS_RSTD); const float* cw = a->in[I_CONVW] + (size_t)layer * 3 * NUP; const float* cb = a->in[I_CONVB] + (size_t)layer * NUP;
        if (wid == 0) __builtin_amdgcn_global_load_lds((const unsigned*)((const char*)rs + (size_t)u.pm * (BM * 4) + l_ * 16u), (LAS unsigned*)(lds + LRS_OFF), 16, 0, 0);
        const unsigned sg = 2u * (unsigned)wid + (l_ >> 5), tap = sg & 3u;
        const float* src = (tap < 3u ? cw + (size_t)tap * NUP : cb) + (size_t)(sg >> 2) * DFF + (size_t)u.pn * 128 + (l_ & 31u) * 4u;
        __builtin_amdgcn_global_load_lds((const unsigned*)src, (LAS unsigned*)(lds + LRS_OFF + 1024 + wid * 1024), 16, 0, 0); }
    unsigned char* ws; KArgs a; int layer; LAS const float* lrs;
    static __device__ __forceinline__ f32x4 shr1(const f32x4 v) {
        f32x4 r;
#pragma unroll
        for (int e = 0; e < 4; ++e) r[e] = __int_as_float(__builtin_amdgcn_update_dpp(0, __float_as_int(v[e]), 0x111, 0xf, 0xf, true));
        return r; }
    __device__ __forceinline__ void operator()(const f32x4 (&acc)[2][2][4][2], const Unit& u, int wr, int wc, int fr, int fq) const {
        const int row0 = u.pm * BM + wr * 64 + 4 * fr, ch0 = u.pn * 128 + wc * 32 + 8 * fq;
        bf16_t* ACT = (bf16_t*)(ws + WS_ACT); bf16_t* side = (bf16_t*)(ws + WS_USIDE);
        f32x4 rsv[2];
#pragma unroll
        for (int ai = 0; ai < 2; ++ai) rsv[ai] = *(const LAS f32x4*)(lrs + ai * HALF + wr * 64 + 4 * fr);
        if (fr == 0 || fr == 15) {
            const bool lo = fr == 0;
#pragma unroll
            for (int ai = 0; ai < 2; ++ai) { const int blk = (u.pm * BM + ai * HALF + wr * 64) >> 6;
#pragma unroll
                for (int s2 = 0; s2 < 2; ++s2) { const float r_ = lo ? rsv[ai][s2] : rsv[ai][2 + s2];
                    bf16_t* sp = side + ((size_t)blk * 4 + (lo ? s2 : 2 + s2)) * NUP + u.pn * 256 + wc * 32 + 8 * fq;
#pragma unroll
                    for (int bj = 0; bj < 2; ++bj) { const f32x4 l0 = acc[ai][bj][s2][0], h0 = acc[ai][bj][2 + s2][0], l1 = acc[ai][bj][s2][1], h1 = acc[ai][bj][2 + s2][1]; f32x4 a0, a1;
#pragma unroll
                        for (int e = 0; e < 4; ++e) { a0[e] = (lo ? l0[e] : h0[e]) * r_; a1[e] = (lo ? l1[e] : h1[e]) * r_; }
                        *(u32x4*)(sp + bj * HALF) = (u32x4){pk2(a0[0], a0[1]), pk2(a0[2], a0[3]), pk2(a1[0], a1[1]), pk2(a1[2], a1[3])}; } } }
        }
        __builtin_amdgcn_sched_barrier(0);
#pragma unroll
        for (int ai = 0; ai < 2; ++ai) {
            u32x2 keep[4];
#pragma unroll
            for (int n = 0; n < 2; ++n) {
                LAS const float* lw = lrs + 256 + wc * 32 + 8 * fq + 4 * n;
                f32x4 sg[4];
                { const f32x4 w0 = *(const LAS f32x4*)(lw), w1 = *(const LAS f32x4*)(lw + 128), w2 = *(const LAS f32x4*)(lw + 256), bb = *(const LAS f32x4*)(lw + 384);
                  const f32x4 x0 = acc[ai][0][0][n] * rsv[ai][0], x1 = acc[ai][0][1][n] * rsv[ai][1], x2 = acc[ai][0][2][n] * rsv[ai][2], x3 = acc[ai][0][3][n] * rsv[ai][3];
                  const f32x4 p1 = shr1(x3), p2 = shr1(x2);
                  const f32x4 c0 = bb + w0 * p2 + w1 * p1 + w2 * x0, c1 = bb + w0 * p1 + w1 * x0 + w2 * x1, c2 = bb + w0 * x0 + w1 * x1 + w2 * x2, c3 = bb + w0 * x1 + w1 * x2 + w2 * x3;
#pragma unroll
                  for (int e = 0; e < 4; ++e) { sg[0][e] = c0[e] * sigmoidf_(c0[e]); sg[1][e] = c1[e] * sigmoidf_(c1[e]); sg[2][e] = c2[e] * sigmoidf_(c2[e]); sg[3][e] = c3[e] * sigmoidf_(c3[e]); } }
                __builtin_amdgcn_sched_barrier(0);
                { const f32x4 w0 = *(const LAS f32x4*)(lw + 512), w1 = *(const LAS f32x4*)(lw + 640), w2 = *(const LAS f32x4*)(lw + 768), bb = *(const LAS f32x4*)(lw + 896);
                  const f32x4 x0 = acc[ai][1][0][n] * rsv[ai][0], x1 = acc[ai][1][1][n] * rsv[ai][1], x2 = acc[ai][1][2][n] * rsv[ai][2], x3 = acc[ai][1][3][n] * rsv[ai][3];
                  const f32x4 p1 = shr1(x3), p2 = shr1(x2);
                  f32x4 cv[4]; cv[0] = bb + w0 * p2 + w1 * p1 + w2 * x0; cv[1] = bb + w0 * p1 + w1 * x0 + w2 * x1; cv[2] = bb + w0 * x0 + w1 * x1 + w2 * x2; cv[3] = bb + w0 * x1 + w1 * x2 + w2 * x3;
#pragma unroll
                  for (int m = 0; m < 4; ++m) { const f32x4 act = sg[m] * cv[m];
                      u32x2 w; w.x = pk2(act[0], act[1]); w.y = pk2(act[2], act[3]);
                      if (n == 0) keep[m] = w;
                      else *(u32x4*)(ACT + ((size_t)(ch0 >> 6) * M + (size_t)(row0 + ai * HALF + m)) * 64 + (ch0 & 63)) = (u32x4){keep[m].x, keep[m].y, w.x, w.y}; } }
                __builtin_amdgcn_sched_barrier(0);
            }
        }
    }
};
#ifndef ER_DEPTH
#define ER_DEPTH 4
#endif
struct EpiResidBf16 {
    static constexpr bool BPERM2 = true;
    static constexpr bool PERM = true, AFTER_DRAIN = false;
    bf16_t* XB; float* Cout; float* ssq; int ldc;
    __device__ __forceinline__ void operator()(const f32x4 (&acc)[2][2][4][2], const Unit& u, int wr, int wc, int fr, int fq) const {
        const int row0 = u.pm * BM + wr * 64 + fr, col0 = u.pn * BM + wc * WCS + 8 * fq;
        u32x4 old[ER_DEPTH][2]; float ssv[8];
#define ER_ROWI(g) (row0 + ((g) >> 2) * HALF + ((g) & 3) * 16)
#define ER_LOAD(g) do { old[(g) % ER_DEPTH][0] = *(const u32x4*)(XB + akm(ER_ROWI(g), col0)); old[(g) % ER_DEPTH][1] = *(const u32x4*)(XB + akm(ER_ROWI(g), col0 + BJS)); } while (0)
#pragma unroll
        for (int g = 0; g < ER_DEPTH; ++g) ER_LOAD(g);
#pragma unroll
        for (int g = 0; g < 8; ++g) {
            asm volatile("" ::: "memory");
            const size_t ro = (size_t)ER_ROWI(g) * ldc + col0; float ss = 0.f;
#pragma unroll
            for (int bj = 0; bj < 2; ++bj) { const u32x4 o_ = old[g % ER_DEPTH][bj];
                f32x4 v0 = acc[g >> 2][bj][g & 3][0], v1 = acc[g >> 2][bj][g & 3][1];
                v0[0] += bflo(o_.x); v0[1] += bfhi(o_.x); v0[2] += bflo(o_.y); v0[3] += bfhi(o_.y); v1[0] += bflo(o_.z); v1[1] += bfhi(o_.z); v1[2] += bflo(o_.w); v1[3] += bfhi(o_.w);
                if (Cout) { *(f32x4*)(Cout + ro + bj * BJS) = v0; *(f32x4*)(Cout + ro + bj * BJS + 4) = v1; }
                else { u32x4 w; w.x = pk2(v0[0], v0[1]); w.y = pk2(v0[2], v0[3]); w.z = pk2(v1[0], v1[1]); w.w = pk2(v1[2], v1[3]); *(u32x4*)(XB + akm(ER_ROWI(g), col0 + bj * BJS)) = w;
                    const float r0 = bflo(w.x), r1 = bfhi(w.x), r2 = bflo(w.y), r3 = bfhi(w.y), r4 = bflo(w.z), r5 = bfhi(w.z), r6 = bflo(w.w), r7 = bfhi(w.w);
                    ss += ((r0 * r0 + r1 * r1) + (r2 * r2 + r3 * r3)) + ((r4 * r4 + r5 * r5) + (r6 * r6 + r7 * r7)); } }
            ssv[g] = ss;
            if (g + ER_DEPTH < 8) ER_LOAD(g + ER_DEPTH);
        }
        if (!Cout) {
#pragma unroll
            for (int g = 0; g < 8; ++g) ssv[g] += __shfl_xor(ssv[g], 16);
#pragma unroll
            for (int g = 0; g < 8; ++g) ssv[g] += __shfl_xor(ssv[g], 32);
            if (fq == 0) {
#pragma unroll
                for (int g = 0; g < 8; ++g) ssq[(size_t)ER_ROWI(g) * 32 + u.pn * 4 + wc] = ssv[g]; } }
#undef ER_ROWI
#undef ER_LOAD
    }
};
struct EpiGated {
    static constexpr bool PERM = true, AFTER_DRAIN = false, HOOK = true, BPERM2 = true; static constexpr int HOOK_KT = 16;
    const bf16_t* P; bf16_t* merged;
    static __device__ __forceinline__ float gl(unsigned w) { return fmaxf(bflo(w), 1e-30f); }
    static __device__ __forceinline__ float gh(unsigned w) { return fmaxf(bfhi(w), 1e-30f); }
    __device__ __forceinline__ void mid(f32x4 (&acc)[2][2][4][2], const Unit& u, int wr, int wc, int fr, int fq, int s) const {
        const unsigned grow0 = (unsigned)(u.pm * BM + (wr * 4 + wc) * 2 + (fq >> 1)), gcol0 = (unsigned)(u.pn * BM + ((fq & 1) * 16 + fr) * 8);
        const char* Pa = (const char*)(P + PGT + (s - 1) * DM); const char* Pb = (const char*)(P + PGT + s * DM);
#pragma unroll
        for (int hf = 0; hf < 2; ++hf) {
            u32x4 ga[4][2], gb[4][2];
#pragma unroll
            for (int gg = 0; gg < 4; ++gg) { const int g = hf * 4 + gg; const unsigned po = ((grow0 + (unsigned)(g * 32)) * (unsigned)NPC + gcol0) * 2u;
#pragma unroll
                for (int bj = 0; bj < 2; ++bj) { ga[gg][bj] = *(const u32x4*)(Pa + (size_t)(po + bj * (16u * NPC * 2u))); gb[gg][bj] = *(const u32x4*)(Pb + (size_t)(po + bj * (16u * NPC * 2u))); } }
#pragma unroll
            for (int gg = 0; gg < 4; ++gg) { const int g = hf * 4 + gg;
#pragma unroll
                for (int bj = 0; bj < 2; ++bj) { const u32x4 a_ = ga[gg][bj], b_ = gb[gg][bj];
                    f32x4& v0 = acc[g >> 2][bj][g & 3][0]; f32x4& v1 = acc[g >> 2][bj][g & 3][1];
                    v0[0] *= bflo(a_.x) * fast_rcp(gl(b_.x)); v0[1] *= bfhi(a_.x) * fast_rcp(gh(b_.x)); v0[2] *= bflo(a_.y) * fast_rcp(gl(b_.y)); v0[3] *= bfhi(a_.y) * fast_rcp(gh(b_.y));
                    v1[0] *= bflo(a_.z) * fast_rcp(gl(b_.z)); v1[1] *= bfhi(a_.z) * fast_rcp(gh(b_.z)); v1[2] *= bflo(a_.w) * fast_rcp(gl(b_.w)); v1[3] *= bfhi(a_.w) * fast_rcp(gh(b_.w)); } }
            asm volatile("" ::: "memory"); }
    }
    __device__ __forceinline__ void operator()(const f32x4 (&acc)[2][2][4][2], const Unit& u, int wr, int wc, int fr, int fq) const {
        const unsigned row0 = (unsigned)(u.pm * BM + wr * 64 + fr), col0 = (unsigned)(u.pn * BM + wc * WCS + 8 * fq);
        const char* Pg = (const char*)(P + PGT + 2 * DM); char* mg = (char*)merged;
        u32x4 gw[8][2];
        const unsigned grow0 = (unsigned)(u.pm * BM + (wr * 4 + wc) * 2 + (fq >> 1)), gcol0 = (unsigned)(u.pn * BM + ((fq & 1) * 16 + fr) * 8);
#pragma unroll
        for (int g = 0; g < 8; ++g) { const unsigned po = ((grow0 + (unsigned)(g * 32)) * (unsigned)NPC + gcol0) * 2u;
#pragma unroll
            for (int bj = 0; bj < 2; ++bj) gw[g][bj] = *(const u32x4*)(Pg + (size_t)(po + bj * (16u * NPC * 2u))); }
#pragma unroll
        for (int g = 0; g < 8; ++g) { const unsigned moff = ((row0 + (unsigned)((g >> 2) * HALF + (g & 3) * 16)) * (unsigned)DM + col0) * 2u;
#pragma unroll
            for (int bj = 0; bj < 2; ++bj) { const u32x4 w_ = gw[g][bj]; const f32x4 v0 = acc[g >> 2][bj][g & 3][0], v1 = acc[g >> 2][bj][g & 3][1];
                u32x4 w; w.x = pk2(v0[0] * gl(w_.x), v0[1] * gh(w_.x)); w.y = pk2(v0[2] * gl(w_.y), v0[3] * gh(w_.y)); w.z = pk2(v1[0] * gl(w_.z), v1[1] * gh(w_.z)); w.w = pk2(v1[2] * gl(w_.w), v1[3] * gh(w_.w));
                *(u32x4*)(merged + akm(row0 + (unsigned)((g >> 2) * HALF + (g & 3) * 16), (int)col0 + bj * BJS)) = w; } }
    }
};

template <class E, class = void> struct has_relax { static constexpr bool v = true; };
template <class E> struct has_relax<E, decltype((void)E::NO_RELAX)> { static constexpr bool v = false; };
template <class E, class = void> struct has_lrs { static constexpr bool v = false; };
template <class E> struct has_lrs<E, decltype((void)E::LDS_RS)> { static constexpr bool v = true; };
template <class E, class = void> struct has_aperm { static constexpr bool v = false; };
template <class E> struct has_aperm<E, decltype((void)E::APERM)> { static constexpr bool v = true; };
template <class E, class = void> struct has_bperm2 { static constexpr bool v = false; };
template <class E> struct has_bperm2<E, decltype((void)E::BPERM2)> { static constexpr bool v = true; };
template <class E, class = void> struct has_hook { static constexpr bool v = false; };
template <class E> struct has_hook<E, decltype((void)E::HOOK)> { static constexpr bool v = true; };
template <class Epi, class Sched, bool ALIGN_EPI = false, bool SP2 = false>
__device__ __forceinline__ void gemm_phase(LAS unsigned char* lds, const Gemm g, const Sched& S, const Epi& E, const int tid, unsigned long long* dg = nullptr) {
    float zf; asm volatile("v_mov_b32 %0, 0" : "=v"(zf));
    const int wid = __builtin_amdgcn_readfirstlane(tid >> 6), lane = tid & 63, wr = wid >> 2, wc = wid & 3, fr = lane & 15, fq = lane >> 4;
    const int K = g.K, nt = K / BK;
    unsigned voffA[2], voffB[2];
#pragma unroll
    for (int i = 0; i < 2; ++i) { int R, C; stage_rc(tid * 16 + i * 8192, R, C); const int Rb = has_bperm2<Epi>::v ? (2 * (R & ~31) + perm32(R & 31)) : (Epi::PERM ? ((R & ~31) + perm32(R & 31)) : R);
        const int Ra = has_aperm<Epi>::v ? ((R & ~63) + 4 * (R & 15) + ((R >> 4) & 3)) : R;
        voffA[i] = (unsigned)(Ra * (g.akm ? BK : K) + C) * 2u; voffB[i] = (unsigned)(Rb * (g.bkm ? BK : K) + C) * 2u; }
    const size_t kstep = (size_t)(BK * 2);
    const size_t hstep = (size_t)HALF * K * 2;
    const size_t tstep = 2 * hstep;
    const size_t kstepA = g.akm ? (size_t)g.M * BK * 2 : kstep, hstepA = g.akm ? (size_t)HALF * BK * 2 : hstep, tstepA = 2 * hstepA;
    const size_t kstepB = g.bkm ? (size_t)g.N * BK * 2 : kstep, hstepB = has_bperm2<Epi>::v ? (g.bkm ? (size_t)32 * BK * 2 : (size_t)32 * K * 2) : (g.bkm ? (size_t)HALF * BK * 2 : hstep), tstepB = g.bkm ? (size_t)BM * BK * 2 : tstep;
    const unsigned ldsw = (unsigned)wid * 1024u;
    const int aoff = lds_byte(wr * 64 + fr, fq * 8), boff = lds_byte(wc * 32 + fr, fq * 8);
#define PG8_SA(b, h) (((b) * 2 + (h)) * HTB)
#define PG8_SB(b, h) ((4 + (b) * 2 + (h)) * HTB)
#define PG8_STAGE(bufoff, gbase, voff) do { _Pragma("unroll") for (int _i = 0; _i < 2; ++_i) \
        __builtin_amdgcn_global_load_lds((const unsigned*)((const char*)(gbase) + (voff)[_i]), (LAS unsigned*)(lds + (bufoff) + ldsw + _i * 8192), 16, 0, 0); } while (0)
#define PG8_LDA(dst, b, h) do { _Pragma("unroll") for (int m = 0; m < 4; ++m) _Pragma("unroll") for (int k = 0; k < 2; ++k) dst[m][k] = *(const LAS bf16x8*)(lds + PG8_SA(b, h) + aoff + m * 2048 + k * 1024); } while (0)
#define PG8_LDB(dst, b, h) do { _Pragma("unroll") for (int n = 0; n < 2; ++n) _Pragma("unroll") for (int k = 0; k < 2; ++k) dst[n][k] = *(const LAS bf16x8*)(lds + PG8_SB(b, h) + boff + n * 2048 + k * 1024); } while (0)
#define PG8_MMA(ai, bj, At, Bt) do { __builtin_amdgcn_s_setprio(1); _Pragma("unroll") for (int m = 0; m < 4; ++m) _Pragma("unroll") for (int n = 0; n < 2; ++n) _Pragma("unroll") for (int k = 0; k < 2; ++k) \
        acc[ai][bj][m][n] = __builtin_amdgcn_mfma_f32_16x16x32_bf16(Bt[n][k], At[m][k], acc[ai][bj][m][n], 0, 0, 0); __builtin_amdgcn_s_setprio(0); } while (0)
#define PG8_WAIT_V(n) asm volatile("s_waitcnt vmcnt(" #n ")" ::: "memory")
#define PG8_WAIT_L(n) asm volatile("s_waitcnt lgkmcnt(" #n ")" ::: "memory")
#define PG8_BAR __builtin_amdgcn_s_barrier()
#define PG8_SCHED __builtin_amdgcn_sched_barrier(0)
    Unit cur, nxt; int ui = 0;
    if (!S.next(0, cur)) return;
    f32x4 acc[2][2][4][2];
#pragma unroll
    for (int a = 0; a < 2; ++a)
#pragma unroll
        for (int b = 0; b < 2; ++b)
#pragma unroll
            for (int m = 0; m < 4; ++m)
#pragma unroll
                for (int n = 0; n < 2; ++n) acc[a][b][m][n] = (f32x4){zf, zf, zf, zf};
    bf16x8 At[4][2], B0[2][2], B1[2][2];
    const char* cA = S.aptr(g, cur, tstepA); const char* cB = S.bptr(g, cur, tstepB);
    S.a_ready(cur);
    if constexpr (SP2) {
        PG8_STAGE(PG8_SB(0, 0), cB, voffB); PG8_STAGE(PG8_SB(0, 1), cB + hstepB, voffB); PG8_STAGE(PG8_SA(0, 0), cA, voffA); PG8_STAGE(PG8_SA(0, 1), cA + hstepA, voffA);
        if (wr == 1) PG8_BAR;
        PG8_WAIT_V(2); PG8_BAR;
        PG8_STAGE(PG8_SB(1, 0), cB + kstepB, voffB); PG8_STAGE(PG8_SA(1, 0), cA + kstepA, voffA); PG8_STAGE(PG8_SB(1, 1), cB + hstepB + kstepB, voffB);
        PG8_WAIT_V(6); PG8_BAR;
    } else {
        PG8_STAGE(PG8_SB(0, 0), cB, voffB); PG8_STAGE(PG8_SA(0, 0), cA, voffA); PG8_STAGE(PG8_SB(0, 1), cB + hstepB, voffB); PG8_STAGE(PG8_SA(0, 1), cA + hstepA, voffA);
        if (wr == 1) PG8_BAR;
        PG8_WAIT_V(4); PG8_BAR;
        PG8_STAGE(PG8_SB(1, 0), cB + kstepB, voffB); PG8_STAGE(PG8_SA(1, 0), cA + kstepA, voffA); PG8_STAGE(PG8_SB(1, 1), cB + hstepB + kstepB, voffB);
        PG8_WAIT_V(6); PG8_BAR;
    }
    for (;;) {
        const bool has_next = S.next(ui + 1, nxt);
        if (MK_DIAG && dg && tid == 0 && (ui == 2 || ui == 3)) dg[(ui - 2) * 2] = wall_clock64();
        const char* nA = has_next ? S.aptr(g, nxt, tstepA) : cA; const char* nB = has_next ? S.bptr(g, nxt, tstepB) : cB;
        constexpr bool RELAX_ = has_relax<Epi>::v;
#define PG8_ITER(FIRST) do { \
            const bool last = (t == nt - 2); \
            const char* a1 = cA + (size_t)(t + 1) * kstepA; \
            const char* a2 = last ? nA : cA + (size_t)(t + 2) * kstepA; const char* b2 = last ? nB : cB + (size_t)(t + 2) * kstepB; \
            const char* a3 = a2 + kstepA; const char* b3 = b2 + kstepB; \
            if (last && has_next) S.a_ready(nxt); \
            PG8_LDB(B0, 0, 0); PG8_LDB(B1, 0, 1); PG8_SCHED; PG8_LDA(At, 0, 0); if (!(FIRST)) PG8_STAGE(PG8_SA(1, 1), a1 + hstepA, voffA); \
            if constexpr (has_lrs<Epi>::v) { if (t == 4 && wid < Epi::PF_WAVES) E.prefetch(lds, cur, wid, lane); } \
            if (FIRST) PG8_WAIT_V(24); else PG8_WAIT_V(8); PG8_WAIT_L(0); PG8_BAR; PG8_MMA(0, 0, At, B0); PG8_MMA(0, 1, At, B1); PG8_BAR; PG8_SCHED; \
            PG8_LDA(At, 0, 1); PG8_STAGE(PG8_SB(0, 0), b2, voffB); PG8_STAGE(PG8_SB(0, 1), b2 + hstepB, voffB); PG8_STAGE(PG8_SA(0, 0), a2, voffA); \
            if (FIRST) PG8_WAIT_V(24); else PG8_WAIT_V(8); PG8_WAIT_L(0); PG8_BAR; PG8_MMA(1, 0, At, B0); PG8_MMA(1, 1, At, B1); PG8_BAR; PG8_SCHED; \
            PG8_LDB(B0, 1, 0); PG8_LDB(B1, 1, 1); PG8_SCHED; PG8_LDA(At, 1, 0); PG8_STAGE(PG8_SA(0, 1), a2 + hstepA, voffA); \
            if (FIRST) PG8_WAIT_V(24); else PG8_WAIT_V(8); PG8_WAIT_L(0); PG8_BAR; PG8_MMA(0, 0, At, B0); PG8_MMA(0, 1, At, B1); PG8_BAR; PG8_SCHED; \
            PG8_LDA(At, 1, 1); PG8_STAGE(PG8_SB(1, 0), b3, voffB); PG8_STAGE(PG8_SB(1, 1), b3 + hstepB, voffB); PG8_STAGE(PG8_SA(1, 0), a3, voffA); \
            PG8_WAIT_V(8); PG8_WAIT_L(0); PG8_BAR; PG8_MMA(1, 0, At, B0); PG8_MMA(1, 1, At, B1); PG8_BAR; PG8_SCHED; \
            if constexpr (has_hook<Epi>::v) { if (t + 2 < nt && (t + 2) % Epi::HOOK_KT == 0) { int fr_ = fr, fq_ = fq; asm volatile("" : "+v"(fr_), "+v"(fq_)); const_cast<Epi&>(E).mid(acc, cur, wr, wc, fr_, fq_, (t + 2) / Epi::HOOK_KT); PG8_SCHED; } } \
            if (RELAX_ && last && has_next) { PG8_STAGE(PG8_SA(1, 1), a3 + hstepA, voffA); PG8_SCHED; }     \
        } while (0)
        int t = 0;
        if constexpr (RELAX_) { if (ui > 0) { PG8_ITER(1); t = 2; } }
        for (; t < nt; t += 2) { PG8_ITER(0); }
#undef PG8_ITER
        if (MK_DIAG && dg && tid == 0 && ui == 2) dg[1] = wall_clock64();
        if constexpr (ALIGN_EPI) { if (wr == 0) PG8_BAR; }
        if constexpr (!Epi::AFTER_DRAIN) { int fr_ = fr, fq_ = fq; asm volatile("" : "+v"(fr_), "+v"(fq_));
            E(acc, cur, wr, wc, fr_, fq_); S.done(cur); }
        if (!has_next) break;
#pragma unroll
        for (int a = 0; a < 2; ++a)
#pragma unroll
            for (int b = 0; b < 2; ++b)
#pragma unroll
                for (int m = 0; m < 4; ++m)
#pragma unroll
                    for (int n = 0; n < 2; ++n) acc[a][b][m][n] = (f32x4){zf, zf, zf, zf};
        cur = nxt; cA = nA; cB = nB; ++ui;
        if constexpr (ALIGN_EPI) { if (wr == 1) PG8_BAR; }
    }
    PG8_WAIT_V(0);
    if constexpr (!ALIGN_EPI) { if (wr == 0) PG8_BAR; }
    PG8_BAR;
#undef PG8_SA
#undef PG8_SB
#undef PG8_STAGE
#undef PG8_LDA
#undef PG8_LDB
#undef PG8_MMA
#undef PG8_WAIT_V
#undef PG8_WAIT_L
#undef PG8_BAR
#undef PG8_SCHED
}
}
#define PG8_SP2 true
#define PG8_ALIGN true


struct Frame {
    LAS unsigned char* lds; volatile LAS unsigned* MISC;
    unsigned* ctl; unsigned char* ws;
    int tid, lane, wave, G, bid;
};

__device__ __forceinline__ int up_src_col(int n) { const int pn = n >> 8, c = n & 255; return c < 128 ? 128 * pn + c : DFF + 128 * pn + (c - 128); }
__device__ __forceinline__ int inproj_src_col(int n) { return n < 2560 ? n : (n < 15872 ? n + 24 : (n < 15896 ? n - 15872 + 2560 : -1)); }
__device__ __forceinline__ void transpose_item(const float* W, int K, int Nsrc, bf16_t* WT, const float* gain, int mode, LAS float* scr, int item, int nblk, int lane, int ntot, int kbase = 0) {
    const int kb = item / nblk, nb = item - kb * nblk, k0 = 64 * kb, n0 = 32 * nb;
    const int nn = n0 + (lane & 7) * 4; const int sc = mode == 1 ? inproj_src_col(nn) : (mode == 2 ? up_src_col(nn) : nn);
    const float cs = mode != 1 ? 1.f : ((nn >= PQS && nn < PQS + 1024) ? -QSCALE * LOG2E : ((nn >= PGT && nn < PGN) ? -LOG2E : 1.f));
    f32x4 v[8];
#pragma unroll
    for (int i = 0; i < 8; ++i) { const int kk = 8 * i + (lane >> 3); v[i] = sc >= 0 ? __builtin_nontemporal_load((const f32x4*)(W + (size_t)(k0 + kk) * Nsrc + sc)) : (f32x4){0.f, 0.f, 0.f, 0.f}; }
#pragma unroll
    for (int i = 0; i < 8; ++i) { const int kk = 8 * i + (lane >> 3); const float gk = (gain ? gain[k0 + kk] : 1.f) * cs; LAS float* d = scr + kk * 33 + (lane & 7) * 4;
        d[0] = v[i].x * gk; d[1] = v[i].y * gk; d[2] = v[i].z * gk; d[3] = v[i].w * gk; }
    LDS_WAIT(); asm volatile("" ::: "memory");
    const int c = lane & 7;
#pragma unroll
    for (int j = 0; j < 4; ++j) { const int n = (lane >> 3) + 8 * j; const LAS float* sp = scr + (8 * c) * 33 + n;
        u32x4 o; o.x = pk2(sp[0 * 33], sp[1 * 33]); o.y = pk2(sp[2 * 33], sp[3 * 33]); o.z = pk2(sp[4 * 33], sp[5 * 33]); o.w = pk2(sp[6 * 33], sp[7 * 33]);
        if (ntot) *(u32x4*)(WT + ((size_t)((kbase + k0) >> 6) * ntot + (size_t)(n0 + n)) * 64 + 8 * c) = o;
        else *(u32x4*)(WT + (size_t)(n0 + n) * K + k0 + 8 * c) = o; }
    LDS_WAIT(); asm volatile("" ::: "memory");
}
__device__ __forceinline__ void rms_row0(const float* xin, bf16_t* XB, int m, float* rstd, int lane) {
    const f32x4* xr = (const f32x4*)xin + lane;
    f32x4 v[8]; float s = 0.f;
#pragma unroll
    for (int j = 0; j < 8; ++j) { v[j] = xr[64 * j]; s += (v[j].x * v[j].x + v[j].y * v[j].y) + (v[j].z * v[j].z + v[j].w * v[j].w); }
    s = wave_sum(s);
    if (lane == 0) *rstd = rsqrtf(s * (1.f / DM) + EPS);
#pragma unroll
    for (int j = 0; j < 8; ++j) { u32x2 w; w.x = pk2(v[j].x, v[j].y); w.y = pk2(v[j].z, v[j].w); *(u32x2*)(XB + akm((size_t)m, 4 * (lane + 64 * j))) = w; }
}
__device__ __forceinline__ void rstd_rows(Frame& F) {
    const float* ssq = (const float*)(F.ws + WS_SSQ); float* rstd = (float*)(F.ws + WS_RSTD);
    for (int row = F.bid * 512 + F.tid; row < M; row += F.G * 512) { const f32x4* p = (const f32x4*)(ssq + (size_t)row * 32); float s = 0.f;
#pragma unroll
        for (int j = 0; j < 8; ++j) { const f32x4 v = p[j]; s += (v.x + v.y) + (v.z + v.w); }
        rstd[row] = rsqrtf(s * (1.f / DM) + EPS); }
}

__device__ __forceinline__ void cvec_item(Frame& F, KArgs a, int layer, int j);
__device__ __forceinline__ void phase_A(Frame& F, KArgs a, int layer) {
    LAS float* scr = (LAS float*)(F.lds + F.wave * 16384);
    const int gw = F.bid * 8 + F.wave, NGW = F.G * 8;
    bf16_t* Wt_in = (bf16_t*)(F.ws + WS_WIN); bf16_t* Wt_br = (bf16_t*)(F.ws + WS_WBR); bf16_t* Wt_out = (bf16_t*)(F.ws + WS_WOUT);
    bf16_t* Wt_up = (bf16_t*)(F.ws + WS_WUP); bf16_t* Wt_dn = (bf16_t*)(F.ws + WS_WDN);
    const float* w_in = a->in[I_WIN] + (size_t)layer * DM * INC; const float* g_att = a->in[I_NATT] + layer * DM;
    const float* w_br = a->in[I_WBR] + (size_t)layer * 3 * BW * DM; const float* w_out = a->in[I_WOUT] + (size_t)layer * DM * DM;
    const float* w_up = a->in[I_WUP] + (size_t)layer * DM * NUP; const float* g_ffn = a->in[I_NFFN] + layer * DM;
    const float* w_dn = a->in[I_WDN] + (size_t)layer * DFF * DM;
    constexpr int I_IN = (DM / 64) * (NPC / 32), I_BR1 = (BW / 64) * (DM / 32), I_OUT = (DM / 64) * (DM / 32), I_UP = (DM / 64) * (NUP / 32), I_DN = (DFF / 64) * (DM / 32);
    constexpr int I_C1 = (4096 / 64) * (HD / 32);
    constexpr int NITEMS = I_IN + 3 * I_BR1 + I_OUT + I_UP + I_DN + 2 * I_C1;
    for (int it = gw; it < NITEMS; it += NGW) {
        int r = it;
        if (r < I_IN) { transpose_item(w_in, DM, INC, Wt_in, g_att, 1, scr, r, NPC / 32, F.lane, NPC); continue; } r -= I_IN;
        if (r < 3 * I_BR1) { const int n = r / I_BR1; r -= n * I_BR1; transpose_item(w_br + (size_t)n * BW * DM, BW, DM, Wt_br, nullptr, 0, scr, r, DM / 32, F.lane, DM, n * BW); continue; } r -= 3 * I_BR1;
        if (r < I_OUT) { transpose_item(w_out, DM, DM, Wt_out, nullptr, 0, scr, r, DM / 32, F.lane, DM); continue; } r -= I_OUT;
        if (r < I_UP) { transpose_item(w_up, DM, NUP, Wt_up, g_ffn, 2, scr, r, NUP / 32, F.lane, NUP); continue; } r -= I_UP;
        if (r < I_DN) { transpose_item(w_dn, DFF, DM, Wt_dn, nullptr, 0, scr, r, DM / 32, F.lane, DM); continue; } r -= I_DN;
        { const int j = r / I_C1; r -= j * I_C1; transpose_item(a->in[I_CW1] + (size_t)(layer * 2 + j) * 4096 * HD, 4096, HD, (bf16_t*)(F.ws + WS_MISC + MISC_WC1) + (size_t)j * HD * 4096, nullptr, 0, scr, r, HD / 32, F.lane, 0); }
    }
    if (F.bid < 64) cvec_item(F, a, layer, F.bid);
    if (layer == 0) { bf16_t* XB = (bf16_t*)(F.ws + WS_XB); float* rstd = (float*)(F.ws + WS_RSTD);
        for (int m = gw; m < M; m += NGW) rms_row0(a->in[I_X] + (size_t)m * DM, XB, m, rstd + m, F.lane); }
    else rstd_rows(F);
}
__device__ __forceinline__ void phase_F(Frame& F, KArgs a) { rstd_rows(F); }
__device__ __forceinline__ void phase_H(Frame& F, KArgs a, int layer) {
    const bf16_t* SD = (const bf16_t*)(F.ws + WS_USIDE); bf16_t* ACT = (bf16_t*)(F.ws + WS_ACT);
    const float* cw = a->in[I_CONVW] + (size_t)layer * 3 * NUP; const float* cb = a->in[I_CONVB] + (size_t)layer * NUP;
    constexpr int CG = DFF / 8, NTASK = (M / 64) * 2 * CG;
    for (int task = F.bid * 512 + F.tid; task < NTASK; task += F.G * 512) {
        const int cg = task % CG, rb = task / CG, rw = rb & 1, blk = rb >> 1; if ((blk & 31) == 0) continue;
        const int c0 = cg * 8, uc = 256 * (c0 >> 7) + (c0 & 127);
        const bf16_t* t2 = rw == 0 ? SD + ((size_t)(blk - 1) * 4 + 2) * NUP : SD + ((size_t)(blk - 1) * 4 + 3) * NUP;
        const bf16_t* t1 = rw == 0 ? SD + ((size_t)(blk - 1) * 4 + 3) * NUP : SD + ((size_t)blk * 4 + 0) * NUP;
        const bf16_t* t0 = SD + ((size_t)blk * 4 + rw) * NUP;
        const u32x4 g2 = *(const u32x4*)(t2 + uc), g1 = *(const u32x4*)(t1 + uc), g0 = *(const u32x4*)(t0 + uc), v2 = *(const u32x4*)(t2 + uc + 128), v1 = *(const u32x4*)(t1 + uc + 128), v0 = *(const u32x4*)(t0 + uc + 128);
        const unsigned G2[4] = {g2.x, g2.y, g2.z, g2.w}, G1[4] = {g1.x, g1.y, g1.z, g1.w}, G0[4] = {g0.x, g0.y, g0.z, g0.w}, V2[4] = {v2.x, v2.y, v2.z, v2.w}, V1[4] = {v1.x, v1.y, v1.z, v1.w}, V0[4] = {v0.x, v0.y, v0.z, v0.w};
        float o[8];
#pragma unroll
        for (int e = 0; e < 8; ++e) { const int q = e >> 1; const bool hi = e & 1;
            const float xg2 = hi ? bfhi(G2[q]) : bflo(G2[q]), xg1 = hi ? bfhi(G1[q]) : bflo(G1[q]), xg0 = hi ? bfhi(G0[q]) : bflo(G0[q]);
            const float xv2 = hi ? bfhi(V2[q]) : bflo(V2[q]), xv1 = hi ? bfhi(V1[q]) : bflo(V1[q]), xv0 = hi ? bfhi(V0[q]) : bflo(V0[q]);
            const float cgv = cb[c0 + e] + cw[c0 + e] * xg2 + cw[NUP + c0 + e] * xg1 + cw[2 * NUP + c0 + e] * xg0;
            const float cvv = cb[DFF + c0 + e] + cw[DFF + c0 + e] * xv2 + cw[NUP + DFF + c0 + e] * xv1 + cw[2 * NUP + DFF + c0 + e] * xv0;
            o[e] = cgv * sigmoidf_(cgv) * cvv; }
        *(u32x4*)(ACT + ((size_t)(c0 >> 6) * M + (size_t)(blk * 64 + rw)) * 64 + (c0 & 63)) = (u32x4){pk2(o[0], o[1]), pk2(o[2], o[3]), pk2(o[4], o[5]), pk2(o[6], o[7])};
    }
}

__device__ __forceinline__ int q_next(Frame& F, unsigned* head) {
    __syncthreads();
    if (F.tid == 0) F.MISC[16] = __hip_atomic_fetch_add(head, 1u, __ATOMIC_RELAXED, __HIP_MEMORY_SCOPE_AGENT);
    __syncthreads();
    return __builtin_amdgcn_readfirstlane((int)F.MISC[16]);
}
__device__ __forceinline__ int t5_bucket(int n) {
    if (n < 16) return n;
    int b = 16;
    b += (n >= 19); b += (n >= 21); b += (n >= 24); b += (n >= 27); b += (n >= 31); b += (n >= 35); b += (n >= 40); b += (n >= 46);
    b += (n >= 52); b += (n >= 59); b += (n >= 67); b += (n >= 77); b += (n >= 87); b += (n >= 99); b += (n >= 113);
    return b;
}
__device__ __forceinline__ int crow(int i, int h) { return (i & 3) + 8 * (i >> 2) + 4 * h; }

#define MFMA32(a, b, c) __builtin_amdgcn_mfma_f32_32x32x16_bf16((a), (b), (c), 0, 0, 0)
__device__ __forceinline__ float sum8lanes(float v) { v += __shfl_xor(v, 1); v += __shfl_xor(v, 2); v += __shfl_xor(v, 4); return v; }
__device__ __forceinline__ void norm16(unsigned* pp, const float* gn, float sc) {
    const u32x4 w0 = *(const u32x4*)pp, w1 = *(const u32x4*)(pp + 4); const unsigned w[8] = {w0.x, w0.y, w0.z, w0.w, w1.x, w1.y, w1.z, w1.w};
    float x[16], ss = 0.f;
#pragma unroll
    for (int q = 0; q < 8; ++q) { x[2 * q] = bflo(w[q]); x[2 * q + 1] = bfhi(w[q]); ss += x[2 * q] * x[2 * q] + x[2 * q + 1] * x[2 * q + 1]; }
    const float r = rsqrtf(sum8lanes(ss) * (1.f / HD) + EPS) * sc;
    u32x4 o0, o1;
    o0.x = pk2(x[0] * r * gn[0], x[1] * r * gn[1]); o0.y = pk2(x[2] * r * gn[2], x[3] * r * gn[3]); o0.z = pk2(x[4] * r * gn[4], x[5] * r * gn[5]); o0.w = pk2(x[6] * r * gn[6], x[7] * r * gn[7]);
    o1.x = pk2(x[8] * r * gn[8], x[9] * r * gn[9]); o1.y = pk2(x[10] * r * gn[10], x[11] * r * gn[11]); o1.z = pk2(x[12] * r * gn[12], x[13] * r * gn[13]); o1.w = pk2(x[14] * r * gn[14], x[15] * r * gn[15]);
    *(u32x4*)pp = o0; *(u32x4*)(pp + 4) = o1;
}
__device__ __forceinline__ void item_norm(Frame& F, KArgs a, int layer, int it) {
    bf16_t* P = (bf16_t*)(F.ws + WS_P);
    const float* qg = a->in[I_QG] + layer * HD; const float* kg = a->in[I_KG] + layer * 3 * HD;
    const int lane = F.lane, e0 = (lane & 7) * 16;
    float gq[16], gk[16];
#pragma unroll
    for (int e = 0; e < 16; ++e) { gq[e] = qg[e0 + e]; gk[e] = kg[((lane >> 4) & 1 ? 2 : 1) * HD + e0 + e]; }
    for (int rr = 0; rr < 8; ++rr) {
        bf16_t* pr = P + (size_t)(it * 64 + F.wave * 8 + rr) * NPC;
        norm16((unsigned*)(pr + PQN + lane * 16), gq, QSCALE * LOG2E);
        if (lane < 32) norm16((unsigned*)(pr + (lane < 16 ? PKS + lane * 16 : PKW + (lane - 16) * 16)), gk, 1.f);
    }
}
__device__ __forceinline__ void item_hgfin(Frame& F, KArgs a, int layer, int it) {
    const bf16_t* P = (const bf16_t*)(F.ws + WS_P); const float* OR = (const float*)(F.ws + WS_ORAW); bf16_t* OH = (bf16_t*)(F.ws + WS_OBR) + 2 * BW;
    const float* ng = a->in[I_HNG] + layer * HD; const int lane = F.lane, e0 = (lane & 7) * 16;
    float gn[16];
#pragma unroll
    for (int e = 0; e < 16; ++e) gn[e] = ng[e0 + e];
    for (int rr = 0; rr < 8; ++rr) { const size_t row = (size_t)(it * 64 + F.wave * 8 + rr);
        const f32x4* op = (const f32x4*)(OR + row * BW + lane * 16); const f32x4 o0 = op[0], o1 = op[1], o2 = op[2], o3 = op[3];
        const unsigned* gp = (const unsigned*)(P + row * NPC + PGH + lane * 16); const u32x4 g0 = *(const u32x4*)gp, g1 = *(const u32x4*)(gp + 4);
        const float x[16] = {o0.x, o0.y, o0.z, o0.w, o1.x, o1.y, o1.z, o1.w, o2.x, o2.y, o2.z, o2.w, o3.x, o3.y, o3.z, o3.w}; const unsigned gw[8] = {g0.x, g0.y, g0.z, g0.w, g1.x, g1.y, g1.z, g1.w};
        float ss = 0.f;
#pragma unroll
        for (int e = 0; e < 16; ++e) ss += x[e] * x[e];
        const float r = rsqrtf(sum8lanes(ss) * (1.f / HD) + EPS);
        unsigned ow[8];
#pragma unroll
        for (int q = 0; q < 8; ++q) ow[q] = pk2(x[2 * q] * r * gn[2 * q] * sigmoidf_(bflo(gw[q])), x[2 * q + 1] * r * gn[2 * q + 1] * sigmoidf_(bfhi(gw[q])));
        unsigned* dst = (unsigned*)(OH + row * (3 * BW) + lane * 16);
        *(u32x4*)dst = (u32x4){ow[0], ow[1], ow[2], ow[3]}; *(u32x4*)(dst + 4) = (u32x4){ow[4], ow[5], ow[6], ow[7]};
    }
}
__device__ __forceinline__ void cvec_item(Frame& F, KArgs a, int layer, int blk) {
    const int j = blk >> 5, ks = blk & 31;
    const float* pos = a->in[I_CPOS] + (size_t)(layer * 2 + j) * 32 * HD; const float* w1 = a->in[I_CW1] + (size_t)(layer * 2 + j) * 32 * HD * HD;
    LAS float* red = (LAS float*)F.lds; const int e = F.tid & 127, sub = F.tid >> 7;
    float acc = 0.f;
#pragma unroll 8
    for (int k = ks * 128 + sub * 32; k < ks * 128 + sub * 32 + 32; ++k) acc += pos[k] * w1[(size_t)k * HD + e];
    __syncthreads(); red[sub * 128 + e] = acc; __syncthreads();
    if (F.tid < 128) ((float*)(F.ctl + CW_CVEC))[(j * 32 + ks) * 128 + F.tid] = (red[F.tid] + red[128 + F.tid]) + (red[256 + F.tid] + red[384 + F.tid]);
    __syncthreads();
}
__device__ __forceinline__ void item_compress(Frame& F, KArgs a, int layer, int id) {
    const int j = id >> 7, rem = id & 127, b = rem >> 3, g = (rem >> 2) & 1, n0 = (rem & 3) * 32;
    const bf16_t* P = (const bf16_t*)(F.ws + WS_P);
    LAS float* red = (LAS float*)F.lds;
    LAS float* hid = (LAS float*)(F.lds + 16384);
    LAS float* outv = (LAS float*)(F.lds + 16384 + 32 * 132 * 4);
    const int tid = F.tid, lane = F.lane, wave = F.wave, r = lane & 31, h = lane >> 5, ct = wave & 3, kh = wave >> 2;
    f32x16 acc;
#pragma unroll
    for (int i = 0; i < 16; ++i) acc[i] = 0.f;
    {
        int trow = 16 * (n0 + r) + 16 * kh; const int tmax = T - 1;
        const bf16_t* Ab = P + (size_t)(b * T) * NPC + (j ? PVC : PKC) + g * HD + 8 * h;
        const bf16_t* Bb = (const bf16_t*)(F.ws + WS_MISC + MISC_WC1) + (size_t)(j * HD + 32 * ct + r) * 4096 + (size_t)(16 * kh) * HD + 8 * h;
        for (int l = 0; l < 16; ++l) { const int t = (trow + l) < tmax ? (trow + l) : tmax; const bf16_t* ap = Ab + (size_t)t * NPC; const bf16_t* bp = Bb + l * HD;
#pragma unroll
            for (int ds = 0; ds < 8; ++ds) { const bf16x8 av = *(const bf16x8*)(ap + 16 * ds), bv = *(const bf16x8*)(bp + 16 * ds); acc = MFMA32(av, bv, acc); } }
    }
    if (kh == 1) {
#pragma unroll
        for (int i = 0; i < 16; ++i) red[(ct * 16 + i) * 64 + lane] = acc[i]; }
    __syncthreads();
    if (kh == 0) { float cv = 0.f; { const float* cp = (const float*)(F.ctl + CW_CVEC) + (size_t)(j * 32) * 128 + 32 * ct + r;
#pragma unroll 8
        for (int q = 0; q < 32; ++q) cv += cp[q * 128]; }
#pragma unroll
        for (int i = 0; i < 16; ++i) { const float x = acc[i] + red[(ct * 16 + i) * 64 + lane] + cv;
            const float y = 0.7978845608028654f * (x + 0.044715f * x * x * x);
            const float th = 1.f - 2.f * fast_rcp(1.f + fast_exp2(2.f * y * LOG2E));
            hid[crow(i, h) * 132 + 32 * ct + r] = 0.5f * x * (1.f + th); } }
    __syncthreads();
    { const int e2 = tid & 127, ng = __builtin_amdgcn_readfirstlane(tid >> 7); const float* w2 = a->in[I_CW2] + (size_t)(layer * 2 + j) * HD * HD + e2;
      float o[8];
#pragma unroll
      for (int q = 0; q < 8; ++q) o[q] = 0.f;
      for (int k = 0; k < 128; k += 4) { const float w0 = w2[(size_t)k * HD], w1 = w2[(size_t)(k + 1) * HD], w2_ = w2[(size_t)(k + 2) * HD], w3 = w2[(size_t)(k + 3) * HD];
#pragma unroll
          for (int q = 0; q < 8; ++q) { const f32x4 hv = *(const LAS f32x4*)(hid + (8 * ng + q) * 132 + k); o[q] += (hv.x * w0 + hv.y * w1) + (hv.z * w2_ + hv.w * w3); } }
#pragma unroll
      for (int q = 0; q < 8; ++q) outv[(8 * ng + q) * 132 + e2] = o[q]; }
    __syncthreads();
    const float* kg0 = a->in[I_KG] + layer * 3 * HD;
#pragma unroll
    for (int q = 0; q < 4; ++q) { const int n = 4 * wave + q; float v0 = outv[n * 132 + 2 * lane], v1 = outv[n * 132 + 2 * lane + 1];
        if (j == 0) { const float ss = wave_sum(v0 * v0 + v1 * v1); const float rr = rsqrtf(ss * (1.f / HD) + EPS); v0 *= rr * kg0[2 * lane]; v1 *= rr * kg0[2 * lane + 1]; }
        if (n0 + n >= 127) { v0 = 0.f; v1 = 0.f; }
        bf16_t* dst = (bf16_t*)(F.ws + WS_MISC + (j ? MISC_VCMP : MISC_KCMP)) + (size_t)((b * 2 + g) * 128 + n0 + n) * HD;
        *((unsigned*)dst + lane) = pk2(v0, v1); }
}
__device__ __forceinline__ float xhalf_sum(float v);
constexpr int HG_Q1 = 0, HG_K1 = 17408, HG_QI = 34816, HG_K2 = 43520, HG_K3T = 52224, HG_VT = 70656, HG_AT = 89088, HG_SB = 98304, HG_TOT = 133120, HG_LB = 135168, HG_SS = 135680;
__device__ __forceinline__ void item_hgrn(Frame& F, KArgs a, int layer, int id) {
    const int b = id >> 3, hh = id & 7;
    const bf16_t* P = (const bf16_t*)(F.ws + WS_P); bf16_t* OH = (bf16_t*)(F.ws + WS_OBR);
    LAS unsigned char* L = F.lds;
    LAS float* tot = (LAS float*)(L + HG_TOT); LAS float* lbs = (LAS float*)(L + HG_LB); LAS float* ssp = (LAS float*)(L + HG_SS);
    const int tid = F.tid, lane = F.lane, wave = F.wave, r = lane & 31, h = lane >> 5;
    if (tid < 128) { const float* hb = a->in[I_HLB] + hh * HD + tid; const float x0 = hb[0], x1 = hb[1024], x2 = hb[2048], x3 = hb[3072];
        const float mx = fmaxf(fmaxf(x0, x1), fmaxf(x2, x3)); const float e0 = __expf(x0 - mx), e1 = __expf(x1 - mx), e2 = __expf(x2 - mx), e3 = __expf(x3 - mx);
        const float inv = 1.f / (e0 + e1 + e2 + e3); float c = 0.f; if (layer >= 1) c += e1; if (layer >= 2) c += e2; if (layer >= 3) c += e3;
        lbs[tid] = fmaxf(c * inv, 0.f); }
    { unsigned zu; asm volatile("v_mov_b32 %0, 0" : "=v"(zu));
      for (int i = tid; i < 34816 / 16; i += 512) *(LAS u32x4*)(L + HG_SB + i * 16) = (u32x4){zu, zu, zu, zu}; }
    f32x16 Sacc[2];
#pragma unroll
    for (int q = 0; q < 2; ++q)
#pragma unroll
        for (int i = 0; i < 16; ++i) Sacc[q][i] = 0.f;
    const int pd = tid & 127, psc = __builtin_amdgcn_readfirstlane(tid >> 7);
    const int srow = tid >> 4, sch = tid & 15;
    const bf16_t* gq = P + (size_t)(b * T + srow) * NPC + PQH + hh * HD + sch * 8; const bf16_t* gf = P + (size_t)(b * T + srow) * NPC + PFH + hh * HD + sch * 8;
    const bf16_t* gv = P + (size_t)(b * T + srow) * NPC + PIH + hh * HD + sch * 8;
    u32x4 rq0 = *(const u32x4*)gq, rq1 = *(const u32x4*)(gq + (size_t)32 * NPC), rf0 = *(const u32x4*)gf, rf1 = *(const u32x4*)(gf + (size_t)32 * NPC), rv0 = *(const u32x4*)gv, rv1 = *(const u32x4*)(gv + (size_t)32 * NPC);
    const int et = wave & 3, tt2 = wave >> 2;
    f32x4 gn4[4]; { const float* ng = a->in[I_HNG] + layer * HD;
#pragma unroll
      for (int g4 = 0; g4 < 4; ++g4) gn4[g4] = *(const f32x4*)(ng + 32 * et + 8 * g4 + 4 * h); }
    u32x2 gw4[4];
    for (int c = 0; c < T / 64; ++c) {
        __syncthreads();
        *(LAS u32x4*)(L + HG_Q1 + srow * 272 + sch * 16) = rq0; *(LAS u32x4*)(L + HG_Q1 + (srow + 32) * 272 + sch * 16) = rq1;
        *(LAS u32x4*)(L + HG_K1 + srow * 272 + sch * 16) = rf0; *(LAS u32x4*)(L + HG_K1 + (srow + 32) * 272 + sch * 16) = rf1;
        { const unsigned v0[4] = {rv0.x, rv0.y, rv0.z, rv0.w}, v1[4] = {rv1.x, rv1.y, rv1.z, rv1.w};
#pragma unroll
          for (int q = 0; q < 4; ++q) { LAS unsigned short* p0 = (LAS unsigned short*)(L + HG_VT + (8 * sch + 2 * q) * 144 + srow * 2); LAS unsigned short* p1 = (LAS unsigned short*)(L + HG_VT + (8 * sch + 2 * q + 1) * 144 + srow * 2);
              p0[0] = (unsigned short)(v0[q] & 0xffffu); p1[0] = (unsigned short)(v0[q] >> 16); p0[32] = (unsigned short)(v1[q] & 0xffffu); p1[32] = (unsigned short)(v1[q] >> 16); } }
        __syncthreads();
        { const bf16_t* gp = P + (size_t)(b * T + 64 * c + 32 * tt2 + r) * NPC + PGH + hh * HD + 32 * et + 4 * h;
#pragma unroll
          for (int g4 = 0; g4 < 4; ++g4) gw4[g4] = *(const u32x2*)(gp + 8 * g4); }
        if (c + 1 < T / 64) { const size_t adv = (size_t)(64 * (c + 1)) * NPC;
            rq0 = *(const u32x4*)(gq + adv); rq1 = *(const u32x4*)(gq + adv + (size_t)32 * NPC); rf0 = *(const u32x4*)(gf + adv); rf1 = *(const u32x4*)(gf + adv + (size_t)32 * NPC);
            rv0 = *(const u32x4*)(gv + adv); rv1 = *(const u32x4*)(gv + adv + (size_t)32 * NPC); }
        float qv[16], kv[16], bl[16];
        { const float lb = lbs[pd]; float run = 0.f;
#pragma unroll
          for (int tt = 0; tt < 16; ++tt) { const int t = 16 * psc + tt;
              qv[tt] = bf2f(*(const LAS unsigned short*)(L + HG_Q1 + t * 272 + pd * 2)); const float fp = bf2f(*(const LAS unsigned short*)(L + HG_K1 + t * 272 + pd * 2));
              const float ex = fast_exp2(-fabsf(fp) * LOG2E);
              const float sg = (fp >= 0.f ? 1.f : ex) * fast_rcp(1.f + ex);
              const float f = lb + (1.f - lb) * sg; kv[tt] = 1.f - f;
              const float lf = (layer == 0) ? (fminf(fp, 0.f) - LN2 * fast_log2(1.f + ex)) : LN2 * fast_log2(f);
              run += lf; bl[tt] = run; }
          tot[psc * 128 + pd] = run; }
        __syncthreads();
        { const float t0 = tot[pd], t1 = tot[128 + pd], t2 = tot[256 + pd], t3 = tot[384 + pd];
          const float b31 = t0 + t1, b63 = (t0 + t1) + (t2 + t3);
          const float pre = psc == 0 ? 0.f : (psc == 1 ? t0 : (psc == 2 ? b31 : b31 + t2));
          const float rref = psc >= 2 ? b31 : 0.f; const float eb31 = fast_exp2(b31 * LOG2E), c3 = fast_exp2((b63 - rref) * LOG2E);
          unsigned k3w[8];
#pragma unroll
          for (int tt = 0; tt < 16; ++tt) { const int t = 16 * psc + tt; const float bb = pre + bl[tt];
              const float e1 = fast_exp2((bb - rref) * LOG2E); const float q1 = qv[tt] * e1;
              const float k1 = kv[tt] * fast_exp2(fminf(rref - bb, 80.f) * LOG2E);
              const float k3 = k1 * c3;
              *(LAS unsigned short*)(L + HG_Q1 + t * 272 + pd * 2) = (unsigned short)(pk2(q1, 0.f) & 0xffffu);
              *(LAS unsigned short*)(L + HG_K1 + t * 272 + pd * 2) = (unsigned short)(pk2(k1, 0.f) & 0xffffu);
              if (psc >= 2) *(LAS unsigned short*)(L + HG_QI + (t - 32) * 272 + pd * 2) = (unsigned short)(pk2(q1 * eb31, 0.f) & 0xffffu);
              else *(LAS unsigned short*)(L + HG_K2 + t * 272 + pd * 2) = (unsigned short)(pk2(k1 * eb31, 0.f) & 0xffffu);
              if (tt & 1) k3w[tt >> 1] = (k3w[tt >> 1] & 0xffffu) | (pk2(0.f, k3) & 0xffff0000u); else k3w[tt >> 1] = pk2(k3, 0.f) & 0xffffu; }
          *(LAS u32x4*)(L + HG_K3T + pd * 144 + psc * 32) = (u32x4){k3w[0], k3w[1], k3w[2], k3w[3]}; *(LAS u32x4*)(L + HG_K3T + pd * 144 + psc * 32 + 16) = (u32x4){k3w[4], k3w[5], k3w[6], k3w[7]}; }
        __syncthreads();
        if (wave < 3) {
            const int st = wave == 1 ? 1 : 0, ta = wave == 0 ? 0 : 1;
            const LAS unsigned char* Kb = L + (wave == 2 ? HG_K2 : HG_K1 + st * 32 * 272) + r * 272 + 16 * h; const LAS unsigned char* Qb = L + HG_Q1 + (32 * ta + r) * 272 + 16 * h;
            f32x16 at;
#pragma unroll
            for (int i = 0; i < 16; ++i) at[i] = 0.f;
#pragma unroll
            for (int s8 = 0; s8 < 8; ++s8) at = MFMA32(*(const LAS bf16x8*)(Kb + 32 * s8), *(const LAS bf16x8*)(Qb + 32 * s8), at);
            if (wave < 2) {
#pragma unroll
                for (int i = 0; i < 16; ++i) at[i] = (crow(i, h) <= r) ? at[i] : 0.f; }
#pragma unroll
            for (int g4 = 0; g4 < 4; ++g4) { u32x2 w; w.x = pk2(at[4 * g4], at[4 * g4 + 1]); w.y = pk2(at[4 * g4 + 2], at[4 * g4 + 3]);
                *(LAS u32x2*)(L + HG_AT + (32 * ta + r) * 144 + (32 * st + 8 * g4 + 4 * h) * 2) = w; }
        }
        f32x16 oo;
#pragma unroll
        for (int i = 0; i < 16; ++i) oo[i] = 0.f;
        { const LAS unsigned char* Sb = L + HG_SB + (32 * et + r) * 272 + 16 * h; const LAS unsigned char* Qb = L + (tt2 ? HG_QI : HG_Q1) + r * 272 + 16 * h;
#pragma unroll
          for (int s8 = 0; s8 < 8; ++s8) oo = MFMA32(*(const LAS bf16x8*)(Sb + 32 * s8), *(const LAS bf16x8*)(Qb + 32 * s8), oo); }
        __syncthreads();
#pragma unroll
        for (int q = 0; q < 2; ++q) { const int dt = (wave >> 2) + 2 * q, dd = 32 * dt + r;
            const float eb63 = fast_exp2(((tot[dd] + tot[128 + dd]) + (tot[256 + dd] + tot[384 + dd])) * LOG2E);
#pragma unroll
            for (int i = 0; i < 16; ++i) Sacc[q][i] *= eb63;
            const LAS unsigned char* Vb = L + HG_VT + (32 * et + r) * 144 + 16 * h; const LAS unsigned char* Kb = L + HG_K3T + dd * 144 + 16 * h;
#pragma unroll
            for (int s4 = 0; s4 < 4; ++s4) Sacc[q] = MFMA32(*(const LAS bf16x8*)(Vb + 32 * s4), *(const LAS bf16x8*)(Kb + 32 * s4), Sacc[q]);
            LAS unsigned char* Sw = L + HG_SB + dd * 2;
#pragma unroll
            for (int i = 0; i < 16; i += 2) { const unsigned w = pk2(Sacc[q][i], Sacc[q][i + 1]);
                *(LAS unsigned short*)(Sw + (32 * et + crow(i, h)) * 272) = (unsigned short)(w & 0xffffu); *(LAS unsigned short*)(Sw + (32 * et + crow(i + 1, h)) * 272) = (unsigned short)(w >> 16); } }
        { const LAS unsigned char* Vb = L + HG_VT + (32 * et + r) * 144 + 16 * h; const LAS unsigned char* Ab = L + HG_AT + (32 * tt2 + r) * 144 + 16 * h;
          oo = MFMA32(*(const LAS bf16x8*)(Vb), *(const LAS bf16x8*)(Ab), oo); oo = MFMA32(*(const LAS bf16x8*)(Vb + 32), *(const LAS bf16x8*)(Ab + 32), oo);
          if (tt2) { oo = MFMA32(*(const LAS bf16x8*)(Vb + 64), *(const LAS bf16x8*)(Ab + 64), oo); oo = MFMA32(*(const LAS bf16x8*)(Vb + 96), *(const LAS bf16x8*)(Ab + 96), oo); } }
        { float ss = 0.f;
#pragma unroll
          for (int i = 0; i < 16; ++i) ss += oo[i] * oo[i];
          ss = xhalf_sum(ss);
          if (h == 0) ssp[(32 * tt2 + r) * 4 + et] = ss; }
        __syncthreads();
        { const f32x4 s4 = *(const LAS f32x4*)(ssp + (32 * tt2 + r) * 4); const float rn = rsqrtf(((s4.x + s4.y) + (s4.z + s4.w)) * (1.f / HD) + EPS);
          const size_t row = (size_t)(b * T + 64 * c + 32 * tt2 + r);
#pragma unroll
          for (int g4 = 0; g4 < 4; ++g4) { const int e0 = 32 * et + 8 * g4 + 4 * h;
              const u32x2 gw = gw4[g4]; const f32x4 gn = gn4[g4];
              u32x2 w; w.x = pk2(oo[4 * g4] * rn * gn.x * sigmoidf_(bflo(gw.x)), oo[4 * g4 + 1] * rn * gn.y * sigmoidf_(bfhi(gw.x)));
              w.y = pk2(oo[4 * g4 + 2] * rn * gn.z * sigmoidf_(bflo(gw.y)), oo[4 * g4 + 3] * rn * gn.w * sigmoidf_(bfhi(gw.y)));
              *(u32x2*)(OH + akm(row, 2 * BW + hh * HD + e0)) = w; } }
    }
}

constexpr int AT_K = 0, AT_V = 32768, AT_TAB = 73728, AT_IMP = 75776, AT_SELM = 109568, AT_MISC = 109824;
constexpr int AT_BT = AT_MISC + 4096, BT_N = 704;
constexpr int K_TB = 16384, V_RS = 320, V_TB = 64 * V_RS;
__device__ __forceinline__ unsigned koff(int row, int ch) { return 256u * (unsigned)row + 16u * (unsigned)(ch ^ (((row & 3) << 2) | ((row >> 2) & 3))); }
struct Stg { u32x4 k0, k1, v0, v1; };
__device__ __forceinline__ void stg_load(Stg& s, const bf16_t* Kp, const bf16_t* Vp, int ld, int tid) {
    const int row = tid >> 4, ch = tid & 15;
    s.k0 = *(const u32x4*)(Kp + (size_t)row * ld + ch * 8); s.k1 = *(const u32x4*)(Kp + (size_t)(row + 32) * ld + ch * 8);
    s.v0 = *(const u32x4*)(Vp + (size_t)row * ld + ch * 8); s.v1 = *(const u32x4*)(Vp + (size_t)(row + 32) * ld + ch * 8);
}
__device__ __forceinline__ void stg_write(const Stg& s, LAS unsigned char* L, int tid, int buf) {
    const int row = tid >> 4, ch = tid & 15;
    *(LAS u32x4*)(L + AT_K + buf * K_TB + koff(row, ch)) = s.k0; *(LAS u32x4*)(L + AT_K + buf * K_TB + koff(row + 32, ch)) = s.k1;
    *(LAS u32x4*)(L + AT_V + buf * V_TB + row * V_RS + ch * 16) = s.v0; *(LAS u32x4*)(L + AT_V + buf * V_TB + (row + 32) * V_RS + ch * 16) = s.v1;
}
__device__ __forceinline__ float xhalf_max(float v) { auto rr = __builtin_amdgcn_permlane32_swap(__float_as_uint(v), __float_as_uint(v), false, false); return fmaxf(__uint_as_float(rr[0]), __uint_as_float(rr[1])); }
__device__ __forceinline__ float xhalf_sum(float v) { auto rr = __builtin_amdgcn_permlane32_swap(__float_as_uint(v), __float_as_uint(v), false, false); return __uint_as_float(rr[0]) + __uint_as_float(rr[1]); }
__device__ __forceinline__ float xhalf_get(float v, int h) { auto rr = __builtin_amdgcn_permlane32_swap(__float_as_uint(v), __float_as_uint(v), false, false); return __uint_as_float(h ? rr[0] : rr[1]); }
__device__ __forceinline__ void qk_tile(f32x16& p0, f32x16& p1, const LAS unsigned char* L, int buf, const bf16x8 (&qf)[8], int r, int h, const float init = 0.f) {
#pragma unroll
    for (int i = 0; i < 16; ++i) { p0[i] = init; p1[i] = init; }
    const LAS unsigned char* Kb = L + AT_K + buf * K_TB;
    bf16x8 a0[8], a1[8];
#pragma unroll
    for (int s = 0; s < 8; ++s) { a0[s] = *(const LAS bf16x8*)(Kb + koff(r, 2 * s + h)); a1[s] = *(const LAS bf16x8*)(Kb + koff(r + 32, 2 * s + h)); }
#pragma unroll
    for (int s = 0; s < 8; ++s) { p0 = MFMA32(a0[s], qf[s], p0); p1 = MFMA32(a1[s], qf[s], p1); }
    __builtin_amdgcn_sched_group_barrier(0x100, 4, 0);
#pragma unroll
    for (int i = 0; i < 6; ++i) { __builtin_amdgcn_sched_group_barrier(0x008, 2, 0); __builtin_amdgcn_sched_group_barrier(0x100, 2, 0); }
    __builtin_amdgcn_sched_group_barrier(0x008, 4, 0);
}
__device__ __forceinline__ bf16x8 pack8(const f32x16& p, int s) {
    u32x4 w; w.x = pk2(p[8 * s], p[8 * s + 1]); w.y = pk2(p[8 * s + 2], p[8 * s + 3]); w.z = pk2(p[8 * s + 4], p[8 * s + 5]); w.w = pk2(p[8 * s + 6], p[8 * s + 7]);
    return __builtin_bit_cast(bf16x8, w);
}
__device__ __forceinline__ void pv_tile(f32x16 (&o)[4], const f32x16& p0, const f32x16& p1, const LAS unsigned char* L, int buf, int lane) {
    bf16x8 pb[4]; pb[0] = pack8(p0, 0); pb[1] = pack8(p0, 1); pb[2] = pack8(p1, 0); pb[3] = pack8(p1, 1);
    const LAS unsigned char* vb = L + AT_V + buf * V_TB + (4 * (lane >> 5) + ((lane & 15) >> 2)) * V_RS + ((lane >> 4) & 1) * 32 + (lane & 3) * 8;
    __builtin_amdgcn_sched_barrier(0);
    s16x4 lo[16], hi[16];
#pragma unroll
    for (int c = 0; c < 4; ++c)
#pragma unroll
        for (int s = 0; s < 4; ++s) { lo[4 * c + s] = __builtin_amdgcn_ds_read_tr16_b64_v4i16((LAS s16x4*)(vb + (16 * s) * V_RS + 64 * c)); hi[4 * c + s] = __builtin_amdgcn_ds_read_tr16_b64_v4i16((LAS s16x4*)(vb + (16 * s + 8) * V_RS + 64 * c)); }
#pragma unroll
    for (int c = 0; c < 4; ++c)
#pragma unroll
        for (int s = 0; s < 4; ++s) o[c] = MFMA32(__builtin_shufflevector(lo[4 * c + s], hi[4 * c + s], 0, 1, 2, 3, 4, 5, 6, 7), pb[s], o[c]);
    __builtin_amdgcn_sched_group_barrier(0x100, 4, 1);
#pragma unroll
    for (int i = 0; i < 14; ++i) { __builtin_amdgcn_sched_group_barrier(0x008, 1, 1); __builtin_amdgcn_sched_group_barrier(0x100, 2, 1); }
    __builtin_amdgcn_sched_group_barrier(0x008, 2, 1);
    __builtin_amdgcn_sched_barrier(0);
}
#ifndef SM_THR
#define SM_THR 6.f
#endif
__device__ __forceinline__ void softmax_step(f32x16& p0, f32x16& p1, float& m, float& l, f32x16 (&o)[4]) {
    float mx = p0[0];
#pragma unroll
    for (int i = 1; i < 16; ++i) mx = fmaxf(mx, p0[i]);
#pragma unroll
    for (int i = 0; i < 16; ++i) mx = fmaxf(mx, p1[i]);
    mx = xhalf_max(mx);
    const bool live = mx > -3.0e38f;
    if (__any(live && (l == 0.f || mx > SM_THR * LOG2E))) {
        const float d = live ? (l == 0.f ? mx : fmaxf(mx, 0.f)) : 0.f;
        const float alpha = l == 0.f ? 1.f : fast_exp2(-d); m += d; l *= alpha;
#pragma unroll
        for (int i = 0; i < 16; ++i) { p0[i] -= d; p1[i] -= d; }
        if (!__all(alpha == 1.f)) {
#pragma unroll
            for (int c = 0; c < 4; ++c)
#pragma unroll
                for (int i = 0; i < 16; ++i) o[c][i] *= alpha; }
    }
    float ps = 0.f;
#pragma unroll
    for (int i = 0; i < 16; ++i) { p0[i] = fast_exp2(p0[i]); ps += p0[i]; }
#pragma unroll
    for (int i = 0; i < 16; ++i) { p1[i] = fast_exp2(p1[i]); ps += p1[i]; }
    l += xhalf_sum(ps);
}
__device__ __forceinline__ void store_ot(const f32x16 (&o)[4], float sc, bf16_t* base, size_t row, int col  , int h, bool add) {
    bf16_t* p0 = base + akm(row, col) + 4 * h;
#pragma unroll
    for (int c = 0; c < 4; ++c)
#pragma unroll
        for (int g4 = 0; g4 < 4; ++g4) { u32x2* p = (u32x2*)(p0 + (size_t)(c >> 1) * ((size_t)M * 64) + 32 * (c & 1) + 8 * g4);
            float v0 = sc * o[c][4 * g4], v1 = sc * o[c][4 * g4 + 1], v2 = sc * o[c][4 * g4 + 2], v3 = sc * o[c][4 * g4 + 3];
            if (add) { const u32x2 w0 = *p; v0 += bflo(w0.x); v1 += bfhi(w0.x); v2 += bflo(w0.y); v3 += bfhi(w0.y); }
            u32x2 w; w.x = pk2(v0, v1); w.y = pk2(v2, v3); *p = w; }
}

__device__ __forceinline__ void item_sb(Frame& F, KArgs a, int item) {
    LAS unsigned char* L = F.lds;
    const int qb = 7 - (item >> 7), rem = item & 127, b = rem >> 3, hh = rem & 7, t0 = qb * 256;
    const int tid = F.tid, lane = F.lane, wave = F.wave, r = lane & 31, h = lane >> 5;
    const int tq = t0 + 32 * wave + r;
    const bf16_t* P = (const bf16_t*)(F.ws + WS_P); const size_t rowq = (size_t)(b * T + tq);
    const bf16_t* Kb = P + (size_t)(b * T) * NPC + PKSB + hh * HD; const bf16_t* Vb = P + (size_t)(b * T) * NPC + PVSB + hh * HD;
    bf16x8 qf[8];
#pragma unroll
    for (int s = 0; s < 8; ++s) qf[s] = *(const bf16x8*)(P + rowq * NPC + PQS + hh * HD + 16 * s + 8 * h);
    f32x16 o[4];
#pragma unroll
    for (int c = 0; c < 4; ++c)
#pragma unroll
        for (int i = 0; i < 16; ++i) o[c][i] = 0.f;
    float C = 1.f; bool wdone = false;
    volatile LAS unsigned* flags = (volatile LAS unsigned*)(L + AT_MISC);
    Stg st; int j = 4 * qb + 3, buf = 0, it = 0;
    stg_load(st, Kb + (size_t)(64 * j) * NPC, Vb + (size_t)(64 * j) * NPC, NPC, tid);
    __syncthreads();
    stg_write(st, L, tid, 0);
    if (j > 0) stg_load(st, Kb + (size_t)(64 * (j - 1)) * NPC, Vb + (size_t)(64 * (j - 1)) * NPC, NPC, tid);
    for (;;) {
        if (lane == 0) flags[(it & 1) * 8 + wave] = wdone ? 1u : 0u;
        __syncthreads();
        unsigned nd = 0;
#pragma unroll
        for (int w = 0; w < 8; ++w) nd += flags[(it & 1) * 8 + w];
        if (__builtin_amdgcn_readfirstlane(nd) == 8u) break;
        if (j > 0) stg_write(st, L, tid, buf ^ 1);
        if (j > 1) stg_load(st, Kb + (size_t)(64 * (j - 2)) * NPC, Vb + (size_t)(64 * (j - 2)) * NPC, NPC, tid);
        const bool active = !wdone && (64 * j <= t0 + 32 * wave + 30);
        if (active) {
            f32x16 p0, p1; qk_tile(p0, p1, L, buf, qf, r, h);
            float om0[16], om1[16];
            const int kb = 64 * j + 4 * h;
#define SB_ELEM(MASK) do { _Pragma("unroll") for (int i = 0; i < 16; ++i) { const int key0 = kb + (i & 3) + 8 * (i >> 2); \
                { const float ex = fast_exp2(fminf(p0[i], 120.f)); float be = fast_rcp(1.f + ex), om = ex * be; \
                  if (MASK) { const bool cz = key0 < tq; om = cz ? om : 1.f; be = cz ? be : 0.f; } om0[i] = om; p0[i] = be; } \
                { const float ex = fast_exp2(fminf(p1[i], 120.f)); float be = fast_rcp(1.f + ex), om = ex * be; \
                  if (MASK) { const bool cz = key0 + 32 < tq; om = cz ? om : 1.f; be = cz ? be : 0.f; } om1[i] = om; p1[i] = be; } } } while (0)
            SB_ELEM(false);
#undef SB_ELEM
            if (64 * j + 63 >= t0 + 32 * wave) {
#pragma unroll
                for (int i = 0; i < 16; ++i) { const int key0 = kb + (i & 3) + 8 * (i >> 2); const bool c0 = key0 < tq, c1 = key0 + 32 < tq;
                    om0[i] = c0 ? om0[i] : 1.f; p0[i] = c0 ? p0[i] : 0.f; om1[i] = c1 ? om1[i] : 1.f; p1[i] = c1 ? p1[i] : 0.f; } }
            float Tm[2][4], Tr[2][4];
#pragma unroll
            for (int g4 = 0; g4 < 4; ++g4) { Tm[0][g4] = (om0[4 * g4] * om0[4 * g4 + 1]) * (om0[4 * g4 + 2] * om0[4 * g4 + 3]); Tm[1][g4] = (om1[4 * g4] * om1[4 * g4 + 1]) * (om1[4 * g4 + 2] * om1[4 * g4 + 3]); }
#pragma unroll
            for (int k = 0; k < 2; ++k)
#pragma unroll
                for (int g4 = 0; g4 < 4; ++g4) Tr[k][g4] = xhalf_get(Tm[k][g4], h);
            float aft[2][4]; float run = C;
#pragma unroll
            for (int G = 15; G >= 0; --G) { const int k = G >> 3, g4 = (G >> 1) & 3, par = G & 1;
                const float tg = (par == 1) ? (h ? Tm[k][g4] : Tr[k][g4]) : (h ? Tr[k][g4] : Tm[k][g4]);
                if (par == 1) { if (h) aft[k][g4] = run; } else { if (!h) aft[k][g4] = run; }
                run *= tg; }
            C = run;
#pragma unroll
            for (int g4 = 0; g4 < 4; ++g4) {
                { float ca = aft[0][g4];
#pragma unroll
                  for (int e = 3; e >= 0; --e) { const int i = 4 * g4 + e; const float w_ = p0[i] * ca; ca *= om0[i]; p0[i] = w_; } }
                { float ca = aft[1][g4];
#pragma unroll
                  for (int e = 3; e >= 0; --e) { const int i = 4 * g4 + e; const float w_ = p1[i] * ca; ca *= om1[i]; p1[i] = w_; } }
            }
            pv_tile(o, p0, p1, L, buf, lane);
            wdone = __all(C < 1e-30f);
        }
        if (j == 0) break;
        --j; buf ^= 1; ++it;
    }
    store_ot(o, 1.f, (bf16_t*)(F.ws + WS_OBR), rowq, BW + hh * HD, h, false);
}

__device__ __forceinline__ void item_nsa(Frame& F, KArgs a, int item) {
    LAS unsigned char* L = F.lds;
    const int qblk = 31 - (item >> 5), rem = item & 31, b = rem >> 1, g = rem & 1, t0 = qblk * 64;
    const int tid = F.tid, lane = F.lane, wave = F.wave, r = lane & 31, h = lane >> 5, hr = wave >> 1, th = wave & 1;
    const int tl = 32 * th + r, tq = t0 + tl, hq = g * 4 + hr;
    const bf16_t* P = (const bf16_t*)(F.ws + WS_P);
    LAS float* tab = (LAS float*)(L + AT_TAB); LAS float* imp = (LAS float*)(L + AT_IMP); volatile LAS unsigned* selm = (volatile LAS unsigned*)(L + AT_SELM); LAS unsigned* misc = (LAS unsigned*)(L + AT_MISC);
    { const int hh = tid >> 7, dd = tid & 127; tab[tid] = a->in[I_RELB][t5_bucket(dd) * 8 + g * 4 + hh] * LOG2E; }
    if (tid == 0) misc[0] = 0u;
    bf16x8 qf[8];
#pragma unroll
    for (int s = 0; s < 8; ++s) qf[s] = *(const bf16x8*)(P + (size_t)(b * T + tq) * NPC + PQN + hq * HD + 16 * s + 8 * h);
    f32x16 o[4];
    Stg st;
    auto opq = [](int v) { asm volatile("" : "+v"(v)); return v; };
#define NSA_GATE(i) sigmoidf_(bf2f(P[((size_t)(b * T + opq(tq))) * NPC + PGN + hq * 3 + (i)]))
#define NSA_OUT() (bf16_t*)(F.ws + WS_OBR), (size_t)(b * T + opq(tq)), hq * HD
    {
        const bf16_t* kc = (const bf16_t*)(F.ws + WS_MISC + MISC_KCMP) + (size_t)((b * 2 + g) * 128) * HD; const bf16_t* vc = (const bf16_t*)(F.ws + WS_MISC + MISC_VCMP) + (size_t)((b * 2 + g) * 128) * HD;
        const bool two = qblk >= 16;
        f32x16 pc[4];
        __syncthreads();
        { Stg st1; stg_load(st, kc, vc, HD, tid); if (two) stg_load(st1, kc + 64 * HD, vc + 64 * HD, HD, tid);
          stg_write(st, L, tid, 0); if (two) stg_write(st1, L, tid, 1); }
        { LAS float* bt = (LAS float*)(L + AT_BT);
          for (int idx = tid; idx < 4 * BT_N; idx += 512) { const int hh = idx / BT_N, d = idx - hh * BT_N - 64;
              bt[idx] = (d < 0 || d >= 512) ? -__builtin_inff() : tab[hh * 128 + (d > 113 ? 113 : d)]; } }
        __syncthreads();
        qk_tile(pc[0], pc[1], L, 0, qf, r, h);
        if (two) qk_tile(pc[2], pc[3], L, 1, qf, r, h);
        float mx = -1e30f;
#pragma unroll
        for (int k = 0; k < 4; ++k) { if (k >= 2 && !two) break;
#pragma unroll
            for (int i = 0; i < 16; ++i) { const int n = 32 * k + crow(i, h); const int dc = tq - (16 * n + 31); const int di = dc < 113 ? dc : 113;
                const float sv = dc >= 0 ? pc[k][i] + tab[hr * 128 + (di < 0 ? 0 : di)] : -__builtin_inff(); pc[k][i] = sv; mx = fmaxf(mx, sv); } }
        mx = xhalf_max(mx);
        float sum = 0.f;
#pragma unroll
        for (int k = 0; k < 4; ++k) { if (k >= 2 && !two) break;
#pragma unroll
            for (int i = 0; i < 16; ++i) { const float e = fast_exp2(pc[k][i] - mx); pc[k][i] = e; sum += e; } }
        sum = xhalf_sum(sum);
        const float inv = 1.f / fmaxf(sum, 1e-30f);
#pragma unroll
        for (int k = 0; k < 4; ++k)
#pragma unroll
            for (int i = 0; i < 16; ++i) pc[k][i] = (k >= 2 && !two) ? 0.f : pc[k][i] * inv;
        float gs[16], gl[16], rc[16];
#pragma unroll
        for (int k = 0; k < 4; ++k)
#pragma unroll
            for (int g4 = 0; g4 < 4; ++g4) { gs[4 * k + g4] = (pc[k][4 * g4] + pc[k][4 * g4 + 1]) + (pc[k][4 * g4 + 2] + pc[k][4 * g4 + 3]); gl[4 * k + g4] = pc[k][4 * g4 + 3]; }
#pragma unroll
        for (int f = 0; f < 16; ++f) rc[f] = xhalf_get(gl[f], h);
#pragma unroll
        for (int f = 0; f < 16; ++f) { const float prev = h ? rc[f] : (f >= 1 ? rc[f - 1] : 0.f); const int G = 8 * (f >> 2) + 2 * (f & 3) + h;
            imp[(hr * 64 + tl) * 33 + G] = gs[f] + prev; }
#pragma unroll
        for (int c = 0; c < 4; ++c)
#pragma unroll
            for (int i = 0; i < 16; ++i) o[c][i] = 0.f;
        pv_tile(o, pc[0], pc[1], L, 0, lane);
        if (two) pv_tile(o, pc[2], pc[3], L, 1, lane);
        store_ot(o, NSA_GATE(0), NSA_OUT(), h, false);
    }
    __syncthreads();
    const int tk = tid >> 3, part = tid & 7;
    if (qblk >= 16) {
#pragma unroll
        for (int q = 0; q < 4; ++q) { const int jj = part + 8 * q; imp[tk * 33 + jj] = (imp[tk * 33 + jj] + imp[(64 + tk) * 33 + jj]) + (imp[(128 + tk) * 33 + jj] + imp[(192 + tk) * 33 + jj]); }
    }
    __syncthreads();
    {
        unsigned msk;
        if (qblk < 16) msk = (2u << qblk) - 1u;
        else {
            msk = 0u;
#pragma unroll
            for (int q = 0; q < 4; ++q) { const int jj = part + 8 * q;
                if (jj >= 1 && jj <= qblk - 2) { const float v = imp[tk * 33 + jj]; int rank = 0;
#pragma unroll
                    for (int j2 = 1; j2 < 30; ++j2) { const float v2 = imp[tk * 33 + j2]; rank += (j2 <= qblk - 2 && (v2 > v || (v2 == v && j2 < jj))) ? 1 : 0; }
                    if (rank < 13) msk |= 1u << jj; } }
            msk |= (unsigned)__shfl_xor((int)msk, 1); msk |= (unsigned)__shfl_xor((int)msk, 2); msk |= (unsigned)__shfl_xor((int)msk, 4);
            msk |= 1u | (1u << (qblk - 1)) | (1u << qblk);
        }
        if (part == 0) selm[tk] = msk;
        unsigned om = msk;
#pragma unroll
        for (int off = 8; off < 64; off <<= 1) om |= (unsigned)__shfl_xor((int)om, off);
        if (lane == 0) __hip_atomic_fetch_or(misc, om, __ATOMIC_RELAXED, __HIP_MEMORY_SCOPE_WORKGROUP);
    }
    __syncthreads();
    const bf16_t* Kbase = P + (size_t)(b * T) * NPC + g * HD;
    const float bfar = tab[hr * 128 + 113];
    for (int rep = 0; rep < (MK_PROBE == 31 ? 2 : 1); ++rep) {
        if (rep) __syncthreads();
        unsigned om = __builtin_amdgcn_readfirstlane(misc[0]); const unsigned mym = selm[tl];
        float m = 0.f, l = 0.f;
#pragma unroll
        for (int c = 0; c < 4; ++c)
#pragma unroll
            for (int i = 0; i < 16; ++i) o[c][i] = 0.f;
        int jc = __builtin_ctz(om); om &= om - 1u;
        stg_load(st, Kbase + PKS + (size_t)(64 * jc) * NPC, Kbase + PVS + (size_t)(64 * jc) * NPC, NPC, tid);
        stg_write(st, L, tid, 0);
        int jn = om ? __builtin_ctz(om) : -1; if (jn >= 0) { om &= om - 1u; stg_load(st, Kbase + PKS + (size_t)(64 * jn) * NPC, Kbase + PVS + (size_t)(64 * jn) * NPC, NPC, tid); }
        int buf = 0;
        for (;;) {
            __syncthreads();
            if (jn >= 0) stg_write(st, L, tid, buf ^ 1);
            const int jnn = om ? __builtin_ctz(om) : -1; if (jnn >= 0) { om &= om - 1u; stg_load(st, Kbase + PKS + (size_t)(64 * jnn) * NPC, Kbase + PVS + (size_t)(64 * jnn) * NPC, NPC, tid); }
            const bool sel = (mym >> jc) & 1u; const bool farsel = jc <= qblk - 3;
            f32x16 p0, p1; qk_tile(p0, p1, L, buf, qf, r, h, sel ? (farsel ? bfar - m : -m) : -__builtin_inff());
            if (!farsel) {
                const LAS float* bp = (const LAS float*)(L + AT_BT) + hr * BT_N + (tq - 64 * jc + 5 - 4 * h);
#pragma unroll
                for (int i = 0; i < 16; ++i) { const int cc = 27 - ((i & 3) + 8 * (i >> 2)); p0[i] += bp[cc + 32]; p1[i] += bp[cc]; }
            }
            softmax_step(p0, p1, m, l, o);
            pv_tile(o, p0, p1, L, buf, lane);
            if (jn < 0) break;
            jc = jn; jn = jnn; buf ^= 1;
        }
        if (rep == (MK_PROBE == 31 ? 1 : 0)) store_ot(o, NSA_GATE(1) / l, NSA_OUT(), h, true);
    }
    for (int rep = 0; rep < (MK_PROBE == 32 ? 2 : 1); ++rep) {
        float m = 0.f, l = 0.f;
#pragma unroll
        for (int c = 0; c < 4; ++c)
#pragma unroll
            for (int i = 0; i < 16; ++i) o[c][i] = 0.f;
        int jc = qblk >= 8 ? qblk - 8 : 0;
        stg_load(st, Kbase + PKW + (size_t)(64 * jc) * NPC, Kbase + PVW + (size_t)(64 * jc) * NPC, NPC, tid);
        __syncthreads();
        stg_write(st, L, tid, 0);
        if (jc < qblk) stg_load(st, Kbase + PKW + (size_t)(64 * (jc + 1)) * NPC, Kbase + PVW + (size_t)(64 * (jc + 1)) * NPC, NPC, tid);
        int buf = 0;
        for (;;) {
            __syncthreads();
            if (jc < qblk) stg_write(st, L, tid, buf ^ 1);
            if (jc + 1 < qblk) stg_load(st, Kbase + PKW + (size_t)(64 * (jc + 2)) * NPC, Kbase + PVW + (size_t)(64 * (jc + 2)) * NPC, NPC, tid);
            const bool interior = jc <= qblk - 3 && jc >= qblk - 7;
            f32x16 p0, p1; qk_tile(p0, p1, L, buf, qf, r, h, interior ? bfar - m : -m);
            if (!interior) {
                const LAS float* bp = (const LAS float*)(L + AT_BT) + hr * BT_N + (tq - 64 * jc + 5 - 4 * h);
#pragma unroll
                for (int i = 0; i < 16; ++i) { const int cc = 27 - ((i & 3) + 8 * (i >> 2)); p0[i] += bp[cc + 32]; p1[i] += bp[cc]; }
            }
            softmax_step(p0, p1, m, l, o);
            pv_tile(o, p0, p1, L, buf, lane);
            if (jc == qblk) break;
            ++jc; buf ^= 1;
        }
        if (rep == (MK_PROBE == 32 ? 1 : 0)) store_ot(o, NSA_GATE(2) / l, NSA_OUT(), h, true);
    }
#undef NSA_GATE
#undef NSA_OUT
}

constexpr int NI_H = 128, NI_S = 1024, NI_C = 256, NI_N = 512, NI_A = 1024;
#define FRESH_F() do { unsigned on_ = ~0u; asm volatile("" : "+s"(on_)); int t_ = F.wave * 64 + (int)__builtin_amdgcn_mbcnt_hi(on_, __builtin_amdgcn_mbcnt_lo(on_, 0u)); asm volatile("" : "+v"(t_)); F.tid = t_; F.lane = t_ & 63; F.wave = __builtin_amdgcn_readfirstlane(t_ >> 6); } while (0)
__device__ __forceinline__ void phase_Ca(Frame& F, KArgs a, int layer, int bank, int types) {
    unsigned* head = F.ctl + CW_QUEUE + 64 * (layer * 8) + bank * 4096;
    if (types & 1) for (;;) { const int it = q_next(F, head + 0); if (it >= NI_H) break; FRESH_F(); item_hgrn(F, a, layer, it); }
    if (types & 2) for (;;) { const int it = q_next(F, head + 64); if (it >= NI_S) break; FRESH_F(); item_sb(F, a, it); }
    if (types & 4) for (;;) { const int it = q_next(F, head + 128); if (it >= NI_C) break; FRESH_F(); item_compress(F, a, layer, it); }
    if (types & 8) for (;;) { const int it = q_next(F, head + 192); if (it >= NI_N) break; FRESH_F(); item_norm(F, a, layer, it); }
}
__device__ __forceinline__ void phase_Cb(Frame& F, KArgs a, int layer, int bank) {
    unsigned* head = F.ctl + CW_QUEUE + 64 * (layer * 8 + 4) + bank * 4096;
    for (;;) { const int it = q_next(F, head + 0); if (it >= NI_A) break; FRESH_F(); item_nsa(F, a, it); }
}

__global__ void __launch_bounds__(512, 2) mega(Args karg) {
    extern __shared__ __attribute__((aligned(16))) unsigned char lds_raw[];
    Frame F;
    F.lds = (LAS unsigned char*)lds_raw; F.MISC = (volatile LAS unsigned*)(F.lds + MISC_OFF);
    F.tid = threadIdx.x; F.lane = F.tid & 63; F.wave = __builtin_amdgcn_readfirstlane(F.tid >> 6); F.G = gridDim.x; F.bid = blockIdx.x;
    KArgs a = (KArgs)__builtin_amdgcn_kernarg_segment_ptr();
    F.ws = a->ws; F.ctl = (unsigned*)(a->ws + WS_CTL);
    if (F.tid < 64) F.MISC[F.tid] = 0u;
    __syncthreads();
    const int lo = karg.ph_lo, hi = karg.ph_hi;
    XcdBarrier bar; bar.bar = F.ctl + CW_BAR; bar.x = 0; bar.st = F.MISC + 8;
    if (hi - lo > 1) bar = xcd_barrier_post(F.ctl + CW_BAR, F.MISC + 8);
#define IN(k) (lo <= (k) && (k) < hi)
#define ON(k) (((MK_PHASE_MASK & MK_BUILD_MASK) >> (k)) & 1)
#define GRID_BAR() do { unsigned* bp_ = (unsigned*)(a->ws + WS_CTL) + CW_BAR; asm volatile("" : "+s"(bp_)); bar.bar = bp_; xcd_barrier(bar); } while (0)
#define SEAM(k) do { if (IN(k) && IN((k) + 1)) GRID_BAR(); } while (0)
    bf16_t* Hb; bf16_t* Pb; const int wave_s = __builtin_amdgcn_readfirstlane(threadIdx.x >> 6);
    for (int layer = 0; layer < DEPTH; ++layer) {
        const int pb = layer * 10;
#define FRESH() do { unsigned on_ = ~0u; asm volatile("" : "+s"(on_)); int t_ = wave_s * 64 + (int)__builtin_amdgcn_mbcnt_hi(on_, __builtin_amdgcn_mbcnt_lo(on_, 0u)); asm volatile("" : "+v"(t_)); F.tid = t_; F.lane = t_ & 63; F.wave = __builtin_amdgcn_readfirstlane(t_ >> 6); \
        asm volatile("" : "+s"(a)); F.ws = a->ws; F.ctl = (unsigned*)(a->ws + WS_CTL); Hb = (bf16_t*)(F.ws + WS_H); Pb = (bf16_t*)(F.ws + WS_P); } while (0)
        if (ON(0) && IN(pb + 0)) { FRESH(); if (MK_PROBE == 0) { phase_A(F, a, layer); GRID_BAR(); } phase_A(F, a, layer); } SEAM(pb + 0);
        if (ON(1) && IN(pb + 1)) for (int rep = 0; rep < (MK_PROBE == 1 ? 2 : 1); ++rep) { FRESH();
            if (rep) GRID_BAR();
            if (MK_STAGGER) { const unsigned long long t0 = __builtin_amdgcn_s_memrealtime(), dl = (unsigned long long)((F.bid >> 3) & 7) * MK_STAGGER; while (__builtin_amdgcn_s_memrealtime() - t0 < dl) __builtin_amdgcn_s_sleep(4); }
            pg8::Gemm g{(const bf16_t*)(F.ws + WS_XB), (const bf16_t*)(F.ws + WS_WIN), M, NPC, DM, 1, 1}; pg8::StaticOrder S; S.init(M, NPC, F.G, F.bid);
            pg8::EpiStoreBf16 E{Pb, NPC, PGT / 256, PGN / 256, (const float*)(F.ws + WS_RSTD), (LAS const float*)(F.lds + pg8::LRS_OFF)};
            pg8::gemm_phase<pg8::EpiStoreBf16, pg8::StaticOrder, PG8_ALIGN, PG8_SP2>(F.lds, g, S, E, F.tid, (MK_DIAG && layer == 0 && F.bid == 0) ? (unsigned long long*)(F.ctl + 49152) : nullptr);
        } SEAM(pb + 1);
        if (ON(2) && IN(pb + 2)) { FRESH(); if (MK_PROBE >= 20 && MK_PROBE < 28) { phase_Ca(F, a, layer, 1, MK_PROBE - 20); GRID_BAR(); } phase_Ca(F, a, layer, 0, 15); } SEAM(pb + 2);
        if (ON(3) && IN(pb + 3)) { FRESH(); if (MK_PROBE == 3) { phase_Cb(F, a, layer, 1); GRID_BAR(); } phase_Cb(F, a, layer, 0); } SEAM(pb + 3);
        if (ON(4) && IN(pb + 4)) for (int rep = 0; rep < (MK_PROBE == 4 ? 2 : 1); ++rep) { FRESH();
            if (rep) GRID_BAR();
            pg8::Gemm g{(const bf16_t*)(F.ws + WS_OBR), (const bf16_t*)(F.ws + WS_WBR), M, DM, 3 * BW, 1, 1}; pg8::StaticOrder S; S.init(M, DM, F.G, F.bid);
            pg8::EpiGated E{Pb, Hb};
            pg8::gemm_phase<pg8::EpiGated, pg8::StaticOrder, PG8_ALIGN, PG8_SP2>(F.lds, g, S, E, F.tid);
        } SEAM(pb + 4);
        if (ON(5) && IN(pb + 5)) for (int rep = 0; rep < (MK_PROBE == 5 ? 2 : 1); ++rep) { FRESH();
            if (rep) GRID_BAR();
            pg8::Gemm g{Hb, (const bf16_t*)(F.ws + WS_WOUT), M, DM, DM, 1, 1}; pg8::StaticOrder S; S.init(M, DM, F.G, F.bid);
            pg8::EpiResidBf16 E{(MK_PROBE == 5 && rep == 0) ? (bf16_t*)(F.ws + WS_P) : (bf16_t*)(F.ws + WS_XB), nullptr, (MK_PROBE == 5 && rep == 0) ? (float*)(F.ws + WS_P + 256 * MiB) : (float*)(F.ws + WS_SSQ), DM};
            pg8::gemm_phase<pg8::EpiResidBf16, pg8::StaticOrder, PG8_ALIGN, PG8_SP2>(F.lds, g, S, E, F.tid);
        } SEAM(pb + 5);
        if (ON(6) && IN(pb + 6)) { FRESH(); if (MK_PROBE == 60) { GRID_BAR(); GRID_BAR(); GRID_BAR(); GRID_BAR(); } if (MK_PROBE == 6) { phase_F(F, a); GRID_BAR(); } phase_F(F, a); } SEAM(pb + 6);
        if (ON(7) && IN(pb + 7)) for (int rep = 0; rep < (MK_PROBE == 7 ? 2 : 1); ++rep) { FRESH();
            if (rep) GRID_BAR();
            if (MK_STAGGER) { const unsigned long long t0 = __builtin_amdgcn_s_memrealtime(), dl = (unsigned long long)((F.bid >> 3) & 7) * MK_STAGGER; while (__builtin_amdgcn_s_memrealtime() - t0 < dl) __builtin_amdgcn_s_sleep(4); }
            pg8::Gemm g{(const bf16_t*)(F.ws + WS_XB), (const bf16_t*)(F.ws + WS_WUP), M, NUP, DM, 1, 1}; pg8::StaticOrder S; S.init(M, NUP, F.G, F.bid);
            pg8::EpiConvAct E{F.ws, a, layer, (LAS const float*)(F.lds + pg8::LRS_OFF)};
            pg8::gemm_phase<pg8::EpiConvAct, pg8::StaticOrder, PG8_ALIGN, PG8_SP2>(F.lds, g, S, E, F.tid);
        } SEAM(pb + 7);
        if (ON(8) && IN(pb + 8)) { FRESH(); if (MK_PROBE == 8) { phase_H(F, a, layer); GRID_BAR(); } phase_H(F, a, layer); } SEAM(pb + 8);
        if (ON(9) && IN(pb + 9)) for (int rep = 0; rep < (MK_PROBE == 9 ? 2 : 1); ++rep) { FRESH();
            if (rep) GRID_BAR();
            pg8::Gemm g{(const bf16_t*)(F.ws + WS_ACT), (const bf16_t*)(F.ws + WS_WDN), M, DM, DFF, 1, 1}; pg8::StaticOrder S; S.init(M, DM, F.G, F.bid, 4, 1);
            pg8::EpiResidBf16 E{(MK_PROBE == 9 && rep == 0) ? (bf16_t*)(F.ws + WS_P) : (bf16_t*)(F.ws + WS_XB), (layer == DEPTH - 1 && !(MK_PROBE == 9 && rep == 0)) ? a->out : nullptr, (MK_PROBE == 9 && rep == 0) ? (float*)(F.ws + WS_P + 256 * MiB) : (float*)(F.ws + WS_SSQ), DM};
            pg8::gemm_phase<pg8::EpiResidBf16, pg8::StaticOrder, PG8_ALIGN, PG8_SP2>(F.lds, g, S, E, F.tid);
        } SEAM(pb + 9);
    }
#if MK_DIAG
    GRID_BAR();
    { const unsigned long long* dg = (const unsigned long long*)(F.ctl + 49152); const float kl = (float)(long long)(dg[1] - dg[0]), per = (float)(long long)(dg[2] - dg[0]);
      const float eps = MK_DIAG == 1 ? kl / per : (MK_DIAG == 2 ? per * 1e-4f : kl * 1e-4f);
      for (size_t i = (size_t)F.bid * 512 + threadIdx.x; i < (size_t)M * DM; i += (size_t)F.G * 512) a->out[i] *= (1.f + eps); }
#endif
}

extern "C" void kernel_launch(void* const* d_in, const int* in_sizes, int n_in, void* d_out, int out_size, void* d_ws, size_t ws_size, hipStream_t stream) {
    static int grid = 0;
    if (grid == 0) {
        if (n_in != 18 || in_sizes[0] != M * DM || out_size != M * DM || ws_size < WS_END) { fprintf(stderr, "kernel_launch: unexpected shapes / workspace (%d inputs, ws %zu)\n", n_in, ws_size); grid = -1; return; }
        int dev = 0, cus = 0, per_cu = 0;
        if (hipGetDevice(&dev) != hipSuccess || hipDeviceGetAttribute(&cus, hipDeviceAttributeMultiprocessorCount, dev) != hipSuccess) { grid = -1; return; }
        if (hipFuncSetAttribute((const void*)mega, hipFuncAttributeMaxDynamicSharedMemorySize, LDS_BYTES) != hipSuccess) { grid = -1; return; }
        if (hipOccupancyMaxActiveBlocksPerMultiprocessor(&per_cu, (const void*)mega, 512, LDS_BYTES) != hipSuccess || per_cu < 1) { fprintf(stderr, "kernel_launch: occupancy query says %d\n", per_cu); }
        (void)hipGetLastError();
        grid = cus;
    }
    if (grid < 0) return;
    (void)hipMemsetAsync((char*)d_ws + WS_CTL, 0, CTL_BYTES, stream);
    Args a{};
    for (int i = 0; i < 18; ++i) a.in[i] = (const float*)d_in[i];
    a.out = (float*)d_out; a.ws = (unsigned char*)d_ws;
#if MK_ONE_LAUNCH
    a.ph_lo = 0; a.ph_hi = DEPTH * 10;
    hipLaunchKernelGGL(mega, dim3(grid), dim3(512), LDS_BYTES, stream, a);
#else
    for (int p = 0; p < DEPTH * 10; ++p) { a.ph_lo = p; a.ph_hi = p + 1; hipLaunchKernelGGL(mega, dim3(grid), dim3(512), LDS_BYTES, stream, a); }
#endif
}
```
